# Optimizing an MI355X kernel written in HIP

```python
import math
import jax
import jax.numpy as jnp
from jax import lax
import numpy as np

D_MODEL = 1024
BATCH = 4
SEQ = 4096
DEPTH = 2

MEM_LEN = 256
EPS = 1e-6

MLA_HEADS = 4
MLA_Q_RANK = 256
MLA_KV_RANK = 128
MLA_NOPE = 128
MLA_ROPE = 64
MLA_V = 128
MLA_QK = MLA_NOPE + MLA_ROPE
ROPE_THETA = 10000.0
Q_BLOCK = 128

HG_HEADS = 4
HG_DK = 128
HG_DV = 128
HG_KW = HG_HEADS * HG_DK
HG_VW = HG_HEADS * HG_DV
HG_CHUNK = 64

S5_WIDTH = 512
S5_GROUP = 16
S5_GROUPS = S5_WIDTH // S5_GROUP
S5_STATE = 64

RW_HEADS = 8
RW_HEAD = 64
RW_WIDTH = RW_HEADS * RW_HEAD
RW_DECAY_LORA = 64
RW_AAA_LORA = 64
RW_GATE_LORA = 128
RW_MV_LORA = 32
RW_GN_EPS = 64e-5
RW_COLS = 3 * RW_WIDTH + RW_DECAY_LORA + RW_AAA_LORA + RW_GATE_LORA

N_BRANCH = 4
BRANCH_WIDTH = 512

X_HEADS = 4
X_HEAD_DIM = D_MODEL // X_HEADS

D_FF = 2816
CONV_W = 3

COL_SIZES = (MLA_Q_RANK, MLA_KV_RANK, MLA_ROPE,
             HG_KW, HG_KW, HG_VW, HG_VW,
             S5_WIDTH,
             RW_COLS,
             N_BRANCH * D_MODEL)
P_IN = MLA_Q_RANK + MLA_KV_RANK + MLA_ROPE + 2 * HG_KW + 2 * HG_VW + S5_WIDTH + RW_COLS + N_BRANCH * D_MODEL
RW_SIZES = (RW_WIDTH, RW_WIDTH, RW_WIDTH, RW_DECAY_LORA, RW_AAA_LORA, RW_GATE_LORA)

kernel_name = "hybrid_gated_mla_hgrn2_s5_rwkv7_block"


def split_cols(t, sizes):
    out, start = [], 0
    for n in sizes:
        out.append(t[..., start:start + n])
        start += n
    return out


def rmsnorm(x, g, eps=EPS):
    xf = x.astype(jnp.float32)
    y = xf * lax.rsqrt(jnp.mean(xf * xf, axis=-1, keepdims=True) + eps)
    return (y * g.astype(jnp.float32)).astype(x.dtype)


def rope_tables(positions):
    half = MLA_ROPE // 2
    inv_freq = ROPE_THETA ** (-jnp.arange(half, dtype=jnp.float32) / half)
    ang = positions.astype(jnp.float32)[..., None] * inv_freq
    return jnp.cos(ang), jnp.sin(ang)


def apply_rope(t, cos, sin):
    half = t.shape[-1] // 2
    t1, t2 = t[..., :half], t[..., half:]
    cos = cos.astype(t.dtype)
    sin = sin.astype(t.dtype)
    return jnp.concatenate([t1 * cos - t2 * sin, t1 * sin + t2 * cos], axis=-1)


def mla(cq, ckv, k_rope, cos, sin, q_norm, w_uq, kv_norm, w_ukv):
    B, S, _ = cq.shape
    H = MLA_HEADS
    q = (rmsnorm(cq, q_norm) @ w_uq).reshape(B, S, H, MLA_QK)
    kv = (rmsnorm(ckv, kv_norm) @ w_ukv).reshape(B, S, H, MLA_NOPE + MLA_V)
    q = jnp.concatenate([q[..., :MLA_NOPE],
                         apply_rope(q[..., MLA_NOPE:], cos[:, :, None], sin[:, :, None])], axis=-1)
    k_pe = apply_rope(k_rope, cos, sin)
    k = jnp.concatenate([kv[..., :MLA_NOPE],
                         jnp.broadcast_to(k_pe[:, :, None, :], (B, S, H, MLA_ROPE))], axis=-1)
    v = kv[..., MLA_NOPE:]
    q, k, v = (t.transpose(0, 2, 1, 3) for t in (q, k, v))
    nb = S // Q_BLOCK
    q_blocks = q.reshape(B, H, nb, Q_BLOCK, MLA_QK).transpose(2, 0, 1, 3, 4)
    k_pos = jnp.arange(S)
    scale = MLA_QK ** -0.5

    def one_block(args):
        qb, i = args
        s = jnp.einsum('bhqd,bhkd->bhqk', qb, k).astype(jnp.float32) * scale
        q_pos = i * Q_BLOCK + jnp.arange(Q_BLOCK)
        s = jnp.where(k_pos[None, :] <= q_pos[:, None], s, -jnp.inf)
        p = jax.nn.softmax(s, axis=-1).astype(v.dtype)
        return jnp.einsum('bhqk,bhkd->bhqd', p, v)

    o = lax.map(one_block, (q_blocks, jnp.arange(nb)))
    return o.transpose(1, 0, 3, 2, 4).reshape(B, S, H * MLA_V)


def hgrn2(qc, fc, ic, gc, lb, o_norm):
    B, S, _ = qc.shape
    H, C = HG_HEADS, HG_CHUNK
    f = lb + (1.0 - lb) * jax.nn.sigmoid(fc.astype(jnp.float32))
    logf = jnp.log(f)
    k = 1.0 - f

    def chunks(t, d):
        return t.astype(jnp.float32).reshape(B, S // C, C, H, d).transpose(1, 0, 3, 2, 4)

    xs = (chunks(qc, HG_DK), chunks(k, HG_DK), chunks(ic, HG_DV), chunks(logf, HG_DK))
    causal = jnp.tril(jnp.ones((C, C), dtype=bool))

    def step(state, inp):
        q, kk, v, lf = inp
        b = jnp.cumsum(lf, axis=2)
        diff = jnp.where(causal[:, :, None], b[:, :, :, None, :] - b[:, :, None, :, :], -jnp.inf)
        att = jnp.einsum('bhtk,bhsk,bhtsk->bhts', q, kk, jnp.exp(diff))
        o = (jnp.einsum('bhts,bhsv->bhtv', att, v)
             + jnp.einsum('bhtk,bhkv->bhtv', q * jnp.exp(b), state))
        b_last = b[:, :, -1:, :]
        state = (state * jnp.exp(b_last)[:, :, 0, :, None]
                 + jnp.einsum('bhsk,bhsv->bhkv', kk * jnp.exp(b_last - b), v))
        return state, o

    s0 = jnp.zeros((B, H, HG_DK, HG_DV), jnp.float32)
    _, o = lax.scan(step, s0, xs)
    o = o.transpose(1, 0, 3, 2, 4).reshape(B, S, H, HG_DV)
    o = o * lax.rsqrt(jnp.mean(o * o, axis=-1, keepdims=True) + EPS) * o_norm.astype(jnp.float32).reshape(H, HG_DV)
    o = o.reshape(B, S, HG_VW) * jax.nn.sigmoid(gc.astype(jnp.float32))
    return o.astype(qc.dtype)


def s5(u, A_re, A_im, log_step, B_re, B_im, C_re, C_im, D, w_glu, b_glu):
    Bn, S, _ = u.shape
    G, N = S5_GROUPS, S5_STATE
    f32 = jnp.float32
    uf = u.astype(f32).reshape(Bn, S, G, S5_GROUP)
    a_re = jnp.minimum(A_re.astype(f32), -1e-4)
    a_im = A_im.astype(f32)
    dt = jnp.exp(log_step.astype(f32))[:, None]
    mag = jnp.exp(dt * a_re)
    ab_re = mag * jnp.cos(dt * a_im)
    ab_im = mag * jnp.sin(dt * a_im)
    den = a_re * a_re + a_im * a_im
    z_re = ((ab_re - 1.0) * a_re + ab_im * a_im) / den
    z_im = (ab_im * a_re - (ab_re - 1.0) * a_im) / den
    Br, Bi = B_re.astype(f32), B_im.astype(f32)
    bb_re = z_re[..., None] * Br - z_im[..., None] * Bi
    bb_im = z_re[..., None] * Bi + z_im[..., None] * Br
    bu_re = jnp.einsum('bsgc,gnc->bsgn', uf, bb_re)
    bu_im = jnp.einsum('bsgc,gnc->bsgn', uf, bb_im)
    a_re_s = jnp.broadcast_to(ab_re[None, None], (Bn, S, G, N))
    a_im_s = jnp.broadcast_to(ab_im[None, None], (Bn, S, G, N))

    def combine(e1, e2):
        a1r, a1i, b1r, b1i = e1
        a2r, a2i, b2r, b2i = e2
        return (a2r * a1r - a2i * a1i,
                a2r * a1i + a2i * a1r,
                a2r * b1r - a2i * b1i + b2r,
                a2r * b1i + a2i * b1r + b2i)

    _, _, x_re, x_im = lax.associative_scan(combine, (a_re_s, a_im_s, bu_re, bu_im), axis=1)
    y = (jnp.einsum('bsgn,gcn->bsgc', x_re, C_re.astype(f32))
         - jnp.einsum('bsgn,gcn->bsgc', x_im, C_im.astype(f32)))
    y = y.reshape(Bn, S, S5_WIDTH) + D.astype(f32) * u.astype(f32)
    z = jax.nn.gelu(y)
    out = z * jax.nn.sigmoid(z @ w_glu.astype(f32) + b_glu.astype(f32))
    return out.astype(u.dtype)


def token_shift_mix(t, mu):
    prev = jnp.pad(t, ((0, 0), (1, 0), (0, 0)))[:, :-1]
    return t + (prev - t) * mu


def rwkv7(m, h, v_first, vres, w0, w_up, a0, a_up, g_up, k_k, k_a, r_k, ln_w, ln_b):
    B, S, _ = m.shape
    f32 = jnp.float32
    r, k, v, wd, ad, gd = split_cols(m, RW_SIZES)
    w_log = -jax.nn.softplus(-(w0 + jnp.tanh(wd) @ w_up)) - 0.5
    decay = jnp.exp(-jnp.exp(w_log.astype(f32)))
    a = jax.nn.sigmoid(a0 + ad @ a_up)
    g = jax.nn.sigmoid(gd) @ g_up
    if vres is not None:
        v_down, v_up, v_bias = vres
        v = v + (v_first - v) * jax.nn.sigmoid(v_bias + (h @ v_down) @ v_up)
    v_out = v

    def heads(t):
        return t.astype(f32).reshape(B, S, RW_HEADS, RW_HEAD)

    kk = heads(k * k_k)
    kk = kk * lax.rsqrt(jnp.sum(kk * kk, axis=-1, keepdims=True) + 1e-12)
    a_h = heads(a)
    k_a_h = k_a.astype(f32).reshape(RW_HEADS, RW_HEAD)
    k_h = heads(k) * (1.0 + (a_h - 1.0) * k_a_h)
    r_h, v_h, w_h = heads(r), heads(v), heads(decay)

    def step(st, inp):
        r_t, k_t, v_t, w_t, kk_t, a_t = inp
        sa = jnp.einsum('bhvk,bhk->bhv', st, -kk_t)
        st = (st * w_t[:, :, None, :] + sa[..., None] * (kk_t * a_t)[:, :, None, :]
              + v_t[..., None] * k_t[:, :, None, :])
        return st, jnp.einsum('bhvk,bhk->bhv', st, r_t)

    xs = tuple(t.transpose(1, 0, 2, 3) for t in (r_h, k_h, v_h, w_h, kk, a_h))
    s0 = jnp.zeros((B, RW_HEADS, RW_HEAD, RW_HEAD), f32)
    _, y = lax.scan(step, s0, xs)
    y = y.transpose(1, 0, 2, 3)
    mu = jnp.mean(y, axis=-1, keepdims=True)
    var = jnp.mean((y - mu) ** 2, axis=-1, keepdims=True)
    y = ((y - mu) * lax.rsqrt(var + RW_GN_EPS)).reshape(B, S, RW_WIDTH) * ln_w.astype(f32) + ln_b.astype(f32)
    bonus = jnp.sum(r_h * k_h * r_k.astype(f32), axis=-1, keepdims=True) * v_h
    y = (y + bonus.reshape(B, S, RW_WIDTH)) * g.astype(f32)
    return y.astype(m.dtype), v_out


def cross_attn(hq, hm, w_q, w_kv, w_o):
    B, S, D = hq.shape
    M = hm.shape[1]
    q = (hq @ w_q).reshape(B, S, X_HEADS, X_HEAD_DIM)
    kv = (hm @ w_kv).reshape(B, M, 2, X_HEADS, X_HEAD_DIM)
    k, v = kv[:, :, 0], kv[:, :, 1]
    s = jnp.einsum('bshd,bmhd->bhsm', q, k).astype(jnp.float32) * (X_HEAD_DIM ** -0.5)
    p = jax.nn.softmax(s, axis=-1).astype(v.dtype)
    o = jnp.einsum('bhsm,bmhd->bshd', p, v).reshape(B, S, D)
    return o @ w_o


def conv_ffn(h, w_gate_up, conv_w, conv_b, w_down):
    gu = h @ w_gate_up
    gate, up = gu[..., :D_FF], gu[..., D_FF:]
    gate = lax.conv_general_dilated(gate, conv_w[:, None, :].astype(gate.dtype), window_strides=(1,),
                                    padding=[(CONV_W - 1, 0)], dimension_numbers=('NWC', 'WIO', 'NWC'),
                                    feature_group_count=D_FF) + conv_b
    return (jax.nn.silu(gate) * up) @ w_down


def setup_inputs(seed: int = 0) -> dict:
    key = jax.random.key(seed)
    ks = list(jax.random.split(key, 64))

    def nk():
        return ks.pop()

    def nrm(shape, scale):
        return scale * jax.random.normal(nk(), shape, jnp.float32)

    def gain(shape):
        return 1.0 + nrm(shape, 0.02)

    L, D = DEPTH, D_MODEL
    x = nrm((BATCH, SEQ, D), 1.0)
    mem = nrm((BATCH, MEM_LEN, D), 1.0)
    offsets = jax.random.randint(nk(), (BATCH, 1), 0, 1024, dtype=jnp.int32)
    positions = offsets + jnp.arange(SEQ, dtype=jnp.int32)[None, :]
    n_idx = jnp.arange(S5_STATE, dtype=jnp.float32)
    return {
        "x": x,
        "mem": mem,
        "positions": positions,
        "norm_mix": gain((L, D)),
        "w_in": nrm((L, D, P_IN), D ** -0.5),
        "mla_q_norm": gain((L, MLA_Q_RANK)),
        "mla_w_uq": nrm((L, MLA_Q_RANK, MLA_HEADS * MLA_QK), MLA_Q_RANK ** -0.5),
        "mla_kv_norm": gain((L, MLA_KV_RANK)),
        "mla_w_ukv": nrm((L, MLA_KV_RANK, MLA_HEADS * (MLA_NOPE + MLA_V)), MLA_KV_RANK ** -0.5),
        "hgrn_lb_logits": nrm((L, HG_KW), 0.1),
        "hgrn_o_norm": gain((L, HG_VW)),
        "s5_A_re": -0.5 + nrm((L, S5_GROUPS, S5_STATE), 0.01),
        "s5_A_im": math.pi * n_idx + nrm((L, S5_GROUPS, S5_STATE), 0.01),
        "s5_log_step": jax.random.uniform(nk(), (L, S5_GROUPS), jnp.float32, math.log(1e-3), math.log(1e-1)),
        "s5_B_re": nrm((L, S5_GROUPS, S5_STATE, S5_GROUP), S5_GROUP ** -0.5),
        "s5_B_im": nrm((L, S5_GROUPS, S5_STATE, S5_GROUP), S5_GROUP ** -0.5),
        "s5_C_re": nrm((L, S5_GROUPS, S5_GROUP, S5_STATE), 0.25),
        "s5_C_im": nrm((L, S5_GROUPS, S5_GROUP, S5_STATE), 0.25),
        "s5_D": nrm((L, S5_WIDTH), 1.0),
        "s5_w_glu": nrm((L, S5_WIDTH, S5_WIDTH), S5_WIDTH ** -0.5),
        "s5_b_glu": nrm((L, S5_WIDTH), 0.01),
        "rwkv_mu": jax.random.uniform(nk(), (L, RW_COLS), jnp.float32),
        "rwkv_w0": jax.random.uniform(nk(), (L, RW_WIDTH), jnp.float32, -5.0, 1.0),
        "rwkv_w_up": nrm((L, RW_DECAY_LORA, RW_WIDTH), 0.5 * RW_DECAY_LORA ** -0.5),
        "rwkv_a0": nrm((L, RW_WIDTH), 0.1),
        "rwkv_a_up": nrm((L, RW_AAA_LORA, RW_WIDTH), 0.5 * RW_AAA_LORA ** -0.5),
        "rwkv_g_up": nrm((L, RW_GATE_LORA, RW_WIDTH), RW_GATE_LORA ** -0.5),
        "rwkv_k_k": 0.85 + nrm((L, RW_WIDTH), 0.02),
        "rwkv_k_a": gain((L, RW_WIDTH)),
        "rwkv_r_k": nrm((L, RW_HEADS, RW_HEAD), 0.1),
        "rwkv_ln_w": gain((L, RW_WIDTH)),
        "rwkv_ln_b": nrm((L, RW_WIDTH), 0.01),
        "rwkv_vres_down": nrm((L - 1, D, RW_MV_LORA), D ** -0.5),
        "rwkv_vres_up": nrm((L - 1, RW_MV_LORA, RW_WIDTH), RW_MV_LORA ** -0.5),
        "rwkv_vres_bias": nrm((L - 1, RW_WIDTH), 0.1),
        "w_branch_mla": nrm((L, BRANCH_WIDTH, D), BRANCH_WIDTH ** -0.5),
        "w_branch_hgrn": nrm((L, BRANCH_WIDTH, D), BRANCH_WIDTH ** -0.5),
        "w_branch_s5": nrm((L, BRANCH_WIDTH, D), BRANCH_WIDTH ** -0.5),
        "w_branch_rwkv": nrm((L, BRANCH_WIDTH, D), BRANCH_WIDTH ** -0.5),
        "w_out": nrm((L, D, D), D ** -0.5),
        "norm_xq": gain((L, D)),
        "norm_xm": gain((L, D)),
        "xattn_w_q": nrm((L, D, D), D ** -0.5),
        "xattn_w_kv": nrm((L, D, 2 * D), D ** -0.5),
        "xattn_w_o": nrm((L, D, D), D ** -0.5),
        "norm_ffn": gain((L, D)),
        "ffn_w_gate_up": nrm((L, D, 2 * D_FF), D ** -0.5),
        "ffn_conv_w": nrm((L, CONV_W, D_FF), CONV_W ** -0.5),
        "ffn_conv_b": nrm((L, D_FF), 0.01),
        "ffn_w_down": nrm((L, D_FF, D), D_FF ** -0.5),
        "norm_final": gain((D,)),
    }


def reference(x, mem, positions, norm_mix, w_in, mla_q_norm, mla_w_uq, mla_kv_norm, mla_w_ukv,
              hgrn_lb_logits, hgrn_o_norm,
              s5_A_re, s5_A_im, s5_log_step, s5_B_re, s5_B_im, s5_C_re, s5_C_im, s5_D, s5_w_glu, s5_b_glu,
              rwkv_mu, rwkv_w0, rwkv_w_up, rwkv_a0, rwkv_a_up, rwkv_g_up, rwkv_k_k, rwkv_k_a, rwkv_r_k,
              rwkv_ln_w, rwkv_ln_b, rwkv_vres_down, rwkv_vres_up, rwkv_vres_bias,
              w_branch_mla, w_branch_hgrn, w_branch_s5, w_branch_rwkv, w_out,
              norm_xq, norm_xm, xattn_w_q, xattn_w_kv, xattn_w_o,
              norm_ffn, ffn_w_gate_up, ffn_conv_w, ffn_conv_b, ffn_w_down, norm_final):
    B, S, D = x.shape
    lb_p = jax.nn.softmax(hgrn_lb_logits.astype(jnp.float32), axis=0)
    lb_c = jnp.cumsum(lb_p, axis=0)
    lower_bounds = lb_c - lb_c[0:1]
    cos, sin = rope_tables(positions)
    v_first = None
    for l in range(DEPTH):
        h = rmsnorm(x, norm_mix[l])
        p = h @ w_in[l]
        cq, ckv, krope, hq, hf, hi, hg, su, rw, gate_logits = split_cols(p, COL_SIZES)
        o_mla = mla(cq, ckv, krope, cos, sin, mla_q_norm[l], mla_w_uq[l], mla_kv_norm[l], mla_w_ukv[l])
        o_hg = hgrn2(hq, hf, hi, hg, lower_bounds[l], hgrn_o_norm[l])
        o_s5 = s5(su, s5_A_re[l], s5_A_im[l], s5_log_step[l], s5_B_re[l], s5_B_im[l],
                  s5_C_re[l], s5_C_im[l], s5_D[l], s5_w_glu[l], s5_b_glu[l])
        vres = None if l == 0 else (rwkv_vres_down[l - 1], rwkv_vres_up[l - 1], rwkv_vres_bias[l - 1])
        o_rw, v_l = rwkv7(token_shift_mix(rw, rwkv_mu[l]), h, v_first, vres,
                          rwkv_w0[l], rwkv_w_up[l], rwkv_a0[l], rwkv_a_up[l], rwkv_g_up[l],
                          rwkv_k_k[l], rwkv_k_a[l], rwkv_r_k[l], rwkv_ln_w[l], rwkv_ln_b[l])
        if l == 0:
            v_first = v_l
        gates = jax.nn.sigmoid(gate_logits).reshape(B, S, N_BRANCH, D)
        y = (gates[:, :, 0] * (o_mla @ w_branch_mla[l])
             + gates[:, :, 1] * (o_hg @ w_branch_hgrn[l])
             + gates[:, :, 2] * (o_s5 @ w_branch_s5[l])
             + gates[:, :, 3] * (o_rw @ w_branch_rwkv[l]))
        x = x + y @ w_out[l]
        x = x + cross_attn(rmsnorm(x, norm_xq[l]), rmsnorm(mem, norm_xm[l]),
                           xattn_w_q[l], xattn_w_kv[l], xattn_w_o[l])
        x = x + conv_ffn(rmsnorm(x, norm_ffn[l]), ffn_w_gate_up[l], ffn_conv_w[l], ffn_conv_b[l], ffn_w_down[l])
    return rmsnorm(x, norm_final)
```

```cpp
#include <hip/hip_runtime.h>
#include <hip/hip_cooperative_groups.h>
#include <cstdio>
#include <cstdint>
namespace cg = cooperative_groups;

typedef unsigned short bf16_t;
using bf16x8 = __attribute__((ext_vector_type(8))) short;
using s16x4 = __attribute__((ext_vector_type(4))) short;
using f32x4 = __attribute__((ext_vector_type(4))) float;
using f32x16 = __attribute__((ext_vector_type(16))) float;
#define DI __device__ __forceinline__

constexpr int T_ALL = 16384, SEQ = 4096, DM = 1024, TH = 8192;
constexpr int P_IN = 8896, GATE_OFF = 4800;
constexpr int PLD = 4864;
constexpr int PC_HG = 512, PC_S5 = 2560, PC_RW = 3072;
constexpr int D_FF = 2816;

constexpr size_t al256(size_t x) { return (x + 255) & ~(size_t)255; }
constexpr size_t OFF_WIN = 0;
constexpr size_t OFF_WQ = OFF_WIN + al256((size_t)P_IN * 1024 * 2);
constexpr size_t OFF_WBR = OFF_WQ + al256((size_t)768 * 256 * 2);
constexpr size_t OFF_WOUT = OFF_WBR + al256((size_t)4 * 1024 * 512 * 2);
constexpr size_t OFF_WGLU = OFF_WOUT + al256((size_t)1024 * 1024 * 2);
constexpr size_t OFF_WWUP = OFF_WGLU + al256((size_t)512 * 512 * 2);
constexpr size_t OFF_WAUP = OFF_WWUP + al256((size_t)512 * 64 * 2);
constexpr size_t OFF_WGUP = OFF_WAUP + al256((size_t)512 * 64 * 2);
constexpr size_t OFF_WV = OFF_WGUP + al256((size_t)512 * 128 * 2);
constexpr size_t OFF_WXKV = OFF_WV + al256((size_t)512 * 1024 * 2);
constexpr size_t OFF_S5AB = OFF_WXKV + al256((size_t)2048 * 1024 * 2);
constexpr size_t OFF_S5BB = OFF_S5AB + al256((size_t)32 * 64 * 2 * 4);
constexpr size_t OFF_H = OFF_S5BB + al256((size_t)32 * 64 * 32 * 4);
constexpr size_t OFF_VFIRST = OFF_H + al256((size_t)T_ALL * 1024 * 2);
constexpr size_t OFF_KX = OFF_VFIRST + al256((size_t)T_ALL * 512 * 2);
constexpr size_t OFF_VXT = OFF_KX + al256((size_t)16 * 256 * 256 * 2);
constexpr size_t OFF_HM = OFF_VXT + al256((size_t)16 * 256 * 256 * 2);
constexpr size_t OFF_COS = OFF_HM + al256((size_t)1024 * 1024 * 2);
constexpr size_t OFF_SIN = OFF_COS + al256((size_t)TH * 32 * 4);
constexpr size_t OFF_REG = OFF_SIN + al256((size_t)TH * 32 * 4);
constexpr size_t R_P = OFF_REG;
constexpr size_t R_CQN = R_P + al256((size_t)TH * PLD * 2);
constexpr size_t R_QP = R_CQN + (size_t)TH * 256 * 2;
constexpr size_t R_KVLAT = R_QP + al256((size_t)TH * 768 * 2);
constexpr size_t R_VT = R_KVLAT + al256((size_t)TH * 192 * 2);
constexpr size_t R_RKV = R_VT + al256((size_t)2 * 128 * 4096 * 2);
constexpr size_t R_ALORA = R_RKV + al256((size_t)TH * 1536 * 2);
constexpr size_t R_YRW = R_ALORA + al256((size_t)TH * 256 * 2);
constexpr size_t R_ZS5 = R_YRW + al256((size_t)TH * 512 * 4);
constexpr size_t R_END1 = R_ZS5 + al256((size_t)TH * 512 * 2);
constexpr size_t R_YBR = R_CQN;
constexpr size_t R_WXQ = OFF_REG;
constexpr size_t R_WXO = R_WXQ + al256((size_t)1024 * 1024 * 2);
constexpr size_t R_WGU = R_WXO + al256((size_t)1024 * 1024 * 2);
constexpr size_t R_WDOWN = R_WGU + al256((size_t)5632 * 1024 * 2);
constexpr size_t R_QX = R_WDOWN + al256((size_t)1024 * 2816 * 2);
constexpr size_t R_OX = R_QX + al256((size_t)T_ALL * 1024 * 2);
constexpr size_t R_GU = R_QX;
constexpr size_t R_END2 = R_GU + al256((size_t)TH * 5632 * 2);
constexpr size_t WS_NEED = (R_END1 > R_END2 ? R_END1 : R_END2);

constexpr int SMEM_BYTES = 73728;

struct Params {
  const float* in[51];
  const int* pos;
  float* out;
  char* ws;
};

DI bf16_t f2bf(float x) { unsigned u = __float_as_uint(x); u += 0x7fffu + ((u >> 16) & 1u); return (bf16_t)(u >> 16); }
DI float bf2f(bf16_t b) { return __uint_as_float(((unsigned)b) << 16); }
DI unsigned pack2(float a, float b) { return (unsigned)f2bf(a) | ((unsigned)f2bf(b) << 16); }
DI float bflo(unsigned u) { return __uint_as_float(u << 16); }
DI float bfhi(unsigned u) { return __uint_as_float(u & 0xffff0000u); }
DI float sigm(float x) { return 1.f / (1.f + __expf(-x)); }
template <int CTRL> DI float dppf(float v) {
  return __builtin_bit_cast(float, __builtin_amdgcn_update_dpp(0, __builtin_bit_cast(int, v), CTRL, 0xf, 0xf, false));
}
DI float red8(float v) { v += dppf<0xB1>(v); v += dppf<0x4E>(v); v += dppf<0x141>(v); return v; }
DI float red16(float v) { v = red8(v); v += dppf<0x140>(v); return v; }
DI int TID() { int t = threadIdx.x; asm volatile("" : "+v"(t)); return t; }
#define PHASE_IDS const int tid = TID(); const int lane = tid & 63, wave = tid >> 6; (void)lane; (void)wave;
DI float wave_sum(float v) { for (int o = 32; o > 0; o >>= 1) v += __shfl_xor(v, o); return v; }

template <int BN>
DI void gemm_acc(const bf16_t* __restrict__ A, int lda, const bf16_t* __restrict__ Bt, int ldb, int K, char* smem,
                 f32x4 (&acc)[4][BN / 32]) {
  constexpr int A_EL = 128 * 72, B_EL = BN * 72, BUF_EL = A_EL + B_EL;
  constexpr int NJ = BN / 32, BCH = BN / 32;
  bf16_t* sm = (bf16_t*)smem;
  const int tid = TID(), lane = tid & 63, wave = tid >> 6;
  const int wm = wave >> 1, wn = wave & 1, l16 = lane & 15, quad = lane >> 4;
  const int crow = tid >> 3, ccol = (tid & 7) * 8;
  uint4 ra[4], rb[BCH];
  const bf16_t* Ap = A + (size_t)crow * lda + ccol;
  const bf16_t* Bp = Bt + (size_t)crow * ldb + ccol;
  const int nk = K >> 6;
#pragma unroll
  for (int i = 0; i < 4; ++i) ra[i] = *(const uint4*)(Ap + (size_t)(32 * i) * lda);
#pragma unroll
  for (int i = 0; i < BCH; ++i) rb[i] = *(const uint4*)(Bp + (size_t)(32 * i) * ldb);
  {
    bf16_t* sa = sm; bf16_t* sb = sa + A_EL;
#pragma unroll
    for (int i = 0; i < 4; ++i) *(uint4*)(sa + (crow + 32 * i) * 72 + ccol) = ra[i];
#pragma unroll
    for (int i = 0; i < BCH; ++i) *(uint4*)(sb + (crow + 32 * i) * 72 + ccol) = rb[i];
  }
  __syncthreads();
  for (int kt = 0; kt < nk; ++kt) {
    const bool more = (kt + 1 < nk);
    if (more) {
      const int k0 = (kt + 1) << 6;
#pragma unroll
      for (int i = 0; i < 4; ++i) ra[i] = *(const uint4*)(Ap + (size_t)(32 * i) * lda + k0);
#pragma unroll
      for (int i = 0; i < BCH; ++i) rb[i] = *(const uint4*)(Bp + (size_t)(32 * i) * ldb + k0);
    }
    {
      const bf16_t* sa = sm + (kt & 1) * BUF_EL; const bf16_t* sb = sa + A_EL;
#pragma unroll
      for (int ks = 0; ks < 2; ++ks) {
        bf16x8 a[4], b[NJ];
#pragma unroll
        for (int i = 0; i < 4; ++i) a[i] = *(const bf16x8*)(sa + (wm * 64 + i * 16 + l16) * 72 + ks * 32 + quad * 8);
#pragma unroll
        for (int j = 0; j < NJ; ++j) b[j] = *(const bf16x8*)(sb + (wn * (BN / 2) + j * 16 + l16) * 72 + ks * 32 + quad * 8);
#pragma unroll
        for (int i = 0; i < 4; ++i)
#pragma unroll
          for (int j = 0; j < NJ; ++j) acc[i][j] = __builtin_amdgcn_mfma_f32_16x16x32_bf16(a[i], b[j], acc[i][j], 0, 0, 0);
      }
    }
    if (more) {
      bf16_t* sa = sm + ((kt + 1) & 1) * BUF_EL; bf16_t* sb = sa + A_EL;
#pragma unroll
      for (int i = 0; i < 4; ++i) *(uint4*)(sa + (crow + 32 * i) * 72 + ccol) = ra[i];
#pragma unroll
      for (int i = 0; i < BCH; ++i) *(uint4*)(sb + (crow + 32 * i) * 72 + ccol) = rb[i];
    }
    __syncthreads();
  }
}
template <int NJ> DI void zero_acc(f32x4 (&acc)[4][NJ]) {
#pragma unroll
  for (int i = 0; i < 4; ++i)
#pragma unroll
    for (int j = 0; j < NJ; ++j) acc[i][j] = f32x4{0.f, 0.f, 0.f, 0.f};
}
#define EPI_FOR(BN_)                                                                         \
  const int _t = TID(); const int _lane = _t & 63, _wave = _t >> 6;                              \
  const int _wm = _wave >> 1, _wn = _wave & 1, _l16 = _lane & 15, _quad = _lane >> 4;        \
  _Pragma("unroll") for (int i = 0; i < 4; ++i)                                              \
  _Pragma("unroll") for (int j = 0; j < (BN_) / 32; ++j)                                     \
  _Pragma("unroll") for (int r = 0; r < 4; ++r)
#define EPI_ROW (_wm * 64 + i * 16 + _quad * 4 + r)
#define EPI_COL(BN_) (_wn * ((BN_) / 2) + j * 16 + _l16)

DI void transpose_tile(const float* __restrict__ W, int ldw, bf16_t* __restrict__ Wt, int ldt, int k0, int n0, char* smem) {
  float* sm = (float*)smem;
  const int tid = TID();
  __syncthreads();
#pragma unroll
  for (int i = 0; i < 4; ++i) {
    const int k = (tid >> 4) + 16 * i, n4 = (tid & 15) * 4;
    const float4 v = *(const float4*)(W + (size_t)(k0 + k) * ldw + n0 + n4);
    sm[k * 65 + n4 + 0] = v.x; sm[k * 65 + n4 + 1] = v.y; sm[k * 65 + n4 + 2] = v.z; sm[k * 65 + n4 + 3] = v.w;
  }
  __syncthreads();
  const int n = tid >> 2, ks = (tid & 3) * 16;
  unsigned u[8];
#pragma unroll
  for (int e = 0; e < 8; ++e) u[e] = pack2(sm[(ks + 2 * e) * 65 + n], sm[(ks + 2 * e + 1) * 65 + n]);
  uint4* dst = (uint4*)(Wt + (size_t)(n0 + n) * ldt + k0 + ks);
  dst[0] = uint4{u[0], u[1], u[2], u[3]};
  dst[1] = uint4{u[4], u[5], u[6], u[7]};
}
DI void transpose_all(const float* W, int ldw, int K, int N, bf16_t* Wt, int bid, int nb, char* smem) {
  const int tk = K >> 6, tn = N >> 6;
  for (int t = bid; t < tk * tn; t += nb) transpose_tile(W, ldw, Wt, K, (t % tk) * 64, (t / tk) * 64, smem);
}

DI void rmsnorm_rows(const float* __restrict__ x, const float* __restrict__ g, bf16_t* __restrict__ h, float* xcopy, int rows,
                     int bid, int nb) {
  const int lane = TID() & 63, wave = TID() >> 6;
  for (int r = bid * 4 + wave; r < rows; r += nb * 4) {
    const float4* xr = (const float4*)(x + (size_t)r * 1024);
    float4 v[4]; float ss = 0.f;
#pragma unroll
    for (int i = 0; i < 4; ++i) { v[i] = xr[lane + 64 * i]; ss += v[i].x * v[i].x + v[i].y * v[i].y + v[i].z * v[i].z + v[i].w * v[i].w; }
    ss = wave_sum(ss);
    const float rs = rsqrtf(ss * (1.f / 1024.f) + 1e-6f);
#pragma unroll
    for (int i = 0; i < 4; ++i) {
      const float4 gg = ((const float4*)g)[lane + 64 * i];
      uint2 o; o.x = pack2(v[i].x * rs * gg.x, v[i].y * rs * gg.y); o.y = pack2(v[i].z * rs * gg.z, v[i].w * rs * gg.w);
      *(uint2*)(h + (size_t)r * 1024 + (lane + 64 * i) * 4) = o;
      if (xcopy) ((float4*)(xcopy + (size_t)r * 1024))[lane + 64 * i] = v[i];
    }
  }
}

template <int DQK, bool CAUSAL>
DI void attn_item(const bf16_t* __restrict__ Q, int ldq, const bf16_t* __restrict__ Kp, int ldk, const bf16_t* __restrict__ VT, int ldvt,
                  int ntiles, int q0, bf16_t* __restrict__ out, int ldo, char* smem) {
  constexpr int KS = DQK + 8, NS = DQK / 16, KCH = DQK / 8;
  bf16_t* Ks = (bf16_t*)smem;
  bf16_t* Vs = Ks + 64 * KS;
  const int tid = TID(), lane = tid & 63, wave = tid >> 6, ql = lane & 31, hh = lane >> 5;
  const int qrow = q0 + wave * 32 + ql;
  bf16x8 bq[NS];
#pragma unroll
  for (int s = 0; s < NS; ++s) bq[s] = *(const bf16x8*)(Q + (size_t)qrow * ldq + s * 16 + hh * 8);
  f32x16 ot[4];
#pragma unroll
  for (int d = 0; d < 4; ++d)
#pragma unroll
    for (int i = 0; i < 16; ++i) ot[d][i] = 0.f;
  float mrun = -INFINITY, lrun = 0.f;
  for (int kt = 0; kt < ntiles; ++kt) {
    __syncthreads();
    for (int c = tid; c < 64 * KCH; c += 256) {
      const int row = c / KCH, cc = c % KCH;
      *(uint4*)(Ks + row * KS + cc * 8) = *(const uint4*)(Kp + (size_t)(kt * 64 + row) * ldk + cc * 8);
    }
#pragma unroll
    for (int c0 = 0; c0 < 4; ++c0) {
      const int c = tid + c0 * 256, row = c >> 3, cc = c & 7;
      *(uint4*)(Vs + row * 72 + cc * 8) = *(const uint4*)(VT + (size_t)row * ldvt + kt * 64 + cc * 8);
    }
    __syncthreads();
    f32x16 st[2];
#pragma unroll
    for (int kb = 0; kb < 2; ++kb) {
#pragma unroll
      for (int i = 0; i < 16; ++i) st[kb][i] = 0.f;
#pragma unroll
      for (int s = 0; s < NS; ++s) {
        const bf16x8 a = *(const bf16x8*)(Ks + (kb * 32 + ql) * KS + s * 16 + hh * 8);
        st[kb] = __builtin_amdgcn_mfma_f32_32x32x16_bf16(a, bq[s], st[kb], 0, 0, 0);
      }
    }
    float mx = -INFINITY;
#pragma unroll
    for (int kb = 0; kb < 2; ++kb)
#pragma unroll
      for (int i = 0; i < 16; ++i) {
        if (CAUSAL) {
          const int key = kt * 64 + kb * 32 + (i & 3) + 8 * (i >> 2) + 4 * hh;
          if (key > qrow) st[kb][i] = -INFINITY;
        }
        mx = fmaxf(mx, st[kb][i]);
      }
    mx = fmaxf(mx, __shfl_xor(mx, 32));
    const float mnew = fmaxf(mrun, mx);
    const float alpha = exp2f(mrun - mnew);
    float ps = 0.f;
#pragma unroll
    for (int kb = 0; kb < 2; ++kb)
#pragma unroll
      for (int i = 0; i < 16; ++i) { const float pv = exp2f(st[kb][i] - mnew); st[kb][i] = pv; ps += pv; }
    ps += __shfl_xor(ps, 32);
    lrun = lrun * alpha + ps;
    mrun = mnew;
#pragma unroll
    for (int d = 0; d < 4; ++d)
#pragma unroll
      for (int i = 0; i < 16; ++i) ot[d][i] *= alpha;
#pragma unroll
    for (int kb = 0; kb < 2; ++kb)
#pragma unroll
      for (int s2 = 0; s2 < 2; ++s2) {
        unsigned pk[4];
#pragma unroll
        for (int e = 0; e < 4; ++e) pk[e] = pack2(st[kb][8 * s2 + 2 * e], st[kb][8 * s2 + 2 * e + 1]);
        const bf16x8 pb = __builtin_bit_cast(bf16x8, uint4{pk[0], pk[1], pk[2], pk[3]});
#pragma unroll
        for (int d = 0; d < 4; ++d) {
          const bf16_t* vp = Vs + (d * 32 + ql) * 72 + kb * 32 + s2 * 16 + hh * 4;
          const s16x4 lo = *(const s16x4*)vp;
          const s16x4 hi = *(const s16x4*)(vp + 8);
          const bf16x8 av = __builtin_shufflevector(lo, hi, 0, 1, 2, 3, 4, 5, 6, 7);
          ot[d] = __builtin_amdgcn_mfma_f32_32x32x16_bf16(av, pb, ot[d], 0, 0, 0);
        }
      }
  }
  const float inv = 1.f / lrun;
#pragma unroll
  for (int d = 0; d < 4; ++d)
#pragma unroll
    for (int g4 = 0; g4 < 4; ++g4) {
      uint2 o; o.x = pack2(ot[d][4 * g4] * inv, ot[d][4 * g4 + 1] * inv); o.y = pack2(ot[d][4 * g4 + 2] * inv, ot[d][4 * g4 + 3] * inv);
      *(uint2*)(out + (size_t)qrow * ldo + d * 32 + 8 * g4 + 4 * hh) = o;
    }
}

DI void rwkv_scan_unit(const Params& p, int l, int u, char* smem) {
  const int tid = TID();
  const int bl = u >> 5, hd = (u >> 2) & 7, rg = u & 3;
  const int kq = tid & 15, g16 = tid >> 4;
  const bf16_t* RKV = (const bf16_t*)(p.ws + R_RKV) + (size_t)bl * SEQ * 1536;
  const bf16_t* Pm = (const bf16_t*)(p.ws + R_P) + (size_t)bl * SEQ * PLD;
  float* Y = (float*)(p.ws + R_YRW) + (size_t)bl * SEQ * 512;
  float* sm = (float*)smem;
  constexpr int BUFF = 5 * 1024 + 256;
  const int kc = hd * 64 + kq * 4;
  const float4 kk_w = *(const float4*)(p.in[27] + l * 512 + kc);
  const float4 ka_w = *(const float4*)(p.in[28] + l * 512 + kc);
  float S0 = 0.f, S1 = 0.f, S2 = 0.f, S3 = 0.f;
  uint2 g_r, g_k, g_w, g_a; bf16_t g_v;
  auto gload = [&](int c) {
    const int tok = c * 16 + g16;
    g_r = *(const uint2*)(RKV + (size_t)tok * 1536 + kc);
    g_k = *(const uint2*)(RKV + (size_t)tok * 1536 + 512 + kc);
    g_v = RKV[(size_t)tok * 1536 + 1024 + hd * 64 + rg * 16 + kq];
    g_w = *(const uint2*)(Pm + (size_t)tok * PLD + PC_RW + kc);
    g_a = *(const uint2*)(Pm + (size_t)tok * PLD + PC_RW + 512 + kc);
  };
  auto derive = [&](int buf) {
    float* b = sm + buf * BUFF;
    const float r[4] = {bflo(g_r.x), bfhi(g_r.x), bflo(g_r.y), bfhi(g_r.y)};
    const float k[4] = {bflo(g_k.x), bfhi(g_k.x), bflo(g_k.y), bfhi(g_k.y)};
    const float w[4] = {bflo(g_w.x), bfhi(g_w.x), bflo(g_w.y), bfhi(g_w.y)};
    const float a[4] = {bflo(g_a.x), bfhi(g_a.x), bflo(g_a.y), bfhi(g_a.y)};
    const float kkw[4] = {kk_w.x, kk_w.y, kk_w.z, kk_w.w};
    const float kaw[4] = {ka_w.x, ka_w.y, ka_w.z, ka_w.w};
    float kk[4], ss = 0.f;
#pragma unroll
    for (int e = 0; e < 4; ++e) { kk[e] = k[e] * kkw[e]; ss += kk[e] * kk[e]; }
    ss = red16(ss);
    const float rn = rsqrtf(ss + 1e-12f);
    float4 oR, oW, oK, oN, oB;
    float dr[4], dw[4], dk[4], dn[4], db[4];
#pragma unroll
    for (int e = 0; e < 4; ++e) {
      const float xm = -w[e];
      const float sp = (xm > 20.f) ? xm : log1pf(expf(xm));
      const float wlog = -sp - 0.5f;
      dw[e] = expf(-expf(wlog));
      const float kn = kk[e] * rn;
      dn[e] = -kn; db[e] = kn * a[e];
      dk[e] = k[e] * (1.f + (a[e] - 1.f) * kaw[e]);
      dr[e] = r[e];
    }
    oR = float4{dr[0], dr[1], dr[2], dr[3]}; oW = float4{dw[0], dw[1], dw[2], dw[3]}; oK = float4{dk[0], dk[1], dk[2], dk[3]};
    oN = float4{dn[0], dn[1], dn[2], dn[3]}; oB = float4{db[0], db[1], db[2], db[3]};
    *(float4*)(b + 0 * 1024 + g16 * 64 + kq * 4) = oR;
    *(float4*)(b + 1 * 1024 + g16 * 64 + kq * 4) = oW;
    *(float4*)(b + 2 * 1024 + g16 * 64 + kq * 4) = oK;
    *(float4*)(b + 3 * 1024 + g16 * 64 + kq * 4) = oN;
    *(float4*)(b + 4 * 1024 + g16 * 64 + kq * 4) = oB;
    b[5 * 1024 + g16 * 16 + kq] = bf2f(g_v);
  };
  __syncthreads();
  gload(0); derive(0);
  __syncthreads();
  constexpr int NC = SEQ / 16;
  for (int c = 0; c < NC; ++c) {
    if (c + 1 < NC) gload(c + 1);
    const float* b = sm + (c & 1) * BUFF;
#pragma unroll 4
    for (int t = 0; t < 16; ++t) {
      const float4 nk = *(const float4*)(b + 3 * 1024 + t * 64 + kq * 4);
      const float4 w = *(const float4*)(b + 1 * 1024 + t * 64 + kq * 4);
      const float4 bb = *(const float4*)(b + 4 * 1024 + t * 64 + kq * 4);
      const float4 kh = *(const float4*)(b + 2 * 1024 + t * 64 + kq * 4);
      const float4 rr = *(const float4*)(b + 0 * 1024 + t * 64 + kq * 4);
      const float v = b[5 * 1024 + t * 16 + g16];
      float sa = S0 * nk.x + S1 * nk.y + S2 * nk.z + S3 * nk.w;
      sa = red16(sa);
      S0 = S0 * w.x + sa * bb.x + v * kh.x;
      S1 = S1 * w.y + sa * bb.y + v * kh.y;
      S2 = S2 * w.z + sa * bb.z + v * kh.z;
      S3 = S3 * w.w + sa * bb.w + v * kh.w;
      float y = S0 * rr.x + S1 * rr.y + S2 * rr.z + S3 * rr.w;
      y = red16(y);
      if (kq == 0) Y[(size_t)(c * 16 + t) * 512 + hd * 64 + rg * 16 + g16] = y;
    }
    if (c + 1 < NC) derive((c + 1) & 1);
    __syncthreads();
  }
}

DI void hgrn_scan_unit(const Params& p, int l, int u, char* smem) {
  const int tid = TID();
  const int bl = u >> 5, hd = (u >> 3) & 3, vg = u & 7;
  const int kq = tid & 15, g16 = tid >> 4;
  bf16_t* Pm = (bf16_t*)(p.ws + R_P) + (size_t)bl * SEQ * PLD;
  float* sm = (float*)smem;
  constexpr int BUFF = 2 * 2048 + 256;
  const int kc = hd * 128 + kq * 8;
  float lb[8];
#pragma unroll
  for (int e = 0; e < 8; ++e) {
    if (l == 0) lb[e] = 0.f;
    else { const float x0 = p.in[9][kc + e], x1 = p.in[9][512 + kc + e]; lb[e] = 1.f / (1.f + expf(x0 - x1)); }
  }
  float S[8];
#pragma unroll
  for (int e = 0; e < 8; ++e) S[e] = 0.f;
  uint4 g_q, g_f; bf16_t g_v;
  const int vcol = PC_HG + 1024 + hd * 128 + vg * 16;
  auto gload = [&](int c) {
    const int tok = c * 16 + g16;
    g_q = *(const uint4*)(Pm + (size_t)tok * PLD + PC_HG + kc);
    g_f = *(const uint4*)(Pm + (size_t)tok * PLD + PC_HG + 512 + kc);
    g_v = Pm[(size_t)tok * PLD + vcol + kq];
  };
  auto derive = [&](int buf) {
    float* b = sm + buf * BUFF;
    const unsigned qu[4] = {g_q.x, g_q.y, g_q.z, g_q.w}, fu[4] = {g_f.x, g_f.y, g_f.z, g_f.w};
    float q[8], f[8];
#pragma unroll
    for (int e = 0; e < 4; ++e) {
      q[2 * e] = bflo(qu[e]); q[2 * e + 1] = bfhi(qu[e]);
      const float f0 = bflo(fu[e]), f1 = bfhi(fu[e]);
      f[2 * e] = lb[2 * e] + (1.f - lb[2 * e]) * (1.f / (1.f + expf(-f0)));
      f[2 * e + 1] = lb[2 * e + 1] + (1.f - lb[2 * e + 1]) * (1.f / (1.f + expf(-f1)));
    }
    *(float4*)(b + g16 * 128 + kq * 8) = float4{q[0], q[1], q[2], q[3]};
    *(float4*)(b + g16 * 128 + kq * 8 + 4) = float4{q[4], q[5], q[6], q[7]};
    *(float4*)(b + 2048 + g16 * 128 + kq * 8) = float4{f[0], f[1], f[2], f[3]};
    *(float4*)(b + 2048 + g16 * 128 + kq * 8 + 4) = float4{f[4], f[5], f[6], f[7]};
    b[4096 + g16 * 16 + kq] = bf2f(g_v);
  };
  __syncthreads();
  gload(0); derive(0);
  __syncthreads();
  constexpr int NC = SEQ / 16;
  for (int c = 0; c < NC; ++c) {
    if (c + 1 < NC) gload(c + 1);
    const float* b = sm + (c & 1) * BUFF;
#pragma unroll 4
    for (int t = 0; t < 16; ++t) {
      const float4 q0 = *(const float4*)(b + t * 128 + kq * 8), q1 = *(const float4*)(b + t * 128 + kq * 8 + 4);
      const float4 f0 = *(const float4*)(b + 2048 + t * 128 + kq * 8), f1 = *(const float4*)(b + 2048 + t * 128 + kq * 8 + 4);
      const float v = b[4096 + t * 16 + g16];
      const float q[8] = {q0.x, q0.y, q0.z, q0.w, q1.x, q1.y, q1.z, q1.w};
      const float f[8] = {f0.x, f0.y, f0.z, f0.w, f1.x, f1.y, f1.z, f1.w};
      float o = 0.f;
#pragma unroll
      for (int e = 0; e < 8; ++e) { S[e] = f[e] * S[e] + (1.f - f[e]) * v; o += S[e] * q[e]; }
      o = red16(o);
      if (kq == 0) Pm[(size_t)(c * 16 + t) * PLD + vcol + g16] = f2bf(o);
    }
    if (c + 1 < NC) derive((c + 1) & 1);
    __syncthreads();
  }
}

DI void s5_scan_unit(const Params& p, int l, int u, char* smem) {
  const int tid = TID(), lane = tid & 63, wave = tid >> 6;
  const int idx = u * 4 + wave, bl = idx >> 5, g = idx & 31;
  const bf16_t* Pm = (const bf16_t*)(p.ws + R_P) + (size_t)bl * SEQ * PLD + PC_S5 + g * 16;
  bf16_t* Z = (bf16_t*)(p.ws + R_ZS5) + (size_t)bl * SEQ * 512 + g * 16;
  float* su = (float*)smem + wave * 256;
  bf16_t* hist = (bf16_t*)(smem + 4096) + wave * (16 * 136);
  const float2 ab = *(const float2*)((const float*)(p.ws + OFF_S5AB) + (g * 64 + lane) * 2);
  float bre[16], bim[16];
  {
    const float* bbp = (const float*)(p.ws + OFF_S5BB) + (size_t)(g * 64 + lane) * 32;
#pragma unroll
    for (int c = 0; c < 16; ++c) { bre[c] = bbp[c]; bim[c] = bbp[16 + c]; }
  }
  const int l16 = lane & 15, quad = lane >> 4;
  bf16x8 cf[4];
  {
    const float* Cre = p.in[16] + (size_t)l * 32768 + (size_t)(g * 16 + l16) * 64;
    const float* Cim = p.in[17] + (size_t)l * 32768 + (size_t)(g * 16 + l16) * 64;
#pragma unroll
    for (int ks = 0; ks < 4; ++ks) {
      unsigned pk[4];
#pragma unroll
      for (int e = 0; e < 4; ++e) {
        const int k = ks * 32 + quad * 8 + 2 * e;
        const float v0 = (k < 64) ? Cre[k] : -Cim[k - 64];
        const float v1 = (k < 64) ? Cre[k + 1] : -Cim[k + 1 - 64];
        pk[e] = pack2(v0, v1);
      }
      cf[ks] = __builtin_bit_cast(bf16x8, uint4{pk[0], pk[1], pk[2], pk[3]});
    }
  }
  const float dcoef = p.in[18][l * 512 + g * 16 + l16];
  float xr = 0.f, xi = 0.f;
  uint2 gu;
  auto gload = [&](int c) { gu = *(const uint2*)(Pm + (size_t)(c * 16 + (lane >> 2)) * PLD + (lane & 3) * 4); };
  __syncthreads();
  gload(0);
  constexpr int NC = SEQ / 16;
  for (int c = 0; c < NC; ++c) {
    *(float4*)(su + (lane >> 2) * 16 + (lane & 3) * 4) = float4{bflo(gu.x), bfhi(gu.x), bflo(gu.y), bfhi(gu.y)};
    __syncthreads();
    if (c + 1 < NC) gload(c + 1);
#pragma unroll 2
    for (int t = 0; t < 16; ++t) {
      float ur = 0.f, ui = 0.f;
#pragma unroll
      for (int q4 = 0; q4 < 4; ++q4) {
        const float4 uu = *(const float4*)(su + t * 16 + q4 * 4);
        ur += uu.x * bre[q4 * 4] + uu.y * bre[q4 * 4 + 1] + uu.z * bre[q4 * 4 + 2] + uu.w * bre[q4 * 4 + 3];
        ui += uu.x * bim[q4 * 4] + uu.y * bim[q4 * 4 + 1] + uu.z * bim[q4 * 4 + 2] + uu.w * bim[q4 * 4 + 3];
      }
      const float nr = ab.x * xr - ab.y * xi + ur;
      const float ni = ab.x * xi + ab.y * xr + ui;
      xr = nr; xi = ni;
      hist[t * 136 + lane] = f2bf(xr);
      hist[t * 136 + 64 + lane] = f2bf(xi);
    }
    __syncthreads();
    f32x4 acc = {0.f, 0.f, 0.f, 0.f};
#pragma unroll
    for (int ks = 0; ks < 4; ++ks) {
      const bf16x8 a = *(const bf16x8*)(hist + l16 * 136 + ks * 32 + quad * 8);
      acc = __builtin_amdgcn_mfma_f32_16x16x32_bf16(a, cf[ks], acc, 0, 0, 0);
    }
#pragma unroll
    for (int r = 0; r < 4; ++r) {
      const int t = quad * 4 + r;
      const float y = acc[r] + dcoef * su[t * 16 + l16];
      const float z = 0.5f * y * (1.f + tanhf(0.7978845608028654f * (y + 0.044715f * y * y * y)));
      Z[(size_t)(c * 16 + t) * 512 + l16] = f2bf(z);
    }
    __syncthreads();
  }
}

__global__ void __launch_bounds__(256, 2) mega_kernel(Params p) {
  cg::grid_group grid = cg::this_grid();
  __shared__ __attribute__((aligned(16))) char smem[SMEM_BYTES];
  const int bid = blockIdx.x, nb = gridDim.x;
  char* ws = p.ws;
  float* X = p.out;
  bf16_t* Wt_in = (bf16_t*)(ws + OFF_WIN);
  bf16_t* Wt_q = (bf16_t*)(ws + OFF_WQ);
  bf16_t* Wt_br = (bf16_t*)(ws + OFF_WBR);
  bf16_t* Wt_out = (bf16_t*)(ws + OFF_WOUT);
  bf16_t* Wt_glu = (bf16_t*)(ws + OFF_WGLU);
  bf16_t* Wt_wup = (bf16_t*)(ws + OFF_WWUP);
  bf16_t* Wt_aup = (bf16_t*)(ws + OFF_WAUP);
  bf16_t* Wt_gup = (bf16_t*)(ws + OFF_WGUP);
  bf16_t* Wt_v = (bf16_t*)(ws + OFF_WV);
  bf16_t* Wt_xkv = (bf16_t*)(ws + OFF_WXKV);
  bf16_t* Hb = (bf16_t*)(ws + OFF_H);
  bf16_t* Vfirst = (bf16_t*)(ws + OFF_VFIRST);
  bf16_t* Kx = (bf16_t*)(ws + OFF_KX);
  bf16_t* VxT = (bf16_t*)(ws + OFF_VXT);
  bf16_t* Hm = (bf16_t*)(ws + OFF_HM);
  float* CosT = (float*)(ws + OFF_COS);
  float* SinT = (float*)(ws + OFF_SIN);
  bf16_t* Pm = (bf16_t*)(ws + R_P);
  bf16_t* Cqn = (bf16_t*)(ws + R_CQN);
  bf16_t* Qp = (bf16_t*)(ws + R_QP);
  bf16_t* KVlat = (bf16_t*)(ws + R_KVLAT);
  bf16_t* VTm = (bf16_t*)(ws + R_VT);
  bf16_t* RKV = (bf16_t*)(ws + R_RKV);
  bf16_t* Alora = (bf16_t*)(ws + R_ALORA);
  float* Yrw = (float*)(ws + R_YRW);
  bf16_t* Zs5 = (bf16_t*)(ws + R_ZS5);
  bf16_t* Ybr = (bf16_t*)(ws + R_YBR);
  bf16_t* Wt_xq = (bf16_t*)(ws + R_WXQ);
  bf16_t* Wt_xo = (bf16_t*)(ws + R_WXO);
  bf16_t* Wt_gu = (bf16_t*)(ws + R_WGU);
  bf16_t* Wt_down = (bf16_t*)(ws + R_WDOWN);
  bf16_t* Qx = (bf16_t*)(ws + R_QX);
  bf16_t* Ox = (bf16_t*)(ws + R_OX);
  bf16_t* GU = (bf16_t*)(ws + R_GU);
  const float LOG2E = 1.4426950408889634f;

  for (int l = 0; l < 2; ++l) {
    {
      PHASE_IDS
      const float* w_in = p.in[4] + (size_t)l * 1024 * P_IN;
      transpose_all(w_in, P_IN, 1024, P_IN, Wt_in, bid, nb, smem);
      transpose_all(p.in[36] + (size_t)l * 512 * 1024, 1024, 512, 1024, Wt_br + (size_t)1 * 1024 * 512, bid, nb, smem);
      transpose_all(p.in[37] + (size_t)l * 512 * 1024, 1024, 512, 1024, Wt_br + (size_t)2 * 1024 * 512, bid, nb, smem);
      transpose_all(p.in[38] + (size_t)l * 512 * 1024, 1024, 512, 1024, Wt_br + (size_t)3 * 1024 * 512, bid, nb, smem);
      transpose_all(p.in[39] + (size_t)l * 1024 * 1024, 1024, 1024, 1024, Wt_out, bid, nb, smem);
      transpose_all(p.in[19] + (size_t)l * 512 * 512, 512, 512, 512, Wt_glu, bid, nb, smem);
      transpose_all(p.in[23] + (size_t)l * 64 * 512, 512, 64, 512, Wt_wup, bid, nb, smem);
      transpose_all(p.in[25] + (size_t)l * 64 * 512, 512, 64, 512, Wt_aup, bid, nb, smem);
      transpose_all(p.in[26] + (size_t)l * 128 * 512, 512, 128, 512, Wt_gup, bid, nb, smem);
      transpose_all(p.in[43] + (size_t)l * 1024 * 2048, 2048, 1024, 2048, Wt_xkv, bid, nb, smem);
      const int gtid = bid * 256 + tid, gsz = nb * 256;
      {
        const float* w_uq = p.in[6] + (size_t)l * 256 * 768;
        const float* w_ukv = p.in[8] + (size_t)l * 128 * 1024;
        for (int e = gtid; e < 768 * 256; e += gsz) {
          const int n = e >> 8, kq = e & 255, hh = n / 192, j = n % 192;
          float v;
          if (j >= 128) v = w_uq[kq * 768 + n];
          else {
            v = 0.f;
            const float* a = w_uq + kq * 768 + hh * 192;
            const float* b = w_ukv + j * 1024 + hh * 256;
            for (int d = 0; d < 128; ++d) v += a[d] * b[d];
          }
          Wt_q[e] = f2bf(v);
        }
        const float* w_bm = p.in[35] + (size_t)l * 512 * 1024;
        for (int e = gtid; e < 1024 * 512; e += gsz) {
          const int n = e & 1023, kk = e >> 10, hh = kk >> 7, j = kk & 127;
          const float* a = w_ukv + j * 1024 + hh * 256 + 128;
          float v = 0.f;
          for (int d = 0; d < 128; ++d) v += a[d] * w_bm[(size_t)(hh * 128 + d) * 1024 + n];
          Wt_br[(size_t)n * 512 + kk] = f2bf(v);
        }
        if (l == 1) {
          const float* vd = p.in[32];
          const float* vu = p.in[33];
          for (int e = gtid; e < 512 * 1024; e += gsz) {
            const int n = e & 511, kk = e >> 9;
            float v = 0.f;
            for (int r = 0; r < 32; ++r) v += vd[kk * 32 + r] * vu[r * 512 + n];
            Wt_v[(size_t)n * 1024 + kk] = f2bf(v);
          }
        }
      }
      {
        float* abp = (float*)(ws + OFF_S5AB);
        float* bbp = (float*)(ws + OFF_S5BB);
        for (int e = gtid; e < 2048; e += gsz) {
          const int g = e >> 6;
          const float are = fminf(p.in[11][l * 2048 + e], -1e-4f), aim = p.in[12][l * 2048 + e];
          const float dt = expf(p.in[13][l * 32 + g]);
          const float mag = expf(dt * are);
          const float abre = mag * cosf(dt * aim), abim = mag * sinf(dt * aim);
          const float den = are * are + aim * aim;
          const float zre = ((abre - 1.f) * are + abim * aim) / den;
          const float zim = (abim * are - (abre - 1.f) * aim) / den;
          abp[e * 2] = abre; abp[e * 2 + 1] = abim;
          const float* Br = p.in[14] + (size_t)l * 32768 + (size_t)e * 16;
          const float* Bi = p.in[15] + (size_t)l * 32768 + (size_t)e * 16;
          for (int c = 0; c < 16; ++c) {
            bbp[e * 32 + c] = zre * Br[c] - zim * Bi[c];
            bbp[e * 32 + 16 + c] = zre * Bi[c] + zim * Br[c];
          }
        }
      }
      if (l == 0) rmsnorm_rows(p.in[0], p.in[3], Hb, X, T_ALL, bid, nb);
      else rmsnorm_rows(X, p.in[3] + 1024, Hb, nullptr, T_ALL, bid, nb);
      rmsnorm_rows(p.in[1], p.in[41] + l * 1024, Hm, nullptr, 1024, bid, nb);
    }
    grid.sync();

    for (int half = 0; half < 2; ++half) {
      const bf16_t* Hh = Hb + (size_t)half * TH * 1024;
      {
        const int n1 = 64 * 38;
        const int n2 = (half == 0) ? 8 * 16 : 0;
        for (int u = bid; u < n1 + n2; u += nb) {
          f32x4 acc[4][4];
          zero_acc<4>(acc);
          if (u < n1) {
            const int tn = u % 38, tm = u / 38;
            gemm_acc<128>(Hh + (size_t)tm * 128 * 1024, 1024, Wt_in + (size_t)tn * 128 * 1024, 1024, 1024, smem, acc);
            EPI_FOR(128) {
              const int row = tm * 128 + EPI_ROW, n = tn * 128 + EPI_COL(128);
              if (n < GATE_OFF) {
                const int pc = (n < 448) ? n : n + 64;
                Pm[(size_t)row * PLD + pc] = f2bf(acc[i][j][r]);
              }
            }
          } else {
            const int v = u - n1, tn = v % 16, tm = v / 16;
            gemm_acc<128>(Hm + (size_t)tm * 128 * 1024, 1024, Wt_xkv + (size_t)tn * 128 * 1024, 1024, 1024, smem, acc);
            EPI_FOR(128) {
              const int row = tm * 128 + EPI_ROW, n = tn * 128 + EPI_COL(128);
              const int b = row >> 8, m = row & 255, sel = n >> 10, hh = (n >> 8) & 3, d = n & 255;
              if (sel == 0) Kx[((size_t)(b * 4 + hh) * 256 + m) * 256 + d] = f2bf(acc[i][j][r]);
              else VxT[((size_t)(b * 4 + hh) * 256 + d) * 256 + m] = f2bf(acc[i][j][r]);
            }
          }
        }
      }
      grid.sync();
      {
      PHASE_IDS
        const float* qn = p.in[5] + l * 256;
        const float* kvn = p.in[7] + l * 128;
        const float* mu = p.in[21] + l * 1792;
        for (int tk = bid * 4 + wave; tk < TH; tk += nb * 4) {
          const int gtok = half * TH + tk, s = gtok & (SEQ - 1), bl = tk >> 12;
          const bf16_t* prow = Pm + (size_t)tk * PLD;
          {
            const uint2 cu = *(const uint2*)(prow + lane * 4);
            float f[4] = {bflo(cu.x), bfhi(cu.x), bflo(cu.y), bfhi(cu.y)};
            float ss = wave_sum(f[0] * f[0] + f[1] * f[1] + f[2] * f[2] + f[3] * f[3]);
            const float rs = rsqrtf(ss * (1.f / 256.f) + 1e-6f);
            const float4 g4 = *(const float4*)(qn + lane * 4);
            uint2 o; o.x = pack2(f[0] * rs * g4.x, f[1] * rs * g4.y); o.y = pack2(f[2] * rs * g4.z, f[3] * rs * g4.w);
            *(uint2*)(Cqn + (size_t)tk * 256 + lane * 4) = o;
          }
          {
            const unsigned cu = *(const unsigned*)(prow + 256 + lane * 2);
            const float f0 = bflo(cu), f1 = bfhi(cu);
            const float ss = wave_sum(f0 * f0 + f1 * f1);
            const float rs = rsqrtf(ss * (1.f / 128.f) + 1e-6f);
            const float v0 = f0 * rs * kvn[lane * 2], v1 = f1 * rs * kvn[lane * 2 + 1];
            const bf16_t b0 = f2bf(v0), b1 = f2bf(v1);
            *(unsigned*)(KVlat + (size_t)tk * 192 + lane * 2) = (unsigned)b0 | ((unsigned)b1 << 16);
            VTm[((size_t)bl * 128 + lane * 2) * SEQ + s] = b0;
            VTm[((size_t)bl * 128 + lane * 2 + 1) * SEQ + s] = b1;
          }
          if (lane < 32) {
            const float t1 = bf2f(prow[384 + lane]), t2 = bf2f(prow[384 + 32 + lane]);
            const float posf = (float)p.pos[gtok];
            const float invf = exp2f(-(float)lane * (13.287712379549449f / 32.f));
            const float ang = posf * invf;
            const float cs = cosf(ang), sn = sinf(ang);
            KVlat[(size_t)tk * 192 + 128 + lane] = f2bf(t1 * cs - t2 * sn);
            KVlat[(size_t)tk * 192 + 160 + lane] = f2bf(t1 * sn + t2 * cs);
            CosT[tk * 32 + lane] = cs; SinT[tk * 32 + lane] = sn;
          }
#pragma unroll
          for (int jj = 0; jj < 7; ++jj) {
            const int col = (jj * 64 + lane) * 4;
            const uint2 cu = *(const uint2*)(prow + PC_RW + col);
            uint2 pu = uint2{0u, 0u};
            if (s > 0) pu = *(const uint2*)(prow - PLD + PC_RW + col);
            const float4 m4 = *(const float4*)(mu + col);
            const float cv[4] = {bflo(cu.x), bfhi(cu.x), bflo(cu.y), bfhi(cu.y)};
            const float pv[4] = {bflo(pu.x), bfhi(pu.x), bflo(pu.y), bfhi(pu.y)};
            const float mm[4] = {m4.x, m4.y, m4.z, m4.w};
            float o[4];
#pragma unroll
            for (int e = 0; e < 4; ++e) o[e] = cv[e] + (pv[e] - cv[e]) * mm[e];
            if (col < 1536) {
              uint2 ov; ov.x = pack2(o[0], o[1]); ov.y = pack2(o[2], o[3]);
              *(uint2*)(RKV + (size_t)tk * 1536 + col) = ov;
              if (l == 0 && col >= 1024) *(uint2*)(Vfirst + (size_t)gtok * 512 + (col - 1024)) = ov;
            } else {
              int dc;
              if (col < 1600) { dc = col - 1536; for (int e = 0; e < 4; ++e) o[e] = tanhf(o[e]); }
              else if (col < 1664) { dc = 64 + col - 1600; }
              else { dc = 128 + col - 1664; for (int e = 0; e < 4; ++e) o[e] = sigm(o[e]); }
              uint2 ov; ov.x = pack2(o[0], o[1]); ov.y = pack2(o[2], o[3]);
              *(uint2*)(Alora + (size_t)tk * 256 + dc) = ov;
            }
          }
        }
      }
      grid.sync();
      {
      PHASE_IDS
        const int nq = 64 * 6, nl = 64 * 4;
        const int total = nq + 3 * nl + (l == 1 ? nl : 0);
        for (int u = bid; u < total; u += nb) {
          f32x4 acc[4][4];
          zero_acc<4>(acc);
          if (u < nq) {
            const int tn = u % 6, tm = u / 6;
            gemm_acc<128>(Cqn + (size_t)tm * 128 * 256, 256, Wt_q + (size_t)tn * 128 * 256, 256, 256, smem, acc);
            const float qs = 0.07216878364870322f * LOG2E;
            const int lane_ = tid & 63, wave_ = tid >> 6, wm_ = wave_ >> 1, wn_ = wave_ & 1, l16_ = lane_ & 15, quad_ = lane_ >> 4;
            const int gc = tn * 128 + wn_ * 64;
            const bool is_rope = (gc % 192) == 128;
#pragma unroll
            for (int i = 0; i < 4; ++i)
#pragma unroll
              for (int r = 0; r < 4; ++r) {
                const int row = tm * 128 + wm_ * 64 + i * 16 + quad_ * 4 + r;
                float v[4] = {acc[i][0][r], acc[i][1][r], acc[i][2][r], acc[i][3][r]};
                if (is_rope) {
#pragma unroll
                  for (int j = 0; j < 2; ++j) {
                    const int fi = j * 16 + l16_;
                    const float cs = CosT[row * 32 + fi], sn = SinT[row * 32 + fi];
                    const float t1 = v[j], t2 = v[j + 2];
                    v[j] = t1 * cs - t2 * sn; v[j + 2] = t1 * sn + t2 * cs;
                  }
                }
#pragma unroll
                for (int j = 0; j < 4; ++j) Qp[(size_t)row * 768 + gc + j * 16 + l16_] = f2bf(v[j] * qs);
              }
          } else if (u < nq + 3 * nl) {
            const int v = u - nq, which = v / nl, w2 = v % nl, tn = w2 % 4, tm = w2 / 4;
            if (which == 0) {
              gemm_acc<128>(Alora + (size_t)tm * 128 * 256, 256, Wt_wup + (size_t)tn * 128 * 64, 64, 64, smem, acc);
              const float* w0 = p.in[22] + l * 512;
              EPI_FOR(128) {
                const int row = tm * 128 + EPI_ROW, n = tn * 128 + EPI_COL(128);
                Pm[(size_t)row * PLD + PC_RW + n] = f2bf(w0[n] + acc[i][j][r]);
              }
            } else if (which == 1) {
              gemm_acc<128>(Alora + (size_t)tm * 128 * 256 + 64, 256, Wt_aup + (size_t)tn * 128 * 64, 64, 64, smem, acc);
              const float* a0 = p.in[24] + l * 512;
              EPI_FOR(128) {
                const int row = tm * 128 + EPI_ROW, n = tn * 128 + EPI_COL(128);
                Pm[(size_t)row * PLD + PC_RW + 512 + n] = f2bf(sigm(a0[n] + acc[i][j][r]));
              }
            } else {
              gemm_acc<128>(Alora + (size_t)tm * 128 * 256 + 128, 256, Wt_gup + (size_t)tn * 128 * 128, 128, 128, smem, acc);
              EPI_FOR(128) {
                const int row = tm * 128 + EPI_ROW, n = tn * 128 + EPI_COL(128);
                Pm[(size_t)row * PLD + PC_RW + 1024 + n] = f2bf(acc[i][j][r]);
              }
            }
          } else {
            const int w2 = u - nq - 3 * nl, tn = w2 % 4, tm = w2 / 4;
            gemm_acc<128>(Hh + (size_t)tm * 128 * 1024, 1024, Wt_v + (size_t)tn * 128 * 1024, 1024, 1024, smem, acc);
            const float* vb = p.in[34];
            EPI_FOR(128) {
              const int row = tm * 128 + EPI_ROW, n = tn * 128 + EPI_COL(128);
              const float gate = sigm(vb[n] + acc[i][j][r]);
              const float vc = bf2f(RKV[(size_t)row * 1536 + 1024 + n]);
              const float vf = bf2f(Vfirst[((size_t)half * TH + row) * 512 + n]);
              RKV[(size_t)row * 1536 + 1024 + n] = f2bf(vc + (vf - vc) * gate);
            }
          }
        }
      }
      grid.sync();
      {
        for (int u = bid; u < 64 + 64 + 16 + 256; u += nb) {
          if (u < 64) rwkv_scan_unit(p, l, u, smem);
          else if (u < 128) hgrn_scan_unit(p, l, u - 64, smem);
          else if (u < 144) s5_scan_unit(p, l, u - 128, smem);
          else {
            const int it = u - 144, qt = 31 - (it >> 3), bl = (it >> 2) & 1, hh = it & 3;
            attn_item<192, true>(Qp + (size_t)bl * SEQ * 768 + hh * 192, 768, KVlat + (size_t)bl * SEQ * 192, 192,
                                 VTm + (size_t)bl * 128 * SEQ, SEQ, (qt * 128 + 128) / 64, qt * 128,
                                 Pm + (size_t)bl * SEQ * PLD + hh * 128, PLD, smem);
          }
        }
      }
      grid.sync();
      {
      PHASE_IDS
        const int nglu = 64 * 4;
        for (int u = bid; u < nglu; u += nb) {
          const int tn = u % 4, tm = u / 4;
          f32x4 acc[4][4];
          zero_acc<4>(acc);
          gemm_acc<128>(Zs5 + (size_t)tm * 128 * 512, 512, Wt_glu + (size_t)tn * 128 * 512, 512, 512, smem, acc);
          const float* bg = p.in[20] + l * 512;
          EPI_FOR(128) {
            const int row = tm * 128 + EPI_ROW, n = tn * 128 + EPI_COL(128);
            const float z = bf2f(Zs5[(size_t)row * 512 + n]);
            Pm[(size_t)row * PLD + PC_S5 + n] = f2bf(z * sigm(acc[i][j][r] + bg[n]));
          }
        }
        const float* k_a = p.in[28] + l * 512;
        const float* r_k = p.in[29] + l * 512;
        const float* ln_w = p.in[30] + l * 512;
        const float* ln_b = p.in[31] + l * 512;
        const float* o_norm = p.in[10] + l * 512;
        for (int tk = bid * 4 + wave; tk < TH; tk += nb * 4) {
          const int c0 = lane * 8;
          {
            const float4 y0 = *(const float4*)(Yrw + (size_t)tk * 512 + c0), y1 = *(const float4*)(Yrw + (size_t)tk * 512 + c0 + 4);
            const float y[8] = {y0.x, y0.y, y0.z, y0.w, y1.x, y1.y, y1.z, y1.w};
            const uint4 ru = *(const uint4*)(RKV + (size_t)tk * 1536 + c0);
            const uint4 ku = *(const uint4*)(RKV + (size_t)tk * 1536 + 512 + c0);
            const uint4 vu = *(const uint4*)(RKV + (size_t)tk * 1536 + 1024 + c0);
            const uint4 au = *(const uint4*)(Pm + (size_t)tk * PLD + PC_RW + 512 + c0);
            const uint4 gu = *(const uint4*)(Pm + (size_t)tk * PLD + PC_RW + 1024 + c0);
            const unsigned ra[4] = {ru.x, ru.y, ru.z, ru.w}, ka[4] = {ku.x, ku.y, ku.z, ku.w}, va[4] = {vu.x, vu.y, vu.z, vu.w};
            const unsigned aa[4] = {au.x, au.y, au.z, au.w}, ga[4] = {gu.x, gu.y, gu.z, gu.w};
            float rr[8], kh[8], vv[8], gg[8];
            float sm1 = 0.f, bsum = 0.f;
#pragma unroll
            for (int e = 0; e < 8; ++e) {
              const unsigned sh = (e & 1);
              rr[e] = sh ? bfhi(ra[e >> 1]) : bflo(ra[e >> 1]);
              const float kx = sh ? bfhi(ka[e >> 1]) : bflo(ka[e >> 1]);
              vv[e] = sh ? bfhi(va[e >> 1]) : bflo(va[e >> 1]);
              const float a = sh ? bfhi(aa[e >> 1]) : bflo(aa[e >> 1]);
              gg[e] = sh ? bfhi(ga[e >> 1]) : bflo(ga[e >> 1]);
              kh[e] = kx * (1.f + (a - 1.f) * k_a[c0 + e]);
              sm1 += y[e];
              bsum += rr[e] * kh[e] * r_k[c0 + e];
            }
            sm1 = red8(sm1); bsum = red8(bsum);
            const float mean = sm1 * (1.f / 64.f);
            float vs = 0.f;
#pragma unroll
            for (int e = 0; e < 8; ++e) { const float d = y[e] - mean; vs += d * d; }
            vs = red8(vs);
            const float rstd = rsqrtf(vs * (1.f / 64.f) + 64e-5f);
            float o[8];
#pragma unroll
            for (int e = 0; e < 8; ++e) o[e] = (((y[e] - mean) * rstd) * ln_w[c0 + e] + ln_b[c0 + e] + bsum * vv[e]) * gg[e];
            uint4 ov; ov.x = pack2(o[0], o[1]); ov.y = pack2(o[2], o[3]); ov.z = pack2(o[4], o[5]); ov.w = pack2(o[6], o[7]);
            *(uint4*)(RKV + (size_t)tk * 1536 + c0) = ov;
          }
          {
            bf16_t* op = Pm + (size_t)tk * PLD + PC_HG + 1024 + c0;
            const uint4 ou = *(const uint4*)op;
            const uint4 gu = *(const uint4*)(Pm + (size_t)tk * PLD + PC_HG + 1536 + c0);
            const unsigned oa[4] = {ou.x, ou.y, ou.z, ou.w}, ga[4] = {gu.x, gu.y, gu.z, gu.w};
            float o[8], ss = 0.f;
#pragma unroll
            for (int e = 0; e < 4; ++e) { o[2 * e] = bflo(oa[e]); o[2 * e + 1] = bfhi(oa[e]); }
#pragma unroll
            for (int e = 0; e < 8; ++e) ss += o[e] * o[e];
            ss = red16(ss);
            const float rs = rsqrtf(ss * (1.f / 128.f) + 1e-6f);
            float r8[8];
#pragma unroll
            for (int e = 0; e < 8; ++e) {
              const float gte = (e & 1) ? bfhi(ga[e >> 1]) : bflo(ga[e >> 1]);
              r8[e] = o[e] * rs * o_norm[c0 + e] * sigm(gte);
            }
            uint4 ov; ov.x = pack2(r8[0], r8[1]); ov.y = pack2(r8[2], r8[3]); ov.z = pack2(r8[4], r8[5]); ov.w = pack2(r8[6], r8[7]);
            *(uint4*)op = ov;
          }
        }
      }
      grid.sync();
      {
        for (int u = bid; u < 64 * 16; u += nb) {
          const int tn = u % 16, tm = u / 16;
          f32x4 yacc[4][2];
          zero_acc<2>(yacc);
#pragma unroll 1
          for (int m = 0; m < 4; ++m) {
            f32x4 ag[4][2];
            zero_acc<2>(ag);
            gemm_acc<64>(Hh + (size_t)tm * 128 * 1024, 1024, Wt_in + (size_t)(GATE_OFF + m * 1024 + tn * 64) * 1024, 1024, 1024, smem, ag);
#pragma unroll
            for (int i = 0; i < 4; ++i)
#pragma unroll
              for (int j = 0; j < 2; ++j)
#pragma unroll
                for (int r = 0; r < 4; ++r) ag[i][j][r] = sigm(ag[i][j][r]);
            f32x4 ao[4][2];
            zero_acc<2>(ao);
            const bf16_t* Ao; int lda;
            if (m == 0) { Ao = Pm; lda = PLD; }
            else if (m == 1) { Ao = Pm + PC_HG + 1024; lda = PLD; }
            else if (m == 2) { Ao = Pm + PC_S5; lda = PLD; }
            else { Ao = RKV; lda = 1536; }
            gemm_acc<64>(Ao + (size_t)tm * 128 * lda, lda, Wt_br + ((size_t)m * 1024 + tn * 64) * 512, 512, 512, smem, ao);
#pragma unroll
            for (int i = 0; i < 4; ++i)
#pragma unroll
              for (int j = 0; j < 2; ++j)
#pragma unroll
                for (int r = 0; r < 4; ++r) yacc[i][j][r] += ag[i][j][r] * ao[i][j][r];
          }
          {
            f32x4 (&acc)[4][2] = yacc;
            EPI_FOR(64) {
              const int row = tm * 128 + EPI_ROW, n = tn * 64 + EPI_COL(64);
              Ybr[(size_t)row * 1024 + n] = f2bf(acc[i][j][r]);
            }
          }
        }
      }
      grid.sync();
      {
        for (int u = bid; u < 64 * 8; u += nb) {
          const int tn = u % 8, tm = u / 8;
          f32x4 acc[4][4];
          zero_acc<4>(acc);
          gemm_acc<128>(Ybr + (size_t)tm * 128 * 1024, 1024, Wt_out + (size_t)tn * 128 * 1024, 1024, 1024, smem, acc);
          EPI_FOR(128) {
            const int row = half * TH + tm * 128 + EPI_ROW, n = tn * 128 + EPI_COL(128);
            X[(size_t)row * 1024 + n] += acc[i][j][r];
          }
        }
      }
      grid.sync();
    }

    {
      transpose_all(p.in[42] + (size_t)l * 1024 * 1024, 1024, 1024, 1024, Wt_xq, bid, nb, smem);
      transpose_all(p.in[44] + (size_t)l * 1024 * 1024, 1024, 1024, 1024, Wt_xo, bid, nb, smem);
      transpose_all(p.in[46] + (size_t)l * 1024 * 5632, 5632, 1024, 5632, Wt_gu, bid, nb, smem);
      transpose_all(p.in[49] + (size_t)l * 2816 * 1024, 1024, 2816, 1024, Wt_down, bid, nb, smem);
      rmsnorm_rows(X, p.in[40] + l * 1024, Hb, nullptr, T_ALL, bid, nb);
    }
    grid.sync();
    {
      const float qs = 0.0625f * LOG2E;
      for (int u = bid; u < 128 * 8; u += nb) {
        const int tn = u % 8, tm = u / 8;
        f32x4 acc[4][4];
        zero_acc<4>(acc);
        gemm_acc<128>(Hb + (size_t)tm * 128 * 1024, 1024, Wt_xq + (size_t)tn * 128 * 1024, 1024, 1024, smem, acc);
        EPI_FOR(128) {
          const int row = tm * 128 + EPI_ROW, n = tn * 128 + EPI_COL(128);
          Qx[(size_t)row * 1024 + n] = f2bf(acc[i][j][r] * qs);
        }
      }
    }
    grid.sync();
    {
      for (int u = bid; u < 1024; u += nb) {
        const int dvh = u & 1, hh = (u >> 1) & 3, qt = (u >> 3) & 31, b = u >> 8;
        attn_item<256, false>(Qx + (size_t)b * SEQ * 1024 + hh * 256, 1024, Kx + (size_t)(b * 4 + hh) * 65536, 256,
                              VxT + (size_t)(b * 4 + hh) * 65536 + (size_t)dvh * 128 * 256, 256, 4, qt * 128,
                              Ox + (size_t)b * SEQ * 1024 + hh * 256 + dvh * 128, 1024, smem);
      }
    }
    grid.sync();
    {
      for (int u = bid; u < 128 * 8; u += nb) {
        const int tn = u % 8, tm = u / 8;
        f32x4 acc[4][4];
        zero_acc<4>(acc);
        gemm_acc<128>(Ox + (size_t)tm * 128 * 1024, 1024, Wt_xo + (size_t)tn * 128 * 1024, 1024, 1024, smem, acc);
        EPI_FOR(128) {
          const int row = tm * 128 + EPI_ROW, n = tn * 128 + EPI_COL(128);
          X[(size_t)row * 1024 + n] += acc[i][j][r];
        }
      }
    }
    grid.sync();
    rmsnorm_rows(X, p.in[45] + l * 1024, Hb, nullptr, T_ALL, bid, nb);
    grid.sync();
    for (int half = 0; half < 2; ++half) {
      const bf16_t* Hh = Hb + (size_t)half * TH * 1024;
      for (int u = bid; u < 64 * 44; u += nb) {
        const int tn = u % 44, tm = u / 44;
        f32x4 acc[4][4];
        zero_acc<4>(acc);
        gemm_acc<128>(Hh + (size_t)tm * 128 * 1024, 1024, Wt_gu + (size_t)tn * 128 * 1024, 1024, 1024, smem, acc);
        EPI_FOR(128) {
          const int row = tm * 128 + EPI_ROW, n = tn * 128 + EPI_COL(128);
          GU[(size_t)row * 5632 + n] = f2bf(acc[i][j][r]);
        }
      }
      grid.sync();
      {
      PHASE_IDS
        const float* cw = p.in[47] + (size_t)l * 3 * D_FF;
        const float* cb = p.in[48] + (size_t)l * D_FF;
        for (int e = bid * 256 + tid; e < TH * 352; e += nb * 256) {
          const int tk = e / 352, c0 = (e % 352) * 8;
          const int s = tk & (SEQ - 1);
          const bf16_t* gp = GU + (size_t)tk * 5632 + c0;
          const uint4 g2 = *(const uint4*)gp;
          uint4 g1 = uint4{0, 0, 0, 0}, g0 = uint4{0, 0, 0, 0};
          if (s >= 1) g1 = *(const uint4*)(gp - 5632);
          if (s >= 2) g0 = *(const uint4*)(gp - 2 * 5632);
          const uint4 uu = *(const uint4*)(gp + D_FF);
          const unsigned a2[4] = {g2.x, g2.y, g2.z, g2.w}, a1[4] = {g1.x, g1.y, g1.z, g1.w}, a0[4] = {g0.x, g0.y, g0.z, g0.w};
          const unsigned au[4] = {uu.x, uu.y, uu.z, uu.w};
          float o[8];
#pragma unroll
          for (int q = 0; q < 8; ++q) {
            const bool hi = q & 1;
            const float x2 = hi ? bfhi(a2[q >> 1]) : bflo(a2[q >> 1]);
            const float x1 = hi ? bfhi(a1[q >> 1]) : bflo(a1[q >> 1]);
            const float x0 = hi ? bfhi(a0[q >> 1]) : bflo(a0[q >> 1]);
            const float up = hi ? bfhi(au[q >> 1]) : bflo(au[q >> 1]);
            const int c = c0 + q;
            const float gv = cw[c] * x0 + cw[D_FF + c] * x1 + cw[2 * D_FF + c] * x2 + cb[c];
            o[q] = gv * sigm(gv) * up;
          }
          uint4 ov; ov.x = pack2(o[0], o[1]); ov.y = pack2(o[2], o[3]); ov.z = pack2(o[4], o[5]); ov.w = pack2(o[6], o[7]);
          *(uint4*)(GU + (size_t)tk * 5632 + D_FF + c0) = ov;
        }
      }
      grid.sync();
      for (int u = bid; u < 64 * 8; u += nb) {
        const int tn = u % 8, tm = u / 8;
        f32x4 acc[4][4];
        zero_acc<4>(acc);
        gemm_acc<128>(GU + (size_t)tm * 128 * 5632 + D_FF, 5632, Wt_down + (size_t)tn * 128 * 2816, 2816, 2816, smem, acc);
        EPI_FOR(128) {
          const int row = half * TH + tm * 128 + EPI_ROW, n = tn * 128 + EPI_COL(128);
          X[(size_t)row * 1024 + n] += acc[i][j][r];
        }
      }
      grid.sync();
    }
  }

  {
      PHASE_IDS
    const float* g = p.in[50];
    for (int r = bid * 4 + wave; r < T_ALL; r += nb * 4) {
      float4* xr = (float4*)(X + (size_t)r * 1024);
      float4 v[4]; float ss = 0.f;
#pragma unroll
      for (int i = 0; i < 4; ++i) { v[i] = xr[lane + 64 * i]; ss += v[i].x * v[i].x + v[i].y * v[i].y + v[i].z * v[i].z + v[i].w * v[i].w; }
      ss = wave_sum(ss);
      const float rs = rsqrtf(ss * (1.f / 1024.f) + 1e-6f);
#pragma unroll
      for (int i = 0; i < 4; ++i) {
        const float4 gg = ((const float4*)g)[lane + 64 * i];
        xr[lane + 64 * i] = float4{v[i].x * rs * gg.x, v[i].y * rs * gg.y, v[i].z * rs * gg.z, v[i].w * rs * gg.w};
      }
    }
  }
}

extern "C" void kernel_launch(void* const* d_in, const int* in_sizes, int n_in, void* d_out, int out_size, void* d_ws, size_t ws_size,
                              hipStream_t stream) {
  static int grid_blocks = 0;
  if (!grid_blocks) {
    int dev = 0, cus = 0, per_cu = 0;
    hipGetDevice(&dev);
    hipDeviceGetAttribute(&cus, hipDeviceAttributeMultiprocessorCount, dev);
    hipOccupancyMaxActiveBlocksPerMultiprocessor(&per_cu, mega_kernel, 256, 0);
    if (per_cu > 2) per_cu = 2;
    if (per_cu < 1) per_cu = 1;
    grid_blocks = cus * per_cu;
  }
  if (ws_size < WS_NEED) fprintf(stderr, "workspace too small: %zu < %zu\n", ws_size, (size_t)WS_NEED);
  Params p{};
  for (int i = 0; i < 51; ++i) p.in[i] = (const float*)d_in[i];
  p.pos = (const int*)d_in[2];
  p.out = (float*)d_out;
  p.ws = (char*)d_ws;
  void* args[] = {&p};
  hipError_t e = hipLaunchCooperativeKernel((void*)mega_kernel, dim3(grid_blocks), dim3(256), args, 0, stream);
  if (e != hipSuccess) fprintf(stderr, "cooperative launch failed: %s (grid %d)\n", hipGetErrorString(e), grid_blocks);
}
```

```cpp
#include <hip/hip_runtime.h>
#include <hip/hip_cooperative_groups.h>
#include <cstdio>
#include <cstdint>
namespace cg = cooperative_groups;

typedef unsigned short bf16_t;
using bf16x8 = __attribute__((ext_vector_type(8))) short;
using s16x4 = __attribute__((ext_vector_type(4))) short;
using f32x4 = __attribute__((ext_vector_type(4))) float;
using f32x16 = __attribute__((ext_vector_type(16))) float;
#define DI __device__ __forceinline__

constexpr int T_ALL = 16384, SEQ = 4096, DM = 1024, TH = 8192;
constexpr int P_IN = 8896, GATE_OFF = 4800;
constexpr int PLD = 4864;
constexpr int PC_HG = 512, PC_S5 = 2560, PC_RW = 3072;
constexpr int D_FF = 2816;

constexpr size_t al256(size_t x) { return (x + 255) & ~(size_t)255; }
constexpr size_t OFF_WIN = 0;
constexpr size_t OFF_WQ = OFF_WIN + al256((size_t)P_IN * 1024 * 2);
constexpr size_t OFF_WBR = OFF_WQ + al256((size_t)768 * 256 * 2);
constexpr size_t OFF_WOUT = OFF_WBR + al256((size_t)4 * 1024 * 512 * 2);
constexpr size_t OFF_WGLU = OFF_WOUT + al256((size_t)1024 * 1024 * 2);
constexpr size_t OFF_WWUP = OFF_WGLU + al256((size_t)512 * 512 * 2);
constexpr size_t OFF_WAUP = OFF_WWUP + al256((size_t)512 * 64 * 2);
constexpr size_t OFF_WGUP = OFF_WAUP + al256((size_t)512 * 64 * 2);
constexpr size_t OFF_WV = OFF_WGUP + al256((size_t)512 * 128 * 2);
constexpr size_t OFF_WXKV = OFF_WV + al256((size_t)512 * 1024 * 2);
constexpr size_t OFF_S5AB = OFF_WXKV + al256((size_t)2048 * 1024 * 2);
constexpr size_t OFF_S5BB = OFF_S5AB + al256((size_t)32 * 64 * 2 * 4);
constexpr size_t OFF_H = OFF_S5BB + al256((size_t)32 * 64 * 32 * 4);
constexpr size_t OFF_VFIRST = OFF_H + al256((size_t)T_ALL * 1024 * 2);
constexpr size_t OFF_KX = OFF_VFIRST + al256((size_t)T_ALL * 512 * 2);
constexpr size_t OFF_VXT = OFF_KX + al256((size_t)16 * 256 * 256 * 2);
constexpr size_t OFF_HM = OFF_VXT + al256((size_t)16 * 256 * 256 * 2);
constexpr size_t OFF_COS = OFF_HM + al256((size_t)1024 * 1024 * 2);
constexpr size_t OFF_SIN = OFF_COS + al256((size_t)TH * 32 * 4);
constexpr size_t OFF_BAR = OFF_SIN + al256((size_t)TH * 32 * 4);
constexpr size_t OFF_REG = OFF_BAR + 16384;
constexpr size_t R_P = OFF_REG;
constexpr size_t R_CQN = R_P + al256((size_t)TH * PLD * 2);
constexpr size_t R_QP = R_CQN + (size_t)TH * 256 * 2;
constexpr size_t R_KVLAT = R_QP + al256((size_t)TH * 768 * 2);
constexpr size_t R_VT = R_KVLAT + al256((size_t)TH * 192 * 2);
constexpr size_t R_RKV = R_VT + al256((size_t)2 * 128 * 4096 * 2);
constexpr size_t R_ALORA = R_RKV + al256((size_t)TH * 1536 * 2);
constexpr size_t R_YRW = R_ALORA + al256((size_t)TH * 256 * 2);
constexpr size_t R_ZS5 = R_YRW + al256((size_t)TH * 512 * 4);
constexpr size_t R_END1 = R_ZS5 + al256((size_t)TH * 512 * 2);
constexpr size_t R_YBR = R_CQN;
constexpr size_t R_WXQ = OFF_REG;
constexpr size_t R_WXO = R_WXQ + al256((size_t)1024 * 1024 * 2);
constexpr size_t R_WGU = R_WXO + al256((size_t)1024 * 1024 * 2);
constexpr size_t R_WDOWN = R_WGU + al256((size_t)5632 * 1024 * 2);
constexpr size_t R_QX = R_WDOWN + al256((size_t)1024 * 2816 * 2);
constexpr size_t R_OX = R_QX + al256((size_t)T_ALL * 1024 * 2);
constexpr size_t R_GU = R_QX;
constexpr size_t R_END2 = R_GU + al256((size_t)TH * 5632 * 2);
constexpr size_t WS_NEED = (R_END1 > R_END2 ? R_END1 : R_END2);

constexpr int SMEM_BYTES = 73728;

struct Params {
  const float* in[51];
  const int* pos;
  float* out;
  char* ws;
};

DI bf16_t f2bf(float x) { unsigned u = __float_as_uint(x); u += 0x7fffu + ((u >> 16) & 1u); return (bf16_t)(u >> 16); }
DI float bf2f(bf16_t b) { return __uint_as_float(((unsigned)b) << 16); }
DI unsigned pack2(float a, float b) { return (unsigned)f2bf(a) | ((unsigned)f2bf(b) << 16); }
DI float bflo(unsigned u) { return __uint_as_float(u << 16); }
DI float bfhi(unsigned u) { return __uint_as_float(u & 0xffff0000u); }
DI float sigm(float x) { return 1.f / (1.f + __expf(-x)); }
template <int CTRL> DI float dppf(float v) {
  return __builtin_bit_cast(float, __builtin_amdgcn_update_dpp(0, __builtin_bit_cast(int, v), CTRL, 0xf, 0xf, false));
}
DI float red8(float v) { v += dppf<0xB1>(v); v += dppf<0x4E>(v); v += dppf<0x141>(v); return v; }
DI float red16(float v) { v = red8(v); v += dppf<0x140>(v); return v; }
DI int TID() { int t = threadIdx.x; asm volatile("" : "+v"(t)); return t; }
#define PHASE_IDS const int tid = TID(); const int lane = tid & 63, wave = tid >> 6; (void)lane; (void)wave;
DI float wave_sum(float v) { for (int o = 32; o > 0; o >>= 1) v += __shfl_xor(v, o); return v; }


#define XB_TMO      128
#define XB_XCNT(j)  (256  + 64 * (j))
#define XB_XSUB(j)  (1280 + 64 * (j))
#define XB_XGEN(j)  (2304 + 64 * (j))
#define XB_TOP      3328
#define XB_TOPGEN   3392
#define XCD_BAR_WORDS 3456
#define XB_SPIN_CAP (1u << 22)
#define LAS __attribute__((address_space(3)))
DI unsigned xb_ld(unsigned* p) { return __hip_atomic_load(p, __ATOMIC_RELAXED, __HIP_MEMORY_SCOPE_AGENT); }
DI unsigned xb_add(unsigned* p, unsigned v) { return __hip_atomic_fetch_add(p, v, __ATOMIC_RELAXED, __HIP_MEMORY_SCOPE_AGENT); }
DI unsigned xb_xcc_id() { return (unsigned)__builtin_amdgcn_s_getreg((3 << 11) | 20) & 0xFu; }
#define XB_SPIN(cond, bar) do { unsigned _sp = 0; while (cond) { __builtin_amdgcn_s_sleep(1); \
    if ((++_sp & 255u) == 0u) { if (xb_ld(&(bar)[XB_TMO])) break; if (_sp > XB_SPIN_CAP) { atomicAdd(&(bar)[XB_TMO], 1u); break; } } } } while (0)
struct XcdBarrier { unsigned* bar; unsigned x; volatile LAS unsigned* st; };
DI XcdBarrier xcd_barrier_post(unsigned* bar, volatile LAS unsigned* st) {
  XcdBarrier b; b.bar = bar; b.x = xb_xcc_id(); b.st = st;
  if (threadIdx.x == 0) (void)xb_add(&bar[XB_XCNT(b.x)], 1u);
  return b;
}
DI void xcd_barrier_complete(unsigned* bar, unsigned x, unsigned& nloc, unsigned& nx) {
  const unsigned G = gridDim.x * gridDim.y * gridDim.z;
  unsigned sum, cnt, mine, sp = 0u;
  for (;;) {
    sum = 0u; cnt = 0u; mine = 0u;
#pragma unroll
    for (unsigned j = 0; j < 16; ++j) { const unsigned c = xb_ld(&bar[XB_XCNT(j)]); sum += c; cnt += (c > 0u) ? 1u : 0u; mine = (j == x) ? c : mine; }
    if (sum == G) break;
    __builtin_amdgcn_s_sleep(1);
    if ((++sp & 255u) == 0u) { if (xb_ld(&bar[XB_TMO])) break; if (sp > XB_SPIN_CAP) { atomicAdd(&bar[XB_TMO], 1u); break; } }
  }
  nloc = mine > 0u ? mine : 1u; nx = cnt > 0u ? cnt : 1u;
}
DI void xcd_barrier(const XcdBarrier& b) {
  asm volatile("s_waitcnt vmcnt(0)" ::: "memory");
  __syncthreads();
  if (threadIdx.x == 0) {
    unsigned* bar = b.bar;
    __builtin_amdgcn_s_waitcnt(0);
    unsigned nloc = b.st[0], nx = b.st[1];
    if (nloc == 0u) { xcd_barrier_complete(bar, b.x, nloc, nx); b.st[0] = nloc; b.st[1] = nx; }
    const unsigned old = xb_add(&bar[XB_XSUB(b.x)], 1u);
    const unsigned gen = old / nloc;
    if (old + 1u == (gen + 1u) * nloc) {
      __builtin_amdgcn_fence(__ATOMIC_RELEASE, "agent");
      asm volatile("s_waitcnt vmcnt(0)" ::: "memory");
      const unsigned og = xb_add(&bar[XB_TOP], 1u);
      const unsigned tg = og / nx;
      if (og + 1u == (tg + 1u) * nx) xb_add(&bar[XB_TOPGEN], 1u);
      else XB_SPIN(xb_ld(&bar[XB_TOPGEN]) == tg, bar);
      __builtin_amdgcn_fence(__ATOMIC_ACQUIRE, "agent");
      xb_add(&bar[XB_XGEN(b.x)], 1u);
      asm volatile("s_waitcnt vmcnt(0)" ::: "memory");
    } else {
      XB_SPIN(xb_ld(&bar[XB_XGEN(b.x)]) == gen, bar);
      __builtin_amdgcn_fence(__ATOMIC_ACQUIRE, "agent");
      asm volatile("s_waitcnt vmcnt(0)" ::: "memory");
    }
  }
  __syncthreads();
}

template <int BN>
DI void gemm_acc(const bf16_t* __restrict__ A, int lda, const bf16_t* __restrict__ Bt, int ldb, int K, char* smem,
                 f32x4 (&acc)[4][BN / 32]) {
  constexpr int A_EL = 128 * 72, B_EL = BN * 72, BUF_EL = A_EL + B_EL;
  constexpr int NJ = BN / 32, BCH = BN / 32;
  bf16_t* sm = (bf16_t*)smem;
  const int tid = TID(), lane = tid & 63, wave = tid >> 6;
  const int wm = wave >> 1, wn = wave & 1, l16 = lane & 15, quad = lane >> 4;
  const int crow = tid >> 3, ccol = (tid & 7) * 8;
  uint4 ra[4], rb[BCH];
  const bf16_t* Ap = A + (size_t)crow * lda + ccol;
  const bf16_t* Bp = Bt + (size_t)crow * ldb + ccol;
  const int nk = K >> 6;
#pragma unroll
  for (int i = 0; i < 4; ++i) ra[i] = *(const uint4*)(Ap + (size_t)(32 * i) * lda);
#pragma unroll
  for (int i = 0; i < BCH; ++i) rb[i] = *(const uint4*)(Bp + (size_t)(32 * i) * ldb);
  {
    bf16_t* sa = sm; bf16_t* sb = sa + A_EL;
#pragma unroll
    for (int i = 0; i < 4; ++i) *(uint4*)(sa + (crow + 32 * i) * 72 + ccol) = ra[i];
#pragma unroll
    for (int i = 0; i < BCH; ++i) *(uint4*)(sb + (crow + 32 * i) * 72 + ccol) = rb[i];
  }
  __syncthreads();
  for (int kt = 0; kt < nk; ++kt) {
    const bool more = (kt + 1 < nk);
    if (more) {
      const int k0 = (kt + 1) << 6;
#pragma unroll
      for (int i = 0; i < 4; ++i) ra[i] = *(const uint4*)(Ap + (size_t)(32 * i) * lda + k0);
#pragma unroll
      for (int i = 0; i < BCH; ++i) rb[i] = *(const uint4*)(Bp + (size_t)(32 * i) * ldb + k0);
    }
    {
      const bf16_t* sa = sm + (kt & 1) * BUF_EL; const bf16_t* sb = sa + A_EL;
#pragma unroll
      for (int ks = 0; ks < 2; ++ks) {
        bf16x8 a[4], b[NJ];
#pragma unroll
        for (int i = 0; i < 4; ++i) a[i] = *(const bf16x8*)(sa + (wm * 64 + i * 16 + l16) * 72 + ks * 32 + quad * 8);
#pragma unroll
        for (int j = 0; j < NJ; ++j) b[j] = *(const bf16x8*)(sb + (wn * (BN / 2) + j * 16 + l16) * 72 + ks * 32 + quad * 8);
#pragma unroll
        for (int i = 0; i < 4; ++i)
#pragma unroll
          for (int j = 0; j < NJ; ++j) acc[i][j] = __builtin_amdgcn_mfma_f32_16x16x32_bf16(a[i], b[j], acc[i][j], 0, 0, 0);
      }
    }
    if (more) {
      bf16_t* sa = sm + ((kt + 1) & 1) * BUF_EL; bf16_t* sb = sa + A_EL;
#pragma unroll
      for (int i = 0; i < 4; ++i) *(uint4*)(sa + (crow + 32 * i) * 72 + ccol) = ra[i];
#pragma unroll
      for (int i = 0; i < BCH; ++i) *(uint4*)(sb + (crow + 32 * i) * 72 + ccol) = rb[i];
    }
    __syncthreads();
  }
}
template <int NJ> DI void zero_acc(f32x4 (&acc)[4][NJ]) {
#pragma unroll
  for (int i = 0; i < 4; ++i)
#pragma unroll
    for (int j = 0; j < NJ; ++j) acc[i][j] = f32x4{0.f, 0.f, 0.f, 0.f};
}
#define EPI_FOR(BN_)                                                                         \
  const int _t = TID(); const int _lane = _t & 63, _wave = _t >> 6;                              \
  const int _wm = _wave >> 1, _wn = _wave & 1, _l16 = _lane & 15, _quad = _lane >> 4;        \
  _Pragma("unroll") for (int i = 0; i < 4; ++i)                                              \
  _Pragma("unroll") for (int j = 0; j < (BN_) / 32; ++j)                                     \
  _Pragma("unroll") for (int r = 0; r < 4; ++r)
#define EPI_ROW (_wm * 64 + i * 16 + _quad * 4 + r)
#define EPI_COL(BN_) (_wn * ((BN_) / 2) + j * 16 + _l16)

DI void transpose_tile(const float* __restrict__ W, int ldw, bf16_t* __restrict__ Wt, int ldt, int k0, int n0, char* smem) {
  float* sm = (float*)smem;
  const int tid = TID();
  __syncthreads();
#pragma unroll
  for (int i = 0; i < 4; ++i) {
    const int k = (tid >> 4) + 16 * i, n4 = (tid & 15) * 4;
    const float4 v = *(const float4*)(W + (size_t)(k0 + k) * ldw + n0 + n4);
    sm[k * 65 + n4 + 0] = v.x; sm[k * 65 + n4 + 1] = v.y; sm[k * 65 + n4 + 2] = v.z; sm[k * 65 + n4 + 3] = v.w;
  }
  __syncthreads();
  const int n = tid >> 2, ks = (tid & 3) * 16;
  unsigned u[8];
#pragma unroll
  for (int e = 0; e < 8; ++e) u[e] = pack2(sm[(ks + 2 * e) * 65 + n], sm[(ks + 2 * e + 1) * 65 + n]);
  uint4* dst = (uint4*)(Wt + (size_t)(n0 + n) * ldt + k0 + ks);
  dst[0] = uint4{u[0], u[1], u[2], u[3]};
  dst[1] = uint4{u[4], u[5], u[6], u[7]};
}
DI void transpose_all(const float* W, int ldw, int K, int N, bf16_t* Wt, int bid, int nb, char* smem) {
  const int tk = K >> 6, tn = N >> 6;
  for (int t = bid; t < tk * tn; t += nb) transpose_tile(W, ldw, Wt, K, (t % tk) * 64, (t / tk) * 64, smem);
}

DI void rmsnorm_rows(const float* __restrict__ x, const float* __restrict__ g, bf16_t* __restrict__ h, float* xcopy, int rows,
                     int bid, int nb) {
  const int lane = TID() & 63, wave = TID() >> 6;
  for (int r = bid * 4 + wave; r < rows; r += nb * 4) {
    const float4* xr = (const float4*)(x + (size_t)r * 1024);
    float4 v[4]; float ss = 0.f;
#pragma unroll
    for (int i = 0; i < 4; ++i) { v[i] = xr[lane + 64 * i]; ss += v[i].x * v[i].x + v[i].y * v[i].y + v[i].z * v[i].z + v[i].w * v[i].w; }
    ss = wave_sum(ss);
    const float rs = rsqrtf(ss * (1.f / 1024.f) + 1e-6f);
#pragma unroll
    for (int i = 0; i < 4; ++i) {
      const float4 gg = ((const float4*)g)[lane + 64 * i];
      uint2 o; o.x = pack2(v[i].x * rs * gg.x, v[i].y * rs * gg.y); o.y = pack2(v[i].z * rs * gg.z, v[i].w * rs * gg.w);
      *(uint2*)(h + (size_t)r * 1024 + (lane + 64 * i) * 4) = o;
      if (xcopy) ((float4*)(xcopy + (size_t)r * 1024))[lane + 64 * i] = v[i];
    }
  }
}

template <int DQK, bool CAUSAL>
DI void attn_item(const bf16_t* __restrict__ Q, int ldq, const bf16_t* __restrict__ Kp, int ldk, const bf16_t* __restrict__ VT, int ldvt,
                  int ntiles, int q0, bf16_t* __restrict__ out, int ldo, char* smem) {
  constexpr int KS = DQK + 8, NS = DQK / 16, KCH = DQK / 8;
  bf16_t* Ks = (bf16_t*)smem;
  bf16_t* Vs = Ks + 64 * KS;
  const int tid = TID(), lane = tid & 63, wave = tid >> 6, ql = lane & 31, hh = lane >> 5;
  const int qrow = q0 + wave * 32 + ql;
  bf16x8 bq[NS];
#pragma unroll
  for (int s = 0; s < NS; ++s) bq[s] = *(const bf16x8*)(Q + (size_t)qrow * ldq + s * 16 + hh * 8);
  f32x16 ot[4];
#pragma unroll
  for (int d = 0; d < 4; ++d)
#pragma unroll
    for (int i = 0; i < 16; ++i) ot[d][i] = 0.f;
  float mrun = -INFINITY, lrun = 0.f;
  for (int kt = 0; kt < ntiles; ++kt) {
    __syncthreads();
    for (int c = tid; c < 64 * KCH; c += 256) {
      const int row = c / KCH, cc = c % KCH;
      *(uint4*)(Ks + row * KS + cc * 8) = *(const uint4*)(Kp + (size_t)(kt * 64 + row) * ldk + cc * 8);
    }
#pragma unroll
    for (int c0 = 0; c0 < 4; ++c0) {
      const int c = tid + c0 * 256, row = c >> 3, cc = c & 7;
      *(uint4*)(Vs + row * 72 + cc * 8) = *(const uint4*)(VT + (size_t)row * ldvt + kt * 64 + cc * 8);
    }
    __syncthreads();
    f32x16 st[2];
#pragma unroll
    for (int kb = 0; kb < 2; ++kb) {
#pragma unroll
      for (int i = 0; i < 16; ++i) st[kb][i] = 0.f;
#pragma unroll
      for (int s = 0; s < NS; ++s) {
        const bf16x8 a = *(const bf16x8*)(Ks + (kb * 32 + ql) * KS + s * 16 + hh * 8);
        st[kb] = __builtin_amdgcn_mfma_f32_32x32x16_bf16(a, bq[s], st[kb], 0, 0, 0);
      }
    }
    float mx = -INFINITY;
#pragma unroll
    for (int kb = 0; kb < 2; ++kb)
#pragma unroll
      for (int i = 0; i < 16; ++i) {
        if (CAUSAL) {
          const int key = kt * 64 + kb * 32 + (i & 3) + 8 * (i >> 2) + 4 * hh;
          if (key > qrow) st[kb][i] = -INFINITY;
        }
        mx = fmaxf(mx, st[kb][i]);
      }
    mx = fmaxf(mx, __shfl_xor(mx, 32));
    const float mnew = fmaxf(mrun, mx);
    const float alpha = exp2f(mrun - mnew);
    float ps = 0.f;
#pragma unroll
    for (int kb = 0; kb < 2; ++kb)
#pragma unroll
      for (int i = 0; i < 16; ++i) { const float pv = exp2f(st[kb][i] - mnew); st[kb][i] = pv; ps += pv; }
    ps += __shfl_xor(ps, 32);
    lrun = lrun * alpha + ps;
    mrun = mnew;
#pragma unroll
    for (int d = 0; d < 4; ++d)
#pragma unroll
      for (int i = 0; i < 16; ++i) ot[d][i] *= alpha;
#pragma unroll
    for (int kb = 0; kb < 2; ++kb)
#pragma unroll
      for (int s2 = 0; s2 < 2; ++s2) {
        unsigned pk[4];
#pragma unroll
        for (int e = 0; e < 4; ++e) pk[e] = pack2(st[kb][8 * s2 + 2 * e], st[kb][8 * s2 + 2 * e + 1]);
        const bf16x8 pb = __builtin_bit_cast(bf16x8, uint4{pk[0], pk[1], pk[2], pk[3]});
#pragma unroll
        for (int d = 0; d < 4; ++d) {
          const bf16_t* vp = Vs + (d * 32 + ql) * 72 + kb * 32 + s2 * 16 + hh * 4;
          const s16x4 lo = *(const s16x4*)vp;
          const s16x4 hi = *(const s16x4*)(vp + 8);
          const bf16x8 av = __builtin_shufflevector(lo, hi, 0, 1, 2, 3, 4, 5, 6, 7);
          ot[d] = __builtin_amdgcn_mfma_f32_32x32x16_bf16(av, pb, ot[d], 0, 0, 0);
        }
      }
  }
  const float inv = 1.f / lrun;
#pragma unroll
  for (int d = 0; d < 4; ++d)
#pragma unroll
    for (int g4 = 0; g4 < 4; ++g4) {
      uint2 o; o.x = pack2(ot[d][4 * g4] * inv, ot[d][4 * g4 + 1] * inv); o.y = pack2(ot[d][4 * g4 + 2] * inv, ot[d][4 * g4 + 3] * inv);
      *(uint2*)(out + (size_t)qrow * ldo + d * 32 + 8 * g4 + 4 * hh) = o;
    }
}

DI void rwkv_scan_unit(const Params& p, int l, int u, char* smem) {
  const int tid = TID();
  const int bl = u >> 5, hd = (u >> 2) & 7, rg = u & 3;
  const int kq = tid & 15, g16 = tid >> 4;
  const bf16_t* RKV = (const bf16_t*)(p.ws + R_RKV) + (size_t)bl * SEQ * 1536;
  const bf16_t* Pm = (const bf16_t*)(p.ws + R_P) + (size_t)bl * SEQ * PLD;
  float* Y = (float*)(p.ws + R_YRW) + (size_t)bl * SEQ * 512;
  float* sm = (float*)smem;
  constexpr int BUFF = 5 * 1024 + 256;
  const int kc = hd * 64 + kq * 4;
  const float4 kk_w = *(const float4*)(p.in[27] + l * 512 + kc);
  const float4 ka_w = *(const float4*)(p.in[28] + l * 512 + kc);
  float S0 = 0.f, S1 = 0.f, S2 = 0.f, S3 = 0.f;
  uint2 g_r, g_k, g_w, g_a; bf16_t g_v;
  auto gload = [&](int c) {
    const int tok = c * 16 + g16;
    g_r = *(const uint2*)(RKV + (size_t)tok * 1536 + kc);
    g_k = *(const uint2*)(RKV + (size_t)tok * 1536 + 512 + kc);
    g_v = RKV[(size_t)tok * 1536 + 1024 + hd * 64 + rg * 16 + kq];
    g_w = *(const uint2*)(Pm + (size_t)tok * PLD + PC_RW + kc);
    g_a = *(const uint2*)(Pm + (size_t)tok * PLD + PC_RW + 512 + kc);
  };
  auto derive = [&](int buf) {
    float* b = sm + buf * BUFF;
    const float r[4] = {bflo(g_r.x), bfhi(g_r.x), bflo(g_r.y), bfhi(g_r.y)};
    const float k[4] = {bflo(g_k.x), bfhi(g_k.x), bflo(g_k.y), bfhi(g_k.y)};
    const float w[4] = {bflo(g_w.x), bfhi(g_w.x), bflo(g_w.y), bfhi(g_w.y)};
    const float a[4] = {bflo(g_a.x), bfhi(g_a.x), bflo(g_a.y), bfhi(g_a.y)};
    const float kkw[4] = {kk_w.x, kk_w.y, kk_w.z, kk_w.w};
    const float kaw[4] = {ka_w.x, ka_w.y, ka_w.z, ka_w.w};
    float kk[4], ss = 0.f;
#pragma unroll
    for (int e = 0; e < 4; ++e) { kk[e] = k[e] * kkw[e]; ss += kk[e] * kk[e]; }
    ss = red16(ss);
    const float rn = rsqrtf(ss + 1e-12f);
    float4 oR, oW, oK, oN, oB;
    float dr[4], dw[4], dk[4], dn[4], db[4];
#pragma unroll
    for (int e = 0; e < 4; ++e) {
      const float xm = -w[e];
      const float sp = (xm > 20.f) ? xm : log1pf(expf(xm));
      const float wlog = -sp - 0.5f;
      dw[e] = expf(-expf(wlog));
      const float kn = kk[e] * rn;
      dn[e] = -kn; db[e] = kn * a[e];
      dk[e] = k[e] * (1.f + (a[e] - 1.f) * kaw[e]);
      dr[e] = r[e];
    }
    oR = float4{dr[0], dr[1], dr[2], dr[3]}; oW = float4{dw[0], dw[1], dw[2], dw[3]}; oK = float4{dk[0], dk[1], dk[2], dk[3]};
    oN = float4{dn[0], dn[1], dn[2], dn[3]}; oB = float4{db[0], db[1], db[2], db[3]};
    *(float4*)(b + 0 * 1024 + g16 * 64 + kq * 4) = oR;
    *(float4*)(b + 1 * 1024 + g16 * 64 + kq * 4) = oW;
    *(float4*)(b + 2 * 1024 + g16 * 64 + kq * 4) = oK;
    *(float4*)(b + 3 * 1024 + g16 * 64 + kq * 4) = oN;
    *(float4*)(b + 4 * 1024 + g16 * 64 + kq * 4) = oB;
    b[5 * 1024 + g16 * 16 + kq] = bf2f(g_v);
  };
  __syncthreads();
  gload(0); derive(0);
  __syncthreads();
  constexpr int NC = SEQ / 16;
  for (int c = 0; c < NC; ++c) {
    if (c + 1 < NC) gload(c + 1);
    const float* b = sm + (c & 1) * BUFF;
#pragma unroll 4
    for (int t = 0; t < 16; ++t) {
      const float4 nk = *(const float4*)(b + 3 * 1024 + t * 64 + kq * 4);
      const float4 w = *(const float4*)(b + 1 * 1024 + t * 64 + kq * 4);
      const float4 bb = *(const float4*)(b + 4 * 1024 + t * 64 + kq * 4);
      const float4 kh = *(const float4*)(b + 2 * 1024 + t * 64 + kq * 4);
      const float4 rr = *(const float4*)(b + 0 * 1024 + t * 64 + kq * 4);
      const float v = b[5 * 1024 + t * 16 + g16];
      float sa = S0 * nk.x + S1 * nk.y + S2 * nk.z + S3 * nk.w;
      sa = red16(sa);
      S0 = S0 * w.x + sa * bb.x + v * kh.x;
      S1 = S1 * w.y + sa * bb.y + v * kh.y;
      S2 = S2 * w.z + sa * bb.z + v * kh.z;
      S3 = S3 * w.w + sa * bb.w + v * kh.w;
      float y = S0 * rr.x + S1 * rr.y + S2 * rr.z + S3 * rr.w;
      y = red16(y);
      if (kq == 0) Y[(size_t)(c * 16 + t) * 512 + hd * 64 + rg * 16 + g16] = y;
    }
    if (c + 1 < NC) derive((c + 1) & 1);
    __syncthreads();
  }
}

DI void hgrn_scan_unit(const Params& p, int l, int u, char* smem) {
  const int tid = TID();
  const int bl = u >> 5, hd = (u >> 3) & 3, vg = u & 7;
  const int kq = tid & 15, g16 = tid >> 4;
  bf16_t* Pm = (bf16_t*)(p.ws + R_P) + (size_t)bl * SEQ * PLD;
  float* sm = (float*)smem;
  constexpr int BUFF = 2 * 2048 + 256;
  const int kc = hd * 128 + kq * 8;
  float lb[8];
#pragma unroll
  for (int e = 0; e < 8; ++e) {
    if (l == 0) lb[e] = 0.f;
    else { const float x0 = p.in[9][kc + e], x1 = p.in[9][512 + kc + e]; lb[e] = 1.f / (1.f + expf(x0 - x1)); }
  }
  float S[8];
#pragma unroll
  for (int e = 0; e < 8; ++e) S[e] = 0.f;
  uint4 g_q, g_f; bf16_t g_v;
  const int vcol = PC_HG + 1024 + hd * 128 + vg * 16;
  auto gload = [&](int c) {
    const int tok = c * 16 + g16;
    g_q = *(const uint4*)(Pm + (size_t)tok * PLD + PC_HG + kc);
    g_f = *(const uint4*)(Pm + (size_t)tok * PLD + PC_HG + 512 + kc);
    g_v = Pm[(size_t)tok * PLD + vcol + kq];
  };
  auto derive = [&](int buf) {
    float* b = sm + buf * BUFF;
    const unsigned qu[4] = {g_q.x, g_q.y, g_q.z, g_q.w}, fu[4] = {g_f.x, g_f.y, g_f.z, g_f.w};
    float q[8], f[8];
#pragma unroll
    for (int e = 0; e < 4; ++e) {
      q[2 * e] = bflo(qu[e]); q[2 * e + 1] = bfhi(qu[e]);
      const float f0 = bflo(fu[e]), f1 = bfhi(fu[e]);
      f[2 * e] = lb[2 * e] + (1.f - lb[2 * e]) * (1.f / (1.f + expf(-f0)));
      f[2 * e + 1] = lb[2 * e + 1] + (1.f - lb[2 * e + 1]) * (1.f / (1.f + expf(-f1)));
    }
    *(float4*)(b + g16 * 128 + kq * 8) = float4{q[0], q[1], q[2], q[3]};
    *(float4*)(b + g16 * 128 + kq * 8 + 4) = float4{q[4], q[5], q[6], q[7]};
    *(float4*)(b + 2048 + g16 * 128 + kq * 8) = float4{f[0], f[1], f[2], f[3]};
    *(float4*)(b + 2048 + g16 * 128 + kq * 8 + 4) = float4{f[4], f[5], f[6], f[7]};
    b[4096 + g16 * 16 + kq] = bf2f(g_v);
  };
  __syncthreads();
  gload(0); derive(0);
  __syncthreads();
  constexpr int NC = SEQ / 16;
  for (int c = 0; c < NC; ++c) {
    if (c + 1 < NC) gload(c + 1);
    const float* b = sm + (c & 1) * BUFF;
#pragma unroll 4
    for (int t = 0; t < 16; ++t) {
      const float4 q0 = *(const float4*)(b + t * 128 + kq * 8), q1 = *(const float4*)(b + t * 128 + kq * 8 + 4);
      const float4 f0 = *(const float4*)(b + 2048 + t * 128 + kq * 8), f1 = *(const float4*)(b + 2048 + t * 128 + kq * 8 + 4);
      const float v = b[4096 + t * 16 + g16];
      const float q[8] = {q0.x, q0.y, q0.z, q0.w, q1.x, q1.y, q1.z, q1.w};
      const float f[8] = {f0.x, f0.y, f0.z, f0.w, f1.x, f1.y, f1.z, f1.w};
      float o = 0.f;
#pragma unroll
      for (int e = 0; e < 8; ++e) { S[e] = f[e] * S[e] + (1.f - f[e]) * v; o += S[e] * q[e]; }
      o = red16(o);
      if (kq == 0) Pm[(size_t)(c * 16 + t) * PLD + vcol + g16] = f2bf(o);
    }
    if (c + 1 < NC) derive((c + 1) & 1);
    __syncthreads();
  }
}

DI void s5_scan_unit(const Params& p, int l, int u, char* smem) {
  const int tid = TID(), lane = tid & 63, wave = tid >> 6;
  const int idx = u * 4 + wave, bl = idx >> 5, g = idx & 31;
  const bf16_t* Pm = (const bf16_t*)(p.ws + R_P) + (size_t)bl * SEQ * PLD + PC_S5 + g * 16;
  bf16_t* Z = (bf16_t*)(p.ws + R_ZS5) + (size_t)bl * SEQ * 512 + g * 16;
  float* su = (float*)smem + wave * 256;
  bf16_t* hist = (bf16_t*)(smem + 4096) + wave * (16 * 136);
  const float2 ab = *(const float2*)((const float*)(p.ws + OFF_S5AB) + (g * 64 + lane) * 2);
  float bre[16], bim[16];
  {
    const float* bbp = (const float*)(p.ws + OFF_S5BB) + (size_t)(g * 64 + lane) * 32;
#pragma unroll
    for (int c = 0; c < 16; ++c) { bre[c] = bbp[c]; bim[c] = bbp[16 + c]; }
  }
  const int l16 = lane & 15, quad = lane >> 4;
  bf16x8 cf[4];
  {
    const float* Cre = p.in[16] + (size_t)l * 32768 + (size_t)(g * 16 + l16) * 64;
    const float* Cim = p.in[17] + (size_t)l * 32768 + (size_t)(g * 16 + l16) * 64;
#pragma unroll
    for (int ks = 0; ks < 4; ++ks) {
      unsigned pk[4];
#pragma unroll
      for (int e = 0; e < 4; ++e) {
        const int k = ks * 32 + quad * 8 + 2 * e;
        const float v0 = (k < 64) ? Cre[k] : -Cim[k - 64];
        const float v1 = (k < 64) ? Cre[k + 1] : -Cim[k + 1 - 64];
        pk[e] = pack2(v0, v1);
      }
      cf[ks] = __builtin_bit_cast(bf16x8, uint4{pk[0], pk[1], pk[2], pk[3]});
    }
  }
  const float dcoef = p.in[18][l * 512 + g * 16 + l16];
  float xr = 0.f, xi = 0.f;
  uint2 gu;
  auto gload = [&](int c) { gu = *(const uint2*)(Pm + (size_t)(c * 16 + (lane >> 2)) * PLD + (lane & 3) * 4); };
  __syncthreads();
  gload(0);
  constexpr int NC = SEQ / 16;
  for (int c = 0; c < NC; ++c) {
    *(float4*)(su + (lane >> 2) * 16 + (lane & 3) * 4) = float4{bflo(gu.x), bfhi(gu.x), bflo(gu.y), bfhi(gu.y)};
    __syncthreads();
    if (c + 1 < NC) gload(c + 1);
#pragma unroll 2
    for (int t = 0; t < 16; ++t) {
      float ur = 0.f, ui = 0.f;
#pragma unroll
      for (int q4 = 0; q4 < 4; ++q4) {
        const float4 uu = *(const float4*)(su + t * 16 + q4 * 4);
        ur += uu.x * bre[q4 * 4] + uu.y * bre[q4 * 4 + 1] + uu.z * bre[q4 * 4 + 2] + uu.w * bre[q4 * 4 + 3];
        ui += uu.x * bim[q4 * 4] + uu.y * bim[q4 * 4 + 1] + uu.z * bim[q4 * 4 + 2] + uu.w * bim[q4 * 4 + 3];
      }
      const float nr = ab.x * xr - ab.y * xi + ur;
      const float ni = ab.x * xi + ab.y * xr + ui;
      xr = nr; xi = ni;
      hist[t * 136 + lane] = f2bf(xr);
      hist[t * 136 + 64 + lane] = f2bf(xi);
    }
    __syncthreads();
    f32x4 acc = {0.f, 0.f, 0.f, 0.f};
#pragma unroll
    for (int ks = 0; ks < 4; ++ks) {
      const bf16x8 a = *(const bf16x8*)(hist + l16 * 136 + ks * 32 + quad * 8);
      acc = __builtin_amdgcn_mfma_f32_16x16x32_bf16(a, cf[ks], acc, 0, 0, 0);
    }
#pragma unroll
    for (int r = 0; r < 4; ++r) {
      const int t = quad * 4 + r;
      const float y = acc[r] + dcoef * su[t * 16 + l16];
      const float z = 0.5f * y * (1.f + tanhf(0.7978845608028654f * (y + 0.044715f * y * y * y)));
      Z[(size_t)(c * 16 + t) * 512 + l16] = f2bf(z);
    }
    __syncthreads();
  }
}

#define GSYNC() xcd_barrier(xb)
__global__ void __launch_bounds__(256, 2) mega_kernel(Params p) {
  cg::grid_group grid = cg::this_grid();
  __shared__ __attribute__((aligned(16))) char smem[SMEM_BYTES];
  __shared__ uint4 xb_words;
  const int bid = blockIdx.x, nb = gridDim.x;
  if (p.ws == nullptr) grid.sync();
  if (threadIdx.x == 0) xb_words = make_uint4(0u, 0u, 0u, 0u);
  __syncthreads();
  const XcdBarrier xb = xcd_barrier_post((unsigned*)(p.ws + OFF_BAR), (volatile LAS unsigned*)&xb_words);
  char* ws = p.ws;
  float* X = p.out;
  bf16_t* Wt_in = (bf16_t*)(ws + OFF_WIN);
  bf16_t* Wt_q = (bf16_t*)(ws + OFF_WQ);
  bf16_t* Wt_br = (bf16_t*)(ws + OFF_WBR);
  bf16_t* Wt_out = (bf16_t*)(ws + OFF_WOUT);
  bf16_t* Wt_glu = (bf16_t*)(ws + OFF_WGLU);
  bf16_t* Wt_wup = (bf16_t*)(ws + OFF_WWUP);
  bf16_t* Wt_aup = (bf16_t*)(ws + OFF_WAUP);
  bf16_t* Wt_gup = (bf16_t*)(ws + OFF_WGUP);
  bf16_t* Wt_v = (bf16_t*)(ws + OFF_WV);
  bf16_t* Wt_xkv = (bf16_t*)(ws + OFF_WXKV);
  bf16_t* Hb = (bf16_t*)(ws + OFF_H);
  bf16_t* Vfirst = (bf16_t*)(ws + OFF_VFIRST);
  bf16_t* Kx = (bf16_t*)(ws + OFF_KX);
  bf16_t* VxT = (bf16_t*)(ws + OFF_VXT);
  bf16_t* Hm = (bf16_t*)(ws + OFF_HM);
  float* CosT = (float*)(ws + OFF_COS);
  float* SinT = (float*)(ws + OFF_SIN);
  bf16_t* Pm = (bf16_t*)(ws + R_P);
  bf16_t* Cqn = (bf16_t*)(ws + R_CQN);
  bf16_t* Qp = (bf16_t*)(ws + R_QP);
  bf16_t* KVlat = (bf16_t*)(ws + R_KVLAT);
  bf16_t* VTm = (bf16_t*)(ws + R_VT);
  bf16_t* RKV = (bf16_t*)(ws + R_RKV);
  bf16_t* Alora = (bf16_t*)(ws + R_ALORA);
  float* Yrw = (float*)(ws + R_YRW);
  bf16_t* Zs5 = (bf16_t*)(ws + R_ZS5);
  bf16_t* Ybr = (bf16_t*)(ws + R_YBR);
  bf16_t* Wt_xq = (bf16_t*)(ws + R_WXQ);
  bf16_t* Wt_xo = (bf16_t*)(ws + R_WXO);
  bf16_t* Wt_gu = (bf16_t*)(ws + R_WGU);
  bf16_t* Wt_down = (bf16_t*)(ws + R_WDOWN);
  bf16_t* Qx = (bf16_t*)(ws + R_QX);
  bf16_t* Ox = (bf16_t*)(ws + R_OX);
  bf16_t* GU = (bf16_t*)(ws + R_GU);
  const float LOG2E = 1.4426950408889634f;

  for (int l = 0; l < 2; ++l) {
    {
      PHASE_IDS
      const float* w_in = p.in[4] + (size_t)l * 1024 * P_IN;
      transpose_all(w_in, P_IN, 1024, P_IN, Wt_in, bid, nb, smem);
      transpose_all(p.in[36] + (size_t)l * 512 * 1024, 1024, 512, 1024, Wt_br + (size_t)1 * 1024 * 512, bid, nb, smem);
      transpose_all(p.in[37] + (size_t)l * 512 * 1024, 1024, 512, 1024, Wt_br + (size_t)2 * 1024 * 512, bid, nb, smem);
      transpose_all(p.in[38] + (size_t)l * 512 * 1024, 1024, 512, 1024, Wt_br + (size_t)3 * 1024 * 512, bid, nb, smem);
      transpose_all(p.in[39] + (size_t)l * 1024 * 1024, 1024, 1024, 1024, Wt_out, bid, nb, smem);
      transpose_all(p.in[19] + (size_t)l * 512 * 512, 512, 512, 512, Wt_glu, bid, nb, smem);
      transpose_all(p.in[23] + (size_t)l * 64 * 512, 512, 64, 512, Wt_wup, bid, nb, smem);
      transpose_all(p.in[25] + (size_t)l * 64 * 512, 512, 64, 512, Wt_aup, bid, nb, smem);
      transpose_all(p.in[26] + (size_t)l * 128 * 512, 512, 128, 512, Wt_gup, bid, nb, smem);
      transpose_all(p.in[43] + (size_t)l * 1024 * 2048, 2048, 1024, 2048, Wt_xkv, bid, nb, smem);
      const int gtid = bid * 256 + tid, gsz = nb * 256;
      {
        const float* w_uq = p.in[6] + (size_t)l * 256 * 768;
        const float* w_ukv = p.in[8] + (size_t)l * 128 * 1024;
        for (int e = gtid; e < 768 * 256; e += gsz) {
          const int n = e >> 8, kq = e & 255, hh = n / 192, j = n % 192;
          float v;
          if (j >= 128) v = w_uq[kq * 768 + n];
          else {
            v = 0.f;
            const float* a = w_uq + kq * 768 + hh * 192;
            const float* b = w_ukv + j * 1024 + hh * 256;
            for (int d = 0; d < 128; ++d) v += a[d] * b[d];
          }
          Wt_q[e] = f2bf(v);
        }
        const float* w_bm = p.in[35] + (size_t)l * 512 * 1024;
        for (int e = gtid; e < 1024 * 512; e += gsz) {
          const int n = e & 1023, kk = e >> 10, hh = kk >> 7, j = kk & 127;
          const float* a = w_ukv + j * 1024 + hh * 256 + 128;
          float v = 0.f;
          for (int d = 0; d < 128; ++d) v += a[d] * w_bm[(size_t)(hh * 128 + d) * 1024 + n];
          Wt_br[(size_t)n * 512 + kk] = f2bf(v);
        }
        if (l == 1) {
          const float* vd = p.in[32];
          const float* vu = p.in[33];
          for (int e = gtid; e < 512 * 1024; e += gsz) {
            const int n = e & 511, kk = e >> 9;
            float v = 0.f;
            for (int r = 0; r < 32; ++r) v += vd[kk * 32 + r] * vu[r * 512 + n];
            Wt_v[(size_t)n * 1024 + kk] = f2bf(v);
          }
        }
      }
      {
        float* abp = (float*)(ws + OFF_S5AB);
        float* bbp = (float*)(ws + OFF_S5BB);
        for (int e = gtid; e < 2048; e += gsz) {
          const int g = e >> 6;
          const float are = fminf(p.in[11][l * 2048 + e], -1e-4f), aim = p.in[12][l * 2048 + e];
          const float dt = expf(p.in[13][l * 32 + g]);
          const float mag = expf(dt * are);
          const float abre = mag * cosf(dt * aim), abim = mag * sinf(dt * aim);
          const float den = are * are + aim * aim;
          const float zre = ((abre - 1.f) * are + abim * aim) / den;
          const float zim = (abim * are - (abre - 1.f) * aim) / den;
          abp[e * 2] = abre; abp[e * 2 + 1] = abim;
          const float* Br = p.in[14] + (size_t)l * 32768 + (size_t)e * 16;
          const float* Bi = p.in[15] + (size_t)l * 32768 + (size_t)e * 16;
          for (int c = 0; c < 16; ++c) {
            bbp[e * 32 + c] = zre * Br[c] - zim * Bi[c];
            bbp[e * 32 + 16 + c] = zre * Bi[c] + zim * Br[c];
          }
        }
      }
      if (l == 0) rmsnorm_rows(p.in[0], p.in[3], Hb, X, T_ALL, bid, nb);
      else rmsnorm_rows(X, p.in[3] + 1024, Hb, nullptr, T_ALL, bid, nb);
      rmsnorm_rows(p.in[1], p.in[41] + l * 1024, Hm, nullptr, 1024, bid, nb);
    }
    GSYNC();

    for (int half = 0; half < 2; ++half) {
      const bf16_t* Hh = Hb + (size_t)half * TH * 1024;
      {
        const int n1 = 64 * 38;
        const int n2 = (half == 0) ? 8 * 16 : 0;
        for (int u = bid; u < n1 + n2; u += nb) {
          f32x4 acc[4][4];
          zero_acc<4>(acc);
          if (u < n1) {
            const int tn = u % 38, tm = u / 38;
            gemm_acc<128>(Hh + (size_t)tm * 128 * 1024, 1024, Wt_in + (size_t)tn * 128 * 1024, 1024, 1024, smem, acc);
            EPI_FOR(128) {
              const int row = tm * 128 + EPI_ROW, n = tn * 128 + EPI_COL(128);
              if (n < GATE_OFF) {
                const int pc = (n < 448) ? n : n + 64;
                Pm[(size_t)row * PLD + pc] = f2bf(acc[i][j][r]);
              }
            }
          } else {
            const int v = u - n1, tn = v % 16, tm = v / 16;
            gemm_acc<128>(Hm + (size_t)tm * 128 * 1024, 1024, Wt_xkv + (size_t)tn * 128 * 1024, 1024, 1024, smem, acc);
            EPI_FOR(128) {
              const int row = tm * 128 + EPI_ROW, n = tn * 128 + EPI_COL(128);
              const int b = row >> 8, m = row & 255, sel = n >> 10, hh = (n >> 8) & 3, d = n & 255;
              if (sel == 0) Kx[((size_t)(b * 4 + hh) * 256 + m) * 256 + d] = f2bf(acc[i][j][r]);
              else VxT[((size_t)(b * 4 + hh) * 256 + d) * 256 + m] = f2bf(acc[i][j][r]);
            }
          }
        }
      }
      GSYNC();
      {
      PHASE_IDS
        const float* qn = p.in[5] + l * 256;
        const float* kvn = p.in[7] + l * 128;
        const float* mu = p.in[21] + l * 1792;
        for (int tk = bid * 4 + wave; tk < TH; tk += nb * 4) {
          const int gtok = half * TH + tk, s = gtok & (SEQ - 1), bl = tk >> 12;
          const bf16_t* prow = Pm + (size_t)tk * PLD;
          {
            const uint2 cu = *(const uint2*)(prow + lane * 4);
            float f[4] = {bflo(cu.x), bfhi(cu.x), bflo(cu.y), bfhi(cu.y)};
            float ss = wave_sum(f[0] * f[0] + f[1] * f[1] + f[2] * f[2] + f[3] * f[3]);
            const float rs = rsqrtf(ss * (1.f / 256.f) + 1e-6f);
            const float4 g4 = *(const float4*)(qn + lane * 4);
            uint2 o; o.x = pack2(f[0] * rs * g4.x, f[1] * rs * g4.y); o.y = pack2(f[2] * rs * g4.z, f[3] * rs * g4.w);
            *(uint2*)(Cqn + (size_t)tk * 256 + lane * 4) = o;
          }
          {
            const unsigned cu = *(const unsigned*)(prow + 256 + lane * 2);
            const float f0 = bflo(cu), f1 = bfhi(cu);
            const float ss = wave_sum(f0 * f0 + f1 * f1);
            const float rs = rsqrtf(ss * (1.f / 128.f) + 1e-6f);
            const float v0 = f0 * rs * kvn[lane * 2], v1 = f1 * rs * kvn[lane * 2 + 1];
            const bf16_t b0 = f2bf(v0), b1 = f2bf(v1);
            *(unsigned*)(KVlat + (size_t)tk * 192 + lane * 2) = (unsigned)b0 | ((unsigned)b1 << 16);
            VTm[((size_t)bl * 128 + lane * 2) * SEQ + s] = b0;
            VTm[((size_t)bl * 128 + lane * 2 + 1) * SEQ + s] = b1;
          }
          if (lane < 32) {
            const float t1 = bf2f(prow[384 + lane]), t2 = bf2f(prow[384 + 32 + lane]);
            const float posf = (float)p.pos[gtok];
            const float invf = exp2f(-(float)lane * (13.287712379549449f / 32.f));
            const float ang = posf * invf;
            const float cs = cosf(ang), sn = sinf(ang);
            KVlat[(size_t)tk * 192 + 128 + lane] = f2bf(t1 * cs - t2 * sn);
            KVlat[(size_t)tk * 192 + 160 + lane] = f2bf(t1 * sn + t2 * cs);
            CosT[tk * 32 + lane] = cs; SinT[tk * 32 + lane] = sn;
          }
#pragma unroll
          for (int jj = 0; jj < 7; ++jj) {
            const int col = (jj * 64 + lane) * 4;
            const uint2 cu = *(const uint2*)(prow + PC_RW + col);
            uint2 pu = uint2{0u, 0u};
            if (s > 0) pu = *(const uint2*)(prow - PLD + PC_RW + col);
            const float4 m4 = *(const float4*)(mu + col);
            const float cv[4] = {bflo(cu.x), bfhi(cu.x), bflo(cu.y), bfhi(cu.y)};
            const float pv[4] = {bflo(pu.x), bfhi(pu.x), bflo(pu.y), bfhi(pu.y)};
            const float mm[4] = {m4.x, m4.y, m4.z, m4.w};
            float o[4];
#pragma unroll
            for (int e = 0; e < 4; ++e) o[e] = cv[e] + (pv[e] - cv[e]) * mm[e];
            if (col < 1536) {
              uint2 ov; ov.x = pack2(o[0], o[1]); ov.y = pack2(o[2], o[3]);
              *(uint2*)(RKV + (size_t)tk * 1536 + col) = ov;
              if (l == 0 && col >= 1024) *(uint2*)(Vfirst + (size_t)gtok * 512 + (col - 1024)) = ov;
            } else {
              int dc;
              if (col < 1600) { dc = col - 1536; for (int e = 0; e < 4; ++e) o[e] = tanhf(o[e]); }
              else if (col < 1664) { dc = 64 + col - 1600; }
              else { dc = 128 + col - 1664; for (int e = 0; e < 4; ++e) o[e] = sigm(o[e]); }
              uint2 ov; ov.x = pack2(o[0], o[1]); ov.y = pack2(o[2], o[3]);
              *(uint2*)(Alora + (size_t)tk * 256 + dc) = ov;
            }
          }
        }
      }
      GSYNC();
      {
      PHASE_IDS
        const int nq = 64 * 6, nl = 64 * 4;
        const int total = nq + 3 * nl + (l == 1 ? nl : 0);
        for (int u = bid; u < total; u += nb) {
          f32x4 acc[4][4];
          zero_acc<4>(acc);
          if (u < nq) {
            const int tn = u % 6, tm = u / 6;
            gemm_acc<128>(Cqn + (size_t)tm * 128 * 256, 256, Wt_q + (size_t)tn * 128 * 256, 256, 256, smem, acc);
            const float qs = 0.07216878364870322f * LOG2E;
            const int lane_ = tid & 63, wave_ = tid >> 6, wm_ = wave_ >> 1, wn_ = wave_ & 1, l16_ = lane_ & 15, quad_ = lane_ >> 4;
            const int gc = tn * 128 + wn_ * 64;
            const bool is_rope = (gc % 192) == 128;
#pragma unroll
            for (int i = 0; i < 4; ++i)
#pragma unroll
              for (int r = 0; r < 4; ++r) {
                const int row = tm * 128 + wm_ * 64 + i * 16 + quad_ * 4 + r;
                float v[4] = {acc[i][0][r], acc[i][1][r], acc[i][2][r], acc[i][3][r]};
                if (is_rope) {
#pragma unroll
                  for (int j = 0; j < 2; ++j) {
                    const int fi = j * 16 + l16_;
                    const float cs = CosT[row * 32 + fi], sn = SinT[row * 32 + fi];
                    const float t1 = v[j], t2 = v[j + 2];
                    v[j] = t1 * cs - t2 * sn; v[j + 2] = t1 * sn + t2 * cs;
                  }
                }
#pragma unroll
                for (int j = 0; j < 4; ++j) Qp[(size_t)row * 768 + gc + j * 16 + l16_] = f2bf(v[j] * qs);
              }
          } else if (u < nq + 3 * nl) {
            const int v = u - nq, which = v / nl, w2 = v % nl, tn = w2 % 4, tm = w2 / 4;
            if (which == 0) {
              gemm_acc<128>(Alora + (size_t)tm * 128 * 256, 256, Wt_wup + (size_t)tn * 128 * 64, 64, 64, smem, acc);
              const float* w0 = p.in[22] + l * 512;
              EPI_FOR(128) {
                const int row = tm * 128 + EPI_ROW, n = tn * 128 + EPI_COL(128);
                Pm[(size_t)row * PLD + PC_RW + n] = f2bf(w0[n] + acc[i][j][r]);
              }
            } else if (which == 1) {
              gemm_acc<128>(Alora + (size_t)tm * 128 * 256 + 64, 256, Wt_aup + (size_t)tn * 128 * 64, 64, 64, smem, acc);
              const float* a0 = p.in[24] + l * 512;
              EPI_FOR(128) {
                const int row = tm * 128 + EPI_ROW, n = tn * 128 + EPI_COL(128);
                Pm[(size_t)row * PLD + PC_RW + 512 + n] = f2bf(sigm(a0[n] + acc[i][j][r]));
              }
            } else {
              gemm_acc<128>(Alora + (size_t)tm * 128 * 256 + 128, 256, Wt_gup + (size_t)tn * 128 * 128, 128, 128, smem, acc);
              EPI_FOR(128) {
                const int row = tm * 128 + EPI_ROW, n = tn * 128 + EPI_COL(128);
                Pm[(size_t)row * PLD + PC_RW + 1024 + n] = f2bf(acc[i][j][r]);
              }
            }
          } else {
            const int w2 = u - nq - 3 * nl, tn = w2 % 4, tm = w2 / 4;
            gemm_acc<128>(Hh + (size_t)tm * 128 * 1024, 1024, Wt_v + (size_t)tn * 128 * 1024, 1024, 1024, smem, acc);
            const float* vb = p.in[34];
            EPI_FOR(128) {
              const int row = tm * 128 + EPI_ROW, n = tn * 128 + EPI_COL(128);
              const float gate = sigm(vb[n] + acc[i][j][r]);
              const float vc = bf2f(RKV[(size_t)row * 1536 + 1024 + n]);
              const float vf = bf2f(Vfirst[((size_t)half * TH + row) * 512 + n]);
              RKV[(size_t)row * 1536 + 1024 + n] = f2bf(vc + (vf - vc) * gate);
            }
          }
        }
      }
      GSYNC();
      {
        for (int u = bid; u < 64 + 64 + 16 + 256; u += nb) {
          if (u < 64) rwkv_scan_unit(p, l, u, smem);
          else if (u < 128) hgrn_scan_unit(p, l, u - 64, smem);
          else if (u < 144) s5_scan_unit(p, l, u - 128, smem);
          else {
            const int it = u - 144, qt = 31 - (it >> 3), bl = (it >> 2) & 1, hh = it & 3;
            attn_item<192, true>(Qp + (size_t)bl * SEQ * 768 + hh * 192, 768, KVlat + (size_t)bl * SEQ * 192, 192,
                                 VTm + (size_t)bl * 128 * SEQ, SEQ, (qt * 128 + 128) / 64, qt * 128,
                                 Pm + (size_t)bl * SEQ * PLD + hh * 128, PLD, smem);
          }
        }
      }
      GSYNC();
      {
      PHASE_IDS
        const int nglu = 64 * 4;
        for (int u = bid; u < nglu; u += nb) {
          const int tn = u % 4, tm = u / 4;
          f32x4 acc[4][4];
          zero_acc<4>(acc);
          gemm_acc<128>(Zs5 + (size_t)tm * 128 * 512, 512, Wt_glu + (size_t)tn * 128 * 512, 512, 512, smem, acc);
          const float* bg = p.in[20] + l * 512;
          EPI_FOR(128) {
            const int row = tm * 128 + EPI_ROW, n = tn * 128 + EPI_COL(128);
            const float z = bf2f(Zs5[(size_t)row * 512 + n]);
            Pm[(size_t)row * PLD + PC_S5 + n] = f2bf(z * sigm(acc[i][j][r] + bg[n]));
          }
        }
        const float* k_a = p.in[28] + l * 512;
        const float* r_k = p.in[29] + l * 512;
        const float* ln_w = p.in[30] + l * 512;
        const float* ln_b = p.in[31] + l * 512;
        const float* o_norm = p.in[10] + l * 512;
        for (int tk = bid * 4 + wave; tk < TH; tk += nb * 4) {
          const int c0 = lane * 8;
          {
            const float4 y0 = *(const float4*)(Yrw + (size_t)tk * 512 + c0), y1 = *(const float4*)(Yrw + (size_t)tk * 512 + c0 + 4);
            const float y[8] = {y0.x, y0.y, y0.z, y0.w, y1.x, y1.y, y1.z, y1.w};
            const uint4 ru = *(const uint4*)(RKV + (size_t)tk * 1536 + c0);
            const uint4 ku = *(const uint4*)(RKV + (size_t)tk * 1536 + 512 + c0);
            const uint4 vu = *(const uint4*)(RKV + (size_t)tk * 1536 + 1024 + c0);
            const uint4 au = *(const uint4*)(Pm + (size_t)tk * PLD + PC_RW + 512 + c0);
            const uint4 gu = *(const uint4*)(Pm + (size_t)tk * PLD + PC_RW + 1024 + c0);
            const unsigned ra[4] = {ru.x, ru.y, ru.z, ru.w}, ka[4] = {ku.x, ku.y, ku.z, ku.w}, va[4] = {vu.x, vu.y, vu.z, vu.w};
            const unsigned aa[4] = {au.x, au.y, au.z, au.w}, ga[4] = {gu.x, gu.y, gu.z, gu.w};
            float rr[8], kh[8], vv[8], gg[8];
            float sm1 = 0.f, bsum = 0.f;
#pragma unroll
            for (int e = 0; e < 8; ++e) {
              const unsigned sh = (e & 1);
              rr[e] = sh ? bfhi(ra[e >> 1]) : bflo(ra[e >> 1]);
              const float kx = sh ? bfhi(ka[e >> 1]) : bflo(ka[e >> 1]);
              vv[e] = sh ? bfhi(va[e >> 1]) : bflo(va[e >> 1]);
              const float a = sh ? bfhi(aa[e >> 1]) : bflo(aa[e >> 1]);
              gg[e] = sh ? bfhi(ga[e >> 1]) : bflo(ga[e >> 1]);
              kh[e] = kx * (1.f + (a - 1.f) * k_a[c0 + e]);
              sm1 += y[e];
              bsum += rr[e] * kh[e] * r_k[c0 + e];
            }
            sm1 = red8(sm1); bsum = red8(bsum);
            const float mean = sm1 * (1.f / 64.f);
            float vs = 0.f;
#pragma unroll
            for (int e = 0; e < 8; ++e) { const float d = y[e] - mean; vs += d * d; }
            vs = red8(vs);
            const float rstd = rsqrtf(vs * (1.f / 64.f) + 64e-5f);
            float o[8];
#pragma unroll
            for (int e = 0; e < 8; ++e) o[e] = (((y[e] - mean) * rstd) * ln_w[c0 + e] + ln_b[c0 + e] + bsum * vv[e]) * gg[e];
            uint4 ov; ov.x = pack2(o[0], o[1]); ov.y = pack2(o[2], o[3]); ov.z = pack2(o[4], o[5]); ov.w = pack2(o[6], o[7]);
            *(uint4*)(RKV + (size_t)tk * 1536 + c0) = ov;
          }
          {
            bf16_t* op = Pm + (size_t)tk * PLD + PC_HG + 1024 + c0;
            const uint4 ou = *(const uint4*)op;
            const uint4 gu = *(const uint4*)(Pm + (size_t)tk * PLD + PC_HG + 1536 + c0);
            const unsigned oa[4] = {ou.x, ou.y, ou.z, ou.w}, ga[4] = {gu.x, gu.y, gu.z, gu.w};
            float o[8], ss = 0.f;
#pragma unroll
            for (int e = 0; e < 4; ++e) { o[2 * e] = bflo(oa[e]); o[2 * e + 1] = bfhi(oa[e]); }
#pragma unroll
            for (int e = 0; e < 8; ++e) ss += o[e] * o[e];
            ss = red16(ss);
            const float rs = rsqrtf(ss * (1.f / 128.f) + 1e-6f);
            float r8[8];
#pragma unroll
            for (int e = 0; e < 8; ++e) {
              const float gte = (e & 1) ? bfhi(ga[e >> 1]) : bflo(ga[e >> 1]);
              r8[e] = o[e] * rs * o_norm[c0 + e] * sigm(gte);
            }
            uint4 ov; ov.x = pack2(r8[0], r8[1]); ov.y = pack2(r8[2], r8[3]); ov.z = pack2(r8[4], r8[5]); ov.w = pack2(r8[6], r8[7]);
            *(uint4*)op = ov;
          }
        }
      }
      GSYNC();
      {
        for (int u = bid; u < 64 * 16; u += nb) {
          const int tn = u % 16, tm = u / 16;
          f32x4 yacc[4][2];
          zero_acc<2>(yacc);
#pragma unroll 1
          for (int m = 0; m < 4; ++m) {
            f32x4 ag[4][2];
            zero_acc<2>(ag);
            gemm_acc<64>(Hh + (size_t)tm * 128 * 1024, 1024, Wt_in + (size_t)(GATE_OFF + m * 1024 + tn * 64) * 1024, 1024, 1024, smem, ag);
#pragma unroll
            for (int i = 0; i < 4; ++i)
#pragma unroll
              for (int j = 0; j < 2; ++j)
#pragma unroll
                for (int r = 0; r < 4; ++r) ag[i][j][r] = sigm(ag[i][j][r]);
            f32x4 ao[4][2];
            zero_acc<2>(ao);
            const bf16_t* Ao; int lda;
            if (m == 0) { Ao = Pm; lda = PLD; }
            else if (m == 1) { Ao = Pm + PC_HG + 1024; lda = PLD; }
            else if (m == 2) { Ao = Pm + PC_S5; lda = PLD; }
            else { Ao = RKV; lda = 1536; }
            gemm_acc<64>(Ao + (size_t)tm * 128 * lda, lda, Wt_br + ((size_t)m * 1024 + tn * 64) * 512, 512, 512, smem, ao);
#pragma unroll
            for (int i = 0; i < 4; ++i)
#pragma unroll
              for (int j = 0; j < 2; ++j)
#pragma unroll
                for (int r = 0; r < 4; ++r) yacc[i][j][r] += ag[i][j][r] * ao[i][j][r];
          }
          {
            f32x4 (&acc)[4][2] = yacc;
            EPI_FOR(64) {
              const int row = tm * 128 + EPI_ROW, n = tn * 64 + EPI_COL(64);
              Ybr[(size_t)row * 1024 + n] = f2bf(acc[i][j][r]);
            }
          }
        }
      }
      GSYNC();
      {
        for (int u = bid; u < 64 * 8; u += nb) {
          const int tn = u % 8, tm = u / 8;
          f32x4 acc[4][4];
          zero_acc<4>(acc);
          gemm_acc<128>(Ybr + (size_t)tm * 128 * 1024, 1024, Wt_out + (size_t)tn * 128 * 1024, 1024, 1024, smem, acc);
          EPI_FOR(128) {
            const int row = half * TH + tm * 128 + EPI_ROW, n = tn * 128 + EPI_COL(128);
            X[(size_t)row * 1024 + n] += acc[i][j][r];
          }
        }
      }
      GSYNC();
    }

    {
      transpose_all(p.in[42] + (size_t)l * 1024 * 1024, 1024, 1024, 1024, Wt_xq, bid, nb, smem);
      transpose_all(p.in[44] + (size_t)l * 1024 * 1024, 1024, 1024, 1024, Wt_xo, bid, nb, smem);
      transpose_all(p.in[46] + (size_t)l * 1024 * 5632, 5632, 1024, 5632, Wt_gu, bid, nb, smem);
      transpose_all(p.in[49] + (size_t)l * 2816 * 1024, 1024, 2816, 1024, Wt_down, bid, nb, smem);
      rmsnorm_rows(X, p.in[40] + l * 1024, Hb, nullptr, T_ALL, bid, nb);
    }
    GSYNC();
    {
      const float qs = 0.0625f * LOG2E;
      for (int u = bid; u < 128 * 8; u += nb) {
        const int tn = u % 8, tm = u / 8;
        f32x4 acc[4][4];
        zero_acc<4>(acc);
        gemm_acc<128>(Hb + (size_t)tm * 128 * 1024, 1024, Wt_xq + (size_t)tn * 128 * 1024, 1024, 1024, smem, acc);
        EPI_FOR(128) {
          const int row = tm * 128 + EPI_ROW, n = tn * 128 + EPI_COL(128);
          Qx[(size_t)row * 1024 + n] = f2bf(acc[i][j][r] * qs);
        }
      }
    }
    GSYNC();
    {
      for (int u = bid; u < 1024; u += nb) {
        const int dvh = u & 1, hh = (u >> 1) & 3, qt = (u >> 3) & 31, b = u >> 8;
        attn_item<256, false>(Qx + (size_t)b * SEQ * 1024 + hh * 256, 1024, Kx + (size_t)(b * 4 + hh) * 65536, 256,
                              VxT + (size_t)(b * 4 + hh) * 65536 + (size_t)dvh * 128 * 256, 256, 4, qt * 128,
                              Ox + (size_t)b * SEQ * 1024 + hh * 256 + dvh * 128, 1024, smem);
      }
    }
    GSYNC();
    {
      for (int u = bid; u < 128 * 8; u += nb) {
        const int tn = u % 8, tm = u / 8;
        f32x4 acc[4][4];
        zero_acc<4>(acc);
        gemm_acc<128>(Ox + (size_t)tm * 128 * 1024, 1024, Wt_xo + (size_t)tn * 128 * 1024, 1024, 1024, smem, acc);
        EPI_FOR(128) {
          const int row = tm * 128 + EPI_ROW, n = tn * 128 + EPI_COL(128);
          X[(size_t)row * 1024 + n] += acc[i][j][r];
        }
      }
    }
    GSYNC();
    rmsnorm_rows(X, p.in[45] + l * 1024, Hb, nullptr, T_ALL, bid, nb);
    GSYNC();
    for (int half = 0; half < 2; ++half) {
      const bf16_t* Hh = Hb + (size_t)half * TH * 1024;
      for (int u = bid; u < 64 * 44; u += nb) {
        const int tn = u % 44, tm = u / 44;
        f32x4 acc[4][4];
        zero_acc<4>(acc);
        gemm_acc<128>(Hh + (size_t)tm * 128 * 1024, 1024, Wt_gu + (size_t)tn * 128 * 1024, 1024, 1024, smem, acc);
        EPI_FOR(128) {
          const int row = tm * 128 + EPI_ROW, n = tn * 128 + EPI_COL(128);
          GU[(size_t)row * 5632 + n] = f2bf(acc[i][j][r]);
        }
      }
      GSYNC();
      {
      PHASE_IDS
        const float* cw = p.in[47] + (size_t)l * 3 * D_FF;
        const float* cb = p.in[48] + (size_t)l * D_FF;
        for (int e = bid * 256 + tid; e < TH * 352; e += nb * 256) {
          const int tk = e / 352, c0 = (e % 352) * 8;
          const int s = tk & (SEQ - 1);
          const bf16_t* gp = GU + (size_t)tk * 5632 + c0;
          const uint4 g2 = *(const uint4*)gp;
          uint4 g1 = uint4{0, 0, 0, 0}, g0 = uint4{0, 0, 0, 0};
          if (s >= 1) g1 = *(const uint4*)(gp - 5632);
          if (s >= 2) g0 = *(const uint4*)(gp - 2 * 5632);
          const uint4 uu = *(const uint4*)(gp + D_FF);
          const unsigned a2[4] = {g2.x, g2.y, g2.z, g2.w}, a1[4] = {g1.x, g1.y, g1.z, g1.w}, a0[4] = {g0.x, g0.y, g0.z, g0.w};
          const unsigned au[4] = {uu.x, uu.y, uu.z, uu.w};
          float o[8];
#pragma unroll
          for (int q = 0; q < 8; ++q) {
            const bool hi = q & 1;
            const float x2 = hi ? bfhi(a2[q >> 1]) : bflo(a2[q >> 1]);
            const float x1 = hi ? bfhi(a1[q >> 1]) : bflo(a1[q >> 1]);
            const float x0 = hi ? bfhi(a0[q >> 1]) : bflo(a0[q >> 1]);
            const float up = hi ? bfhi(au[q >> 1]) : bflo(au[q >> 1]);
            const int c = c0 + q;
            const float gv = cw[c] * x0 + cw[D_FF + c] * x1 + cw[2 * D_FF + c] * x2 + cb[c];
            o[q] = gv * sigm(gv) * up;
          }
          uint4 ov; ov.x = pack2(o[0], o[1]); ov.y = pack2(o[2], o[3]); ov.z = pack2(o[4], o[5]); ov.w = pack2(o[6], o[7]);
          *(uint4*)(GU + (size_t)tk * 5632 + D_FF + c0) = ov;
        }
      }
      GSYNC();
      for (int u = bid; u < 64 * 8; u += nb) {
        const int tn = u % 8, tm = u / 8;
        f32x4 acc[4][4];
        zero_acc<4>(acc);
        gemm_acc<128>(GU + (size_t)tm * 128 * 5632 + D_FF, 5632, Wt_down + (size_t)tn * 128 * 2816, 2816, 2816, smem, acc);
        EPI_FOR(128) {
          const int row = half * TH + tm * 128 + EPI_ROW, n = tn * 128 + EPI_COL(128);
          X[(size_t)row * 1024 + n] += acc[i][j][r];
        }
      }
      GSYNC();
    }
  }

  {
      PHASE_IDS
    const float* g = p.in[50];
    for (int r = bid * 4 + wave; r < T_ALL; r += nb * 4) {
      float4* xr = (float4*)(X + (size_t)r * 1024);
      float4 v[4]; float ss = 0.f;
#pragma unroll
      for (int i = 0; i < 4; ++i) { v[i] = xr[lane + 64 * i]; ss += v[i].x * v[i].x + v[i].y * v[i].y + v[i].z * v[i].z + v[i].w * v[i].w; }
      ss = wave_sum(ss);
      const float rs = rsqrtf(ss * (1.f / 1024.f) + 1e-6f);
#pragma unroll
      for (int i = 0; i < 4; ++i) {
        const float4 gg = ((const float4*)g)[lane + 64 * i];
        xr[lane + 64 * i] = float4{v[i].x * rs * gg.x, v[i].y * rs * gg.y, v[i].z * rs * gg.z, v[i].w * rs * gg.w};
      }
    }
  }
}

extern "C" void kernel_launch(void* const* d_in, const int* in_sizes, int n_in, void* d_out, int out_size, void* d_ws, size_t ws_size,
                              hipStream_t stream) {
  static int grid_blocks = 0;
  if (!grid_blocks) {
    int dev = 0, cus = 0, per_cu = 0;
    hipGetDevice(&dev);
    hipDeviceGetAttribute(&cus, hipDeviceAttributeMultiprocessorCount, dev);
    hipOccupancyMaxActiveBlocksPerMultiprocessor(&per_cu, mega_kernel, 256, 0);
    if (per_cu > 2) per_cu = 2;
    if (per_cu < 1) per_cu = 1;
    grid_blocks = cus * per_cu;
  }
  if (ws_size < WS_NEED) fprintf(stderr, "workspace too small: %zu < %zu\n", ws_size, (size_t)WS_NEED);
  Params p{};
  for (int i = 0; i < 51; ++i) p.in[i] = (const float*)d_in[i];
  p.pos = (const int*)d_in[2];
  p.out = (float*)d_out;
  p.ws = (char*)d_ws;
  hipMemsetAsync((char*)d_ws + OFF_BAR, 0, 16384, stream);
  void* args[] = {&p};
  hipError_t e = hipLaunchCooperativeKernel((void*)mega_kernel, dim3(grid_blocks), dim3(256), args, 0, stream);
  if (e != hipSuccess) fprintf(stderr, "cooperative launch failed: %s (grid %d)\n", hipGetErrorString(e), grid_blocks);
}
```

```cpp
#include <hip/hip_runtime.h>
#include <hip/hip_cooperative_groups.h>
#include <cstdio>
#include <cstdint>
namespace cg = cooperative_groups;

typedef unsigned short bf16_t;
using bf16x8 = __attribute__((ext_vector_type(8))) short;
using s16x4 = __attribute__((ext_vector_type(4))) short;
using f32x4 = __attribute__((ext_vector_type(4))) float;
using f32x16 = __attribute__((ext_vector_type(16))) float;
#define DI __device__ __forceinline__

constexpr int T_ALL = 16384, SEQ = 4096, DM = 1024, TH = 8192;
constexpr int P_IN = 8896, GATE_OFF = 4800;
constexpr int PLD = 4864;
constexpr int PC_HG = 512, PC_S5 = 2560, PC_RW = 3072;
constexpr int D_FF = 2816;

constexpr size_t al256(size_t x) { return (x + 255) & ~(size_t)255; }
constexpr size_t OFF_WIN = 0;
constexpr size_t OFF_WQ = OFF_WIN + al256((size_t)P_IN * 1024 * 2);
constexpr size_t OFF_WBR = OFF_WQ + al256((size_t)768 * 256 * 2);
constexpr size_t OFF_WOUT = OFF_WBR + al256((size_t)4 * 1024 * 512 * 2);
constexpr size_t OFF_WGLU = OFF_WOUT + al256((size_t)1024 * 1024 * 2);
constexpr size_t OFF_WWUP = OFF_WGLU + al256((size_t)512 * 512 * 2);
constexpr size_t OFF_WAUP = OFF_WWUP + al256((size_t)512 * 64 * 2);
constexpr size_t OFF_WGUP = OFF_WAUP + al256((size_t)512 * 64 * 2);
constexpr size_t OFF_WV = OFF_WGUP + al256((size_t)512 * 128 * 2);
constexpr size_t OFF_WXKV = OFF_WV + al256((size_t)512 * 1024 * 2);
constexpr size_t OFF_S5AB = OFF_WXKV + al256((size_t)2048 * 1024 * 2);
constexpr size_t OFF_S5BB = OFF_S5AB + al256((size_t)32 * 64 * 2 * 4);
constexpr size_t OFF_H = OFF_S5BB + al256((size_t)32 * 64 * 32 * 4);
constexpr size_t OFF_VFIRST = OFF_H + al256((size_t)T_ALL * 1024 * 2);
constexpr size_t OFF_KX = OFF_VFIRST + al256((size_t)T_ALL * 512 * 2);
constexpr size_t OFF_VXT = OFF_KX + al256((size_t)16 * 256 * 256 * 2);
constexpr size_t OFF_HM = OFF_VXT + al256((size_t)16 * 256 * 256 * 2);
constexpr size_t OFF_COS = OFF_HM + al256((size_t)1024 * 1024 * 2);
constexpr size_t OFF_SIN = OFF_COS + al256((size_t)TH * 32 * 4);
constexpr size_t OFF_BAR = OFF_SIN + al256((size_t)TH * 32 * 4);
constexpr size_t OFF_REG = OFF_BAR + 16384;
constexpr size_t R_P = OFF_REG;
constexpr size_t R_CQN = R_P + al256((size_t)TH * PLD * 2);
constexpr size_t R_QP = R_CQN + (size_t)TH * 256 * 2;
constexpr size_t R_KVLAT = R_QP + al256((size_t)TH * 768 * 2);
constexpr size_t R_VT = R_KVLAT + al256((size_t)TH * 192 * 2);
constexpr size_t R_RKV = R_VT + al256((size_t)2 * 128 * 4096 * 2);
constexpr size_t R_ALORA = R_RKV + al256((size_t)TH * 1536 * 2);
constexpr size_t R_YRW = R_ALORA + al256((size_t)TH * 256 * 2);
constexpr size_t R_ZS5 = R_YRW + al256((size_t)TH * 512 * 4);
constexpr size_t R_END1 = R_ZS5 + al256((size_t)TH * 512 * 2);
constexpr size_t R_YBR = R_CQN;
constexpr size_t R_WXQ = OFF_REG;
constexpr size_t R_WXO = R_WXQ + al256((size_t)1024 * 1024 * 2);
constexpr size_t R_WGU = R_WXO + al256((size_t)1024 * 1024 * 2);
constexpr size_t R_WDOWN = R_WGU + al256((size_t)5632 * 1024 * 2);
constexpr size_t R_QX = R_WDOWN + al256((size_t)1024 * 2816 * 2);
constexpr size_t R_OX = R_QX + al256((size_t)T_ALL * 1024 * 2);
constexpr size_t R_GU = R_QX;
constexpr size_t R_END2 = R_GU + al256((size_t)TH * 5632 * 2);
constexpr size_t WS_NEED = (R_END1 > R_END2 ? R_END1 : R_END2);

constexpr int SMEM_BYTES = 73728;

struct Params {
  const float* in[51];
  const int* pos;
  float* out;
  char* ws;
};

DI bf16_t f2bf(float x) { unsigned u = __float_as_uint(x); u += 0x7fffu + ((u >> 16) & 1u); return (bf16_t)(u >> 16); }
DI float bf2f(bf16_t b) { return __uint_as_float(((unsigned)b) << 16); }
DI unsigned pack2(float a, float b) { return (unsigned)f2bf(a) | ((unsigned)f2bf(b) << 16); }
DI float bflo(unsigned u) { return __uint_as_float(u << 16); }
DI float bfhi(unsigned u) { return __uint_as_float(u & 0xffff0000u); }
DI float sigm(float x) { return 1.f / (1.f + __expf(-x)); }
template <int CTRL> DI float dppf(float v) {
  return __builtin_bit_cast(float, __builtin_amdgcn_update_dpp(0, __builtin_bit_cast(int, v), CTRL, 0xf, 0xf, false));
}
DI float red8(float v) { v += dppf<0xB1>(v); v += dppf<0x4E>(v); v += dppf<0x141>(v); return v; }
DI float red16(float v) { v = red8(v); v += dppf<0x140>(v); return v; }
DI int TID() { int t = threadIdx.x; asm volatile("" : "+v"(t)); return t; }
#define PHASE_IDS const int tid = TID(); const int lane = tid & 63, wave = tid >> 6; (void)lane; (void)wave;
DI float wave_sum(float v) { for (int o = 32; o > 0; o >>= 1) v += __shfl_xor(v, o); return v; }


#define XB_TMO      128
#define XB_XCNT(j)  (256  + 64 * (j))
#define XB_XSUB(j)  (1280 + 64 * (j))
#define XB_XGEN(j)  (2304 + 64 * (j))
#define XB_TOP      3328
#define XB_TOPGEN   3392
#define XCD_BAR_WORDS 3456
#define XB_SPIN_CAP (1u << 22)
#define LAS __attribute__((address_space(3)))
DI unsigned xb_ld(unsigned* p) { return __hip_atomic_load(p, __ATOMIC_RELAXED, __HIP_MEMORY_SCOPE_AGENT); }
DI unsigned xb_add(unsigned* p, unsigned v) { return __hip_atomic_fetch_add(p, v, __ATOMIC_RELAXED, __HIP_MEMORY_SCOPE_AGENT); }
DI unsigned xb_xcc_id() { return (unsigned)__builtin_amdgcn_s_getreg((3 << 11) | 20) & 0xFu; }
#define XB_SPIN(cond, bar) do { unsigned _sp = 0; while (cond) { __builtin_amdgcn_s_sleep(1); \
    if ((++_sp & 255u) == 0u) { if (xb_ld(&(bar)[XB_TMO])) break; if (_sp > XB_SPIN_CAP) { atomicAdd(&(bar)[XB_TMO], 1u); break; } } } } while (0)
struct XcdBarrier { unsigned* bar; unsigned x; volatile LAS unsigned* st; };
DI XcdBarrier xcd_barrier_post(unsigned* bar, volatile LAS unsigned* st) {
  XcdBarrier b; b.bar = bar; b.x = xb_xcc_id(); b.st = st;
  if (threadIdx.x == 0) (void)xb_add(&bar[XB_XCNT(b.x)], 1u);
  return b;
}
DI void xcd_barrier_complete(unsigned* bar, unsigned x, unsigned& nloc, unsigned& nx) {
  const unsigned G = gridDim.x * gridDim.y * gridDim.z;
  unsigned sum, cnt, mine, sp = 0u;
  for (;;) {
    sum = 0u; cnt = 0u; mine = 0u;
#pragma unroll
    for (unsigned j = 0; j < 16; ++j) { const unsigned c = xb_ld(&bar[XB_XCNT(j)]); sum += c; cnt += (c > 0u) ? 1u : 0u; mine = (j == x) ? c : mine; }
    if (sum == G) break;
    __builtin_amdgcn_s_sleep(1);
    if ((++sp & 255u) == 0u) { if (xb_ld(&bar[XB_TMO])) break; if (sp > XB_SPIN_CAP) { atomicAdd(&bar[XB_TMO], 1u); break; } }
  }
  nloc = mine > 0u ? mine : 1u; nx = cnt > 0u ? cnt : 1u;
}
DI void xcd_barrier(const XcdBarrier& b) {
  asm volatile("s_waitcnt vmcnt(0)" ::: "memory");
  __syncthreads();
  if (threadIdx.x == 0) {
    unsigned* bar = b.bar;
    __builtin_amdgcn_s_waitcnt(0);
    unsigned nloc = b.st[0], nx = b.st[1];
    if (nloc == 0u) { xcd_barrier_complete(bar, b.x, nloc, nx); b.st[0] = nloc; b.st[1] = nx; }
    const unsigned old = xb_add(&bar[XB_XSUB(b.x)], 1u);
    const unsigned gen = old / nloc;
    if (old + 1u == (gen + 1u) * nloc) {
      __builtin_amdgcn_fence(__ATOMIC_RELEASE, "agent");
      asm volatile("s_waitcnt vmcnt(0)" ::: "memory");
      const unsigned og = xb_add(&bar[XB_TOP], 1u);
      const unsigned tg = og / nx;
      if (og + 1u == (tg + 1u) * nx) xb_add(&bar[XB_TOPGEN], 1u);
      else XB_SPIN(xb_ld(&bar[XB_TOPGEN]) == tg, bar);
      __builtin_amdgcn_fence(__ATOMIC_ACQUIRE, "agent");
      xb_add(&bar[XB_XGEN(b.x)], 1u);
      asm volatile("s_waitcnt vmcnt(0)" ::: "memory");
    } else {
      XB_SPIN(xb_ld(&bar[XB_XGEN(b.x)]) == gen, bar);
      __builtin_amdgcn_fence(__ATOMIC_ACQUIRE, "agent");
      asm volatile("s_waitcnt vmcnt(0)" ::: "memory");
    }
  }
  __syncthreads();
}

template <int BN>
DI void gemm_acc(const bf16_t* __restrict__ A, int lda, const bf16_t* __restrict__ Bt, int ldb, int K, char* smem,
                 f32x4 (&acc)[4][BN / 32]) {
  constexpr int A_EL = 128 * 72, B_EL = BN * 72, BUF_EL = A_EL + B_EL;
  constexpr int NJ = BN / 32, BCH = BN / 32;
  bf16_t* sm = (bf16_t*)smem;
  const int tid = TID(), lane = tid & 63, wave = tid >> 6;
  const int wm = wave >> 1, wn = wave & 1, l16 = lane & 15, quad = lane >> 4;
  const int crow = tid >> 3, ccol = (tid & 7) * 8;
  uint4 ra[4], rb[BCH];
  const bf16_t* Ap = A + (size_t)crow * lda + ccol;
  const bf16_t* Bp = Bt + (size_t)crow * ldb + ccol;
  const int nk = K >> 6;
#pragma unroll
  for (int i = 0; i < 4; ++i) ra[i] = *(const uint4*)(Ap + (size_t)(32 * i) * lda);
#pragma unroll
  for (int i = 0; i < BCH; ++i) rb[i] = *(const uint4*)(Bp + (size_t)(32 * i) * ldb);
  {
    bf16_t* sa = sm; bf16_t* sb = sa + A_EL;
#pragma unroll
    for (int i = 0; i < 4; ++i) *(uint4*)(sa + (crow + 32 * i) * 72 + ccol) = ra[i];
#pragma unroll
    for (int i = 0; i < BCH; ++i) *(uint4*)(sb + (crow + 32 * i) * 72 + ccol) = rb[i];
  }
  __syncthreads();
  for (int kt = 0; kt < nk; ++kt) {
    const bool more = (kt + 1 < nk);
    if (more) {
      const int k0 = (kt + 1) << 6;
#pragma unroll
      for (int i = 0; i < 4; ++i) ra[i] = *(const uint4*)(Ap + (size_t)(32 * i) * lda + k0);
#pragma unroll
      for (int i = 0; i < BCH; ++i) rb[i] = *(const uint4*)(Bp + (size_t)(32 * i) * ldb + k0);
    }
    {
      const bf16_t* sa = sm + (kt & 1) * BUF_EL; const bf16_t* sb = sa + A_EL;
#pragma unroll
      for (int ks = 0; ks < 2; ++ks) {
        bf16x8 a[4], b[NJ];
#pragma unroll
        for (int i = 0; i < 4; ++i) a[i] = *(const bf16x8*)(sa + (wm * 64 + i * 16 + l16) * 72 + ks * 32 + quad * 8);
#pragma unroll
        for (int j = 0; j < NJ; ++j) b[j] = *(const bf16x8*)(sb + (wn * (BN / 2) + j * 16 + l16) * 72 + ks * 32 + quad * 8);
#pragma unroll
        for (int i = 0; i < 4; ++i)
#pragma unroll
          for (int j = 0; j < NJ; ++j) acc[i][j] = __builtin_amdgcn_mfma_f32_16x16x32_bf16(a[i], b[j], acc[i][j], 0, 0, 0);
      }
    }
    if (more) {
      bf16_t* sa = sm + ((kt + 1) & 1) * BUF_EL; bf16_t* sb = sa + A_EL;
#pragma unroll
      for (int i = 0; i < 4; ++i) *(uint4*)(sa + (crow + 32 * i) * 72 + ccol) = ra[i];
#pragma unroll
      for (int i = 0; i < BCH; ++i) *(uint4*)(sb + (crow + 32 * i) * 72 + ccol) = rb[i];
    }
    __syncthreads();
  }
}
template <int NJ> DI void zero_acc(f32x4 (&acc)[4][NJ]) {
#pragma unroll
  for (int i = 0; i < 4; ++i)
#pragma unroll
    for (int j = 0; j < NJ; ++j) acc[i][j] = f32x4{0.f, 0.f, 0.f, 0.f};
}
#define EPI_FOR(BN_)                                                                         \
  const int _t = TID(); const int _lane = _t & 63, _wave = _t >> 6;                              \
  const int _wm = _wave >> 1, _wn = _wave & 1, _l16 = _lane & 15, _quad = _lane >> 4;        \
  _Pragma("unroll") for (int i = 0; i < 4; ++i)                                              \
  _Pragma("unroll") for (int j = 0; j < (BN_) / 32; ++j)                                     \
  _Pragma("unroll") for (int r = 0; r < 4; ++r)
#define EPI_ROW (_wm * 64 + i * 16 + _quad * 4 + r)
#define EPI_COL(BN_) (_wn * ((BN_) / 2) + j * 16 + _l16)

DI void transpose_tile(const float* __restrict__ W, int ldw, bf16_t* __restrict__ Wt, int ldt, int k0, int n0, char* smem) {
  float* sm = (float*)smem;
  const int tid = TID();
  __syncthreads();
#pragma unroll
  for (int i = 0; i < 4; ++i) {
    const int k = (tid >> 4) + 16 * i, n4 = (tid & 15) * 4;
    const float4 v = *(const float4*)(W + (size_t)(k0 + k) * ldw + n0 + n4);
    sm[k * 65 + n4 + 0] = v.x; sm[k * 65 + n4 + 1] = v.y; sm[k * 65 + n4 + 2] = v.z; sm[k * 65 + n4 + 3] = v.w;
  }
  __syncthreads();
  const int n = tid >> 2, ks = (tid & 3) * 16;
  unsigned u[8];
#pragma unroll
  for (int e = 0; e < 8; ++e) u[e] = pack2(sm[(ks + 2 * e) * 65 + n], sm[(ks + 2 * e + 1) * 65 + n]);
  uint4* dst = (uint4*)(Wt + (size_t)(n0 + n) * ldt + k0 + ks);
  dst[0] = uint4{u[0], u[1], u[2], u[3]};
  dst[1] = uint4{u[4], u[5], u[6], u[7]};
}
DI void transpose_all(const float* W, int ldw, int K, int N, bf16_t* Wt, int bid, int nb, char* smem) {
  const int tk = K >> 6, tn = N >> 6;
  for (int t = bid; t < tk * tn; t += nb) transpose_tile(W, ldw, Wt, K, (t % tk) * 64, (t / tk) * 64, smem);
}

DI void rmsnorm_rows(const float* __restrict__ x, const float* __restrict__ g, bf16_t* __restrict__ h, float* xcopy, int rows,
                     int bid, int nb) {
  const int lane = TID() & 63, wave = TID() >> 6;
  for (int r = bid * 4 + wave; r < rows; r += nb * 4) {
    const float4* xr = (const float4*)(x + (size_t)r * 1024);
    float4 v[4]; float ss = 0.f;
#pragma unroll
    for (int i = 0; i < 4; ++i) { v[i] = xr[lane + 64 * i]; ss += v[i].x * v[i].x + v[i].y * v[i].y + v[i].z * v[i].z + v[i].w * v[i].w; }
    ss = wave_sum(ss);
    const float rs = rsqrtf(ss * (1.f / 1024.f) + 1e-6f);
#pragma unroll
    for (int i = 0; i < 4; ++i) {
      const float4 gg = ((const float4*)g)[lane + 64 * i];
      uint2 o; o.x = pack2(v[i].x * rs * gg.x, v[i].y * rs * gg.y); o.y = pack2(v[i].z * rs * gg.z, v[i].w * rs * gg.w);
      *(uint2*)(h + (size_t)r * 1024 + (lane + 64 * i) * 4) = o;
      if (xcopy) ((float4*)(xcopy + (size_t)r * 1024))[lane + 64 * i] = v[i];
    }
  }
}

template <int DQK, bool CAUSAL>
DI void attn_item(const bf16_t* __restrict__ Q, int ldq, const bf16_t* __restrict__ Kp, int ldk, const bf16_t* __restrict__ VT, int ldvt,
                  int ntiles, int q0, bf16_t* __restrict__ out, int ldo, char* smem) {
  constexpr int KS = DQK + 8, NS = DQK / 16, KCH = DQK / 8;
  bf16_t* Ks = (bf16_t*)smem;
  bf16_t* Vs = Ks + 64 * KS;
  const int tid = TID(), lane = tid & 63, wave = tid >> 6, ql = lane & 31, hh = lane >> 5;
  const int qrow = q0 + wave * 32 + ql;
  bf16x8 bq[NS];
#pragma unroll
  for (int s = 0; s < NS; ++s) bq[s] = *(const bf16x8*)(Q + (size_t)qrow * ldq + s * 16 + hh * 8);
  f32x16 ot[4];
#pragma unroll
  for (int d = 0; d < 4; ++d)
#pragma unroll
    for (int i = 0; i < 16; ++i) ot[d][i] = 0.f;
  float mrun = -INFINITY, lrun = 0.f;
  for (int kt = 0; kt < ntiles; ++kt) {
    __syncthreads();
    for (int c = tid; c < 64 * KCH; c += 256) {
      const int row = c / KCH, cc = c % KCH;
      *(uint4*)(Ks + row * KS + cc * 8) = *(const uint4*)(Kp + (size_t)(kt * 64 + row) * ldk + cc * 8);
    }
#pragma unroll
    for (int c0 = 0; c0 < 4; ++c0) {
      const int c = tid + c0 * 256, row = c >> 3, cc = c & 7;
      *(uint4*)(Vs + row * 72 + cc * 8) = *(const uint4*)(VT + (size_t)row * ldvt + kt * 64 + cc * 8);
    }
    __syncthreads();
    f32x16 st[2];
#pragma unroll
    for (int kb = 0; kb < 2; ++kb) {
#pragma unroll
      for (int i = 0; i < 16; ++i) st[kb][i] = 0.f;
#pragma unroll
      for (int s = 0; s < NS; ++s) {
        const bf16x8 a = *(const bf16x8*)(Ks + (kb * 32 + ql) * KS + s * 16 + hh * 8);
        st[kb] = __builtin_amdgcn_mfma_f32_32x32x16_bf16(a, bq[s], st[kb], 0, 0, 0);
      }
    }
    float mx = -INFINITY;
#pragma unroll
    for (int kb = 0; kb < 2; ++kb)
#pragma unroll
      for (int i = 0; i < 16; ++i) {
        if (CAUSAL) {
          const int key = kt * 64 + kb * 32 + (i & 3) + 8 * (i >> 2) + 4 * hh;
          if (key > qrow) st[kb][i] = -INFINITY;
        }
        mx = fmaxf(mx, st[kb][i]);
      }
    mx = fmaxf(mx, __shfl_xor(mx, 32));
    const float mnew = fmaxf(mrun, mx);
    const float alpha = exp2f(mrun - mnew);
    float ps = 0.f;
#pragma unroll
    for (int kb = 0; kb < 2; ++kb)
#pragma unroll
      for (int i = 0; i < 16; ++i) { const float pv = exp2f(st[kb][i] - mnew); st[kb][i] = pv; ps += pv; }
    ps += __shfl_xor(ps, 32);
    lrun = lrun * alpha + ps;
    mrun = mnew;
#pragma unroll
    for (int d = 0; d < 4; ++d)
#pragma unroll
      for (int i = 0; i < 16; ++i) ot[d][i] *= alpha;
#pragma unroll
    for (int kb = 0; kb < 2; ++kb)
#pragma unroll
      for (int s2 = 0; s2 < 2; ++s2) {
        unsigned pk[4];
#pragma unroll
        for (int e = 0; e < 4; ++e) pk[e] = pack2(st[kb][8 * s2 + 2 * e], st[kb][8 * s2 + 2 * e + 1]);
        const bf16x8 pb = __builtin_bit_cast(bf16x8, uint4{pk[0], pk[1], pk[2], pk[3]});
#pragma unroll
        for (int d = 0; d < 4; ++d) {
          const bf16_t* vp = Vs + (d * 32 + ql) * 72 + kb * 32 + s2 * 16 + hh * 4;
          const s16x4 lo = *(const s16x4*)vp;
          const s16x4 hi = *(const s16x4*)(vp + 8);
          const bf16x8 av = __builtin_shufflevector(lo, hi, 0, 1, 2, 3, 4, 5, 6, 7);
          ot[d] = __builtin_amdgcn_mfma_f32_32x32x16_bf16(av, pb, ot[d], 0, 0, 0);
        }
      }
  }
  const float inv = 1.f / lrun;
#pragma unroll
  for (int d = 0; d < 4; ++d)
#pragma unroll
    for (int g4 = 0; g4 < 4; ++g4) {
      uint2 o; o.x = pack2(ot[d][4 * g4] * inv, ot[d][4 * g4 + 1] * inv); o.y = pack2(ot[d][4 * g4 + 2] * inv, ot[d][4 * g4 + 3] * inv);
      *(uint2*)(out + (size_t)qrow * ldo + d * 32 + 8 * g4 + 4 * hh) = o;
    }
}

DI void rwkv_scan_unit(const Params& p, int l, int u, char* smem) {
  const int tid = TID();
  const int bl = u >> 5, hd = (u >> 2) & 7, rg = u & 3;
  const int kq = tid & 15, g16 = tid >> 4;
  const bf16_t* RKV = (const bf16_t*)(p.ws + R_RKV) + (size_t)bl * SEQ * 1536;
  const bf16_t* Pm = (const bf16_t*)(p.ws + R_P) + (size_t)bl * SEQ * PLD;
  float* Y = (float*)(p.ws + R_YRW) + (size_t)bl * SEQ * 512;
  float* sm = (float*)smem;
  constexpr int BUFF = 5 * 1024 + 256 + 32;
  const int kc = hd * 64 + kq * 4;
  const float4 kk_w = *(const float4*)(p.in[27] + l * 512 + kc);
  const float4 ka_w = *(const float4*)(p.in[28] + l * 512 + kc);
  float S0 = 0.f, S1 = 0.f, S2 = 0.f, S3 = 0.f;
  uint2 g_r, g_k, g_w, g_a; bf16_t g_v;
  auto gload = [&](int c) {
    const int tok = c * 16 + g16;
    g_r = *(const uint2*)(RKV + (size_t)tok * 1536 + kc);
    g_k = *(const uint2*)(RKV + (size_t)tok * 1536 + 512 + kc);
    g_v = RKV[(size_t)tok * 1536 + 1024 + hd * 64 + rg * 16 + kq];
    g_w = *(const uint2*)(Pm + (size_t)tok * PLD + PC_RW + kc);
    g_a = *(const uint2*)(Pm + (size_t)tok * PLD + PC_RW + 512 + kc);
  };
  auto derive = [&](int buf) {
    float* b = sm + buf * BUFF;
    const float r[4] = {bflo(g_r.x), bfhi(g_r.x), bflo(g_r.y), bfhi(g_r.y)};
    const float k[4] = {bflo(g_k.x), bfhi(g_k.x), bflo(g_k.y), bfhi(g_k.y)};
    const float w[4] = {bflo(g_w.x), bfhi(g_w.x), bflo(g_w.y), bfhi(g_w.y)};
    const float a[4] = {bflo(g_a.x), bfhi(g_a.x), bflo(g_a.y), bfhi(g_a.y)};
    const float kkw[4] = {kk_w.x, kk_w.y, kk_w.z, kk_w.w};
    const float kaw[4] = {ka_w.x, ka_w.y, ka_w.z, ka_w.w};
    float kk[4], ss = 0.f;
#pragma unroll
    for (int e = 0; e < 4; ++e) { kk[e] = k[e] * kkw[e]; ss += kk[e] * kk[e]; }
    ss = red16(ss);
    const float rn = rsqrtf(ss + 1e-12f);
    float dwr[4], dw[4], dk[4], dn[4], db[4];
    float br = 0.f, khr = 0.f;
#pragma unroll
    for (int e = 0; e < 4; ++e) {
      const float xm = -w[e];
      const float sp = (xm > 20.f) ? xm : log1pf(expf(xm));
      const float wlog = -sp - 0.5f;
      dw[e] = expf(-expf(wlog));
      const float kn = kk[e] * rn;
      dn[e] = -kn; db[e] = kn * a[e];
      dk[e] = k[e] * (1.f + (a[e] - 1.f) * kaw[e]);
      dwr[e] = dw[e] * r[e];
      br += db[e] * r[e]; khr += dk[e] * r[e];
    }
    br = red16(br); khr = red16(khr);
    *(float4*)(b + 0 * 1024 + g16 * 64 + kq * 4) = float4{dwr[0], dwr[1], dwr[2], dwr[3]};
    *(float4*)(b + 1 * 1024 + g16 * 64 + kq * 4) = float4{dw[0], dw[1], dw[2], dw[3]};
    *(float4*)(b + 2 * 1024 + g16 * 64 + kq * 4) = float4{dk[0], dk[1], dk[2], dk[3]};
    *(float4*)(b + 3 * 1024 + g16 * 64 + kq * 4) = float4{dn[0], dn[1], dn[2], dn[3]};
    *(float4*)(b + 4 * 1024 + g16 * 64 + kq * 4) = float4{db[0], db[1], db[2], db[3]};
    b[5 * 1024 + g16 * 16 + kq] = bf2f(g_v);
    if (kq == 0) { b[5 * 1024 + 256 + g16] = br; b[5 * 1024 + 272 + g16] = khr; }
  };
  __syncthreads();
  gload(0); derive(0);
  __syncthreads();
  constexpr int NC = SEQ / 16;
  for (int c = 0; c < NC; ++c) {
    if (c + 1 < NC) gload(c + 1);
    const float* b = sm + (c & 1) * BUFF;
    float ysel = 0.f;
    float4 nk = *(const float4*)(b + 3 * 1024 + kq * 4);
    float4 w = *(const float4*)(b + 1 * 1024 + kq * 4);
    float4 bb = *(const float4*)(b + 4 * 1024 + kq * 4);
    float4 kh = *(const float4*)(b + 2 * 1024 + kq * 4);
    float4 wr = *(const float4*)(b + 0 * 1024 + kq * 4);
    float v = b[5 * 1024 + g16];
    float brs = b[5 * 1024 + 256], khrs = b[5 * 1024 + 272];
#pragma unroll
    for (int t = 0; t < 16; ++t) {
      float4 nk2, w2, bb2, kh2, wr2; float v2, brs2, khrs2;
      if (t < 15) {
        nk2 = *(const float4*)(b + 3 * 1024 + (t + 1) * 64 + kq * 4);
        w2 = *(const float4*)(b + 1 * 1024 + (t + 1) * 64 + kq * 4);
        bb2 = *(const float4*)(b + 4 * 1024 + (t + 1) * 64 + kq * 4);
        kh2 = *(const float4*)(b + 2 * 1024 + (t + 1) * 64 + kq * 4);
        wr2 = *(const float4*)(b + 0 * 1024 + (t + 1) * 64 + kq * 4);
        v2 = b[5 * 1024 + (t + 1) * 16 + g16];
        brs2 = b[5 * 1024 + 256 + t + 1]; khrs2 = b[5 * 1024 + 272 + t + 1];
      }
      float sa = S0 * nk.x + S1 * nk.y + S2 * nk.z + S3 * nk.w;
      float yy = S0 * wr.x + S1 * wr.y + S2 * wr.z + S3 * wr.w;
      sa = red16(sa);
      yy = red16(yy);
      S0 = S0 * w.x + sa * bb.x + v * kh.x;
      S1 = S1 * w.y + sa * bb.y + v * kh.y;
      S2 = S2 * w.z + sa * bb.z + v * kh.z;
      S3 = S3 * w.w + sa * bb.w + v * kh.w;
      yy += sa * brs + v * khrs;
      ysel = (kq == t) ? yy : ysel;
      if (t < 15) { nk = nk2; w = w2; bb = bb2; kh = kh2; wr = wr2; v = v2; brs = brs2; khrs = khrs2; }
    }
    Y[(size_t)(c * 16 + kq) * 512 + hd * 64 + rg * 16 + g16] = ysel;
    if (c + 1 < NC) derive((c + 1) & 1);
    __syncthreads();
  }
}

DI void hgrn_scan_unit(const Params& p, int l, int u, char* smem) {
  const int tid = TID();
  const int bl = u >> 5, hd = (u >> 3) & 3, vg = u & 7;
  const int kq = tid & 15, g16 = tid >> 4;
  bf16_t* Pm = (bf16_t*)(p.ws + R_P) + (size_t)bl * SEQ * PLD;
  float* sm = (float*)smem;
  constexpr int BUFF = 2 * 2048 + 256 + 16;
  const int kc = hd * 128 + kq * 8;
  float lb[8];
#pragma unroll
  for (int e = 0; e < 8; ++e) {
    if (l == 0) lb[e] = 0.f;
    else { const float x0 = p.in[9][kc + e], x1 = p.in[9][512 + kc + e]; lb[e] = 1.f / (1.f + expf(x0 - x1)); }
  }
  float S[8];
#pragma unroll
  for (int e = 0; e < 8; ++e) S[e] = 0.f;
  uint4 g_q, g_f; bf16_t g_v;
  const int vcol = PC_HG + 1024 + hd * 128 + vg * 16;
  auto gload = [&](int c) {
    const int tok = c * 16 + g16;
    g_q = *(const uint4*)(Pm + (size_t)tok * PLD + PC_HG + kc);
    g_f = *(const uint4*)(Pm + (size_t)tok * PLD + PC_HG + 512 + kc);
    g_v = Pm[(size_t)tok * PLD + vcol + kq];
  };
  auto derive = [&](int buf) {
    float* b = sm + buf * BUFF;
    const unsigned qu[4] = {g_q.x, g_q.y, g_q.z, g_q.w}, fu[4] = {g_f.x, g_f.y, g_f.z, g_f.w};
    float fq[8], f[8], cs = 0.f;
#pragma unroll
    for (int e = 0; e < 8; ++e) {
      const float q = (e & 1) ? bfhi(qu[e >> 1]) : bflo(qu[e >> 1]);
      const float fx = (e & 1) ? bfhi(fu[e >> 1]) : bflo(fu[e >> 1]);
      f[e] = lb[e] + (1.f - lb[e]) * (1.f / (1.f + expf(-fx)));
      fq[e] = f[e] * q;
      cs += (1.f - f[e]) * q;
    }
    cs = red16(cs);
    *(float4*)(b + g16 * 128 + kq * 8) = float4{fq[0], fq[1], fq[2], fq[3]};
    *(float4*)(b + g16 * 128 + kq * 8 + 4) = float4{fq[4], fq[5], fq[6], fq[7]};
    *(float4*)(b + 2048 + g16 * 128 + kq * 8) = float4{f[0], f[1], f[2], f[3]};
    *(float4*)(b + 2048 + g16 * 128 + kq * 8 + 4) = float4{f[4], f[5], f[6], f[7]};
    b[4096 + g16 * 16 + kq] = bf2f(g_v);
    if (kq == 0) b[4096 + 256 + g16] = cs;
  };
  __syncthreads();
  gload(0); derive(0);
  __syncthreads();
  constexpr int NC = SEQ / 16;
  for (int c = 0; c < NC; ++c) {
    if (c + 1 < NC) gload(c + 1);
    const float* b = sm + (c & 1) * BUFF;
    float osel = 0.f;
#pragma unroll
    for (int t = 0; t < 16; ++t) {
      const float4 q0 = *(const float4*)(b + t * 128 + kq * 8), q1 = *(const float4*)(b + t * 128 + kq * 8 + 4);
      const float4 f0 = *(const float4*)(b + 2048 + t * 128 + kq * 8), f1 = *(const float4*)(b + 2048 + t * 128 + kq * 8 + 4);
      const float v = b[4096 + t * 16 + g16];
      const float cs = b[4096 + 256 + t];
      const float fq[8] = {q0.x, q0.y, q0.z, q0.w, q1.x, q1.y, q1.z, q1.w};
      const float f[8] = {f0.x, f0.y, f0.z, f0.w, f1.x, f1.y, f1.z, f1.w};
      float o = 0.f;
#pragma unroll
      for (int e = 0; e < 8; ++e) { o += S[e] * fq[e]; S[e] = f[e] * (S[e] - v) + v; }
      o = red16(o) + v * cs;
      osel = (kq == t) ? o : osel;
    }
    Pm[(size_t)(c * 16 + kq) * PLD + vcol + g16] = f2bf(osel);
    if (c + 1 < NC) derive((c + 1) & 1);
    __syncthreads();
  }
}

DI void s5_scan_unit(const Params& p, int l, int u, char* smem) {
  const int tid = TID(), lane = tid & 63, wave = tid >> 6;
  const int idx = u * 4 + wave, bl = idx >> 5, g = idx & 31;
  const bf16_t* Pm = (const bf16_t*)(p.ws + R_P) + (size_t)bl * SEQ * PLD + PC_S5 + g * 16;
  bf16_t* Z = (bf16_t*)(p.ws + R_ZS5) + (size_t)bl * SEQ * 512 + g * 16;
  constexpr int BUS = 132;
  float* buT = (float*)smem + wave * (16 * BUS);
  bf16_t* hist = (bf16_t*)(smem + 4 * 16 * BUS * 4) + wave * (16 * 136);
  const float2 ab = *(const float2*)((const float*)(p.ws + OFF_S5AB) + (g * 64 + lane) * 2);
  const int l16 = lane & 15, quad = lane >> 4;
  bf16x8 bbf[8];
  {
    const float* bbp = (const float*)(p.ws + OFF_S5BB);
#pragma unroll
    for (int jb = 0; jb < 8; ++jb) {
      const int col = jb * 16 + l16, nn = col & 63, im = col >> 6;
      unsigned pk[4] = {0u, 0u, 0u, 0u};
      if (quad < 2) {
        const float* src = bbp + (size_t)(g * 64 + nn) * 32 + im * 16 + quad * 8;
#pragma unroll
        for (int e = 0; e < 4; ++e) pk[e] = pack2(src[2 * e], src[2 * e + 1]);
      }
      bbf[jb] = __builtin_bit_cast(bf16x8, uint4{pk[0], pk[1], pk[2], pk[3]});
    }
  }
  bf16x8 cf[4];
  {
    const float* Cre = p.in[16] + (size_t)l * 32768 + (size_t)(g * 16 + l16) * 64;
    const float* Cim = p.in[17] + (size_t)l * 32768 + (size_t)(g * 16 + l16) * 64;
#pragma unroll
    for (int ks = 0; ks < 4; ++ks) {
      unsigned pk[4];
#pragma unroll
      for (int e = 0; e < 4; ++e) {
        const int k = ks * 32 + quad * 8 + 2 * e;
        const float v0 = (k < 64) ? Cre[k] : -Cim[k - 64];
        const float v1 = (k < 64) ? Cre[k + 1] : -Cim[k + 1 - 64];
        pk[e] = pack2(v0, v1);
      }
      cf[ks] = __builtin_bit_cast(bf16x8, uint4{pk[0], pk[1], pk[2], pk[3]});
    }
  }
  const float dcoef = p.in[18][l * 512 + g * 16 + l16];
  float xr = 0.f, xi = 0.f;
  uint4 ua = uint4{0u, 0u, 0u, 0u};
  bf16_t ue[4];
  auto gload = [&](int c) {
    if (quad < 2) ua = *(const uint4*)(Pm + (size_t)(c * 16 + l16) * PLD + quad * 8);
#pragma unroll
    for (int r = 0; r < 4; ++r) ue[r] = Pm[(size_t)(c * 16 + quad * 4 + r) * PLD + l16];
  };
  __syncthreads();
  gload(0);
  constexpr int NC = SEQ / 16;
  for (int c = 0; c < NC; ++c) {
    const bf16x8 afr = __builtin_bit_cast(bf16x8, ua);
    float us[4];
#pragma unroll
    for (int r = 0; r < 4; ++r) us[r] = bf2f(ue[r]);
#pragma unroll
    for (int jb = 0; jb < 8; ++jb) {
      f32x4 acc = {0.f, 0.f, 0.f, 0.f};
      acc = __builtin_amdgcn_mfma_f32_16x16x32_bf16(afr, bbf[jb], acc, 0, 0, 0);
#pragma unroll
      for (int r = 0; r < 4; ++r) buT[(quad * 4 + r) * BUS + jb * 16 + l16] = acc[r];
    }
    if (c + 1 < NC) gload(c + 1);
    __syncthreads();
#pragma unroll
    for (int t = 0; t < 16; ++t) {
      const float ur = buT[t * BUS + lane], ui = buT[t * BUS + 64 + lane];
      const float nr = ab.x * xr - ab.y * xi + ur;
      const float ni = ab.x * xi + ab.y * xr + ui;
      xr = nr; xi = ni;
      hist[t * 136 + lane] = f2bf(xr);
      hist[t * 136 + 64 + lane] = f2bf(xi);
    }
    __syncthreads();
    f32x4 acc = {0.f, 0.f, 0.f, 0.f};
#pragma unroll
    for (int ks = 0; ks < 4; ++ks) {
      const bf16x8 a = *(const bf16x8*)(hist + l16 * 136 + ks * 32 + quad * 8);
      acc = __builtin_amdgcn_mfma_f32_16x16x32_bf16(a, cf[ks], acc, 0, 0, 0);
    }
#pragma unroll
    for (int r = 0; r < 4; ++r) {
      const int t = quad * 4 + r;
      const float y = acc[r] + dcoef * us[r];
      const float z = y * sigm(1.5957691216057308f * (y + 0.044715f * y * y * y));
      Z[(size_t)(c * 16 + t) * 512 + l16] = f2bf(z);
    }
  }
}

#define GSYNC() xcd_barrier(xb)
__global__ void __launch_bounds__(256, 2) mega_kernel(Params p) {
  cg::grid_group grid = cg::this_grid();
  __shared__ __attribute__((aligned(16))) char smem[SMEM_BYTES];
  __shared__ uint4 xb_words;
  const int bid = blockIdx.x, nb = gridDim.x;
  if (p.ws == nullptr) grid.sync();
  if (threadIdx.x == 0) xb_words = make_uint4(0u, 0u, 0u, 0u);
  __syncthreads();
  const XcdBarrier xb = xcd_barrier_post((unsigned*)(p.ws + OFF_BAR), (volatile LAS unsigned*)&xb_words);
  char* ws = p.ws;
  float* X = p.out;
  bf16_t* Wt_in = (bf16_t*)(ws + OFF_WIN);
  bf16_t* Wt_q = (bf16_t*)(ws + OFF_WQ);
  bf16_t* Wt_br = (bf16_t*)(ws + OFF_WBR);
  bf16_t* Wt_out = (bf16_t*)(ws + OFF_WOUT);
  bf16_t* Wt_glu = (bf16_t*)(ws + OFF_WGLU);
  bf16_t* Wt_wup = (bf16_t*)(ws + OFF_WWUP);
  bf16_t* Wt_aup = (bf16_t*)(ws + OFF_WAUP);
  bf16_t* Wt_gup = (bf16_t*)(ws + OFF_WGUP);
  bf16_t* Wt_v = (bf16_t*)(ws + OFF_WV);
  bf16_t* Wt_xkv = (bf16_t*)(ws + OFF_WXKV);
  bf16_t* Hb = (bf16_t*)(ws + OFF_H);
  bf16_t* Vfirst = (bf16_t*)(ws + OFF_VFIRST);
  bf16_t* Kx = (bf16_t*)(ws + OFF_KX);
  bf16_t* VxT = (bf16_t*)(ws + OFF_VXT);
  bf16_t* Hm = (bf16_t*)(ws + OFF_HM);
  float* CosT = (float*)(ws + OFF_COS);
  float* SinT = (float*)(ws + OFF_SIN);
  bf16_t* Pm = (bf16_t*)(ws + R_P);
  bf16_t* Cqn = (bf16_t*)(ws + R_CQN);
  bf16_t* Qp = (bf16_t*)(ws + R_QP);
  bf16_t* KVlat = (bf16_t*)(ws + R_KVLAT);
  bf16_t* VTm = (bf16_t*)(ws + R_VT);
  bf16_t* RKV = (bf16_t*)(ws + R_RKV);
  bf16_t* Alora = (bf16_t*)(ws + R_ALORA);
  float* Yrw = (float*)(ws + R_YRW);
  bf16_t* Zs5 = (bf16_t*)(ws + R_ZS5);
  bf16_t* Ybr = (bf16_t*)(ws + R_YBR);
  bf16_t* Wt_xq = (bf16_t*)(ws + R_WXQ);
  bf16_t* Wt_xo = (bf16_t*)(ws + R_WXO);
  bf16_t* Wt_gu = (bf16_t*)(ws + R_WGU);
  bf16_t* Wt_down = (bf16_t*)(ws + R_WDOWN);
  bf16_t* Qx = (bf16_t*)(ws + R_QX);
  bf16_t* Ox = (bf16_t*)(ws + R_OX);
  bf16_t* GU = (bf16_t*)(ws + R_GU);
  const float LOG2E = 1.4426950408889634f;

  for (int l = 0; l < 2; ++l) {
    {
      PHASE_IDS
      const float* w_in = p.in[4] + (size_t)l * 1024 * P_IN;
      transpose_all(w_in, P_IN, 1024, P_IN, Wt_in, bid, nb, smem);
      transpose_all(p.in[36] + (size_t)l * 512 * 1024, 1024, 512, 1024, Wt_br + (size_t)1 * 1024 * 512, bid, nb, smem);
      transpose_all(p.in[37] + (size_t)l * 512 * 1024, 1024, 512, 1024, Wt_br + (size_t)2 * 1024 * 512, bid, nb, smem);
      transpose_all(p.in[38] + (size_t)l * 512 * 1024, 1024, 512, 1024, Wt_br + (size_t)3 * 1024 * 512, bid, nb, smem);
      transpose_all(p.in[39] + (size_t)l * 1024 * 1024, 1024, 1024, 1024, Wt_out, bid, nb, smem);
      transpose_all(p.in[19] + (size_t)l * 512 * 512, 512, 512, 512, Wt_glu, bid, nb, smem);
      transpose_all(p.in[23] + (size_t)l * 64 * 512, 512, 64, 512, Wt_wup, bid, nb, smem);
      transpose_all(p.in[25] + (size_t)l * 64 * 512, 512, 64, 512, Wt_aup, bid, nb, smem);
      transpose_all(p.in[26] + (size_t)l * 128 * 512, 512, 128, 512, Wt_gup, bid, nb, smem);
      transpose_all(p.in[43] + (size_t)l * 1024 * 2048, 2048, 1024, 2048, Wt_xkv, bid, nb, smem);
      const int gtid = bid * 256 + tid, gsz = nb * 256;
      {
        const float* w_uq = p.in[6] + (size_t)l * 256 * 768;
        const float* w_ukv = p.in[8] + (size_t)l * 128 * 1024;
        for (int e = gtid; e < 768 * 256; e += gsz) {
          const int n = e >> 8, kq = e & 255, hh = n / 192, j = n % 192;
          float v;
          if (j >= 128) v = w_uq[kq * 768 + n];
          else {
            v = 0.f;
            const float* a = w_uq + kq * 768 + hh * 192;
            const float* b = w_ukv + j * 1024 + hh * 256;
            for (int d = 0; d < 128; ++d) v += a[d] * b[d];
          }
          Wt_q[e] = f2bf(v);
        }
        const float* w_bm = p.in[35] + (size_t)l * 512 * 1024;
        for (int e = gtid; e < 1024 * 512; e += gsz) {
          const int n = e & 1023, kk = e >> 10, hh = kk >> 7, j = kk & 127;
          const float* a = w_ukv + j * 1024 + hh * 256 + 128;
          float v = 0.f;
          for (int d = 0; d < 128; ++d) v += a[d] * w_bm[(size_t)(hh * 128 + d) * 1024 + n];
          Wt_br[(size_t)n * 512 + kk] = f2bf(v);
        }
        if (l == 1) {
          const float* vd = p.in[32];
          const float* vu = p.in[33];
          for (int e = gtid; e < 512 * 1024; e += gsz) {
            const int n = e & 511, kk = e >> 9;
            float v = 0.f;
            for (int r = 0; r < 32; ++r) v += vd[kk * 32 + r] * vu[r * 512 + n];
            Wt_v[(size_t)n * 1024 + kk] = f2bf(v);
          }
        }
      }
      {
        float* abp = (float*)(ws + OFF_S5AB);
        float* bbp = (float*)(ws + OFF_S5BB);
        for (int e = gtid; e < 2048; e += gsz) {
          const int g = e >> 6;
          const float are = fminf(p.in[11][l * 2048 + e], -1e-4f), aim = p.in[12][l * 2048 + e];
          const float dt = expf(p.in[13][l * 32 + g]);
          const float mag = expf(dt * are);
          const float abre = mag * cosf(dt * aim), abim = mag * sinf(dt * aim);
          const float den = are * are + aim * aim;
          const float zre = ((abre - 1.f) * are + abim * aim) / den;
          const float zim = (abim * are - (abre - 1.f) * aim) / den;
          abp[e * 2] = abre; abp[e * 2 + 1] = abim;
          const float* Br = p.in[14] + (size_t)l * 32768 + (size_t)e * 16;
          const float* Bi = p.in[15] + (size_t)l * 32768 + (size_t)e * 16;
          for (int c = 0; c < 16; ++c) {
            bbp[e * 32 + c] = zre * Br[c] - zim * Bi[c];
            bbp[e * 32 + 16 + c] = zre * Bi[c] + zim * Br[c];
          }
        }
      }
      if (l == 0) rmsnorm_rows(p.in[0], p.in[3], Hb, X, T_ALL, bid, nb);
      else rmsnorm_rows(X, p.in[3] + 1024, Hb, nullptr, T_ALL, bid, nb);
      rmsnorm_rows(p.in[1], p.in[41] + l * 1024, Hm, nullptr, 1024, bid, nb);
    }
    GSYNC();

    for (int half = 0; half < 2; ++half) {
      const bf16_t* Hh = Hb + (size_t)half * TH * 1024;
      {
        const int n1 = 64 * 38;
        const int n2 = (half == 0) ? 8 * 16 : 0;
        for (int u = bid; u < n1 + n2; u += nb) {
          f32x4 acc[4][4];
          zero_acc<4>(acc);
          if (u < n1) {
            const int tn = u % 38, tm = u / 38;
            gemm_acc<128>(Hh + (size_t)tm * 128 * 1024, 1024, Wt_in + (size_t)tn * 128 * 1024, 1024, 1024, smem, acc);
            EPI_FOR(128) {
              const int row = tm * 128 + EPI_ROW, n = tn * 128 + EPI_COL(128);
              if (n < GATE_OFF) {
                const int pc = (n < 448) ? n : n + 64;
                Pm[(size_t)row * PLD + pc] = f2bf(acc[i][j][r]);
              }
            }
          } else {
            const int v = u - n1, tn = v % 16, tm = v / 16;
            gemm_acc<128>(Hm + (size_t)tm * 128 * 1024, 1024, Wt_xkv + (size_t)tn * 128 * 1024, 1024, 1024, smem, acc);
            EPI_FOR(128) {
              const int row = tm * 128 + EPI_ROW, n = tn * 128 + EPI_COL(128);
              const int b = row >> 8, m = row & 255, sel = n >> 10, hh = (n >> 8) & 3, d = n & 255;
              if (sel == 0) Kx[((size_t)(b * 4 + hh) * 256 + m) * 256 + d] = f2bf(acc[i][j][r]);
              else VxT[((size_t)(b * 4 + hh) * 256 + d) * 256 + m] = f2bf(acc[i][j][r]);
            }
          }
        }
      }
      GSYNC();
      {
      PHASE_IDS
        const float* qn = p.in[5] + l * 256;
        const float* kvn = p.in[7] + l * 128;
        const float* mu = p.in[21] + l * 1792;
        for (int tk = bid * 4 + wave; tk < TH; tk += nb * 4) {
          const int gtok = half * TH + tk, s = gtok & (SEQ - 1), bl = tk >> 12;
          const bf16_t* prow = Pm + (size_t)tk * PLD;
          {
            const uint2 cu = *(const uint2*)(prow + lane * 4);
            float f[4] = {bflo(cu.x), bfhi(cu.x), bflo(cu.y), bfhi(cu.y)};
            float ss = wave_sum(f[0] * f[0] + f[1] * f[1] + f[2] * f[2] + f[3] * f[3]);
            const float rs = rsqrtf(ss * (1.f / 256.f) + 1e-6f);
            const float4 g4 = *(const float4*)(qn + lane * 4);
            uint2 o; o.x = pack2(f[0] * rs * g4.x, f[1] * rs * g4.y); o.y = pack2(f[2] * rs * g4.z, f[3] * rs * g4.w);
            *(uint2*)(Cqn + (size_t)tk * 256 + lane * 4) = o;
          }
          {
            const unsigned cu = *(const unsigned*)(prow + 256 + lane * 2);
            const float f0 = bflo(cu), f1 = bfhi(cu);
            const float ss = wave_sum(f0 * f0 + f1 * f1);
            const float rs = rsqrtf(ss * (1.f / 128.f) + 1e-6f);
            const float v0 = f0 * rs * kvn[lane * 2], v1 = f1 * rs * kvn[lane * 2 + 1];
            const bf16_t b0 = f2bf(v0), b1 = f2bf(v1);
            *(unsigned*)(KVlat + (size_t)tk * 192 + lane * 2) = (unsigned)b0 | ((unsigned)b1 << 16);
            VTm[((size_t)bl * 128 + lane * 2) * SEQ + s] = b0;
            VTm[((size_t)bl * 128 + lane * 2 + 1) * SEQ + s] = b1;
          }
          if (lane < 32) {
            const float t1 = bf2f(prow[384 + lane]), t2 = bf2f(prow[384 + 32 + lane]);
            const float posf = (float)p.pos[gtok];
            const float invf = exp2f(-(float)lane * (13.287712379549449f / 32.f));
            const float ang = posf * invf;
            const float cs = cosf(ang), sn = sinf(ang);
            KVlat[(size_t)tk * 192 + 128 + lane] = f2bf(t1 * cs - t2 * sn);
            KVlat[(size_t)tk * 192 + 160 + lane] = f2bf(t1 * sn + t2 * cs);
            CosT[tk * 32 + lane] = cs; SinT[tk * 32 + lane] = sn;
          }
#pragma unroll
          for (int jj = 0; jj < 7; ++jj) {
            const int col = (jj * 64 + lane) * 4;
            const uint2 cu = *(const uint2*)(prow + PC_RW + col);
            uint2 pu = uint2{0u, 0u};
            if (s > 0) pu = *(const uint2*)(prow - PLD + PC_RW + col);
            const float4 m4 = *(const float4*)(mu + col);
            const float cv[4] = {bflo(cu.x), bfhi(cu.x), bflo(cu.y), bfhi(cu.y)};
            const float pv[4] = {bflo(pu.x), bfhi(pu.x), bflo(pu.y), bfhi(pu.y)};
            const float mm[4] = {m4.x, m4.y, m4.z, m4.w};
            float o[4];
#pragma unroll
            for (int e = 0; e < 4; ++e) o[e] = cv[e] + (pv[e] - cv[e]) * mm[e];
            if (col < 1536) {
              uint2 ov; ov.x = pack2(o[0], o[1]); ov.y = pack2(o[2], o[3]);
              *(uint2*)(RKV + (size_t)tk * 1536 + col) = ov;
              if (l == 0 && col >= 1024) *(uint2*)(Vfirst + (size_t)gtok * 512 + (col - 1024)) = ov;
            } else {
              int dc;
              if (col < 1600) { dc = col - 1536; for (int e = 0; e < 4; ++e) o[e] = tanhf(o[e]); }
              else if (col < 1664) { dc = 64 + col - 1600; }
              else { dc = 128 + col - 1664; for (int e = 0; e < 4; ++e) o[e] = sigm(o[e]); }
              uint2 ov; ov.x = pack2(o[0], o[1]); ov.y = pack2(o[2], o[3]);
              *(uint2*)(Alora + (size_t)tk * 256 + dc) = ov;
            }
          }
        }
      }
      GSYNC();
      {
      PHASE_IDS
        const int nq = 64 * 6, nl = 64 * 4;
        const int total = nq + 3 * nl + (l == 1 ? nl : 0);
        for (int u = bid; u < total; u += nb) {
          f32x4 acc[4][4];
          zero_acc<4>(acc);
          if (u < nq) {
            const int tn = u % 6, tm = u / 6;
            gemm_acc<128>(Cqn + (size_t)tm * 128 * 256, 256, Wt_q + (size_t)tn * 128 * 256, 256, 256, smem, acc);
            const float qs = 0.07216878364870322f * LOG2E;
            const int lane_ = tid & 63, wave_ = tid >> 6, wm_ = wave_ >> 1, wn_ = wave_ & 1, l16_ = lane_ & 15, quad_ = lane_ >> 4;
            const int gc = tn * 128 + wn_ * 64;
            const bool is_rope = (gc % 192) == 128;
#pragma unroll
            for (int i = 0; i < 4; ++i)
#pragma unroll
              for (int r = 0; r < 4; ++r) {
                const int row = tm * 128 + wm_ * 64 + i * 16 + quad_ * 4 + r;
                float v[4] = {acc[i][0][r], acc[i][1][r], acc[i][2][r], acc[i][3][r]};
                if (is_rope) {
#pragma unroll
                  for (int j = 0; j < 2; ++j) {
                    const int fi = j * 16 + l16_;
                    const float cs = CosT[row * 32 + fi], sn = SinT[row * 32 + fi];
                    const float t1 = v[j], t2 = v[j + 2];
                    v[j] = t1 * cs - t2 * sn; v[j + 2] = t1 * sn + t2 * cs;
                  }
                }
#pragma unroll
                for (int j = 0; j < 4; ++j) Qp[(size_t)row * 768 + gc + j * 16 + l16_] = f2bf(v[j] * qs);
              }
          } else if (u < nq + 3 * nl) {
            const int v = u - nq, which = v / nl, w2 = v % nl, tn = w2 % 4, tm = w2 / 4;
            if (which == 0) {
              gemm_acc<128>(Alora + (size_t)tm * 128 * 256, 256, Wt_wup + (size_t)tn * 128 * 64, 64, 64, smem, acc);
              const float* w0 = p.in[22] + l * 512;
              EPI_FOR(128) {
                const int row = tm * 128 + EPI_ROW, n = tn * 128 + EPI_COL(128);
                Pm[(size_t)row * PLD + PC_RW + n] = f2bf(w0[n] + acc[i][j][r]);
              }
            } else if (which == 1) {
              gemm_acc<128>(Alora + (size_t)tm * 128 * 256 + 64, 256, Wt_aup + (size_t)tn * 128 * 64, 64, 64, smem, acc);
              const float* a0 = p.in[24] + l * 512;
              EPI_FOR(128) {
                const int row = tm * 128 + EPI_ROW, n = tn * 128 + EPI_COL(128);
                Pm[(size_t)row * PLD + PC_RW + 512 + n] = f2bf(sigm(a0[n] + acc[i][j][r]));
              }
            } else {
              gemm_acc<128>(Alora + (size_t)tm * 128 * 256 + 128, 256, Wt_gup + (size_t)tn * 128 * 128, 128, 128, smem, acc);
              EPI_FOR(128) {
                const int row = tm * 128 + EPI_ROW, n = tn * 128 + EPI_COL(128);
                Pm[(size_t)row * PLD + PC_RW + 1024 + n] = f2bf(acc[i][j][r]);
              }
            }
          } else {
            const int w2 = u - nq - 3 * nl, tn = w2 % 4, tm = w2 / 4;
            gemm_acc<128>(Hh + (size_t)tm * 128 * 1024, 1024, Wt_v + (size_t)tn * 128 * 1024, 1024, 1024, smem, acc);
            const float* vb = p.in[34];
            EPI_FOR(128) {
              const int row = tm * 128 + EPI_ROW, n = tn * 128 + EPI_COL(128);
              const float gate = sigm(vb[n] + acc[i][j][r]);
              const float vc = bf2f(RKV[(size_t)row * 1536 + 1024 + n]);
              const float vf = bf2f(Vfirst[((size_t)half * TH + row) * 512 + n]);
              RKV[(size_t)row * 1536 + 1024 + n] = f2bf(vc + (vf - vc) * gate);
            }
          }
        }
      }
      GSYNC();
      {
        for (int u = bid; u < 64 + 64 + 16 + 256; u += nb) {
          if (u < 64) rwkv_scan_unit(p, l, u, smem);
          else if (u < 128) hgrn_scan_unit(p, l, u - 64, smem);
          else if (u < 144) s5_scan_unit(p, l, u - 128, smem);
          else {
            const int it = u - 144, qt = 31 - (it >> 3), bl = (it >> 2) & 1, hh = it & 3;
            attn_item<192, true>(Qp + (size_t)bl * SEQ * 768 + hh * 192, 768, KVlat + (size_t)bl * SEQ * 192, 192,
                                 VTm + (size_t)bl * 128 * SEQ, SEQ, (qt * 128 + 128) / 64, qt * 128,
                                 Pm + (size_t)bl * SEQ * PLD + hh * 128, PLD, smem);
          }
        }
      }
      GSYNC();
      {
      PHASE_IDS
        const int nglu = 64 * 4;
        for (int u = bid; u < nglu; u += nb) {
          const int tn = u % 4, tm = u / 4;
          f32x4 acc[4][4];
          zero_acc<4>(acc);
          gemm_acc<128>(Zs5 + (size_t)tm * 128 * 512, 512, Wt_glu + (size_t)tn * 128 * 512, 512, 512, smem, acc);
          const float* bg = p.in[20] + l * 512;
          EPI_FOR(128) {
            const int row = tm * 128 + EPI_ROW, n = tn * 128 + EPI_COL(128);
            const float z = bf2f(Zs5[(size_t)row * 512 + n]);
            Pm[(size_t)row * PLD + PC_S5 + n] = f2bf(z * sigm(acc[i][j][r] + bg[n]));
          }
        }
        const float* k_a = p.in[28] + l * 512;
        const float* r_k = p.in[29] + l * 512;
        const float* ln_w = p.in[30] + l * 512;
        const float* ln_b = p.in[31] + l * 512;
        const float* o_norm = p.in[10] + l * 512;
        for (int tk = bid * 4 + wave; tk < TH; tk += nb * 4) {
          const int c0 = lane * 8;
          {
            const float4 y0 = *(const float4*)(Yrw + (size_t)tk * 512 + c0), y1 = *(const float4*)(Yrw + (size_t)tk * 512 + c0 + 4);
            const float y[8] = {y0.x, y0.y, y0.z, y0.w, y1.x, y1.y, y1.z, y1.w};
            const uint4 ru = *(const uint4*)(RKV + (size_t)tk * 1536 + c0);
            const uint4 ku = *(const uint4*)(RKV + (size_t)tk * 1536 + 512 + c0);
            const uint4 vu = *(const uint4*)(RKV + (size_t)tk * 1536 + 1024 + c0);
            const uint4 au = *(const uint4*)(Pm + (size_t)tk * PLD + PC_RW + 512 + c0);
            const uint4 gu = *(const uint4*)(Pm + (size_t)tk * PLD + PC_RW + 1024 + c0);
            const unsigned ra[4] = {ru.x, ru.y, ru.z, ru.w}, ka[4] = {ku.x, ku.y, ku.z, ku.w}, va[4] = {vu.x, vu.y, vu.z, vu.w};
            const unsigned aa[4] = {au.x, au.y, au.z, au.w}, ga[4] = {gu.x, gu.y, gu.z, gu.w};
            float rr[8], kh[8], vv[8], gg[8];
            float sm1 = 0.f, bsum = 0.f;
#pragma unroll
            for (int e = 0; e < 8; ++e) {
              const unsigned sh = (e & 1);
              rr[e] = sh ? bfhi(ra[e >> 1]) : bflo(ra[e >> 1]);
              const float kx = sh ? bfhi(ka[e >> 1]) : bflo(ka[e >> 1]);
              vv[e] = sh ? bfhi(va[e >> 1]) : bflo(va[e >> 1]);
              const float a = sh ? bfhi(aa[e >> 1]) : bflo(aa[e >> 1]);
              gg[e] = sh ? bfhi(ga[e >> 1]) : bflo(ga[e >> 1]);
              kh[e] = kx * (1.f + (a - 1.f) * k_a[c0 + e]);
              sm1 += y[e];
              bsum += rr[e] * kh[e] * r_k[c0 + e];
            }
            sm1 = red8(sm1); bsum = red8(bsum);
            const float mean = sm1 * (1.f / 64.f);
            float vs = 0.f;
#pragma unroll
            for (int e = 0; e < 8; ++e) { const float d = y[e] - mean; vs += d * d; }
            vs = red8(vs);
            const float rstd = rsqrtf(vs * (1.f / 64.f) + 64e-5f);
            float o[8];
#pragma unroll
            for (int e = 0; e < 8; ++e) o[e] = (((y[e] - mean) * rstd) * ln_w[c0 + e] + ln_b[c0 + e] + bsum * vv[e]) * gg[e];
            uint4 ov; ov.x = pack2(o[0], o[1]); ov.y = pack2(o[2], o[3]); ov.z = pack2(o[4], o[5]); ov.w = pack2(o[6], o[7]);
            *(uint4*)(RKV + (size_t)tk * 1536 + c0) = ov;
          }
          {
            bf16_t* op = Pm + (size_t)tk * PLD + PC_HG + 1024 + c0;
            const uint4 ou = *(const uint4*)op;
            const uint4 gu = *(const uint4*)(Pm + (size_t)tk * PLD + PC_HG + 1536 + c0);
            const unsigned oa[4] = {ou.x, ou.y, ou.z, ou.w}, ga[4] = {gu.x, gu.y, gu.z, gu.w};
            float o[8], ss = 0.f;
#pragma unroll
            for (int e = 0; e < 4; ++e) { o[2 * e] = bflo(oa[e]); o[2 * e + 1] = bfhi(oa[e]); }
#pragma unroll
            for (int e = 0; e < 8; ++e) ss += o[e] * o[e];
            ss = red16(ss);
            const float rs = rsqrtf(ss * (1.f / 128.f) + 1e-6f);
            float r8[8];
#pragma unroll
            for (int e = 0; e < 8; ++e) {
              const float gte = (e & 1) ? bfhi(ga[e >> 1]) : bflo(ga[e >> 1]);
              r8[e] = o[e] * rs * o_norm[c0 + e] * sigm(gte);
            }
            uint4 ov; ov.x = pack2(r8[0], r8[1]); ov.y = pack2(r8[2], r8[3]); ov.z = pack2(r8[4], r8[5]); ov.w = pack2(r8[6], r8[7]);
            *(uint4*)op = ov;
          }
        }
      }
      GSYNC();
      {
        for (int u = bid; u < 64 * 16; u += nb) {
          const int tn = u % 16, tm = u / 16;
          f32x4 yacc[4][2];
          zero_acc<2>(yacc);
#pragma unroll 1
          for (int m = 0; m < 4; ++m) {
            f32x4 ag[4][2];
            zero_acc<2>(ag);
            gemm_acc<64>(Hh + (size_t)tm * 128 * 1024, 1024, Wt_in + (size_t)(GATE_OFF + m * 1024 + tn * 64) * 1024, 1024, 1024, smem, ag);
#pragma unroll
            for (int i = 0; i < 4; ++i)
#pragma unroll
              for (int j = 0; j < 2; ++j)
#pragma unroll
                for (int r = 0; r < 4; ++r) ag[i][j][r] = sigm(ag[i][j][r]);
            f32x4 ao[4][2];
            zero_acc<2>(ao);
            const bf16_t* Ao; int lda;
            if (m == 0) { Ao = Pm; lda = PLD; }
            else if (m == 1) { Ao = Pm + PC_HG + 1024; lda = PLD; }
            else if (m == 2) { Ao = Pm + PC_S5; lda = PLD; }
            else { Ao = RKV; lda = 1536; }
            gemm_acc<64>(Ao + (size_t)tm * 128 * lda, lda, Wt_br + ((size_t)m * 1024 + tn * 64) * 512, 512, 512, smem, ao);
#pragma unroll
            for (int i = 0; i < 4; ++i)
#pragma unroll
              for (int j = 0; j < 2; ++j)
#pragma unroll
                for (int r = 0; r < 4; ++r) yacc[i][j][r] += ag[i][j][r] * ao[i][j][r];
          }
          {
            f32x4 (&acc)[4][2] = yacc;
            EPI_FOR(64) {
              const int row = tm * 128 + EPI_ROW, n = tn * 64 + EPI_COL(64);
              Ybr[(size_t)row * 1024 + n] = f2bf(acc[i][j][r]);
            }
          }
        }
      }
      GSYNC();
      {
        for (int u = bid; u < 64 * 8; u += nb) {
          const int tn = u % 8, tm = u / 8;
          f32x4 acc[4][4];
          zero_acc<4>(acc);
          gemm_acc<128>(Ybr + (size_t)tm * 128 * 1024, 1024, Wt_out + (size_t)tn * 128 * 1024, 1024, 1024, smem, acc);
          EPI_FOR(128) {
            const int row = half * TH + tm * 128 + EPI_ROW, n = tn * 128 + EPI_COL(128);
            X[(size_t)row * 1024 + n] += acc[i][j][r];
          }
        }
      }
      GSYNC();
    }

    {
      transpose_all(p.in[42] + (size_t)l * 1024 * 1024, 1024, 1024, 1024, Wt_xq, bid, nb, smem);
      transpose_all(p.in[44] + (size_t)l * 1024 * 1024, 1024, 1024, 1024, Wt_xo, bid, nb, smem);
      transpose_all(p.in[46] + (size_t)l * 1024 * 5632, 5632, 1024, 5632, Wt_gu, bid, nb, smem);
      transpose_all(p.in[49] + (size_t)l * 2816 * 1024, 1024, 2816, 1024, Wt_down, bid, nb, smem);
      rmsnorm_rows(X, p.in[40] + l * 1024, Hb, nullptr, T_ALL, bid, nb);
    }
    GSYNC();
    {
      const float qs = 0.0625f * LOG2E;
      for (int u = bid; u < 128 * 8; u += nb) {
        const int tn = u % 8, tm = u / 8;
        f32x4 acc[4][4];
        zero_acc<4>(acc);
        gemm_acc<128>(Hb + (size_t)tm * 128 * 1024, 1024, Wt_xq + (size_t)tn * 128 * 1024, 1024, 1024, smem, acc);
        EPI_FOR(128) {
          const int row = tm * 128 + EPI_ROW, n = tn * 128 + EPI_COL(128);
          Qx[(size_t)row * 1024 + n] = f2bf(acc[i][j][r] * qs);
        }
      }
    }
    GSYNC();
    {
      for (int u = bid; u < 1024; u += nb) {
        const int dvh = u & 1, hh = (u >> 1) & 3, qt = (u >> 3) & 31, b = u >> 8;
        attn_item<256, false>(Qx + (size_t)b * SEQ * 1024 + hh * 256, 1024, Kx + (size_t)(b * 4 + hh) * 65536, 256,
                              VxT + (size_t)(b * 4 + hh) * 65536 + (size_t)dvh * 128 * 256, 256, 4, qt * 128,
                              Ox + (size_t)b * SEQ * 1024 + hh * 256 + dvh * 128, 1024, smem);
      }
    }
    GSYNC();
    {
      for (int u = bid; u < 128 * 8; u += nb) {
        const int tn = u % 8, tm = u / 8;
        f32x4 acc[4][4];
        zero_acc<4>(acc);
        gemm_acc<128>(Ox + (size_t)tm * 128 * 1024, 1024, Wt_xo + (size_t)tn * 128 * 1024, 1024, 1024, smem, acc);
        EPI_FOR(128) {
          const int row = tm * 128 + EPI_ROW, n = tn * 128 + EPI_COL(128);
          X[(size_t)row * 1024 + n] += acc[i][j][r];
        }
      }
    }
    GSYNC();
    rmsnorm_rows(X, p.in[45] + l * 1024, Hb, nullptr, T_ALL, bid, nb);
    GSYNC();
    for (int half = 0; half < 2; ++half) {
      const bf16_t* Hh = Hb + (size_t)half * TH * 1024;
      for (int u = bid; u < 64 * 44; u += nb) {
        const int tn = u % 44, tm = u / 44;
        f32x4 acc[4][4];
        zero_acc<4>(acc);
        gemm_acc<128>(Hh + (size_t)tm * 128 * 1024, 1024, Wt_gu + (size_t)tn * 128 * 1024, 1024, 1024, smem, acc);
        EPI_FOR(128) {
          const int row = tm * 128 + EPI_ROW, n = tn * 128 + EPI_COL(128);
          GU[(size_t)row * 5632 + n] = f2bf(acc[i][j][r]);
        }
      }
      GSYNC();
      {
      PHASE_IDS
        const float* cw = p.in[47] + (size_t)l * 3 * D_FF;
        const float* cb = p.in[48] + (size_t)l * D_FF;
        for (int e = bid * 256 + tid; e < TH * 352; e += nb * 256) {
          const int tk = e / 352, c0 = (e % 352) * 8;
          const int s = tk & (SEQ - 1);
          const bf16_t* gp = GU + (size_t)tk * 5632 + c0;
          const uint4 g2 = *(const uint4*)gp;
          uint4 g1 = uint4{0, 0, 0, 0}, g0 = uint4{0, 0, 0, 0};
          if (s >= 1) g1 = *(const uint4*)(gp - 5632);
          if (s >= 2) g0 = *(const uint4*)(gp - 2 * 5632);
          const uint4 uu = *(const uint4*)(gp + D_FF);
          const unsigned a2[4] = {g2.x, g2.y, g2.z, g2.w}, a1[4] = {g1.x, g1.y, g1.z, g1.w}, a0[4] = {g0.x, g0.y, g0.z, g0.w};
          const unsigned au[4] = {uu.x, uu.y, uu.z, uu.w};
          float o[8];
#pragma unroll
          for (int q = 0; q < 8; ++q) {
            const bool hi = q & 1;
            const float x2 = hi ? bfhi(a2[q >> 1]) : bflo(a2[q >> 1]);
            const float x1 = hi ? bfhi(a1[q >> 1]) : bflo(a1[q >> 1]);
            const float x0 = hi ? bfhi(a0[q >> 1]) : bflo(a0[q >> 1]);
            const float up = hi ? bfhi(au[q >> 1]) : bflo(au[q >> 1]);
            const int c = c0 + q;
            const float gv = cw[c] * x0 + cw[D_FF + c] * x1 + cw[2 * D_FF + c] * x2 + cb[c];
            o[q] = gv * sigm(gv) * up;
          }
          uint4 ov; ov.x = pack2(o[0], o[1]); ov.y = pack2(o[2], o[3]); ov.z = pack2(o[4], o[5]); ov.w = pack2(o[6], o[7]);
          *(uint4*)(GU + (size_t)tk * 5632 + D_FF + c0) = ov;
        }
      }
      GSYNC();
      for (int u = bid; u < 64 * 8; u += nb) {
        const int tn = u % 8, tm = u / 8;
        f32x4 acc[4][4];
        zero_acc<4>(acc);
        gemm_acc<128>(GU + (size_t)tm * 128 * 5632 + D_FF, 5632, Wt_down + (size_t)tn * 128 * 2816, 2816, 2816, smem, acc);
        EPI_FOR(128) {
          const int row = half * TH + tm * 128 + EPI_ROW, n = tn * 128 + EPI_COL(128);
          X[(size_t)row * 1024 + n] += acc[i][j][r];
        }
      }
      GSYNC();
    }
  }

  {
      PHASE_IDS
    const float* g = p.in[50];
    for (int r = bid * 4 + wave; r < T_ALL; r += nb * 4) {
      float4* xr = (float4*)(X + (size_t)r * 1024);
      float4 v[4]; float ss = 0.f;
#pragma unroll
      for (int i = 0; i < 4; ++i) { v[i] = xr[lane + 64 * i]; ss += v[i].x * v[i].x + v[i].y * v[i].y + v[i].z * v[i].z + v[i].w * v[i].w; }
      ss = wave_sum(ss);
      const float rs = rsqrtf(ss * (1.f / 1024.f) + 1e-6f);
#pragma unroll
      for (int i = 0; i < 4; ++i) {
        const float4 gg = ((const float4*)g)[lane + 64 * i];
        xr[lane + 64 * i] = float4{v[i].x * rs * gg.x, v[i].y * rs * gg.y, v[i].z * rs * gg.z, v[i].w * rs * gg.w};
      }
    }
  }
}

extern "C" void kernel_launch(void* const* d_in, const int* in_sizes, int n_in, void* d_out, int out_size, void* d_ws, size_t ws_size,
                              hipStream_t stream) {
  static int grid_blocks = 0;
  if (!grid_blocks) {
    int dev = 0, cus = 0, per_cu = 0;
    hipGetDevice(&dev);
    hipDeviceGetAttribute(&cus, hipDeviceAttributeMultiprocessorCount, dev);
    hipOccupancyMaxActiveBlocksPerMultiprocessor(&per_cu, mega_kernel, 256, 0);
    if (per_cu > 2) per_cu = 2;
    if (per_cu < 1) per_cu = 1;
    grid_blocks = cus * per_cu;
  }
  if (ws_size < WS_NEED) fprintf(stderr, "workspace too small: %zu < %zu\n", ws_size, (size_t)WS_NEED);
  Params p{};
  for (int i = 0; i < 51; ++i) p.in[i] = (const float*)d_in[i];
  p.pos = (const int*)d_in[2];
  p.out = (float*)d_out;
  p.ws = (char*)d_ws;
  hipMemsetAsync((char*)d_ws + OFF_BAR, 0, 16384, stream);
  void* args[] = {&p};
  hipError_t e = hipLaunchCooperativeKernel((void*)mega_kernel, dim3(grid_blocks), dim3(256), args, 0, stream);
  if (e != hipSuccess) fprintf(stderr, "cooperative launch failed: %s (grid %d)\n", hipGetErrorString(e), grid_blocks);
}
```

```cpp
#include <hip/hip_runtime.h>
#include <hip/hip_cooperative_groups.h>
#include <cstdio>
#include <cstdint>
namespace cg = cooperative_groups;

typedef unsigned short bf16_t;
using bf16x8 = __attribute__((ext_vector_type(8))) short;
using s16x4 = __attribute__((ext_vector_type(4))) short;
using f32x4 = __attribute__((ext_vector_type(4))) float;
using f32x16 = __attribute__((ext_vector_type(16))) float;
using u32x4 = __attribute__((ext_vector_type(4))) unsigned;
#define DI __device__ __forceinline__

constexpr int T_ALL = 16384, SEQ = 4096, DM = 1024, TH = 8192;
constexpr int P_IN = 8896, GATE_OFF = 4800;
constexpr int PLD = 4864;
constexpr int PC_HG = 512, PC_S5 = 2560, PC_RW = 3072;
constexpr int D_FF = 2816;

constexpr size_t al256(size_t x) { return (x + 255) & ~(size_t)255; }
constexpr size_t OFF_WIN = 0;
constexpr size_t OFF_WQ = OFF_WIN + al256((size_t)P_IN * 1024 * 2);
constexpr size_t OFF_WBR = OFF_WQ + al256((size_t)768 * 256 * 2);
constexpr size_t OFF_WOUT = OFF_WBR + al256((size_t)4 * 1024 * 512 * 2);
constexpr size_t OFF_WGLU = OFF_WOUT + al256((size_t)1024 * 1024 * 2);
constexpr size_t OFF_WWUP = OFF_WGLU + al256((size_t)512 * 512 * 2);
constexpr size_t OFF_WAUP = OFF_WWUP + al256((size_t)512 * 64 * 2);
constexpr size_t OFF_WGUP = OFF_WAUP + al256((size_t)512 * 64 * 2);
constexpr size_t OFF_WV = OFF_WGUP + al256((size_t)512 * 128 * 2);
constexpr size_t OFF_WXKV = OFF_WV + al256((size_t)512 * 1024 * 2);
constexpr size_t OFF_S5AB = OFF_WXKV + al256((size_t)2048 * 1024 * 2);
constexpr size_t OFF_S5BB = OFF_S5AB + al256((size_t)32 * 64 * 2 * 4);
constexpr size_t OFF_H = OFF_S5BB + al256((size_t)32 * 64 * 32 * 4);
constexpr size_t OFF_VFIRST = OFF_H + al256((size_t)T_ALL * 1024 * 2);
constexpr size_t OFF_KX = OFF_VFIRST + al256((size_t)T_ALL * 512 * 2);
constexpr size_t OFF_VXT = OFF_KX + al256((size_t)16 * 256 * 256 * 2);
constexpr size_t OFF_HM = OFF_VXT + al256((size_t)16 * 256 * 256 * 2);
constexpr size_t OFF_COS = OFF_HM + al256((size_t)1024 * 1024 * 2);
constexpr size_t OFF_SIN = OFF_COS + al256((size_t)TH * 32 * 4);
constexpr size_t OFF_BAR = OFF_SIN + al256((size_t)TH * 32 * 4);
constexpr size_t OFF_REG = OFF_BAR + 16384;
constexpr size_t R_P = OFF_REG;
constexpr size_t R_CQN = R_P + al256((size_t)TH * PLD * 2);
constexpr size_t R_QP = R_CQN + (size_t)TH * 256 * 2;
constexpr size_t R_KVLAT = R_QP + al256((size_t)TH * 768 * 2);
constexpr size_t R_VT = R_KVLAT + al256((size_t)TH * 192 * 2);
constexpr size_t R_RKV = R_VT + al256((size_t)2 * 128 * 4096 * 2);
constexpr size_t R_ALORA = R_RKV + al256((size_t)TH * 1536 * 2);
constexpr size_t R_YRW = R_ALORA + al256((size_t)TH * 256 * 2);
constexpr size_t R_ZS5 = R_YRW + al256((size_t)TH * 512 * 4);
constexpr size_t R_END1 = R_ZS5 + al256((size_t)TH * 512 * 2);
constexpr size_t R_YBR = R_CQN;
constexpr size_t R_WXQ = OFF_REG;
constexpr size_t R_WXO = R_WXQ + al256((size_t)1024 * 1024 * 2);
constexpr size_t R_WGU = R_WXO + al256((size_t)1024 * 1024 * 2);
constexpr size_t R_WDOWN = R_WGU + al256((size_t)5632 * 1024 * 2);
constexpr size_t R_QX = R_WDOWN + al256((size_t)1024 * 2816 * 2);
constexpr size_t R_OX = R_QX + al256((size_t)T_ALL * 1024 * 2);
constexpr size_t R_GU = R_QX;
constexpr size_t R_END2 = R_GU + al256((size_t)TH * 5632 * 2);
constexpr size_t WS_NEED = (R_END1 > R_END2 ? R_END1 : R_END2);

constexpr int SMEM_BYTES = 73728;

struct Params {
  const float* in[51];
  const int* pos;
  float* out;
  char* ws;
};

DI bf16_t f2bf(float x) { unsigned u = __float_as_uint(x); u += 0x7fffu + ((u >> 16) & 1u); return (bf16_t)(u >> 16); }
DI float bf2f(bf16_t b) { return __uint_as_float(((unsigned)b) << 16); }
DI unsigned pack2(float a, float b) { return (unsigned)f2bf(a) | ((unsigned)f2bf(b) << 16); }
DI float bflo(unsigned u) { return __uint_as_float(u << 16); }
DI float bfhi(unsigned u) { return __uint_as_float(u & 0xffff0000u); }
DI float sigm(float x) { return 1.f / (1.f + __expf(-x)); }
template <int CTRL> DI float dppf(float v) {
  return __builtin_bit_cast(float, __builtin_amdgcn_update_dpp(0, __builtin_bit_cast(int, v), CTRL, 0xf, 0xf, false));
}
DI float red8(float v) { v += dppf<0xB1>(v); v += dppf<0x4E>(v); v += dppf<0x141>(v); return v; }
DI float red16(float v) { v = red8(v); v += dppf<0x140>(v); return v; }
DI int TID() { int t = threadIdx.x; asm volatile("" : "+v"(t)); return t; }
#define PHASE_IDS const int tid = TID(); const int lane = tid & 63, wave = tid >> 6; (void)lane; (void)wave;
DI float wave_sum(float v) { for (int o = 32; o > 0; o >>= 1) v += __shfl_xor(v, o); return v; }


#define XB_TMO      128
#define XB_XCNT(j)  (256  + 64 * (j))
#define XB_XSUB(j)  (1280 + 64 * (j))
#define XB_XGEN(j)  (2304 + 64 * (j))
#define XB_TOP      3328
#define XB_TOPGEN   3392
#define XCD_BAR_WORDS 3456
#define XB_SPIN_CAP (1u << 22)
#define LAS __attribute__((address_space(3)))
DI unsigned xb_ld(unsigned* p) { return __hip_atomic_load(p, __ATOMIC_RELAXED, __HIP_MEMORY_SCOPE_AGENT); }
DI unsigned xb_add(unsigned* p, unsigned v) { return __hip_atomic_fetch_add(p, v, __ATOMIC_RELAXED, __HIP_MEMORY_SCOPE_AGENT); }
DI unsigned xb_xcc_id() { return (unsigned)__builtin_amdgcn_s_getreg((3 << 11) | 20) & 0xFu; }
#define XB_SPIN(cond, bar) do { unsigned _sp = 0; while (cond) { __builtin_amdgcn_s_sleep(1); \
    if ((++_sp & 255u) == 0u) { if (xb_ld(&(bar)[XB_TMO])) break; if (_sp > XB_SPIN_CAP) { atomicAdd(&(bar)[XB_TMO], 1u); break; } } } } while (0)
struct XcdBarrier { unsigned* bar; unsigned x; volatile LAS unsigned* st; };
DI XcdBarrier xcd_barrier_post(unsigned* bar, volatile LAS unsigned* st) {
  XcdBarrier b; b.bar = bar; b.x = xb_xcc_id(); b.st = st;
  if (threadIdx.x == 0) (void)xb_add(&bar[XB_XCNT(b.x)], 1u);
  return b;
}
DI void xcd_barrier_complete(unsigned* bar, unsigned x, unsigned& nloc, unsigned& nx) {
  const unsigned G = gridDim.x * gridDim.y * gridDim.z;
  unsigned sum, cnt, mine, sp = 0u;
  for (;;) {
    sum = 0u; cnt = 0u; mine = 0u;
#pragma unroll
    for (unsigned j = 0; j < 16; ++j) { const unsigned c = xb_ld(&bar[XB_XCNT(j)]); sum += c; cnt += (c > 0u) ? 1u : 0u; mine = (j == x) ? c : mine; }
    if (sum == G) break;
    __builtin_amdgcn_s_sleep(1);
    if ((++sp & 255u) == 0u) { if (xb_ld(&bar[XB_TMO])) break; if (sp > XB_SPIN_CAP) { atomicAdd(&bar[XB_TMO], 1u); break; } }
  }
  nloc = mine > 0u ? mine : 1u; nx = cnt > 0u ? cnt : 1u;
}
DI void xcd_barrier(const XcdBarrier& b) {
  asm volatile("s_waitcnt vmcnt(0)" ::: "memory");
  __syncthreads();
  if (threadIdx.x == 0) {
    unsigned* bar = b.bar;
    __builtin_amdgcn_s_waitcnt(0);
    unsigned nloc = b.st[0], nx = b.st[1];
    if (nloc == 0u) { xcd_barrier_complete(bar, b.x, nloc, nx); b.st[0] = nloc; b.st[1] = nx; }
    const unsigned old = xb_add(&bar[XB_XSUB(b.x)], 1u);
    const unsigned gen = old / nloc;
    if (old + 1u == (gen + 1u) * nloc) {
      __builtin_amdgcn_fence(__ATOMIC_RELEASE, "agent");
      asm volatile("s_waitcnt vmcnt(0)" ::: "memory");
      const unsigned og = xb_add(&bar[XB_TOP], 1u);
      const unsigned tg = og / nx;
      if (og + 1u == (tg + 1u) * nx) xb_add(&bar[XB_TOPGEN], 1u);
      else XB_SPIN(xb_ld(&bar[XB_TOPGEN]) == tg, bar);
      __builtin_amdgcn_fence(__ATOMIC_ACQUIRE, "agent");
      xb_add(&bar[XB_XGEN(b.x)], 1u);
      asm volatile("s_waitcnt vmcnt(0)" ::: "memory");
    } else {
      XB_SPIN(xb_ld(&bar[XB_XGEN(b.x)]) == gen, bar);
      __builtin_amdgcn_fence(__ATOMIC_ACQUIRE, "agent");
      asm volatile("s_waitcnt vmcnt(0)" ::: "memory");
    }
  }
  __syncthreads();
}

#define GLOAD16(dst, ptr) asm volatile("global_load_dwordx4 %0, %1, off" : "=v"(dst) : "v"(ptr))
template <int BN>
DI void gemm_acc(const bf16_t* __restrict__ A, int lda, const bf16_t* __restrict__ Bt, int ldb, int K, char* smem,
                 f32x4 (&acc)[4][BN / 32]) {
  constexpr int A_EL = 128 * 72, B_EL = BN * 72, BUF_EL = A_EL + B_EL;
  constexpr int NJ = BN / 32, BCH = BN / 32;
  bf16_t* sm = (bf16_t*)smem;
  const int tid = TID(), lane = tid & 63, wave = tid >> 6;
  const int wm = wave >> 1, wn = wave & 1, l16 = lane & 15, quad = lane >> 4;
  const int crow = tid >> 3, ccol = (tid & 7) * 8;
  u32x4 ra[4], rb[BCH];
  const bf16_t* Ap = A + (size_t)crow * lda + ccol;
  const bf16_t* Bp = Bt + (size_t)crow * ldb + ccol;
  const int nk = K >> 6;
#define GEMM_ISSUE(k0_)                                                                           \
  {                                                                                               \
    _Pragma("unroll") for (int i = 0; i < 4; ++i) GLOAD16(ra[i], Ap + (size_t)(32 * i) * lda + (k0_));   \
    _Pragma("unroll") for (int i = 0; i < BCH; ++i) GLOAD16(rb[i], Bp + (size_t)(32 * i) * ldb + (k0_)); \
  }
#define GEMM_LAND(buf_)                                                                           \
  {                                                                                               \
    if constexpr (BCH == 4)                                                                       \
      asm volatile("s_waitcnt vmcnt(0)" : "+v"(ra[0]), "+v"(ra[1]), "+v"(ra[2]), "+v"(ra[3]), "+v"(rb[0]), "+v"(rb[1]), "+v"(rb[2]), "+v"(rb[3])); \
    else                                                                                          \
      asm volatile("s_waitcnt vmcnt(0)" : "+v"(ra[0]), "+v"(ra[1]), "+v"(ra[2]), "+v"(ra[3]), "+v"(rb[0]), "+v"(rb[1])); \
    bf16_t* sa_ = sm + (buf_) * BUF_EL; bf16_t* sb_ = sa_ + A_EL;                                 \
    _Pragma("unroll") for (int i = 0; i < 4; ++i) *(u32x4*)(sa_ + (crow + 32 * i) * 72 + ccol) = ra[i];   \
    _Pragma("unroll") for (int i = 0; i < BCH; ++i) *(u32x4*)(sb_ + (crow + 32 * i) * 72 + ccol) = rb[i]; \
  }
  GEMM_ISSUE(0);
  GEMM_LAND(0);
  __syncthreads();
  for (int kt = 0; kt < nk; ++kt) {
    {
      const int k0 = ((kt + 1 < nk) ? (kt + 1) : kt) << 6;
      GEMM_ISSUE(k0);
    }
    __builtin_amdgcn_sched_barrier(0);
    {
      const bf16_t* sa = sm + (kt & 1) * BUF_EL; const bf16_t* sb = sa + A_EL;
#pragma unroll
      for (int ks = 0; ks < 2; ++ks) {
        bf16x8 a[4], b[NJ];
#pragma unroll
        for (int i = 0; i < 4; ++i) a[i] = *(const bf16x8*)(sa + (wm * 64 + i * 16 + l16) * 72 + ks * 32 + quad * 8);
#pragma unroll
        for (int j = 0; j < NJ; ++j) b[j] = *(const bf16x8*)(sb + (wn * (BN / 2) + j * 16 + l16) * 72 + ks * 32 + quad * 8);
#pragma unroll
        for (int i = 0; i < 4; ++i)
#pragma unroll
          for (int j = 0; j < NJ; ++j) acc[i][j] = __builtin_amdgcn_mfma_f32_16x16x32_bf16(b[j], a[i], acc[i][j], 0, 0, 0);
      }
    }
    __builtin_amdgcn_sched_barrier(0);
    GEMM_LAND((kt + 1) & 1);
    __syncthreads();
  }
#undef GEMM_ISSUE
#undef GEMM_LAND
}
template <int NJ> DI void zero_acc(f32x4 (&acc)[4][NJ]) {
#pragma unroll
  for (int i = 0; i < 4; ++i)
#pragma unroll
    for (int j = 0; j < NJ; ++j) acc[i][j] = f32x4{0.f, 0.f, 0.f, 0.f};
}
#define EPI_FOR(BN_)                                                                         \
  const int _t = TID(); const int _lane = _t & 63, _wave = _t >> 6;                              \
  const int _wm = _wave >> 1, _wn = _wave & 1, _l16 = _lane & 15, _quad = _lane >> 4;        \
  _Pragma("unroll") for (int i = 0; i < 4; ++i)                                              \
  _Pragma("unroll") for (int j = 0; j < (BN_) / 32; ++j)                                     \
  _Pragma("unroll") for (int r = 0; r < 4; ++r)
#define EPI_ROW (_wm * 64 + i * 16 + _l16)
#define EPI_COL(BN_) (_wn * ((BN_) / 2) + j * 16 + _quad * 4 + r)
#define EPI4_FOR(BN_)                                                                        \
  const int _t = TID(); const int _lane = _t & 63, _wave = _t >> 6;                          \
  const int _wm = _wave >> 1, _wn = _wave & 1, _l16 = _lane & 15, _quad = _lane >> 4;        \
  _Pragma("unroll") for (int i = 0; i < 4; ++i)                                              \
  _Pragma("unroll") for (int j = 0; j < (BN_) / 32; ++j)
#define EPI4_COL(BN_) (_wn * ((BN_) / 2) + j * 16 + _quad * 4)
DI uint2 pack4(f32x4 v) { uint2 o; o.x = pack2(v[0], v[1]); o.y = pack2(v[2], v[3]); return o; }
DI f32x4 unpack4(uint2 u) { return f32x4{bflo(u.x), bfhi(u.x), bflo(u.y), bfhi(u.y)}; }

DI void transpose_tile(const float* __restrict__ W, int ldw, bf16_t* __restrict__ Wt, int ldt, int k0, int n0, char* smem) {
  float* sm = (float*)smem;
  const int tid = TID();
  __syncthreads();
#pragma unroll
  for (int i = 0; i < 4; ++i) {
    const int k = (tid >> 4) + 16 * i, n4 = (tid & 15) * 4;
    const float4 v = *(const float4*)(W + (size_t)(k0 + k) * ldw + n0 + n4);
    sm[k * 65 + n4 + 0] = v.x; sm[k * 65 + n4 + 1] = v.y; sm[k * 65 + n4 + 2] = v.z; sm[k * 65 + n4 + 3] = v.w;
  }
  __syncthreads();
  const int n = tid >> 2, ks = (tid & 3) * 16;
  unsigned u[8];
#pragma unroll
  for (int e = 0; e < 8; ++e) u[e] = pack2(sm[(ks + 2 * e) * 65 + n], sm[(ks + 2 * e + 1) * 65 + n]);
  uint4* dst = (uint4*)(Wt + (size_t)(n0 + n) * ldt + k0 + ks);
  dst[0] = uint4{u[0], u[1], u[2], u[3]};
  dst[1] = uint4{u[4], u[5], u[6], u[7]};
}
DI void transpose_all(const float* W, int ldw, int K, int N, bf16_t* Wt, int bid, int nb, char* smem) {
  const int tk = K >> 6, tn = N >> 6;
  for (int t = bid; t < tk * tn; t += nb) transpose_tile(W, ldw, Wt, K, (t % tk) * 64, (t / tk) * 64, smem);
}

DI void rmsnorm_rows(const float* __restrict__ x, const float* __restrict__ g, bf16_t* __restrict__ h, float* xcopy, int rows,
                     int bid, int nb) {
  const int lane = TID() & 63, wave = TID() >> 6;
  for (int r = bid * 4 + wave; r < rows; r += nb * 4) {
    const float4* xr = (const float4*)(x + (size_t)r * 1024);
    float4 v[4]; float ss = 0.f;
#pragma unroll
    for (int i = 0; i < 4; ++i) { v[i] = xr[lane + 64 * i]; ss += v[i].x * v[i].x + v[i].y * v[i].y + v[i].z * v[i].z + v[i].w * v[i].w; }
    ss = wave_sum(ss);
    const float rs = rsqrtf(ss * (1.f / 1024.f) + 1e-6f);
#pragma unroll
    for (int i = 0; i < 4; ++i) {
      const float4 gg = ((const float4*)g)[lane + 64 * i];
      uint2 o; o.x = pack2(v[i].x * rs * gg.x, v[i].y * rs * gg.y); o.y = pack2(v[i].z * rs * gg.z, v[i].w * rs * gg.w);
      *(uint2*)(h + (size_t)r * 1024 + (lane + 64 * i) * 4) = o;
      if (xcopy) ((float4*)(xcopy + (size_t)r * 1024))[lane + 64 * i] = v[i];
    }
  }
}

template <int DQK, bool CAUSAL>
DI void attn_item(const bf16_t* __restrict__ Q, int ldq, const bf16_t* __restrict__ Kp, int ldk, const bf16_t* __restrict__ VT, int ldvt,
                  int ntiles, int q0, bf16_t* __restrict__ out, int ldo, char* smem) {
  constexpr int KS = DQK + 8, NS = DQK / 16, KCH = DQK / 8;
  bf16_t* Ks = (bf16_t*)smem;
  bf16_t* Vs = Ks + 64 * KS;
  const int tid = TID(), lane = tid & 63, wave = tid >> 6, ql = lane & 31, hh = lane >> 5;
  const int qrow = q0 + wave * 32 + ql;
  bf16x8 bq[NS];
#pragma unroll
  for (int s = 0; s < NS; ++s) bq[s] = *(const bf16x8*)(Q + (size_t)qrow * ldq + s * 16 + hh * 8);
  f32x16 ot[4];
#pragma unroll
  for (int d = 0; d < 4; ++d)
#pragma unroll
    for (int i = 0; i < 16; ++i) ot[d][i] = 0.f;
  float mrun = -INFINITY, lrun = 0.f;
  for (int kt = 0; kt < ntiles; ++kt) {
    __syncthreads();
    for (int c = tid; c < 64 * KCH; c += 256) {
      const int row = c / KCH, cc = c % KCH;
      *(uint4*)(Ks + row * KS + cc * 8) = *(const uint4*)(Kp + (size_t)(kt * 64 + row) * ldk + cc * 8);
    }
#pragma unroll
    for (int c0 = 0; c0 < 4; ++c0) {
      const int c = tid + c0 * 256, row = c >> 3, cc = c & 7;
      *(uint4*)(Vs + row * 72 + cc * 8) = *(const uint4*)(VT + (size_t)row * ldvt + kt * 64 + cc * 8);
    }
    __syncthreads();
    f32x16 st[2];
#pragma unroll
    for (int kb = 0; kb < 2; ++kb) {
#pragma unroll
      for (int i = 0; i < 16; ++i) st[kb][i] = 0.f;
#pragma unroll
      for (int s = 0; s < NS; ++s) {
        const bf16x8 a = *(const bf16x8*)(Ks + (kb * 32 + ql) * KS + s * 16 + hh * 8);
        st[kb] = __builtin_amdgcn_mfma_f32_32x32x16_bf16(a, bq[s], st[kb], 0, 0, 0);
      }
    }
    float mx = -INFINITY;
#pragma unroll
    for (int kb = 0; kb < 2; ++kb)
#pragma unroll
      for (int i = 0; i < 16; ++i) {
        if (CAUSAL) {
          const int key = kt * 64 + kb * 32 + (i & 3) + 8 * (i >> 2) + 4 * hh;
          if (key > qrow) st[kb][i] = -INFINITY;
        }
        mx = fmaxf(mx, st[kb][i]);
      }
    mx = fmaxf(mx, __shfl_xor(mx, 32));
    const float mnew = fmaxf(mrun, mx);
    const float alpha = exp2f(mrun - mnew);
    float ps = 0.f;
#pragma unroll
    for (int kb = 0; kb < 2; ++kb)
#pragma unroll
      for (int i = 0; i < 16; ++i) { const float pv = exp2f(st[kb][i] - mnew); st[kb][i] = pv; ps += pv; }
    ps += __shfl_xor(ps, 32);
    lrun = lrun * alpha + ps;
    mrun = mnew;
#pragma unroll
    for (int d = 0; d < 4; ++d)
#pragma unroll
      for (int i = 0; i < 16; ++i) ot[d][i] *= alpha;
#pragma unroll
    for (int kb = 0; kb < 2; ++kb)
#pragma unroll
      for (int s2 = 0; s2 < 2; ++s2) {
        unsigned pk[4];
#pragma unroll
        for (int e = 0; e < 4; ++e) pk[e] = pack2(st[kb][8 * s2 + 2 * e], st[kb][8 * s2 + 2 * e + 1]);
        const bf16x8 pb = __builtin_bit_cast(bf16x8, uint4{pk[0], pk[1], pk[2], pk[3]});
#pragma unroll
        for (int d = 0; d < 4; ++d) {
          const bf16_t* vp = Vs + (d * 32 + ql) * 72 + kb * 32 + s2 * 16 + hh * 4;
          const s16x4 lo = *(const s16x4*)vp;
          const s16x4 hi = *(const s16x4*)(vp + 8);
          const bf16x8 av = __builtin_shufflevector(lo, hi, 0, 1, 2, 3, 4, 5, 6, 7);
          ot[d] = __builtin_amdgcn_mfma_f32_32x32x16_bf16(av, pb, ot[d], 0, 0, 0);
        }
      }
  }
  const float inv = 1.f / lrun;
#pragma unroll
  for (int d = 0; d < 4; ++d)
#pragma unroll
    for (int g4 = 0; g4 < 4; ++g4) {
      uint2 o; o.x = pack2(ot[d][4 * g4] * inv, ot[d][4 * g4 + 1] * inv); o.y = pack2(ot[d][4 * g4 + 2] * inv, ot[d][4 * g4 + 3] * inv);
      *(uint2*)(out + (size_t)qrow * ldo + d * 32 + 8 * g4 + 4 * hh) = o;
    }
}

DI void rwkv_scan_unit(const Params& p, int l, int u, char* smem) {
  const int tid = TID();
  const int bl = u >> 5, hd = (u >> 2) & 7, rg = u & 3;
  const int kq = tid & 15, g16 = tid >> 4;
  const bf16_t* RKV = (const bf16_t*)(p.ws + R_RKV) + (size_t)bl * SEQ * 1536;
  const bf16_t* Pm = (const bf16_t*)(p.ws + R_P) + (size_t)bl * SEQ * PLD;
  float* Y = (float*)(p.ws + R_YRW) + (size_t)bl * SEQ * 512;
  float* sm = (float*)smem;
  constexpr int BUFF = 5 * 1024 + 256 + 32;
  const int kc = hd * 64 + kq * 4;
  const float4 kk_w = *(const float4*)(p.in[27] + l * 512 + kc);
  const float4 ka_w = *(const float4*)(p.in[28] + l * 512 + kc);
  float S0 = 0.f, S1 = 0.f, S2 = 0.f, S3 = 0.f;
  uint2 g_r, g_k, g_w, g_a; bf16_t g_v;
  auto gload = [&](int c) {
    const int tok = c * 16 + g16;
    g_r = *(const uint2*)(RKV + (size_t)tok * 1536 + kc);
    g_k = *(const uint2*)(RKV + (size_t)tok * 1536 + 512 + kc);
    g_v = RKV[(size_t)tok * 1536 + 1024 + hd * 64 + rg * 16 + kq];
    g_w = *(const uint2*)(Pm + (size_t)tok * PLD + PC_RW + kc);
    g_a = *(const uint2*)(Pm + (size_t)tok * PLD + PC_RW + 512 + kc);
  };
  auto derive = [&](int buf) {
    float* b = sm + buf * BUFF;
    const float r[4] = {bflo(g_r.x), bfhi(g_r.x), bflo(g_r.y), bfhi(g_r.y)};
    const float k[4] = {bflo(g_k.x), bfhi(g_k.x), bflo(g_k.y), bfhi(g_k.y)};
    const float w[4] = {bflo(g_w.x), bfhi(g_w.x), bflo(g_w.y), bfhi(g_w.y)};
    const float a[4] = {bflo(g_a.x), bfhi(g_a.x), bflo(g_a.y), bfhi(g_a.y)};
    const float kkw[4] = {kk_w.x, kk_w.y, kk_w.z, kk_w.w};
    const float kaw[4] = {ka_w.x, ka_w.y, ka_w.z, ka_w.w};
    float kk[4], ss = 0.f;
#pragma unroll
    for (int e = 0; e < 4; ++e) { kk[e] = k[e] * kkw[e]; ss += kk[e] * kk[e]; }
    ss = red16(ss);
    const float rn = rsqrtf(ss + 1e-12f);
    float dwr[4], dw[4], dk[4], dn[4], db[4];
    float br = 0.f, khr = 0.f;
#pragma unroll
    for (int e = 0; e < 4; ++e) {
      const float xm = -w[e];
      const float sp = (xm > 20.f) ? xm : log1pf(expf(xm));
      const float wlog = -sp - 0.5f;
      dw[e] = expf(-expf(wlog));
      const float kn = kk[e] * rn;
      dn[e] = -kn; db[e] = kn * a[e];
      dk[e] = k[e] * (1.f + (a[e] - 1.f) * kaw[e]);
      dwr[e] = dw[e] * r[e];
      br += db[e] * r[e]; khr += dk[e] * r[e];
    }
    br = red16(br); khr = red16(khr);
    *(float4*)(b + 0 * 1024 + g16 * 64 + kq * 4) = float4{dwr[0], dwr[1], dwr[2], dwr[3]};
    *(float4*)(b + 1 * 1024 + g16 * 64 + kq * 4) = float4{dw[0], dw[1], dw[2], dw[3]};
    *(float4*)(b + 2 * 1024 + g16 * 64 + kq * 4) = float4{dk[0], dk[1], dk[2], dk[3]};
    *(float4*)(b + 3 * 1024 + g16 * 64 + kq * 4) = float4{dn[0], dn[1], dn[2], dn[3]};
    *(float4*)(b + 4 * 1024 + g16 * 64 + kq * 4) = float4{db[0], db[1], db[2], db[3]};
    b[5 * 1024 + g16 * 16 + kq] = bf2f(g_v);
    if (kq == 0) { b[5 * 1024 + 256 + g16] = br; b[5 * 1024 + 272 + g16] = khr; }
  };
  __syncthreads();
  gload(0); derive(0);
  __syncthreads();
  constexpr int NC = SEQ / 16;
  for (int c = 0; c < NC; ++c) {
    if (c + 1 < NC) gload(c + 1);
    const float* b = sm + (c & 1) * BUFF;
    float ysel = 0.f;
    float4 nk = *(const float4*)(b + 3 * 1024 + kq * 4);
    float4 w = *(const float4*)(b + 1 * 1024 + kq * 4);
    float4 bb = *(const float4*)(b + 4 * 1024 + kq * 4);
    float4 kh = *(const float4*)(b + 2 * 1024 + kq * 4);
    float4 wr = *(const float4*)(b + 0 * 1024 + kq * 4);
    float v = b[5 * 1024 + g16];
    float brs = b[5 * 1024 + 256], khrs = b[5 * 1024 + 272];
#pragma unroll
    for (int t = 0; t < 16; ++t) {
      float4 nk2, w2, bb2, kh2, wr2; float v2, brs2, khrs2;
      if (t < 15) {
        nk2 = *(const float4*)(b + 3 * 1024 + (t + 1) * 64 + kq * 4);
        w2 = *(const float4*)(b + 1 * 1024 + (t + 1) * 64 + kq * 4);
        bb2 = *(const float4*)(b + 4 * 1024 + (t + 1) * 64 + kq * 4);
        kh2 = *(const float4*)(b + 2 * 1024 + (t + 1) * 64 + kq * 4);
        wr2 = *(const float4*)(b + 0 * 1024 + (t + 1) * 64 + kq * 4);
        v2 = b[5 * 1024 + (t + 1) * 16 + g16];
        brs2 = b[5 * 1024 + 256 + t + 1]; khrs2 = b[5 * 1024 + 272 + t + 1];
      }
      float sa = S0 * nk.x + S1 * nk.y + S2 * nk.z + S3 * nk.w;
      float yy = S0 * wr.x + S1 * wr.y + S2 * wr.z + S3 * wr.w;
      sa = red16(sa);
      yy = red16(yy);
      S0 = S0 * w.x + sa * bb.x + v * kh.x;
      S1 = S1 * w.y + sa * bb.y + v * kh.y;
      S2 = S2 * w.z + sa * bb.z + v * kh.z;
      S3 = S3 * w.w + sa * bb.w + v * kh.w;
      yy += sa * brs + v * khrs;
      ysel = (kq == t) ? yy : ysel;
      if (t < 15) { nk = nk2; w = w2; bb = bb2; kh = kh2; wr = wr2; v = v2; brs = brs2; khrs = khrs2; }
    }
    Y[(size_t)(c * 16 + kq) * 512 + hd * 64 + rg * 16 + g16] = ysel;
    if (c + 1 < NC) derive((c + 1) & 1);
    __syncthreads();
  }
}

DI void hgrn_scan_unit(const Params& p, int l, int u, char* smem) {
  const int tid = TID();
  const int bl = u >> 5, hd = (u >> 3) & 3, vg = u & 7;
  const int kq = tid & 15, g16 = tid >> 4;
  bf16_t* Pm = (bf16_t*)(p.ws + R_P) + (size_t)bl * SEQ * PLD;
  float* sm = (float*)smem;
  constexpr int BUFF = 2 * 2048 + 256 + 16;
  const int kc = hd * 128 + kq * 8;
  float lb[8];
#pragma unroll
  for (int e = 0; e < 8; ++e) {
    if (l == 0) lb[e] = 0.f;
    else { const float x0 = p.in[9][kc + e], x1 = p.in[9][512 + kc + e]; lb[e] = 1.f / (1.f + expf(x0 - x1)); }
  }
  float S[8];
#pragma unroll
  for (int e = 0; e < 8; ++e) S[e] = 0.f;
  uint4 g_q, g_f; bf16_t g_v;
  const int vcol = PC_HG + 1024 + hd * 128 + vg * 16;
  auto gload = [&](int c) {
    const int tok = c * 16 + g16;
    g_q = *(const uint4*)(Pm + (size_t)tok * PLD + PC_HG + kc);
    g_f = *(const uint4*)(Pm + (size_t)tok * PLD + PC_HG + 512 + kc);
    g_v = Pm[(size_t)tok * PLD + vcol + kq];
  };
  auto derive = [&](int buf) {
    float* b = sm + buf * BUFF;
    const unsigned qu[4] = {g_q.x, g_q.y, g_q.z, g_q.w}, fu[4] = {g_f.x, g_f.y, g_f.z, g_f.w};
    float fq[8], f[8], cs = 0.f;
#pragma unroll
    for (int e = 0; e < 8; ++e) {
      const float q = (e & 1) ? bfhi(qu[e >> 1]) : bflo(qu[e >> 1]);
      const float fx = (e & 1) ? bfhi(fu[e >> 1]) : bflo(fu[e >> 1]);
      f[e] = lb[e] + (1.f - lb[e]) * (1.f / (1.f + expf(-fx)));
      fq[e] = f[e] * q;
      cs += (1.f - f[e]) * q;
    }
    cs = red16(cs);
    *(float4*)(b + g16 * 128 + kq * 8) = float4{fq[0], fq[1], fq[2], fq[3]};
    *(float4*)(b + g16 * 128 + kq * 8 + 4) = float4{fq[4], fq[5], fq[6], fq[7]};
    *(float4*)(b + 2048 + g16 * 128 + kq * 8) = float4{f[0], f[1], f[2], f[3]};
    *(float4*)(b + 2048 + g16 * 128 + kq * 8 + 4) = float4{f[4], f[5], f[6], f[7]};
    b[4096 + g16 * 16 + kq] = bf2f(g_v);
    if (kq == 0) b[4096 + 256 + g16] = cs;
  };
  __syncthreads();
  gload(0); derive(0);
  __syncthreads();
  constexpr int NC = SEQ / 16;
  for (int c = 0; c < NC; ++c) {
    if (c + 1 < NC) gload(c + 1);
    const float* b = sm + (c & 1) * BUFF;
    float osel = 0.f;
#pragma unroll
    for (int t = 0; t < 16; ++t) {
      const float4 q0 = *(const float4*)(b + t * 128 + kq * 8), q1 = *(const float4*)(b + t * 128 + kq * 8 + 4);
      const float4 f0 = *(const float4*)(b + 2048 + t * 128 + kq * 8), f1 = *(const float4*)(b + 2048 + t * 128 + kq * 8 + 4);
      const float v = b[4096 + t * 16 + g16];
      const float cs = b[4096 + 256 + t];
      const float fq[8] = {q0.x, q0.y, q0.z, q0.w, q1.x, q1.y, q1.z, q1.w};
      const float f[8] = {f0.x, f0.y, f0.z, f0.w, f1.x, f1.y, f1.z, f1.w};
      float o = 0.f;
#pragma unroll
      for (int e = 0; e < 8; ++e) { o += S[e] * fq[e]; S[e] = f[e] * (S[e] - v) + v; }
      o = red16(o) + v * cs;
      osel = (kq == t) ? o : osel;
    }
    Pm[(size_t)(c * 16 + kq) * PLD + vcol + g16] = f2bf(osel);
    if (c + 1 < NC) derive((c + 1) & 1);
    __syncthreads();
  }
}

DI void s5_scan_unit(const Params& p, int l, int u, char* smem) {
  const int tid = TID(), lane = tid & 63, wave = tid >> 6;
  const int idx = u * 4 + wave, bl = idx >> 5, g = idx & 31;
  const bf16_t* Pm = (const bf16_t*)(p.ws + R_P) + (size_t)bl * SEQ * PLD + PC_S5 + g * 16;
  bf16_t* Z = (bf16_t*)(p.ws + R_ZS5) + (size_t)bl * SEQ * 512 + g * 16;
  constexpr int BUS = 132;
  float* buT = (float*)smem + wave * (16 * BUS);
  bf16_t* hist = (bf16_t*)(smem + 4 * 16 * BUS * 4) + wave * (16 * 136);
  const float2 ab = *(const float2*)((const float*)(p.ws + OFF_S5AB) + (g * 64 + lane) * 2);
  const int l16 = lane & 15, quad = lane >> 4;
  bf16x8 bbf[8];
  {
    const float* bbp = (const float*)(p.ws + OFF_S5BB);
#pragma unroll
    for (int jb = 0; jb < 8; ++jb) {
      const int col = jb * 16 + l16, nn = col & 63, im = col >> 6;
      unsigned pk[4] = {0u, 0u, 0u, 0u};
      if (quad < 2) {
        const float* src = bbp + (size_t)(g * 64 + nn) * 32 + im * 16 + quad * 8;
#pragma unroll
        for (int e = 0; e < 4; ++e) pk[e] = pack2(src[2 * e], src[2 * e + 1]);
      }
      bbf[jb] = __builtin_bit_cast(bf16x8, uint4{pk[0], pk[1], pk[2], pk[3]});
    }
  }
  bf16x8 cf[4];
  {
    const float* Cre = p.in[16] + (size_t)l * 32768 + (size_t)(g * 16 + l16) * 64;
    const float* Cim = p.in[17] + (size_t)l * 32768 + (size_t)(g * 16 + l16) * 64;
#pragma unroll
    for (int ks = 0; ks < 4; ++ks) {
      unsigned pk[4];
#pragma unroll
      for (int e = 0; e < 4; ++e) {
        const int k = ks * 32 + quad * 8 + 2 * e;
        const float v0 = (k < 64) ? Cre[k] : -Cim[k - 64];
        const float v1 = (k < 64) ? Cre[k + 1] : -Cim[k + 1 - 64];
        pk[e] = pack2(v0, v1);
      }
      cf[ks] = __builtin_bit_cast(bf16x8, uint4{pk[0], pk[1], pk[2], pk[3]});
    }
  }
  const float dcoef = p.in[18][l * 512 + g * 16 + l16];
  float xr = 0.f, xi = 0.f;
  uint4 ua = uint4{0u, 0u, 0u, 0u};
  bf16_t ue[4];
  auto gload = [&](int c) {
    if (quad < 2) ua = *(const uint4*)(Pm + (size_t)(c * 16 + l16) * PLD + quad * 8);
#pragma unroll
    for (int r = 0; r < 4; ++r) ue[r] = Pm[(size_t)(c * 16 + quad * 4 + r) * PLD + l16];
  };
  __syncthreads();
  gload(0);
  constexpr int NC = SEQ / 16;
  for (int c = 0; c < NC; ++c) {
    const bf16x8 afr = __builtin_bit_cast(bf16x8, ua);
    float us[4];
#pragma unroll
    for (int r = 0; r < 4; ++r) us[r] = bf2f(ue[r]);
#pragma unroll
    for (int jb = 0; jb < 8; ++jb) {
      f32x4 acc = {0.f, 0.f, 0.f, 0.f};
      acc = __builtin_amdgcn_mfma_f32_16x16x32_bf16(afr, bbf[jb], acc, 0, 0, 0);
#pragma unroll
      for (int r = 0; r < 4; ++r) buT[(quad * 4 + r) * BUS + jb * 16 + l16] = acc[r];
    }
    if (c + 1 < NC) gload(c + 1);
    __syncthreads();
#pragma unroll
    for (int t = 0; t < 16; ++t) {
      const float ur = buT[t * BUS + lane], ui = buT[t * BUS + 64 + lane];
      const float nr = ab.x * xr - ab.y * xi + ur;
      const float ni = ab.x * xi + ab.y * xr + ui;
      xr = nr; xi = ni;
      hist[t * 136 + lane] = f2bf(xr);
      hist[t * 136 + 64 + lane] = f2bf(xi);
    }
    __syncthreads();
    f32x4 acc = {0.f, 0.f, 0.f, 0.f};
#pragma unroll
    for (int ks = 0; ks < 4; ++ks) {
      const bf16x8 a = *(const bf16x8*)(hist + l16 * 136 + ks * 32 + quad * 8);
      acc = __builtin_amdgcn_mfma_f32_16x16x32_bf16(a, cf[ks], acc, 0, 0, 0);
    }
#pragma unroll
    for (int r = 0; r < 4; ++r) {
      const int t = quad * 4 + r;
      const float y = acc[r] + dcoef * us[r];
      const float z = y * sigm(1.5957691216057308f * (y + 0.044715f * y * y * y));
      Z[(size_t)(c * 16 + t) * 512 + l16] = f2bf(z);
    }
  }
}

#define GSYNC() xcd_barrier(xb)
#define TILE_MAP(u_, ntm_, tm_, tn_) { const int _x = (u_) & 7, _li = (u_) >> 3, _per = (ntm_) >> 3; tm_ = _x * _per + (_li % _per); tn_ = _li / _per; }
__global__ void __launch_bounds__(256, 2) mega_kernel(Params p) {
  cg::grid_group grid = cg::this_grid();
  __shared__ __attribute__((aligned(16))) char smem[SMEM_BYTES];
  __shared__ uint4 xb_words;
  const int bid = blockIdx.x, nb = gridDim.x;
  if (p.ws == nullptr) grid.sync();
  if (threadIdx.x == 0) xb_words = make_uint4(0u, 0u, 0u, 0u);
  __syncthreads();
  const XcdBarrier xb = xcd_barrier_post((unsigned*)(p.ws + OFF_BAR), (volatile LAS unsigned*)&xb_words);
  char* ws = p.ws;
  float* X = p.out;
  bf16_t* Wt_in = (bf16_t*)(ws + OFF_WIN);
  bf16_t* Wt_q = (bf16_t*)(ws + OFF_WQ);
  bf16_t* Wt_br = (bf16_t*)(ws + OFF_WBR);
  bf16_t* Wt_out = (bf16_t*)(ws + OFF_WOUT);
  bf16_t* Wt_glu = (bf16_t*)(ws + OFF_WGLU);
  bf16_t* Wt_wup = (bf16_t*)(ws + OFF_WWUP);
  bf16_t* Wt_aup = (bf16_t*)(ws + OFF_WAUP);
  bf16_t* Wt_gup = (bf16_t*)(ws + OFF_WGUP);
  bf16_t* Wt_v = (bf16_t*)(ws + OFF_WV);
  bf16_t* Wt_xkv = (bf16_t*)(ws + OFF_WXKV);
  bf16_t* Hb = (bf16_t*)(ws + OFF_H);
  bf16_t* Vfirst = (bf16_t*)(ws + OFF_VFIRST);
  bf16_t* Kx = (bf16_t*)(ws + OFF_KX);
  bf16_t* VxT = (bf16_t*)(ws + OFF_VXT);
  bf16_t* Hm = (bf16_t*)(ws + OFF_HM);
  float* CosT = (float*)(ws + OFF_COS);
  float* SinT = (float*)(ws + OFF_SIN);
  bf16_t* Pm = (bf16_t*)(ws + R_P);
  bf16_t* Cqn = (bf16_t*)(ws + R_CQN);
  bf16_t* Qp = (bf16_t*)(ws + R_QP);
  bf16_t* KVlat = (bf16_t*)(ws + R_KVLAT);
  bf16_t* VTm = (bf16_t*)(ws + R_VT);
  bf16_t* RKV = (bf16_t*)(ws + R_RKV);
  bf16_t* Alora = (bf16_t*)(ws + R_ALORA);
  float* Yrw = (float*)(ws + R_YRW);
  bf16_t* Zs5 = (bf16_t*)(ws + R_ZS5);
  bf16_t* Ybr = (bf16_t*)(ws + R_YBR);
  bf16_t* Wt_xq = (bf16_t*)(ws + R_WXQ);
  bf16_t* Wt_xo = (bf16_t*)(ws + R_WXO);
  bf16_t* Wt_gu = (bf16_t*)(ws + R_WGU);
  bf16_t* Wt_down = (bf16_t*)(ws + R_WDOWN);
  bf16_t* Qx = (bf16_t*)(ws + R_QX);
  bf16_t* Ox = (bf16_t*)(ws + R_OX);
  bf16_t* GU = (bf16_t*)(ws + R_GU);
  const float LOG2E = 1.4426950408889634f;

  for (int l = 0; l < 2; ++l) {
    {
      PHASE_IDS
      const float* w_in = p.in[4] + (size_t)l * 1024 * P_IN;
      transpose_all(w_in, P_IN, 1024, P_IN, Wt_in, bid, nb, smem);
      transpose_all(p.in[36] + (size_t)l * 512 * 1024, 1024, 512, 1024, Wt_br + (size_t)1 * 1024 * 512, bid, nb, smem);
      transpose_all(p.in[37] + (size_t)l * 512 * 1024, 1024, 512, 1024, Wt_br + (size_t)2 * 1024 * 512, bid, nb, smem);
      transpose_all(p.in[38] + (size_t)l * 512 * 1024, 1024, 512, 1024, Wt_br + (size_t)3 * 1024 * 512, bid, nb, smem);
      transpose_all(p.in[39] + (size_t)l * 1024 * 1024, 1024, 1024, 1024, Wt_out, bid, nb, smem);
      transpose_all(p.in[19] + (size_t)l * 512 * 512, 512, 512, 512, Wt_glu, bid, nb, smem);
      transpose_all(p.in[23] + (size_t)l * 64 * 512, 512, 64, 512, Wt_wup, bid, nb, smem);
      transpose_all(p.in[25] + (size_t)l * 64 * 512, 512, 64, 512, Wt_aup, bid, nb, smem);
      transpose_all(p.in[26] + (size_t)l * 128 * 512, 512, 128, 512, Wt_gup, bid, nb, smem);
      transpose_all(p.in[43] + (size_t)l * 1024 * 2048, 2048, 1024, 2048, Wt_xkv, bid, nb, smem);
      const int gtid = bid * 256 + tid, gsz = nb * 256;
      {
        const float* w_uq = p.in[6] + (size_t)l * 256 * 768;
        const float* w_ukv = p.in[8] + (size_t)l * 128 * 1024;
        for (int e = gtid; e < 768 * 256; e += gsz) {
          const int n = e >> 8, kq = e & 255, hh = n / 192, j = n % 192;
          float v;
          if (j >= 128) v = w_uq[kq * 768 + n];
          else {
            v = 0.f;
            const float* a = w_uq + kq * 768 + hh * 192;
            const float* b = w_ukv + j * 1024 + hh * 256;
            for (int d = 0; d < 128; ++d) v += a[d] * b[d];
          }
          Wt_q[e] = f2bf(v);
        }
        const float* w_bm = p.in[35] + (size_t)l * 512 * 1024;
        for (int e = gtid; e < 1024 * 512; e += gsz) {
          const int n = e & 1023, kk = e >> 10, hh = kk >> 7, j = kk & 127;
          const float* a = w_ukv + j * 1024 + hh * 256 + 128;
          float v = 0.f;
          for (int d = 0; d < 128; ++d) v += a[d] * w_bm[(size_t)(hh * 128 + d) * 1024 + n];
          Wt_br[(size_t)n * 512 + kk] = f2bf(v);
        }
        if (l == 1) {
          const float* vd = p.in[32];
          const float* vu = p.in[33];
          for (int e = gtid; e < 512 * 1024; e += gsz) {
            const int n = e & 511, kk = e >> 9;
            float v = 0.f;
            for (int r = 0; r < 32; ++r) v += vd[kk * 32 + r] * vu[r * 512 + n];
            Wt_v[(size_t)n * 1024 + kk] = f2bf(v);
          }
        }
      }
      {
        float* abp = (float*)(ws + OFF_S5AB);
        float* bbp = (float*)(ws + OFF_S5BB);
        for (int e = gtid; e < 2048; e += gsz) {
          const int g = e >> 6;
          const float are = fminf(p.in[11][l * 2048 + e], -1e-4f), aim = p.in[12][l * 2048 + e];
          const float dt = expf(p.in[13][l * 32 + g]);
          const float mag = expf(dt * are);
          const float abre = mag * cosf(dt * aim), abim = mag * sinf(dt * aim);
          const float den = are * are + aim * aim;
          const float zre = ((abre - 1.f) * are + abim * aim) / den;
          const float zim = (abim * are - (abre - 1.f) * aim) / den;
          abp[e * 2] = abre; abp[e * 2 + 1] = abim;
          const float* Br = p.in[14] + (size_t)l * 32768 + (size_t)e * 16;
          const float* Bi = p.in[15] + (size_t)l * 32768 + (size_t)e * 16;
          for (int c = 0; c < 16; ++c) {
            bbp[e * 32 + c] = zre * Br[c] - zim * Bi[c];
            bbp[e * 32 + 16 + c] = zre * Bi[c] + zim * Br[c];
          }
        }
      }
      if (l == 0) rmsnorm_rows(p.in[0], p.in[3], Hb, X, T_ALL, bid, nb);
      else rmsnorm_rows(X, p.in[3] + 1024, Hb, nullptr, T_ALL, bid, nb);
      rmsnorm_rows(p.in[1], p.in[41] + l * 1024, Hm, nullptr, 1024, bid, nb);
    }
    GSYNC();

    for (int half = 0; half < 2; ++half) {
      const bf16_t* Hh = Hb + (size_t)half * TH * 1024;
      {
        const int n1 = 64 * 38;
        const int n2 = (half == 0) ? 8 * 16 : 0;
        for (int u = bid; u < n1 + n2; u += nb) {
          f32x4 acc[4][4];
          zero_acc<4>(acc);
          if (u < n1) {
            int tm, tn; TILE_MAP(u, 64, tm, tn);
            gemm_acc<128>(Hh + (size_t)tm * 128 * 1024, 1024, Wt_in + (size_t)tn * 128 * 1024, 1024, 1024, smem, acc);
            EPI4_FOR(128) {
              const int row = tm * 128 + EPI_ROW, n = tn * 128 + EPI4_COL(128);
              if (n < GATE_OFF) {
                const int pc = (n < 448) ? n : n + 64;
                *(uint2*)(Pm + (size_t)row * PLD + pc) = pack4(acc[i][j]);
              }
            }
          } else {
            const int v = u - n1, tn = v % 16, tm = v / 16;
            gemm_acc<128>(Hm + (size_t)tm * 128 * 1024, 1024, Wt_xkv + (size_t)tn * 128 * 1024, 1024, 1024, smem, acc);
            EPI_FOR(128) {
              const int row = tm * 128 + EPI_ROW, n = tn * 128 + EPI_COL(128);
              const int b = row >> 8, m = row & 255, sel = n >> 10, hh = (n >> 8) & 3, d = n & 255;
              if (sel == 0) Kx[((size_t)(b * 4 + hh) * 256 + m) * 256 + d] = f2bf(acc[i][j][r]);
              else VxT[((size_t)(b * 4 + hh) * 256 + d) * 256 + m] = f2bf(acc[i][j][r]);
            }
          }
        }
      }
      GSYNC();
      {
      PHASE_IDS
        const float* qn = p.in[5] + l * 256;
        const float* kvn = p.in[7] + l * 128;
        const float* mu = p.in[21] + l * 1792;
        for (int tk = bid * 4 + wave; tk < TH; tk += nb * 4) {
          const int gtok = half * TH + tk, s = gtok & (SEQ - 1), bl = tk >> 12;
          const bf16_t* prow = Pm + (size_t)tk * PLD;
          {
            const uint2 cu = *(const uint2*)(prow + lane * 4);
            float f[4] = {bflo(cu.x), bfhi(cu.x), bflo(cu.y), bfhi(cu.y)};
            float ss = wave_sum(f[0] * f[0] + f[1] * f[1] + f[2] * f[2] + f[3] * f[3]);
            const float rs = rsqrtf(ss * (1.f / 256.f) + 1e-6f);
            const float4 g4 = *(const float4*)(qn + lane * 4);
            uint2 o; o.x = pack2(f[0] * rs * g4.x, f[1] * rs * g4.y); o.y = pack2(f[2] * rs * g4.z, f[3] * rs * g4.w);
            *(uint2*)(Cqn + (size_t)tk * 256 + lane * 4) = o;
          }
          {
            const unsigned cu = *(const unsigned*)(prow + 256 + lane * 2);
            const float f0 = bflo(cu), f1 = bfhi(cu);
            const float ss = wave_sum(f0 * f0 + f1 * f1);
            const float rs = rsqrtf(ss * (1.f / 128.f) + 1e-6f);
            const float v0 = f0 * rs * kvn[lane * 2], v1 = f1 * rs * kvn[lane * 2 + 1];
            const bf16_t b0 = f2bf(v0), b1 = f2bf(v1);
            *(unsigned*)(KVlat + (size_t)tk * 192 + lane * 2) = (unsigned)b0 | ((unsigned)b1 << 16);
            VTm[((size_t)bl * 128 + lane * 2) * SEQ + s] = b0;
            VTm[((size_t)bl * 128 + lane * 2 + 1) * SEQ + s] = b1;
          }
          if (lane < 32) {
            const float t1 = bf2f(prow[384 + lane]), t2 = bf2f(prow[384 + 32 + lane]);
            const float posf = (float)p.pos[gtok];
            const float invf = exp2f(-(float)lane * (13.287712379549449f / 32.f));
            const float ang = posf * invf;
            const float cs = cosf(ang), sn = sinf(ang);
            KVlat[(size_t)tk * 192 + 128 + lane] = f2bf(t1 * cs - t2 * sn);
            KVlat[(size_t)tk * 192 + 160 + lane] = f2bf(t1 * sn + t2 * cs);
            CosT[tk * 32 + lane] = cs; SinT[tk * 32 + lane] = sn;
          }
#pragma unroll
          for (int jj = 0; jj < 7; ++jj) {
            const int col = (jj * 64 + lane) * 4;
            const uint2 cu = *(const uint2*)(prow + PC_RW + col);
            uint2 pu = uint2{0u, 0u};
            if (s > 0) pu = *(const uint2*)(prow - PLD + PC_RW + col);
            const float4 m4 = *(const float4*)(mu + col);
            const float cv[4] = {bflo(cu.x), bfhi(cu.x), bflo(cu.y), bfhi(cu.y)};
            const float pv[4] = {bflo(pu.x), bfhi(pu.x), bflo(pu.y), bfhi(pu.y)};
            const float mm[4] = {m4.x, m4.y, m4.z, m4.w};
            float o[4];
#pragma unroll
            for (int e = 0; e < 4; ++e) o[e] = cv[e] + (pv[e] - cv[e]) * mm[e];
            if (col < 1536) {
              uint2 ov; ov.x = pack2(o[0], o[1]); ov.y = pack2(o[2], o[3]);
              *(uint2*)(RKV + (size_t)tk * 1536 + col) = ov;
              if (l == 0 && col >= 1024) *(uint2*)(Vfirst + (size_t)gtok * 512 + (col - 1024)) = ov;
            } else {
              int dc;
              if (col < 1600) { dc = col - 1536; for (int e = 0; e < 4; ++e) o[e] = tanhf(o[e]); }
              else if (col < 1664) { dc = 64 + col - 1600; }
              else { dc = 128 + col - 1664; for (int e = 0; e < 4; ++e) o[e] = sigm(o[e]); }
              uint2 ov; ov.x = pack2(o[0], o[1]); ov.y = pack2(o[2], o[3]);
              *(uint2*)(Alora + (size_t)tk * 256 + dc) = ov;
            }
          }
        }
      }
      GSYNC();
      {
      PHASE_IDS
        const int nq = 64 * 6, nl = 64 * 4;
        const int total = nq + 3 * nl + (l == 1 ? nl : 0);
        for (int u = bid; u < total; u += nb) {
          f32x4 acc[4][4];
          zero_acc<4>(acc);
          if (u < nq) {
            int tm, tn; TILE_MAP(u, 64, tm, tn);
            gemm_acc<128>(Cqn + (size_t)tm * 128 * 256, 256, Wt_q + (size_t)tn * 128 * 256, 256, 256, smem, acc);
            const float qs = 0.07216878364870322f * LOG2E;
            const int lane_ = tid & 63, wave_ = tid >> 6, wm_ = wave_ >> 1, wn_ = wave_ & 1, l16_ = lane_ & 15, quad_ = lane_ >> 4;
            const int gc = tn * 128 + wn_ * 64;
            const bool is_rope = (gc % 192) == 128;
#pragma unroll
            for (int i = 0; i < 4; ++i) {
              const int row = tm * 128 + wm_ * 64 + i * 16 + l16_;
              if (is_rope) {
#pragma unroll
                for (int j = 0; j < 2; ++j) {
                  const int fi = j * 16 + quad_ * 4;
                  const float4 cs = *(const float4*)(CosT + row * 32 + fi), sn = *(const float4*)(SinT + row * 32 + fi);
                  const float c4[4] = {cs.x, cs.y, cs.z, cs.w}, s4[4] = {sn.x, sn.y, sn.z, sn.w};
#pragma unroll
                  for (int r = 0; r < 4; ++r) {
                    const float t1 = acc[i][j][r], t2 = acc[i][j + 2][r];
                    acc[i][j][r] = t1 * c4[r] - t2 * s4[r]; acc[i][j + 2][r] = t1 * s4[r] + t2 * c4[r];
                  }
                }
              }
#pragma unroll
              for (int j = 0; j < 4; ++j) *(uint2*)(Qp + (size_t)row * 768 + gc + j * 16 + quad_ * 4) = pack4(acc[i][j] * qs);
            }
          } else if (u < nq + 3 * nl) {
            const int v = u - nq, which = v / nl, w2 = v % nl, tn = w2 % 4, tm = w2 / 4;
            if (which == 0) {
              gemm_acc<128>(Alora + (size_t)tm * 128 * 256, 256, Wt_wup + (size_t)tn * 128 * 64, 64, 64, smem, acc);
              const float* w0 = p.in[22] + l * 512;
              EPI4_FOR(128) {
                const int row = tm * 128 + EPI_ROW, n = tn * 128 + EPI4_COL(128);
                const float4 b4 = *(const float4*)(w0 + n);
                *(uint2*)(Pm + (size_t)row * PLD + PC_RW + n) = pack4(acc[i][j] + f32x4{b4.x, b4.y, b4.z, b4.w});
              }
            } else if (which == 1) {
              gemm_acc<128>(Alora + (size_t)tm * 128 * 256 + 64, 256, Wt_aup + (size_t)tn * 128 * 64, 64, 64, smem, acc);
              const float* a0 = p.in[24] + l * 512;
              EPI4_FOR(128) {
                const int row = tm * 128 + EPI_ROW, n = tn * 128 + EPI4_COL(128);
                const float4 b4 = *(const float4*)(a0 + n);
                f32x4 v = acc[i][j] + f32x4{b4.x, b4.y, b4.z, b4.w};
#pragma unroll
                for (int r = 0; r < 4; ++r) v[r] = sigm(v[r]);
                *(uint2*)(Pm + (size_t)row * PLD + PC_RW + 512 + n) = pack4(v);
              }
            } else {
              gemm_acc<128>(Alora + (size_t)tm * 128 * 256 + 128, 256, Wt_gup + (size_t)tn * 128 * 128, 128, 128, smem, acc);
              EPI4_FOR(128) {
                const int row = tm * 128 + EPI_ROW, n = tn * 128 + EPI4_COL(128);
                *(uint2*)(Pm + (size_t)row * PLD + PC_RW + 1024 + n) = pack4(acc[i][j]);
              }
            }
          } else {
            const int w2 = u - nq - 3 * nl, tn = w2 % 4, tm = w2 / 4;
            gemm_acc<128>(Hh + (size_t)tm * 128 * 1024, 1024, Wt_v + (size_t)tn * 128 * 1024, 1024, 1024, smem, acc);
            const float* vb = p.in[34];
            EPI4_FOR(128) {
              const int row = tm * 128 + EPI_ROW, n = tn * 128 + EPI4_COL(128);
              const float4 b4 = *(const float4*)(vb + n);
              const f32x4 lg = acc[i][j] + f32x4{b4.x, b4.y, b4.z, b4.w};
              const f32x4 vc = unpack4(*(const uint2*)(RKV + (size_t)row * 1536 + 1024 + n));
              const f32x4 vf = unpack4(*(const uint2*)(Vfirst + ((size_t)half * TH + row) * 512 + n));
              f32x4 o;
#pragma unroll
              for (int r = 0; r < 4; ++r) o[r] = vc[r] + (vf[r] - vc[r]) * sigm(lg[r]);
              *(uint2*)(RKV + (size_t)row * 1536 + 1024 + n) = pack4(o);
            }
          }
        }
      }
      GSYNC();
      {
        for (int u = bid; u < 64 + 64 + 16 + 256; u += nb) {
          if (u < 64) rwkv_scan_unit(p, l, u, smem);
          else if (u < 128) hgrn_scan_unit(p, l, u - 64, smem);
          else if (u < 144) s5_scan_unit(p, l, u - 128, smem);
          else {
            const int it = u - 144, qt = 31 - (it >> 3), bl = (it >> 2) & 1, hh = it & 3;
            attn_item<192, true>(Qp + (size_t)bl * SEQ * 768 + hh * 192, 768, KVlat + (size_t)bl * SEQ * 192, 192,
                                 VTm + (size_t)bl * 128 * SEQ, SEQ, (qt * 128 + 128) / 64, qt * 128,
                                 Pm + (size_t)bl * SEQ * PLD + hh * 128, PLD, smem);
          }
        }
      }
      GSYNC();
      {
      PHASE_IDS
        const int nglu = 64 * 4;
        for (int u = bid; u < nglu; u += nb) {
          int tm, tn; TILE_MAP(u, 64, tm, tn);
          f32x4 acc[4][4];
          zero_acc<4>(acc);
          gemm_acc<128>(Zs5 + (size_t)tm * 128 * 512, 512, Wt_glu + (size_t)tn * 128 * 512, 512, 512, smem, acc);
          const float* bg = p.in[20] + l * 512;
          EPI4_FOR(128) {
            const int row = tm * 128 + EPI_ROW, n = tn * 128 + EPI4_COL(128);
            const f32x4 z = unpack4(*(const uint2*)(Zs5 + (size_t)row * 512 + n));
            const float4 b4 = *(const float4*)(bg + n);
            const f32x4 lg = acc[i][j] + f32x4{b4.x, b4.y, b4.z, b4.w};
            f32x4 o;
#pragma unroll
            for (int r = 0; r < 4; ++r) o[r] = z[r] * sigm(lg[r]);
            *(uint2*)(Pm + (size_t)row * PLD + PC_S5 + n) = pack4(o);
          }
        }
        const float* k_a = p.in[28] + l * 512;
        const float* r_k = p.in[29] + l * 512;
        const float* ln_w = p.in[30] + l * 512;
        const float* ln_b = p.in[31] + l * 512;
        const float* o_norm = p.in[10] + l * 512;
        for (int tk = bid * 4 + wave; tk < TH; tk += nb * 4) {
          const int c0 = lane * 8;
          {
            const float4 y0 = *(const float4*)(Yrw + (size_t)tk * 512 + c0), y1 = *(const float4*)(Yrw + (size_t)tk * 512 + c0 + 4);
            const float y[8] = {y0.x, y0.y, y0.z, y0.w, y1.x, y1.y, y1.z, y1.w};
            const uint4 ru = *(const uint4*)(RKV + (size_t)tk * 1536 + c0);
            const uint4 ku = *(const uint4*)(RKV + (size_t)tk * 1536 + 512 + c0);
            const uint4 vu = *(const uint4*)(RKV + (size_t)tk * 1536 + 1024 + c0);
            const uint4 au = *(const uint4*)(Pm + (size_t)tk * PLD + PC_RW + 512 + c0);
            const uint4 gu = *(const uint4*)(Pm + (size_t)tk * PLD + PC_RW + 1024 + c0);
            const unsigned ra[4] = {ru.x, ru.y, ru.z, ru.w}, ka[4] = {ku.x, ku.y, ku.z, ku.w}, va[4] = {vu.x, vu.y, vu.z, vu.w};
            const unsigned aa[4] = {au.x, au.y, au.z, au.w}, ga[4] = {gu.x, gu.y, gu.z, gu.w};
            float rr[8], kh[8], vv[8], gg[8];
            float sm1 = 0.f, bsum = 0.f;
#pragma unroll
            for (int e = 0; e < 8; ++e) {
              const unsigned sh = (e & 1);
              rr[e] = sh ? bfhi(ra[e >> 1]) : bflo(ra[e >> 1]);
              const float kx = sh ? bfhi(ka[e >> 1]) : bflo(ka[e >> 1]);
              vv[e] = sh ? bfhi(va[e >> 1]) : bflo(va[e >> 1]);
              const float a = sh ? bfhi(aa[e >> 1]) : bflo(aa[e >> 1]);
              gg[e] = sh ? bfhi(ga[e >> 1]) : bflo(ga[e >> 1]);
              kh[e] = kx * (1.f + (a - 1.f) * k_a[c0 + e]);
              sm1 += y[e];
              bsum += rr[e] * kh[e] * r_k[c0 + e];
            }
            sm1 = red8(sm1); bsum = red8(bsum);
            const float mean = sm1 * (1.f / 64.f);
            float vs = 0.f;
#pragma unroll
            for (int e = 0; e < 8; ++e) { const float d = y[e] - mean; vs += d * d; }
            vs = red8(vs);
            const float rstd = rsqrtf(vs * (1.f / 64.f) + 64e-5f);
            float o[8];
#pragma unroll
            for (int e = 0; e < 8; ++e) o[e] = (((y[e] - mean) * rstd) * ln_w[c0 + e] + ln_b[c0 + e] + bsum * vv[e]) * gg[e];
            uint4 ov; ov.x = pack2(o[0], o[1]); ov.y = pack2(o[2], o[3]); ov.z = pack2(o[4], o[5]); ov.w = pack2(o[6], o[7]);
            *(uint4*)(RKV + (size_t)tk * 1536 + c0) = ov;
          }
          {
            bf16_t* op = Pm + (size_t)tk * PLD + PC_HG + 1024 + c0;
            const uint4 ou = *(const uint4*)op;
            const uint4 gu = *(const uint4*)(Pm + (size_t)tk * PLD + PC_HG + 1536 + c0);
            const unsigned oa[4] = {ou.x, ou.y, ou.z, ou.w}, ga[4] = {gu.x, gu.y, gu.z, gu.w};
            float o[8], ss = 0.f;
#pragma unroll
            for (int e = 0; e < 4; ++e) { o[2 * e] = bflo(oa[e]); o[2 * e + 1] = bfhi(oa[e]); }
#pragma unroll
            for (int e = 0; e < 8; ++e) ss += o[e] * o[e];
            ss = red16(ss);
            const float rs = rsqrtf(ss * (1.f / 128.f) + 1e-6f);
            float r8[8];
#pragma unroll
            for (int e = 0; e < 8; ++e) {
              const float gte = (e & 1) ? bfhi(ga[e >> 1]) : bflo(ga[e >> 1]);
              r8[e] = o[e] * rs * o_norm[c0 + e] * sigm(gte);
            }
            uint4 ov; ov.x = pack2(r8[0], r8[1]); ov.y = pack2(r8[2], r8[3]); ov.z = pack2(r8[4], r8[5]); ov.w = pack2(r8[6], r8[7]);
            *(uint4*)op = ov;
          }
        }
      }
      GSYNC();
      {
        for (int u = bid; u < 64 * 16; u += nb) {
          int tm, tn; TILE_MAP(u, 64, tm, tn);
          f32x4 yacc[4][2];
          zero_acc<2>(yacc);
#pragma unroll 1
          for (int m = 0; m < 4; ++m) {
            f32x4 ag[4][2];
            zero_acc<2>(ag);
            gemm_acc<64>(Hh + (size_t)tm * 128 * 1024, 1024, Wt_in + (size_t)(GATE_OFF + m * 1024 + tn * 64) * 1024, 1024, 1024, smem, ag);
#pragma unroll
            for (int i = 0; i < 4; ++i)
#pragma unroll
              for (int j = 0; j < 2; ++j)
#pragma unroll
                for (int r = 0; r < 4; ++r) ag[i][j][r] = sigm(ag[i][j][r]);
            f32x4 ao[4][2];
            zero_acc<2>(ao);
            const bf16_t* Ao; int lda;
            if (m == 0) { Ao = Pm; lda = PLD; }
            else if (m == 1) { Ao = Pm + PC_HG + 1024; lda = PLD; }
            else if (m == 2) { Ao = Pm + PC_S5; lda = PLD; }
            else { Ao = RKV; lda = 1536; }
            gemm_acc<64>(Ao + (size_t)tm * 128 * lda, lda, Wt_br + ((size_t)m * 1024 + tn * 64) * 512, 512, 512, smem, ao);
#pragma unroll
            for (int i = 0; i < 4; ++i)
#pragma unroll
              for (int j = 0; j < 2; ++j)
#pragma unroll
                for (int r = 0; r < 4; ++r) yacc[i][j][r] += ag[i][j][r] * ao[i][j][r];
          }
          {
            f32x4 (&acc)[4][2] = yacc;
            EPI4_FOR(64) {
              const int row = tm * 128 + EPI_ROW, n = tn * 64 + EPI4_COL(64);
              *(uint2*)(Ybr + (size_t)row * 1024 + n) = pack4(acc[i][j]);
            }
          }
        }
      }
      GSYNC();
      {
        for (int u = bid; u < 64 * 8; u += nb) {
          int tm, tn; TILE_MAP(u, 64, tm, tn);
          f32x4 acc[4][4];
          zero_acc<4>(acc);
          gemm_acc<128>(Ybr + (size_t)tm * 128 * 1024, 1024, Wt_out + (size_t)tn * 128 * 1024, 1024, 1024, smem, acc);
          EPI4_FOR(128) {
            const int row = half * TH + tm * 128 + EPI_ROW, n = tn * 128 + EPI4_COL(128);
            float4* xp = (float4*)(X + (size_t)row * 1024 + n);
            float4 xv = *xp; xv.x += acc[i][j][0]; xv.y += acc[i][j][1]; xv.z += acc[i][j][2]; xv.w += acc[i][j][3];
            *xp = xv;
          }
        }
      }
      GSYNC();
    }

    {
      transpose_all(p.in[42] + (size_t)l * 1024 * 1024, 1024, 1024, 1024, Wt_xq, bid, nb, smem);
      transpose_all(p.in[44] + (size_t)l * 1024 * 1024, 1024, 1024, 1024, Wt_xo, bid, nb, smem);
      transpose_all(p.in[46] + (size_t)l * 1024 * 5632, 5632, 1024, 5632, Wt_gu, bid, nb, smem);
      transpose_all(p.in[49] + (size_t)l * 2816 * 1024, 1024, 2816, 1024, Wt_down, bid, nb, smem);
      rmsnorm_rows(X, p.in[40] + l * 1024, Hb, nullptr, T_ALL, bid, nb);
    }
    GSYNC();
    {
      const float qs = 0.0625f * LOG2E;
      for (int u = bid; u < 128 * 8; u += nb) {
        int tm, tn; TILE_MAP(u, 128, tm, tn);
        f32x4 acc[4][4];
        zero_acc<4>(acc);
        gemm_acc<128>(Hb + (size_t)tm * 128 * 1024, 1024, Wt_xq + (size_t)tn * 128 * 1024, 1024, 1024, smem, acc);
        EPI4_FOR(128) {
          const int row = tm * 128 + EPI_ROW, n = tn * 128 + EPI4_COL(128);
          *(uint2*)(Qx + (size_t)row * 1024 + n) = pack4(acc[i][j] * qs);
        }
      }
    }
    GSYNC();
    {
      for (int u = bid; u < 1024; u += nb) {
        const int dvh = u & 1, hh = (u >> 1) & 3, qt = (u >> 3) & 31, b = u >> 8;
        attn_item<256, false>(Qx + (size_t)b * SEQ * 1024 + hh * 256, 1024, Kx + (size_t)(b * 4 + hh) * 65536, 256,
                              VxT + (size_t)(b * 4 + hh) * 65536 + (size_t)dvh * 128 * 256, 256, 4, qt * 128,
                              Ox + (size_t)b * SEQ * 1024 + hh * 256 + dvh * 128, 1024, smem);
      }
    }
    GSYNC();
    {
      for (int u = bid; u < 128 * 8; u += nb) {
        int tm, tn; TILE_MAP(u, 128, tm, tn);
        f32x4 acc[4][4];
        zero_acc<4>(acc);
        gemm_acc<128>(Ox + (size_t)tm * 128 * 1024, 1024, Wt_xo + (size_t)tn * 128 * 1024, 1024, 1024, smem, acc);
        EPI4_FOR(128) {
          const int row = tm * 128 + EPI_ROW, n = tn * 128 + EPI4_COL(128);
          float4* xp = (float4*)(X + (size_t)row * 1024 + n);
          float4 xv = *xp; xv.x += acc[i][j][0]; xv.y += acc[i][j][1]; xv.z += acc[i][j][2]; xv.w += acc[i][j][3];
          *xp = xv;
        }
      }
    }
    GSYNC();
    rmsnorm_rows(X, p.in[45] + l * 1024, Hb, nullptr, T_ALL, bid, nb);
    GSYNC();
    for (int half = 0; half < 2; ++half) {
      const bf16_t* Hh = Hb + (size_t)half * TH * 1024;
      for (int u = bid; u < 64 * 44; u += nb) {
        int tm, tn; TILE_MAP(u, 64, tm, tn);
        f32x4 acc[4][4];
        zero_acc<4>(acc);
        gemm_acc<128>(Hh + (size_t)tm * 128 * 1024, 1024, Wt_gu + (size_t)tn * 128 * 1024, 1024, 1024, smem, acc);
        EPI4_FOR(128) {
          const int row = tm * 128 + EPI_ROW, n = tn * 128 + EPI4_COL(128);
          *(uint2*)(GU + (size_t)row * 5632 + n) = pack4(acc[i][j]);
        }
      }
      GSYNC();
      {
      PHASE_IDS
        const float* cw = p.in[47] + (size_t)l * 3 * D_FF;
        const float* cb = p.in[48] + (size_t)l * D_FF;
        for (int e = bid * 256 + tid; e < TH * 352; e += nb * 256) {
          const int tk = e / 352, c0 = (e % 352) * 8;
          const int s = tk & (SEQ - 1);
          const bf16_t* gp = GU + (size_t)tk * 5632 + c0;
          const uint4 g2 = *(const uint4*)gp;
          uint4 g1 = uint4{0, 0, 0, 0}, g0 = uint4{0, 0, 0, 0};
          if (s >= 1) g1 = *(const uint4*)(gp - 5632);
          if (s >= 2) g0 = *(const uint4*)(gp - 2 * 5632);
          const uint4 uu = *(const uint4*)(gp + D_FF);
          const unsigned a2[4] = {g2.x, g2.y, g2.z, g2.w}, a1[4] = {g1.x, g1.y, g1.z, g1.w}, a0[4] = {g0.x, g0.y, g0.z, g0.w};
          const unsigned au[4] = {uu.x, uu.y, uu.z, uu.w};
          float o[8];
#pragma unroll
          for (int q = 0; q < 8; ++q) {
            const bool hi = q & 1;
            const float x2 = hi ? bfhi(a2[q >> 1]) : bflo(a2[q >> 1]);
            const float x1 = hi ? bfhi(a1[q >> 1]) : bflo(a1[q >> 1]);
            const float x0 = hi ? bfhi(a0[q >> 1]) : bflo(a0[q >> 1]);
            const float up = hi ? bfhi(au[q >> 1]) : bflo(au[q >> 1]);
            const int c = c0 + q;
            const float gv = cw[c] * x0 + cw[D_FF + c] * x1 + cw[2 * D_FF + c] * x2 + cb[c];
            o[q] = gv * sigm(gv) * up;
          }
          uint4 ov; ov.x = pack2(o[0], o[1]); ov.y = pack2(o[2], o[3]); ov.z = pack2(o[4], o[5]); ov.w = pack2(o[6], o[7]);
          *(uint4*)(GU + (size_t)tk * 5632 + D_FF + c0) = ov;
        }
      }
      GSYNC();
      for (int u = bid; u < 64 * 8; u += nb) {
        int tm, tn; TILE_MAP(u, 64, tm, tn);
        f32x4 acc[4][4];
        zero_acc<4>(acc);
        gemm_acc<128>(GU + (size_t)tm * 128 * 5632 + D_FF, 5632, Wt_down + (size_t)tn * 128 * 2816, 2816, 2816, smem, acc);
        EPI4_FOR(128) {
          const int row = half * TH + tm * 128 + EPI_ROW, n = tn * 128 + EPI4_COL(128);
          float4* xp = (float4*)(X + (size_t)row * 1024 + n);
          float4 xv = *xp; xv.x += acc[i][j][0]; xv.y += acc[i][j][1]; xv.z += acc[i][j][2]; xv.w += acc[i][j][3];
          *xp = xv;
        }
      }
      GSYNC();
    }
  }

  {
      PHASE_IDS
    const float* g = p.in[50];
    for (int r = bid * 4 + wave; r < T_ALL; r += nb * 4) {
      float4* xr = (float4*)(X + (size_t)r * 1024);
      float4 v[4]; float ss = 0.f;
#pragma unroll
      for (int i = 0; i < 4; ++i) { v[i] = xr[lane + 64 * i]; ss += v[i].x * v[i].x + v[i].y * v[i].y + v[i].z * v[i].z + v[i].w * v[i].w; }
      ss = wave_sum(ss);
      const float rs = rsqrtf(ss * (1.f / 1024.f) + 1e-6f);
#pragma unroll
      for (int i = 0; i < 4; ++i) {
        const float4 gg = ((const float4*)g)[lane + 64 * i];
        xr[lane + 64 * i] = float4{v[i].x * rs * gg.x, v[i].y * rs * gg.y, v[i].z * rs * gg.z, v[i].w * rs * gg.w};
      }
    }
  }
}

extern "C" void kernel_launch(void* const* d_in, const int* in_sizes, int n_in, void* d_out, int out_size, void* d_ws, size_t ws_size,
                              hipStream_t stream) {
  static int grid_blocks = 0;
  if (!grid_blocks) {
    int dev = 0, cus = 0, per_cu = 0;
    hipGetDevice(&dev);
    hipDeviceGetAttribute(&cus, hipDeviceAttributeMultiprocessorCount, dev);
    hipOccupancyMaxActiveBlocksPerMultiprocessor(&per_cu, mega_kernel, 256, 0);
    if (per_cu > 2) per_cu = 2;
    if (per_cu < 1) per_cu = 1;
    grid_blocks = cus * per_cu;
  }
  if (ws_size < WS_NEED) fprintf(stderr, "workspace too small: %zu < %zu\n", ws_size, (size_t)WS_NEED);
  Params p{};
  for (int i = 0; i < 51; ++i) p.in[i] = (const float*)d_in[i];
  p.pos = (const int*)d_in[2];
  p.out = (float*)d_out;
  p.ws = (char*)d_ws;
  hipMemsetAsync((char*)d_ws + OFF_BAR, 0, 16384, stream);
  void* args[] = {&p};
  hipError_t e = hipLaunchCooperativeKernel((void*)mega_kernel, dim3(grid_blocks), dim3(256), args, 0, stream);
  if (e != hipSuccess) fprintf(stderr, "cooperative launch failed: %s (grid %d)\n", hipGetErrorString(e), grid_blocks);
}
```

```cpp
#include <hip/hip_runtime.h>
#include <hip/hip_cooperative_groups.h>
#include <cstdio>
#include <cstdint>
namespace cg = cooperative_groups;

typedef unsigned short bf16_t;
using bf16x8 = __attribute__((ext_vector_type(8))) short;
using s16x4 = __attribute__((ext_vector_type(4))) short;
using f32x4 = __attribute__((ext_vector_type(4))) float;
using f32x16 = __attribute__((ext_vector_type(16))) float;
using u32x4 = __attribute__((ext_vector_type(4))) unsigned;
#define DI __device__ __forceinline__

constexpr int T_ALL = 16384, SEQ = 4096, DM = 1024, TH = 8192;
constexpr int P_IN = 8896, GATE_OFF = 4800;
constexpr int PLD = 4864;
constexpr int PC_HG = 512, PC_S5 = 2560, PC_RW = 3072;
constexpr int D_FF = 2816;

constexpr size_t al256(size_t x) { return (x + 255) & ~(size_t)255; }
constexpr size_t OFF_WIN = 0;
constexpr size_t OFF_WQ = OFF_WIN + al256((size_t)P_IN * 1024 * 2);
constexpr size_t OFF_WBR = OFF_WQ + al256((size_t)768 * 256 * 2);
constexpr size_t OFF_WOUT = OFF_WBR + al256((size_t)4 * 1024 * 512 * 2);
constexpr size_t OFF_WGLU = OFF_WOUT + al256((size_t)1024 * 1024 * 2);
constexpr size_t OFF_WWUP = OFF_WGLU + al256((size_t)512 * 512 * 2);
constexpr size_t OFF_WAUP = OFF_WWUP + al256((size_t)512 * 64 * 2);
constexpr size_t OFF_WGUP = OFF_WAUP + al256((size_t)512 * 64 * 2);
constexpr size_t OFF_WV = OFF_WGUP + al256((size_t)512 * 128 * 2);
constexpr size_t OFF_WXKV = OFF_WV + al256((size_t)512 * 1024 * 2);
constexpr size_t OFF_S5AB = OFF_WXKV + al256((size_t)2048 * 1024 * 2);
constexpr size_t OFF_S5BB = OFF_S5AB + al256((size_t)32 * 64 * 2 * 4);
constexpr size_t OFF_H = OFF_S5BB + al256((size_t)32 * 64 * 32 * 4);
constexpr size_t OFF_VFIRST = OFF_H + al256((size_t)T_ALL * 1024 * 2);
constexpr size_t OFF_KX = OFF_VFIRST + al256((size_t)T_ALL * 512 * 2);
constexpr size_t OFF_VXT = OFF_KX + al256((size_t)16 * 256 * 256 * 2);
constexpr size_t OFF_HM = OFF_VXT + al256((size_t)16 * 256 * 256 * 2);
constexpr size_t OFF_COS = OFF_HM + al256((size_t)1024 * 1024 * 2);
constexpr size_t OFF_SIN = OFF_COS + al256((size_t)TH * 32 * 4);
constexpr size_t OFF_BAR = OFF_SIN + al256((size_t)TH * 32 * 4);
constexpr size_t OFF_REG = OFF_BAR + 16384;
constexpr size_t R_P = OFF_REG;
constexpr size_t R_CQN = R_P + al256((size_t)TH * PLD * 2);
constexpr size_t R_QP = R_CQN + (size_t)TH * 256 * 2;
constexpr size_t R_KVLAT = R_QP + al256((size_t)TH * 768 * 2);
constexpr size_t R_VT = R_KVLAT + al256((size_t)TH * 192 * 2);
constexpr size_t R_RKV = R_VT + al256((size_t)2 * 128 * 4096 * 2);
constexpr size_t R_ALORA = R_RKV + al256((size_t)TH * 1536 * 2);
constexpr size_t R_YRW = R_ALORA + al256((size_t)TH * 256 * 2);
constexpr size_t R_ZS5 = R_YRW + al256((size_t)TH * 512 * 4);
constexpr size_t R_OHG = R_ZS5 + al256((size_t)TH * 512 * 2);
constexpr size_t R_END1 = R_OHG + al256((size_t)TH * 512 * 2);
constexpr size_t R_YBR = R_CQN;
constexpr size_t R_WXQ = OFF_REG;
constexpr size_t R_WXO = R_WXQ + al256((size_t)1024 * 1024 * 2);
constexpr size_t R_WGU = R_WXO + al256((size_t)1024 * 1024 * 2);
constexpr size_t R_WDOWN = R_WGU + al256((size_t)5632 * 1024 * 2);
constexpr size_t R_QX = R_WDOWN + al256((size_t)1024 * 2816 * 2);
constexpr size_t R_OX = R_QX + al256((size_t)T_ALL * 1024 * 2);
constexpr size_t R_GU = R_QX;
constexpr size_t R_END2 = R_GU + al256((size_t)TH * 5632 * 2);
constexpr size_t WS_NEED = (R_END1 > R_END2 ? R_END1 : R_END2);

constexpr int SMEM_BYTES = 73728;

struct Params {
  const float* in[51];
  const int* pos;
  float* out;
  char* ws;
};

DI bf16_t f2bf(float x) { unsigned u = __float_as_uint(x); u += 0x7fffu + ((u >> 16) & 1u); return (bf16_t)(u >> 16); }
DI float bf2f(bf16_t b) { return __uint_as_float(((unsigned)b) << 16); }
DI unsigned pack2(float a, float b) { return (unsigned)f2bf(a) | ((unsigned)f2bf(b) << 16); }
DI float bflo(unsigned u) { return __uint_as_float(u << 16); }
DI float bfhi(unsigned u) { return __uint_as_float(u & 0xffff0000u); }
DI float sigm(float x) { return 1.f / (1.f + __expf(-x)); }
template <int CTRL> DI float dppf(float v) {
  return __builtin_bit_cast(float, __builtin_amdgcn_update_dpp(0, __builtin_bit_cast(int, v), CTRL, 0xf, 0xf, false));
}
DI float red8(float v) { v += dppf<0xB1>(v); v += dppf<0x4E>(v); v += dppf<0x141>(v); return v; }
DI float red16(float v) { v = red8(v); v += dppf<0x140>(v); return v; }
DI int TID() { int t = threadIdx.x; asm volatile("" : "+v"(t)); return t; }
#define PHASE_IDS const int tid = TID(); const int lane = tid & 63, wave = tid >> 6; (void)lane; (void)wave;
DI float wave_sum(float v) { for (int o = 32; o > 0; o >>= 1) v += __shfl_xor(v, o); return v; }


#define XB_TMO      128
#define XB_XCNT(j)  (256  + 64 * (j))
#define XB_XSUB(j)  (1280 + 64 * (j))
#define XB_XGEN(j)  (2304 + 64 * (j))
#define XB_TOP      3328
#define XB_TOPGEN   3392
#define XCD_BAR_WORDS 3456
#define XB_SPIN_CAP (1u << 22)
#define LAS __attribute__((address_space(3)))
DI unsigned xb_ld(unsigned* p) { return __hip_atomic_load(p, __ATOMIC_RELAXED, __HIP_MEMORY_SCOPE_AGENT); }
DI unsigned xb_add(unsigned* p, unsigned v) { return __hip_atomic_fetch_add(p, v, __ATOMIC_RELAXED, __HIP_MEMORY_SCOPE_AGENT); }
DI unsigned xb_xcc_id() { return (unsigned)__builtin_amdgcn_s_getreg((3 << 11) | 20) & 0xFu; }
#define XB_SPIN(cond, bar) do { unsigned _sp = 0; while (cond) { __builtin_amdgcn_s_sleep(1); \
    if ((++_sp & 255u) == 0u) { if (xb_ld(&(bar)[XB_TMO])) break; if (_sp > XB_SPIN_CAP) { atomicAdd(&(bar)[XB_TMO], 1u); break; } } } } while (0)
struct XcdBarrier { unsigned* bar; unsigned x; volatile LAS unsigned* st; };
DI XcdBarrier xcd_barrier_post(unsigned* bar, volatile LAS unsigned* st) {
  XcdBarrier b; b.bar = bar; b.x = xb_xcc_id(); b.st = st;
  if (threadIdx.x == 0) (void)xb_add(&bar[XB_XCNT(b.x)], 1u);
  return b;
}
DI void xcd_barrier_complete(unsigned* bar, unsigned x, unsigned& nloc, unsigned& nx) {
  const unsigned G = gridDim.x * gridDim.y * gridDim.z;
  unsigned sum, cnt, mine, sp = 0u;
  for (;;) {
    sum = 0u; cnt = 0u; mine = 0u;
#pragma unroll
    for (unsigned j = 0; j < 16; ++j) { const unsigned c = xb_ld(&bar[XB_XCNT(j)]); sum += c; cnt += (c > 0u) ? 1u : 0u; mine = (j == x) ? c : mine; }
    if (sum == G) break;
    __builtin_amdgcn_s_sleep(1);
    if ((++sp & 255u) == 0u) { if (xb_ld(&bar[XB_TMO])) break; if (sp > XB_SPIN_CAP) { atomicAdd(&bar[XB_TMO], 1u); break; } }
  }
  nloc = mine > 0u ? mine : 1u; nx = cnt > 0u ? cnt : 1u;
}
DI void xcd_barrier(const XcdBarrier& b) {
  asm volatile("s_waitcnt vmcnt(0)" ::: "memory");
  __syncthreads();
  if (threadIdx.x == 0) {
    unsigned* bar = b.bar;
    __builtin_amdgcn_s_waitcnt(0);
    unsigned nloc = b.st[0], nx = b.st[1];
    if (nloc == 0u) { xcd_barrier_complete(bar, b.x, nloc, nx); b.st[0] = nloc; b.st[1] = nx; }
    const unsigned old = xb_add(&bar[XB_XSUB(b.x)], 1u);
    const unsigned gen = old / nloc;
    if (old + 1u == (gen + 1u) * nloc) {
      __builtin_amdgcn_fence(__ATOMIC_RELEASE, "agent");
      asm volatile("s_waitcnt vmcnt(0)" ::: "memory");
      const unsigned og = xb_add(&bar[XB_TOP], 1u);
      const unsigned tg = og / nx;
      if (og + 1u == (tg + 1u) * nx) xb_add(&bar[XB_TOPGEN], 1u);
      else XB_SPIN(xb_ld(&bar[XB_TOPGEN]) == tg, bar);
      __builtin_amdgcn_fence(__ATOMIC_ACQUIRE, "agent");
      xb_add(&bar[XB_XGEN(b.x)], 1u);
      asm volatile("s_waitcnt vmcnt(0)" ::: "memory");
    } else {
      XB_SPIN(xb_ld(&bar[XB_XGEN(b.x)]) == gen, bar);
      __builtin_amdgcn_fence(__ATOMIC_ACQUIRE, "agent");
      asm volatile("s_waitcnt vmcnt(0)" ::: "memory");
    }
  }
  __syncthreads();
}

#define GLOAD16(dst, ptr) asm volatile("global_load_dwordx4 %0, %1, off" : "=v"(dst) : "v"(ptr))
template <int BN>
DI void gemm_acc(const bf16_t* __restrict__ A, int lda, const bf16_t* __restrict__ Bt, int ldb, int K, char* smem,
                 f32x4 (&acc)[4][BN / 32]) {
  constexpr int A_EL = 128 * 72, B_EL = BN * 72, BUF_EL = A_EL + B_EL;
  constexpr int NJ = BN / 32, BCH = BN / 32;
  bf16_t* sm = (bf16_t*)smem;
  const int tid = TID(), lane = tid & 63, wave = tid >> 6;
  const int wm = wave >> 1, wn = wave & 1, l16 = lane & 15, quad = lane >> 4;
  const int crow = tid >> 3, ccol = (tid & 7) * 8;
  u32x4 ra[4], rb[BCH];
  const bf16_t* Ap = A + (size_t)crow * lda + ccol;
  const bf16_t* Bp = Bt + (size_t)crow * ldb + ccol;
  const int nk = K >> 6;
#define GEMM_ISSUE(k0_)                                                                           \
  {                                                                                               \
    _Pragma("unroll") for (int i = 0; i < 4; ++i) GLOAD16(ra[i], Ap + (size_t)(32 * i) * lda + (k0_));   \
    _Pragma("unroll") for (int i = 0; i < BCH; ++i) GLOAD16(rb[i], Bp + (size_t)(32 * i) * ldb + (k0_)); \
  }
#define GEMM_LAND(buf_)                                                                           \
  {                                                                                               \
    if constexpr (BCH == 4)                                                                       \
      asm volatile("s_waitcnt vmcnt(0)" : "+v"(ra[0]), "+v"(ra[1]), "+v"(ra[2]), "+v"(ra[3]), "+v"(rb[0]), "+v"(rb[1]), "+v"(rb[2]), "+v"(rb[3])); \
    else                                                                                          \
      asm volatile("s_waitcnt vmcnt(0)" : "+v"(ra[0]), "+v"(ra[1]), "+v"(ra[2]), "+v"(ra[3]), "+v"(rb[0]), "+v"(rb[1])); \
    bf16_t* sa_ = sm + (buf_) * BUF_EL; bf16_t* sb_ = sa_ + A_EL;                                 \
    _Pragma("unroll") for (int i = 0; i < 4; ++i) *(u32x4*)(sa_ + (crow + 32 * i) * 72 + ccol) = ra[i];   \
    _Pragma("unroll") for (int i = 0; i < BCH; ++i) *(u32x4*)(sb_ + (crow + 32 * i) * 72 + ccol) = rb[i]; \
  }
  GEMM_ISSUE(0);
  GEMM_LAND(0);
  __syncthreads();
  for (int kt = 0; kt < nk; ++kt) {
    {
      const int k0 = ((kt + 1 < nk) ? (kt + 1) : kt) << 6;
      GEMM_ISSUE(k0);
    }
    __builtin_amdgcn_sched_barrier(0);
    {
      const bf16_t* sa = sm + (kt & 1) * BUF_EL; const bf16_t* sb = sa + A_EL;
#pragma unroll
      for (int ks = 0; ks < 2; ++ks) {
        bf16x8 a[4], b[NJ];
#pragma unroll
        for (int i = 0; i < 4; ++i) a[i] = *(const bf16x8*)(sa + (wm * 64 + i * 16 + l16) * 72 + ks * 32 + quad * 8);
#pragma unroll
        for (int j = 0; j < NJ; ++j) b[j] = *(const bf16x8*)(sb + (wn * (BN / 2) + j * 16 + l16) * 72 + ks * 32 + quad * 8);
#pragma unroll
        for (int i = 0; i < 4; ++i)
#pragma unroll
          for (int j = 0; j < NJ; ++j) acc[i][j] = __builtin_amdgcn_mfma_f32_16x16x32_bf16(b[j], a[i], acc[i][j], 0, 0, 0);
      }
    }
    __builtin_amdgcn_sched_barrier(0);
    GEMM_LAND((kt + 1) & 1);
    __syncthreads();
  }
#undef GEMM_ISSUE
#undef GEMM_LAND
}
template <int NJ> DI void zero_acc(f32x4 (&acc)[4][NJ]) {
#pragma unroll
  for (int i = 0; i < 4; ++i)
#pragma unroll
    for (int j = 0; j < NJ; ++j) acc[i][j] = f32x4{0.f, 0.f, 0.f, 0.f};
}
#define EPI_FOR(BN_)                                                                         \
  const int _t = TID(); const int _lane = _t & 63, _wave = _t >> 6;                              \
  const int _wm = _wave >> 1, _wn = _wave & 1, _l16 = _lane & 15, _quad = _lane >> 4;        \
  _Pragma("unroll") for (int i = 0; i < 4; ++i)                                              \
  _Pragma("unroll") for (int j = 0; j < (BN_) / 32; ++j)                                     \
  _Pragma("unroll") for (int r = 0; r < 4; ++r)
#define EPI_ROW (_wm * 64 + i * 16 + _l16)
#define EPI_COL(BN_) (_wn * ((BN_) / 2) + j * 16 + _quad * 4 + r)
#define EPI4_FOR(BN_)                                                                        \
  const int _t = TID(); const int _lane = _t & 63, _wave = _t >> 6;                          \
  const int _wm = _wave >> 1, _wn = _wave & 1, _l16 = _lane & 15, _quad = _lane >> 4;        \
  _Pragma("unroll") for (int i = 0; i < 4; ++i)                                              \
  _Pragma("unroll") for (int j = 0; j < (BN_) / 32; ++j)
#define EPI4_COL(BN_) (_wn * ((BN_) / 2) + j * 16 + _quad * 4)
DI uint2 pack4(f32x4 v) { uint2 o; o.x = pack2(v[0], v[1]); o.y = pack2(v[2], v[3]); return o; }
DI f32x4 unpack4(uint2 u) { return f32x4{bflo(u.x), bfhi(u.x), bflo(u.y), bfhi(u.y)}; }

DI void transpose_tile(const float* __restrict__ W, int ldw, bf16_t* __restrict__ Wt, int ldt, int k0, int n0, char* smem) {
  float* sm = (float*)smem;
  const int tid = TID();
  __syncthreads();
#pragma unroll
  for (int i = 0; i < 4; ++i) {
    const int k = (tid >> 4) + 16 * i, n4 = (tid & 15) * 4;
    const float4 v = *(const float4*)(W + (size_t)(k0 + k) * ldw + n0 + n4);
    sm[k * 65 + n4 + 0] = v.x; sm[k * 65 + n4 + 1] = v.y; sm[k * 65 + n4 + 2] = v.z; sm[k * 65 + n4 + 3] = v.w;
  }
  __syncthreads();
  const int n = tid >> 2, ks = (tid & 3) * 16;
  unsigned u[8];
#pragma unroll
  for (int e = 0; e < 8; ++e) u[e] = pack2(sm[(ks + 2 * e) * 65 + n], sm[(ks + 2 * e + 1) * 65 + n]);
  uint4* dst = (uint4*)(Wt + (size_t)(n0 + n) * ldt + k0 + ks);
  dst[0] = uint4{u[0], u[1], u[2], u[3]};
  dst[1] = uint4{u[4], u[5], u[6], u[7]};
}
DI void transpose_all(const float* W, int ldw, int K, int N, bf16_t* Wt, int bid, int nb, char* smem) {
  const int tk = K >> 6, tn = N >> 6;
  for (int t = bid; t < tk * tn; t += nb) transpose_tile(W, ldw, Wt, K, (t % tk) * 64, (t / tk) * 64, smem);
}

DI void rmsnorm_rows(const float* __restrict__ x, const float* __restrict__ g, bf16_t* __restrict__ h, float* xcopy, int rows,
                     int bid, int nb) {
  const int lane = TID() & 63, wave = TID() >> 6;
  for (int r = bid * 4 + wave; r < rows; r += nb * 4) {
    const float4* xr = (const float4*)(x + (size_t)r * 1024);
    float4 v[4]; float ss = 0.f;
#pragma unroll
    for (int i = 0; i < 4; ++i) { v[i] = xr[lane + 64 * i]; ss += v[i].x * v[i].x + v[i].y * v[i].y + v[i].z * v[i].z + v[i].w * v[i].w; }
    ss = wave_sum(ss);
    const float rs = rsqrtf(ss * (1.f / 1024.f) + 1e-6f);
#pragma unroll
    for (int i = 0; i < 4; ++i) {
      const float4 gg = ((const float4*)g)[lane + 64 * i];
      uint2 o; o.x = pack2(v[i].x * rs * gg.x, v[i].y * rs * gg.y); o.y = pack2(v[i].z * rs * gg.z, v[i].w * rs * gg.w);
      *(uint2*)(h + (size_t)r * 1024 + (lane + 64 * i) * 4) = o;
      if (xcopy) ((float4*)(xcopy + (size_t)r * 1024))[lane + 64 * i] = v[i];
    }
  }
}

template <int DQK, bool CAUSAL>
DI void attn_item(const bf16_t* __restrict__ Q, int ldq, const bf16_t* __restrict__ Kp, int ldk, const bf16_t* __restrict__ VT, int ldvt,
                  int ntiles, int q0, bf16_t* __restrict__ out, int ldo, char* smem) {
  constexpr int KS = DQK + 8, NS = DQK / 16, KCH = DQK / 8;
  bf16_t* Ks = (bf16_t*)smem;
  bf16_t* Vs = Ks + 64 * KS;
  const int tid = TID(), lane = tid & 63, wave = tid >> 6, ql = lane & 31, hh = lane >> 5;
  const int qrow = q0 + wave * 32 + ql;
  bf16x8 bq[NS];
#pragma unroll
  for (int s = 0; s < NS; ++s) bq[s] = *(const bf16x8*)(Q + (size_t)qrow * ldq + s * 16 + hh * 8);
  f32x16 ot[4];
#pragma unroll
  for (int d = 0; d < 4; ++d)
#pragma unroll
    for (int i = 0; i < 16; ++i) ot[d][i] = 0.f;
  float mrun = -INFINITY, lrun = 0.f;
  for (int kt = 0; kt < ntiles; ++kt) {
    __syncthreads();
    for (int c = tid; c < 64 * KCH; c += 256) {
      const int row = c / KCH, cc = c % KCH;
      *(uint4*)(Ks + row * KS + cc * 8) = *(const uint4*)(Kp + (size_t)(kt * 64 + row) * ldk + cc * 8);
    }
#pragma unroll
    for (int c0 = 0; c0 < 4; ++c0) {
      const int c = tid + c0 * 256, row = c >> 3, cc = c & 7;
      *(uint4*)(Vs + row * 72 + cc * 8) = *(const uint4*)(VT + (size_t)row * ldvt + kt * 64 + cc * 8);
    }
    __syncthreads();
    f32x16 st[2];
#pragma unroll
    for (int kb = 0; kb < 2; ++kb) {
#pragma unroll
      for (int i = 0; i < 16; ++i) st[kb][i] = 0.f;
#pragma unroll
      for (int s = 0; s < NS; ++s) {
        const bf16x8 a = *(const bf16x8*)(Ks + (kb * 32 + ql) * KS + s * 16 + hh * 8);
        st[kb] = __builtin_amdgcn_mfma_f32_32x32x16_bf16(a, bq[s], st[kb], 0, 0, 0);
      }
    }
    float mx = -INFINITY;
#pragma unroll
    for (int kb = 0; kb < 2; ++kb)
#pragma unroll
      for (int i = 0; i < 16; ++i) {
        if (CAUSAL) {
          const int key = kt * 64 + kb * 32 + (i & 3) + 8 * (i >> 2) + 4 * hh;
          if (key > qrow) st[kb][i] = -INFINITY;
        }
        mx = fmaxf(mx, st[kb][i]);
      }
    mx = fmaxf(mx, __shfl_xor(mx, 32));
    const float mnew = fmaxf(mrun, mx);
    const float alpha = exp2f(mrun - mnew);
    float ps = 0.f;
#pragma unroll
    for (int kb = 0; kb < 2; ++kb)
#pragma unroll
      for (int i = 0; i < 16; ++i) { const float pv = exp2f(st[kb][i] - mnew); st[kb][i] = pv; ps += pv; }
    ps += __shfl_xor(ps, 32);
    lrun = lrun * alpha + ps;
    mrun = mnew;
#pragma unroll
    for (int d = 0; d < 4; ++d)
#pragma unroll
      for (int i = 0; i < 16; ++i) ot[d][i] *= alpha;
#pragma unroll
    for (int kb = 0; kb < 2; ++kb)
#pragma unroll
      for (int s2 = 0; s2 < 2; ++s2) {
        unsigned pk[4];
#pragma unroll
        for (int e = 0; e < 4; ++e) pk[e] = pack2(st[kb][8 * s2 + 2 * e], st[kb][8 * s2 + 2 * e + 1]);
        const bf16x8 pb = __builtin_bit_cast(bf16x8, uint4{pk[0], pk[1], pk[2], pk[3]});
#pragma unroll
        for (int d = 0; d < 4; ++d) {
          const bf16_t* vp = Vs + (d * 32 + ql) * 72 + kb * 32 + s2 * 16 + hh * 4;
          const s16x4 lo = *(const s16x4*)vp;
          const s16x4 hi = *(const s16x4*)(vp + 8);
          const bf16x8 av = __builtin_shufflevector(lo, hi, 0, 1, 2, 3, 4, 5, 6, 7);
          ot[d] = __builtin_amdgcn_mfma_f32_32x32x16_bf16(av, pb, ot[d], 0, 0, 0);
        }
      }
  }
  const float inv = 1.f / lrun;
#pragma unroll
  for (int d = 0; d < 4; ++d)
#pragma unroll
    for (int g4 = 0; g4 < 4; ++g4) {
      uint2 o; o.x = pack2(ot[d][4 * g4] * inv, ot[d][4 * g4 + 1] * inv); o.y = pack2(ot[d][4 * g4 + 2] * inv, ot[d][4 * g4 + 3] * inv);
      *(uint2*)(out + (size_t)qrow * ldo + d * 32 + 8 * g4 + 4 * hh) = o;
    }
}

DI void rwkv_scan_unit(const Params& p, int l, int u, char* smem) {
  const int tid = TID();
  const int bl = u >> 5, hd = (u >> 2) & 7, rg = u & 3;
  const int kq = tid & 15, g16 = tid >> 4;
  const bf16_t* RKV = (const bf16_t*)(p.ws + R_RKV) + (size_t)bl * SEQ * 1536;
  const bf16_t* Pm = (const bf16_t*)(p.ws + R_P) + (size_t)bl * SEQ * PLD;
  float* Y = (float*)(p.ws + R_YRW) + (size_t)bl * SEQ * 512;
  float* sm = (float*)smem;
  constexpr int BUFF = 5 * 1024 + 256 + 32;
  const int kc = hd * 64 + kq * 4;
  const float4 kk_w = *(const float4*)(p.in[27] + l * 512 + kc);
  const float4 ka_w = *(const float4*)(p.in[28] + l * 512 + kc);
  float S0 = 0.f, S1 = 0.f, S2 = 0.f, S3 = 0.f;
  uint2 g_r, g_k, g_w, g_a; bf16_t g_v;
  auto gload = [&](int c) {
    const int tok = c * 16 + g16;
    g_r = *(const uint2*)(RKV + (size_t)tok * 1536 + kc);
    g_k = *(const uint2*)(RKV + (size_t)tok * 1536 + 512 + kc);
    g_v = RKV[(size_t)tok * 1536 + 1024 + hd * 64 + rg * 16 + kq];
    g_w = *(const uint2*)(Pm + (size_t)tok * PLD + PC_RW + kc);
    g_a = *(const uint2*)(Pm + (size_t)tok * PLD + PC_RW + 512 + kc);
  };
  auto derive = [&](int buf) {
    float* b = sm + buf * BUFF;
    const float r[4] = {bflo(g_r.x), bfhi(g_r.x), bflo(g_r.y), bfhi(g_r.y)};
    const float k[4] = {bflo(g_k.x), bfhi(g_k.x), bflo(g_k.y), bfhi(g_k.y)};
    const float w[4] = {bflo(g_w.x), bfhi(g_w.x), bflo(g_w.y), bfhi(g_w.y)};
    const float a[4] = {bflo(g_a.x), bfhi(g_a.x), bflo(g_a.y), bfhi(g_a.y)};
    const float kkw[4] = {kk_w.x, kk_w.y, kk_w.z, kk_w.w};
    const float kaw[4] = {ka_w.x, ka_w.y, ka_w.z, ka_w.w};
    float kk[4], ss = 0.f;
#pragma unroll
    for (int e = 0; e < 4; ++e) { kk[e] = k[e] * kkw[e]; ss += kk[e] * kk[e]; }
    ss = red16(ss);
    const float rn = rsqrtf(ss + 1e-12f);
    float dwr[4], dw[4], dk[4], dn[4], db[4];
    float br = 0.f, khr = 0.f;
#pragma unroll
    for (int e = 0; e < 4; ++e) {
      dw[e] = __expf(-0.6065306597126334f * sigm(w[e]));
      const float kn = kk[e] * rn;
      dn[e] = -kn; db[e] = kn * a[e];
      dk[e] = k[e] * (1.f + (a[e] - 1.f) * kaw[e]);
      dwr[e] = dw[e] * r[e];
      br += db[e] * r[e]; khr += dk[e] * r[e];
    }
    br = red16(br); khr = red16(khr);
#pragma unroll
    for (int e = 0; e < 4; ++e) dwr[e] += dn[e] * br;
    *(float4*)(b + 0 * 1024 + g16 * 64 + kq * 4) = float4{dwr[0], dwr[1], dwr[2], dwr[3]};
    *(float4*)(b + 1 * 1024 + g16 * 64 + kq * 4) = float4{dw[0], dw[1], dw[2], dw[3]};
    *(float4*)(b + 2 * 1024 + g16 * 64 + kq * 4) = float4{dk[0], dk[1], dk[2], dk[3]};
    *(float4*)(b + 3 * 1024 + g16 * 64 + kq * 4) = float4{dn[0], dn[1], dn[2], dn[3]};
    *(float4*)(b + 4 * 1024 + g16 * 64 + kq * 4) = float4{db[0], db[1], db[2], db[3]};
    b[5 * 1024 + g16 * 16 + kq] = bf2f(g_v);
    if (kq == 0) b[5 * 1024 + 256 + g16] = khr;
  };
  __syncthreads();
  gload(0); derive(0);
  __syncthreads();
  constexpr int NC = SEQ / 16;
  for (int c = 0; c < NC; ++c) {
    if (c + 1 < NC) gload(c + 1);
    const float* b = sm + (c & 1) * BUFF;
    float ysel = 0.f;
    float4 nk = *(const float4*)(b + 3 * 1024 + kq * 4);
    float4 w = *(const float4*)(b + 1 * 1024 + kq * 4);
    float4 bb = *(const float4*)(b + 4 * 1024 + kq * 4);
    float4 kh = *(const float4*)(b + 2 * 1024 + kq * 4);
    float4 wr = *(const float4*)(b + 0 * 1024 + kq * 4);
    float v = b[5 * 1024 + g16];
    float khrs = b[5 * 1024 + 256];
#pragma unroll
    for (int t = 0; t < 16; ++t) {
      float4 nk2, w2, bb2, kh2, wr2; float v2, khrs2;
      if (t < 15) {
        nk2 = *(const float4*)(b + 3 * 1024 + (t + 1) * 64 + kq * 4);
        w2 = *(const float4*)(b + 1 * 1024 + (t + 1) * 64 + kq * 4);
        bb2 = *(const float4*)(b + 4 * 1024 + (t + 1) * 64 + kq * 4);
        kh2 = *(const float4*)(b + 2 * 1024 + (t + 1) * 64 + kq * 4);
        wr2 = *(const float4*)(b + 0 * 1024 + (t + 1) * 64 + kq * 4);
        v2 = b[5 * 1024 + (t + 1) * 16 + g16];
        khrs2 = b[5 * 1024 + 256 + t + 1];
      }
      float sa = S0 * nk.x + S1 * nk.y + S2 * nk.z + S3 * nk.w;
      float yy = S0 * wr.x + S1 * wr.y + S2 * wr.z + S3 * wr.w;
      sa = red16(sa);
      yy = red16(yy);
      S0 = S0 * w.x + sa * bb.x + v * kh.x;
      S1 = S1 * w.y + sa * bb.y + v * kh.y;
      S2 = S2 * w.z + sa * bb.z + v * kh.z;
      S3 = S3 * w.w + sa * bb.w + v * kh.w;
      yy += v * khrs;
      ysel = (kq == t) ? yy : ysel;
      if (t < 15) { nk = nk2; w = w2; bb = bb2; kh = kh2; wr = wr2; v = v2; khrs = khrs2; }
    }
    Y[(size_t)(c * 16 + kq) * 512 + hd * 64 + rg * 16 + g16] = ysel;
    if (c + 1 < NC) derive((c + 1) & 1);
    __syncthreads();
  }
}

DI void hgrn_scan_unit(const Params& p, int l, int u, char* smem) {
  const int tid = TID();
  const int bl = u >> 5, hd = (u >> 3) & 3, vg = u & 7;
  const int kq = tid & 15, g16 = tid >> 4;
  const bf16_t* Pm = (const bf16_t*)(p.ws + R_P) + (size_t)bl * SEQ * PLD;
  bf16_t* Og = (bf16_t*)(p.ws + R_OHG) + (size_t)bl * SEQ * 512;
  float* sm = (float*)smem;
  constexpr int BUFF = 2 * 2048 + 256 + 16;
  const int kc = hd * 128 + kq * 8;
  float lb[8];
#pragma unroll
  for (int e = 0; e < 8; ++e) {
    if (l == 0) lb[e] = 0.f;
    else { const float x0 = p.in[9][kc + e], x1 = p.in[9][512 + kc + e]; lb[e] = 1.f / (1.f + expf(x0 - x1)); }
  }
  float S[8];
#pragma unroll
  for (int e = 0; e < 8; ++e) S[e] = 0.f;
  uint4 g_q, g_f; bf16_t g_v;
  const int vcol = PC_HG + 1024 + hd * 128 + vg * 16;
  auto gload = [&](int c) {
    const int tok = c * 16 + g16;
    g_q = *(const uint4*)(Pm + (size_t)tok * PLD + PC_HG + kc);
    g_f = *(const uint4*)(Pm + (size_t)tok * PLD + PC_HG + 512 + kc);
    g_v = Pm[(size_t)tok * PLD + vcol + kq];
  };
  auto derive = [&](int buf) {
    float* b = sm + buf * BUFF;
    const unsigned qu[4] = {g_q.x, g_q.y, g_q.z, g_q.w}, fu[4] = {g_f.x, g_f.y, g_f.z, g_f.w};
    float fq[8], f[8], cs = 0.f;
#pragma unroll
    for (int e = 0; e < 8; ++e) {
      const float q = (e & 1) ? bfhi(qu[e >> 1]) : bflo(qu[e >> 1]);
      const float fx = (e & 1) ? bfhi(fu[e >> 1]) : bflo(fu[e >> 1]);
      f[e] = lb[e] + (1.f - lb[e]) * sigm(fx);
      fq[e] = f[e] * q;
      cs += (1.f - f[e]) * q;
    }
    cs = red16(cs);
    *(float4*)(b + g16 * 128 + kq * 8) = float4{fq[0], fq[1], fq[2], fq[3]};
    *(float4*)(b + g16 * 128 + kq * 8 + 4) = float4{fq[4], fq[5], fq[6], fq[7]};
    *(float4*)(b + 2048 + g16 * 128 + kq * 8) = float4{f[0], f[1], f[2], f[3]};
    *(float4*)(b + 2048 + g16 * 128 + kq * 8 + 4) = float4{f[4], f[5], f[6], f[7]};
    b[4096 + g16 * 16 + kq] = bf2f(g_v);
    if (kq == 0) b[4096 + 256 + g16] = cs;
  };
  __syncthreads();
  gload(0); derive(0);
  __syncthreads();
  constexpr int NC = SEQ / 16;
  for (int c = 0; c < NC; ++c) {
    if (c + 1 < NC) gload(c + 1);
    const float* b = sm + (c & 1) * BUFF;
    float osel = 0.f;
#pragma unroll
    for (int t = 0; t < 16; ++t) {
      const float4 q0 = *(const float4*)(b + t * 128 + kq * 8), q1 = *(const float4*)(b + t * 128 + kq * 8 + 4);
      const float4 f0 = *(const float4*)(b + 2048 + t * 128 + kq * 8), f1 = *(const float4*)(b + 2048 + t * 128 + kq * 8 + 4);
      const float v = b[4096 + t * 16 + g16];
      const float cs = b[4096 + 256 + t];
      const float fq[8] = {q0.x, q0.y, q0.z, q0.w, q1.x, q1.y, q1.z, q1.w};
      const float f[8] = {f0.x, f0.y, f0.z, f0.w, f1.x, f1.y, f1.z, f1.w};
      float o = 0.f;
#pragma unroll
      for (int e = 0; e < 8; ++e) { o += S[e] * fq[e]; S[e] = f[e] * (S[e] - v) + v; }
      o = red16(o) + v * cs;
      osel = (kq == t) ? o : osel;
    }
    Og[(size_t)(c * 16 + kq) * 512 + hd * 128 + vg * 16 + g16] = f2bf(osel);
    if (c + 1 < NC) derive((c + 1) & 1);
    __syncthreads();
  }
}

DI void s5_scan_unit(const Params& p, int l, int u, char* smem) {
  const int tid = TID(), lane = tid & 63, wave = tid >> 6;
  const int idx = u * 4 + wave, bl = idx >> 5, g = idx & 31;
  const bf16_t* Pm = (const bf16_t*)(p.ws + R_P) + (size_t)bl * SEQ * PLD + PC_S5 + g * 16;
  bf16_t* Z = (bf16_t*)(p.ws + R_ZS5) + (size_t)bl * SEQ * 512 + g * 16;
  constexpr int BUS = 132;
  float* buT = (float*)smem + wave * (16 * BUS);
  bf16_t* hist = (bf16_t*)(smem + 4 * 16 * BUS * 4) + wave * (16 * 136);
  const float2 ab = *(const float2*)((const float*)(p.ws + OFF_S5AB) + (g * 64 + lane) * 2);
  const int l16 = lane & 15, quad = lane >> 4;
  bf16x8 bbf[8];
  {
    const float* bbp = (const float*)(p.ws + OFF_S5BB);
#pragma unroll
    for (int jb = 0; jb < 8; ++jb) {
      const int col = jb * 16 + l16, nn = col & 63, im = col >> 6;
      unsigned pk[4] = {0u, 0u, 0u, 0u};
      if (quad < 2) {
        const float* src = bbp + (size_t)(g * 64 + nn) * 32 + im * 16 + quad * 8;
#pragma unroll
        for (int e = 0; e < 4; ++e) pk[e] = pack2(src[2 * e], src[2 * e + 1]);
      }
      bbf[jb] = __builtin_bit_cast(bf16x8, uint4{pk[0], pk[1], pk[2], pk[3]});
    }
  }
  bf16x8 cf[4];
  {
    const float* Cre = p.in[16] + (size_t)l * 32768 + (size_t)(g * 16 + l16) * 64;
    const float* Cim = p.in[17] + (size_t)l * 32768 + (size_t)(g * 16 + l16) * 64;
#pragma unroll
    for (int ks = 0; ks < 4; ++ks) {
      unsigned pk[4];
#pragma unroll
      for (int e = 0; e < 4; ++e) {
        const int k = ks * 32 + quad * 8 + 2 * e;
        const float v0 = (k < 64) ? Cre[k] : -Cim[k - 64];
        const float v1 = (k < 64) ? Cre[k + 1] : -Cim[k + 1 - 64];
        pk[e] = pack2(v0, v1);
      }
      cf[ks] = __builtin_bit_cast(bf16x8, uint4{pk[0], pk[1], pk[2], pk[3]});
    }
  }
  const float dcoef = p.in[18][l * 512 + g * 16 + l16];
  float xr = 0.f, xi = 0.f;
  uint4 ua = uint4{0u, 0u, 0u, 0u};
  bf16_t ue[4];
  auto gload = [&](int c) {
    if (quad < 2) ua = *(const uint4*)(Pm + (size_t)(c * 16 + l16) * PLD + quad * 8);
#pragma unroll
    for (int r = 0; r < 4; ++r) ue[r] = Pm[(size_t)(c * 16 + quad * 4 + r) * PLD + l16];
  };
  __syncthreads();
  gload(0);
  constexpr int NC = SEQ / 16;
  for (int c = 0; c < NC; ++c) {
    const bf16x8 afr = __builtin_bit_cast(bf16x8, ua);
    float us[4];
#pragma unroll
    for (int r = 0; r < 4; ++r) us[r] = bf2f(ue[r]);
#pragma unroll
    for (int jb = 0; jb < 8; ++jb) {
      f32x4 acc = {0.f, 0.f, 0.f, 0.f};
      acc = __builtin_amdgcn_mfma_f32_16x16x32_bf16(afr, bbf[jb], acc, 0, 0, 0);
#pragma unroll
      for (int r = 0; r < 4; ++r) buT[(quad * 4 + r) * BUS + jb * 16 + l16] = acc[r];
    }
    if (c + 1 < NC) gload(c + 1);
    __syncthreads();
#pragma unroll
    for (int t = 0; t < 16; ++t) {
      const float ur = buT[t * BUS + lane], ui = buT[t * BUS + 64 + lane];
      const float nr = ab.x * xr - ab.y * xi + ur;
      const float ni = ab.x * xi + ab.y * xr + ui;
      xr = nr; xi = ni;
      hist[t * 136 + lane] = f2bf(xr);
      hist[t * 136 + 64 + lane] = f2bf(xi);
    }
    __syncthreads();
    f32x4 acc = {0.f, 0.f, 0.f, 0.f};
#pragma unroll
    for (int ks = 0; ks < 4; ++ks) {
      const bf16x8 a = *(const bf16x8*)(hist + l16 * 136 + ks * 32 + quad * 8);
      acc = __builtin_amdgcn_mfma_f32_16x16x32_bf16(a, cf[ks], acc, 0, 0, 0);
    }
#pragma unroll
    for (int r = 0; r < 4; ++r) {
      const int t = quad * 4 + r;
      const float y = acc[r] + dcoef * us[r];
      const float z = y * sigm(1.5957691216057308f * (y + 0.044715f * y * y * y));
      Z[(size_t)(c * 16 + t) * 512 + l16] = f2bf(z);
    }
  }
}

#define GSYNC() xcd_barrier(xb)
#define TILE_MAP(u_, ntm_, tm_, tn_) { const int _x = (u_) & 7, _li = (u_) >> 3, _per = (ntm_) >> 3; tm_ = _x * _per + (_li % _per); tn_ = _li / _per; }
__global__ void __launch_bounds__(256, 2) mega_kernel(Params p) {
  cg::grid_group grid = cg::this_grid();
  __shared__ __attribute__((aligned(16))) char smem[SMEM_BYTES];
  __shared__ uint4 xb_words;
  const int bid = blockIdx.x, nb = gridDim.x;
  if (p.ws == nullptr) grid.sync();
  if (threadIdx.x == 0) xb_words = make_uint4(0u, 0u, 0u, 0u);
  __syncthreads();
  const XcdBarrier xb = xcd_barrier_post((unsigned*)(p.ws + OFF_BAR), (volatile LAS unsigned*)&xb_words);
  char* ws = p.ws;
  float* X = p.out;
  bf16_t* Wt_in = (bf16_t*)(ws + OFF_WIN);
  bf16_t* Wt_q = (bf16_t*)(ws + OFF_WQ);
  bf16_t* Wt_br = (bf16_t*)(ws + OFF_WBR);
  bf16_t* Wt_out = (bf16_t*)(ws + OFF_WOUT);
  bf16_t* Wt_glu = (bf16_t*)(ws + OFF_WGLU);
  bf16_t* Wt_wup = (bf16_t*)(ws + OFF_WWUP);
  bf16_t* Wt_aup = (bf16_t*)(ws + OFF_WAUP);
  bf16_t* Wt_gup = (bf16_t*)(ws + OFF_WGUP);
  bf16_t* Wt_v = (bf16_t*)(ws + OFF_WV);
  bf16_t* Wt_xkv = (bf16_t*)(ws + OFF_WXKV);
  bf16_t* Hb = (bf16_t*)(ws + OFF_H);
  bf16_t* Vfirst = (bf16_t*)(ws + OFF_VFIRST);
  bf16_t* Kx = (bf16_t*)(ws + OFF_KX);
  bf16_t* VxT = (bf16_t*)(ws + OFF_VXT);
  bf16_t* Hm = (bf16_t*)(ws + OFF_HM);
  float* CosT = (float*)(ws + OFF_COS);
  float* SinT = (float*)(ws + OFF_SIN);
  bf16_t* Pm = (bf16_t*)(ws + R_P);
  bf16_t* Cqn = (bf16_t*)(ws + R_CQN);
  bf16_t* Qp = (bf16_t*)(ws + R_QP);
  bf16_t* KVlat = (bf16_t*)(ws + R_KVLAT);
  bf16_t* VTm = (bf16_t*)(ws + R_VT);
  bf16_t* RKV = (bf16_t*)(ws + R_RKV);
  bf16_t* Alora = (bf16_t*)(ws + R_ALORA);
  float* Yrw = (float*)(ws + R_YRW);
  bf16_t* Zs5 = (bf16_t*)(ws + R_ZS5);
  bf16_t* Ybr = (bf16_t*)(ws + R_YBR);
  bf16_t* Wt_xq = (bf16_t*)(ws + R_WXQ);
  bf16_t* Wt_xo = (bf16_t*)(ws + R_WXO);
  bf16_t* Wt_gu = (bf16_t*)(ws + R_WGU);
  bf16_t* Wt_down = (bf16_t*)(ws + R_WDOWN);
  bf16_t* Qx = (bf16_t*)(ws + R_QX);
  bf16_t* Ox = (bf16_t*)(ws + R_OX);
  bf16_t* GU = (bf16_t*)(ws + R_GU);
  const float LOG2E = 1.4426950408889634f;

  for (int l = 0; l < 2; ++l) {
    {
      PHASE_IDS
      const float* w_in = p.in[4] + (size_t)l * 1024 * P_IN;
      transpose_all(w_in, P_IN, 1024, P_IN, Wt_in, bid, nb, smem);
      transpose_all(p.in[36] + (size_t)l * 512 * 1024, 1024, 512, 1024, Wt_br + (size_t)1 * 1024 * 512, bid, nb, smem);
      transpose_all(p.in[37] + (size_t)l * 512 * 1024, 1024, 512, 1024, Wt_br + (size_t)2 * 1024 * 512, bid, nb, smem);
      transpose_all(p.in[38] + (size_t)l * 512 * 1024, 1024, 512, 1024, Wt_br + (size_t)3 * 1024 * 512, bid, nb, smem);
      transpose_all(p.in[39] + (size_t)l * 1024 * 1024, 1024, 1024, 1024, Wt_out, bid, nb, smem);
      transpose_all(p.in[19] + (size_t)l * 512 * 512, 512, 512, 512, Wt_glu, bid, nb, smem);
      transpose_all(p.in[23] + (size_t)l * 64 * 512, 512, 64, 512, Wt_wup, bid, nb, smem);
      transpose_all(p.in[25] + (size_t)l * 64 * 512, 512, 64, 512, Wt_aup, bid, nb, smem);
      transpose_all(p.in[26] + (size_t)l * 128 * 512, 512, 128, 512, Wt_gup, bid, nb, smem);
      transpose_all(p.in[43] + (size_t)l * 1024 * 2048, 2048, 1024, 2048, Wt_xkv, bid, nb, smem);
      const int gtid = bid * 256 + tid, gsz = nb * 256;
      {
        const float* w_uq = p.in[6] + (size_t)l * 256 * 768;
        const float* w_ukv = p.in[8] + (size_t)l * 128 * 1024;
        for (int e = gtid; e < 768 * 256; e += gsz) {
          const int n = e >> 8, kq = e & 255, hh = n / 192, j = n % 192;
          float v;
          if (j >= 128) v = w_uq[kq * 768 + n];
          else {
            v = 0.f;
            const float* a = w_uq + kq * 768 + hh * 192;
            const float* b = w_ukv + j * 1024 + hh * 256;
            for (int d = 0; d < 128; ++d) v += a[d] * b[d];
          }
          Wt_q[e] = f2bf(v);
        }
        const float* w_bm = p.in[35] + (size_t)l * 512 * 1024;
        for (int e = gtid; e < 1024 * 512; e += gsz) {
          const int n = e & 1023, kk = e >> 10, hh = kk >> 7, j = kk & 127;
          const float* a = w_ukv + j * 1024 + hh * 256 + 128;
          float v = 0.f;
          for (int d = 0; d < 128; ++d) v += a[d] * w_bm[(size_t)(hh * 128 + d) * 1024 + n];
          Wt_br[(size_t)n * 512 + kk] = f2bf(v);
        }
        if (l == 1) {
          const float* vd = p.in[32];
          const float* vu = p.in[33];
          for (int e = gtid; e < 512 * 1024; e += gsz) {
            const int n = e & 511, kk = e >> 9;
            float v = 0.f;
            for (int r = 0; r < 32; ++r) v += vd[kk * 32 + r] * vu[r * 512 + n];
            Wt_v[(size_t)n * 1024 + kk] = f2bf(v);
          }
        }
      }
      {
        float* abp = (float*)(ws + OFF_S5AB);
        float* bbp = (float*)(ws + OFF_S5BB);
        for (int e = gtid; e < 2048; e += gsz) {
          const int g = e >> 6;
          const float are = fminf(p.in[11][l * 2048 + e], -1e-4f), aim = p.in[12][l * 2048 + e];
          const float dt = expf(p.in[13][l * 32 + g]);
          const float mag = expf(dt * are);
          const float abre = mag * cosf(dt * aim), abim = mag * sinf(dt * aim);
          const float den = are * are + aim * aim;
          const float zre = ((abre - 1.f) * are + abim * aim) / den;
          const float zim = (abim * are - (abre - 1.f) * aim) / den;
          abp[e * 2] = abre; abp[e * 2 + 1] = abim;
          const float* Br = p.in[14] + (size_t)l * 32768 + (size_t)e * 16;
          const float* Bi = p.in[15] + (size_t)l * 32768 + (size_t)e * 16;
          for (int c = 0; c < 16; ++c) {
            bbp[e * 32 + c] = zre * Br[c] - zim * Bi[c];
            bbp[e * 32 + 16 + c] = zre * Bi[c] + zim * Br[c];
          }
        }
      }
      if (l == 0) rmsnorm_rows(p.in[0], p.in[3], Hb, X, T_ALL, bid, nb);
      else rmsnorm_rows(X, p.in[3] + 1024, Hb, nullptr, T_ALL, bid, nb);
      rmsnorm_rows(p.in[1], p.in[41] + l * 1024, Hm, nullptr, 1024, bid, nb);
    }
    GSYNC();

    for (int half = 0; half < 2; ++half) {
      const bf16_t* Hh = Hb + (size_t)half * TH * 1024;
      {
        const int n1 = 64 * 38;
        const int n2 = (half == 0) ? 8 * 16 : 0;
        for (int u = bid; u < n1 + n2; u += nb) {
          f32x4 acc[4][4];
          zero_acc<4>(acc);
          if (u < n1) {
            int tm, tn; TILE_MAP(u, 64, tm, tn);
            gemm_acc<128>(Hh + (size_t)tm * 128 * 1024, 1024, Wt_in + (size_t)tn * 128 * 1024, 1024, 1024, smem, acc);
            EPI4_FOR(128) {
              const int row = tm * 128 + EPI_ROW, n = tn * 128 + EPI4_COL(128);
              if (n < GATE_OFF) {
                const int pc = (n < 448) ? n : n + 64;
                *(uint2*)(Pm + (size_t)row * PLD + pc) = pack4(acc[i][j]);
              }
            }
          } else {
            const int v = u - n1, tn = v % 16, tm = v / 16;
            gemm_acc<128>(Hm + (size_t)tm * 128 * 1024, 1024, Wt_xkv + (size_t)tn * 128 * 1024, 1024, 1024, smem, acc);
            EPI_FOR(128) {
              const int row = tm * 128 + EPI_ROW, n = tn * 128 + EPI_COL(128);
              const int b = row >> 8, m = row & 255, sel = n >> 10, hh = (n >> 8) & 3, d = n & 255;
              if (sel == 0) Kx[((size_t)(b * 4 + hh) * 256 + m) * 256 + d] = f2bf(acc[i][j][r]);
              else VxT[((size_t)(b * 4 + hh) * 256 + d) * 256 + m] = f2bf(acc[i][j][r]);
            }
          }
        }
      }
      GSYNC();
      {
      PHASE_IDS
        const float* qn = p.in[5] + l * 256;
        const float* kvn = p.in[7] + l * 128;
        const float* mu = p.in[21] + l * 1792;
        for (int tk = bid * 4 + wave; tk < TH; tk += nb * 4) {
          const int gtok = half * TH + tk, s = gtok & (SEQ - 1), bl = tk >> 12;
          const bf16_t* prow = Pm + (size_t)tk * PLD;
          {
            const uint2 cu = *(const uint2*)(prow + lane * 4);
            float f[4] = {bflo(cu.x), bfhi(cu.x), bflo(cu.y), bfhi(cu.y)};
            float ss = wave_sum(f[0] * f[0] + f[1] * f[1] + f[2] * f[2] + f[3] * f[3]);
            const float rs = rsqrtf(ss * (1.f / 256.f) + 1e-6f);
            const float4 g4 = *(const float4*)(qn + lane * 4);
            uint2 o; o.x = pack2(f[0] * rs * g4.x, f[1] * rs * g4.y); o.y = pack2(f[2] * rs * g4.z, f[3] * rs * g4.w);
            *(uint2*)(Cqn + (size_t)tk * 256 + lane * 4) = o;
          }
          {
            const unsigned cu = *(const unsigned*)(prow + 256 + lane * 2);
            const float f0 = bflo(cu), f1 = bfhi(cu);
            const float ss = wave_sum(f0 * f0 + f1 * f1);
            const float rs = rsqrtf(ss * (1.f / 128.f) + 1e-6f);
            const float v0 = f0 * rs * kvn[lane * 2], v1 = f1 * rs * kvn[lane * 2 + 1];
            const bf16_t b0 = f2bf(v0), b1 = f2bf(v1);
            *(unsigned*)(KVlat + (size_t)tk * 192 + lane * 2) = (unsigned)b0 | ((unsigned)b1 << 16);
            VTm[((size_t)bl * 128 + lane * 2) * SEQ + s] = b0;
            VTm[((size_t)bl * 128 + lane * 2 + 1) * SEQ + s] = b1;
          }
          if (lane < 32) {
            const float t1 = bf2f(prow[384 + lane]), t2 = bf2f(prow[384 + 32 + lane]);
            const float posf = (float)p.pos[gtok];
            const float invf = exp2f(-(float)lane * (13.287712379549449f / 32.f));
            const float ang = posf * invf;
            const float cs = cosf(ang), sn = sinf(ang);
            KVlat[(size_t)tk * 192 + 128 + lane] = f2bf(t1 * cs - t2 * sn);
            KVlat[(size_t)tk * 192 + 160 + lane] = f2bf(t1 * sn + t2 * cs);
            CosT[tk * 32 + lane] = cs; SinT[tk * 32 + lane] = sn;
          }
#pragma unroll
          for (int jj = 0; jj < 7; ++jj) {
            const int col = (jj * 64 + lane) * 4;
            const uint2 cu = *(const uint2*)(prow + PC_RW + col);
            uint2 pu = uint2{0u, 0u};
            if (s > 0) pu = *(const uint2*)(prow - PLD + PC_RW + col);
            const float4 m4 = *(const float4*)(mu + col);
            const float cv[4] = {bflo(cu.x), bfhi(cu.x), bflo(cu.y), bfhi(cu.y)};
            const float pv[4] = {bflo(pu.x), bfhi(pu.x), bflo(pu.y), bfhi(pu.y)};
            const float mm[4] = {m4.x, m4.y, m4.z, m4.w};
            float o[4];
#pragma unroll
            for (int e = 0; e < 4; ++e) o[e] = cv[e] + (pv[e] - cv[e]) * mm[e];
            if (col < 1536) {
              uint2 ov; ov.x = pack2(o[0], o[1]); ov.y = pack2(o[2], o[3]);
              *(uint2*)(RKV + (size_t)tk * 1536 + col) = ov;
              if (l == 0 && col >= 1024) *(uint2*)(Vfirst + (size_t)gtok * 512 + (col - 1024)) = ov;
            } else {
              int dc;
              if (col < 1600) { dc = col - 1536; for (int e = 0; e < 4; ++e) o[e] = tanhf(o[e]); }
              else if (col < 1664) { dc = 64 + col - 1600; }
              else { dc = 128 + col - 1664; for (int e = 0; e < 4; ++e) o[e] = sigm(o[e]); }
              uint2 ov; ov.x = pack2(o[0], o[1]); ov.y = pack2(o[2], o[3]);
              *(uint2*)(Alora + (size_t)tk * 256 + dc) = ov;
            }
          }
        }
      }
      GSYNC();
      {
      PHASE_IDS
        const int nq = 64 * 6, nl = 64 * 4;
        const int total = nq + 3 * nl + (l == 1 ? nl : 0);
        for (int u = bid; u < total; u += nb) {
          f32x4 acc[4][4];
          zero_acc<4>(acc);
          if (u < nq) {
            int tm, tn; TILE_MAP(u, 64, tm, tn);
            gemm_acc<128>(Cqn + (size_t)tm * 128 * 256, 256, Wt_q + (size_t)tn * 128 * 256, 256, 256, smem, acc);
            const float qs = 0.07216878364870322f * LOG2E;
            const int lane_ = tid & 63, wave_ = tid >> 6, wm_ = wave_ >> 1, wn_ = wave_ & 1, l16_ = lane_ & 15, quad_ = lane_ >> 4;
            const int gc = tn * 128 + wn_ * 64;
            const bool is_rope = (gc % 192) == 128;
#pragma unroll
            for (int i = 0; i < 4; ++i) {
              const int row = tm * 128 + wm_ * 64 + i * 16 + l16_;
              if (is_rope) {
#pragma unroll
                for (int j = 0; j < 2; ++j) {
                  const int fi = j * 16 + quad_ * 4;
                  const float4 cs = *(const float4*)(CosT + row * 32 + fi), sn = *(const float4*)(SinT + row * 32 + fi);
                  const float c4[4] = {cs.x, cs.y, cs.z, cs.w}, s4[4] = {sn.x, sn.y, sn.z, sn.w};
#pragma unroll
                  for (int r = 0; r < 4; ++r) {
                    const float t1 = acc[i][j][r], t2 = acc[i][j + 2][r];
                    acc[i][j][r] = t1 * c4[r] - t2 * s4[r]; acc[i][j + 2][r] = t1 * s4[r] + t2 * c4[r];
                  }
                }
              }
#pragma unroll
              for (int j = 0; j < 4; ++j) *(uint2*)(Qp + (size_t)row * 768 + gc + j * 16 + quad_ * 4) = pack4(acc[i][j] * qs);
            }
          } else if (u < nq + 3 * nl) {
            const int v = u - nq, which = v / nl, w2 = v % nl, tn = w2 % 4, tm = w2 / 4;
            if (which == 0) {
              gemm_acc<128>(Alora + (size_t)tm * 128 * 256, 256, Wt_wup + (size_t)tn * 128 * 64, 64, 64, smem, acc);
              const float* w0 = p.in[22] + l * 512;
              EPI4_FOR(128) {
                const int row = tm * 128 + EPI_ROW, n = tn * 128 + EPI4_COL(128);
                const float4 b4 = *(const float4*)(w0 + n);
                *(uint2*)(Pm + (size_t)row * PLD + PC_RW + n) = pack4(acc[i][j] + f32x4{b4.x, b4.y, b4.z, b4.w});
              }
            } else if (which == 1) {
              gemm_acc<128>(Alora + (size_t)tm * 128 * 256 + 64, 256, Wt_aup + (size_t)tn * 128 * 64, 64, 64, smem, acc);
              const float* a0 = p.in[24] + l * 512;
              EPI4_FOR(128) {
                const int row = tm * 128 + EPI_ROW, n = tn * 128 + EPI4_COL(128);
                const float4 b4 = *(const float4*)(a0 + n);
                f32x4 v = acc[i][j] + f32x4{b4.x, b4.y, b4.z, b4.w};
#pragma unroll
                for (int r = 0; r < 4; ++r) v[r] = sigm(v[r]);
                *(uint2*)(Pm + (size_t)row * PLD + PC_RW + 512 + n) = pack4(v);
              }
            } else {
              gemm_acc<128>(Alora + (size_t)tm * 128 * 256 + 128, 256, Wt_gup + (size_t)tn * 128 * 128, 128, 128, smem, acc);
              EPI4_FOR(128) {
                const int row = tm * 128 + EPI_ROW, n = tn * 128 + EPI4_COL(128);
                *(uint2*)(Pm + (size_t)row * PLD + PC_RW + 1024 + n) = pack4(acc[i][j]);
              }
            }
          } else {
            const int w2 = u - nq - 3 * nl, tn = w2 % 4, tm = w2 / 4;
            gemm_acc<128>(Hh + (size_t)tm * 128 * 1024, 1024, Wt_v + (size_t)tn * 128 * 1024, 1024, 1024, smem, acc);
            const float* vb = p.in[34];
            EPI4_FOR(128) {
              const int row = tm * 128 + EPI_ROW, n = tn * 128 + EPI4_COL(128);
              const float4 b4 = *(const float4*)(vb + n);
              const f32x4 lg = acc[i][j] + f32x4{b4.x, b4.y, b4.z, b4.w};
              const f32x4 vc = unpack4(*(const uint2*)(RKV + (size_t)row * 1536 + 1024 + n));
              const f32x4 vf = unpack4(*(const uint2*)(Vfirst + ((size_t)half * TH + row) * 512 + n));
              f32x4 o;
#pragma unroll
              for (int r = 0; r < 4; ++r) o[r] = vc[r] + (vf[r] - vc[r]) * sigm(lg[r]);
              *(uint2*)(RKV + (size_t)row * 1536 + 1024 + n) = pack4(o);
            }
          }
        }
      }
      GSYNC();
      {
        for (int u = bid; u < 64 + 64 + 16 + 256; u += nb) {
          if (u < 144) {
            __builtin_amdgcn_s_setprio(3);
            if (u < 64) rwkv_scan_unit(p, l, u, smem);
            else if (u < 128) hgrn_scan_unit(p, l, u - 64, smem);
            else s5_scan_unit(p, l, u - 128, smem);
            __builtin_amdgcn_s_setprio(0);
          } else {
            const int it = u - 144, qt = 31 - (it >> 3), bl = (it >> 2) & 1, hh = it & 3;
            attn_item<192, true>(Qp + (size_t)bl * SEQ * 768 + hh * 192, 768, KVlat + (size_t)bl * SEQ * 192, 192,
                                 VTm + (size_t)bl * 128 * SEQ, SEQ, (qt * 128 + 128) / 64, qt * 128,
                                 Pm + (size_t)bl * SEQ * PLD + hh * 128, PLD, smem);
          }
        }
      }
      GSYNC();
      {
      PHASE_IDS
        const int nglu = 64 * 4;
        for (int u = bid; u < nglu; u += nb) {
          int tm, tn; TILE_MAP(u, 64, tm, tn);
          f32x4 acc[4][4];
          zero_acc<4>(acc);
          gemm_acc<128>(Zs5 + (size_t)tm * 128 * 512, 512, Wt_glu + (size_t)tn * 128 * 512, 512, 512, smem, acc);
          const float* bg = p.in[20] + l * 512;
          EPI4_FOR(128) {
            const int row = tm * 128 + EPI_ROW, n = tn * 128 + EPI4_COL(128);
            const f32x4 z = unpack4(*(const uint2*)(Zs5 + (size_t)row * 512 + n));
            const float4 b4 = *(const float4*)(bg + n);
            const f32x4 lg = acc[i][j] + f32x4{b4.x, b4.y, b4.z, b4.w};
            f32x4 o;
#pragma unroll
            for (int r = 0; r < 4; ++r) o[r] = z[r] * sigm(lg[r]);
            *(uint2*)(Pm + (size_t)row * PLD + PC_S5 + n) = pack4(o);
          }
        }
        const float* k_a = p.in[28] + l * 512;
        const float* r_k = p.in[29] + l * 512;
        const float* ln_w = p.in[30] + l * 512;
        const float* ln_b = p.in[31] + l * 512;
        const float* o_norm = p.in[10] + l * 512;
        for (int tk = bid * 4 + wave; tk < TH; tk += nb * 4) {
          const int c0 = lane * 8;
          {
            const float4 y0 = *(const float4*)(Yrw + (size_t)tk * 512 + c0), y1 = *(const float4*)(Yrw + (size_t)tk * 512 + c0 + 4);
            const float y[8] = {y0.x, y0.y, y0.z, y0.w, y1.x, y1.y, y1.z, y1.w};
            const uint4 ru = *(const uint4*)(RKV + (size_t)tk * 1536 + c0);
            const uint4 ku = *(const uint4*)(RKV + (size_t)tk * 1536 + 512 + c0);
            const uint4 vu = *(const uint4*)(RKV + (size_t)tk * 1536 + 1024 + c0);
            const uint4 au = *(const uint4*)(Pm + (size_t)tk * PLD + PC_RW + 512 + c0);
            const uint4 gu = *(const uint4*)(Pm + (size_t)tk * PLD + PC_RW + 1024 + c0);
            const unsigned ra[4] = {ru.x, ru.y, ru.z, ru.w}, ka[4] = {ku.x, ku.y, ku.z, ku.w}, va[4] = {vu.x, vu.y, vu.z, vu.w};
            const unsigned aa[4] = {au.x, au.y, au.z, au.w}, ga[4] = {gu.x, gu.y, gu.z, gu.w};
            float rr[8], kh[8], vv[8], gg[8];
            float sm1 = 0.f, bsum = 0.f;
#pragma unroll
            for (int e = 0; e < 8; ++e) {
              const unsigned sh = (e & 1);
              rr[e] = sh ? bfhi(ra[e >> 1]) : bflo(ra[e >> 1]);
              const float kx = sh ? bfhi(ka[e >> 1]) : bflo(ka[e >> 1]);
              vv[e] = sh ? bfhi(va[e >> 1]) : bflo(va[e >> 1]);
              const float a = sh ? bfhi(aa[e >> 1]) : bflo(aa[e >> 1]);
              gg[e] = sh ? bfhi(ga[e >> 1]) : bflo(ga[e >> 1]);
              kh[e] = kx * (1.f + (a - 1.f) * k_a[c0 + e]);
              sm1 += y[e];
              bsum += rr[e] * kh[e] * r_k[c0 + e];
            }
            sm1 = red8(sm1); bsum = red8(bsum);
            const float mean = sm1 * (1.f / 64.f);
            float vs = 0.f;
#pragma unroll
            for (int e = 0; e < 8; ++e) { const float d = y[e] - mean; vs += d * d; }
            vs = red8(vs);
            const float rstd = rsqrtf(vs * (1.f / 64.f) + 64e-5f);
            float o[8];
#pragma unroll
            for (int e = 0; e < 8; ++e) o[e] = (((y[e] - mean) * rstd) * ln_w[c0 + e] + ln_b[c0 + e] + bsum * vv[e]) * gg[e];
            uint4 ov; ov.x = pack2(o[0], o[1]); ov.y = pack2(o[2], o[3]); ov.z = pack2(o[4], o[5]); ov.w = pack2(o[6], o[7]);
            *(uint4*)(RKV + (size_t)tk * 1536 + c0) = ov;
          }
          {
            bf16_t* op = Pm + (size_t)tk * PLD + PC_HG + 1024 + c0;
            const uint4 ou = *(const uint4*)((const bf16_t*)(ws + R_OHG) + (size_t)tk * 512 + c0);
            const uint4 gu = *(const uint4*)(Pm + (size_t)tk * PLD + PC_HG + 1536 + c0);
            const unsigned oa[4] = {ou.x, ou.y, ou.z, ou.w}, ga[4] = {gu.x, gu.y, gu.z, gu.w};
            float o[8], ss = 0.f;
#pragma unroll
            for (int e = 0; e < 4; ++e) { o[2 * e] = bflo(oa[e]); o[2 * e + 1] = bfhi(oa[e]); }
#pragma unroll
            for (int e = 0; e < 8; ++e) ss += o[e] * o[e];
            ss = red16(ss);
            const float rs = rsqrtf(ss * (1.f / 128.f) + 1e-6f);
            float r8[8];
#pragma unroll
            for (int e = 0; e < 8; ++e) {
              const float gte = (e & 1) ? bfhi(ga[e >> 1]) : bflo(ga[e >> 1]);
              r8[e] = o[e] * rs * o_norm[c0 + e] * sigm(gte);
            }
            uint4 ov; ov.x = pack2(r8[0], r8[1]); ov.y = pack2(r8[2], r8[3]); ov.z = pack2(r8[4], r8[5]); ov.w = pack2(r8[6], r8[7]);
            *(uint4*)op = ov;
          }
        }
      }
      GSYNC();
      {
        for (int u = bid; u < 64 * 16; u += nb) {
          int tm, tn; TILE_MAP(u, 64, tm, tn);
          f32x4 yacc[4][2];
          zero_acc<2>(yacc);
#pragma unroll 1
          for (int m = 0; m < 4; ++m) {
            f32x4 ag[4][2];
            zero_acc<2>(ag);
            gemm_acc<64>(Hh + (size_t)tm * 128 * 1024, 1024, Wt_in + (size_t)(GATE_OFF + m * 1024 + tn * 64) * 1024, 1024, 1024, smem, ag);
#pragma unroll
            for (int i = 0; i < 4; ++i)
#pragma unroll
              for (int j = 0; j < 2; ++j)
#pragma unroll
                for (int r = 0; r < 4; ++r) ag[i][j][r] = sigm(ag[i][j][r]);
            f32x4 ao[4][2];
            zero_acc<2>(ao);
            const bf16_t* Ao; int lda;
            if (m == 0) { Ao = Pm; lda = PLD; }
            else if (m == 1) { Ao = Pm + PC_HG + 1024; lda = PLD; }
            else if (m == 2) { Ao = Pm + PC_S5; lda = PLD; }
            else { Ao = RKV; lda = 1536; }
            gemm_acc<64>(Ao + (size_t)tm * 128 * lda, lda, Wt_br + ((size_t)m * 1024 + tn * 64) * 512, 512, 512, smem, ao);
#pragma unroll
            for (int i = 0; i < 4; ++i)
#pragma unroll
              for (int j = 0; j < 2; ++j)
#pragma unroll
                for (int r = 0; r < 4; ++r) yacc[i][j][r] += ag[i][j][r] * ao[i][j][r];
          }
          {
            f32x4 (&acc)[4][2] = yacc;
            EPI4_FOR(64) {
              const int row = tm * 128 + EPI_ROW, n = tn * 64 + EPI4_COL(64);
              *(uint2*)(Ybr + (size_t)row * 1024 + n) = pack4(acc[i][j]);
            }
          }
        }
      }
      GSYNC();
      {
        for (int u = bid; u < 64 * 8; u += nb) {
          int tm, tn; TILE_MAP(u, 64, tm, tn);
          f32x4 acc[4][4];
          zero_acc<4>(acc);
          gemm_acc<128>(Ybr + (size_t)tm * 128 * 1024, 1024, Wt_out + (size_t)tn * 128 * 1024, 1024, 1024, smem, acc);
          EPI4_FOR(128) {
            const int row = half * TH + tm * 128 + EPI_ROW, n = tn * 128 + EPI4_COL(128);
            float4* xp = (float4*)(X + (size_t)row * 1024 + n);
            float4 xv = *xp; xv.x += acc[i][j][0]; xv.y += acc[i][j][1]; xv.z += acc[i][j][2]; xv.w += acc[i][j][3];
            *xp = xv;
          }
        }
      }
      GSYNC();
    }

    {
      transpose_all(p.in[42] + (size_t)l * 1024 * 1024, 1024, 1024, 1024, Wt_xq, bid, nb, smem);
      transpose_all(p.in[44] + (size_t)l * 1024 * 1024, 1024, 1024, 1024, Wt_xo, bid, nb, smem);
      transpose_all(p.in[46] + (size_t)l * 1024 * 5632, 5632, 1024, 5632, Wt_gu, bid, nb, smem);
      transpose_all(p.in[49] + (size_t)l * 2816 * 1024, 1024, 2816, 1024, Wt_down, bid, nb, smem);
      rmsnorm_rows(X, p.in[40] + l * 1024, Hb, nullptr, T_ALL, bid, nb);
    }
    GSYNC();
    {
      const float qs = 0.0625f * LOG2E;
      for (int u = bid; u < 128 * 8; u += nb) {
        int tm, tn; TILE_MAP(u, 128, tm, tn);
        f32x4 acc[4][4];
        zero_acc<4>(acc);
        gemm_acc<128>(Hb + (size_t)tm * 128 * 1024, 1024, Wt_xq + (size_t)tn * 128 * 1024, 1024, 1024, smem, acc);
        EPI4_FOR(128) {
          const int row = tm * 128 + EPI_ROW, n = tn * 128 + EPI4_COL(128);
          *(uint2*)(Qx + (size_t)row * 1024 + n) = pack4(acc[i][j] * qs);
        }
      }
    }
    GSYNC();
    {
      for (int u = bid; u < 1024; u += nb) {
        const int dvh = u & 1, hh = (u >> 1) & 3, qt = (u >> 3) & 31, b = u >> 8;
        attn_item<256, false>(Qx + (size_t)b * SEQ * 1024 + hh * 256, 1024, Kx + (size_t)(b * 4 + hh) * 65536, 256,
                              VxT + (size_t)(b * 4 + hh) * 65536 + (size_t)dvh * 128 * 256, 256, 4, qt * 128,
                              Ox + (size_t)b * SEQ * 1024 + hh * 256 + dvh * 128, 1024, smem);
      }
    }
    GSYNC();
    {
      for (int u = bid; u < 128 * 8; u += nb) {
        int tm, tn; TILE_MAP(u, 128, tm, tn);
        f32x4 acc[4][4];
        zero_acc<4>(acc);
        gemm_acc<128>(Ox + (size_t)tm * 128 * 1024, 1024, Wt_xo + (size_t)tn * 128 * 1024, 1024, 1024, smem, acc);
        EPI4_FOR(128) {
          const int row = tm * 128 + EPI_ROW, n = tn * 128 + EPI4_COL(128);
          float4* xp = (float4*)(X + (size_t)row * 1024 + n);
          float4 xv = *xp; xv.x += acc[i][j][0]; xv.y += acc[i][j][1]; xv.z += acc[i][j][2]; xv.w += acc[i][j][3];
          *xp = xv;
        }
      }
    }
    GSYNC();
    rmsnorm_rows(X, p.in[45] + l * 1024, Hb, nullptr, T_ALL, bid, nb);
    GSYNC();
    for (int half = 0; half < 2; ++half) {
      const bf16_t* Hh = Hb + (size_t)half * TH * 1024;
      for (int u = bid; u < 64 * 44; u += nb) {
        int tm, tn; TILE_MAP(u, 64, tm, tn);
        f32x4 acc[4][4];
        zero_acc<4>(acc);
        gemm_acc<128>(Hh + (size_t)tm * 128 * 1024, 1024, Wt_gu + (size_t)tn * 128 * 1024, 1024, 1024, smem, acc);
        EPI4_FOR(128) {
          const int row = tm * 128 + EPI_ROW, n = tn * 128 + EPI4_COL(128);
          *(uint2*)(GU + (size_t)row * 5632 + n) = pack4(acc[i][j]);
        }
      }
      GSYNC();
      {
      PHASE_IDS
        const float* cw = p.in[47] + (size_t)l * 3 * D_FF;
        const float* cb = p.in[48] + (size_t)l * D_FF;
        for (int e = bid * 256 + tid; e < TH * 352; e += nb * 256) {
          const int tk = e / 352, c0 = (e % 352) * 8;
          const int s = tk & (SEQ - 1);
          const bf16_t* gp = GU + (size_t)tk * 5632 + c0;
          const uint4 g2 = *(const uint4*)gp;
          uint4 g1 = uint4{0, 0, 0, 0}, g0 = uint4{0, 0, 0, 0};
          if (s >= 1) g1 = *(const uint4*)(gp - 5632);
          if (s >= 2) g0 = *(const uint4*)(gp - 2 * 5632);
          const uint4 uu = *(const uint4*)(gp + D_FF);
          const unsigned a2[4] = {g2.x, g2.y, g2.z, g2.w}, a1[4] = {g1.x, g1.y, g1.z, g1.w}, a0[4] = {g0.x, g0.y, g0.z, g0.w};
          const unsigned au[4] = {uu.x, uu.y, uu.z, uu.w};
          float o[8];
#pragma unroll
          for (int q = 0; q < 8; ++q) {
            const bool hi = q & 1;
            const float x2 = hi ? bfhi(a2[q >> 1]) : bflo(a2[q >> 1]);
            const float x1 = hi ? bfhi(a1[q >> 1]) : bflo(a1[q >> 1]);
            const float x0 = hi ? bfhi(a0[q >> 1]) : bflo(a0[q >> 1]);
            const float up = hi ? bfhi(au[q >> 1]) : bflo(au[q >> 1]);
            const int c = c0 + q;
            const float gv = cw[c] * x0 + cw[D_FF + c] * x1 + cw[2 * D_FF + c] * x2 + cb[c];
            o[q] = gv * sigm(gv) * up;
          }
          uint4 ov; ov.x = pack2(o[0], o[1]); ov.y = pack2(o[2], o[3]); ov.z = pack2(o[4], o[5]); ov.w = pack2(o[6], o[7]);
          *(uint4*)(GU + (size_t)tk * 5632 + D_FF + c0) = ov;
        }
      }
      GSYNC();
      for (int u = bid; u < 64 * 8; u += nb) {
        int tm, tn; TILE_MAP(u, 64, tm, tn);
        f32x4 acc[4][4];
        zero_acc<4>(acc);
        gemm_acc<128>(GU + (size_t)tm * 128 * 5632 + D_FF, 5632, Wt_down + (size_t)tn * 128 * 2816, 2816, 2816, smem, acc);
        EPI4_FOR(128) {
          const int row = half * TH + tm * 128 + EPI_ROW, n = tn * 128 + EPI4_COL(128);
          float4* xp = (float4*)(X + (size_t)row * 1024 + n);
          float4 xv = *xp; xv.x += acc[i][j][0]; xv.y += acc[i][j][1]; xv.z += acc[i][j][2]; xv.w += acc[i][j][3];
          *xp = xv;
        }
      }
      GSYNC();
    }
  }

  {
      PHASE_IDS
    const float* g = p.in[50];
    for (int r = bid * 4 + wave; r < T_ALL; r += nb * 4) {
      float4* xr = (float4*)(X + (size_t)r * 1024);
      float4 v[4]; float ss = 0.f;
#pragma unroll
      for (int i = 0; i < 4; ++i) { v[i] = xr[lane + 64 * i]; ss += v[i].x * v[i].x + v[i].y * v[i].y + v[i].z * v[i].z + v[i].w * v[i].w; }
      ss = wave_sum(ss);
      const float rs = rsqrtf(ss * (1.f / 1024.f) + 1e-6f);
#pragma unroll
      for (int i = 0; i < 4; ++i) {
        const float4 gg = ((const float4*)g)[lane + 64 * i];
        xr[lane + 64 * i] = float4{v[i].x * rs * gg.x, v[i].y * rs * gg.y, v[i].z * rs * gg.z, v[i].w * rs * gg.w};
      }
    }
  }
}

extern "C" void kernel_launch(void* const* d_in, const int* in_sizes, int n_in, void* d_out, int out_size, void* d_ws, size_t ws_size,
                              hipStream_t stream) {
  static int grid_blocks = 0;
  if (!grid_blocks) {
    int dev = 0, cus = 0, per_cu = 0;
    hipGetDevice(&dev);
    hipDeviceGetAttribute(&cus, hipDeviceAttributeMultiprocessorCount, dev);
    hipOccupancyMaxActiveBlocksPerMultiprocessor(&per_cu, mega_kernel, 256, 0);
    if (per_cu > 2) per_cu = 2;
    if (per_cu < 1) per_cu = 1;
    grid_blocks = cus * per_cu;
  }
  if (ws_size < WS_NEED) fprintf(stderr, "workspace too small: %zu < %zu\n", ws_size, (size_t)WS_NEED);
  Params p{};
  for (int i = 0; i < 51; ++i) p.in[i] = (const float*)d_in[i];
  p.pos = (const int*)d_in[2];
  p.out = (float*)d_out;
  p.ws = (char*)d_ws;
  hipMemsetAsync((char*)d_ws + OFF_BAR, 0, 16384, stream);
  void* args[] = {&p};
  hipError_t e = hipLaunchCooperativeKernel((void*)mega_kernel, dim3(grid_blocks), dim3(256), args, 0, stream);
  if (e != hipSuccess) fprintf(stderr, "cooperative launch failed: %s (grid %d)\n", hipGetErrorString(e), grid_blocks);
}
```

```cpp
#include <hip/hip_runtime.h>
#include <hip/hip_cooperative_groups.h>
#include <cstdio>
#include <cstdint>
namespace cg = cooperative_groups;

typedef unsigned short bf16_t;
using bf16x8 = __attribute__((ext_vector_type(8))) short;
using s16x4 = __attribute__((ext_vector_type(4))) short;
using f32x4 = __attribute__((ext_vector_type(4))) float;
using f32x16 = __attribute__((ext_vector_type(16))) float;
using u32x4 = __attribute__((ext_vector_type(4))) unsigned;
#define DI __device__ __forceinline__

constexpr int T_ALL = 16384, SEQ = 4096, DM = 1024, TH = 8192;
constexpr int P_IN = 8896, GATE_OFF = 4800;
constexpr int PLD = 4864;
constexpr int PC_HG = 512, PC_S5 = 2560, PC_RW = 3072;
constexpr int D_FF = 2816;

constexpr size_t al256(size_t x) { return (x + 255) & ~(size_t)255; }
constexpr size_t OFF_WIN = 0;
constexpr size_t OFF_WQ = OFF_WIN + al256((size_t)P_IN * 1024 * 2);
constexpr size_t OFF_WBR = OFF_WQ + al256((size_t)768 * 256 * 2);
constexpr size_t OFF_WOUT = OFF_WBR + al256((size_t)4 * 1024 * 512 * 2);
constexpr size_t OFF_WGLU = OFF_WOUT + al256((size_t)1024 * 1024 * 2);
constexpr size_t OFF_WWUP = OFF_WGLU + al256((size_t)512 * 512 * 2);
constexpr size_t OFF_WAUP = OFF_WWUP + al256((size_t)512 * 64 * 2);
constexpr size_t OFF_WGUP = OFF_WAUP + al256((size_t)512 * 64 * 2);
constexpr size_t OFF_WV = OFF_WGUP + al256((size_t)512 * 128 * 2);
constexpr size_t OFF_WXKV = OFF_WV + al256((size_t)512 * 1024 * 2);
constexpr size_t OFF_S5AB = OFF_WXKV + al256((size_t)2048 * 1024 * 2);
constexpr size_t OFF_S5BB = OFF_S5AB + al256((size_t)32 * 64 * 2 * 4);
constexpr size_t OFF_H = OFF_S5BB + al256((size_t)32 * 64 * 32 * 4);
constexpr size_t OFF_VFIRST = OFF_H + al256((size_t)T_ALL * 1024 * 2);
constexpr size_t OFF_KX = OFF_VFIRST + al256((size_t)T_ALL * 512 * 2);
constexpr size_t OFF_VXT = OFF_KX + al256((size_t)16 * 256 * 256 * 2);
constexpr size_t OFF_HM = OFF_VXT + al256((size_t)16 * 256 * 256 * 2);
constexpr size_t OFF_COS = OFF_HM + al256((size_t)1024 * 1024 * 2);
constexpr size_t OFF_SIN = OFF_COS + al256((size_t)TH * 32 * 4);
constexpr size_t OFF_BAR = OFF_SIN + al256((size_t)TH * 32 * 4);
constexpr size_t OFF_REG = OFF_BAR + 16384;
constexpr size_t R_P = OFF_REG;
constexpr size_t R_CQN = R_P + al256((size_t)TH * PLD * 2);
constexpr size_t R_QP = R_CQN + (size_t)TH * 256 * 2;
constexpr size_t R_KVLAT = R_QP + al256((size_t)TH * 768 * 2);
constexpr size_t R_VT = R_KVLAT + al256((size_t)TH * 192 * 2);
constexpr size_t R_RKV = R_VT + al256((size_t)2 * 128 * 4096 * 2);
constexpr size_t R_ALORA = R_RKV + al256((size_t)TH * 1536 * 2);
constexpr size_t R_YRW = R_ALORA + al256((size_t)TH * 256 * 2);
constexpr size_t R_ZS5 = R_YRW + al256((size_t)TH * 512 * 4);
constexpr size_t R_OHG = R_ZS5 + al256((size_t)TH * 512 * 2);
constexpr size_t R_END1 = R_OHG + al256((size_t)TH * 512 * 2);
constexpr size_t R_YBR = R_CQN;
constexpr size_t R_WXQ = OFF_REG;
constexpr size_t R_WXO = R_WXQ + al256((size_t)1024 * 1024 * 2);
constexpr size_t R_WGU = R_WXO + al256((size_t)1024 * 1024 * 2);
constexpr size_t R_WDOWN = R_WGU + al256((size_t)5632 * 1024 * 2);
constexpr size_t R_QX = R_WDOWN + al256((size_t)1024 * 2816 * 2);
constexpr size_t R_OX = R_QX + al256((size_t)T_ALL * 1024 * 2);
constexpr size_t R_GU = R_QX;
constexpr size_t R_END2 = R_GU + al256((size_t)TH * 5632 * 2);
constexpr size_t WS_NEED = (R_END1 > R_END2 ? R_END1 : R_END2);

constexpr int SMEM_BYTES = 73728;

struct Params {
  const float* in[51];
  const int* pos;
  float* out;
  char* ws;
};

DI bf16_t f2bf(float x) { unsigned u = __float_as_uint(x); u += 0x7fffu + ((u >> 16) & 1u); return (bf16_t)(u >> 16); }
DI float bf2f(bf16_t b) { return __uint_as_float(((unsigned)b) << 16); }
DI unsigned pack2(float a, float b) { return (unsigned)f2bf(a) | ((unsigned)f2bf(b) << 16); }
DI float bflo(unsigned u) { return __uint_as_float(u << 16); }
DI float bfhi(unsigned u) { return __uint_as_float(u & 0xffff0000u); }
DI float sigm(float x) { return __builtin_amdgcn_rcpf(1.f + __expf(-x)); }
template <int CTRL> DI float dppf(float v) {
  return __builtin_bit_cast(float, __builtin_amdgcn_update_dpp(0, __builtin_bit_cast(int, v), CTRL, 0xf, 0xf, false));
}
DI float red8(float v) { v += dppf<0xB1>(v); v += dppf<0x4E>(v); v += dppf<0x141>(v); return v; }
DI float red16(float v) { v = red8(v); v += dppf<0x140>(v); return v; }
DI int TID() { int t = threadIdx.x; asm volatile("" : "+v"(t)); return t; }
#define PHASE_IDS const int tid = TID(); const int lane = tid & 63, wave = tid >> 6; (void)lane; (void)wave;
DI float wave_sum(float v) { for (int o = 32; o > 0; o >>= 1) v += __shfl_xor(v, o); return v; }


#define XB_TMO      128
#define XB_XCNT(j)  (256  + 64 * (j))
#define XB_XSUB(j)  (1280 + 64 * (j))
#define XB_XGEN(j)  (2304 + 64 * (j))
#define XB_TOP      3328
#define XB_TOPGEN   3392
#define XCD_BAR_WORDS 3456
#define XB_SPIN_CAP (1u << 22)
#define LAS __attribute__((address_space(3)))
DI unsigned xb_ld(unsigned* p) { return __hip_atomic_load(p, __ATOMIC_RELAXED, __HIP_MEMORY_SCOPE_AGENT); }
DI unsigned xb_add(unsigned* p, unsigned v) { return __hip_atomic_fetch_add(p, v, __ATOMIC_RELAXED, __HIP_MEMORY_SCOPE_AGENT); }
DI unsigned xb_xcc_id() { return (unsigned)__builtin_amdgcn_s_getreg((3 << 11) | 20) & 0xFu; }
#define XB_SPIN(cond, bar) do { unsigned _sp = 0; while (cond) { __builtin_amdgcn_s_sleep(1); \
    if ((++_sp & 255u) == 0u) { if (xb_ld(&(bar)[XB_TMO])) break; if (_sp > XB_SPIN_CAP) { atomicAdd(&(bar)[XB_TMO], 1u); break; } } } } while (0)
struct XcdBarrier { unsigned* bar; unsigned x; volatile LAS unsigned* st; };
DI XcdBarrier xcd_barrier_post(unsigned* bar, volatile LAS unsigned* st) {
  XcdBarrier b; b.bar = bar; b.x = xb_xcc_id(); b.st = st;
  if (threadIdx.x == 0) (void)xb_add(&bar[XB_XCNT(b.x)], 1u);
  return b;
}
DI void xcd_barrier_complete(unsigned* bar, unsigned x, unsigned& nloc, unsigned& nx) {
  const unsigned G = gridDim.x * gridDim.y * gridDim.z;
  unsigned sum, cnt, mine, sp = 0u;
  for (;;) {
    sum = 0u; cnt = 0u; mine = 0u;
#pragma unroll
    for (unsigned j = 0; j < 16; ++j) { const unsigned c = xb_ld(&bar[XB_XCNT(j)]); sum += c; cnt += (c > 0u) ? 1u : 0u; mine = (j == x) ? c : mine; }
    if (sum == G) break;
    __builtin_amdgcn_s_sleep(1);
    if ((++sp & 255u) == 0u) { if (xb_ld(&bar[XB_TMO])) break; if (sp > XB_SPIN_CAP) { atomicAdd(&bar[XB_TMO], 1u); break; } }
  }
  nloc = mine > 0u ? mine : 1u; nx = cnt > 0u ? cnt : 1u;
}
DI void xcd_barrier(const XcdBarrier& b) {
  asm volatile("s_waitcnt vmcnt(0)" ::: "memory");
  __syncthreads();
  if (threadIdx.x == 0) {
    unsigned* bar = b.bar;
    __builtin_amdgcn_s_waitcnt(0);
    unsigned nloc = b.st[0], nx = b.st[1];
    if (nloc == 0u) { xcd_barrier_complete(bar, b.x, nloc, nx); b.st[0] = nloc; b.st[1] = nx; }
    const unsigned old = xb_add(&bar[XB_XSUB(b.x)], 1u);
    const unsigned gen = old / nloc;
    if (old + 1u == (gen + 1u) * nloc) {
      __builtin_amdgcn_fence(__ATOMIC_RELEASE, "agent");
      asm volatile("s_waitcnt vmcnt(0)" ::: "memory");
      const unsigned og = xb_add(&bar[XB_TOP], 1u);
      const unsigned tg = og / nx;
      if (og + 1u == (tg + 1u) * nx) xb_add(&bar[XB_TOPGEN], 1u);
      else XB_SPIN(xb_ld(&bar[XB_TOPGEN]) == tg, bar);
      __builtin_amdgcn_fence(__ATOMIC_ACQUIRE, "agent");
      xb_add(&bar[XB_XGEN(b.x)], 1u);
      asm volatile("s_waitcnt vmcnt(0)" ::: "memory");
    } else {
      XB_SPIN(xb_ld(&bar[XB_XGEN(b.x)]) == gen, bar);
      __builtin_amdgcn_fence(__ATOMIC_ACQUIRE, "agent");
      asm volatile("s_waitcnt vmcnt(0)" ::: "memory");
    }
  }
  __syncthreads();
}

#define GLOAD16(dst, ptr) asm volatile("global_load_dwordx4 %0, %1, off" : "=v"(dst) : "v"(ptr))
template <int BN>
DI void gemm_acc(const bf16_t* __restrict__ A, int lda, const bf16_t* __restrict__ Bt, int ldb, int K, char* smem,
                 f32x4 (&acc)[4][BN / 32]) {
  constexpr int A_EL = 128 * 72, B_EL = BN * 72, BUF_EL = A_EL + B_EL;
  constexpr int NJ = BN / 32, BCH = BN / 32;
  bf16_t* sm = (bf16_t*)smem;
  const int tid = TID(), lane = tid & 63, wave = tid >> 6;
  const int wm = wave >> 1, wn = wave & 1, l16 = lane & 15, quad = lane >> 4;
  const int crow = tid >> 3, ccol = (tid & 7) * 8;
  u32x4 ra[4], rb[BCH];
  const bf16_t* Ap = A + (size_t)crow * lda + ccol;
  const bf16_t* Bp = Bt + (size_t)crow * ldb + ccol;
  const int nk = K >> 6;
#define GEMM_ISSUE(k0_)                                                                           \
  {                                                                                               \
    _Pragma("unroll") for (int i = 0; i < 4; ++i) GLOAD16(ra[i], Ap + (size_t)(32 * i) * lda + (k0_));   \
    _Pragma("unroll") for (int i = 0; i < BCH; ++i) GLOAD16(rb[i], Bp + (size_t)(32 * i) * ldb + (k0_)); \
  }
#define GEMM_LAND(buf_)                                                                           \
  {                                                                                               \
    if constexpr (BCH == 4)                                                                       \
      asm volatile("s_waitcnt vmcnt(0)" : "+v"(ra[0]), "+v"(ra[1]), "+v"(ra[2]), "+v"(ra[3]), "+v"(rb[0]), "+v"(rb[1]), "+v"(rb[2]), "+v"(rb[3])); \
    else                                                                                          \
      asm volatile("s_waitcnt vmcnt(0)" : "+v"(ra[0]), "+v"(ra[1]), "+v"(ra[2]), "+v"(ra[3]), "+v"(rb[0]), "+v"(rb[1])); \
    bf16_t* sa_ = sm + (buf_) * BUF_EL; bf16_t* sb_ = sa_ + A_EL;                                 \
    _Pragma("unroll") for (int i = 0; i < 4; ++i) *(u32x4*)(sa_ + (crow + 32 * i) * 72 + ccol) = ra[i];   \
    _Pragma("unroll") for (int i = 0; i < BCH; ++i) *(u32x4*)(sb_ + (crow + 32 * i) * 72 + ccol) = rb[i]; \
  }
  GEMM_ISSUE(0);
  GEMM_LAND(0);
  __syncthreads();
  for (int kt = 0; kt < nk; ++kt) {
    {
      const int k0 = ((kt + 1 < nk) ? (kt + 1) : kt) << 6;
      GEMM_ISSUE(k0);
    }
    __builtin_amdgcn_sched_barrier(0);
    {
      const bf16_t* sa = sm + (kt & 1) * BUF_EL; const bf16_t* sb = sa + A_EL;
#pragma unroll
      for (int ks = 0; ks < 2; ++ks) {
        bf16x8 a[4], b[NJ];
#pragma unroll
        for (int i = 0; i < 4; ++i) a[i] = *(const bf16x8*)(sa + (wm * 64 + i * 16 + l16) * 72 + ks * 32 + quad * 8);
#pragma unroll
        for (int j = 0; j < NJ; ++j) b[j] = *(const bf16x8*)(sb + (wn * (BN / 2) + j * 16 + l16) * 72 + ks * 32 + quad * 8);
#pragma unroll
        for (int i = 0; i < 4; ++i)
#pragma unroll
          for (int j = 0; j < NJ; ++j) acc[i][j] = __builtin_amdgcn_mfma_f32_16x16x32_bf16(b[j], a[i], acc[i][j], 0, 0, 0);
      }
    }
    __builtin_amdgcn_sched_barrier(0);
    GEMM_LAND((kt + 1) & 1);
    __syncthreads();
  }
#undef GEMM_ISSUE
#undef GEMM_LAND
}
template <int NJ> DI void zero_acc(f32x4 (&acc)[4][NJ]) {
#pragma unroll
  for (int i = 0; i < 4; ++i)
#pragma unroll
    for (int j = 0; j < NJ; ++j) acc[i][j] = f32x4{0.f, 0.f, 0.f, 0.f};
}
#define EPI_FOR(BN_)                                                                         \
  const int _t = TID(); const int _lane = _t & 63, _wave = _t >> 6;                              \
  const int _wm = _wave >> 1, _wn = _wave & 1, _l16 = _lane & 15, _quad = _lane >> 4;        \
  _Pragma("unroll") for (int i = 0; i < 4; ++i)                                              \
  _Pragma("unroll") for (int j = 0; j < (BN_) / 32; ++j)                                     \
  _Pragma("unroll") for (int r = 0; r < 4; ++r)
#define EPI_ROW (_wm * 64 + i * 16 + _l16)
#define EPI_COL(BN_) (_wn * ((BN_) / 2) + j * 16 + _quad * 4 + r)
#define EPI4_FOR(BN_)                                                                        \
  const int _t = TID(); const int _lane = _t & 63, _wave = _t >> 6;                          \
  const int _wm = _wave >> 1, _wn = _wave & 1, _l16 = _lane & 15, _quad = _lane >> 4;        \
  _Pragma("unroll") for (int i = 0; i < 4; ++i)                                              \
  _Pragma("unroll") for (int j = 0; j < (BN_) / 32; ++j)
#define EPI4_COL(BN_) (_wn * ((BN_) / 2) + j * 16 + _quad * 4)
DI uint2 pack4(f32x4 v) { uint2 o; o.x = pack2(v[0], v[1]); o.y = pack2(v[2], v[3]); return o; }
DI f32x4 unpack4(uint2 u) { return f32x4{bflo(u.x), bfhi(u.x), bflo(u.y), bfhi(u.y)}; }

DI void transpose_tile(const float* __restrict__ W, int ldw, bf16_t* __restrict__ Wt, int ldt, int k0, int n0, char* smem) {
  float* sm = (float*)smem;
  const int tid = TID();
  __syncthreads();
#pragma unroll
  for (int i = 0; i < 4; ++i) {
    const int k = (tid >> 4) + 16 * i, n4 = (tid & 15) * 4;
    const float4 v = *(const float4*)(W + (size_t)(k0 + k) * ldw + n0 + n4);
    sm[k * 65 + n4 + 0] = v.x; sm[k * 65 + n4 + 1] = v.y; sm[k * 65 + n4 + 2] = v.z; sm[k * 65 + n4 + 3] = v.w;
  }
  __syncthreads();
  const int n = tid >> 2, ks = (tid & 3) * 16;
  unsigned u[8];
#pragma unroll
  for (int e = 0; e < 8; ++e) u[e] = pack2(sm[(ks + 2 * e) * 65 + n], sm[(ks + 2 * e + 1) * 65 + n]);
  uint4* dst = (uint4*)(Wt + (size_t)(n0 + n) * ldt + k0 + ks);
  dst[0] = uint4{u[0], u[1], u[2], u[3]};
  dst[1] = uint4{u[4], u[5], u[6], u[7]};
}
DI void transpose_all(const float* W, int ldw, int K, int N, bf16_t* Wt, int bid, int nb, char* smem) {
  const int tk = K >> 6, tn = N >> 6;
  for (int t = bid; t < tk * tn; t += nb) transpose_tile(W, ldw, Wt, K, (t % tk) * 64, (t / tk) * 64, smem);
}

DI void rmsnorm_rows(const float* __restrict__ x, const float* __restrict__ g, bf16_t* __restrict__ h, float* xcopy, int rows,
                     int bid, int nb) {
  const int lane = TID() & 63, wave = TID() >> 6;
  for (int r = bid * 4 + wave; r < rows; r += nb * 4) {
    const float4* xr = (const float4*)(x + (size_t)r * 1024);
    float4 v[4]; float ss = 0.f;
#pragma unroll
    for (int i = 0; i < 4; ++i) { v[i] = xr[lane + 64 * i]; ss += v[i].x * v[i].x + v[i].y * v[i].y + v[i].z * v[i].z + v[i].w * v[i].w; }
    ss = wave_sum(ss);
    const float rs = rsqrtf(ss * (1.f / 1024.f) + 1e-6f);
#pragma unroll
    for (int i = 0; i < 4; ++i) {
      const float4 gg = ((const float4*)g)[lane + 64 * i];
      uint2 o; o.x = pack2(v[i].x * rs * gg.x, v[i].y * rs * gg.y); o.y = pack2(v[i].z * rs * gg.z, v[i].w * rs * gg.w);
      *(uint2*)(h + (size_t)r * 1024 + (lane + 64 * i) * 4) = o;
      if (xcopy) ((float4*)(xcopy + (size_t)r * 1024))[lane + 64 * i] = v[i];
    }
  }
}

template <int DQK, bool CAUSAL>
DI void attn_item(const bf16_t* __restrict__ Q, int ldq, const bf16_t* __restrict__ Kp, int ldk, const bf16_t* __restrict__ VT, int ldvt,
                  int ntiles, int q0, bf16_t* __restrict__ out, int ldo, char* smem) {
  constexpr int KS = DQK + 8, NS = DQK / 16, KCH = DQK / 8;
  bf16_t* Ks = (bf16_t*)smem;
  bf16_t* Vs = Ks + 64 * KS;
  const int tid = TID(), lane = tid & 63, wave = tid >> 6, ql = lane & 31, hh = lane >> 5;
  const int qrow = q0 + wave * 32 + ql;
  bf16x8 bq[NS];
#pragma unroll
  for (int s = 0; s < NS; ++s) bq[s] = *(const bf16x8*)(Q + (size_t)qrow * ldq + s * 16 + hh * 8);
  f32x16 ot[4];
#pragma unroll
  for (int d = 0; d < 4; ++d)
#pragma unroll
    for (int i = 0; i < 16; ++i) ot[d][i] = 0.f;
  float mrun = -INFINITY, lrun = 0.f;
  for (int kt = 0; kt < ntiles; ++kt) {
    __syncthreads();
    for (int c = tid; c < 64 * KCH; c += 256) {
      const int row = c / KCH, cc = c % KCH;
      *(uint4*)(Ks + row * KS + cc * 8) = *(const uint4*)(Kp + (size_t)(kt * 64 + row) * ldk + cc * 8);
    }
#pragma unroll
    for (int c0 = 0; c0 < 4; ++c0) {
      const int c = tid + c0 * 256, row = c >> 3, cc = c & 7;
      *(uint4*)(Vs + row * 72 + cc * 8) = *(const uint4*)(VT + (size_t)row * ldvt + kt * 64 + cc * 8);
    }
    __syncthreads();
    f32x16 st[2];
#pragma unroll
    for (int kb = 0; kb < 2; ++kb) {
#pragma unroll
      for (int i = 0; i < 16; ++i) st[kb][i] = 0.f;
#pragma unroll
      for (int s = 0; s < NS; ++s) {
        const bf16x8 a = *(const bf16x8*)(Ks + (kb * 32 + ql) * KS + s * 16 + hh * 8);
        st[kb] = __builtin_amdgcn_mfma_f32_32x32x16_bf16(a, bq[s], st[kb], 0, 0, 0);
      }
    }
    float mx = -INFINITY;
#pragma unroll
    for (int kb = 0; kb < 2; ++kb)
#pragma unroll
      for (int i = 0; i < 16; ++i) {
        if (CAUSAL) {
          const int key = kt * 64 + kb * 32 + (i & 3) + 8 * (i >> 2) + 4 * hh;
          if (key > qrow) st[kb][i] = -INFINITY;
        }
        mx = fmaxf(mx, st[kb][i]);
      }
    mx = fmaxf(mx, __shfl_xor(mx, 32));
    const float mnew = fmaxf(mrun, mx);
    const float alpha = __builtin_amdgcn_exp2f(mrun - mnew);
    float ps = 0.f;
#pragma unroll
    for (int kb = 0; kb < 2; ++kb)
#pragma unroll
      for (int i = 0; i < 16; ++i) { const float pv = __builtin_amdgcn_exp2f(st[kb][i] - mnew); st[kb][i] = pv; ps += pv; }
    ps += __shfl_xor(ps, 32);
    lrun = lrun * alpha + ps;
    mrun = mnew;
#pragma unroll
    for (int d = 0; d < 4; ++d)
#pragma unroll
      for (int i = 0; i < 16; ++i) ot[d][i] *= alpha;
#pragma unroll
    for (int kb = 0; kb < 2; ++kb)
#pragma unroll
      for (int s2 = 0; s2 < 2; ++s2) {
        unsigned pk[4];
#pragma unroll
        for (int e = 0; e < 4; ++e) pk[e] = pack2(st[kb][8 * s2 + 2 * e], st[kb][8 * s2 + 2 * e + 1]);
        const bf16x8 pb = __builtin_bit_cast(bf16x8, uint4{pk[0], pk[1], pk[2], pk[3]});
#pragma unroll
        for (int d = 0; d < 4; ++d) {
          const bf16_t* vp = Vs + (d * 32 + ql) * 72 + kb * 32 + s2 * 16 + hh * 4;
          const s16x4 lo = *(const s16x4*)vp;
          const s16x4 hi = *(const s16x4*)(vp + 8);
          const bf16x8 av = __builtin_shufflevector(lo, hi, 0, 1, 2, 3, 4, 5, 6, 7);
          ot[d] = __builtin_amdgcn_mfma_f32_32x32x16_bf16(av, pb, ot[d], 0, 0, 0);
        }
      }
  }
  const float inv = 1.f / lrun;
#pragma unroll
  for (int d = 0; d < 4; ++d)
#pragma unroll
    for (int g4 = 0; g4 < 4; ++g4) {
      uint2 o; o.x = pack2(ot[d][4 * g4] * inv, ot[d][4 * g4 + 1] * inv); o.y = pack2(ot[d][4 * g4 + 2] * inv, ot[d][4 * g4 + 3] * inv);
      *(uint2*)(out + (size_t)qrow * ldo + d * 32 + 8 * g4 + 4 * hh) = o;
    }
}


template <int DQK, bool CAUSAL>
DI void attn_item_pf(const bf16_t* __restrict__ Q, int ldq, const bf16_t* __restrict__ Kp, int ldk, const bf16_t* __restrict__ VT, int ldvt,
                  int ntiles, int q0, bf16_t* __restrict__ out, int ldo, char* smem) {
  constexpr int KS = DQK + 8, NS = DQK / 16, KCH = DQK / 8;
  bf16_t* Ks = (bf16_t*)smem;
  bf16_t* Vs = Ks + 64 * KS;
  const int tid = TID(), lane = tid & 63, wave = tid >> 6, ql = lane & 31, hh = lane >> 5;
  const int qrow = q0 + wave * 32 + ql;
  bf16x8 bq[NS];
#pragma unroll
  for (int s = 0; s < NS; ++s) bq[s] = *(const bf16x8*)(Q + (size_t)qrow * ldq + s * 16 + hh * 8);
  f32x16 ot[4];
#pragma unroll
  for (int d = 0; d < 4; ++d)
#pragma unroll
    for (int i = 0; i < 16; ++i) ot[d][i] = 0.f;
  float mrun = -INFINITY, lrun = 0.f;
  constexpr int KR = KCH / 4;
  static_assert(KR == 6, "prefetch variant is written for DQK = 192");
  u32x4 kreg[KR], vreg[4];
  const unsigned kvoff = (unsigned)(((tid >> 2) * ldk + (tid & 3) * 8) * 2);
  const unsigned vvoff = (unsigned)(((tid >> 3) * ldvt + (tid & 7) * 8) * 2);
#define GLOADS(dst, voff, sbase) asm volatile("global_load_dwordx4 %0, %1, %2" : "=v"(dst) : "v"(voff), "s"(sbase))
#define ATT_ISSUE(kt_)                                                                                        \
  {                                                                                                           \
    _Pragma("unroll") for (int c0 = 0; c0 < KR; ++c0) GLOADS(kreg[c0], kvoff, Kp + (size_t)(kt_) * 64 * ldk + c0 * 32);   \
    _Pragma("unroll") for (int c0 = 0; c0 < 4; ++c0) GLOADS(vreg[c0], vvoff, VT + (size_t)(c0 * 32) * ldvt + (kt_) * 64); \
  }
#define ATT_LAND()                                                                                            \
  {                                                                                                           \
    asm volatile("s_waitcnt vmcnt(0)" : "+v"(kreg[0]), "+v"(kreg[1]), "+v"(kreg[2]), "+v"(kreg[3]), "+v"(kreg[4]), "+v"(kreg[5]), \
                 "+v"(vreg[0]), "+v"(vreg[1]), "+v"(vreg[2]), "+v"(vreg[3]));                                 \
    _Pragma("unroll") for (int c0 = 0; c0 < KR; ++c0) *(u32x4*)(Ks + (tid >> 2) * KS + ((tid & 3) + 4 * c0) * 8) = kreg[c0];   \
    _Pragma("unroll") for (int c0 = 0; c0 < 4; ++c0) *(u32x4*)(Vs + ((tid >> 3) + 32 * c0) * 72 + (tid & 7) * 8) = vreg[c0];   \
  }
  __syncthreads();
  ATT_ISSUE(0);
  ATT_LAND();
  __syncthreads();
  for (int kt = 0; kt < ntiles; ++kt) {
    {
      const int ktn = (kt + 1 < ntiles) ? kt + 1 : kt;
      ATT_ISSUE(ktn);
    }
    __builtin_amdgcn_sched_barrier(0);
    f32x16 st[2];
#pragma unroll
    for (int kb = 0; kb < 2; ++kb) {
#pragma unroll
      for (int i = 0; i < 16; ++i) st[kb][i] = 0.f;
#pragma unroll
      for (int s = 0; s < NS; ++s) {
        const bf16x8 a = *(const bf16x8*)(Ks + (kb * 32 + ql) * KS + s * 16 + hh * 8);
        st[kb] = __builtin_amdgcn_mfma_f32_32x32x16_bf16(a, bq[s], st[kb], 0, 0, 0);
      }
    }
    float mx = -INFINITY;
#pragma unroll
    for (int kb = 0; kb < 2; ++kb)
#pragma unroll
      for (int i = 0; i < 16; ++i) {
        if (CAUSAL) {
          const int key = kt * 64 + kb * 32 + (i & 3) + 8 * (i >> 2) + 4 * hh;
          if (key > qrow) st[kb][i] = -INFINITY;
        }
        mx = fmaxf(mx, st[kb][i]);
      }
    mx = fmaxf(mx, __shfl_xor(mx, 32));
    const float mnew = fmaxf(mrun, mx);
    const float alpha = __builtin_amdgcn_exp2f(mrun - mnew);
    float ps = 0.f;
#pragma unroll
    for (int kb = 0; kb < 2; ++kb)
#pragma unroll
      for (int i = 0; i < 16; ++i) { const float pv = __builtin_amdgcn_exp2f(st[kb][i] - mnew); st[kb][i] = pv; ps += pv; }
    ps += __shfl_xor(ps, 32);
    lrun = lrun * alpha + ps;
    mrun = mnew;
#pragma unroll
    for (int d = 0; d < 4; ++d)
#pragma unroll
      for (int i = 0; i < 16; ++i) ot[d][i] *= alpha;
#pragma unroll
    for (int kb = 0; kb < 2; ++kb)
#pragma unroll
      for (int s2 = 0; s2 < 2; ++s2) {
        unsigned pk[4];
#pragma unroll
        for (int e = 0; e < 4; ++e) pk[e] = pack2(st[kb][8 * s2 + 2 * e], st[kb][8 * s2 + 2 * e + 1]);
        const bf16x8 pb = __builtin_bit_cast(bf16x8, uint4{pk[0], pk[1], pk[2], pk[3]});
#pragma unroll
        for (int d = 0; d < 4; ++d) {
          const bf16_t* vp = Vs + (d * 32 + ql) * 72 + kb * 32 + s2 * 16 + hh * 4;
          const s16x4 lo = *(const s16x4*)vp;
          const s16x4 hi = *(const s16x4*)(vp + 8);
          const bf16x8 av = __builtin_shufflevector(lo, hi, 0, 1, 2, 3, 4, 5, 6, 7);
          ot[d] = __builtin_amdgcn_mfma_f32_32x32x16_bf16(av, pb, ot[d], 0, 0, 0);
        }
      }
    __builtin_amdgcn_sched_barrier(0);
    __syncthreads();
    ATT_LAND();
    __syncthreads();
  }
#undef ATT_ISSUE
#undef ATT_LAND
#undef GLOADS
  const float inv = 1.f / lrun;
#pragma unroll
  for (int d = 0; d < 4; ++d)
#pragma unroll
    for (int g4 = 0; g4 < 4; ++g4) {
      uint2 o; o.x = pack2(ot[d][4 * g4] * inv, ot[d][4 * g4 + 1] * inv); o.y = pack2(ot[d][4 * g4 + 2] * inv, ot[d][4 * g4 + 3] * inv);
      *(uint2*)(out + (size_t)qrow * ldo + d * 32 + 8 * g4 + 4 * hh) = o;
    }
}

DI void rwkv_scan_unit(const Params& p, int l, int u, char* smem) {
  const int tid = TID();
  const int bl = u >> 5, hd = (u >> 2) & 7, rg = u & 3;
  const int kq = tid & 15, g16 = tid >> 4;
  const bf16_t* RKV = (const bf16_t*)(p.ws + R_RKV) + (size_t)bl * SEQ * 1536;
  const bf16_t* Pm = (const bf16_t*)(p.ws + R_P) + (size_t)bl * SEQ * PLD;
  float* Y = (float*)(p.ws + R_YRW) + (size_t)bl * SEQ * 512;
  float* sm = (float*)smem;
  constexpr int BUFF = 5 * 1024 + 256 + 32;
  const int kc = hd * 64 + kq * 4;
  const float4 kk_w = *(const float4*)(p.in[27] + l * 512 + kc);
  const float4 ka_w = *(const float4*)(p.in[28] + l * 512 + kc);
  float S0 = 0.f, S1 = 0.f, S2 = 0.f, S3 = 0.f;
  uint2 g_r, g_k, g_w, g_a; bf16_t g_v;
  auto gload = [&](int c) {
    const int tok = c * 16 + g16;
    g_r = *(const uint2*)(RKV + (size_t)tok * 1536 + kc);
    g_k = *(const uint2*)(RKV + (size_t)tok * 1536 + 512 + kc);
    g_v = RKV[(size_t)tok * 1536 + 1024 + hd * 64 + rg * 16 + kq];
    g_w = *(const uint2*)(Pm + (size_t)tok * PLD + PC_RW + kc);
    g_a = *(const uint2*)(Pm + (size_t)tok * PLD + PC_RW + 512 + kc);
  };
  auto derive = [&](int buf) {
    float* b = sm + buf * BUFF;
    const float r[4] = {bflo(g_r.x), bfhi(g_r.x), bflo(g_r.y), bfhi(g_r.y)};
    const float k[4] = {bflo(g_k.x), bfhi(g_k.x), bflo(g_k.y), bfhi(g_k.y)};
    const float w[4] = {bflo(g_w.x), bfhi(g_w.x), bflo(g_w.y), bfhi(g_w.y)};
    const float a[4] = {bflo(g_a.x), bfhi(g_a.x), bflo(g_a.y), bfhi(g_a.y)};
    const float kkw[4] = {kk_w.x, kk_w.y, kk_w.z, kk_w.w};
    const float kaw[4] = {ka_w.x, ka_w.y, ka_w.z, ka_w.w};
    float kk[4], ss = 0.f;
#pragma unroll
    for (int e = 0; e < 4; ++e) { kk[e] = k[e] * kkw[e]; ss += kk[e] * kk[e]; }
    ss = red16(ss);
    const float rn = rsqrtf(ss + 1e-12f);
    float dwr[4], dw[4], dk[4], dn[4], db[4];
    float br = 0.f, khr = 0.f;
#pragma unroll
    for (int e = 0; e < 4; ++e) {
      dw[e] = __expf(-0.6065306597126334f * sigm(w[e]));
      const float kn = kk[e] * rn;
      dn[e] = -kn; db[e] = kn * a[e];
      dk[e] = k[e] * (1.f + (a[e] - 1.f) * kaw[e]);
      dwr[e] = dw[e] * r[e];
      br += db[e] * r[e]; khr += dk[e] * r[e];
    }
    br = red16(br); khr = red16(khr);
#pragma unroll
    for (int e = 0; e < 4; ++e) dwr[e] += dn[e] * br;
    *(float4*)(b + 0 * 1024 + g16 * 64 + kq * 4) = float4{dwr[0], dwr[1], dwr[2], dwr[3]};
    *(float4*)(b + 1 * 1024 + g16 * 64 + kq * 4) = float4{dw[0], dw[1], dw[2], dw[3]};
    *(float4*)(b + 2 * 1024 + g16 * 64 + kq * 4) = float4{dk[0], dk[1], dk[2], dk[3]};
    *(float4*)(b + 3 * 1024 + g16 * 64 + kq * 4) = float4{dn[0], dn[1], dn[2], dn[3]};
    *(float4*)(b + 4 * 1024 + g16 * 64 + kq * 4) = float4{db[0], db[1], db[2], db[3]};
    b[5 * 1024 + g16 * 16 + kq] = bf2f(g_v);
    if (kq == 0) b[5 * 1024 + 256 + g16] = khr;
  };
  __syncthreads();
  gload(0); derive(0);
  __syncthreads();
  constexpr int NC = SEQ / 16;
  for (int c = 0; c < NC; ++c) {
    if (c + 1 < NC) gload(c + 1);
    const float* b = sm + (c & 1) * BUFF;
    float ysel = 0.f;
    float4 nk = *(const float4*)(b + 3 * 1024 + kq * 4);
    float4 w = *(const float4*)(b + 1 * 1024 + kq * 4);
    float4 bb = *(const float4*)(b + 4 * 1024 + kq * 4);
    float4 kh = *(const float4*)(b + 2 * 1024 + kq * 4);
    float4 wr = *(const float4*)(b + 0 * 1024 + kq * 4);
    float v = b[5 * 1024 + g16];
    float khrs = b[5 * 1024 + 256];
#pragma unroll
    for (int t = 0; t < 16; ++t) {
      float4 nk2, w2, bb2, kh2, wr2; float v2, khrs2;
      if (t < 15) {
        nk2 = *(const float4*)(b + 3 * 1024 + (t + 1) * 64 + kq * 4);
        w2 = *(const float4*)(b + 1 * 1024 + (t + 1) * 64 + kq * 4);
        bb2 = *(const float4*)(b + 4 * 1024 + (t + 1) * 64 + kq * 4);
        kh2 = *(const float4*)(b + 2 * 1024 + (t + 1) * 64 + kq * 4);
        wr2 = *(const float4*)(b + 0 * 1024 + (t + 1) * 64 + kq * 4);
        v2 = b[5 * 1024 + (t + 1) * 16 + g16];
        khrs2 = b[5 * 1024 + 256 + t + 1];
      }
      float sa = S0 * nk.x + S1 * nk.y + S2 * nk.z + S3 * nk.w;
      float yy = S0 * wr.x + S1 * wr.y + S2 * wr.z + S3 * wr.w;
      sa = red16(sa);
      yy = red16(yy);
      S0 = S0 * w.x + sa * bb.x + v * kh.x;
      S1 = S1 * w.y + sa * bb.y + v * kh.y;
      S2 = S2 * w.z + sa * bb.z + v * kh.z;
      S3 = S3 * w.w + sa * bb.w + v * kh.w;
      yy += v * khrs;
      ysel = (kq == t) ? yy : ysel;
      if (t < 15) { nk = nk2; w = w2; bb = bb2; kh = kh2; wr = wr2; v = v2; khrs = khrs2; }
    }
    Y[(size_t)(c * 16 + kq) * 512 + hd * 64 + rg * 16 + g16] = ysel;
    if (c + 1 < NC) derive((c + 1) & 1);
    __syncthreads();
  }
}

DI void hgrn_scan_unit(const Params& p, int l, int u, char* smem) {
  const int tid = TID();
  const int bl = u >> 5, hd = (u >> 3) & 3, vg = u & 7;
  const int kq = tid & 15, g16 = tid >> 4;
  const bf16_t* Pm = (const bf16_t*)(p.ws + R_P) + (size_t)bl * SEQ * PLD;
  bf16_t* Og = (bf16_t*)(p.ws + R_OHG) + (size_t)bl * SEQ * 512;
  float* sm = (float*)smem;
  constexpr int BUFF = 2 * 2048 + 256 + 16;
  const int kc = hd * 128 + kq * 8;
  float lb[8];
#pragma unroll
  for (int e = 0; e < 8; ++e) {
    if (l == 0) lb[e] = 0.f;
    else { const float x0 = p.in[9][kc + e], x1 = p.in[9][512 + kc + e]; lb[e] = 1.f / (1.f + expf(x0 - x1)); }
  }
  float S[8];
#pragma unroll
  for (int e = 0; e < 8; ++e) S[e] = 0.f;
  uint4 g_q, g_f; bf16_t g_v;
  const int vcol = PC_HG + 1024 + hd * 128 + vg * 16;
  auto gload = [&](int c) {
    const int tok = c * 16 + g16;
    g_q = *(const uint4*)(Pm + (size_t)tok * PLD + PC_HG + kc);
    g_f = *(const uint4*)(Pm + (size_t)tok * PLD + PC_HG + 512 + kc);
    g_v = Pm[(size_t)tok * PLD + vcol + kq];
  };
  auto derive = [&](int buf) {
    float* b = sm + buf * BUFF;
    const unsigned qu[4] = {g_q.x, g_q.y, g_q.z, g_q.w}, fu[4] = {g_f.x, g_f.y, g_f.z, g_f.w};
    float fq[8], f[8], cs = 0.f;
#pragma unroll
    for (int e = 0; e < 8; ++e) {
      const float q = (e & 1) ? bfhi(qu[e >> 1]) : bflo(qu[e >> 1]);
      const float fx = (e & 1) ? bfhi(fu[e >> 1]) : bflo(fu[e >> 1]);
      f[e] = lb[e] + (1.f - lb[e]) * sigm(fx);
      fq[e] = f[e] * q;
      cs += (1.f - f[e]) * q;
    }
    cs = red16(cs);
    *(float4*)(b + g16 * 128 + kq * 8) = float4{fq[0], fq[1], fq[2], fq[3]};
    *(float4*)(b + g16 * 128 + kq * 8 + 4) = float4{fq[4], fq[5], fq[6], fq[7]};
    *(float4*)(b + 2048 + g16 * 128 + kq * 8) = float4{f[0], f[1], f[2], f[3]};
    *(float4*)(b + 2048 + g16 * 128 + kq * 8 + 4) = float4{f[4], f[5], f[6], f[7]};
    b[4096 + g16 * 16 + kq] = bf2f(g_v);
    if (kq == 0) b[4096 + 256 + g16] = cs;
  };
  __syncthreads();
  gload(0); derive(0);
  __syncthreads();
  constexpr int NC = SEQ / 16;
  for (int c = 0; c < NC; ++c) {
    if (c + 1 < NC) gload(c + 1);
    const float* b = sm + (c & 1) * BUFF;
    float osel = 0.f;
#pragma unroll
    for (int t = 0; t < 16; ++t) {
      const float4 q0 = *(const float4*)(b + t * 128 + kq * 8), q1 = *(const float4*)(b + t * 128 + kq * 8 + 4);
      const float4 f0 = *(const float4*)(b + 2048 + t * 128 + kq * 8), f1 = *(const float4*)(b + 2048 + t * 128 + kq * 8 + 4);
      const float v = b[4096 + t * 16 + g16];
      const float cs = b[4096 + 256 + t];
      const float fq[8] = {q0.x, q0.y, q0.z, q0.w, q1.x, q1.y, q1.z, q1.w};
      const float f[8] = {f0.x, f0.y, f0.z, f0.w, f1.x, f1.y, f1.z, f1.w};
      float o = 0.f;
#pragma unroll
      for (int e = 0; e < 8; ++e) { o += S[e] * fq[e]; S[e] = f[e] * (S[e] - v) + v; }
      o = red16(o) + v * cs;
      osel = (kq == t) ? o : osel;
    }
    Og[(size_t)(c * 16 + kq) * 512 + hd * 128 + vg * 16 + g16] = f2bf(osel);
    if (c + 1 < NC) derive((c + 1) & 1);
    __syncthreads();
  }
}

DI void s5_scan_unit(const Params& p, int l, int u, char* smem) {
  const int tid = TID(), lane = tid & 63, wave = tid >> 6;
  const int idx = u * 4 + wave, bl = idx >> 5, g = idx & 31;
  const bf16_t* Pm = (const bf16_t*)(p.ws + R_P) + (size_t)bl * SEQ * PLD + PC_S5 + g * 16;
  bf16_t* Z = (bf16_t*)(p.ws + R_ZS5) + (size_t)bl * SEQ * 512 + g * 16;
  constexpr int BUS = 132;
  float* buT = (float*)smem + wave * (16 * BUS);
  bf16_t* hist = (bf16_t*)(smem + 4 * 16 * BUS * 4) + wave * (16 * 136);
  const float2 ab = *(const float2*)((const float*)(p.ws + OFF_S5AB) + (g * 64 + lane) * 2);
  const int l16 = lane & 15, quad = lane >> 4;
  bf16x8 bbf[8];
  {
    const float* bbp = (const float*)(p.ws + OFF_S5BB);
#pragma unroll
    for (int jb = 0; jb < 8; ++jb) {
      const int col = jb * 16 + l16, nn = col & 63, im = col >> 6;
      unsigned pk[4] = {0u, 0u, 0u, 0u};
      if (quad < 2) {
        const float* src = bbp + (size_t)(g * 64 + nn) * 32 + im * 16 + quad * 8;
#pragma unroll
        for (int e = 0; e < 4; ++e) pk[e] = pack2(src[2 * e], src[2 * e + 1]);
      }
      bbf[jb] = __builtin_bit_cast(bf16x8, uint4{pk[0], pk[1], pk[2], pk[3]});
    }
  }
  bf16x8 cf[4];
  {
    const float* Cre = p.in[16] + (size_t)l * 32768 + (size_t)(g * 16 + l16) * 64;
    const float* Cim = p.in[17] + (size_t)l * 32768 + (size_t)(g * 16 + l16) * 64;
#pragma unroll
    for (int ks = 0; ks < 4; ++ks) {
      unsigned pk[4];
#pragma unroll
      for (int e = 0; e < 4; ++e) {
        const int k = ks * 32 + quad * 8 + 2 * e;
        const float v0 = (k < 64) ? Cre[k] : -Cim[k - 64];
        const float v1 = (k < 64) ? Cre[k + 1] : -Cim[k + 1 - 64];
        pk[e] = pack2(v0, v1);
      }
      cf[ks] = __builtin_bit_cast(bf16x8, uint4{pk[0], pk[1], pk[2], pk[3]});
    }
  }
  const float dcoef = p.in[18][l * 512 + g * 16 + l16];
  float xr = 0.f, xi = 0.f;
  uint4 ua = uint4{0u, 0u, 0u, 0u};
  bf16_t ue[4];
  auto gload = [&](int c) {
    if (quad < 2) ua = *(const uint4*)(Pm + (size_t)(c * 16 + l16) * PLD + quad * 8);
#pragma unroll
    for (int r = 0; r < 4; ++r) ue[r] = Pm[(size_t)(c * 16 + quad * 4 + r) * PLD + l16];
  };
  __syncthreads();
  gload(0);
  constexpr int NC = SEQ / 16;
  for (int c = 0; c < NC; ++c) {
    const bf16x8 afr = __builtin_bit_cast(bf16x8, ua);
    float us[4];
#pragma unroll
    for (int r = 0; r < 4; ++r) us[r] = bf2f(ue[r]);
#pragma unroll
    for (int jb = 0; jb < 8; ++jb) {
      f32x4 acc = {0.f, 0.f, 0.f, 0.f};
      acc = __builtin_amdgcn_mfma_f32_16x16x32_bf16(afr, bbf[jb], acc, 0, 0, 0);
#pragma unroll
      for (int r = 0; r < 4; ++r) buT[(quad * 4 + r) * BUS + jb * 16 + l16] = acc[r];
    }
    if (c + 1 < NC) gload(c + 1);
    __syncthreads();
#pragma unroll
    for (int t = 0; t < 16; ++t) {
      const float ur = buT[t * BUS + lane], ui = buT[t * BUS + 64 + lane];
      const float nr = ab.x * xr - ab.y * xi + ur;
      const float ni = ab.x * xi + ab.y * xr + ui;
      xr = nr; xi = ni;
      hist[t * 136 + lane] = f2bf(xr);
      hist[t * 136 + 64 + lane] = f2bf(xi);
    }
    __syncthreads();
    f32x4 acc = {0.f, 0.f, 0.f, 0.f};
#pragma unroll
    for (int ks = 0; ks < 4; ++ks) {
      const bf16x8 a = *(const bf16x8*)(hist + l16 * 136 + ks * 32 + quad * 8);
      acc = __builtin_amdgcn_mfma_f32_16x16x32_bf16(a, cf[ks], acc, 0, 0, 0);
    }
#pragma unroll
    for (int r = 0; r < 4; ++r) {
      const int t = quad * 4 + r;
      const float y = acc[r] + dcoef * us[r];
      const float z = y * sigm(1.5957691216057308f * (y + 0.044715f * y * y * y));
      Z[(size_t)(c * 16 + t) * 512 + l16] = f2bf(z);
    }
  }
}

#define GSYNC() xcd_barrier(xb)
#define TILE_MAP(u_, ntm_, tm_, tn_) { const int _x = (u_) & 7, _li = (u_) >> 3, _per = (ntm_) >> 3; tm_ = _x * _per + (_li % _per); tn_ = _li / _per; }
__global__ void __launch_bounds__(256, 2) mega_kernel(Params p) {
  cg::grid_group grid = cg::this_grid();
  __shared__ __attribute__((aligned(16))) char smem[SMEM_BYTES];
  __shared__ uint4 xb_words;
  const int bid = blockIdx.x, nb = gridDim.x;
  if (p.ws == nullptr) grid.sync();
  if (threadIdx.x == 0) xb_words = make_uint4(0u, 0u, 0u, 0u);
  __syncthreads();
  const XcdBarrier xb = xcd_barrier_post((unsigned*)(p.ws + OFF_BAR), (volatile LAS unsigned*)&xb_words);
  char* ws = p.ws;
  float* X = p.out;
  bf16_t* Wt_in = (bf16_t*)(ws + OFF_WIN);
  bf16_t* Wt_q = (bf16_t*)(ws + OFF_WQ);
  bf16_t* Wt_br = (bf16_t*)(ws + OFF_WBR);
  bf16_t* Wt_out = (bf16_t*)(ws + OFF_WOUT);
  bf16_t* Wt_glu = (bf16_t*)(ws + OFF_WGLU);
  bf16_t* Wt_wup = (bf16_t*)(ws + OFF_WWUP);
  bf16_t* Wt_aup = (bf16_t*)(ws + OFF_WAUP);
  bf16_t* Wt_gup = (bf16_t*)(ws + OFF_WGUP);
  bf16_t* Wt_v = (bf16_t*)(ws + OFF_WV);
  bf16_t* Wt_xkv = (bf16_t*)(ws + OFF_WXKV);
  bf16_t* Hb = (bf16_t*)(ws + OFF_H);
  bf16_t* Vfirst = (bf16_t*)(ws + OFF_VFIRST);
  bf16_t* Kx = (bf16_t*)(ws + OFF_KX);
  bf16_t* VxT = (bf16_t*)(ws + OFF_VXT);
  bf16_t* Hm = (bf16_t*)(ws + OFF_HM);
  float* CosT = (float*)(ws + OFF_COS);
  float* SinT = (float*)(ws + OFF_SIN);
  bf16_t* Pm = (bf16_t*)(ws + R_P);
  bf16_t* Cqn = (bf16_t*)(ws + R_CQN);
  bf16_t* Qp = (bf16_t*)(ws + R_QP);
  bf16_t* KVlat = (bf16_t*)(ws + R_KVLAT);
  bf16_t* VTm = (bf16_t*)(ws + R_VT);
  bf16_t* RKV = (bf16_t*)(ws + R_RKV);
  bf16_t* Alora = (bf16_t*)(ws + R_ALORA);
  float* Yrw = (float*)(ws + R_YRW);
  bf16_t* Zs5 = (bf16_t*)(ws + R_ZS5);
  bf16_t* Ybr = (bf16_t*)(ws + R_YBR);
  bf16_t* Wt_xq = (bf16_t*)(ws + R_WXQ);
  bf16_t* Wt_xo = (bf16_t*)(ws + R_WXO);
  bf16_t* Wt_gu = (bf16_t*)(ws + R_WGU);
  bf16_t* Wt_down = (bf16_t*)(ws + R_WDOWN);
  bf16_t* Qx = (bf16_t*)(ws + R_QX);
  bf16_t* Ox = (bf16_t*)(ws + R_OX);
  bf16_t* GU = (bf16_t*)(ws + R_GU);
  const float LOG2E = 1.4426950408889634f;

  for (int l = 0; l < 2; ++l) {
    {
      PHASE_IDS
      const float* w_in = p.in[4] + (size_t)l * 1024 * P_IN;
      transpose_all(w_in, P_IN, 1024, P_IN, Wt_in, bid, nb, smem);
      transpose_all(p.in[36] + (size_t)l * 512 * 1024, 1024, 512, 1024, Wt_br + (size_t)1 * 1024 * 512, bid, nb, smem);
      transpose_all(p.in[37] + (size_t)l * 512 * 1024, 1024, 512, 1024, Wt_br + (size_t)2 * 1024 * 512, bid, nb, smem);
      transpose_all(p.in[38] + (size_t)l * 512 * 1024, 1024, 512, 1024, Wt_br + (size_t)3 * 1024 * 512, bid, nb, smem);
      transpose_all(p.in[39] + (size_t)l * 1024 * 1024, 1024, 1024, 1024, Wt_out, bid, nb, smem);
      transpose_all(p.in[19] + (size_t)l * 512 * 512, 512, 512, 512, Wt_glu, bid, nb, smem);
      transpose_all(p.in[23] + (size_t)l * 64 * 512, 512, 64, 512, Wt_wup, bid, nb, smem);
      transpose_all(p.in[25] + (size_t)l * 64 * 512, 512, 64, 512, Wt_aup, bid, nb, smem);
      transpose_all(p.in[26] + (size_t)l * 128 * 512, 512, 128, 512, Wt_gup, bid, nb, smem);
      transpose_all(p.in[43] + (size_t)l * 1024 * 2048, 2048, 1024, 2048, Wt_xkv, bid, nb, smem);
      const int gtid = bid * 256 + tid, gsz = nb * 256;
      {
        const float* w_uq = p.in[6] + (size_t)l * 256 * 768;
        const float* w_ukv = p.in[8] + (size_t)l * 128 * 1024;
        for (int e = gtid; e < 768 * 256; e += gsz) {
          const int n = e >> 8, kq = e & 255, hh = n / 192, j = n % 192;
          float v;
          if (j >= 128) v = w_uq[kq * 768 + n];
          else {
            v = 0.f;
            const float* a = w_uq + kq * 768 + hh * 192;
            const float* b = w_ukv + j * 1024 + hh * 256;
            for (int d = 0; d < 128; ++d) v += a[d] * b[d];
          }
          Wt_q[e] = f2bf(v);
        }
        const float* w_bm = p.in[35] + (size_t)l * 512 * 1024;
        for (int e = gtid; e < 1024 * 512; e += gsz) {
          const int n = e & 1023, kk = e >> 10, hh = kk >> 7, j = kk & 127;
          const float* a = w_ukv + j * 1024 + hh * 256 + 128;
          float v = 0.f;
          for (int d = 0; d < 128; ++d) v += a[d] * w_bm[(size_t)(hh * 128 + d) * 1024 + n];
          Wt_br[(size_t)n * 512 + kk] = f2bf(v);
        }
        if (l == 1) {
          const float* vd = p.in[32];
          const float* vu = p.in[33];
          for (int e = gtid; e < 512 * 1024; e += gsz) {
            const int n = e & 511, kk = e >> 9;
            float v = 0.f;
            for (int r = 0; r < 32; ++r) v += vd[kk * 32 + r] * vu[r * 512 + n];
            Wt_v[(size_t)n * 1024 + kk] = f2bf(v);
          }
        }
      }
      {
        float* abp = (float*)(ws + OFF_S5AB);
        float* bbp = (float*)(ws + OFF_S5BB);
        for (int e = gtid; e < 2048; e += gsz) {
          const int g = e >> 6;
          const float are = fminf(p.in[11][l * 2048 + e], -1e-4f), aim = p.in[12][l * 2048 + e];
          const float dt = expf(p.in[13][l * 32 + g]);
          const float mag = expf(dt * are);
          const float abre = mag * cosf(dt * aim), abim = mag * sinf(dt * aim);
          const float den = are * are + aim * aim;
          const float zre = ((abre - 1.f) * are + abim * aim) / den;
          const float zim = (abim * are - (abre - 1.f) * aim) / den;
          abp[e * 2] = abre; abp[e * 2 + 1] = abim;
          const float* Br = p.in[14] + (size_t)l * 32768 + (size_t)e * 16;
          const float* Bi = p.in[15] + (size_t)l * 32768 + (size_t)e * 16;
          for (int c = 0; c < 16; ++c) {
            bbp[e * 32 + c] = zre * Br[c] - zim * Bi[c];
            bbp[e * 32 + 16 + c] = zre * Bi[c] + zim * Br[c];
          }
        }
      }
      if (l == 0) rmsnorm_rows(p.in[0], p.in[3], Hb, X, T_ALL, bid, nb);
      else rmsnorm_rows(X, p.in[3] + 1024, Hb, nullptr, T_ALL, bid, nb);
      rmsnorm_rows(p.in[1], p.in[41] + l * 1024, Hm, nullptr, 1024, bid, nb);
    }
    GSYNC();

    for (int half = 0; half < 2; ++half) {
      const bf16_t* Hh = Hb + (size_t)half * TH * 1024;
      {
        const int n1 = 64 * 38;
        const int n2 = (half == 0) ? 8 * 16 : 0;
        for (int u = bid; u < n1 + n2; u += nb) {
          f32x4 acc[4][4];
          zero_acc<4>(acc);
          if (u < n1) {
            int tm, tn; TILE_MAP(u, 64, tm, tn);
            gemm_acc<128>(Hh + (size_t)tm * 128 * 1024, 1024, Wt_in + (size_t)tn * 128 * 1024, 1024, 1024, smem, acc);
            EPI4_FOR(128) {
              const int row = tm * 128 + EPI_ROW, n = tn * 128 + EPI4_COL(128);
              if (n < GATE_OFF) {
                const int pc = (n < 448) ? n : n + 64;
                *(uint2*)(Pm + (size_t)row * PLD + pc) = pack4(acc[i][j]);
              }
            }
          } else {
            const int v = u - n1, tn = v % 16, tm = v / 16;
            gemm_acc<128>(Hm + (size_t)tm * 128 * 1024, 1024, Wt_xkv + (size_t)tn * 128 * 1024, 1024, 1024, smem, acc);
            EPI_FOR(128) {
              const int row = tm * 128 + EPI_ROW, n = tn * 128 + EPI_COL(128);
              const int b = row >> 8, m = row & 255, sel = n >> 10, hh = (n >> 8) & 3, d = n & 255;
              if (sel == 0) Kx[((size_t)(b * 4 + hh) * 256 + m) * 256 + d] = f2bf(acc[i][j][r]);
              else VxT[((size_t)(b * 4 + hh) * 256 + d) * 256 + m] = f2bf(acc[i][j][r]);
            }
          }
        }
      }
      GSYNC();
      {
      PHASE_IDS
        const float* qn = p.in[5] + l * 256;
        const float* kvn = p.in[7] + l * 128;
        const float* mu = p.in[21] + l * 1792;
        for (int tk = bid * 4 + wave; tk < TH; tk += nb * 4) {
          const int gtok = half * TH + tk, s = gtok & (SEQ - 1), bl = tk >> 12;
          const bf16_t* prow = Pm + (size_t)tk * PLD;
          {
            const uint2 cu = *(const uint2*)(prow + lane * 4);
            float f[4] = {bflo(cu.x), bfhi(cu.x), bflo(cu.y), bfhi(cu.y)};
            float ss = wave_sum(f[0] * f[0] + f[1] * f[1] + f[2] * f[2] + f[3] * f[3]);
            const float rs = rsqrtf(ss * (1.f / 256.f) + 1e-6f);
            const float4 g4 = *(const float4*)(qn + lane * 4);
            uint2 o; o.x = pack2(f[0] * rs * g4.x, f[1] * rs * g4.y); o.y = pack2(f[2] * rs * g4.z, f[3] * rs * g4.w);
            *(uint2*)(Cqn + (size_t)tk * 256 + lane * 4) = o;
          }
          {
            const unsigned cu = *(const unsigned*)(prow + 256 + lane * 2);
            const float f0 = bflo(cu), f1 = bfhi(cu);
            const float ss = wave_sum(f0 * f0 + f1 * f1);
            const float rs = rsqrtf(ss * (1.f / 128.f) + 1e-6f);
            const float v0 = f0 * rs * kvn[lane * 2], v1 = f1 * rs * kvn[lane * 2 + 1];
            const bf16_t b0 = f2bf(v0), b1 = f2bf(v1);
            *(unsigned*)(KVlat + (size_t)tk * 192 + lane * 2) = (unsigned)b0 | ((unsigned)b1 << 16);
            VTm[((size_t)bl * 128 + lane * 2) * SEQ + s] = b0;
            VTm[((size_t)bl * 128 + lane * 2 + 1) * SEQ + s] = b1;
          }
          if (lane < 32) {
            const float t1 = bf2f(prow[384 + lane]), t2 = bf2f(prow[384 + 32 + lane]);
            const float posf = (float)p.pos[gtok];
            const float invf = exp2f(-(float)lane * (13.287712379549449f / 32.f));
            const float ang = posf * invf;
            const float cs = cosf(ang), sn = sinf(ang);
            KVlat[(size_t)tk * 192 + 128 + lane] = f2bf(t1 * cs - t2 * sn);
            KVlat[(size_t)tk * 192 + 160 + lane] = f2bf(t1 * sn + t2 * cs);
            CosT[tk * 32 + lane] = cs; SinT[tk * 32 + lane] = sn;
          }
#pragma unroll
          for (int jj = 0; jj < 7; ++jj) {
            const int col = (jj * 64 + lane) * 4;
            const uint2 cu = *(const uint2*)(prow + PC_RW + col);
            uint2 pu = uint2{0u, 0u};
            if (s > 0) pu = *(const uint2*)(prow - PLD + PC_RW + col);
            const float4 m4 = *(const float4*)(mu + col);
            const float cv[4] = {bflo(cu.x), bfhi(cu.x), bflo(cu.y), bfhi(cu.y)};
            const float pv[4] = {bflo(pu.x), bfhi(pu.x), bflo(pu.y), bfhi(pu.y)};
            const float mm[4] = {m4.x, m4.y, m4.z, m4.w};
            float o[4];
#pragma unroll
            for (int e = 0; e < 4; ++e) o[e] = cv[e] + (pv[e] - cv[e]) * mm[e];
            if (col < 1536) {
              uint2 ov; ov.x = pack2(o[0], o[1]); ov.y = pack2(o[2], o[3]);
              *(uint2*)(RKV + (size_t)tk * 1536 + col) = ov;
              if (l == 0 && col >= 1024) *(uint2*)(Vfirst + (size_t)gtok * 512 + (col - 1024)) = ov;
            } else {
              int dc;
              if (col < 1600) { dc = col - 1536; for (int e = 0; e < 4; ++e) o[e] = tanhf(o[e]); }
              else if (col < 1664) { dc = 64 + col - 1600; }
              else { dc = 128 + col - 1664; for (int e = 0; e < 4; ++e) o[e] = sigm(o[e]); }
              uint2 ov; ov.x = pack2(o[0], o[1]); ov.y = pack2(o[2], o[3]);
              *(uint2*)(Alora + (size_t)tk * 256 + dc) = ov;
            }
          }
        }
      }
      GSYNC();
      {
      PHASE_IDS
        const int nq = 64 * 6, nl = 64 * 4;
        const int total = nq + 3 * nl + (l == 1 ? nl : 0);
        for (int u = bid; u < total; u += nb) {
          f32x4 acc[4][4];
          zero_acc<4>(acc);
          if (u < nq) {
            int tm, tn; TILE_MAP(u, 64, tm, tn);
            gemm_acc<128>(Cqn + (size_t)tm * 128 * 256, 256, Wt_q + (size_t)tn * 128 * 256, 256, 256, smem, acc);
            const float qs = 0.07216878364870322f * LOG2E;
            const int lane_ = tid & 63, wave_ = tid >> 6, wm_ = wave_ >> 1, wn_ = wave_ & 1, l16_ = lane_ & 15, quad_ = lane_ >> 4;
            const int gc = tn * 128 + wn_ * 64;
            const bool is_rope = (gc % 192) == 128;
#pragma unroll
            for (int i = 0; i < 4; ++i) {
              const int row = tm * 128 + wm_ * 64 + i * 16 + l16_;
              if (is_rope) {
#pragma unroll
                for (int j = 0; j < 2; ++j) {
                  const int fi = j * 16 + quad_ * 4;
                  const float4 cs = *(const float4*)(CosT + row * 32 + fi), sn = *(const float4*)(SinT + row * 32 + fi);
                  const float c4[4] = {cs.x, cs.y, cs.z, cs.w}, s4[4] = {sn.x, sn.y, sn.z, sn.w};
#pragma unroll
                  for (int r = 0; r < 4; ++r) {
                    const float t1 = acc[i][j][r], t2 = acc[i][j + 2][r];
                    acc[i][j][r] = t1 * c4[r] - t2 * s4[r]; acc[i][j + 2][r] = t1 * s4[r] + t2 * c4[r];
                  }
                }
              }
#pragma unroll
              for (int j = 0; j < 4; ++j) *(uint2*)(Qp + (size_t)row * 768 + gc + j * 16 + quad_ * 4) = pack4(acc[i][j] * qs);
            }
          } else if (u < nq + 3 * nl) {
            const int v = u - nq, which = v / nl, w2 = v % nl, tn = w2 % 4, tm = w2 / 4;
            if (which == 0) {
              gemm_acc<128>(Alora + (size_t)tm * 128 * 256, 256, Wt_wup + (size_t)tn * 128 * 64, 64, 64, smem, acc);
              const float* w0 = p.in[22] + l * 512;
              EPI4_FOR(128) {
                const int row = tm * 128 + EPI_ROW, n = tn * 128 + EPI4_COL(128);
                const float4 b4 = *(const float4*)(w0 + n);
                *(uint2*)(Pm + (size_t)row * PLD + PC_RW + n) = pack4(acc[i][j] + f32x4{b4.x, b4.y, b4.z, b4.w});
              }
            } else if (which == 1) {
              gemm_acc<128>(Alora + (size_t)tm * 128 * 256 + 64, 256, Wt_aup + (size_t)tn * 128 * 64, 64, 64, smem, acc);
              const float* a0 = p.in[24] + l * 512;
              EPI4_FOR(128) {
                const int row = tm * 128 + EPI_ROW, n = tn * 128 + EPI4_COL(128);
                const float4 b4 = *(const float4*)(a0 + n);
                f32x4 v = acc[i][j] + f32x4{b4.x, b4.y, b4.z, b4.w};
#pragma unroll
                for (int r = 0; r < 4; ++r) v[r] = sigm(v[r]);
                *(uint2*)(Pm + (size_t)row * PLD + PC_RW + 512 + n) = pack4(v);
              }
            } else {
              gemm_acc<128>(Alora + (size_t)tm * 128 * 256 + 128, 256, Wt_gup + (size_t)tn * 128 * 128, 128, 128, smem, acc);
              EPI4_FOR(128) {
                const int row = tm * 128 + EPI_ROW, n = tn * 128 + EPI4_COL(128);
                *(uint2*)(Pm + (size_t)row * PLD + PC_RW + 1024 + n) = pack4(acc[i][j]);
              }
            }
          } else {
            const int w2 = u - nq - 3 * nl, tn = w2 % 4, tm = w2 / 4;
            gemm_acc<128>(Hh + (size_t)tm * 128 * 1024, 1024, Wt_v + (size_t)tn * 128 * 1024, 1024, 1024, smem, acc);
            const float* vb = p.in[34];
            EPI4_FOR(128) {
              const int row = tm * 128 + EPI_ROW, n = tn * 128 + EPI4_COL(128);
              const float4 b4 = *(const float4*)(vb + n);
              const f32x4 lg = acc[i][j] + f32x4{b4.x, b4.y, b4.z, b4.w};
              const f32x4 vc = unpack4(*(const uint2*)(RKV + (size_t)row * 1536 + 1024 + n));
              const f32x4 vf = unpack4(*(const uint2*)(Vfirst + ((size_t)half * TH + row) * 512 + n));
              f32x4 o;
#pragma unroll
              for (int r = 0; r < 4; ++r) o[r] = vc[r] + (vf[r] - vc[r]) * sigm(lg[r]);
              *(uint2*)(RKV + (size_t)row * 1536 + 1024 + n) = pack4(o);
            }
          }
        }
      }
      GSYNC();
      {
        for (int u = bid; u < 64 + 64 + 16 + 256; u += nb) {
          if (u < 144) {
            __builtin_amdgcn_s_setprio(3);
            if (u < 64) rwkv_scan_unit(p, l, u, smem);
            else if (u < 128) hgrn_scan_unit(p, l, u - 64, smem);
            else s5_scan_unit(p, l, u - 128, smem);
            __builtin_amdgcn_s_setprio(0);
          } else {
            const int it = u - 144, qt = 31 - (it >> 3), bl = (it >> 2) & 1, hh = it & 3;
            attn_item_pf<192, true>(Qp + (size_t)bl * SEQ * 768 + hh * 192, 768, KVlat + (size_t)bl * SEQ * 192, 192,
                                 VTm + (size_t)bl * 128 * SEQ, SEQ, (qt * 128 + 128) / 64, qt * 128,
                                 Pm + (size_t)bl * SEQ * PLD + hh * 128, PLD, smem);
          }
        }
      }
      GSYNC();
      {
      PHASE_IDS
        const int nglu = 64 * 4;
        for (int u = bid; u < nglu; u += nb) {
          int tm, tn; TILE_MAP(u, 64, tm, tn);
          f32x4 acc[4][4];
          zero_acc<4>(acc);
          gemm_acc<128>(Zs5 + (size_t)tm * 128 * 512, 512, Wt_glu + (size_t)tn * 128 * 512, 512, 512, smem, acc);
          const float* bg = p.in[20] + l * 512;
          EPI4_FOR(128) {
            const int row = tm * 128 + EPI_ROW, n = tn * 128 + EPI4_COL(128);
            const f32x4 z = unpack4(*(const uint2*)(Zs5 + (size_t)row * 512 + n));
            const float4 b4 = *(const float4*)(bg + n);
            const f32x4 lg = acc[i][j] + f32x4{b4.x, b4.y, b4.z, b4.w};
            f32x4 o;
#pragma unroll
            for (int r = 0; r < 4; ++r) o[r] = z[r] * sigm(lg[r]);
            *(uint2*)(Pm + (size_t)row * PLD + PC_S5 + n) = pack4(o);
          }
        }
        const float* k_a = p.in[28] + l * 512;
        const float* r_k = p.in[29] + l * 512;
        const float* ln_w = p.in[30] + l * 512;
        const float* ln_b = p.in[31] + l * 512;
        const float* o_norm = p.in[10] + l * 512;
        for (int tk = bid * 4 + wave; tk < TH; tk += nb * 4) {
          const int c0 = lane * 8;
          {
            const float4 y0 = *(const float4*)(Yrw + (size_t)tk * 512 + c0), y1 = *(const float4*)(Yrw + (size_t)tk * 512 + c0 + 4);
            const float y[8] = {y0.x, y0.y, y0.z, y0.w, y1.x, y1.y, y1.z, y1.w};
            const uint4 ru = *(const uint4*)(RKV + (size_t)tk * 1536 + c0);
            const uint4 ku = *(const uint4*)(RKV + (size_t)tk * 1536 + 512 + c0);
            const uint4 vu = *(const uint4*)(RKV + (size_t)tk * 1536 + 1024 + c0);
            const uint4 au = *(const uint4*)(Pm + (size_t)tk * PLD + PC_RW + 512 + c0);
            const uint4 gu = *(const uint4*)(Pm + (size_t)tk * PLD + PC_RW + 1024 + c0);
            const unsigned ra[4] = {ru.x, ru.y, ru.z, ru.w}, ka[4] = {ku.x, ku.y, ku.z, ku.w}, va[4] = {vu.x, vu.y, vu.z, vu.w};
            const unsigned aa[4] = {au.x, au.y, au.z, au.w}, ga[4] = {gu.x, gu.y, gu.z, gu.w};
            float rr[8], kh[8], vv[8], gg[8];
            float sm1 = 0.f, bsum = 0.f;
#pragma unroll
            for (int e = 0; e < 8; ++e) {
              const unsigned sh = (e & 1);
              rr[e] = sh ? bfhi(ra[e >> 1]) : bflo(ra[e >> 1]);
              const float kx = sh ? bfhi(ka[e >> 1]) : bflo(ka[e >> 1]);
              vv[e] = sh ? bfhi(va[e >> 1]) : bflo(va[e >> 1]);
              const float a = sh ? bfhi(aa[e >> 1]) : bflo(aa[e >> 1]);
              gg[e] = sh ? bfhi(ga[e >> 1]) : bflo(ga[e >> 1]);
              kh[e] = kx * (1.f + (a - 1.f) * k_a[c0 + e]);
              sm1 += y[e];
              bsum += rr[e] * kh[e] * r_k[c0 + e];
            }
            sm1 = red8(sm1); bsum = red8(bsum);
            const float mean = sm1 * (1.f / 64.f);
            float vs = 0.f;
#pragma unroll
            for (int e = 0; e < 8; ++e) { const float d = y[e] - mean; vs += d * d; }
            vs = red8(vs);
            const float rstd = rsqrtf(vs * (1.f / 64.f) + 64e-5f);
            float o[8];
#pragma unroll
            for (int e = 0; e < 8; ++e) o[e] = (((y[e] - mean) * rstd) * ln_w[c0 + e] + ln_b[c0 + e] + bsum * vv[e]) * gg[e];
            uint4 ov; ov.x = pack2(o[0], o[1]); ov.y = pack2(o[2], o[3]); ov.z = pack2(o[4], o[5]); ov.w = pack2(o[6], o[7]);
            *(uint4*)(RKV + (size_t)tk * 1536 + c0) = ov;
          }
          {
            bf16_t* op = Pm + (size_t)tk * PLD + PC_HG + 1024 + c0;
            const uint4 ou = *(const uint4*)((const bf16_t*)(ws + R_OHG) + (size_t)tk * 512 + c0);
            const uint4 gu = *(const uint4*)(Pm + (size_t)tk * PLD + PC_HG + 1536 + c0);
            const unsigned oa[4] = {ou.x, ou.y, ou.z, ou.w}, ga[4] = {gu.x, gu.y, gu.z, gu.w};
            float o[8], ss = 0.f;
#pragma unroll
            for (int e = 0; e < 4; ++e) { o[2 * e] = bflo(oa[e]); o[2 * e + 1] = bfhi(oa[e]); }
#pragma unroll
            for (int e = 0; e < 8; ++e) ss += o[e] * o[e];
            ss = red16(ss);
            const float rs = rsqrtf(ss * (1.f / 128.f) + 1e-6f);
            float r8[8];
#pragma unroll
            for (int e = 0; e < 8; ++e) {
              const float gte = (e & 1) ? bfhi(ga[e >> 1]) : bflo(ga[e >> 1]);
              r8[e] = o[e] * rs * o_norm[c0 + e] * sigm(gte);
            }
            uint4 ov; ov.x = pack2(r8[0], r8[1]); ov.y = pack2(r8[2], r8[3]); ov.z = pack2(r8[4], r8[5]); ov.w = pack2(r8[6], r8[7]);
            *(uint4*)op = ov;
          }
        }
      }
      GSYNC();
      {
        for (int u = bid; u < 64 * 16; u += nb) {
          int tm, tn; TILE_MAP(u, 64, tm, tn);
          f32x4 yacc[4][2];
          zero_acc<2>(yacc);
#pragma unroll 1
          for (int m = 0; m < 4; ++m) {
            f32x4 ag[4][2];
            zero_acc<2>(ag);
            gemm_acc<64>(Hh + (size_t)tm * 128 * 1024, 1024, Wt_in + (size_t)(GATE_OFF + m * 1024 + tn * 64) * 1024, 1024, 1024, smem, ag);
#pragma unroll
            for (int i = 0; i < 4; ++i)
#pragma unroll
              for (int j = 0; j < 2; ++j)
#pragma unroll
                for (int r = 0; r < 4; ++r) ag[i][j][r] = sigm(ag[i][j][r]);
            f32x4 ao[4][2];
            zero_acc<2>(ao);
            const bf16_t* Ao; int lda;
            if (m == 0) { Ao = Pm; lda = PLD; }
            else if (m == 1) { Ao = Pm + PC_HG + 1024; lda = PLD; }
            else if (m == 2) { Ao = Pm + PC_S5; lda = PLD; }
            else { Ao = RKV; lda = 1536; }
            gemm_acc<64>(Ao + (size_t)tm * 128 * lda, lda, Wt_br + ((size_t)m * 1024 + tn * 64) * 512, 512, 512, smem, ao);
#pragma unroll
            for (int i = 0; i < 4; ++i)
#pragma unroll
              for (int j = 0; j < 2; ++j)
#pragma unroll
                for (int r = 0; r < 4; ++r) yacc[i][j][r] += ag[i][j][r] * ao[i][j][r];
          }
          {
            f32x4 (&acc)[4][2] = yacc;
            EPI4_FOR(64) {
              const int row = tm * 128 + EPI_ROW, n = tn * 64 + EPI4_COL(64);
              *(uint2*)(Ybr + (size_t)row * 1024 + n) = pack4(acc[i][j]);
            }
          }
        }
      }
      GSYNC();
      {
        for (int u = bid; u < 64 * 8; u += nb) {
          int tm, tn; TILE_MAP(u, 64, tm, tn);
          f32x4 acc[4][4];
          zero_acc<4>(acc);
          gemm_acc<128>(Ybr + (size_t)tm * 128 * 1024, 1024, Wt_out + (size_t)tn * 128 * 1024, 1024, 1024, smem, acc);
          EPI4_FOR(128) {
            const int row = half * TH + tm * 128 + EPI_ROW, n = tn * 128 + EPI4_COL(128);
            float4* xp = (float4*)(X + (size_t)row * 1024 + n);
            float4 xv = *xp; xv.x += acc[i][j][0]; xv.y += acc[i][j][1]; xv.z += acc[i][j][2]; xv.w += acc[i][j][3];
            *xp = xv;
          }
        }
      }
      GSYNC();
    }

    {
      transpose_all(p.in[42] + (size_t)l * 1024 * 1024, 1024, 1024, 1024, Wt_xq, bid, nb, smem);
      transpose_all(p.in[44] + (size_t)l * 1024 * 1024, 1024, 1024, 1024, Wt_xo, bid, nb, smem);
      transpose_all(p.in[46] + (size_t)l * 1024 * 5632, 5632, 1024, 5632, Wt_gu, bid, nb, smem);
      transpose_all(p.in[49] + (size_t)l * 2816 * 1024, 1024, 2816, 1024, Wt_down, bid, nb, smem);
      rmsnorm_rows(X, p.in[40] + l * 1024, Hb, nullptr, T_ALL, bid, nb);
    }
    GSYNC();
    {
      const float qs = 0.0625f * LOG2E;
      for (int u = bid; u < 128 * 8; u += nb) {
        int tm, tn; TILE_MAP(u, 128, tm, tn);
        f32x4 acc[4][4];
        zero_acc<4>(acc);
        gemm_acc<128>(Hb + (size_t)tm * 128 * 1024, 1024, Wt_xq + (size_t)tn * 128 * 1024, 1024, 1024, smem, acc);
        EPI4_FOR(128) {
          const int row = tm * 128 + EPI_ROW, n = tn * 128 + EPI4_COL(128);
          *(uint2*)(Qx + (size_t)row * 1024 + n) = pack4(acc[i][j] * qs);
        }
      }
    }
    GSYNC();
    {
      for (int u = bid; u < 1024; u += nb) {
        const int dvh = u & 1, hh = (u >> 1) & 3, qt = (u >> 3) & 31, b = u >> 8;
        attn_item<256, false>(Qx + (size_t)b * SEQ * 1024 + hh * 256, 1024, Kx + (size_t)(b * 4 + hh) * 65536, 256,
                              VxT + (size_t)(b * 4 + hh) * 65536 + (size_t)dvh * 128 * 256, 256, 4, qt * 128,
                              Ox + (size_t)b * SEQ * 1024 + hh * 256 + dvh * 128, 1024, smem);
      }
    }
    GSYNC();
    {
      for (int u = bid; u < 128 * 8; u += nb) {
        int tm, tn; TILE_MAP(u, 128, tm, tn);
        f32x4 acc[4][4];
        zero_acc<4>(acc);
        gemm_acc<128>(Ox + (size_t)tm * 128 * 1024, 1024, Wt_xo + (size_t)tn * 128 * 1024, 1024, 1024, smem, acc);
        EPI4_FOR(128) {
          const int row = tm * 128 + EPI_ROW, n = tn * 128 + EPI4_COL(128);
          float4* xp = (float4*)(X + (size_t)row * 1024 + n);
          float4 xv = *xp; xv.x += acc[i][j][0]; xv.y += acc[i][j][1]; xv.z += acc[i][j][2]; xv.w += acc[i][j][3];
          *xp = xv;
        }
      }
    }
    GSYNC();
    rmsnorm_rows(X, p.in[45] + l * 1024, Hb, nullptr, T_ALL, bid, nb);
    GSYNC();
    for (int half = 0; half < 2; ++half) {
      const bf16_t* Hh = Hb + (size_t)half * TH * 1024;
      for (int u = bid; u < 64 * 44; u += nb) {
        int tm, tn; TILE_MAP(u, 64, tm, tn);
        f32x4 acc[4][4];
        zero_acc<4>(acc);
        gemm_acc<128>(Hh + (size_t)tm * 128 * 1024, 1024, Wt_gu + (size_t)tn * 128 * 1024, 1024, 1024, smem, acc);
        EPI4_FOR(128) {
          const int row = tm * 128 + EPI_ROW, n = tn * 128 + EPI4_COL(128);
          *(uint2*)(GU + (size_t)row * 5632 + n) = pack4(acc[i][j]);
        }
      }
      GSYNC();
      {
      PHASE_IDS
        const float* cw = p.in[47] + (size_t)l * 3 * D_FF;
        const float* cb = p.in[48] + (size_t)l * D_FF;
        for (int e = bid * 256 + tid; e < TH * 352; e += nb * 256) {
          const int tk = e / 352, c0 = (e % 352) * 8;
          const int s = tk & (SEQ - 1);
          const bf16_t* gp = GU + (size_t)tk * 5632 + c0;
          const uint4 g2 = *(const uint4*)gp;
          uint4 g1 = uint4{0, 0, 0, 0}, g0 = uint4{0, 0, 0, 0};
          if (s >= 1) g1 = *(const uint4*)(gp - 5632);
          if (s >= 2) g0 = *(const uint4*)(gp - 2 * 5632);
          const uint4 uu = *(const uint4*)(gp + D_FF);
          const unsigned a2[4] = {g2.x, g2.y, g2.z, g2.w}, a1[4] = {g1.x, g1.y, g1.z, g1.w}, a0[4] = {g0.x, g0.y, g0.z, g0.w};
          const unsigned au[4] = {uu.x, uu.y, uu.z, uu.w};
          float o[8];
#pragma unroll
          for (int q = 0; q < 8; ++q) {
            const bool hi = q & 1;
            const float x2 = hi ? bfhi(a2[q >> 1]) : bflo(a2[q >> 1]);
            const float x1 = hi ? bfhi(a1[q >> 1]) : bflo(a1[q >> 1]);
            const float x0 = hi ? bfhi(a0[q >> 1]) : bflo(a0[q >> 1]);
            const float up = hi ? bfhi(au[q >> 1]) : bflo(au[q >> 1]);
            const int c = c0 + q;
            const float gv = cw[c] * x0 + cw[D_FF + c] * x1 + cw[2 * D_FF + c] * x2 + cb[c];
            o[q] = gv * sigm(gv) * up;
          }
          uint4 ov; ov.x = pack2(o[0], o[1]); ov.y = pack2(o[2], o[3]); ov.z = pack2(o[4], o[5]); ov.w = pack2(o[6], o[7]);
          *(uint4*)(GU + (size_t)tk * 5632 + D_FF + c0) = ov;
        }
      }
      GSYNC();
      for (int u = bid; u < 64 * 8; u += nb) {
        int tm, tn; TILE_MAP(u, 64, tm, tn);
        f32x4 acc[4][4];
        zero_acc<4>(acc);
        gemm_acc<128>(GU + (size_t)tm * 128 * 5632 + D_FF, 5632, Wt_down + (size_t)tn * 128 * 2816, 2816, 2816, smem, acc);
        EPI4_FOR(128) {
          const int row = half * TH + tm * 128 + EPI_ROW, n = tn * 128 + EPI4_COL(128);
          float4* xp = (float4*)(X + (size_t)row * 1024 + n);
          float4 xv = *xp; xv.x += acc[i][j][0]; xv.y += acc[i][j][1]; xv.z += acc[i][j][2]; xv.w += acc[i][j][3];
          *xp = xv;
        }
      }
      GSYNC();
    }
  }

  {
      PHASE_IDS
    const float* g = p.in[50];
    for (int r = bid * 4 + wave; r < T_ALL; r += nb * 4) {
      float4* xr = (float4*)(X + (size_t)r * 1024);
      float4 v[4]; float ss = 0.f;
#pragma unroll
      for (int i = 0; i < 4; ++i) { v[i] = xr[lane + 64 * i]; ss += v[i].x * v[i].x + v[i].y * v[i].y + v[i].z * v[i].z + v[i].w * v[i].w; }
      ss = wave_sum(ss);
      const float rs = rsqrtf(ss * (1.f / 1024.f) + 1e-6f);
#pragma unroll
      for (int i = 0; i < 4; ++i) {
        const float4 gg = ((const float4*)g)[lane + 64 * i];
        xr[lane + 64 * i] = float4{v[i].x * rs * gg.x, v[i].y * rs * gg.y, v[i].z * rs * gg.z, v[i].w * rs * gg.w};
      }
    }
  }
}

extern "C" void kernel_launch(void* const* d_in, const int* in_sizes, int n_in, void* d_out, int out_size, void* d_ws, size_t ws_size,
                              hipStream_t stream) {
  static int grid_blocks = 0;
  if (!grid_blocks) {
    int dev = 0, cus = 0, per_cu = 0;
    hipGetDevice(&dev);
    hipDeviceGetAttribute(&cus, hipDeviceAttributeMultiprocessorCount, dev);
    hipOccupancyMaxActiveBlocksPerMultiprocessor(&per_cu, mega_kernel, 256, 0);
    if (per_cu > 2) per_cu = 2;
    if (per_cu < 1) per_cu = 1;
    grid_blocks = cus * per_cu;
  }
  if (ws_size < WS_NEED) fprintf(stderr, "workspace too small: %zu < %zu\n", ws_size, (size_t)WS_NEED);
  Params p{};
  for (int i = 0; i < 51; ++i) p.in[i] = (const float*)d_in[i];
  p.pos = (const int*)d_in[2];
  p.out = (float*)d_out;
  p.ws = (char*)d_ws;
  hipMemsetAsync((char*)d_ws + OFF_BAR, 0, 16384, stream);
  void* args[] = {&p};
  hipError_t e = hipLaunchCooperativeKernel((void*)mega_kernel, dim3(grid_blocks), dim3(256), args, 0, stream);
  if (e != hipSuccess) fprintf(stderr, "cooperative launch failed: %s (grid %d)\n", hipGetErrorString(e), grid_blocks);
}
```

```cpp
#include <hip/hip_runtime.h>
#include <hip/hip_cooperative_groups.h>
#include <cstdio>
#include <cstdint>
namespace cg = cooperative_groups;

typedef unsigned short bf16_t;
using bf16x8 = __attribute__((ext_vector_type(8))) short;
using s16x4 = __attribute__((ext_vector_type(4))) short;
using f32x4 = __attribute__((ext_vector_type(4))) float;
using f32x16 = __attribute__((ext_vector_type(16))) float;
using u32x4 = __attribute__((ext_vector_type(4))) unsigned;
#define DI __device__ __forceinline__

constexpr int T_ALL = 16384, SEQ = 4096, DM = 1024, TH = 8192;
constexpr int P_IN = 8896, GATE_OFF = 4800;
constexpr int PLD = 4864;
constexpr int PC_HG = 512, PC_S5 = 2560, PC_RW = 3072;
constexpr int D_FF = 2816;

constexpr size_t al256(size_t x) { return (x + 255) & ~(size_t)255; }
constexpr size_t OFF_WIN = 0;
constexpr size_t OFF_WQ = OFF_WIN + al256((size_t)P_IN * 1024 * 2);
constexpr size_t OFF_WBR = OFF_WQ + al256((size_t)768 * 256 * 2);
constexpr size_t OFF_WOUT = OFF_WBR + al256((size_t)4 * 1024 * 512 * 2);
constexpr size_t OFF_WGLU = OFF_WOUT + al256((size_t)1024 * 1024 * 2);
constexpr size_t OFF_WWUP = OFF_WGLU + al256((size_t)512 * 512 * 2);
constexpr size_t OFF_WAUP = OFF_WWUP + al256((size_t)512 * 64 * 2);
constexpr size_t OFF_WGUP = OFF_WAUP + al256((size_t)512 * 64 * 2);
constexpr size_t OFF_WV = OFF_WGUP + al256((size_t)512 * 128 * 2);
constexpr size_t OFF_WXKV = OFF_WV + al256((size_t)512 * 1024 * 2);
constexpr size_t OFF_S5AB = OFF_WXKV + al256((size_t)2048 * 1024 * 2);
constexpr size_t OFF_S5BB = OFF_S5AB + al256((size_t)32 * 64 * 2 * 4);
constexpr size_t OFF_H = OFF_S5BB + al256((size_t)32 * 64 * 32 * 4);
constexpr size_t OFF_VFIRST = OFF_H + al256((size_t)T_ALL * 1024 * 2);
constexpr size_t OFF_KX = OFF_VFIRST + al256((size_t)T_ALL * 512 * 2);
constexpr size_t OFF_VXT = OFF_KX + al256((size_t)16 * 256 * 256 * 2);
constexpr size_t OFF_HM = OFF_VXT + al256((size_t)16 * 256 * 256 * 2);
constexpr size_t OFF_COS = OFF_HM + al256((size_t)1024 * 1024 * 2);
constexpr size_t OFF_SIN = OFF_COS + al256((size_t)TH * 32 * 4);
constexpr size_t OFF_BAR = OFF_SIN + al256((size_t)TH * 32 * 4);
constexpr size_t OFF_REG = OFF_BAR + 16384;
constexpr size_t R_P = OFF_REG;
constexpr size_t R_CQN = R_P + al256((size_t)TH * PLD * 2);
constexpr size_t R_QP = R_CQN + (size_t)TH * 256 * 2;
constexpr size_t R_KVLAT = R_QP + al256((size_t)TH * 768 * 2);
constexpr size_t R_VT = R_KVLAT + al256((size_t)TH * 192 * 2);
constexpr size_t R_RKV = R_VT + al256((size_t)2 * 128 * 4096 * 2);
constexpr size_t R_ALORA = R_RKV + al256((size_t)TH * 1536 * 2);
constexpr size_t R_YRW = R_ALORA + al256((size_t)TH * 256 * 2);
constexpr size_t R_ZS5 = R_YRW + al256((size_t)TH * 512 * 4);
constexpr size_t R_OHG = R_ZS5 + al256((size_t)TH * 512 * 2);
constexpr size_t R_END1 = R_OHG + al256((size_t)TH * 512 * 2);
constexpr size_t R_YBR = R_CQN;
constexpr size_t R_WXQ = OFF_REG;
constexpr size_t R_WXO = R_WXQ + al256((size_t)1024 * 1024 * 2);
constexpr size_t R_WGU = R_WXO + al256((size_t)1024 * 1024 * 2);
constexpr size_t R_WDOWN = R_WGU + al256((size_t)5632 * 1024 * 2);
constexpr size_t R_QX = R_WDOWN + al256((size_t)1024 * 2816 * 2);
constexpr size_t R_OX = R_QX + al256((size_t)T_ALL * 1024 * 2);
constexpr size_t R_GU = R_QX;
constexpr size_t R_END2 = R_GU + al256((size_t)TH * 5632 * 2);
constexpr size_t WS_NEED = (R_END1 > R_END2 ? R_END1 : R_END2);

constexpr int SMEM_BYTES = 73728;

struct Params {
  const float* in[51];
  const int* pos;
  float* out;
  char* ws;
};

DI bf16_t f2bf(float x) { unsigned u = __float_as_uint(x); u += 0x7fffu + ((u >> 16) & 1u); return (bf16_t)(u >> 16); }
DI float bf2f(bf16_t b) { return __uint_as_float(((unsigned)b) << 16); }
DI unsigned pack2(float a, float b) { return (unsigned)f2bf(a) | ((unsigned)f2bf(b) << 16); }
DI float bflo(unsigned u) { return __uint_as_float(u << 16); }
DI float bfhi(unsigned u) { return __uint_as_float(u & 0xffff0000u); }
DI float sigm(float x) { return __builtin_amdgcn_rcpf(1.f + __expf(-x)); }
template <int CTRL> DI float dppf(float v) {
  return __builtin_bit_cast(float, __builtin_amdgcn_update_dpp(0, __builtin_bit_cast(int, v), CTRL, 0xf, 0xf, false));
}
DI float red8(float v) { v += dppf<0xB1>(v); v += dppf<0x4E>(v); v += dppf<0x141>(v); return v; }
DI float red16(float v) { v = red8(v); v += dppf<0x140>(v); return v; }
DI int TID() { int t = threadIdx.x; asm volatile("" : "+v"(t)); return t; }
#define PHASE_IDS const int tid = TID(); const int lane = tid & 63, wave = tid >> 6; (void)lane; (void)wave;
DI const bf16_t* uniform_ptr(const bf16_t* p) {
  const unsigned long long v = (unsigned long long)p;
  const unsigned lo = __builtin_amdgcn_readfirstlane((unsigned)v), hi = __builtin_amdgcn_readfirstlane((unsigned)(v >> 32));
  return (const bf16_t*)(((unsigned long long)hi << 32) | lo);
}
DI float wave_sum(float v) { for (int o = 32; o > 0; o >>= 1) v += __shfl_xor(v, o); return v; }


#define XB_TMO      128
#define XB_XCNT(j)  (256  + 64 * (j))
#define XB_XSUB(j)  (1280 + 64 * (j))
#define XB_XGEN(j)  (2304 + 64 * (j))
#define XB_TOP      3328
#define XB_TOPGEN   3392
#define XCD_BAR_WORDS 3456
#define XB_SPIN_CAP (1u << 22)
#define LAS __attribute__((address_space(3)))
DI unsigned xb_ld(unsigned* p) { return __hip_atomic_load(p, __ATOMIC_RELAXED, __HIP_MEMORY_SCOPE_AGENT); }
DI unsigned xb_add(unsigned* p, unsigned v) { return __hip_atomic_fetch_add(p, v, __ATOMIC_RELAXED, __HIP_MEMORY_SCOPE_AGENT); }
DI unsigned xb_xcc_id() { return (unsigned)__builtin_amdgcn_s_getreg((3 << 11) | 20) & 0xFu; }
#define XB_SPIN(cond, bar) do { unsigned _sp = 0; while (cond) { __builtin_amdgcn_s_sleep(1); \
    if ((++_sp & 255u) == 0u) { if (xb_ld(&(bar)[XB_TMO])) break; if (_sp > XB_SPIN_CAP) { atomicAdd(&(bar)[XB_TMO], 1u); break; } } } } while (0)
struct XcdBarrier { unsigned* bar; unsigned x; volatile LAS unsigned* st; };
DI XcdBarrier xcd_barrier_post(unsigned* bar, volatile LAS unsigned* st) {
  XcdBarrier b; b.bar = bar; b.x = xb_xcc_id(); b.st = st;
  if (threadIdx.x == 0) (void)xb_add(&bar[XB_XCNT(b.x)], 1u);
  return b;
}
DI void xcd_barrier_complete(unsigned* bar, unsigned x, unsigned& nloc, unsigned& nx) {
  const unsigned G = gridDim.x * gridDim.y * gridDim.z;
  unsigned sum, cnt, mine, sp = 0u;
  for (;;) {
    sum = 0u; cnt = 0u; mine = 0u;
#pragma unroll
    for (unsigned j = 0; j < 16; ++j) { const unsigned c = xb_ld(&bar[XB_XCNT(j)]); sum += c; cnt += (c > 0u) ? 1u : 0u; mine = (j == x) ? c : mine; }
    if (sum == G) break;
    __builtin_amdgcn_s_sleep(1);
    if ((++sp & 255u) == 0u) { if (xb_ld(&bar[XB_TMO])) break; if (sp > XB_SPIN_CAP) { atomicAdd(&bar[XB_TMO], 1u); break; } }
  }
  nloc = mine > 0u ? mine : 1u; nx = cnt > 0u ? cnt : 1u;
}
DI void xcd_barrier(const XcdBarrier& b) {
  asm volatile("s_waitcnt vmcnt(0)" ::: "memory");
  __syncthreads();
  if (threadIdx.x == 0) {
    unsigned* bar = b.bar;
    __builtin_amdgcn_s_waitcnt(0);
    unsigned nloc = b.st[0], nx = b.st[1];
    if (nloc == 0u) { xcd_barrier_complete(bar, b.x, nloc, nx); b.st[0] = nloc; b.st[1] = nx; }
    const unsigned old = xb_add(&bar[XB_XSUB(b.x)], 1u);
    const unsigned gen = old / nloc;
    if (old + 1u == (gen + 1u) * nloc) {
      __builtin_amdgcn_fence(__ATOMIC_RELEASE, "agent");
      asm volatile("s_waitcnt vmcnt(0)" ::: "memory");
      const unsigned og = xb_add(&bar[XB_TOP], 1u);
      const unsigned tg = og / nx;
      if (og + 1u == (tg + 1u) * nx) xb_add(&bar[XB_TOPGEN], 1u);
      else XB_SPIN(xb_ld(&bar[XB_TOPGEN]) == tg, bar);
      __builtin_amdgcn_fence(__ATOMIC_ACQUIRE, "agent");
      xb_add(&bar[XB_XGEN(b.x)], 1u);
      asm volatile("s_waitcnt vmcnt(0)" ::: "memory");
    } else {
      XB_SPIN(xb_ld(&bar[XB_XGEN(b.x)]) == gen, bar);
      __builtin_amdgcn_fence(__ATOMIC_ACQUIRE, "agent");
      asm volatile("s_waitcnt vmcnt(0)" ::: "memory");
    }
  }
  __syncthreads();
}

#define GLOAD16(dst, ptr) asm volatile("global_load_dwordx4 %0, %1, off" : "=v"(dst) : "v"(ptr))
template <int BN>
DI void gemm_acc(const bf16_t* __restrict__ A, int lda, const bf16_t* __restrict__ Bt, int ldb, int K, char* smem,
                 f32x4 (&acc)[4][BN / 32], const bf16_t* __restrict__ An, int ldan, const bf16_t* __restrict__ Bn, int ldbn,
                 bool pre, int& par) {
  constexpr int A_EL = 128 * 72, B_EL = BN * 72, BUF_EL = A_EL + B_EL;
  constexpr int NJ = BN / 32, BCH = BN / 32;
  bf16_t* sm = (bf16_t*)smem;
  const int tid = TID(), lane = tid & 63, wave = tid >> 6;
  const int wm = wave >> 1, wn = wave & 1, l16 = lane & 15, quad = lane >> 4;
  const int crow = tid >> 3, ccol = (tid & 7) * 8;
  u32x4 ra[4], rb[BCH];
  const bf16_t* Ap = A + (size_t)crow * lda + ccol;
  const bf16_t* Bp = Bt + (size_t)crow * ldb + ccol;
  const bf16_t* Apn = An + (size_t)crow * ldan + ccol;
  const bf16_t* Bpn = Bn + (size_t)crow * ldbn + ccol;
  const int nk = K >> 6;
#define GEMM_ISSUE(ap_, sa_, bp_, sb_)                                                            \
  {                                                                                               \
    _Pragma("unroll") for (int i = 0; i < 4; ++i) GLOAD16(ra[i], (ap_) + (size_t)(32 * i) * (sa_));      \
    _Pragma("unroll") for (int i = 0; i < BCH; ++i) GLOAD16(rb[i], (bp_) + (size_t)(32 * i) * (sb_));    \
  }
#define GEMM_LAND(buf_)                                                                           \
  {                                                                                               \
    if constexpr (BCH == 4)                                                                       \
      asm volatile("s_waitcnt vmcnt(0)" : "+v"(ra[0]), "+v"(ra[1]), "+v"(ra[2]), "+v"(ra[3]), "+v"(rb[0]), "+v"(rb[1]), "+v"(rb[2]), "+v"(rb[3])); \
    else                                                                                          \
      asm volatile("s_waitcnt vmcnt(0)" : "+v"(ra[0]), "+v"(ra[1]), "+v"(ra[2]), "+v"(ra[3]), "+v"(rb[0]), "+v"(rb[1])); \
    bf16_t* sa_ = sm + (buf_) * BUF_EL; bf16_t* sb_ = sa_ + A_EL;                                 \
    _Pragma("unroll") for (int i = 0; i < 4; ++i) *(u32x4*)(sa_ + (crow + 32 * i) * 72 + ccol) = ra[i];   \
    _Pragma("unroll") for (int i = 0; i < BCH; ++i) *(u32x4*)(sb_ + (crow + 32 * i) * 72 + ccol) = rb[i]; \
  }
  if (!pre) {
    GEMM_ISSUE(Ap, lda, Bp, ldb);
    GEMM_LAND(par);
    __syncthreads();
  }
  for (int kt = 0; kt < nk; ++kt) {
    {
      const bool inner = (kt + 1 < nk);
      const bf16_t* ap = inner ? Ap + ((kt + 1) << 6) : Apn;
      const bf16_t* bp = inner ? Bp + ((kt + 1) << 6) : Bpn;
      const int sa = inner ? lda : ldan, sb = inner ? ldb : ldbn;
      GEMM_ISSUE(ap, sa, bp, sb);
    }
    __builtin_amdgcn_sched_barrier(0);
    {
      const bf16_t* sa = sm + ((par + kt) & 1) * BUF_EL; const bf16_t* sb = sa + A_EL;
#pragma unroll
      for (int ks = 0; ks < 2; ++ks) {
        bf16x8 a[4], b[NJ];
#pragma unroll
        for (int i = 0; i < 4; ++i) a[i] = *(const bf16x8*)(sa + (wm * 64 + i * 16 + l16) * 72 + ks * 32 + quad * 8);
#pragma unroll
        for (int j = 0; j < NJ; ++j) b[j] = *(const bf16x8*)(sb + (wn * (BN / 2) + j * 16 + l16) * 72 + ks * 32 + quad * 8);
#pragma unroll
        for (int i = 0; i < 4; ++i)
#pragma unroll
          for (int j = 0; j < NJ; ++j) acc[i][j] = __builtin_amdgcn_mfma_f32_16x16x32_bf16(b[j], a[i], acc[i][j], 0, 0, 0);
      }
    }
    __builtin_amdgcn_sched_barrier(0);
    GEMM_LAND((par + kt + 1) & 1);
    __syncthreads();
  }
  par = (par + nk) & 1;
#undef GEMM_ISSUE
#undef GEMM_LAND
}
template <int BN>
DI void gemm_acc(const bf16_t* __restrict__ A, int lda, const bf16_t* __restrict__ Bt, int ldb, int K, char* smem,
                 f32x4 (&acc)[4][BN / 32]) {
  int par = 0;
  gemm_acc<BN>(A, lda, Bt, ldb, K, smem, acc, A, lda, Bt, ldb, false, par);
}
template <int NJ> DI void zero_acc(f32x4 (&acc)[4][NJ]) {
#pragma unroll
  for (int i = 0; i < 4; ++i)
#pragma unroll
    for (int j = 0; j < NJ; ++j) acc[i][j] = f32x4{0.f, 0.f, 0.f, 0.f};
}
#define EPI_FOR(BN_)                                                                         \
  const int _t = TID(); const int _lane = _t & 63, _wave = _t >> 6;                              \
  const int _wm = _wave >> 1, _wn = _wave & 1, _l16 = _lane & 15, _quad = _lane >> 4;        \
  _Pragma("unroll") for (int i = 0; i < 4; ++i)                                              \
  _Pragma("unroll") for (int j = 0; j < (BN_) / 32; ++j)                                     \
  _Pragma("unroll") for (int r = 0; r < 4; ++r)
#define EPI_ROW (_wm * 64 + i * 16 + _l16)
#define EPI_COL(BN_) (_wn * ((BN_) / 2) + j * 16 + _quad * 4 + r)
#define EPI4_FOR(BN_)                                                                        \
  const int _t = TID(); const int _lane = _t & 63, _wave = _t >> 6;                          \
  const int _wm = _wave >> 1, _wn = _wave & 1, _l16 = _lane & 15, _quad = _lane >> 4;        \
  _Pragma("unroll") for (int i = 0; i < 4; ++i)                                              \
  _Pragma("unroll") for (int j = 0; j < (BN_) / 32; ++j)
#define EPI4_COL(BN_) (_wn * ((BN_) / 2) + j * 16 + _quad * 4)
DI uint2 pack4(f32x4 v) { uint2 o; o.x = pack2(v[0], v[1]); o.y = pack2(v[2], v[3]); return o; }
DI f32x4 unpack4(uint2 u) { return f32x4{bflo(u.x), bfhi(u.x), bflo(u.y), bfhi(u.y)}; }

DI void transpose_tile(const float* __restrict__ W, int ldw, bf16_t* __restrict__ Wt, int ldt, int k0, int n0, char* smem) {
  float* sm = (float*)smem;
  const int tid = TID();
  __syncthreads();
#pragma unroll
  for (int i = 0; i < 4; ++i) {
    const int k = (tid >> 4) + 16 * i, n4 = (tid & 15) * 4;
    const float4 v = *(const float4*)(W + (size_t)(k0 + k) * ldw + n0 + n4);
    sm[k * 65 + n4 + 0] = v.x; sm[k * 65 + n4 + 1] = v.y; sm[k * 65 + n4 + 2] = v.z; sm[k * 65 + n4 + 3] = v.w;
  }
  __syncthreads();
  const int n = tid >> 2, ks = (tid & 3) * 16;
  unsigned u[8];
#pragma unroll
  for (int e = 0; e < 8; ++e) u[e] = pack2(sm[(ks + 2 * e) * 65 + n], sm[(ks + 2 * e + 1) * 65 + n]);
  uint4* dst = (uint4*)(Wt + (size_t)(n0 + n) * ldt + k0 + ks);
  dst[0] = uint4{u[0], u[1], u[2], u[3]};
  dst[1] = uint4{u[4], u[5], u[6], u[7]};
}
DI void transpose_all(const float* W, int ldw, int K, int N, bf16_t* Wt, int bid, int nb, char* smem) {
  const int tk = K >> 6, tn = N >> 6;
  for (int t = bid; t < tk * tn; t += nb) transpose_tile(W, ldw, Wt, K, (t % tk) * 64, (t / tk) * 64, smem);
}

DI void rmsnorm_rows(const float* __restrict__ x, const float* __restrict__ g, bf16_t* __restrict__ h, float* xcopy, int rows,
                     int bid, int nb) {
  const int lane = TID() & 63, wave = TID() >> 6;
  for (int r = bid * 4 + wave; r < rows; r += nb * 4) {
    const float4* xr = (const float4*)(x + (size_t)r * 1024);
    float4 v[4]; float ss = 0.f;
#pragma unroll
    for (int i = 0; i < 4; ++i) { v[i] = xr[lane + 64 * i]; ss += v[i].x * v[i].x + v[i].y * v[i].y + v[i].z * v[i].z + v[i].w * v[i].w; }
    ss = wave_sum(ss);
    const float rs = rsqrtf(ss * (1.f / 1024.f) + 1e-6f);
#pragma unroll
    for (int i = 0; i < 4; ++i) {
      const float4 gg = ((const float4*)g)[lane + 64 * i];
      uint2 o; o.x = pack2(v[i].x * rs * gg.x, v[i].y * rs * gg.y); o.y = pack2(v[i].z * rs * gg.z, v[i].w * rs * gg.w);
      *(uint2*)(h + (size_t)r * 1024 + (lane + 64 * i) * 4) = o;
      if (xcopy) ((float4*)(xcopy + (size_t)r * 1024))[lane + 64 * i] = v[i];
    }
  }
}

template <int DQK, bool CAUSAL>
DI void attn_item(const bf16_t* __restrict__ Q, int ldq, const bf16_t* __restrict__ Kp, int ldk, const bf16_t* __restrict__ VT, int ldvt,
                  int ntiles, int q0, bf16_t* __restrict__ out, int ldo, char* smem) {
  constexpr int KS = DQK + 8, NS = DQK / 16, KCH = DQK / 8;
  bf16_t* Ks = (bf16_t*)smem;
  bf16_t* Vs = Ks + 64 * KS;
  const int tid = TID(), lane = tid & 63, wave = tid >> 6, ql = lane & 31, hh = lane >> 5;
  const int qrow = q0 + wave * 32 + ql;
  bf16x8 bq[NS];
#pragma unroll
  for (int s = 0; s < NS; ++s) bq[s] = *(const bf16x8*)(Q + (size_t)qrow * ldq + s * 16 + hh * 8);
  f32x16 ot[4];
#pragma unroll
  for (int d = 0; d < 4; ++d)
#pragma unroll
    for (int i = 0; i < 16; ++i) ot[d][i] = 0.f;
  float mrun = -INFINITY, lrun = 0.f;
  for (int kt = 0; kt < ntiles; ++kt) {
    __syncthreads();
    for (int c = tid; c < 64 * KCH; c += 256) {
      const int row = c / KCH, cc = c % KCH;
      *(uint4*)(Ks + row * KS + cc * 8) = *(const uint4*)(Kp + (size_t)(kt * 64 + row) * ldk + cc * 8);
    }
#pragma unroll
    for (int c0 = 0; c0 < 4; ++c0) {
      const int c = tid + c0 * 256, row = c >> 3, cc = c & 7;
      *(uint4*)(Vs + row * 72 + cc * 8) = *(const uint4*)(VT + (size_t)row * ldvt + kt * 64 + cc * 8);
    }
    __syncthreads();
    f32x16 st[2];
#pragma unroll
    for (int kb = 0; kb < 2; ++kb) {
#pragma unroll
      for (int i = 0; i < 16; ++i) st[kb][i] = 0.f;
#pragma unroll
      for (int s = 0; s < NS; ++s) {
        const bf16x8 a = *(const bf16x8*)(Ks + (kb * 32 + ql) * KS + s * 16 + hh * 8);
        st[kb] = __builtin_amdgcn_mfma_f32_32x32x16_bf16(a, bq[s], st[kb], 0, 0, 0);
      }
    }
    float mx = -INFINITY;
#pragma unroll
    for (int kb = 0; kb < 2; ++kb)
#pragma unroll
      for (int i = 0; i < 16; ++i) {
        if (CAUSAL) {
          const int key = kt * 64 + kb * 32 + (i & 3) + 8 * (i >> 2) + 4 * hh;
          if (key > qrow) st[kb][i] = -INFINITY;
        }
        mx = fmaxf(mx, st[kb][i]);
      }
    mx = fmaxf(mx, __shfl_xor(mx, 32));
    const float mnew = fmaxf(mrun, mx);
    const float alpha = __builtin_amdgcn_exp2f(mrun - mnew);
    float ps = 0.f;
#pragma unroll
    for (int kb = 0; kb < 2; ++kb)
#pragma unroll
      for (int i = 0; i < 16; ++i) { const float pv = __builtin_amdgcn_exp2f(st[kb][i] - mnew); st[kb][i] = pv; ps += pv; }
    ps += __shfl_xor(ps, 32);
    lrun = lrun * alpha + ps;
    mrun = mnew;
#pragma unroll
    for (int d = 0; d < 4; ++d)
#pragma unroll
      for (int i = 0; i < 16; ++i) ot[d][i] *= alpha;
#pragma unroll
    for (int kb = 0; kb < 2; ++kb)
#pragma unroll
      for (int s2 = 0; s2 < 2; ++s2) {
        unsigned pk[4];
#pragma unroll
        for (int e = 0; e < 4; ++e) pk[e] = pack2(st[kb][8 * s2 + 2 * e], st[kb][8 * s2 + 2 * e + 1]);
        const bf16x8 pb = __builtin_bit_cast(bf16x8, uint4{pk[0], pk[1], pk[2], pk[3]});
#pragma unroll
        for (int d = 0; d < 4; ++d) {
          const bf16_t* vp = Vs + (d * 32 + ql) * 72 + kb * 32 + s2 * 16 + hh * 4;
          const s16x4 lo = *(const s16x4*)vp;
          const s16x4 hi = *(const s16x4*)(vp + 8);
          const bf16x8 av = __builtin_shufflevector(lo, hi, 0, 1, 2, 3, 4, 5, 6, 7);
          ot[d] = __builtin_amdgcn_mfma_f32_32x32x16_bf16(av, pb, ot[d], 0, 0, 0);
        }
      }
  }
  const float inv = 1.f / lrun;
#pragma unroll
  for (int d = 0; d < 4; ++d)
#pragma unroll
    for (int g4 = 0; g4 < 4; ++g4) {
      uint2 o; o.x = pack2(ot[d][4 * g4] * inv, ot[d][4 * g4 + 1] * inv); o.y = pack2(ot[d][4 * g4 + 2] * inv, ot[d][4 * g4 + 3] * inv);
      *(uint2*)(out + (size_t)qrow * ldo + d * 32 + 8 * g4 + 4 * hh) = o;
    }
}


template <int DQK, bool CAUSAL>
DI void attn_item_pf(const bf16_t* __restrict__ Q, int ldq, const bf16_t* Kp, int ldk, const bf16_t* VT, int ldvt,
                  int ntiles, int q0, bf16_t* __restrict__ out, int ldo, char* smem) {
  constexpr int KS = DQK + 8, NS = DQK / 16, KCH = DQK / 8;
  bf16_t* Ks = (bf16_t*)smem;
  bf16_t* Vs = Ks + 64 * KS;
  const int tid = TID(), lane = tid & 63, wave = tid >> 6, ql = lane & 31, hh = lane >> 5;
  const int qrow = q0 + wave * 32 + ql;
  bf16x8 bq[NS];
#pragma unroll
  for (int s = 0; s < NS; ++s) bq[s] = *(const bf16x8*)(Q + (size_t)qrow * ldq + s * 16 + hh * 8);
  f32x16 ot[4];
#pragma unroll
  for (int d = 0; d < 4; ++d)
#pragma unroll
    for (int i = 0; i < 16; ++i) ot[d][i] = 0.f;
  float mrun = -INFINITY, lrun = 0.f;
  Kp = uniform_ptr(Kp); VT = uniform_ptr(VT);
  constexpr int KR = KCH / 4;
  static_assert(KR == 6, "prefetch variant is written for DQK = 192");
  u32x4 kreg[KR], vreg[4];
  const unsigned kvoff = (unsigned)(((tid >> 2) * ldk + (tid & 3) * 8) * 2);
  const unsigned vvoff = (unsigned)(((tid >> 3) * ldvt + (tid & 7) * 8) * 2);
#define GLOADS(dst, voff, sbase) asm volatile("global_load_dwordx4 %0, %1, %2" : "=v"(dst) : "v"(voff), "s"(sbase))
#define ATT_ISSUE(kt_)                                                                                        \
  {                                                                                                           \
    _Pragma("unroll") for (int c0 = 0; c0 < KR; ++c0) GLOADS(kreg[c0], kvoff, Kp + (size_t)(kt_) * 64 * ldk + c0 * 32);   \
    _Pragma("unroll") for (int c0 = 0; c0 < 4; ++c0) GLOADS(vreg[c0], vvoff, VT + (size_t)(c0 * 32) * ldvt + (kt_) * 64); \
  }
#define ATT_LAND()                                                                                            \
  {                                                                                                           \
    asm volatile("s_waitcnt vmcnt(0)" : "+v"(kreg[0]), "+v"(kreg[1]), "+v"(kreg[2]), "+v"(kreg[3]), "+v"(kreg[4]), "+v"(kreg[5]), \
                 "+v"(vreg[0]), "+v"(vreg[1]), "+v"(vreg[2]), "+v"(vreg[3]));                                 \
    _Pragma("unroll") for (int c0 = 0; c0 < KR; ++c0) *(u32x4*)(Ks + (tid >> 2) * KS + ((tid & 3) + 4 * c0) * 8) = kreg[c0];   \
    _Pragma("unroll") for (int c0 = 0; c0 < 4; ++c0) *(u32x4*)(Vs + ((tid >> 3) + 32 * c0) * 72 + (tid & 7) * 8) = vreg[c0];   \
  }
  __syncthreads();
  ATT_ISSUE(0);
  ATT_LAND();
  __syncthreads();
  for (int kt = 0; kt < ntiles; ++kt) {
    {
      const int ktn = (kt + 1 < ntiles) ? kt + 1 : kt;
      ATT_ISSUE(ktn);
    }
    __builtin_amdgcn_sched_barrier(0);
    f32x16 st[2];
#pragma unroll
    for (int kb = 0; kb < 2; ++kb) {
#pragma unroll
      for (int i = 0; i < 16; ++i) st[kb][i] = 0.f;
#pragma unroll
      for (int s = 0; s < NS; ++s) {
        const bf16x8 a = *(const bf16x8*)(Ks + (kb * 32 + ql) * KS + s * 16 + hh * 8);
        st[kb] = __builtin_amdgcn_mfma_f32_32x32x16_bf16(a, bq[s], st[kb], 0, 0, 0);
      }
    }
    float mx = -INFINITY;
#pragma unroll
    for (int kb = 0; kb < 2; ++kb)
#pragma unroll
      for (int i = 0; i < 16; ++i) {
        if (CAUSAL) {
          const int key = kt * 64 + kb * 32 + (i & 3) + 8 * (i >> 2) + 4 * hh;
          if (key > qrow) st[kb][i] = -INFINITY;
        }
        mx = fmaxf(mx, st[kb][i]);
      }
    mx = fmaxf(mx, __shfl_xor(mx, 32));
    const float mnew = fmaxf(mrun, mx);
    const float alpha = __builtin_amdgcn_exp2f(mrun - mnew);
    float ps = 0.f;
#pragma unroll
    for (int kb = 0; kb < 2; ++kb)
#pragma unroll
      for (int i = 0; i < 16; ++i) { const float pv = __builtin_amdgcn_exp2f(st[kb][i] - mnew); st[kb][i] = pv; ps += pv; }
    ps += __shfl_xor(ps, 32);
    lrun = lrun * alpha + ps;
    mrun = mnew;
#pragma unroll
    for (int d = 0; d < 4; ++d)
#pragma unroll
      for (int i = 0; i < 16; ++i) ot[d][i] *= alpha;
#pragma unroll
    for (int kb = 0; kb < 2; ++kb)
#pragma unroll
      for (int s2 = 0; s2 < 2; ++s2) {
        unsigned pk[4];
#pragma unroll
        for (int e = 0; e < 4; ++e) pk[e] = pack2(st[kb][8 * s2 + 2 * e], st[kb][8 * s2 + 2 * e + 1]);
        const bf16x8 pb = __builtin_bit_cast(bf16x8, uint4{pk[0], pk[1], pk[2], pk[3]});
#pragma unroll
        for (int d = 0; d < 4; ++d) {
          const bf16_t* vp = Vs + (d * 32 + ql) * 72 + kb * 32 + s2 * 16 + hh * 4;
          const s16x4 lo = *(const s16x4*)vp;
          const s16x4 hi = *(const s16x4*)(vp + 8);
          const bf16x8 av = __builtin_shufflevector(lo, hi, 0, 1, 2, 3, 4, 5, 6, 7);
          ot[d] = __builtin_amdgcn_mfma_f32_32x32x16_bf16(av, pb, ot[d], 0, 0, 0);
        }
      }
    __builtin_amdgcn_sched_barrier(0);
    __syncthreads();
    ATT_LAND();
    __syncthreads();
  }
#undef ATT_ISSUE
#undef ATT_LAND
#undef GLOADS
  const float inv = 1.f / lrun;
#pragma unroll
  for (int d = 0; d < 4; ++d)
#pragma unroll
    for (int g4 = 0; g4 < 4; ++g4) {
      uint2 o; o.x = pack2(ot[d][4 * g4] * inv, ot[d][4 * g4 + 1] * inv); o.y = pack2(ot[d][4 * g4 + 2] * inv, ot[d][4 * g4 + 3] * inv);
      *(uint2*)(out + (size_t)qrow * ldo + d * 32 + 8 * g4 + 4 * hh) = o;
    }
}

DI void rwkv_scan_unit(const Params& p, int l, int u, char* smem) {
  const int tid = TID();
  const int bl = u >> 5, hd = (u >> 2) & 7, rg = u & 3;
  const int kq = tid & 15, g16 = tid >> 4;
  const bf16_t* RKV = (const bf16_t*)(p.ws + R_RKV) + (size_t)bl * SEQ * 1536;
  const bf16_t* Pm = (const bf16_t*)(p.ws + R_P) + (size_t)bl * SEQ * PLD;
  float* Y = (float*)(p.ws + R_YRW) + (size_t)bl * SEQ * 512;
  float* sm = (float*)smem;
  constexpr int BUFF = 5 * 1024 + 256 + 32;
  const int kc = hd * 64 + kq * 4;
  const float4 kk_w = *(const float4*)(p.in[27] + l * 512 + kc);
  const float4 ka_w = *(const float4*)(p.in[28] + l * 512 + kc);
  float S0 = 0.f, S1 = 0.f, S2 = 0.f, S3 = 0.f;
  uint2 g_r, g_k, g_w, g_a; bf16_t g_v;
  auto gload = [&](int c) {
    const int tok = c * 16 + g16;
    g_r = *(const uint2*)(RKV + (size_t)tok * 1536 + kc);
    g_k = *(const uint2*)(RKV + (size_t)tok * 1536 + 512 + kc);
    g_v = RKV[(size_t)tok * 1536 + 1024 + hd * 64 + rg * 16 + kq];
    g_w = *(const uint2*)(Pm + (size_t)tok * PLD + PC_RW + kc);
    g_a = *(const uint2*)(Pm + (size_t)tok * PLD + PC_RW + 512 + kc);
  };
  auto derive = [&](int buf) {
    float* b = sm + buf * BUFF;
    const float r[4] = {bflo(g_r.x), bfhi(g_r.x), bflo(g_r.y), bfhi(g_r.y)};
    const float k[4] = {bflo(g_k.x), bfhi(g_k.x), bflo(g_k.y), bfhi(g_k.y)};
    const float w[4] = {bflo(g_w.x), bfhi(g_w.x), bflo(g_w.y), bfhi(g_w.y)};
    const float a[4] = {bflo(g_a.x), bfhi(g_a.x), bflo(g_a.y), bfhi(g_a.y)};
    const float kkw[4] = {kk_w.x, kk_w.y, kk_w.z, kk_w.w};
    const float kaw[4] = {ka_w.x, ka_w.y, ka_w.z, ka_w.w};
    float kk[4], ss = 0.f;
#pragma unroll
    for (int e = 0; e < 4; ++e) { kk[e] = k[e] * kkw[e]; ss += kk[e] * kk[e]; }
    ss = red16(ss);
    const float rn = rsqrtf(ss + 1e-12f);
    float dwr[4], dw[4], dk[4], dn[4], db[4];
    float br = 0.f, khr = 0.f;
#pragma unroll
    for (int e = 0; e < 4; ++e) {
      dw[e] = __expf(-0.6065306597126334f * sigm(w[e]));
      const float kn = kk[e] * rn;
      dn[e] = -kn; db[e] = kn * a[e];
      dk[e] = k[e] * (1.f + (a[e] - 1.f) * kaw[e]);
      dwr[e] = dw[e] * r[e];
      br += db[e] * r[e]; khr += dk[e] * r[e];
    }
    br = red16(br); khr = red16(khr);
#pragma unroll
    for (int e = 0; e < 4; ++e) dwr[e] += dn[e] * br;
    *(float4*)(b + 0 * 1024 + g16 * 64 + kq * 4) = float4{dwr[0], dwr[1], dwr[2], dwr[3]};
    *(float4*)(b + 1 * 1024 + g16 * 64 + kq * 4) = float4{dw[0], dw[1], dw[2], dw[3]};
    *(float4*)(b + 2 * 1024 + g16 * 64 + kq * 4) = float4{dk[0], dk[1], dk[2], dk[3]};
    *(float4*)(b + 3 * 1024 + g16 * 64 + kq * 4) = float4{dn[0], dn[1], dn[2], dn[3]};
    *(float4*)(b + 4 * 1024 + g16 * 64 + kq * 4) = float4{db[0], db[1], db[2], db[3]};
    b[5 * 1024 + g16 * 16 + kq] = bf2f(g_v);
    if (kq == 0) b[5 * 1024 + 256 + g16] = khr;
  };
  __syncthreads();
  gload(0); derive(0);
  __syncthreads();
  constexpr int NC = SEQ / 16;
  for (int c = 0; c < NC; ++c) {
    if (c + 1 < NC) gload(c + 1);
    const float* b = sm + (c & 1) * BUFF;
    float ysel = 0.f;
    float4 nk = *(const float4*)(b + 3 * 1024 + kq * 4);
    float4 w = *(const float4*)(b + 1 * 1024 + kq * 4);
    float4 bb = *(const float4*)(b + 4 * 1024 + kq * 4);
    float4 kh = *(const float4*)(b + 2 * 1024 + kq * 4);
    float4 wr = *(const float4*)(b + 0 * 1024 + kq * 4);
    float v = b[5 * 1024 + g16];
    float khrs = b[5 * 1024 + 256];
#pragma unroll
    for (int t = 0; t < 16; ++t) {
      float4 nk2, w2, bb2, kh2, wr2; float v2, khrs2;
      if (t < 15) {
        nk2 = *(const float4*)(b + 3 * 1024 + (t + 1) * 64 + kq * 4);
        w2 = *(const float4*)(b + 1 * 1024 + (t + 1) * 64 + kq * 4);
        bb2 = *(const float4*)(b + 4 * 1024 + (t + 1) * 64 + kq * 4);
        kh2 = *(const float4*)(b + 2 * 1024 + (t + 1) * 64 + kq * 4);
        wr2 = *(const float4*)(b + 0 * 1024 + (t + 1) * 64 + kq * 4);
        v2 = b[5 * 1024 + (t + 1) * 16 + g16];
        khrs2 = b[5 * 1024 + 256 + t + 1];
      }
      float sa = S0 * nk.x + S1 * nk.y + S2 * nk.z + S3 * nk.w;
      float yy = S0 * wr.x + S1 * wr.y + S2 * wr.z + S3 * wr.w;
      sa = red16(sa);
      yy = red16(yy);
      S0 = S0 * w.x + sa * bb.x + v * kh.x;
      S1 = S1 * w.y + sa * bb.y + v * kh.y;
      S2 = S2 * w.z + sa * bb.z + v * kh.z;
      S3 = S3 * w.w + sa * bb.w + v * kh.w;
      yy += v * khrs;
      ysel = (kq == t) ? yy : ysel;
      if (t < 15) { nk = nk2; w = w2; bb = bb2; kh = kh2; wr = wr2; v = v2; khrs = khrs2; }
    }
    Y[(size_t)(c * 16 + kq) * 512 + hd * 64 + rg * 16 + g16] = ysel;
    if (c + 1 < NC) derive((c + 1) & 1);
    __syncthreads();
  }
}

DI void hgrn_scan_unit(const Params& p, int l, int u, char* smem) {
  const int tid = TID();
  const int bl = u >> 5, hd = (u >> 3) & 3, vg = u & 7;
  const int kq = tid & 15, g16 = tid >> 4;
  const bf16_t* Pm = (const bf16_t*)(p.ws + R_P) + (size_t)bl * SEQ * PLD;
  bf16_t* Og = (bf16_t*)(p.ws + R_OHG) + (size_t)bl * SEQ * 512;
  float* sm = (float*)smem;
  constexpr int BUFF = 2 * 2048 + 256 + 16;
  const int kc = hd * 128 + kq * 8;
  float lb[8];
#pragma unroll
  for (int e = 0; e < 8; ++e) {
    if (l == 0) lb[e] = 0.f;
    else { const float x0 = p.in[9][kc + e], x1 = p.in[9][512 + kc + e]; lb[e] = 1.f / (1.f + expf(x0 - x1)); }
  }
  float S[8];
#pragma unroll
  for (int e = 0; e < 8; ++e) S[e] = 0.f;
  uint4 g_q, g_f; bf16_t g_v;
  const int vcol = PC_HG + 1024 + hd * 128 + vg * 16;
  auto gload = [&](int c) {
    const int tok = c * 16 + g16;
    g_q = *(const uint4*)(Pm + (size_t)tok * PLD + PC_HG + kc);
    g_f = *(const uint4*)(Pm + (size_t)tok * PLD + PC_HG + 512 + kc);
    g_v = Pm[(size_t)tok * PLD + vcol + kq];
  };
  auto derive = [&](int buf) {
    float* b = sm + buf * BUFF;
    const unsigned qu[4] = {g_q.x, g_q.y, g_q.z, g_q.w}, fu[4] = {g_f.x, g_f.y, g_f.z, g_f.w};
    float fq[8], f[8], cs = 0.f;
#pragma unroll
    for (int e = 0; e < 8; ++e) {
      const float q = (e & 1) ? bfhi(qu[e >> 1]) : bflo(qu[e >> 1]);
      const float fx = (e & 1) ? bfhi(fu[e >> 1]) : bflo(fu[e >> 1]);
      f[e] = lb[e] + (1.f - lb[e]) * sigm(fx);
      fq[e] = f[e] * q;
      cs += (1.f - f[e]) * q;
    }
    cs = red16(cs);
    *(float4*)(b + g16 * 128 + kq * 8) = float4{fq[0], fq[1], fq[2], fq[3]};
    *(float4*)(b + g16 * 128 + kq * 8 + 4) = float4{fq[4], fq[5], fq[6], fq[7]};
    *(float4*)(b + 2048 + g16 * 128 + kq * 8) = float4{f[0], f[1], f[2], f[3]};
    *(float4*)(b + 2048 + g16 * 128 + kq * 8 + 4) = float4{f[4], f[5], f[6], f[7]};
    b[4096 + g16 * 16 + kq] = bf2f(g_v);
    if (kq == 0) b[4096 + 256 + g16] = cs;
  };
  __syncthreads();
  gload(0); derive(0);
  __syncthreads();
  constexpr int NC = SEQ / 16;
  for (int c = 0; c < NC; ++c) {
    if (c + 1 < NC) gload(c + 1);
    const float* b = sm + (c & 1) * BUFF;
    float osel = 0.f;
#pragma unroll
    for (int t = 0; t < 16; ++t) {
      const float4 q0 = *(const float4*)(b + t * 128 + kq * 8), q1 = *(const float4*)(b + t * 128 + kq * 8 + 4);
      const float4 f0 = *(const float4*)(b + 2048 + t * 128 + kq * 8), f1 = *(const float4*)(b + 2048 + t * 128 + kq * 8 + 4);
      const float v = b[4096 + t * 16 + g16];
      const float cs = b[4096 + 256 + t];
      const float fq[8] = {q0.x, q0.y, q0.z, q0.w, q1.x, q1.y, q1.z, q1.w};
      const float f[8] = {f0.x, f0.y, f0.z, f0.w, f1.x, f1.y, f1.z, f1.w};
      float o = 0.f;
#pragma unroll
      for (int e = 0; e < 8; ++e) { o += S[e] * fq[e]; S[e] = f[e] * (S[e] - v) + v; }
      o = red16(o) + v * cs;
      osel = (kq == t) ? o : osel;
    }
    Og[(size_t)(c * 16 + kq) * 512 + hd * 128 + vg * 16 + g16] = f2bf(osel);
    if (c + 1 < NC) derive((c + 1) & 1);
    __syncthreads();
  }
}

DI void s5_scan_unit(const Params& p, int l, int u, char* smem) {
  const int tid = TID(), lane = tid & 63, wave = tid >> 6;
  const int idx = u * 4 + wave, bl = idx >> 5, g = idx & 31;
  const bf16_t* Pm = (const bf16_t*)(p.ws + R_P) + (size_t)bl * SEQ * PLD + PC_S5 + g * 16;
  bf16_t* Z = (bf16_t*)(p.ws + R_ZS5) + (size_t)bl * SEQ * 512 + g * 16;
  constexpr int BUS = 132;
  float* buT = (float*)smem + wave * (16 * BUS);
  bf16_t* hist = (bf16_t*)(smem + 4 * 16 * BUS * 4) + wave * (16 * 136);
  const float2 ab = *(const float2*)((const float*)(p.ws + OFF_S5AB) + (g * 64 + lane) * 2);
  const int l16 = lane & 15, quad = lane >> 4;
  bf16x8 bbf[8];
  {
    const float* bbp = (const float*)(p.ws + OFF_S5BB);
#pragma unroll
    for (int jb = 0; jb < 8; ++jb) {
      const int col = jb * 16 + l16, nn = col & 63, im = col >> 6;
      unsigned pk[4] = {0u, 0u, 0u, 0u};
      if (quad < 2) {
        const float* src = bbp + (size_t)(g * 64 + nn) * 32 + im * 16 + quad * 8;
#pragma unroll
        for (int e = 0; e < 4; ++e) pk[e] = pack2(src[2 * e], src[2 * e + 1]);
      }
      bbf[jb] = __builtin_bit_cast(bf16x8, uint4{pk[0], pk[1], pk[2], pk[3]});
    }
  }
  bf16x8 cf[4];
  {
    const float* Cre = p.in[16] + (size_t)l * 32768 + (size_t)(g * 16 + l16) * 64;
    const float* Cim = p.in[17] + (size_t)l * 32768 + (size_t)(g * 16 + l16) * 64;
#pragma unroll
    for (int ks = 0; ks < 4; ++ks) {
      unsigned pk[4];
#pragma unroll
      for (int e = 0; e < 4; ++e) {
        const int k = ks * 32 + quad * 8 + 2 * e;
        const float v0 = (k < 64) ? Cre[k] : -Cim[k - 64];
        const float v1 = (k < 64) ? Cre[k + 1] : -Cim[k + 1 - 64];
        pk[e] = pack2(v0, v1);
      }
      cf[ks] = __builtin_bit_cast(bf16x8, uint4{pk[0], pk[1], pk[2], pk[3]});
    }
  }
  const float dcoef = p.in[18][l * 512 + g * 16 + l16];
  float xr = 0.f, xi = 0.f;
  uint4 ua = uint4{0u, 0u, 0u, 0u};
  bf16_t ue[4];
  auto gload = [&](int c) {
    if (quad < 2) ua = *(const uint4*)(Pm + (size_t)(c * 16 + l16) * PLD + quad * 8);
#pragma unroll
    for (int r = 0; r < 4; ++r) ue[r] = Pm[(size_t)(c * 16 + quad * 4 + r) * PLD + l16];
  };
  __syncthreads();
  gload(0);
  constexpr int NC = SEQ / 16;
  for (int c = 0; c < NC; ++c) {
    const bf16x8 afr = __builtin_bit_cast(bf16x8, ua);
    float us[4];
#pragma unroll
    for (int r = 0; r < 4; ++r) us[r] = bf2f(ue[r]);
#pragma unroll
    for (int jb = 0; jb < 8; ++jb) {
      f32x4 acc = {0.f, 0.f, 0.f, 0.f};
      acc = __builtin_amdgcn_mfma_f32_16x16x32_bf16(afr, bbf[jb], acc, 0, 0, 0);
#pragma unroll
      for (int r = 0; r < 4; ++r) buT[(quad * 4 + r) * BUS + jb * 16 + l16] = acc[r];
    }
    if (c + 1 < NC) gload(c + 1);
    __syncthreads();
#pragma unroll
    for (int t = 0; t < 16; ++t) {
      const float ur = buT[t * BUS + lane], ui = buT[t * BUS + 64 + lane];
      const float nr = ab.x * xr - ab.y * xi + ur;
      const float ni = ab.x * xi + ab.y * xr + ui;
      xr = nr; xi = ni;
      hist[t * 136 + lane] = f2bf(xr);
      hist[t * 136 + 64 + lane] = f2bf(xi);
    }
    __syncthreads();
    f32x4 acc = {0.f, 0.f, 0.f, 0.f};
#pragma unroll
    for (int ks = 0; ks < 4; ++ks) {
      const bf16x8 a = *(const bf16x8*)(hist + l16 * 136 + ks * 32 + quad * 8);
      acc = __builtin_amdgcn_mfma_f32_16x16x32_bf16(a, cf[ks], acc, 0, 0, 0);
    }
#pragma unroll
    for (int r = 0; r < 4; ++r) {
      const int t = quad * 4 + r;
      const float y = acc[r] + dcoef * us[r];
      const float z = y * sigm(1.5957691216057308f * (y + 0.044715f * y * y * y));
      Z[(size_t)(c * 16 + t) * 512 + l16] = f2bf(z);
    }
  }
}

#define GSYNC() xcd_barrier(xb)
#define TILE_MAP(u_, ntm_, tm_, tn_) { const int _x = (u_) & 7, _li = (u_) >> 3, _per = (ntm_) >> 3; tm_ = _x * _per + (_li % _per); tn_ = _li / _per; }
__global__ void __launch_bounds__(256, 2) mega_kernel(Params p) {
  cg::grid_group grid = cg::this_grid();
  __shared__ __attribute__((aligned(16))) char smem[SMEM_BYTES];
  __shared__ uint4 xb_words;
  const int bid = blockIdx.x, nb = gridDim.x;
  if (p.ws == nullptr) grid.sync();
  if (threadIdx.x == 0) xb_words = make_uint4(0u, 0u, 0u, 0u);
  __syncthreads();
  const XcdBarrier xb = xcd_barrier_post((unsigned*)(p.ws + OFF_BAR), (volatile LAS unsigned*)&xb_words);
  char* ws = p.ws;
  float* X = p.out;
  bf16_t* Wt_in = (bf16_t*)(ws + OFF_WIN);
  bf16_t* Wt_q = (bf16_t*)(ws + OFF_WQ);
  bf16_t* Wt_br = (bf16_t*)(ws + OFF_WBR);
  bf16_t* Wt_out = (bf16_t*)(ws + OFF_WOUT);
  bf16_t* Wt_glu = (bf16_t*)(ws + OFF_WGLU);
  bf16_t* Wt_wup = (bf16_t*)(ws + OFF_WWUP);
  bf16_t* Wt_aup = (bf16_t*)(ws + OFF_WAUP);
  bf16_t* Wt_gup = (bf16_t*)(ws + OFF_WGUP);
  bf16_t* Wt_v = (bf16_t*)(ws + OFF_WV);
  bf16_t* Wt_xkv = (bf16_t*)(ws + OFF_WXKV);
  bf16_t* Hb = (bf16_t*)(ws + OFF_H);
  bf16_t* Vfirst = (bf16_t*)(ws + OFF_VFIRST);
  bf16_t* Kx = (bf16_t*)(ws + OFF_KX);
  bf16_t* VxT = (bf16_t*)(ws + OFF_VXT);
  bf16_t* Hm = (bf16_t*)(ws + OFF_HM);
  float* CosT = (float*)(ws + OFF_COS);
  float* SinT = (float*)(ws + OFF_SIN);
  bf16_t* Pm = (bf16_t*)(ws + R_P);
  bf16_t* Cqn = (bf16_t*)(ws + R_CQN);
  bf16_t* Qp = (bf16_t*)(ws + R_QP);
  bf16_t* KVlat = (bf16_t*)(ws + R_KVLAT);
  bf16_t* VTm = (bf16_t*)(ws + R_VT);
  bf16_t* RKV = (bf16_t*)(ws + R_RKV);
  bf16_t* Alora = (bf16_t*)(ws + R_ALORA);
  float* Yrw = (float*)(ws + R_YRW);
  bf16_t* Zs5 = (bf16_t*)(ws + R_ZS5);
  bf16_t* Ybr = (bf16_t*)(ws + R_YBR);
  bf16_t* Wt_xq = (bf16_t*)(ws + R_WXQ);
  bf16_t* Wt_xo = (bf16_t*)(ws + R_WXO);
  bf16_t* Wt_gu = (bf16_t*)(ws + R_WGU);
  bf16_t* Wt_down = (bf16_t*)(ws + R_WDOWN);
  bf16_t* Qx = (bf16_t*)(ws + R_QX);
  bf16_t* Ox = (bf16_t*)(ws + R_OX);
  bf16_t* GU = (bf16_t*)(ws + R_GU);
  const float LOG2E = 1.4426950408889634f;

  for (int l = 0; l < 2; ++l) {
    {
      PHASE_IDS
      const float* w_in = p.in[4] + (size_t)l * 1024 * P_IN;
      transpose_all(w_in, P_IN, 1024, P_IN, Wt_in, bid, nb, smem);
      transpose_all(p.in[36] + (size_t)l * 512 * 1024, 1024, 512, 1024, Wt_br + (size_t)1 * 1024 * 512, bid, nb, smem);
      transpose_all(p.in[37] + (size_t)l * 512 * 1024, 1024, 512, 1024, Wt_br + (size_t)2 * 1024 * 512, bid, nb, smem);
      transpose_all(p.in[38] + (size_t)l * 512 * 1024, 1024, 512, 1024, Wt_br + (size_t)3 * 1024 * 512, bid, nb, smem);
      transpose_all(p.in[39] + (size_t)l * 1024 * 1024, 1024, 1024, 1024, Wt_out, bid, nb, smem);
      transpose_all(p.in[19] + (size_t)l * 512 * 512, 512, 512, 512, Wt_glu, bid, nb, smem);
      transpose_all(p.in[23] + (size_t)l * 64 * 512, 512, 64, 512, Wt_wup, bid, nb, smem);
      transpose_all(p.in[25] + (size_t)l * 64 * 512, 512, 64, 512, Wt_aup, bid, nb, smem);
      transpose_all(p.in[26] + (size_t)l * 128 * 512, 512, 128, 512, Wt_gup, bid, nb, smem);
      transpose_all(p.in[43] + (size_t)l * 1024 * 2048, 2048, 1024, 2048, Wt_xkv, bid, nb, smem);
      const int gtid = bid * 256 + tid, gsz = nb * 256;
      {
        const float* w_uq = p.in[6] + (size_t)l * 256 * 768;
        const float* w_ukv = p.in[8] + (size_t)l * 128 * 1024;
        for (int e = gtid; e < 768 * 256; e += gsz) {
          const int n = e >> 8, kq = e & 255, hh = n / 192, j = n % 192;
          float v;
          if (j >= 128) v = w_uq[kq * 768 + n];
          else {
            const float4* a = (const float4*)(w_uq + kq * 768 + hh * 192);
            const float4* b = (const float4*)(w_ukv + j * 1024 + hh * 256);
            float v0 = 0.f, v1 = 0.f, v2 = 0.f, v3 = 0.f;
#pragma unroll 8
            for (int d = 0; d < 32; ++d) { const float4 x = a[d], y = b[d]; v0 += x.x * y.x; v1 += x.y * y.y; v2 += x.z * y.z; v3 += x.w * y.w; }
            v = (v0 + v1) + (v2 + v3);
          }
          Wt_q[e] = f2bf(v);
        }
        const float* w_bm = p.in[35] + (size_t)l * 512 * 1024;
        for (int e = gtid; e < 1024 * 512; e += gsz) {
          const int n = e & 1023, kk = e >> 10, hh = kk >> 7, j = kk & 127;
          const float* a = w_ukv + j * 1024 + hh * 256 + 128;
          const float* bcol = w_bm + (size_t)(hh * 128) * 1024 + n;
          float v0 = 0.f, v1 = 0.f, v2 = 0.f, v3 = 0.f;
#pragma unroll 4
          for (int d = 0; d < 128; d += 4) {
            const float4 x = *(const float4*)(a + d);
            v0 += x.x * bcol[(size_t)(d + 0) * 1024]; v1 += x.y * bcol[(size_t)(d + 1) * 1024];
            v2 += x.z * bcol[(size_t)(d + 2) * 1024]; v3 += x.w * bcol[(size_t)(d + 3) * 1024];
          }
          Wt_br[(size_t)n * 512 + kk] = f2bf((v0 + v1) + (v2 + v3));
        }
        if (l == 1) {
          const float* vd = p.in[32];
          const float* vu = p.in[33];
          for (int e = gtid; e < 512 * 1024; e += gsz) {
            const int n = e & 511, kk = e >> 9;
            float v0 = 0.f, v1 = 0.f, v2 = 0.f, v3 = 0.f;
#pragma unroll
            for (int r = 0; r < 32; r += 4) {
              const float4 x = *(const float4*)(vd + kk * 32 + r);
              v0 += x.x * vu[(r + 0) * 512 + n]; v1 += x.y * vu[(r + 1) * 512 + n];
              v2 += x.z * vu[(r + 2) * 512 + n]; v3 += x.w * vu[(r + 3) * 512 + n];
            }
            Wt_v[(size_t)n * 1024 + kk] = f2bf((v0 + v1) + (v2 + v3));
          }
        }
      }
      {
        float* abp = (float*)(ws + OFF_S5AB);
        float* bbp = (float*)(ws + OFF_S5BB);
        for (int e = gtid; e < 2048; e += gsz) {
          const int g = e >> 6;
          const float are = fminf(p.in[11][l * 2048 + e], -1e-4f), aim = p.in[12][l * 2048 + e];
          const float dt = expf(p.in[13][l * 32 + g]);
          const float mag = expf(dt * are);
          const float abre = mag * cosf(dt * aim), abim = mag * sinf(dt * aim);
          const float den = are * are + aim * aim;
          const float zre = ((abre - 1.f) * are + abim * aim) / den;
          const float zim = (abim * are - (abre - 1.f) * aim) / den;
          abp[e * 2] = abre; abp[e * 2 + 1] = abim;
          const float* Br = p.in[14] + (size_t)l * 32768 + (size_t)e * 16;
          const float* Bi = p.in[15] + (size_t)l * 32768 + (size_t)e * 16;
          for (int c = 0; c < 16; ++c) {
            bbp[e * 32 + c] = zre * Br[c] - zim * Bi[c];
            bbp[e * 32 + 16 + c] = zre * Bi[c] + zim * Br[c];
          }
        }
      }
      if (l == 0) rmsnorm_rows(p.in[0], p.in[3], Hb, X, T_ALL, bid, nb);
      else rmsnorm_rows(X, p.in[3] + 1024, Hb, nullptr, T_ALL, bid, nb);
      rmsnorm_rows(p.in[1], p.in[41] + l * 1024, Hm, nullptr, 1024, bid, nb);
    }
    GSYNC();

    for (int half = 0; half < 2; ++half) {
      const bf16_t* Hh = Hb + (size_t)half * TH * 1024;
      {
        const int n1 = 64 * 38;
        const int n2 = (half == 0) ? 8 * 16 : 0;
        int par = 0;
        for (int u = bid; u < n1 + n2; u += nb) {
          f32x4 acc[4][4];
          zero_acc<4>(acc);
          if (u < n1) {
            int tm, tn; TILE_MAP(u, 64, tm, tn);
            int tmn = tm, tnn = tn; if (u + nb < n1) TILE_MAP(u + nb, 64, tmn, tnn);
            gemm_acc<128>(Hh + (size_t)tm * 128 * 1024, 1024, Wt_in + (size_t)tn * 128 * 1024, 1024, 1024, smem, acc,
                          Hh + (size_t)tmn * 128 * 1024, 1024, Wt_in + (size_t)tnn * 128 * 1024, 1024, u != bid, par);
            EPI4_FOR(128) {
              const int row = tm * 128 + EPI_ROW, n = tn * 128 + EPI4_COL(128);
              if (n < GATE_OFF) {
                const int pc = (n < 448) ? n : n + 64;
                *(uint2*)(Pm + (size_t)row * PLD + pc) = pack4(acc[i][j]);
              }
            }
          } else {
            const int v = u - n1, tn = v % 16, tm = v / 16;
            gemm_acc<128>(Hm + (size_t)tm * 128 * 1024, 1024, Wt_xkv + (size_t)tn * 128 * 1024, 1024, 1024, smem, acc);
            EPI_FOR(128) {
              const int row = tm * 128 + EPI_ROW, n = tn * 128 + EPI_COL(128);
              const int b = row >> 8, m = row & 255, sel = n >> 10, hh = (n >> 8) & 3, d = n & 255;
              if (sel == 0) Kx[((size_t)(b * 4 + hh) * 256 + m) * 256 + d] = f2bf(acc[i][j][r]);
              else VxT[((size_t)(b * 4 + hh) * 256 + d) * 256 + m] = f2bf(acc[i][j][r]);
            }
          }
        }
      }
      GSYNC();
      {
      PHASE_IDS
        const float* qn = p.in[5] + l * 256;
        const float* kvn = p.in[7] + l * 128;
        const float* mu = p.in[21] + l * 1792;
        for (int tk = bid * 4 + wave; tk < TH; tk += nb * 4) {
          const int gtok = half * TH + tk, s = gtok & (SEQ - 1), bl = tk >> 12;
          const bf16_t* prow = Pm + (size_t)tk * PLD;
          {
            const uint2 cu = *(const uint2*)(prow + lane * 4);
            float f[4] = {bflo(cu.x), bfhi(cu.x), bflo(cu.y), bfhi(cu.y)};
            float ss = wave_sum(f[0] * f[0] + f[1] * f[1] + f[2] * f[2] + f[3] * f[3]);
            const float rs = rsqrtf(ss * (1.f / 256.f) + 1e-6f);
            const float4 g4 = *(const float4*)(qn + lane * 4);
            uint2 o; o.x = pack2(f[0] * rs * g4.x, f[1] * rs * g4.y); o.y = pack2(f[2] * rs * g4.z, f[3] * rs * g4.w);
            *(uint2*)(Cqn + (size_t)tk * 256 + lane * 4) = o;
          }
          {
            const unsigned cu = *(const unsigned*)(prow + 256 + lane * 2);
            const float f0 = bflo(cu), f1 = bfhi(cu);
            const float ss = wave_sum(f0 * f0 + f1 * f1);
            const float rs = rsqrtf(ss * (1.f / 128.f) + 1e-6f);
            const float v0 = f0 * rs * kvn[lane * 2], v1 = f1 * rs * kvn[lane * 2 + 1];
            const bf16_t b0 = f2bf(v0), b1 = f2bf(v1);
            *(unsigned*)(KVlat + (size_t)tk * 192 + lane * 2) = (unsigned)b0 | ((unsigned)b1 << 16);
            VTm[((size_t)bl * 128 + lane * 2) * SEQ + s] = b0;
            VTm[((size_t)bl * 128 + lane * 2 + 1) * SEQ + s] = b1;
          }
          if (lane < 32) {
            const float t1 = bf2f(prow[384 + lane]), t2 = bf2f(prow[384 + 32 + lane]);
            const float posf = (float)p.pos[gtok];
            const float invf = exp2f(-(float)lane * (13.287712379549449f / 32.f));
            const float ang = posf * invf;
            const float cs = cosf(ang), sn = sinf(ang);
            KVlat[(size_t)tk * 192 + 128 + lane] = f2bf(t1 * cs - t2 * sn);
            KVlat[(size_t)tk * 192 + 160 + lane] = f2bf(t1 * sn + t2 * cs);
            CosT[tk * 32 + lane] = cs; SinT[tk * 32 + lane] = sn;
          }
#pragma unroll
          for (int jj = 0; jj < 7; ++jj) {
            const int col = (jj * 64 + lane) * 4;
            const uint2 cu = *(const uint2*)(prow + PC_RW + col);
            uint2 pu = uint2{0u, 0u};
            if (s > 0) pu = *(const uint2*)(prow - PLD + PC_RW + col);
            const float4 m4 = *(const float4*)(mu + col);
            const float cv[4] = {bflo(cu.x), bfhi(cu.x), bflo(cu.y), bfhi(cu.y)};
            const float pv[4] = {bflo(pu.x), bfhi(pu.x), bflo(pu.y), bfhi(pu.y)};
            const float mm[4] = {m4.x, m4.y, m4.z, m4.w};
            float o[4];
#pragma unroll
            for (int e = 0; e < 4; ++e) o[e] = cv[e] + (pv[e] - cv[e]) * mm[e];
            if (col < 1536) {
              uint2 ov; ov.x = pack2(o[0], o[1]); ov.y = pack2(o[2], o[3]);
              *(uint2*)(RKV + (size_t)tk * 1536 + col) = ov;
              if (l == 0 && col >= 1024) *(uint2*)(Vfirst + (size_t)gtok * 512 + (col - 1024)) = ov;
            } else {
              int dc;
              if (col < 1600) { dc = col - 1536; for (int e = 0; e < 4; ++e) o[e] = tanhf(o[e]); }
              else if (col < 1664) { dc = 64 + col - 1600; }
              else { dc = 128 + col - 1664; for (int e = 0; e < 4; ++e) o[e] = sigm(o[e]); }
              uint2 ov; ov.x = pack2(o[0], o[1]); ov.y = pack2(o[2], o[3]);
              *(uint2*)(Alora + (size_t)tk * 256 + dc) = ov;
            }
          }
        }
      }
      GSYNC();
      {
      PHASE_IDS
        const int nq = 64 * 6, nl = 64 * 4;
        const int total = nq + 3 * nl + (l == 1 ? nl : 0);
        for (int u = bid; u < total; u += nb) {
          f32x4 acc[4][4];
          zero_acc<4>(acc);
          if (u < nq) {
            int tm, tn; TILE_MAP(u, 64, tm, tn);
            gemm_acc<128>(Cqn + (size_t)tm * 128 * 256, 256, Wt_q + (size_t)tn * 128 * 256, 256, 256, smem, acc);
            const float qs = 0.07216878364870322f * LOG2E;
            const int lane_ = tid & 63, wave_ = tid >> 6, wm_ = wave_ >> 1, wn_ = wave_ & 1, l16_ = lane_ & 15, quad_ = lane_ >> 4;
            const int gc = tn * 128 + wn_ * 64;
            const bool is_rope = (gc % 192) == 128;
#pragma unroll
            for (int i = 0; i < 4; ++i) {
              const int row = tm * 128 + wm_ * 64 + i * 16 + l16_;
              if (is_rope) {
#pragma unroll
                for (int j = 0; j < 2; ++j) {
                  const int fi = j * 16 + quad_ * 4;
                  const float4 cs = *(const float4*)(CosT + row * 32 + fi), sn = *(const float4*)(SinT + row * 32 + fi);
                  const float c4[4] = {cs.x, cs.y, cs.z, cs.w}, s4[4] = {sn.x, sn.y, sn.z, sn.w};
#pragma unroll
                  for (int r = 0; r < 4; ++r) {
                    const float t1 = acc[i][j][r], t2 = acc[i][j + 2][r];
                    acc[i][j][r] = t1 * c4[r] - t2 * s4[r]; acc[i][j + 2][r] = t1 * s4[r] + t2 * c4[r];
                  }
                }
              }
#pragma unroll
              for (int j = 0; j < 4; ++j) *(uint2*)(Qp + (size_t)row * 768 + gc + j * 16 + quad_ * 4) = pack4(acc[i][j] * qs);
            }
          } else if (u < nq + 3 * nl) {
            const int v = u - nq, which = v / nl, w2 = v % nl, tn = w2 % 4, tm = w2 / 4;
            if (which == 0) {
              gemm_acc<128>(Alora + (size_t)tm * 128 * 256, 256, Wt_wup + (size_t)tn * 128 * 64, 64, 64, smem, acc);
              const float* w0 = p.in[22] + l * 512;
              EPI4_FOR(128) {
                const int row = tm * 128 + EPI_ROW, n = tn * 128 + EPI4_COL(128);
                const float4 b4 = *(const float4*)(w0 + n);
                *(uint2*)(Pm + (size_t)row * PLD + PC_RW + n) = pack4(acc[i][j] + f32x4{b4.x, b4.y, b4.z, b4.w});
              }
            } else if (which == 1) {
              gemm_acc<128>(Alora + (size_t)tm * 128 * 256 + 64, 256, Wt_aup + (size_t)tn * 128 * 64, 64, 64, smem, acc);
              const float* a0 = p.in[24] + l * 512;
              EPI4_FOR(128) {
                const int row = tm * 128 + EPI_ROW, n = tn * 128 + EPI4_COL(128);
                const float4 b4 = *(const float4*)(a0 + n);
                f32x4 v = acc[i][j] + f32x4{b4.x, b4.y, b4.z, b4.w};
#pragma unroll
                for (int r = 0; r < 4; ++r) v[r] = sigm(v[r]);
                *(uint2*)(Pm + (size_t)row * PLD + PC_RW + 512 + n) = pack4(v);
              }
            } else {
              gemm_acc<128>(Alora + (size_t)tm * 128 * 256 + 128, 256, Wt_gup + (size_t)tn * 128 * 128, 128, 128, smem, acc);
              EPI4_FOR(128) {
                const int row = tm * 128 + EPI_ROW, n = tn * 128 + EPI4_COL(128);
                *(uint2*)(Pm + (size_t)row * PLD + PC_RW + 1024 + n) = pack4(acc[i][j]);
              }
            }
          } else {
            const int w2 = u - nq - 3 * nl, tn = w2 % 4, tm = w2 / 4;
            gemm_acc<128>(Hh + (size_t)tm * 128 * 1024, 1024, Wt_v + (size_t)tn * 128 * 1024, 1024, 1024, smem, acc);
            const float* vb = p.in[34];
            EPI4_FOR(128) {
              const int row = tm * 128 + EPI_ROW, n = tn * 128 + EPI4_COL(128);
              const float4 b4 = *(const float4*)(vb + n);
              const f32x4 lg = acc[i][j] + f32x4{b4.x, b4.y, b4.z, b4.w};
              const f32x4 vc = unpack4(*(const uint2*)(RKV + (size_t)row * 1536 + 1024 + n));
              const f32x4 vf = unpack4(*(const uint2*)(Vfirst + ((size_t)half * TH + row) * 512 + n));
              f32x4 o;
#pragma unroll
              for (int r = 0; r < 4; ++r) o[r] = vc[r] + (vf[r] - vc[r]) * sigm(lg[r]);
              *(uint2*)(RKV + (size_t)row * 1536 + 1024 + n) = pack4(o);
            }
          }
        }
      }
      GSYNC();
      {
        int first, count, step;
        if (nb == 512) {
          if (bid < 144) { first = bid; count = 1; step = 0; }
          else {
            int pi = -1;
            if (bid < 256) pi = bid - 144; else if (bid >= 400 && bid < 416) pi = 112 + (bid - 400);
            first = 144 + pi; count = (pi >= 0) ? 2 : 0; step = 255 - 2 * pi;
          }
        } else { first = bid; step = nb; count = (bid < 400) ? (400 - bid + nb - 1) / nb : 0; }
#pragma unroll 1
        for (int q = 0; q < count; ++q) {
          const int u = first + q * step;
          if (u < 144) {
            __builtin_amdgcn_s_setprio(3);
            if (u < 64) rwkv_scan_unit(p, l, u, smem);
            else if (u < 128) hgrn_scan_unit(p, l, u - 64, smem);
            else s5_scan_unit(p, l, u - 128, smem);
            __builtin_amdgcn_s_setprio(0);
          } else {
            const int it = u - 144, qt = 31 - (it >> 3), bl = (it >> 2) & 1, hh = it & 3;
            attn_item_pf<192, true>(Qp + (size_t)bl * SEQ * 768 + hh * 192, 768, KVlat + (size_t)bl * SEQ * 192, 192,
                                    VTm + (size_t)bl * 128 * SEQ, SEQ, (qt * 128 + 128) / 64, qt * 128,
                                    Pm + (size_t)bl * SEQ * PLD + hh * 128, PLD, smem);
          }
        }
      }
      GSYNC();
      {
      PHASE_IDS
        const int nglu = 64 * 4;
        for (int u = bid; u < nglu; u += nb) {
          int tm, tn; TILE_MAP(u, 64, tm, tn);
          f32x4 acc[4][4];
          zero_acc<4>(acc);
          gemm_acc<128>(Zs5 + (size_t)tm * 128 * 512, 512, Wt_glu + (size_t)tn * 128 * 512, 512, 512, smem, acc);
          const float* bg = p.in[20] + l * 512;
          EPI4_FOR(128) {
            const int row = tm * 128 + EPI_ROW, n = tn * 128 + EPI4_COL(128);
            const f32x4 z = unpack4(*(const uint2*)(Zs5 + (size_t)row * 512 + n));
            const float4 b4 = *(const float4*)(bg + n);
            const f32x4 lg = acc[i][j] + f32x4{b4.x, b4.y, b4.z, b4.w};
            f32x4 o;
#pragma unroll
            for (int r = 0; r < 4; ++r) o[r] = z[r] * sigm(lg[r]);
            *(uint2*)(Pm + (size_t)row * PLD + PC_S5 + n) = pack4(o);
          }
        }
        const float* k_a = p.in[28] + l * 512;
        const float* r_k = p.in[29] + l * 512;
        const float* ln_w = p.in[30] + l * 512;
        const float* ln_b = p.in[31] + l * 512;
        const float* o_norm = p.in[10] + l * 512;
        for (int tk = bid * 4 + wave; tk < TH; tk += nb * 4) {
          const int c0 = lane * 8;
          {
            const float4 y0 = *(const float4*)(Yrw + (size_t)tk * 512 + c0), y1 = *(const float4*)(Yrw + (size_t)tk * 512 + c0 + 4);
            const float y[8] = {y0.x, y0.y, y0.z, y0.w, y1.x, y1.y, y1.z, y1.w};
            const uint4 ru = *(const uint4*)(RKV + (size_t)tk * 1536 + c0);
            const uint4 ku = *(const uint4*)(RKV + (size_t)tk * 1536 + 512 + c0);
            const uint4 vu = *(const uint4*)(RKV + (size_t)tk * 1536 + 1024 + c0);
            const uint4 au = *(const uint4*)(Pm + (size_t)tk * PLD + PC_RW + 512 + c0);
            const uint4 gu = *(const uint4*)(Pm + (size_t)tk * PLD + PC_RW + 1024 + c0);
            const unsigned ra[4] = {ru.x, ru.y, ru.z, ru.w}, ka[4] = {ku.x, ku.y, ku.z, ku.w}, va[4] = {vu.x, vu.y, vu.z, vu.w};
            const unsigned aa[4] = {au.x, au.y, au.z, au.w}, ga[4] = {gu.x, gu.y, gu.z, gu.w};
            float rr[8], kh[8], vv[8], gg[8];
            float sm1 = 0.f, bsum = 0.f;
#pragma unroll
            for (int e = 0; e < 8; ++e) {
              const unsigned sh = (e & 1);
              rr[e] = sh ? bfhi(ra[e >> 1]) : bflo(ra[e >> 1]);
              const float kx = sh ? bfhi(ka[e >> 1]) : bflo(ka[e >> 1]);
              vv[e] = sh ? bfhi(va[e >> 1]) : bflo(va[e >> 1]);
              const float a = sh ? bfhi(aa[e >> 1]) : bflo(aa[e >> 1]);
              gg[e] = sh ? bfhi(ga[e >> 1]) : bflo(ga[e >> 1]);
              kh[e] = kx * (1.f + (a - 1.f) * k_a[c0 + e]);
              sm1 += y[e];
              bsum += rr[e] * kh[e] * r_k[c0 + e];
            }
            sm1 = red8(sm1); bsum = red8(bsum);
            const float mean = sm1 * (1.f / 64.f);
            float vs = 0.f;
#pragma unroll
            for (int e = 0; e < 8; ++e) { const float d = y[e] - mean; vs += d * d; }
            vs = red8(vs);
            const float rstd = rsqrtf(vs * (1.f / 64.f) + 64e-5f);
            float o[8];
#pragma unroll
            for (int e = 0; e < 8; ++e) o[e] = (((y[e] - mean) * rstd) * ln_w[c0 + e] + ln_b[c0 + e] + bsum * vv[e]) * gg[e];
            uint4 ov; ov.x = pack2(o[0], o[1]); ov.y = pack2(o[2], o[3]); ov.z = pack2(o[4], o[5]); ov.w = pack2(o[6], o[7]);
            *(uint4*)(RKV + (size_t)tk * 1536 + c0) = ov;
          }
          {
            bf16_t* op = Pm + (size_t)tk * PLD + PC_HG + 1024 + c0;
            const uint4 ou = *(const uint4*)((const bf16_t*)(ws + R_OHG) + (size_t)tk * 512 + c0);
            const uint4 gu = *(const uint4*)(Pm + (size_t)tk * PLD + PC_HG + 1536 + c0);
            const unsigned oa[4] = {ou.x, ou.y, ou.z, ou.w}, ga[4] = {gu.x, gu.y, gu.z, gu.w};
            float o[8], ss = 0.f;
#pragma unroll
            for (int e = 0; e < 4; ++e) { o[2 * e] = bflo(oa[e]); o[2 * e + 1] = bfhi(oa[e]); }
#pragma unroll
            for (int e = 0; e < 8; ++e) ss += o[e] * o[e];
            ss = red16(ss);
            const float rs = rsqrtf(ss * (1.f / 128.f) + 1e-6f);
            float r8[8];
#pragma unroll
            for (int e = 0; e < 8; ++e) {
              const float gte = (e & 1) ? bfhi(ga[e >> 1]) : bflo(ga[e >> 1]);
              r8[e] = o[e] * rs * o_norm[c0 + e] * sigm(gte);
            }
            uint4 ov; ov.x = pack2(r8[0], r8[1]); ov.y = pack2(r8[2], r8[3]); ov.z = pack2(r8[4], r8[5]); ov.w = pack2(r8[6], r8[7]);
            *(uint4*)op = ov;
          }
        }
      }
      GSYNC();
      {
        int par6 = 0;
        auto brA = [&](int m, int tm_, int& lda_) -> const bf16_t* {
          const bf16_t* Ao;
          if (m == 0) { Ao = Pm; lda_ = PLD; }
          else if (m == 1) { Ao = Pm + PC_HG + 1024; lda_ = PLD; }
          else if (m == 2) { Ao = Pm + PC_S5; lda_ = PLD; }
          else { Ao = RKV; lda_ = 1536; }
          return Ao + (size_t)tm_ * 128 * lda_;
        };
        for (int u = bid; u < 64 * 16; u += nb) {
          int tm, tn; TILE_MAP(u, 64, tm, tn);
          const bool has_next = (u + nb < 64 * 16);
          int tmn = tm, tnn = tn; if (has_next) TILE_MAP(u + nb, 64, tmn, tnn);
          f32x4 yacc[4][2];
          zero_acc<2>(yacc);
#pragma unroll 1
          for (int m = 0; m < 4; ++m) {
            f32x4 ag[4][2];
            zero_acc<2>(ag);
            int ldo; const bf16_t* Ao = brA(m, tm, ldo);
            const bf16_t* Bo = Wt_br + ((size_t)m * 1024 + tn * 64) * 512;
            gemm_acc<64>(Hh + (size_t)tm * 128 * 1024, 1024, Wt_in + (size_t)(GATE_OFF + m * 1024 + tn * 64) * 1024, 1024, 1024, smem, ag,
                         Ao, ldo, Bo, 512, !(m == 0 && u == bid), par6);
#pragma unroll
            for (int i = 0; i < 4; ++i)
#pragma unroll
              for (int j = 0; j < 2; ++j)
#pragma unroll
                for (int r = 0; r < 4; ++r) ag[i][j][r] = sigm(ag[i][j][r]);
            f32x4 ao[4][2];
            zero_acc<2>(ao);
            const int mn = (m < 3) ? m + 1 : 0;
            const int tmx = (m < 3) ? tm : tmn, tnx = (m < 3) ? tn : tnn;
            const bool self = (m == 3) && !has_next;
            const bf16_t* An = self ? Ao : Hh + (size_t)tmx * 128 * 1024;
            const bf16_t* Bn = self ? Bo : Wt_in + (size_t)(GATE_OFF + mn * 1024 + tnx * 64) * 1024;
            gemm_acc<64>(Ao, ldo, Bo, 512, 512, smem, ao, An, self ? ldo : 1024, Bn, self ? 512 : 1024, true, par6);
#pragma unroll
            for (int i = 0; i < 4; ++i)
#pragma unroll
              for (int j = 0; j < 2; ++j)
#pragma unroll
                for (int r = 0; r < 4; ++r) yacc[i][j][r] += ag[i][j][r] * ao[i][j][r];
          }
          {
            f32x4 (&acc)[4][2] = yacc;
            EPI4_FOR(64) {
              const int row = tm * 128 + EPI_ROW, n = tn * 64 + EPI4_COL(64);
              *(uint2*)(Ybr + (size_t)row * 1024 + n) = pack4(acc[i][j]);
            }
          }
        }
      }
      GSYNC();
      {
        int par = 0;
        for (int u = bid; u < 64 * 8; u += nb) {
          int tm, tn; TILE_MAP(u, 64, tm, tn);
          int tmn = tm, tnn = tn; if (u + nb < 64 * 8) TILE_MAP(u + nb, 64, tmn, tnn);
          f32x4 acc[4][4];
          zero_acc<4>(acc);
          gemm_acc<128>(Ybr + (size_t)tm * 128 * 1024, 1024, Wt_out + (size_t)tn * 128 * 1024, 1024, 1024, smem, acc,
                        Ybr + (size_t)tmn * 128 * 1024, 1024, Wt_out + (size_t)tnn * 128 * 1024, 1024, u != bid, par);
          EPI4_FOR(128) {
            const int row = half * TH + tm * 128 + EPI_ROW, n = tn * 128 + EPI4_COL(128);
            float4* xp = (float4*)(X + (size_t)row * 1024 + n);
            float4 xv = *xp; xv.x += acc[i][j][0]; xv.y += acc[i][j][1]; xv.z += acc[i][j][2]; xv.w += acc[i][j][3];
            *xp = xv;
          }
        }
      }
      GSYNC();
    }

    {
      transpose_all(p.in[42] + (size_t)l * 1024 * 1024, 1024, 1024, 1024, Wt_xq, bid, nb, smem);
      transpose_all(p.in[44] + (size_t)l * 1024 * 1024, 1024, 1024, 1024, Wt_xo, bid, nb, smem);
      transpose_all(p.in[46] + (size_t)l * 1024 * 5632, 5632, 1024, 5632, Wt_gu, bid, nb, smem);
      transpose_all(p.in[49] + (size_t)l * 2816 * 1024, 1024, 2816, 1024, Wt_down, bid, nb, smem);
      rmsnorm_rows(X, p.in[40] + l * 1024, Hb, nullptr, T_ALL, bid, nb);
    }
    GSYNC();
    {
      const float qs = 0.0625f * LOG2E;
      int par = 0;
      for (int u = bid; u < 128 * 8; u += nb) {
        int tm, tn; TILE_MAP(u, 128, tm, tn);
        int tmn = tm, tnn = tn; if (u + nb < 128 * 8) TILE_MAP(u + nb, 128, tmn, tnn);
        f32x4 acc[4][4];
        zero_acc<4>(acc);
        gemm_acc<128>(Hb + (size_t)tm * 128 * 1024, 1024, Wt_xq + (size_t)tn * 128 * 1024, 1024, 1024, smem, acc,
                      Hb + (size_t)tmn * 128 * 1024, 1024, Wt_xq + (size_t)tnn * 128 * 1024, 1024, u != bid, par);
        EPI4_FOR(128) {
          const int row = tm * 128 + EPI_ROW, n = tn * 128 + EPI4_COL(128);
          *(uint2*)(Qx + (size_t)row * 1024 + n) = pack4(acc[i][j] * qs);
        }
      }
    }
    GSYNC();
    {
      for (int u = bid; u < 1024; u += nb) {
        const int dvh = u & 1, hh = (u >> 1) & 3, qt = (u >> 3) & 31, b = u >> 8;
        attn_item<256, false>(Qx + (size_t)b * SEQ * 1024 + hh * 256, 1024, Kx + (size_t)(b * 4 + hh) * 65536, 256,
                              VxT + (size_t)(b * 4 + hh) * 65536 + (size_t)dvh * 128 * 256, 256, 4, qt * 128,
                              Ox + (size_t)b * SEQ * 1024 + hh * 256 + dvh * 128, 1024, smem);
      }
    }
    GSYNC();
    {
      int par = 0;
      for (int u = bid; u < 128 * 8; u += nb) {
        int tm, tn; TILE_MAP(u, 128, tm, tn);
        int tmn = tm, tnn = tn; if (u + nb < 128 * 8) TILE_MAP(u + nb, 128, tmn, tnn);
        f32x4 acc[4][4];
        zero_acc<4>(acc);
        gemm_acc<128>(Ox + (size_t)tm * 128 * 1024, 1024, Wt_xo + (size_t)tn * 128 * 1024, 1024, 1024, smem, acc,
                      Ox + (size_t)tmn * 128 * 1024, 1024, Wt_xo + (size_t)tnn * 128 * 1024, 1024, u != bid, par);
        EPI4_FOR(128) {
          const int row = tm * 128 + EPI_ROW, n = tn * 128 + EPI4_COL(128);
          float4* xp = (float4*)(X + (size_t)row * 1024 + n);
          float4 xv = *xp; xv.x += acc[i][j][0]; xv.y += acc[i][j][1]; xv.z += acc[i][j][2]; xv.w += acc[i][j][3];
          *xp = xv;
        }
      }
    }
    GSYNC();
    rmsnorm_rows(X, p.in[45] + l * 1024, Hb, nullptr, T_ALL, bid, nb);
    GSYNC();
    for (int half = 0; half < 2; ++half) {
      const bf16_t* Hh = Hb + (size_t)half * TH * 1024;
      int par13 = 0;
      for (int u = bid; u < 64 * 44; u += nb) {
        int tm, tn; TILE_MAP(u, 64, tm, tn);
        int tmn = tm, tnn = tn; if (u + nb < 64 * 44) TILE_MAP(u + nb, 64, tmn, tnn);
        f32x4 acc[4][4];
        zero_acc<4>(acc);
        gemm_acc<128>(Hh + (size_t)tm * 128 * 1024, 1024, Wt_gu + (size_t)tn * 128 * 1024, 1024, 1024, smem, acc,
                      Hh + (size_t)tmn * 128 * 1024, 1024, Wt_gu + (size_t)tnn * 128 * 1024, 1024, u != bid, par13);
        EPI4_FOR(128) {
          const int row = tm * 128 + EPI_ROW, n = tn * 128 + EPI4_COL(128);
          *(uint2*)(GU + (size_t)row * 5632 + n) = pack4(acc[i][j]);
        }
      }
      GSYNC();
      {
      PHASE_IDS
        const float* cw = p.in[47] + (size_t)l * 3 * D_FF;
        const float* cb = p.in[48] + (size_t)l * D_FF;
        for (int e = bid * 256 + tid; e < TH * 352; e += nb * 256) {
          const int tk = e / 352, c0 = (e % 352) * 8;
          const int s = tk & (SEQ - 1);
          const bf16_t* gp = GU + (size_t)tk * 5632 + c0;
          const uint4 g2 = *(const uint4*)gp;
          uint4 g1 = uint4{0, 0, 0, 0}, g0 = uint4{0, 0, 0, 0};
          if (s >= 1) g1 = *(const uint4*)(gp - 5632);
          if (s >= 2) g0 = *(const uint4*)(gp - 2 * 5632);
          const uint4 uu = *(const uint4*)(gp + D_FF);
          const unsigned a2[4] = {g2.x, g2.y, g2.z, g2.w}, a1[4] = {g1.x, g1.y, g1.z, g1.w}, a0[4] = {g0.x, g0.y, g0.z, g0.w};
          const unsigned au[4] = {uu.x, uu.y, uu.z, uu.w};
          float o[8];
#pragma unroll
          for (int q = 0; q < 8; ++q) {
            const bool hi = q & 1;
            const float x2 = hi ? bfhi(a2[q >> 1]) : bflo(a2[q >> 1]);
            const float x1 = hi ? bfhi(a1[q >> 1]) : bflo(a1[q >> 1]);
            const float x0 = hi ? bfhi(a0[q >> 1]) : bflo(a0[q >> 1]);
            const float up = hi ? bfhi(au[q >> 1]) : bflo(au[q >> 1]);
            const int c = c0 + q;
            const float gv = cw[c] * x0 + cw[D_FF + c] * x1 + cw[2 * D_FF + c] * x2 + cb[c];
            o[q] = gv * sigm(gv) * up;
          }
          uint4 ov; ov.x = pack2(o[0], o[1]); ov.y = pack2(o[2], o[3]); ov.z = pack2(o[4], o[5]); ov.w = pack2(o[6], o[7]);
          *(uint4*)(GU + (size_t)tk * 5632 + D_FF + c0) = ov;
        }
      }
      GSYNC();
      int par15 = 0;
      for (int u = bid; u < 64 * 8; u += nb) {
        int tm, tn; TILE_MAP(u, 64, tm, tn);
        int tmn = tm, tnn = tn; if (u + nb < 64 * 8) TILE_MAP(u + nb, 64, tmn, tnn);
        f32x4 acc[4][4];
        zero_acc<4>(acc);
        gemm_acc<128>(GU + (size_t)tm * 128 * 5632 + D_FF, 5632, Wt_down + (size_t)tn * 128 * 2816, 2816, 2816, smem, acc,
                      GU + (size_t)tmn * 128 * 5632 + D_FF, 5632, Wt_down + (size_t)tnn * 128 * 2816, 2816, u != bid, par15);
        EPI4_FOR(128) {
          const int row = half * TH + tm * 128 + EPI_ROW, n = tn * 128 + EPI4_COL(128);
          float4* xp = (float4*)(X + (size_t)row * 1024 + n);
          float4 xv = *xp; xv.x += acc[i][j][0]; xv.y += acc[i][j][1]; xv.z += acc[i][j][2]; xv.w += acc[i][j][3];
          *xp = xv;
        }
      }
      GSYNC();
    }
  }

  {
      PHASE_IDS
    const float* g = p.in[50];
    for (int r = bid * 4 + wave; r < T_ALL; r += nb * 4) {
      float4* xr = (float4*)(X + (size_t)r * 1024);
      float4 v[4]; float ss = 0.f;
#pragma unroll
      for (int i = 0; i < 4; ++i) { v[i] = xr[lane + 64 * i]; ss += v[i].x * v[i].x + v[i].y * v[i].y + v[i].z * v[i].z + v[i].w * v[i].w; }
      ss = wave_sum(ss);
      const float rs = rsqrtf(ss * (1.f / 1024.f) + 1e-6f);
#pragma unroll
      for (int i = 0; i < 4; ++i) {
        const float4 gg = ((const float4*)g)[lane + 64 * i];
        xr[lane + 64 * i] = float4{v[i].x * rs * gg.x, v[i].y * rs * gg.y, v[i].z * rs * gg.z, v[i].w * rs * gg.w};
      }
    }
  }
}

extern "C" void kernel_launch(void* const* d_in, const int* in_sizes, int n_in, void* d_out, int out_size, void* d_ws, size_t ws_size,
                              hipStream_t stream) {
  static int grid_blocks = 0;
  if (!grid_blocks) {
    int dev = 0, cus = 0, per_cu = 0;
    hipGetDevice(&dev);
    hipDeviceGetAttribute(&cus, hipDeviceAttributeMultiprocessorCount, dev);
    hipOccupancyMaxActiveBlocksPerMultiprocessor(&per_cu, mega_kernel, 256, 0);
    if (per_cu > 2) per_cu = 2;
    if (per_cu < 1) per_cu = 1;
    grid_blocks = cus * per_cu;
  }
  if (ws_size < WS_NEED) fprintf(stderr, "workspace too small: %zu < %zu\n", ws_size, (size_t)WS_NEED);
  Params p{};
  for (int i = 0; i < 51; ++i) p.in[i] = (const float*)d_in[i];
  p.pos = (const int*)d_in[2];
  p.out = (float*)d_out;
  p.ws = (char*)d_ws;
  hipMemsetAsync((char*)d_ws + OFF_BAR, 0, 16384, stream);
  void* args[] = {&p};
  hipError_t e = hipLaunchCooperativeKernel((void*)mega_kernel, dim3(grid_blocks), dim3(256), args, 0, stream);
  if (e != hipSuccess) fprintf(stderr, "cooperative launch failed: %s (grid %d)\n", hipGetErrorString(e), grid_blocks);
}
```

```cpp
#include <hip/hip_runtime.h>
#include <hip/hip_cooperative_groups.h>
#include <cstdio>
#include <cstdint>
namespace cg = cooperative_groups;

typedef unsigned short bf16_t;
using bf16x8 = __attribute__((ext_vector_type(8))) short;
using s16x4 = __attribute__((ext_vector_type(4))) short;
using f32x4 = __attribute__((ext_vector_type(4))) float;
using f32x16 = __attribute__((ext_vector_type(16))) float;
using u32x4 = __attribute__((ext_vector_type(4))) unsigned;
#define DI __device__ __forceinline__

constexpr int T_ALL = 16384, SEQ = 4096, DM = 1024, TH = 8192;
constexpr int P_IN = 8896, GATE_OFF = 4800;
constexpr int PLD = 4864;
constexpr int PC_HG = 512, PC_S5 = 2560, PC_RW = 3072;
constexpr int D_FF = 2816;

constexpr size_t al256(size_t x) { return (x + 255) & ~(size_t)255; }
constexpr size_t OFF_WIN = 0;
constexpr size_t OFF_WQ = OFF_WIN + al256((size_t)P_IN * 1024 * 2);
constexpr size_t OFF_WBR = OFF_WQ + al256((size_t)768 * 256 * 2);
constexpr size_t OFF_WOUT = OFF_WBR + al256((size_t)4 * 1024 * 512 * 2);
constexpr size_t OFF_WGLU = OFF_WOUT + al256((size_t)1024 * 1024 * 2);
constexpr size_t OFF_WWUP = OFF_WGLU + al256((size_t)512 * 512 * 2);
constexpr size_t OFF_WAUP = OFF_WWUP + al256((size_t)512 * 64 * 2);
constexpr size_t OFF_WGUP = OFF_WAUP + al256((size_t)512 * 64 * 2);
constexpr size_t OFF_WV = OFF_WGUP + al256((size_t)512 * 128 * 2);
constexpr size_t OFF_WXKV = OFF_WV + al256((size_t)512 * 1024 * 2);
constexpr size_t OFF_S5AB = OFF_WXKV + al256((size_t)2048 * 1024 * 2);
constexpr size_t OFF_S5BB = OFF_S5AB + al256((size_t)32 * 64 * 2 * 4);
constexpr size_t OFF_H = OFF_S5BB + al256((size_t)32 * 64 * 32 * 4);
constexpr size_t OFF_VFIRST = OFF_H + al256((size_t)T_ALL * 1024 * 2);
constexpr size_t OFF_KX = OFF_VFIRST + al256((size_t)T_ALL * 512 * 2);
constexpr size_t OFF_VXT = OFF_KX + al256((size_t)16 * 256 * 256 * 2);
constexpr size_t OFF_HM = OFF_VXT + al256((size_t)16 * 256 * 256 * 2);
constexpr size_t OFF_COS = OFF_HM + al256((size_t)1024 * 1024 * 2);
constexpr size_t OFF_SIN = OFF_COS + al256((size_t)TH * 32 * 4);
constexpr size_t OFF_BAR = OFF_SIN + al256((size_t)TH * 32 * 4);
constexpr size_t OFF_REG = OFF_BAR + 16384;
constexpr size_t R_P = OFF_REG;
constexpr size_t R_CQN = R_P + al256((size_t)TH * PLD * 2);
constexpr size_t R_QP = R_CQN + (size_t)TH * 256 * 2;
constexpr size_t R_KVLAT = R_QP + al256((size_t)TH * 768 * 2);
constexpr size_t R_VT = R_KVLAT + al256((size_t)TH * 192 * 2);
constexpr size_t R_RKV = R_VT + al256((size_t)2 * 128 * 4096 * 2);
constexpr size_t R_ALORA = R_RKV + al256((size_t)TH * 1536 * 2);
constexpr size_t R_YRW = R_ALORA + al256((size_t)TH * 256 * 2);
constexpr size_t R_ZS5 = R_YRW + al256((size_t)TH * 512 * 4);
constexpr size_t R_OHG = R_ZS5 + al256((size_t)TH * 512 * 2);
constexpr size_t R_END1 = R_OHG + al256((size_t)TH * 512 * 2);
constexpr size_t R_YBR = R_CQN;
constexpr size_t R_WXQ = OFF_REG;
constexpr size_t R_WXO = R_WXQ + al256((size_t)1024 * 1024 * 2);
constexpr size_t R_WGU = R_WXO + al256((size_t)1024 * 1024 * 2);
constexpr size_t R_WDOWN = R_WGU + al256((size_t)5632 * 1024 * 2);
constexpr size_t R_QX = R_WDOWN + al256((size_t)1024 * 2816 * 2);
constexpr size_t R_OX = R_QX + al256((size_t)T_ALL * 1024 * 2);
constexpr size_t R_GU = R_QX;
constexpr size_t R_END2 = R_GU + al256((size_t)TH * 5632 * 2);
constexpr size_t WS_NEED = (R_END1 > R_END2 ? R_END1 : R_END2);

constexpr int SMEM_BYTES = 73728;

struct Params {
  const float* in[51];
  const int* pos;
  float* out;
  char* ws;
};

DI bf16_t f2bf(float x) { unsigned u = __float_as_uint(x); u += 0x7fffu + ((u >> 16) & 1u); return (bf16_t)(u >> 16); }
DI float bf2f(bf16_t b) { return __uint_as_float(((unsigned)b) << 16); }
DI unsigned pack2(float a, float b) { return (unsigned)f2bf(a) | ((unsigned)f2bf(b) << 16); }
DI float bflo(unsigned u) { return __uint_as_float(u << 16); }
DI float bfhi(unsigned u) { return __uint_as_float(u & 0xffff0000u); }
DI float sigm(float x) { return __builtin_amdgcn_rcpf(1.f + __expf(-x)); }
template <int CTRL> DI float dppf(float v) {
  return __builtin_bit_cast(float, __builtin_amdgcn_update_dpp(0, __builtin_bit_cast(int, v), CTRL, 0xf, 0xf, false));
}
DI float red8(float v) { v += dppf<0xB1>(v); v += dppf<0x4E>(v); v += dppf<0x141>(v); return v; }
DI float red16(float v) { v = red8(v); v += dppf<0x140>(v); return v; }
DI int TID() { int t = threadIdx.x; asm volatile("" : "+v"(t)); return t; }
#define PHASE_IDS const int tid = TID(); const int lane = tid & 63, wave = tid >> 6; (void)lane; (void)wave;
DI const bf16_t* uniform_ptr(const bf16_t* p) {
  const unsigned long long v = (unsigned long long)p;
  const unsigned lo = __builtin_amdgcn_readfirstlane((unsigned)v), hi = __builtin_amdgcn_readfirstlane((unsigned)(v >> 32));
  return (const bf16_t*)(((unsigned long long)hi << 32) | lo);
}
DI float wave_sum(float v) { for (int o = 32; o > 0; o >>= 1) v += __shfl_xor(v, o); return v; }


#define XB_TMO      128
#define XB_XCNT(j)  (256  + 64 * (j))
#define XB_XSUB(j)  (1280 + 64 * (j))
#define XB_XGEN(j)  (2304 + 64 * (j))
#define XB_TOP      3328
#define XB_TOPGEN   3392
#define XCD_BAR_WORDS 3456
#define XB_SPIN_CAP (1u << 22)
#define LAS __attribute__((address_space(3)))
DI unsigned xb_ld(unsigned* p) { return __hip_atomic_load(p, __ATOMIC_RELAXED, __HIP_MEMORY_SCOPE_AGENT); }
DI unsigned xb_add(unsigned* p, unsigned v) { return __hip_atomic_fetch_add(p, v, __ATOMIC_RELAXED, __HIP_MEMORY_SCOPE_AGENT); }
DI unsigned xb_xcc_id() { return (unsigned)__builtin_amdgcn_s_getreg((3 << 11) | 20) & 0xFu; }
#define XB_SPIN(cond, bar) do { unsigned _sp = 0; while (cond) { __builtin_amdgcn_s_sleep(1); \
    if ((++_sp & 255u) == 0u) { if (xb_ld(&(bar)[XB_TMO])) break; if (_sp > XB_SPIN_CAP) { atomicAdd(&(bar)[XB_TMO], 1u); break; } } } } while (0)
struct XcdBarrier { unsigned* bar; unsigned x; volatile LAS unsigned* st; };
DI XcdBarrier xcd_barrier_post(unsigned* bar, volatile LAS unsigned* st) {
  XcdBarrier b; b.bar = bar; b.x = xb_xcc_id(); b.st = st;
  if (threadIdx.x == 0) (void)xb_add(&bar[XB_XCNT(b.x)], 1u);
  return b;
}
DI void xcd_barrier_complete(unsigned* bar, unsigned x, unsigned& nloc, unsigned& nx) {
  const unsigned G = gridDim.x * gridDim.y * gridDim.z;
  unsigned sum, cnt, mine, sp = 0u;
  for (;;) {
    sum = 0u; cnt = 0u; mine = 0u;
#pragma unroll
    for (unsigned j = 0; j < 16; ++j) { const unsigned c = xb_ld(&bar[XB_XCNT(j)]); sum += c; cnt += (c > 0u) ? 1u : 0u; mine = (j == x) ? c : mine; }
    if (sum == G) break;
    __builtin_amdgcn_s_sleep(1);
    if ((++sp & 255u) == 0u) { if (xb_ld(&bar[XB_TMO])) break; if (sp > XB_SPIN_CAP) { atomicAdd(&bar[XB_TMO], 1u); break; } }
  }
  nloc = mine > 0u ? mine : 1u; nx = cnt > 0u ? cnt : 1u;
}
DI void xcd_barrier(const XcdBarrier& b) {
  asm volatile("s_waitcnt vmcnt(0)" ::: "memory");
  __syncthreads();
  if (threadIdx.x == 0) {
    unsigned* bar = b.bar;
    __builtin_amdgcn_s_waitcnt(0);
    unsigned nloc = b.st[0], nx = b.st[1];
    if (nloc == 0u) { xcd_barrier_complete(bar, b.x, nloc, nx); b.st[0] = nloc; b.st[1] = nx; }
    const unsigned old = xb_add(&bar[XB_XSUB(b.x)], 1u);
    const unsigned gen = old / nloc;
    if (old + 1u == (gen + 1u) * nloc) {
      __builtin_amdgcn_fence(__ATOMIC_RELEASE, "agent");
      asm volatile("s_waitcnt vmcnt(0)" ::: "memory");
      const unsigned og = xb_add(&bar[XB_TOP], 1u);
      const unsigned tg = og / nx;
      if (og + 1u == (tg + 1u) * nx) xb_add(&bar[XB_TOPGEN], 1u);
      else XB_SPIN(xb_ld(&bar[XB_TOPGEN]) == tg, bar);
      __builtin_amdgcn_fence(__ATOMIC_ACQUIRE, "agent");
      xb_add(&bar[XB_XGEN(b.x)], 1u);
      asm volatile("s_waitcnt vmcnt(0)" ::: "memory");
    } else {
      XB_SPIN(xb_ld(&bar[XB_XGEN(b.x)]) == gen, bar);
      __builtin_amdgcn_fence(__ATOMIC_ACQUIRE, "agent");
      asm volatile("s_waitcnt vmcnt(0)" ::: "memory");
    }
  }
  __syncthreads();
}

#define GLOAD16(dst, ptr) asm volatile("global_load_dwordx4 %0, %1, off" : "=v"(dst) : "v"(ptr))
template <int BN>
DI void gemm_acc(const bf16_t* __restrict__ A, int lda, const bf16_t* __restrict__ Bt, int ldb, int K, char* smem,
                 f32x4 (&acc)[4][BN / 32], const bf16_t* __restrict__ An, int ldan, const bf16_t* __restrict__ Bn, int ldbn,
                 bool pre, int& par) {
  constexpr int A_EL = 128 * 72, B_EL = BN * 72, BUF_EL = A_EL + B_EL;
  constexpr int NJ = BN / 32, BCH = BN / 32;
  bf16_t* sm = (bf16_t*)smem;
  const int tid = TID(), lane = tid & 63, wave = tid >> 6;
  const int wm = wave >> 1, wn = wave & 1, l16 = lane & 15, quad = lane >> 4;
  const int crow = tid >> 3, ccol = (tid & 7) * 8;
  u32x4 ra[4], rb[BCH];
  const bf16_t* Ap = A + (size_t)crow * lda + ccol;
  const bf16_t* Bp = Bt + (size_t)crow * ldb + ccol;
  const bf16_t* Apn = An + (size_t)crow * ldan + ccol;
  const bf16_t* Bpn = Bn + (size_t)crow * ldbn + ccol;
  const int nk = K >> 6;
#define GEMM_ISSUE(ap_, sa_, bp_, sb_)                                                            \
  {                                                                                               \
    _Pragma("unroll") for (int i = 0; i < 4; ++i) GLOAD16(ra[i], (ap_) + (size_t)(32 * i) * (sa_));      \
    _Pragma("unroll") for (int i = 0; i < BCH; ++i) GLOAD16(rb[i], (bp_) + (size_t)(32 * i) * (sb_));    \
  }
#define GEMM_LAND(buf_)                                                                           \
  {                                                                                               \
    if constexpr (BCH == 4)                                                                       \
      asm volatile("s_waitcnt vmcnt(0)" : "+v"(ra[0]), "+v"(ra[1]), "+v"(ra[2]), "+v"(ra[3]), "+v"(rb[0]), "+v"(rb[1]), "+v"(rb[2]), "+v"(rb[3])); \
    else                                                                                          \
      asm volatile("s_waitcnt vmcnt(0)" : "+v"(ra[0]), "+v"(ra[1]), "+v"(ra[2]), "+v"(ra[3]), "+v"(rb[0]), "+v"(rb[1])); \
    bf16_t* sa_ = sm + (buf_) * BUF_EL; bf16_t* sb_ = sa_ + A_EL;                                 \
    _Pragma("unroll") for (int i = 0; i < 4; ++i) *(u32x4*)(sa_ + (crow + 32 * i) * 72 + ccol) = ra[i];   \
    _Pragma("unroll") for (int i = 0; i < BCH; ++i) *(u32x4*)(sb_ + (crow + 32 * i) * 72 + ccol) = rb[i]; \
  }
  if (!pre) {
    GEMM_ISSUE(Ap, lda, Bp, ldb);
    GEMM_LAND(par);
    __syncthreads();
  }
  for (int kt = 0; kt < nk; ++kt) {
    {
      const bool inner = (kt + 1 < nk);
      const bf16_t* ap = inner ? Ap + ((kt + 1) << 6) : Apn;
      const bf16_t* bp = inner ? Bp + ((kt + 1) << 6) : Bpn;
      const int sa = inner ? lda : ldan, sb = inner ? ldb : ldbn;
      GEMM_ISSUE(ap, sa, bp, sb);
    }
    __builtin_amdgcn_sched_barrier(0);
    {
      const bf16_t* sa = sm + ((par + kt) & 1) * BUF_EL; const bf16_t* sb = sa + A_EL;
#pragma unroll
      for (int ks = 0; ks < 2; ++ks) {
        bf16x8 a[4], b[NJ];
#pragma unroll
        for (int i = 0; i < 4; ++i) a[i] = *(const bf16x8*)(sa + (wm * 64 + i * 16 + l16) * 72 + ks * 32 + quad * 8);
#pragma unroll
        for (int j = 0; j < NJ; ++j) b[j] = *(const bf16x8*)(sb + (wn * (BN / 2) + j * 16 + l16) * 72 + ks * 32 + quad * 8);
        __builtin_amdgcn_s_setprio(1);
#pragma unroll
        for (int i = 0; i < 4; ++i)
#pragma unroll
          for (int j = 0; j < NJ; ++j) acc[i][j] = __builtin_amdgcn_mfma_f32_16x16x32_bf16(b[j], a[i], acc[i][j], 0, 0, 0);
        __builtin_amdgcn_s_setprio(0);
      }
    }
    __builtin_amdgcn_sched_barrier(0);
    GEMM_LAND((par + kt + 1) & 1);
    __syncthreads();
  }
  par = (par + nk) & 1;
#undef GEMM_ISSUE
#undef GEMM_LAND
}
template <int BN>
DI void gemm_acc(const bf16_t* __restrict__ A, int lda, const bf16_t* __restrict__ Bt, int ldb, int K, char* smem,
                 f32x4 (&acc)[4][BN / 32]) {
  int par = 0;
  gemm_acc<BN>(A, lda, Bt, ldb, K, smem, acc, A, lda, Bt, ldb, false, par);
}
template <int NJ> DI void zero_acc(f32x4 (&acc)[4][NJ]) {
#pragma unroll
  for (int i = 0; i < 4; ++i)
#pragma unroll
    for (int j = 0; j < NJ; ++j) acc[i][j] = f32x4{0.f, 0.f, 0.f, 0.f};
}
#define EPI_FOR(BN_)                                                                         \
  const int _t = TID(); const int _lane = _t & 63, _wave = _t >> 6;                              \
  const int _wm = _wave >> 1, _wn = _wave & 1, _l16 = _lane & 15, _quad = _lane >> 4;        \
  _Pragma("unroll") for (int i = 0; i < 4; ++i)                                              \
  _Pragma("unroll") for (int j = 0; j < (BN_) / 32; ++j)                                     \
  _Pragma("unroll") for (int r = 0; r < 4; ++r)
#define EPI_ROW (_wm * 64 + i * 16 + _l16)
#define EPI_COL(BN_) (_wn * ((BN_) / 2) + j * 16 + _quad * 4 + r)
#define EPI4_FOR(BN_)                                                                        \
  const int _t = TID(); const int _lane = _t & 63, _wave = _t >> 6;                          \
  const int _wm = _wave >> 1, _wn = _wave & 1, _l16 = _lane & 15, _quad = _lane >> 4;        \
  _Pragma("unroll") for (int i = 0; i < 4; ++i)                                              \
  _Pragma("unroll") for (int j = 0; j < (BN_) / 32; ++j)
#define EPI4_COL(BN_) (_wn * ((BN_) / 2) + j * 16 + _quad * 4)
DI uint2 pack4(f32x4 v) { uint2 o; o.x = pack2(v[0], v[1]); o.y = pack2(v[2], v[3]); return o; }
DI f32x4 unpack4(uint2 u) { return f32x4{bflo(u.x), bfhi(u.x), bflo(u.y), bfhi(u.y)}; }

DI void transpose_tile(const float* __restrict__ W, int ldw, bf16_t* __restrict__ Wt, int ldt, int k0, int n0, char* smem) {
  float* sm = (float*)smem;
  const int tid = TID();
  __syncthreads();
#pragma unroll
  for (int i = 0; i < 4; ++i) {
    const int k = (tid >> 4) + 16 * i, n4 = (tid & 15) * 4;
    const float4 v = *(const float4*)(W + (size_t)(k0 + k) * ldw + n0 + n4);
    sm[k * 65 + n4 + 0] = v.x; sm[k * 65 + n4 + 1] = v.y; sm[k * 65 + n4 + 2] = v.z; sm[k * 65 + n4 + 3] = v.w;
  }
  __syncthreads();
  const int n = tid >> 2, ks = (tid & 3) * 16;
  unsigned u[8];
#pragma unroll
  for (int e = 0; e < 8; ++e) u[e] = pack2(sm[(ks + 2 * e) * 65 + n], sm[(ks + 2 * e + 1) * 65 + n]);
  uint4* dst = (uint4*)(Wt + (size_t)(n0 + n) * ldt + k0 + ks);
  dst[0] = uint4{u[0], u[1], u[2], u[3]};
  dst[1] = uint4{u[4], u[5], u[6], u[7]};
}
DI void transpose_all(const float* W, int ldw, int K, int N, bf16_t* Wt, int bid, int nb, char* smem) {
  const int tk = K >> 6, tn = N >> 6;
  for (int t = bid; t < tk * tn; t += nb) transpose_tile(W, ldw, Wt, K, (t % tk) * 64, (t / tk) * 64, smem);
}

DI void rmsnorm_rows(const float* __restrict__ x, const float* __restrict__ g, bf16_t* __restrict__ h, float* xcopy, int rows,
                     int bid, int nb) {
  const int lane = TID() & 63, wave = TID() >> 6;
  for (int r = bid * 4 + wave; r < rows; r += nb * 4) {
    const float4* xr = (const float4*)(x + (size_t)r * 1024);
    float4 v[4]; float ss = 0.f;
#pragma unroll
    for (int i = 0; i < 4; ++i) { v[i] = xr[lane + 64 * i]; ss += v[i].x * v[i].x + v[i].y * v[i].y + v[i].z * v[i].z + v[i].w * v[i].w; }
    ss = wave_sum(ss);
    const float rs = rsqrtf(ss * (1.f / 1024.f) + 1e-6f);
#pragma unroll
    for (int i = 0; i < 4; ++i) {
      const float4 gg = ((const float4*)g)[lane + 64 * i];
      uint2 o; o.x = pack2(v[i].x * rs * gg.x, v[i].y * rs * gg.y); o.y = pack2(v[i].z * rs * gg.z, v[i].w * rs * gg.w);
      *(uint2*)(h + (size_t)r * 1024 + (lane + 64 * i) * 4) = o;
      if (xcopy) ((float4*)(xcopy + (size_t)r * 1024))[lane + 64 * i] = v[i];
    }
  }
}

template <int DQK, bool CAUSAL>
DI void attn_item(const bf16_t* __restrict__ Q, int ldq, const bf16_t* __restrict__ Kp, int ldk, const bf16_t* __restrict__ VT, int ldvt,
                  int ntiles, int q0, bf16_t* __restrict__ out, int ldo, char* smem) {
  constexpr int KS = DQK + 8, NS = DQK / 16, KCH = DQK / 8;
  bf16_t* Ks = (bf16_t*)smem;
  bf16_t* Vs = Ks + 64 * KS;
  const int tid = TID(), lane = tid & 63, wave = tid >> 6, ql = lane & 31, hh = lane >> 5;
  const int qrow = q0 + wave * 32 + ql;
  bf16x8 bq[NS];
#pragma unroll
  for (int s = 0; s < NS; ++s) bq[s] = *(const bf16x8*)(Q + (size_t)qrow * ldq + s * 16 + hh * 8);
  f32x16 ot[4];
#pragma unroll
  for (int d = 0; d < 4; ++d)
#pragma unroll
    for (int i = 0; i < 16; ++i) ot[d][i] = 0.f;
  float mrun = -INFINITY, lrun = 0.f;
  for (int kt = 0; kt < ntiles; ++kt) {
    __syncthreads();
    for (int c = tid; c < 64 * KCH; c += 256) {
      const int row = c / KCH, cc = c % KCH;
      *(uint4*)(Ks + row * KS + cc * 8) = *(const uint4*)(Kp + (size_t)(kt * 64 + row) * ldk + cc * 8);
    }
#pragma unroll
    for (int c0 = 0; c0 < 4; ++c0) {
      const int c = tid + c0 * 256, row = c >> 3, cc = c & 7;
      *(uint4*)(Vs + row * 72 + cc * 8) = *(const uint4*)(VT + (size_t)row * ldvt + kt * 64 + cc * 8);
    }
    __syncthreads();
    f32x16 st[2];
#pragma unroll
    for (int kb = 0; kb < 2; ++kb) {
#pragma unroll
      for (int i = 0; i < 16; ++i) st[kb][i] = 0.f;
#pragma unroll
      for (int s = 0; s < NS; ++s) {
        const bf16x8 a = *(const bf16x8*)(Ks + (kb * 32 + ql) * KS + s * 16 + hh * 8);
        st[kb] = __builtin_amdgcn_mfma_f32_32x32x16_bf16(a, bq[s], st[kb], 0, 0, 0);
      }
    }
    float mx = -INFINITY;
#pragma unroll
    for (int kb = 0; kb < 2; ++kb)
#pragma unroll
      for (int i = 0; i < 16; ++i) {
        if (CAUSAL) {
          const int key = kt * 64 + kb * 32 + (i & 3) + 8 * (i >> 2) + 4 * hh;
          if (key > qrow) st[kb][i] = -INFINITY;
        }
        mx = fmaxf(mx, st[kb][i]);
      }
    mx = fmaxf(mx, __shfl_xor(mx, 32));
    const float mnew = fmaxf(mrun, mx);
    const float alpha = __builtin_amdgcn_exp2f(mrun - mnew);
    float ps = 0.f;
#pragma unroll
    for (int kb = 0; kb < 2; ++kb)
#pragma unroll
      for (int i = 0; i < 16; ++i) { const float pv = __builtin_amdgcn_exp2f(st[kb][i] - mnew); st[kb][i] = pv; ps += pv; }
    ps += __shfl_xor(ps, 32);
    lrun = lrun * alpha + ps;
    mrun = mnew;
#pragma unroll
    for (int d = 0; d < 4; ++d)
#pragma unroll
      for (int i = 0; i < 16; ++i) ot[d][i] *= alpha;
#pragma unroll
    for (int kb = 0; kb < 2; ++kb)
#pragma unroll
      for (int s2 = 0; s2 < 2; ++s2) {
        unsigned pk[4];
#pragma unroll
        for (int e = 0; e < 4; ++e) pk[e] = pack2(st[kb][8 * s2 + 2 * e], st[kb][8 * s2 + 2 * e + 1]);
        const bf16x8 pb = __builtin_bit_cast(bf16x8, uint4{pk[0], pk[1], pk[2], pk[3]});
#pragma unroll
        for (int d = 0; d < 4; ++d) {
          const bf16_t* vp = Vs + (d * 32 + ql) * 72 + kb * 32 + s2 * 16 + hh * 4;
          const s16x4 lo = *(const s16x4*)vp;
          const s16x4 hi = *(const s16x4*)(vp + 8);
          const bf16x8 av = __builtin_shufflevector(lo, hi, 0, 1, 2, 3, 4, 5, 6, 7);
          ot[d] = __builtin_amdgcn_mfma_f32_32x32x16_bf16(av, pb, ot[d], 0, 0, 0);
        }
      }
  }
  const float inv = 1.f / lrun;
#pragma unroll
  for (int d = 0; d < 4; ++d)
#pragma unroll
    for (int g4 = 0; g4 < 4; ++g4) {
      uint2 o; o.x = pack2(ot[d][4 * g4] * inv, ot[d][4 * g4 + 1] * inv); o.y = pack2(ot[d][4 * g4 + 2] * inv, ot[d][4 * g4 + 3] * inv);
      *(uint2*)(out + (size_t)qrow * ldo + d * 32 + 8 * g4 + 4 * hh) = o;
    }
}


template <int DQK, bool CAUSAL>
DI void attn_item_pf(const bf16_t* __restrict__ Q, int ldq, const bf16_t* Kp, int ldk, const bf16_t* VT, int ldvt,
                  int ntiles, int q0, bf16_t* __restrict__ out, int ldo, char* smem) {
  constexpr int KS = DQK + 8, NS = DQK / 16, KCH = DQK / 8;
  bf16_t* Ks = (bf16_t*)smem;
  bf16_t* Vs = Ks + 64 * KS;
  const int tid = TID(), lane = tid & 63, wave = tid >> 6, ql = lane & 31, hh = lane >> 5;
  const int qrow = q0 + wave * 32 + ql;
  bf16x8 bq[NS];
#pragma unroll
  for (int s = 0; s < NS; ++s) bq[s] = *(const bf16x8*)(Q + (size_t)qrow * ldq + s * 16 + hh * 8);
  f32x16 ot[4];
#pragma unroll
  for (int d = 0; d < 4; ++d)
#pragma unroll
    for (int i = 0; i < 16; ++i) ot[d][i] = 0.f;
  float mrun = -INFINITY, lrun = 0.f;
  Kp = uniform_ptr(Kp); VT = uniform_ptr(VT);
  constexpr int KR = KCH / 4;
  static_assert(KR == 6, "prefetch variant is written for DQK = 192");
  u32x4 kreg[KR], vreg[4];
  const unsigned kvoff = (unsigned)(((tid >> 2) * ldk + (tid & 3) * 8) * 2);
  const unsigned vvoff = (unsigned)(((tid >> 3) * ldvt + (tid & 7) * 8) * 2);
#define GLOADS(dst, voff, sbase) asm volatile("global_load_dwordx4 %0, %1, %2" : "=v"(dst) : "v"(voff), "s"(sbase))
#define ATT_ISSUE(kt_)                                                                                        \
  {                                                                                                           \
    _Pragma("unroll") for (int c0 = 0; c0 < KR; ++c0) GLOADS(kreg[c0], kvoff, Kp + (size_t)(kt_) * 64 * ldk + c0 * 32);   \
    _Pragma("unroll") for (int c0 = 0; c0 < 4; ++c0) GLOADS(vreg[c0], vvoff, VT + (size_t)(c0 * 32) * ldvt + (kt_) * 64); \
  }
#define ATT_LAND()                                                                                            \
  {                                                                                                           \
    asm volatile("s_waitcnt vmcnt(0)" : "+v"(kreg[0]), "+v"(kreg[1]), "+v"(kreg[2]), "+v"(kreg[3]), "+v"(kreg[4]), "+v"(kreg[5]), \
                 "+v"(vreg[0]), "+v"(vreg[1]), "+v"(vreg[2]), "+v"(vreg[3]));                                 \
    _Pragma("unroll") for (int c0 = 0; c0 < KR; ++c0) *(u32x4*)(Ks + (tid >> 2) * KS + ((tid & 3) + 4 * c0) * 8) = kreg[c0];   \
    _Pragma("unroll") for (int c0 = 0; c0 < 4; ++c0) *(u32x4*)(Vs + ((tid >> 3) + 32 * c0) * 72 + (tid & 7) * 8) = vreg[c0];   \
  }
  __syncthreads();
  ATT_ISSUE(0);
  ATT_LAND();
  __syncthreads();
  for (int kt = 0; kt < ntiles; ++kt) {
    {
      const int ktn = (kt + 1 < ntiles) ? kt + 1 : kt;
      ATT_ISSUE(ktn);
    }
    __builtin_amdgcn_sched_barrier(0);
    f32x16 st[2];
#pragma unroll
    for (int kb = 0; kb < 2; ++kb) {
#pragma unroll
      for (int i = 0; i < 16; ++i) st[kb][i] = 0.f;
#pragma unroll
      for (int s = 0; s < NS; ++s) {
        const bf16x8 a = *(const bf16x8*)(Ks + (kb * 32 + ql) * KS + s * 16 + hh * 8);
        st[kb] = __builtin_amdgcn_mfma_f32_32x32x16_bf16(a, bq[s], st[kb], 0, 0, 0);
      }
    }
    float mx = -INFINITY;
#pragma unroll
    for (int kb = 0; kb < 2; ++kb)
#pragma unroll
      for (int i = 0; i < 16; ++i) {
        if (CAUSAL) {
          const int key = kt * 64 + kb * 32 + (i & 3) + 8 * (i >> 2) + 4 * hh;
          if (key > qrow) st[kb][i] = -INFINITY;
        }
        mx = fmaxf(mx, st[kb][i]);
      }
    mx = fmaxf(mx, __shfl_xor(mx, 32));
    const float mnew = fmaxf(mrun, mx);
    const float alpha = __builtin_amdgcn_exp2f(mrun - mnew);
    float ps = 0.f;
#pragma unroll
    for (int kb = 0; kb < 2; ++kb)
#pragma unroll
      for (int i = 0; i < 16; ++i) { const float pv = __builtin_amdgcn_exp2f(st[kb][i] - mnew); st[kb][i] = pv; ps += pv; }
    ps += __shfl_xor(ps, 32);
    lrun = lrun * alpha + ps;
    mrun = mnew;
#pragma unroll
    for (int d = 0; d < 4; ++d)
#pragma unroll
      for (int i = 0; i < 16; ++i) ot[d][i] *= alpha;
#pragma unroll
    for (int kb = 0; kb < 2; ++kb)
#pragma unroll
      for (int s2 = 0; s2 < 2; ++s2) {
        unsigned pk[4];
#pragma unroll
        for (int e = 0; e < 4; ++e) pk[e] = pack2(st[kb][8 * s2 + 2 * e], st[kb][8 * s2 + 2 * e + 1]);
        const bf16x8 pb = __builtin_bit_cast(bf16x8, uint4{pk[0], pk[1], pk[2], pk[3]});
#pragma unroll
        for (int d = 0; d < 4; ++d) {
          const bf16_t* vp = Vs + (d * 32 + ql) * 72 + kb * 32 + s2 * 16 + hh * 4;
          const s16x4 lo = *(const s16x4*)vp;
          const s16x4 hi = *(const s16x4*)(vp + 8);
          const bf16x8 av = __builtin_shufflevector(lo, hi, 0, 1, 2, 3, 4, 5, 6, 7);
          ot[d] = __builtin_amdgcn_mfma_f32_32x32x16_bf16(av, pb, ot[d], 0, 0, 0);
        }
      }
    __builtin_amdgcn_sched_barrier(0);
    __syncthreads();
    ATT_LAND();
    __syncthreads();
  }
#undef ATT_ISSUE
#undef ATT_LAND
#undef GLOADS
  const float inv = 1.f / lrun;
#pragma unroll
  for (int d = 0; d < 4; ++d)
#pragma unroll
    for (int g4 = 0; g4 < 4; ++g4) {
      uint2 o; o.x = pack2(ot[d][4 * g4] * inv, ot[d][4 * g4 + 1] * inv); o.y = pack2(ot[d][4 * g4 + 2] * inv, ot[d][4 * g4 + 3] * inv);
      *(uint2*)(out + (size_t)qrow * ldo + d * 32 + 8 * g4 + 4 * hh) = o;
    }
}

DI void rwkv_scan_unit(const Params& p, int l, int u, char* smem) {
  const int tid = TID();
  const int bl = u >> 5, hd = (u >> 2) & 7, rg = u & 3;
  const int kq = tid & 15, g16 = tid >> 4;
  const bf16_t* RKV = (const bf16_t*)(p.ws + R_RKV) + (size_t)bl * SEQ * 1536;
  const bf16_t* Pm = (const bf16_t*)(p.ws + R_P) + (size_t)bl * SEQ * PLD;
  float* Y = (float*)(p.ws + R_YRW) + (size_t)bl * SEQ * 512;
  float* sm = (float*)smem;
  constexpr int BUFF = 5 * 1024 + 256 + 32;
  const int kc = hd * 64 + kq * 4;
  const float4 kk_w = *(const float4*)(p.in[27] + l * 512 + kc);
  const float4 ka_w = *(const float4*)(p.in[28] + l * 512 + kc);
  float S0 = 0.f, S1 = 0.f, S2 = 0.f, S3 = 0.f;
  uint2 g_r, g_k, g_w, g_a; bf16_t g_v;
  auto gload = [&](int c) {
    const int tok = c * 16 + g16;
    g_r = *(const uint2*)(RKV + (size_t)tok * 1536 + kc);
    g_k = *(const uint2*)(RKV + (size_t)tok * 1536 + 512 + kc);
    g_v = RKV[(size_t)tok * 1536 + 1024 + hd * 64 + rg * 16 + kq];
    g_w = *(const uint2*)(Pm + (size_t)tok * PLD + PC_RW + kc);
    g_a = *(const uint2*)(Pm + (size_t)tok * PLD + PC_RW + 512 + kc);
  };
  auto derive = [&](int buf) {
    float* b = sm + buf * BUFF;
    const float r[4] = {bflo(g_r.x), bfhi(g_r.x), bflo(g_r.y), bfhi(g_r.y)};
    const float k[4] = {bflo(g_k.x), bfhi(g_k.x), bflo(g_k.y), bfhi(g_k.y)};
    const float w[4] = {bflo(g_w.x), bfhi(g_w.x), bflo(g_w.y), bfhi(g_w.y)};
    const float a[4] = {bflo(g_a.x), bfhi(g_a.x), bflo(g_a.y), bfhi(g_a.y)};
    const float kkw[4] = {kk_w.x, kk_w.y, kk_w.z, kk_w.w};
    const float kaw[4] = {ka_w.x, ka_w.y, ka_w.z, ka_w.w};
    float kk[4], ss = 0.f;
#pragma unroll
    for (int e = 0; e < 4; ++e) { kk[e] = k[e] * kkw[e]; ss += kk[e] * kk[e]; }
    ss = red16(ss);
    const float rn = rsqrtf(ss + 1e-12f);
    float dwr[4], dw[4], dk[4], dn[4], db[4];
    float br = 0.f, khr = 0.f;
#pragma unroll
    for (int e = 0; e < 4; ++e) {
      dw[e] = __expf(-0.6065306597126334f * sigm(w[e]));
      const float kn = kk[e] * rn;
      dn[e] = -kn; db[e] = kn * a[e];
      dk[e] = k[e] * (1.f + (a[e] - 1.f) * kaw[e]);
      dwr[e] = dw[e] * r[e];
      br += db[e] * r[e]; khr += dk[e] * r[e];
    }
    br = red16(br); khr = red16(khr);
#pragma unroll
    for (int e = 0; e < 4; ++e) dwr[e] += dn[e] * br;
    *(float4*)(b + 0 * 1024 + g16 * 64 + kq * 4) = float4{dwr[0], dwr[1], dwr[2], dwr[3]};
    *(float4*)(b + 1 * 1024 + g16 * 64 + kq * 4) = float4{dw[0], dw[1], dw[2], dw[3]};
    *(float4*)(b + 2 * 1024 + g16 * 64 + kq * 4) = float4{dk[0], dk[1], dk[2], dk[3]};
    *(float4*)(b + 3 * 1024 + g16 * 64 + kq * 4) = float4{dn[0], dn[1], dn[2], dn[3]};
    *(float4*)(b + 4 * 1024 + g16 * 64 + kq * 4) = float4{db[0], db[1], db[2], db[3]};
    b[5 * 1024 + g16 * 16 + kq] = bf2f(g_v);
    if (kq == 0) b[5 * 1024 + 256 + g16] = khr;
  };
  __syncthreads();
  gload(0); derive(0);
  __syncthreads();
  constexpr int NC = SEQ / 16;
  for (int c = 0; c < NC; ++c) {
    if (c + 1 < NC) gload(c + 1);
    const float* b = sm + (c & 1) * BUFF;
    float ysel = 0.f;
    float4 nk = *(const float4*)(b + 3 * 1024 + kq * 4);
    float4 w = *(const float4*)(b + 1 * 1024 + kq * 4);
    float4 bb = *(const float4*)(b + 4 * 1024 + kq * 4);
    float4 kh = *(const float4*)(b + 2 * 1024 + kq * 4);
    float4 wr = *(const float4*)(b + 0 * 1024 + kq * 4);
    float v = b[5 * 1024 + g16];
    float khrs = b[5 * 1024 + 256];
#pragma unroll
    for (int t = 0; t < 16; ++t) {
      float4 nk2, w2, bb2, kh2, wr2; float v2, khrs2;
      if (t < 15) {
        nk2 = *(const float4*)(b + 3 * 1024 + (t + 1) * 64 + kq * 4);
        w2 = *(const float4*)(b + 1 * 1024 + (t + 1) * 64 + kq * 4);
        bb2 = *(const float4*)(b + 4 * 1024 + (t + 1) * 64 + kq * 4);
        kh2 = *(const float4*)(b + 2 * 1024 + (t + 1) * 64 + kq * 4);
        wr2 = *(const float4*)(b + 0 * 1024 + (t + 1) * 64 + kq * 4);
        v2 = b[5 * 1024 + (t + 1) * 16 + g16];
        khrs2 = b[5 * 1024 + 256 + t + 1];
      }
      float sa = S0 * nk.x + S1 * nk.y + S2 * nk.z + S3 * nk.w;
      float yy = S0 * wr.x + S1 * wr.y + S2 * wr.z + S3 * wr.w;
      sa = red16(sa);
      yy = red16(yy);
      S0 = S0 * w.x + sa * bb.x + v * kh.x;
      S1 = S1 * w.y + sa * bb.y + v * kh.y;
      S2 = S2 * w.z + sa * bb.z + v * kh.z;
      S3 = S3 * w.w + sa * bb.w + v * kh.w;
      yy += v * khrs;
      ysel = (kq == t) ? yy : ysel;
      if (t < 15) { nk = nk2; w = w2; bb = bb2; kh = kh2; wr = wr2; v = v2; khrs = khrs2; }
    }
    Y[(size_t)(c * 16 + kq) * 512 + hd * 64 + rg * 16 + g16] = ysel;
    if (c + 1 < NC) derive((c + 1) & 1);
    __syncthreads();
  }
}

DI void hgrn_scan_unit(const Params& p, int l, int u, char* smem) {
  const int tid = TID();
  const int bl = u >> 5, hd = (u >> 3) & 3, vg = u & 7;
  const int kq = tid & 15, g16 = tid >> 4;
  const bf16_t* Pm = (const bf16_t*)(p.ws + R_P) + (size_t)bl * SEQ * PLD;
  bf16_t* Og = (bf16_t*)(p.ws + R_OHG) + (size_t)bl * SEQ * 512;
  float* sm = (float*)smem;
  constexpr int BUFF = 2 * 2048 + 256 + 16;
  const int kc = hd * 128 + kq * 8;
  float lb[8];
#pragma unroll
  for (int e = 0; e < 8; ++e) {
    if (l == 0) lb[e] = 0.f;
    else { const float x0 = p.in[9][kc + e], x1 = p.in[9][512 + kc + e]; lb[e] = 1.f / (1.f + expf(x0 - x1)); }
  }
  float S[8];
#pragma unroll
  for (int e = 0; e < 8; ++e) S[e] = 0.f;
  uint4 g_q, g_f; bf16_t g_v;
  const int vcol = PC_HG + 1024 + hd * 128 + vg * 16;
  auto gload = [&](int c) {
    const int tok = c * 16 + g16;
    g_q = *(const uint4*)(Pm + (size_t)tok * PLD + PC_HG + kc);
    g_f = *(const uint4*)(Pm + (size_t)tok * PLD + PC_HG + 512 + kc);
    g_v = Pm[(size_t)tok * PLD + vcol + kq];
  };
  auto derive = [&](int buf) {
    float* b = sm + buf * BUFF;
    const unsigned qu[4] = {g_q.x, g_q.y, g_q.z, g_q.w}, fu[4] = {g_f.x, g_f.y, g_f.z, g_f.w};
    float fq[8], f[8], cs = 0.f;
#pragma unroll
    for (int e = 0; e < 8; ++e) {
      const float q = (e & 1) ? bfhi(qu[e >> 1]) : bflo(qu[e >> 1]);
      const float fx = (e & 1) ? bfhi(fu[e >> 1]) : bflo(fu[e >> 1]);
      f[e] = lb[e] + (1.f - lb[e]) * sigm(fx);
      fq[e] = f[e] * q;
      cs += (1.f - f[e]) * q;
    }
    cs = red16(cs);
    *(float4*)(b + g16 * 128 + kq * 8) = float4{fq[0], fq[1], fq[2], fq[3]};
    *(float4*)(b + g16 * 128 + kq * 8 + 4) = float4{fq[4], fq[5], fq[6], fq[7]};
    *(float4*)(b + 2048 + g16 * 128 + kq * 8) = float4{f[0], f[1], f[2], f[3]};
    *(float4*)(b + 2048 + g16 * 128 + kq * 8 + 4) = float4{f[4], f[5], f[6], f[7]};
    b[4096 + g16 * 16 + kq] = bf2f(g_v);
    if (kq == 0) b[4096 + 256 + g16] = cs;
  };
  __syncthreads();
  gload(0); derive(0);
  __syncthreads();
  constexpr int NC = SEQ / 16;
  for (int c = 0; c < NC; ++c) {
    if (c + 1 < NC) gload(c + 1);
    const float* b = sm + (c & 1) * BUFF;
    float osel = 0.f;
#pragma unroll
    for (int t = 0; t < 16; ++t) {
      const float4 q0 = *(const float4*)(b + t * 128 + kq * 8), q1 = *(const float4*)(b + t * 128 + kq * 8 + 4);
      const float4 f0 = *(const float4*)(b + 2048 + t * 128 + kq * 8), f1 = *(const float4*)(b + 2048 + t * 128 + kq * 8 + 4);
      const float v = b[4096 + t * 16 + g16];
      const float cs = b[4096 + 256 + t];
      const float fq[8] = {q0.x, q0.y, q0.z, q0.w, q1.x, q1.y, q1.z, q1.w};
      const float f[8] = {f0.x, f0.y, f0.z, f0.w, f1.x, f1.y, f1.z, f1.w};
      float o = 0.f;
#pragma unroll
      for (int e = 0; e < 8; ++e) { o += S[e] * fq[e]; S[e] = f[e] * (S[e] - v) + v; }
      o = red16(o) + v * cs;
      osel = (kq == t) ? o : osel;
    }
    Og[(size_t)(c * 16 + kq) * 512 + hd * 128 + vg * 16 + g16] = f2bf(osel);
    if (c + 1 < NC) derive((c + 1) & 1);
    __syncthreads();
  }
}

DI void s5_scan_unit(const Params& p, int l, int u, char* smem) {
  const int tid = TID(), lane = tid & 63, wave = tid >> 6;
  const int idx = u * 4 + wave, bl = idx >> 5, g = idx & 31;
  const bf16_t* Pm = (const bf16_t*)(p.ws + R_P) + (size_t)bl * SEQ * PLD + PC_S5 + g * 16;
  bf16_t* Z = (bf16_t*)(p.ws + R_ZS5) + (size_t)bl * SEQ * 512 + g * 16;
  constexpr int BUS = 132;
  float* buT = (float*)smem + wave * (16 * BUS);
  bf16_t* hist = (bf16_t*)(smem + 4 * 16 * BUS * 4) + wave * (16 * 136);
  const float2 ab = *(const float2*)((const float*)(p.ws + OFF_S5AB) + (g * 64 + lane) * 2);
  const int l16 = lane & 15, quad = lane >> 4;
  bf16x8 bbf[8];
  {
    const float* bbp = (const float*)(p.ws + OFF_S5BB);
#pragma unroll
    for (int jb = 0; jb < 8; ++jb) {
      const int col = jb * 16 + l16, nn = col & 63, im = col >> 6;
      unsigned pk[4] = {0u, 0u, 0u, 0u};
      if (quad < 2) {
        const float* src = bbp + (size_t)(g * 64 + nn) * 32 + im * 16 + quad * 8;
#pragma unroll
        for (int e = 0; e < 4; ++e) pk[e] = pack2(src[2 * e], src[2 * e + 1]);
      }
      bbf[jb] = __builtin_bit_cast(bf16x8, uint4{pk[0], pk[1], pk[2], pk[3]});
    }
  }
  bf16x8 cf[4];
  {
    const float* Cre = p.in[16] + (size_t)l * 32768 + (size_t)(g * 16 + l16) * 64;
    const float* Cim = p.in[17] + (size_t)l * 32768 + (size_t)(g * 16 + l16) * 64;
#pragma unroll
    for (int ks = 0; ks < 4; ++ks) {
      unsigned pk[4];
#pragma unroll
      for (int e = 0; e < 4; ++e) {
        const int k = ks * 32 + quad * 8 + 2 * e;
        const float v0 = (k < 64) ? Cre[k] : -Cim[k - 64];
        const float v1 = (k < 64) ? Cre[k + 1] : -Cim[k + 1 - 64];
        pk[e] = pack2(v0, v1);
      }
      cf[ks] = __builtin_bit_cast(bf16x8, uint4{pk[0], pk[1], pk[2], pk[3]});
    }
  }
  const float dcoef = p.in[18][l * 512 + g * 16 + l16];
  float xr = 0.f, xi = 0.f;
  uint4 ua = uint4{0u, 0u, 0u, 0u};
  bf16_t ue[4];
  auto gload = [&](int c) {
    if (quad < 2) ua = *(const uint4*)(Pm + (size_t)(c * 16 + l16) * PLD + quad * 8);
#pragma unroll
    for (int r = 0; r < 4; ++r) ue[r] = Pm[(size_t)(c * 16 + quad * 4 + r) * PLD + l16];
  };
  __syncthreads();
  gload(0);
  constexpr int NC = SEQ / 16;
  for (int c = 0; c < NC; ++c) {
    const bf16x8 afr = __builtin_bit_cast(bf16x8, ua);
    float us[4];
#pragma unroll
    for (int r = 0; r < 4; ++r) us[r] = bf2f(ue[r]);
#pragma unroll
    for (int jb = 0; jb < 8; ++jb) {
      f32x4 acc = {0.f, 0.f, 0.f, 0.f};
      acc = __builtin_amdgcn_mfma_f32_16x16x32_bf16(afr, bbf[jb], acc, 0, 0, 0);
#pragma unroll
      for (int r = 0; r < 4; ++r) buT[(quad * 4 + r) * BUS + jb * 16 + l16] = acc[r];
    }
    if (c + 1 < NC) gload(c + 1);
    __syncthreads();
#pragma unroll
    for (int t = 0; t < 16; ++t) {
      const float ur = buT[t * BUS + lane], ui = buT[t * BUS + 64 + lane];
      const float nr = ab.x * xr - ab.y * xi + ur;
      const float ni = ab.x * xi + ab.y * xr + ui;
      xr = nr; xi = ni;
      hist[t * 136 + lane] = f2bf(xr);
      hist[t * 136 + 64 + lane] = f2bf(xi);
    }
    __syncthreads();
    f32x4 acc = {0.f, 0.f, 0.f, 0.f};
#pragma unroll
    for (int ks = 0; ks < 4; ++ks) {
      const bf16x8 a = *(const bf16x8*)(hist + l16 * 136 + ks * 32 + quad * 8);
      acc = __builtin_amdgcn_mfma_f32_16x16x32_bf16(a, cf[ks], acc, 0, 0, 0);
    }
#pragma unroll
    for (int r = 0; r < 4; ++r) {
      const int t = quad * 4 + r;
      const float y = acc[r] + dcoef * us[r];
      const float z = y * sigm(1.5957691216057308f * (y + 0.044715f * y * y * y));
      Z[(size_t)(c * 16 + t) * 512 + l16] = f2bf(z);
    }
  }
}

#define GSYNC() xcd_barrier(xb)
#define TILE_MAP(u_, ntm_, tm_, tn_) { const int _x = (u_) & 7, _li = (u_) >> 3, _per = (ntm_) >> 3; tm_ = _x * _per + (_li % _per); tn_ = _li / _per; }
__global__ void __launch_bounds__(256, 2) mega_kernel(Params p) {
  cg::grid_group grid = cg::this_grid();
  __shared__ __attribute__((aligned(16))) char smem[SMEM_BYTES];
  __shared__ uint4 xb_words;
  const int bid = blockIdx.x, nb = gridDim.x;
  if (p.ws == nullptr) grid.sync();
  if (threadIdx.x == 0) xb_words = make_uint4(0u, 0u, 0u, 0u);
  __syncthreads();
  const XcdBarrier xb = xcd_barrier_post((unsigned*)(p.ws + OFF_BAR), (volatile LAS unsigned*)&xb_words);
  char* ws = p.ws;
  float* X = p.out;
  bf16_t* Wt_in = (bf16_t*)(ws + OFF_WIN);
  bf16_t* Wt_q = (bf16_t*)(ws + OFF_WQ);
  bf16_t* Wt_br = (bf16_t*)(ws + OFF_WBR);
  bf16_t* Wt_out = (bf16_t*)(ws + OFF_WOUT);
  bf16_t* Wt_glu = (bf16_t*)(ws + OFF_WGLU);
  bf16_t* Wt_wup = (bf16_t*)(ws + OFF_WWUP);
  bf16_t* Wt_aup = (bf16_t*)(ws + OFF_WAUP);
  bf16_t* Wt_gup = (bf16_t*)(ws + OFF_WGUP);
  bf16_t* Wt_v = (bf16_t*)(ws + OFF_WV);
  bf16_t* Wt_xkv = (bf16_t*)(ws + OFF_WXKV);
  bf16_t* Hb = (bf16_t*)(ws + OFF_H);
  bf16_t* Vfirst = (bf16_t*)(ws + OFF_VFIRST);
  bf16_t* Kx = (bf16_t*)(ws + OFF_KX);
  bf16_t* VxT = (bf16_t*)(ws + OFF_VXT);
  bf16_t* Hm = (bf16_t*)(ws + OFF_HM);
  float* CosT = (float*)(ws + OFF_COS);
  float* SinT = (float*)(ws + OFF_SIN);
  bf16_t* Pm = (bf16_t*)(ws + R_P);
  bf16_t* Cqn = (bf16_t*)(ws + R_CQN);
  bf16_t* Qp = (bf16_t*)(ws + R_QP);
  bf16_t* KVlat = (bf16_t*)(ws + R_KVLAT);
  bf16_t* VTm = (bf16_t*)(ws + R_VT);
  bf16_t* RKV = (bf16_t*)(ws + R_RKV);
  bf16_t* Alora = (bf16_t*)(ws + R_ALORA);
  float* Yrw = (float*)(ws + R_YRW);
  bf16_t* Zs5 = (bf16_t*)(ws + R_ZS5);
  bf16_t* Ybr = (bf16_t*)(ws + R_YBR);
  bf16_t* Wt_xq = (bf16_t*)(ws + R_WXQ);
  bf16_t* Wt_xo = (bf16_t*)(ws + R_WXO);
  bf16_t* Wt_gu = (bf16_t*)(ws + R_WGU);
  bf16_t* Wt_down = (bf16_t*)(ws + R_WDOWN);
  bf16_t* Qx = (bf16_t*)(ws + R_QX);
  bf16_t* Ox = (bf16_t*)(ws + R_OX);
  bf16_t* GU = (bf16_t*)(ws + R_GU);
  const float LOG2E = 1.4426950408889634f;

  for (int l = 0; l < 2; ++l) {
    {
      PHASE_IDS
      const float* w_in = p.in[4] + (size_t)l * 1024 * P_IN;
      transpose_all(w_in, P_IN, 1024, P_IN, Wt_in, bid, nb, smem);
      transpose_all(p.in[36] + (size_t)l * 512 * 1024, 1024, 512, 1024, Wt_br + (size_t)1 * 1024 * 512, bid, nb, smem);
      transpose_all(p.in[37] + (size_t)l * 512 * 1024, 1024, 512, 1024, Wt_br + (size_t)2 * 1024 * 512, bid, nb, smem);
      transpose_all(p.in[38] + (size_t)l * 512 * 1024, 1024, 512, 1024, Wt_br + (size_t)3 * 1024 * 512, bid, nb, smem);
      transpose_all(p.in[39] + (size_t)l * 1024 * 1024, 1024, 1024, 1024, Wt_out, bid, nb, smem);
      transpose_all(p.in[19] + (size_t)l * 512 * 512, 512, 512, 512, Wt_glu, bid, nb, smem);
      transpose_all(p.in[23] + (size_t)l * 64 * 512, 512, 64, 512, Wt_wup, bid, nb, smem);
      transpose_all(p.in[25] + (size_t)l * 64 * 512, 512, 64, 512, Wt_aup, bid, nb, smem);
      transpose_all(p.in[26] + (size_t)l * 128 * 512, 512, 128, 512, Wt_gup, bid, nb, smem);
      transpose_all(p.in[43] + (size_t)l * 1024 * 2048, 2048, 1024, 2048, Wt_xkv, bid, nb, smem);
      const int gtid = bid * 256 + tid, gsz = nb * 256;
      {
        const float* w_uq = p.in[6] + (size_t)l * 256 * 768;
        const float* w_ukv = p.in[8] + (size_t)l * 128 * 1024;
        for (int e = gtid; e < 768 * 256; e += gsz) {
          const int n = e >> 8, kq = e & 255, hh = n / 192, j = n % 192;
          float v;
          if (j >= 128) v = w_uq[kq * 768 + n];
          else {
            const float4* a = (const float4*)(w_uq + kq * 768 + hh * 192);
            const float4* b = (const float4*)(w_ukv + j * 1024 + hh * 256);
            float v0 = 0.f, v1 = 0.f, v2 = 0.f, v3 = 0.f;
#pragma unroll 8
            for (int d = 0; d < 32; ++d) { const float4 x = a[d], y = b[d]; v0 += x.x * y.x; v1 += x.y * y.y; v2 += x.z * y.z; v3 += x.w * y.w; }
            v = (v0 + v1) + (v2 + v3);
          }
          Wt_q[e] = f2bf(v);
        }
        const float* w_bm = p.in[35] + (size_t)l * 512 * 1024;
        for (int e = gtid; e < 1024 * 512; e += gsz) {
          const int n = e & 1023, kk = e >> 10, hh = kk >> 7, j = kk & 127;
          const float* a = w_ukv + j * 1024 + hh * 256 + 128;
          const float* bcol = w_bm + (size_t)(hh * 128) * 1024 + n;
          float v0 = 0.f, v1 = 0.f, v2 = 0.f, v3 = 0.f;
#pragma unroll 4
          for (int d = 0; d < 128; d += 4) {
            const float4 x = *(const float4*)(a + d);
            v0 += x.x * bcol[(size_t)(d + 0) * 1024]; v1 += x.y * bcol[(size_t)(d + 1) * 1024];
            v2 += x.z * bcol[(size_t)(d + 2) * 1024]; v3 += x.w * bcol[(size_t)(d + 3) * 1024];
          }
          Wt_br[(size_t)n * 512 + kk] = f2bf((v0 + v1) + (v2 + v3));
        }
        if (l == 1) {
          const float* vd = p.in[32];
          const float* vu = p.in[33];
          for (int e = gtid; e < 512 * 1024; e += gsz) {
            const int n = e & 511, kk = e >> 9;
            float v0 = 0.f, v1 = 0.f, v2 = 0.f, v3 = 0.f;
#pragma unroll
            for (int r = 0; r < 32; r += 4) {
              const float4 x = *(const float4*)(vd + kk * 32 + r);
              v0 += x.x * vu[(r + 0) * 512 + n]; v1 += x.y * vu[(r + 1) * 512 + n];
              v2 += x.z * vu[(r + 2) * 512 + n]; v3 += x.w * vu[(r + 3) * 512 + n];
            }
            Wt_v[(size_t)n * 1024 + kk] = f2bf((v0 + v1) + (v2 + v3));
          }
        }
      }
      {
        float* abp = (float*)(ws + OFF_S5AB);
        float* bbp = (float*)(ws + OFF_S5BB);
        for (int e = gtid; e < 2048; e += gsz) {
          const int g = e >> 6;
          const float are = fminf(p.in[11][l * 2048 + e], -1e-4f), aim = p.in[12][l * 2048 + e];
          const float dt = expf(p.in[13][l * 32 + g]);
          const float mag = expf(dt * are);
          const float abre = mag * cosf(dt * aim), abim = mag * sinf(dt * aim);
          const float den = are * are + aim * aim;
          const float zre = ((abre - 1.f) * are + abim * aim) / den;
          const float zim = (abim * are - (abre - 1.f) * aim) / den;
          abp[e * 2] = abre; abp[e * 2 + 1] = abim;
          const float* Br = p.in[14] + (size_t)l * 32768 + (size_t)e * 16;
          const float* Bi = p.in[15] + (size_t)l * 32768 + (size_t)e * 16;
          for (int c = 0; c < 16; ++c) {
            bbp[e * 32 + c] = zre * Br[c] - zim * Bi[c];
            bbp[e * 32 + 16 + c] = zre * Bi[c] + zim * Br[c];
          }
        }
      }
      if (l == 0) rmsnorm_rows(p.in[0], p.in[3], Hb, X, T_ALL, bid, nb);
      else rmsnorm_rows(X, p.in[3] + 1024, Hb, nullptr, T_ALL, bid, nb);
      rmsnorm_rows(p.in[1], p.in[41] + l * 1024, Hm, nullptr, 1024, bid, nb);
    }
    GSYNC();

    for (int half = 0; half < 2; ++half) {
      const bf16_t* Hh = Hb + (size_t)half * TH * 1024;
      {
        const int n1 = 64 * 38;
        const int n2 = (half == 0) ? 8 * 16 : 0;
        int par = 0;
        for (int u = bid; u < n1 + n2; u += nb) {
          f32x4 acc[4][4];
          zero_acc<4>(acc);
          if (u < n1) {
            int tm, tn; TILE_MAP(u, 64, tm, tn);
            int tmn = tm, tnn = tn; if (u + nb < n1) TILE_MAP(u + nb, 64, tmn, tnn);
            gemm_acc<128>(Hh + (size_t)tm * 128 * 1024, 1024, Wt_in + (size_t)tn * 128 * 1024, 1024, 1024, smem, acc,
                          Hh + (size_t)tmn * 128 * 1024, 1024, Wt_in + (size_t)tnn * 128 * 1024, 1024, u != bid, par);
            EPI4_FOR(128) {
              const int row = tm * 128 + EPI_ROW, n = tn * 128 + EPI4_COL(128);
              if (n < GATE_OFF) {
                const int pc = (n < 448) ? n : n + 64;
                *(uint2*)(Pm + (size_t)row * PLD + pc) = pack4(acc[i][j]);
              }
            }
          } else {
            const int v = u - n1, tn = v % 16, tm = v / 16;
            gemm_acc<128>(Hm + (size_t)tm * 128 * 1024, 1024, Wt_xkv + (size_t)tn * 128 * 1024, 1024, 1024, smem, acc);
            EPI_FOR(128) {
              const int row = tm * 128 + EPI_ROW, n = tn * 128 + EPI_COL(128);
              const int b = row >> 8, m = row & 255, sel = n >> 10, hh = (n >> 8) & 3, d = n & 255;
              if (sel == 0) Kx[((size_t)(b * 4 + hh) * 256 + m) * 256 + d] = f2bf(acc[i][j][r]);
              else VxT[((size_t)(b * 4 + hh) * 256 + d) * 256 + m] = f2bf(acc[i][j][r]);
            }
          }
        }
      }
      GSYNC();
      {
      PHASE_IDS
        const float* qn = p.in[5] + l * 256;
        const float* kvn = p.in[7] + l * 128;
        const float* mu = p.in[21] + l * 1792;
        for (int tk = bid * 4 + wave; tk < TH; tk += nb * 4) {
          const int gtok = half * TH + tk, s = gtok & (SEQ - 1), bl = tk >> 12;
          const bf16_t* prow = Pm + (size_t)tk * PLD;
          {
            const uint2 cu = *(const uint2*)(prow + lane * 4);
            float f[4] = {bflo(cu.x), bfhi(cu.x), bflo(cu.y), bfhi(cu.y)};
            float ss = wave_sum(f[0] * f[0] + f[1] * f[1] + f[2] * f[2] + f[3] * f[3]);
            const float rs = rsqrtf(ss * (1.f / 256.f) + 1e-6f);
            const float4 g4 = *(const float4*)(qn + lane * 4);
            uint2 o; o.x = pack2(f[0] * rs * g4.x, f[1] * rs * g4.y); o.y = pack2(f[2] * rs * g4.z, f[3] * rs * g4.w);
            *(uint2*)(Cqn + (size_t)tk * 256 + lane * 4) = o;
          }
          {
            const unsigned cu = *(const unsigned*)(prow + 256 + lane * 2);
            const float f0 = bflo(cu), f1 = bfhi(cu);
            const float ss = wave_sum(f0 * f0 + f1 * f1);
            const float rs = rsqrtf(ss * (1.f / 128.f) + 1e-6f);
            const float v0 = f0 * rs * kvn[lane * 2], v1 = f1 * rs * kvn[lane * 2 + 1];
            const bf16_t b0 = f2bf(v0), b1 = f2bf(v1);
            *(unsigned*)(KVlat + (size_t)tk * 192 + lane * 2) = (unsigned)b0 | ((unsigned)b1 << 16);
            VTm[((size_t)bl * 128 + lane * 2) * SEQ + s] = b0;
            VTm[((size_t)bl * 128 + lane * 2 + 1) * SEQ + s] = b1;
          }
          if (lane < 32) {
            const float t1 = bf2f(prow[384 + lane]), t2 = bf2f(prow[384 + 32 + lane]);
            const float posf = (float)p.pos[gtok];
            const float invf = exp2f(-(float)lane * (13.287712379549449f / 32.f));
            const float ang = posf * invf;
            const float cs = cosf(ang), sn = sinf(ang);
            KVlat[(size_t)tk * 192 + 128 + lane] = f2bf(t1 * cs - t2 * sn);
            KVlat[(size_t)tk * 192 + 160 + lane] = f2bf(t1 * sn + t2 * cs);
            CosT[tk * 32 + lane] = cs; SinT[tk * 32 + lane] = sn;
          }
#pragma unroll
          for (int jj = 0; jj < 7; ++jj) {
            const int col = (jj * 64 + lane) * 4;
            const uint2 cu = *(const uint2*)(prow + PC_RW + col);
            uint2 pu = uint2{0u, 0u};
            if (s > 0) pu = *(const uint2*)(prow - PLD + PC_RW + col);
            const float4 m4 = *(const float4*)(mu + col);
            const float cv[4] = {bflo(cu.x), bfhi(cu.x), bflo(cu.y), bfhi(cu.y)};
            const float pv[4] = {bflo(pu.x), bfhi(pu.x), bflo(pu.y), bfhi(pu.y)};
            const float mm[4] = {m4.x, m4.y, m4.z, m4.w};
            float o[4];
#pragma unroll
            for (int e = 0; e < 4; ++e) o[e] = cv[e] + (pv[e] - cv[e]) * mm[e];
            if (col < 1536) {
              uint2 ov; ov.x = pack2(o[0], o[1]); ov.y = pack2(o[2], o[3]);
              *(uint2*)(RKV + (size_t)tk * 1536 + col) = ov;
              if (l == 0 && col >= 1024) *(uint2*)(Vfirst + (size_t)gtok * 512 + (col - 1024)) = ov;
            } else {
              int dc;
              if (col < 1600) { dc = col - 1536; for (int e = 0; e < 4; ++e) o[e] = tanhf(o[e]); }
              else if (col < 1664) { dc = 64 + col - 1600; }
              else { dc = 128 + col - 1664; for (int e = 0; e < 4; ++e) o[e] = sigm(o[e]); }
              uint2 ov; ov.x = pack2(o[0], o[1]); ov.y = pack2(o[2], o[3]);
              *(uint2*)(Alora + (size_t)tk * 256 + dc) = ov;
            }
          }
        }
      }
      GSYNC();
      {
      PHASE_IDS
        const int nq = 64 * 6, nl = 64 * 4;
        const int total = nq + 3 * nl + (l == 1 ? nl : 0);
        for (int u = bid; u < total; u += nb) {
          f32x4 acc[4][4];
          zero_acc<4>(acc);
          if (u < nq) {
            int tm, tn; TILE_MAP(u, 64, tm, tn);
            gemm_acc<128>(Cqn + (size_t)tm * 128 * 256, 256, Wt_q + (size_t)tn * 128 * 256, 256, 256, smem, acc);
            const float qs = 0.07216878364870322f * LOG2E;
            const int lane_ = tid & 63, wave_ = tid >> 6, wm_ = wave_ >> 1, wn_ = wave_ & 1, l16_ = lane_ & 15, quad_ = lane_ >> 4;
            const int gc = tn * 128 + wn_ * 64;
            const bool is_rope = (gc % 192) == 128;
#pragma unroll
            for (int i = 0; i < 4; ++i) {
              const int row = tm * 128 + wm_ * 64 + i * 16 + l16_;
              if (is_rope) {
#pragma unroll
                for (int j = 0; j < 2; ++j) {
                  const int fi = j * 16 + quad_ * 4;
                  const float4 cs = *(const float4*)(CosT + row * 32 + fi), sn = *(const float4*)(SinT + row * 32 + fi);
                  const float c4[4] = {cs.x, cs.y, cs.z, cs.w}, s4[4] = {sn.x, sn.y, sn.z, sn.w};
#pragma unroll
                  for (int r = 0; r < 4; ++r) {
                    const float t1 = acc[i][j][r], t2 = acc[i][j + 2][r];
                    acc[i][j][r] = t1 * c4[r] - t2 * s4[r]; acc[i][j + 2][r] = t1 * s4[r] + t2 * c4[r];
                  }
                }
              }
#pragma unroll
              for (int j = 0; j < 4; ++j) *(uint2*)(Qp + (size_t)row * 768 + gc + j * 16 + quad_ * 4) = pack4(acc[i][j] * qs);
            }
          } else if (u < nq + 3 * nl) {
            const int v = u - nq, which = v / nl, w2 = v % nl, tn = w2 % 4, tm = w2 / 4;
            if (which == 0) {
              gemm_acc<128>(Alora + (size_t)tm * 128 * 256, 256, Wt_wup + (size_t)tn * 128 * 64, 64, 64, smem, acc);
              const float* w0 = p.in[22] + l * 512;
              EPI4_FOR(128) {
                const int row = tm * 128 + EPI_ROW, n = tn * 128 + EPI4_COL(128);
                const float4 b4 = *(const float4*)(w0 + n);
                *(uint2*)(Pm + (size_t)row * PLD + PC_RW + n) = pack4(acc[i][j] + f32x4{b4.x, b4.y, b4.z, b4.w});
              }
            } else if (which == 1) {
              gemm_acc<128>(Alora + (size_t)tm * 128 * 256 + 64, 256, Wt_aup + (size_t)tn * 128 * 64, 64, 64, smem, acc);
              const float* a0 = p.in[24] + l * 512;
              EPI4_FOR(128) {
                const int row = tm * 128 + EPI_ROW, n = tn * 128 + EPI4_COL(128);
                const float4 b4 = *(const float4*)(a0 + n);
                f32x4 v = acc[i][j] + f32x4{b4.x, b4.y, b4.z, b4.w};
#pragma unroll
                for (int r = 0; r < 4; ++r) v[r] = sigm(v[r]);
                *(uint2*)(Pm + (size_t)row * PLD + PC_RW + 512 + n) = pack4(v);
              }
            } else {
              gemm_acc<128>(Alora + (size_t)tm * 128 * 256 + 128, 256, Wt_gup + (size_t)tn * 128 * 128, 128, 128, smem, acc);
              EPI4_FOR(128) {
                const int row = tm * 128 + EPI_ROW, n = tn * 128 + EPI4_COL(128);
                *(uint2*)(Pm + (size_t)row * PLD + PC_RW + 1024 + n) = pack4(acc[i][j]);
              }
            }
          } else {
            const int w2 = u - nq - 3 * nl, tn = w2 % 4, tm = w2 / 4;
            gemm_acc<128>(Hh + (size_t)tm * 128 * 1024, 1024, Wt_v + (size_t)tn * 128 * 1024, 1024, 1024, smem, acc);
            const float* vb = p.in[34];
            EPI4_FOR(128) {
              const int row = tm * 128 + EPI_ROW, n = tn * 128 + EPI4_COL(128);
              const float4 b4 = *(const float4*)(vb + n);
              const f32x4 lg = acc[i][j] + f32x4{b4.x, b4.y, b4.z, b4.w};
              const f32x4 vc = unpack4(*(const uint2*)(RKV + (size_t)row * 1536 + 1024 + n));
              const f32x4 vf = unpack4(*(const uint2*)(Vfirst + ((size_t)half * TH + row) * 512 + n));
              f32x4 o;
#pragma unroll
              for (int r = 0; r < 4; ++r) o[r] = vc[r] + (vf[r] - vc[r]) * sigm(lg[r]);
              *(uint2*)(RKV + (size_t)row * 1536 + 1024 + n) = pack4(o);
            }
          }
        }
      }
      GSYNC();
      {
        int first, count, step;
        if (nb == 512) {
          if (bid < 144) { first = bid; count = 1; step = 0; }
          else {
            int pi = -1;
            if (bid < 256) pi = bid - 144; else if (bid >= 400 && bid < 416) pi = 112 + (bid - 400);
            first = 144 + pi; count = (pi >= 0) ? 2 : 0; step = 255 - 2 * pi;
          }
        } else { first = bid; step = nb; count = (bid < 400) ? (400 - bid + nb - 1) / nb : 0; }
#pragma unroll 1
        for (int q = 0; q < count; ++q) {
          const int u = first + q * step;
          if (u < 144) {
            __builtin_amdgcn_s_setprio(3);
            if (u < 64) rwkv_scan_unit(p, l, u, smem);
            else if (u < 128) hgrn_scan_unit(p, l, u - 64, smem);
            else s5_scan_unit(p, l, u - 128, smem);
            __builtin_amdgcn_s_setprio(0);
          } else {
            const int it = u - 144, qt = 31 - (it >> 3), bl = (it >> 2) & 1, hh = it & 3;
            attn_item_pf<192, true>(Qp + (size_t)bl * SEQ * 768 + hh * 192, 768, KVlat + (size_t)bl * SEQ * 192, 192,
                                    VTm + (size_t)bl * 128 * SEQ, SEQ, (qt * 128 + 128) / 64, qt * 128,
                                    Pm + (size_t)bl * SEQ * PLD + hh * 128, PLD, smem);
          }
        }
      }
      GSYNC();
      {
      PHASE_IDS
        const int nglu = 64 * 4;
        for (int u = bid; u < nglu; u += nb) {
          int tm, tn; TILE_MAP(u, 64, tm, tn);
          f32x4 acc[4][4];
          zero_acc<4>(acc);
          gemm_acc<128>(Zs5 + (size_t)tm * 128 * 512, 512, Wt_glu + (size_t)tn * 128 * 512, 512, 512, smem, acc);
          const float* bg = p.in[20] + l * 512;
          EPI4_FOR(128) {
            const int row = tm * 128 + EPI_ROW, n = tn * 128 + EPI4_COL(128);
            const f32x4 z = unpack4(*(const uint2*)(Zs5 + (size_t)row * 512 + n));
            const float4 b4 = *(const float4*)(bg + n);
            const f32x4 lg = acc[i][j] + f32x4{b4.x, b4.y, b4.z, b4.w};
            f32x4 o;
#pragma unroll
            for (int r = 0; r < 4; ++r) o[r] = z[r] * sigm(lg[r]);
            *(uint2*)(Pm + (size_t)row * PLD + PC_S5 + n) = pack4(o);
          }
        }
        const float* k_a = p.in[28] + l * 512;
        const float* r_k = p.in[29] + l * 512;
        const float* ln_w = p.in[30] + l * 512;
        const float* ln_b = p.in[31] + l * 512;
        const float* o_norm = p.in[10] + l * 512;
        for (int tk = bid * 4 + wave; tk < TH; tk += nb * 4) {
          const int c0 = lane * 8;
          {
            const float4 y0 = *(const float4*)(Yrw + (size_t)tk * 512 + c0), y1 = *(const float4*)(Yrw + (size_t)tk * 512 + c0 + 4);
            const float y[8] = {y0.x, y0.y, y0.z, y0.w, y1.x, y1.y, y1.z, y1.w};
            const uint4 ru = *(const uint4*)(RKV + (size_t)tk * 1536 + c0);
            const uint4 ku = *(const uint4*)(RKV + (size_t)tk * 1536 + 512 + c0);
            const uint4 vu = *(const uint4*)(RKV + (size_t)tk * 1536 + 1024 + c0);
            const uint4 au = *(const uint4*)(Pm + (size_t)tk * PLD + PC_RW + 512 + c0);
            const uint4 gu = *(const uint4*)(Pm + (size_t)tk * PLD + PC_RW + 1024 + c0);
            const unsigned ra[4] = {ru.x, ru.y, ru.z, ru.w}, ka[4] = {ku.x, ku.y, ku.z, ku.w}, va[4] = {vu.x, vu.y, vu.z, vu.w};
            const unsigned aa[4] = {au.x, au.y, au.z, au.w}, ga[4] = {gu.x, gu.y, gu.z, gu.w};
            float rr[8], kh[8], vv[8], gg[8];
            float sm1 = 0.f, bsum = 0.f;
#pragma unroll
            for (int e = 0; e < 8; ++e) {
              const unsigned sh = (e & 1);
              rr[e] = sh ? bfhi(ra[e >> 1]) : bflo(ra[e >> 1]);
              const float kx = sh ? bfhi(ka[e >> 1]) : bflo(ka[e >> 1]);
              vv[e] = sh ? bfhi(va[e >> 1]) : bflo(va[e >> 1]);
              const float a = sh ? bfhi(aa[e >> 1]) : bflo(aa[e >> 1]);
              gg[e] = sh ? bfhi(ga[e >> 1]) : bflo(ga[e >> 1]);
              kh[e] = kx * (1.f + (a - 1.f) * k_a[c0 + e]);
              sm1 += y[e];
              bsum += rr[e] * kh[e] * r_k[c0 + e];
            }
            sm1 = red8(sm1); bsum = red8(bsum);
            const float mean = sm1 * (1.f / 64.f);
            float vs = 0.f;
#pragma unroll
            for (int e = 0; e < 8; ++e) { const float d = y[e] - mean; vs += d * d; }
            vs = red8(vs);
            const float rstd = rsqrtf(vs * (1.f / 64.f) + 64e-5f);
            float o[8];
#pragma unroll
            for (int e = 0; e < 8; ++e) o[e] = (((y[e] - mean) * rstd) * ln_w[c0 + e] + ln_b[c0 + e] + bsum * vv[e]) * gg[e];
            uint4 ov; ov.x = pack2(o[0], o[1]); ov.y = pack2(o[2], o[3]); ov.z = pack2(o[4], o[5]); ov.w = pack2(o[6], o[7]);
            *(uint4*)(RKV + (size_t)tk * 1536 + c0) = ov;
          }
          {
            bf16_t* op = Pm + (size_t)tk * PLD + PC_HG + 1024 + c0;
            const uint4 ou = *(const uint4*)((const bf16_t*)(ws + R_OHG) + (size_t)tk * 512 + c0);
            const uint4 gu = *(const uint4*)(Pm + (size_t)tk * PLD + PC_HG + 1536 + c0);
            const unsigned oa[4] = {ou.x, ou.y, ou.z, ou.w}, ga[4] = {gu.x, gu.y, gu.z, gu.w};
            float o[8], ss = 0.f;
#pragma unroll
            for (int e = 0; e < 4; ++e) { o[2 * e] = bflo(oa[e]); o[2 * e + 1] = bfhi(oa[e]); }
#pragma unroll
            for (int e = 0; e < 8; ++e) ss += o[e] * o[e];
            ss = red16(ss);
            const float rs = rsqrtf(ss * (1.f / 128.f) + 1e-6f);
            float r8[8];
#pragma unroll
            for (int e = 0; e < 8; ++e) {
              const float gte = (e & 1) ? bfhi(ga[e >> 1]) : bflo(ga[e >> 1]);
              r8[e] = o[e] * rs * o_norm[c0 + e] * sigm(gte);
            }
            uint4 ov; ov.x = pack2(r8[0], r8[1]); ov.y = pack2(r8[2], r8[3]); ov.z = pack2(r8[4], r8[5]); ov.w = pack2(r8[6], r8[7]);
            *(uint4*)op = ov;
          }
        }
      }
      GSYNC();
      {
        int par6 = 0;
        auto brA = [&](int m, int tm_, int& lda_) -> const bf16_t* {
          const bf16_t* Ao;
          if (m == 0) { Ao = Pm; lda_ = PLD; }
          else if (m == 1) { Ao = Pm + PC_HG + 1024; lda_ = PLD; }
          else if (m == 2) { Ao = Pm + PC_S5; lda_ = PLD; }
          else { Ao = RKV; lda_ = 1536; }
          return Ao + (size_t)tm_ * 128 * lda_;
        };
        for (int u = bid; u < 64 * 16; u += nb) {
          int tm, tn; TILE_MAP(u, 64, tm, tn);
          const bool has_next = (u + nb < 64 * 16);
          int tmn = tm, tnn = tn; if (has_next) TILE_MAP(u + nb, 64, tmn, tnn);
          f32x4 yacc[4][2];
          zero_acc<2>(yacc);
#pragma unroll 1
          for (int m = 0; m < 4; ++m) {
            f32x4 ag[4][2];
            zero_acc<2>(ag);
            int ldo; const bf16_t* Ao = brA(m, tm, ldo);
            const bf16_t* Bo = Wt_br + ((size_t)m * 1024 + tn * 64) * 512;
            gemm_acc<64>(Hh + (size_t)tm * 128 * 1024, 1024, Wt_in + (size_t)(GATE_OFF + m * 1024 + tn * 64) * 1024, 1024, 1024, smem, ag,
                         Ao, ldo, Bo, 512, !(m == 0 && u == bid), par6);
#pragma unroll
            for (int i = 0; i < 4; ++i)
#pragma unroll
              for (int j = 0; j < 2; ++j)
#pragma unroll
                for (int r = 0; r < 4; ++r) ag[i][j][r] = sigm(ag[i][j][r]);
            f32x4 ao[4][2];
            zero_acc<2>(ao);
            const int mn = (m < 3) ? m + 1 : 0;
            const int tmx = (m < 3) ? tm : tmn, tnx = (m < 3) ? tn : tnn;
            const bool self = (m == 3) && !has_next;
            const bf16_t* An = self ? Ao : Hh + (size_t)tmx * 128 * 1024;
            const bf16_t* Bn = self ? Bo : Wt_in + (size_t)(GATE_OFF + mn * 1024 + tnx * 64) * 1024;
            gemm_acc<64>(Ao, ldo, Bo, 512, 512, smem, ao, An, self ? ldo : 1024, Bn, self ? 512 : 1024, true, par6);
#pragma unroll
            for (int i = 0; i < 4; ++i)
#pragma unroll
              for (int j = 0; j < 2; ++j)
#pragma unroll
                for (int r = 0; r < 4; ++r) yacc[i][j][r] += ag[i][j][r] * ao[i][j][r];
          }
          {
            f32x4 (&acc)[4][2] = yacc;
            EPI4_FOR(64) {
              const int row = tm * 128 + EPI_ROW, n = tn * 64 + EPI4_COL(64);
              *(uint2*)(Ybr + (size_t)row * 1024 + n) = pack4(acc[i][j]);
            }
          }
        }
      }
      GSYNC();
      {
        int par = 0;
        for (int u = bid; u < 64 * 8; u += nb) {
          int tm, tn; TILE_MAP(u, 64, tm, tn);
          int tmn = tm, tnn = tn; if (u + nb < 64 * 8) TILE_MAP(u + nb, 64, tmn, tnn);
          f32x4 acc[4][4];
          zero_acc<4>(acc);
          gemm_acc<128>(Ybr + (size_t)tm * 128 * 1024, 1024, Wt_out + (size_t)tn * 128 * 1024, 1024, 1024, smem, acc,
                        Ybr + (size_t)tmn * 128 * 1024, 1024, Wt_out + (size_t)tnn * 128 * 1024, 1024, u != bid, par);
          EPI4_FOR(128) {
            const int row = half * TH + tm * 128 + EPI_ROW, n = tn * 128 + EPI4_COL(128);
            float4* xp = (float4*)(X + (size_t)row * 1024 + n);
            float4 xv = *xp; xv.x += acc[i][j][0]; xv.y += acc[i][j][1]; xv.z += acc[i][j][2]; xv.w += acc[i][j][3];
            *xp = xv;
          }
        }
      }
      GSYNC();
    }

    {
      transpose_all(p.in[42] + (size_t)l * 1024 * 1024, 1024, 1024, 1024, Wt_xq, bid, nb, smem);
      transpose_all(p.in[44] + (size_t)l * 1024 * 1024, 1024, 1024, 1024, Wt_xo, bid, nb, smem);
      transpose_all(p.in[46] + (size_t)l * 1024 * 5632, 5632, 1024, 5632, Wt_gu, bid, nb, smem);
      transpose_all(p.in[49] + (size_t)l * 2816 * 1024, 1024, 2816, 1024, Wt_down, bid, nb, smem);
      rmsnorm_rows(X, p.in[40] + l * 1024, Hb, nullptr, T_ALL, bid, nb);
    }
    GSYNC();
    {
      const float qs = 0.0625f * LOG2E;
      int par = 0;
      for (int u = bid; u < 128 * 8; u += nb) {
        int tm, tn; TILE_MAP(u, 128, tm, tn);
        int tmn = tm, tnn = tn; if (u + nb < 128 * 8) TILE_MAP(u + nb, 128, tmn, tnn);
        f32x4 acc[4][4];
        zero_acc<4>(acc);
        gemm_acc<128>(Hb + (size_t)tm * 128 * 1024, 1024, Wt_xq + (size_t)tn * 128 * 1024, 1024, 1024, smem, acc,
                      Hb + (size_t)tmn * 128 * 1024, 1024, Wt_xq + (size_t)tnn * 128 * 1024, 1024, u != bid, par);
        EPI4_FOR(128) {
          const int row = tm * 128 + EPI_ROW, n = tn * 128 + EPI4_COL(128);
          *(uint2*)(Qx + (size_t)row * 1024 + n) = pack4(acc[i][j] * qs);
        }
      }
    }
    GSYNC();
    {
      for (int u = bid; u < 1024; u += nb) {
        const int dvh = u & 1, hh = (u >> 1) & 3, qt = (u >> 3) & 31, b = u >> 8;
        attn_item<256, false>(Qx + (size_t)b * SEQ * 1024 + hh * 256, 1024, Kx + (size_t)(b * 4 + hh) * 65536, 256,
                              VxT + (size_t)(b * 4 + hh) * 65536 + (size_t)dvh * 128 * 256, 256, 4, qt * 128,
                              Ox + (size_t)b * SEQ * 1024 + hh * 256 + dvh * 128, 1024, smem);
      }
    }
    GSYNC();
    {
      int par = 0;
      for (int u = bid; u < 128 * 8; u += nb) {
        int tm, tn; TILE_MAP(u, 128, tm, tn);
        int tmn = tm, tnn = tn; if (u + nb < 128 * 8) TILE_MAP(u + nb, 128, tmn, tnn);
        f32x4 acc[4][4];
        zero_acc<4>(acc);
        gemm_acc<128>(Ox + (size_t)tm * 128 * 1024, 1024, Wt_xo + (size_t)tn * 128 * 1024, 1024, 1024, smem, acc,
                      Ox + (size_t)tmn * 128 * 1024, 1024, Wt_xo + (size_t)tnn * 128 * 1024, 1024, u != bid, par);
        EPI4_FOR(128) {
          const int row = tm * 128 + EPI_ROW, n = tn * 128 + EPI4_COL(128);
          float4* xp = (float4*)(X + (size_t)row * 1024 + n);
          float4 xv = *xp; xv.x += acc[i][j][0]; xv.y += acc[i][j][1]; xv.z += acc[i][j][2]; xv.w += acc[i][j][3];
          *xp = xv;
        }
      }
    }
    GSYNC();
    rmsnorm_rows(X, p.in[45] + l * 1024, Hb, nullptr, T_ALL, bid, nb);
    GSYNC();
    for (int half = 0; half < 2; ++half) {
      const bf16_t* Hh = Hb + (size_t)half * TH * 1024;
      int par13 = 0;
      for (int u = bid; u < 64 * 44; u += nb) {
        int tm, tn; TILE_MAP(u, 64, tm, tn);
        int tmn = tm, tnn = tn; if (u + nb < 64 * 44) TILE_MAP(u + nb, 64, tmn, tnn);
        f32x4 acc[4][4];
        zero_acc<4>(acc);
        gemm_acc<128>(Hh + (size_t)tm * 128 * 1024, 1024, Wt_gu + (size_t)tn * 128 * 1024, 1024, 1024, smem, acc,
                      Hh + (size_t)tmn * 128 * 1024, 1024, Wt_gu + (size_t)tnn * 128 * 1024, 1024, u != bid, par13);
        EPI4_FOR(128) {
          const int row = tm * 128 + EPI_ROW, n = tn * 128 + EPI4_COL(128);
          *(uint2*)(GU + (size_t)row * 5632 + n) = pack4(acc[i][j]);
        }
      }
      GSYNC();
      {
      PHASE_IDS
        const float* cw = p.in[47] + (size_t)l * 3 * D_FF;
        const float* cb = p.in[48] + (size_t)l * D_FF;
        for (int e = bid * 256 + tid; e < TH * 352; e += nb * 256) {
          const int tk = e / 352, c0 = (e % 352) * 8;
          const int s = tk & (SEQ - 1);
          const bf16_t* gp = GU + (size_t)tk * 5632 + c0;
          const uint4 g2 = *(const uint4*)gp;
          uint4 g1 = uint4{0, 0, 0, 0}, g0 = uint4{0, 0, 0, 0};
          if (s >= 1) g1 = *(const uint4*)(gp - 5632);
          if (s >= 2) g0 = *(const uint4*)(gp - 2 * 5632);
          const uint4 uu = *(const uint4*)(gp + D_FF);
          const unsigned a2[4] = {g2.x, g2.y, g2.z, g2.w}, a1[4] = {g1.x, g1.y, g1.z, g1.w}, a0[4] = {g0.x, g0.y, g0.z, g0.w};
          const unsigned au[4] = {uu.x, uu.y, uu.z, uu.w};
          float o[8];
#pragma unroll
          for (int q = 0; q < 8; ++q) {
            const bool hi = q & 1;
            const float x2 = hi ? bfhi(a2[q >> 1]) : bflo(a2[q >> 1]);
            const float x1 = hi ? bfhi(a1[q >> 1]) : bflo(a1[q >> 1]);
            const float x0 = hi ? bfhi(a0[q >> 1]) : bflo(a0[q >> 1]);
            const float up = hi ? bfhi(au[q >> 1]) : bflo(au[q >> 1]);
            const int c = c0 + q;
            const float gv = cw[c] * x0 + cw[D_FF + c] * x1 + cw[2 * D_FF + c] * x2 + cb[c];
            o[q] = gv * sigm(gv) * up;
          }
          uint4 ov; ov.x = pack2(o[0], o[1]); ov.y = pack2(o[2], o[3]); ov.z = pack2(o[4], o[5]); ov.w = pack2(o[6], o[7]);
          *(uint4*)(GU + (size_t)tk * 5632 + D_FF + c0) = ov;
        }
      }
      GSYNC();
      int par15 = 0;
      for (int u = bid; u < 64 * 8; u += nb) {
        int tm, tn; TILE_MAP(u, 64, tm, tn);
        int tmn = tm, tnn = tn; if (u + nb < 64 * 8) TILE_MAP(u + nb, 64, tmn, tnn);
        f32x4 acc[4][4];
        zero_acc<4>(acc);
        gemm_acc<128>(GU + (size_t)tm * 128 * 5632 + D_FF, 5632, Wt_down + (size_t)tn * 128 * 2816, 2816, 2816, smem, acc,
                      GU + (size_t)tmn * 128 * 5632 + D_FF, 5632, Wt_down + (size_t)tnn * 128 * 2816, 2816, u != bid, par15);
        EPI4_FOR(128) {
          const int row = half * TH + tm * 128 + EPI_ROW, n = tn * 128 + EPI4_COL(128);
          float4* xp = (float4*)(X + (size_t)row * 1024 + n);
          float4 xv = *xp; xv.x += acc[i][j][0]; xv.y += acc[i][j][1]; xv.z += acc[i][j][2]; xv.w += acc[i][j][3];
          *xp = xv;
        }
      }
      GSYNC();
    }
  }

  {
      PHASE_IDS
    const float* g = p.in[50];
    for (int r = bid * 4 + wave; r < T_ALL; r += nb * 4) {
      float4* xr = (float4*)(X + (size_t)r * 1024);
      float4 v[4]; float ss = 0.f;
#pragma unroll
      for (int i = 0; i < 4; ++i) { v[i] = xr[lane + 64 * i]; ss += v[i].x * v[i].x + v[i].y * v[i].y + v[i].z * v[i].z + v[i].w * v[i].w; }
      ss = wave_sum(ss);
      const float rs = rsqrtf(ss * (1.f / 1024.f) + 1e-6f);
#pragma unroll
      for (int i = 0; i < 4; ++i) {
        const float4 gg = ((const float4*)g)[lane + 64 * i];
        xr[lane + 64 * i] = float4{v[i].x * rs * gg.x, v[i].y * rs * gg.y, v[i].z * rs * gg.z, v[i].w * rs * gg.w};
      }
    }
  }
}

extern "C" void kernel_launch(void* const* d_in, const int* in_sizes, int n_in, void* d_out, int out_size, void* d_ws, size_t ws_size,
                              hipStream_t stream) {
  static int grid_blocks = 0;
  if (!grid_blocks) {
    int dev = 0, cus = 0, per_cu = 0;
    hipGetDevice(&dev);
    hipDeviceGetAttribute(&cus, hipDeviceAttributeMultiprocessorCount, dev);
    hipOccupancyMaxActiveBlocksPerMultiprocessor(&per_cu, mega_kernel, 256, 0);
    if (per_cu > 2) per_cu = 2;
    if (per_cu < 1) per_cu = 1;
    grid_blocks = cus * per_cu;
  }
  if (ws_size < WS_NEED) fprintf(stderr, "workspace too small: %zu < %zu\n", ws_size, (size_t)WS_NEED);
  Params p{};
  for (int i = 0; i < 51; ++i) p.in[i] = (const float*)d_in[i];
  p.pos = (const int*)d_in[2];
  p.out = (float*)d_out;
  p.ws = (char*)d_ws;
  hipMemsetAsync((char*)d_ws + OFF_BAR, 0, 16384, stream);
  void* args[] = {&p};
  hipError_t e = hipLaunchCooperativeKernel((void*)mega_kernel, dim3(grid_blocks), dim3(256), args, 0, stream);
  if (e != hipSuccess) fprintf(stderr, "cooperative launch failed: %s (grid %d)\n", hipGetErrorString(e), grid_blocks);
}
```

```cpp
#include <hip/hip_runtime.h>
#include <hip/hip_cooperative_groups.h>
#include <cstdio>
#include <cstdint>
namespace cg = cooperative_groups;

typedef unsigned short bf16_t;
using bf16x8 = __attribute__((ext_vector_type(8))) short;
using s16x4 = __attribute__((ext_vector_type(4))) short;
using f32x4 = __attribute__((ext_vector_type(4))) float;
using f32x16 = __attribute__((ext_vector_type(16))) float;
using u32x4 = __attribute__((ext_vector_type(4))) unsigned;
#define DI __device__ __forceinline__

constexpr int T_ALL = 16384, SEQ = 4096, DM = 1024, TH = 8192;
constexpr int P_IN = 8896, GATE_OFF = 4800;
constexpr int PLD = 4864;
constexpr int PC_HG = 512, PC_S5 = 2560, PC_RW = 3072;
constexpr int D_FF = 2816;

constexpr size_t al256(size_t x) { return (x + 255) & ~(size_t)255; }
constexpr size_t OFF_WIN = 0;
constexpr size_t OFF_WQ = OFF_WIN + al256((size_t)P_IN * 1024 * 2);
constexpr size_t OFF_WBR = OFF_WQ + al256((size_t)768 * 256 * 2);
constexpr size_t OFF_WOUT = OFF_WBR + al256((size_t)4 * 1024 * 512 * 2);
constexpr size_t OFF_WGLU = OFF_WOUT + al256((size_t)1024 * 1024 * 2);
constexpr size_t OFF_WWUP = OFF_WGLU + al256((size_t)512 * 512 * 2);
constexpr size_t OFF_WAUP = OFF_WWUP + al256((size_t)512 * 64 * 2);
constexpr size_t OFF_WGUP = OFF_WAUP + al256((size_t)512 * 64 * 2);
constexpr size_t OFF_WV = OFF_WGUP + al256((size_t)512 * 128 * 2);
constexpr size_t OFF_WXKV = OFF_WV + al256((size_t)512 * 1024 * 2);
constexpr size_t OFF_S5AB = OFF_WXKV + al256((size_t)2048 * 1024 * 2);
constexpr size_t OFF_S5BB = OFF_S5AB + al256((size_t)32 * 64 * 2 * 4);
constexpr size_t OFF_H = OFF_S5BB + al256((size_t)32 * 64 * 32 * 4);
constexpr size_t OFF_VFIRST = OFF_H + al256((size_t)T_ALL * 1024 * 2);
constexpr size_t OFF_KX = OFF_VFIRST + al256((size_t)T_ALL * 512 * 2);
constexpr size_t OFF_VXT = OFF_KX + al256((size_t)16 * 256 * 256 * 2);
constexpr size_t OFF_HM = OFF_VXT + al256((size_t)16 * 256 * 256 * 2);
constexpr size_t OFF_COS = OFF_HM + al256((size_t)1024 * 1024 * 2);
constexpr size_t OFF_SIN = OFF_COS + al256((size_t)TH * 32 * 4);
constexpr size_t OFF_BAR = OFF_SIN + al256((size_t)TH * 32 * 4);
constexpr size_t OFF_REG = OFF_BAR + 16384;
constexpr size_t R_P = OFF_REG;
constexpr size_t R_CQN = R_P + al256((size_t)TH * PLD * 2);
constexpr size_t R_QP = R_CQN + (size_t)TH * 256 * 2;
constexpr size_t R_KVLAT = R_QP + al256((size_t)TH * 768 * 2);
constexpr size_t R_VT = R_KVLAT + al256((size_t)TH * 192 * 2);
constexpr size_t R_RKV = R_VT + al256((size_t)2 * 128 * 4096 * 2);
constexpr size_t R_YRW = R_RKV + al256((size_t)TH * 1536 * 2);
constexpr size_t R_ZS5 = R_YRW + al256((size_t)TH * 512 * 2);
constexpr size_t R_ALORA = R_ZS5 + al256((size_t)TH * 512 * 2);
constexpr size_t R_G8 = R_ALORA;
constexpr size_t R_END1 = R_G8 + al256((size_t)TH * 4096);
static_assert(R_END1 <= ((size_t)256 << 20), "workspace plan exceeds the guaranteed 256 MiB");
constexpr size_t R_YBR = R_CQN;
constexpr size_t R_WXQ = OFF_REG;
constexpr size_t R_WXO = R_WXQ + al256((size_t)1024 * 1024 * 2);
constexpr size_t R_WGU = R_WXO + al256((size_t)1024 * 1024 * 2);
constexpr size_t R_WDOWN = R_WGU + al256((size_t)5632 * 1024 * 2);
constexpr size_t R_QX = R_WDOWN + al256((size_t)1024 * 2816 * 2);
constexpr size_t R_OX = R_QX + al256((size_t)T_ALL * 1024 * 2);
constexpr size_t R_GU = R_QX;
constexpr size_t R_END2 = R_GU + al256((size_t)TH * 5632 * 2);
constexpr size_t WS_NEED = (R_END1 > R_END2 ? R_END1 : R_END2);

constexpr int SMEM_BYTES = 73728;

struct Params {
  const float* in[51];
  const int* pos;
  float* out;
  char* ws;
};

DI bf16_t f2bf(float x) { return __builtin_bit_cast(unsigned short, (__bf16)x); }
DI float bf2f(bf16_t b) { return __uint_as_float(((unsigned)b) << 16); }
typedef __bf16 bf16v2_t __attribute__((ext_vector_type(2)));
typedef float f32v2_t __attribute__((ext_vector_type(2)));
DI unsigned pack2(float a, float b) { const f32v2_t v = {a, b}; return __builtin_bit_cast(unsigned, __builtin_convertvector(v, bf16v2_t)); }
DI float bflo(unsigned u) { return __uint_as_float(u << 16); }
DI float bfhi(unsigned u) { return __uint_as_float(u & 0xffff0000u); }
DI float sigm(float x) { return __builtin_amdgcn_rcpf(1.f + __expf(-x)); }
template <int CTRL> DI float dppf(float v) {
  return __builtin_bit_cast(float, __builtin_amdgcn_update_dpp(0, __builtin_bit_cast(int, v), CTRL, 0xf, 0xf, false));
}
DI float red8(float v) { v += dppf<0xB1>(v); v += dppf<0x4E>(v); v += dppf<0x141>(v); return v; }
DI float red16(float v) { v = red8(v); v += dppf<0x140>(v); return v; }
DI int TID() { int t = threadIdx.x; asm volatile("" : "+v"(t)); return t; }
#define PHASE_IDS const int tid = TID(); const int lane = tid & 63, wave = tid >> 6; (void)lane; (void)wave;
DI const bf16_t* uniform_ptr(const bf16_t* p) {
  const unsigned long long v = (unsigned long long)p;
  const unsigned lo = __builtin_amdgcn_readfirstlane((unsigned)v), hi = __builtin_amdgcn_readfirstlane((unsigned)(v >> 32));
  return (const bf16_t*)(((unsigned long long)hi << 32) | lo);
}
DI float wave_sum(float v) { for (int o = 32; o > 0; o >>= 1) v += __shfl_xor(v, o); return v; }


#define XB_TMO      128
#define XB_XCNT(j)  (256  + 64 * (j))
#define XB_XSUB(j)  (1280 + 64 * (j))
#define XB_XGEN(j)  (2304 + 64 * (j))
#define XB_TOP      3328
#define XB_TOPGEN   3392
#define XCD_BAR_WORDS 3456
#define XB_SPIN_CAP (1u << 22)
#define LAS __attribute__((address_space(3)))
DI unsigned xb_ld(unsigned* p) { return __hip_atomic_load(p, __ATOMIC_RELAXED, __HIP_MEMORY_SCOPE_AGENT); }
DI unsigned xb_add(unsigned* p, unsigned v) { return __hip_atomic_fetch_add(p, v, __ATOMIC_RELAXED, __HIP_MEMORY_SCOPE_AGENT); }
DI unsigned xb_xcc_id() { return (unsigned)__builtin_amdgcn_s_getreg((3 << 11) | 20) & 0xFu; }
#define XB_SPIN(cond, bar) do { unsigned _sp = 0; while (cond) { __builtin_amdgcn_s_sleep(1); \
    if ((++_sp & 255u) == 0u) { if (xb_ld(&(bar)[XB_TMO])) break; if (_sp > XB_SPIN_CAP) { atomicAdd(&(bar)[XB_TMO], 1u); break; } } } } while (0)
struct XcdBarrier { unsigned* bar; unsigned x; volatile LAS unsigned* st; };
DI XcdBarrier xcd_barrier_post(unsigned* bar, volatile LAS unsigned* st) {
  XcdBarrier b; b.bar = bar; b.x = xb_xcc_id(); b.st = st;
  if (threadIdx.x == 0) (void)xb_add(&bar[XB_XCNT(b.x)], 1u);
  return b;
}
DI void xcd_barrier_complete(unsigned* bar, unsigned x, unsigned& nloc, unsigned& nx) {
  const unsigned G = gridDim.x * gridDim.y * gridDim.z;
  unsigned sum, cnt, mine, sp = 0u;
  for (;;) {
    sum = 0u; cnt = 0u; mine = 0u;
#pragma unroll
    for (unsigned j = 0; j < 16; ++j) { const unsigned c = xb_ld(&bar[XB_XCNT(j)]); sum += c; cnt += (c > 0u) ? 1u : 0u; mine = (j == x) ? c : mine; }
    if (sum == G) break;
    __builtin_amdgcn_s_sleep(1);
    if ((++sp & 255u) == 0u) { if (xb_ld(&bar[XB_TMO])) break; if (sp > XB_SPIN_CAP) { atomicAdd(&bar[XB_TMO], 1u); break; } }
  }
  nloc = mine > 0u ? mine : 1u; nx = cnt > 0u ? cnt : 1u;
}
DI void xcd_barrier(const XcdBarrier& b) {
  asm volatile("s_waitcnt vmcnt(0)" ::: "memory");
  __syncthreads();
  if (threadIdx.x == 0) {
    unsigned* bar = b.bar;
    __builtin_amdgcn_s_waitcnt(0);
    unsigned nloc = b.st[0], nx = b.st[1];
    if (nloc == 0u) { xcd_barrier_complete(bar, b.x, nloc, nx); b.st[0] = nloc; b.st[1] = nx; }
    const unsigned old = xb_add(&bar[XB_XSUB(b.x)], 1u);
    const unsigned gen = old / nloc;
    if (old + 1u == (gen + 1u) * nloc) {
      __builtin_amdgcn_fence(__ATOMIC_RELEASE, "agent");
      asm volatile("s_waitcnt vmcnt(0)" ::: "memory");
      const unsigned og = xb_add(&bar[XB_TOP], 1u);
      const unsigned tg = og / nx;
      if (og + 1u == (tg + 1u) * nx) xb_add(&bar[XB_TOPGEN], 1u);
      else XB_SPIN(xb_ld(&bar[XB_TOPGEN]) == tg, bar);
      __builtin_amdgcn_fence(__ATOMIC_ACQUIRE, "agent");
      xb_add(&bar[XB_XGEN(b.x)], 1u);
      asm volatile("s_waitcnt vmcnt(0)" ::: "memory");
    } else {
      XB_SPIN(xb_ld(&bar[XB_XGEN(b.x)]) == gen, bar);
      __builtin_amdgcn_fence(__ATOMIC_ACQUIRE, "agent");
      asm volatile("s_waitcnt vmcnt(0)" ::: "memory");
    }
  }
  __syncthreads();
}

#define GLOAD16(dst, ptr) asm volatile("global_load_dwordx4 %0, %1, off" : "=v"(dst) : "v"(ptr))
template <int BN>
DI void gemm_acc(const bf16_t* __restrict__ A, int lda, const bf16_t* __restrict__ Bt, int ldb, int K, char* smem,
                 f32x4 (&acc)[4][BN / 32], const bf16_t* __restrict__ An, int ldan, const bf16_t* __restrict__ Bn, int ldbn,
                 bool pre, int& par) {
  constexpr int A_EL = 128 * 72, B_EL = BN * 72, BUF_EL = A_EL + B_EL;
  constexpr int NJ = BN / 32, BCH = BN / 32;
  bf16_t* sm = (bf16_t*)smem;
  const int tid = TID(), lane = tid & 63, wave = tid >> 6;
  const int wm = wave >> 1, wn = wave & 1, l16 = lane & 15, quad = lane >> 4;
  const int crow = tid >> 3, ccol = (tid & 7) * 8;
  u32x4 ra[4], rb[BCH];
  const bf16_t* Ap = A + (size_t)crow * lda + ccol;
  const bf16_t* Bp = Bt + (size_t)crow * ldb + ccol;
  const bf16_t* Apn = An + (size_t)crow * ldan + ccol;
  const bf16_t* Bpn = Bn + (size_t)crow * ldbn + ccol;
  const int nk = K >> 6;
#define GEMM_ISSUE(ap_, sa_, bp_, sb_)                                                            \
  {                                                                                               \
    _Pragma("unroll") for (int i = 0; i < 4; ++i) GLOAD16(ra[i], (ap_) + (size_t)(32 * i) * (sa_));      \
    _Pragma("unroll") for (int i = 0; i < BCH; ++i) GLOAD16(rb[i], (bp_) + (size_t)(32 * i) * (sb_));    \
  }
#define GEMM_LAND(buf_)                                                                           \
  {                                                                                               \
    if constexpr (BCH == 4)                                                                       \
      asm volatile("s_waitcnt vmcnt(0)" : "+v"(ra[0]), "+v"(ra[1]), "+v"(ra[2]), "+v"(ra[3]), "+v"(rb[0]), "+v"(rb[1]), "+v"(rb[2]), "+v"(rb[3])); \
    else                                                                                          \
      asm volatile("s_waitcnt vmcnt(0)" : "+v"(ra[0]), "+v"(ra[1]), "+v"(ra[2]), "+v"(ra[3]), "+v"(rb[0]), "+v"(rb[1])); \
    bf16_t* sa_ = sm + (buf_) * BUF_EL; bf16_t* sb_ = sa_ + A_EL;                                 \
    _Pragma("unroll") for (int i = 0; i < 4; ++i) *(u32x4*)(sa_ + (crow + 32 * i) * 72 + ccol) = ra[i];   \
    _Pragma("unroll") for (int i = 0; i < BCH; ++i) *(u32x4*)(sb_ + (crow + 32 * i) * 72 + ccol) = rb[i]; \
  }
  if (!pre) {
    GEMM_ISSUE(Ap, lda, Bp, ldb);
    GEMM_LAND(par);
    __syncthreads();
  }
  for (int kt = 0; kt < nk; ++kt) {
    {
      const bool inner = (kt + 1 < nk);
      const bf16_t* ap = inner ? Ap + ((kt + 1) << 6) : Apn;
      const bf16_t* bp = inner ? Bp + ((kt + 1) << 6) : Bpn;
      const int sa = inner ? lda : ldan, sb = inner ? ldb : ldbn;
      GEMM_ISSUE(ap, sa, bp, sb);
    }
    __builtin_amdgcn_sched_barrier(0);
    {
      const bf16_t* sa = sm + ((par + kt) & 1) * BUF_EL; const bf16_t* sb = sa + A_EL;
#pragma unroll
      for (int ks = 0; ks < 2; ++ks) {
        bf16x8 a[4], b[NJ];
#pragma unroll
        for (int i = 0; i < 4; ++i) a[i] = *(const bf16x8*)(sa + (wm * 64 + i * 16 + l16) * 72 + ks * 32 + quad * 8);
#pragma unroll
        for (int j = 0; j < NJ; ++j) b[j] = *(const bf16x8*)(sb + (wn * (BN / 2) + j * 16 + l16) * 72 + ks * 32 + quad * 8);
        __builtin_amdgcn_s_setprio(1);
#pragma unroll
        for (int i = 0; i < 4; ++i)
#pragma unroll
          for (int j = 0; j < NJ; ++j) acc[i][j] = __builtin_amdgcn_mfma_f32_16x16x32_bf16(b[j], a[i], acc[i][j], 0, 0, 0);
        __builtin_amdgcn_s_setprio(0);
      }
    }
    __builtin_amdgcn_sched_barrier(0);
    GEMM_LAND((par + kt + 1) & 1);
    __syncthreads();
  }
  par = (par + nk) & 1;
#undef GEMM_ISSUE
#undef GEMM_LAND
}
template <int BN>
DI void gemm_acc(const bf16_t* __restrict__ A, int lda, const bf16_t* __restrict__ Bt, int ldb, int K, char* smem,
                 f32x4 (&acc)[4][BN / 32]) {
  int par = 0;
  gemm_acc<BN>(A, lda, Bt, ldb, K, smem, acc, A, lda, Bt, ldb, false, par);
}
template <int NJ> DI void zero_acc(f32x4 (&acc)[4][NJ]) {
#pragma unroll
  for (int i = 0; i < 4; ++i)
#pragma unroll
    for (int j = 0; j < NJ; ++j) acc[i][j] = f32x4{0.f, 0.f, 0.f, 0.f};
}
#define EPI_FOR(BN_)                                                                         \
  const int _t = TID(); const int _lane = _t & 63, _wave = _t >> 6;                              \
  const int _wm = _wave >> 1, _wn = _wave & 1, _l16 = _lane & 15, _quad = _lane >> 4;        \
  _Pragma("unroll") for (int i = 0; i < 4; ++i)                                              \
  _Pragma("unroll") for (int j = 0; j < (BN_) / 32; ++j)                                     \
  _Pragma("unroll") for (int r = 0; r < 4; ++r)
#define EPI_ROW (_wm * 64 + i * 16 + _l16)
#define EPI_COL(BN_) (_wn * ((BN_) / 2) + j * 16 + _quad * 4 + r)
#define EPI4_FOR(BN_)                                                                        \
  const int _t = TID(); const int _lane = _t & 63, _wave = _t >> 6;                          \
  const int _wm = _wave >> 1, _wn = _wave & 1, _l16 = _lane & 15, _quad = _lane >> 4;        \
  _Pragma("unroll") for (int i = 0; i < 4; ++i)                                              \
  _Pragma("unroll") for (int j = 0; j < (BN_) / 32; ++j)
#define EPI4_COL(BN_) (_wn * ((BN_) / 2) + j * 16 + _quad * 4)
DI uint2 pack4(f32x4 v) { uint2 o; o.x = pack2(v[0], v[1]); o.y = pack2(v[2], v[3]); return o; }
DI f32x4 unpack4(uint2 u) { return f32x4{bflo(u.x), bfhi(u.x), bflo(u.y), bfhi(u.y)}; }

DI void transpose_tile(const float* __restrict__ W, int ldw, bf16_t* __restrict__ Wt, int ldt, int k0, int n0, char* smem) {
  float* sm = (float*)smem;
  const int tid = TID();
  __syncthreads();
#pragma unroll
  for (int i = 0; i < 4; ++i) {
    const int k = (tid >> 4) + 16 * i, n4 = (tid & 15) * 4;
    const float4 v = *(const float4*)(W + (size_t)(k0 + k) * ldw + n0 + n4);
    sm[k * 65 + n4 + 0] = v.x; sm[k * 65 + n4 + 1] = v.y; sm[k * 65 + n4 + 2] = v.z; sm[k * 65 + n4 + 3] = v.w;
  }
  __syncthreads();
  const int n = tid >> 2, ks = (tid & 3) * 16;
  unsigned u[8];
#pragma unroll
  for (int e = 0; e < 8; ++e) u[e] = pack2(sm[(ks + 2 * e) * 65 + n], sm[(ks + 2 * e + 1) * 65 + n]);
  uint4* dst = (uint4*)(Wt + (size_t)(n0 + n) * ldt + k0 + ks);
  dst[0] = uint4{u[0], u[1], u[2], u[3]};
  dst[1] = uint4{u[4], u[5], u[6], u[7]};
}
DI void transpose_all(const float* W, int ldw, int K, int N, bf16_t* Wt, int bid, int nb, char* smem) {
  const int tk = K >> 6, tn = N >> 6;
  for (int t = bid; t < tk * tn; t += nb) transpose_tile(W, ldw, Wt, K, (t % tk) * 64, (t / tk) * 64, smem);
}

DI void rmsnorm_rows(const float* __restrict__ x, const float* __restrict__ g, bf16_t* __restrict__ h, float* xcopy, int rows,
                     int bid, int nb) {
  const int lane = TID() & 63, wave = TID() >> 6;
  for (int r = bid * 4 + wave; r < rows; r += nb * 4) {
    const float4* xr = (const float4*)(x + (size_t)r * 1024);
    float4 v[4]; float ss = 0.f;
#pragma unroll
    for (int i = 0; i < 4; ++i) { v[i] = xr[lane + 64 * i]; ss += v[i].x * v[i].x + v[i].y * v[i].y + v[i].z * v[i].z + v[i].w * v[i].w; }
    ss = wave_sum(ss);
    const float rs = rsqrtf(ss * (1.f / 1024.f) + 1e-6f);
#pragma unroll
    for (int i = 0; i < 4; ++i) {
      const float4 gg = ((const float4*)g)[lane + 64 * i];
      uint2 o; o.x = pack2(v[i].x * rs * gg.x, v[i].y * rs * gg.y); o.y = pack2(v[i].z * rs * gg.z, v[i].w * rs * gg.w);
      *(uint2*)(h + (size_t)r * 1024 + (lane + 64 * i) * 4) = o;
      if (xcopy) ((float4*)(xcopy + (size_t)r * 1024))[lane + 64 * i] = v[i];
    }
  }
}

template <int DQK, bool CAUSAL>
DI void attn_item(const bf16_t* __restrict__ Q, int ldq, const bf16_t* __restrict__ Kp, int ldk, const bf16_t* __restrict__ VT, int ldvt,
                  int ntiles, int q0, bf16_t* __restrict__ out, int ldo, char* smem) {
  constexpr int KS = DQK + 8, NS = DQK / 16, KCH = DQK / 8;
  bf16_t* Ks = (bf16_t*)smem;
  bf16_t* Vs = Ks + 64 * KS;
  const int tid = TID(), lane = tid & 63, wave = tid >> 6, ql = lane & 31, hh = lane >> 5;
  const int qrow = q0 + wave * 32 + ql;
  bf16x8 bq[NS];
#pragma unroll
  for (int s = 0; s < NS; ++s) bq[s] = *(const bf16x8*)(Q + (size_t)qrow * ldq + s * 16 + hh * 8);
  f32x16 ot[4];
#pragma unroll
  for (int d = 0; d < 4; ++d)
#pragma unroll
    for (int i = 0; i < 16; ++i) ot[d][i] = 0.f;
  float mrun = -INFINITY, lrun = 0.f;
  for (int kt = 0; kt < ntiles; ++kt) {
    __syncthreads();
    for (int c = tid; c < 64 * KCH; c += 256) {
      const int row = c / KCH, cc = c % KCH;
      *(uint4*)(Ks + row * KS + cc * 8) = *(const uint4*)(Kp + (size_t)(kt * 64 + row) * ldk + cc * 8);
    }
#pragma unroll
    for (int c0 = 0; c0 < 4; ++c0) {
      const int c = tid + c0 * 256, row = c >> 3, cc = c & 7;
      *(uint4*)(Vs + row * 72 + cc * 8) = *(const uint4*)(VT + (size_t)row * ldvt + kt * 64 + cc * 8);
    }
    __syncthreads();
    f32x16 st[2];
#pragma unroll
    for (int kb = 0; kb < 2; ++kb) {
#pragma unroll
      for (int i = 0; i < 16; ++i) st[kb][i] = 0.f;
#pragma unroll
      for (int s = 0; s < NS; ++s) {
        const bf16x8 a = *(const bf16x8*)(Ks + (kb * 32 + ql) * KS + s * 16 + hh * 8);
        st[kb] = __builtin_amdgcn_mfma_f32_32x32x16_bf16(a, bq[s], st[kb], 0, 0, 0);
      }
    }
    float mx = -INFINITY;
#pragma unroll
    for (int kb = 0; kb < 2; ++kb)
#pragma unroll
      for (int i = 0; i < 16; ++i) {
        if (CAUSAL) {
          const int key = kt * 64 + kb * 32 + (i & 3) + 8 * (i >> 2) + 4 * hh;
          if (key > qrow) st[kb][i] = -INFINITY;
        }
        mx = fmaxf(mx, st[kb][i]);
      }
    mx = fmaxf(mx, __shfl_xor(mx, 32));
    const float mnew = fmaxf(mrun, mx);
    const float alpha = __builtin_amdgcn_exp2f(mrun - mnew);
    float ps = 0.f;
#pragma unroll
    for (int kb = 0; kb < 2; ++kb)
#pragma unroll
      for (int i = 0; i < 16; ++i) { const float pv = __builtin_amdgcn_exp2f(st[kb][i] - mnew); st[kb][i] = pv; ps += pv; }
    ps += __shfl_xor(ps, 32);
    lrun = lrun * alpha + ps;
    mrun = mnew;
#pragma unroll
    for (int d = 0; d < 4; ++d)
#pragma unroll
      for (int i = 0; i < 16; ++i) ot[d][i] *= alpha;
#pragma unroll
    for (int kb = 0; kb < 2; ++kb)
#pragma unroll
      for (int s2 = 0; s2 < 2; ++s2) {
        unsigned pk[4];
#pragma unroll
        for (int e = 0; e < 4; ++e) pk[e] = pack2(st[kb][8 * s2 + 2 * e], st[kb][8 * s2 + 2 * e + 1]);
        const bf16x8 pb = __builtin_bit_cast(bf16x8, uint4{pk[0], pk[1], pk[2], pk[3]});
#pragma unroll
        for (int d = 0; d < 4; ++d) {
          const bf16_t* vp = Vs + (d * 32 + ql) * 72 + kb * 32 + s2 * 16 + hh * 4;
          const s16x4 lo = *(const s16x4*)vp;
          const s16x4 hi = *(const s16x4*)(vp + 8);
          const bf16x8 av = __builtin_shufflevector(lo, hi, 0, 1, 2, 3, 4, 5, 6, 7);
          ot[d] = __builtin_amdgcn_mfma_f32_32x32x16_bf16(av, pb, ot[d], 0, 0, 0);
        }
      }
  }
  const float inv = 1.f / lrun;
#pragma unroll
  for (int d = 0; d < 4; ++d)
#pragma unroll
    for (int g4 = 0; g4 < 4; ++g4) {
      uint2 o; o.x = pack2(ot[d][4 * g4] * inv, ot[d][4 * g4 + 1] * inv); o.y = pack2(ot[d][4 * g4 + 2] * inv, ot[d][4 * g4 + 3] * inv);
      *(uint2*)(out + (size_t)qrow * ldo + d * 32 + 8 * g4 + 4 * hh) = o;
    }
}


template <int DQK, bool CAUSAL>
DI void attn_item_pf(const bf16_t* __restrict__ Q, int ldq, const bf16_t* Kp, int ldk, const bf16_t* VT, int ldvt,
                  int ntiles, int q0, bf16_t* __restrict__ out, int ldo, char* smem) {
  constexpr int KS = DQK + 8, NS = DQK / 16, KCH = DQK / 8;
  bf16_t* Ks = (bf16_t*)smem;
  bf16_t* Vs = Ks + 64 * KS;
  const int tid = TID(), lane = tid & 63, wave = tid >> 6, ql = lane & 31, hh = lane >> 5;
  const int qrow = q0 + wave * 32 + ql;
  bf16x8 bq[NS];
#pragma unroll
  for (int s = 0; s < NS; ++s) bq[s] = *(const bf16x8*)(Q + (size_t)qrow * ldq + s * 16 + hh * 8);
  f32x16 ot[4];
#pragma unroll
  for (int d = 0; d < 4; ++d)
#pragma unroll
    for (int i = 0; i < 16; ++i) ot[d][i] = 0.f;
  float mrun = -INFINITY, lrun = 0.f;
  Kp = uniform_ptr(Kp); VT = uniform_ptr(VT);
  constexpr int KR = KCH / 4;
  static_assert(KR == 6, "prefetch variant is written for DQK = 192");
  u32x4 kreg[KR], vreg[4];
  const unsigned kvoff = (unsigned)(((tid >> 2) * ldk + (tid & 3) * 8) * 2);
  const unsigned vvoff = (unsigned)(((tid >> 3) * ldvt + (tid & 7) * 8) * 2);
#define GLOADS(dst, voff, sbase) asm volatile("global_load_dwordx4 %0, %1, %2" : "=v"(dst) : "v"(voff), "s"(sbase))
#define ATT_ISSUE(kt_)                                                                                        \
  {                                                                                                           \
    _Pragma("unroll") for (int c0 = 0; c0 < KR; ++c0) GLOADS(kreg[c0], kvoff, Kp + (size_t)(kt_) * 64 * ldk + c0 * 32);   \
    _Pragma("unroll") for (int c0 = 0; c0 < 4; ++c0) GLOADS(vreg[c0], vvoff, VT + (size_t)(c0 * 32) * ldvt + (kt_) * 64); \
  }
#define ATT_LAND()                                                                                            \
  {                                                                                                           \
    asm volatile("s_waitcnt vmcnt(0)" : "+v"(kreg[0]), "+v"(kreg[1]), "+v"(kreg[2]), "+v"(kreg[3]), "+v"(kreg[4]), "+v"(kreg[5]), \
                 "+v"(vreg[0]), "+v"(vreg[1]), "+v"(vreg[2]), "+v"(vreg[3]));                                 \
    _Pragma("unroll") for (int c0 = 0; c0 < KR; ++c0) *(u32x4*)(Ks + (tid >> 2) * KS + ((tid & 3) + 4 * c0) * 8) = kreg[c0];   \
    _Pragma("unroll") for (int c0 = 0; c0 < 4; ++c0) *(u32x4*)(Vs + ((tid >> 3) + 32 * c0) * 72 + (tid & 7) * 8) = vreg[c0];   \
  }
  __syncthreads();
  ATT_ISSUE(0);
  ATT_LAND();
  __syncthreads();
  for (int kt = 0; kt < ntiles; ++kt) {
    {
      const int ktn = (kt + 1 < ntiles) ? kt + 1 : kt;
      ATT_ISSUE(ktn);
    }
    __builtin_amdgcn_sched_barrier(0);
    f32x16 st[2];
#pragma unroll
    for (int kb = 0; kb < 2; ++kb) {
#pragma unroll
      for (int i = 0; i < 16; ++i) st[kb][i] = 0.f;
#pragma unroll
      for (int s = 0; s < NS; ++s) {
        const bf16x8 a = *(const bf16x8*)(Ks + (kb * 32 + ql) * KS + s * 16 + hh * 8);
        st[kb] = __builtin_amdgcn_mfma_f32_32x32x16_bf16(a, bq[s], st[kb], 0, 0, 0);
      }
    }
    float mx = -INFINITY;
#pragma unroll
    for (int kb = 0; kb < 2; ++kb)
#pragma unroll
      for (int i = 0; i < 16; ++i) {
        if (CAUSAL) {
          const int key = kt * 64 + kb * 32 + (i & 3) + 8 * (i >> 2) + 4 * hh;
          if (key > qrow) st[kb][i] = -INFINITY;
        }
        mx = fmaxf(mx, st[kb][i]);
      }
    mx = fmaxf(mx, __shfl_xor(mx, 32));
    const float mnew = fmaxf(mrun, mx);
    const float alpha = __builtin_amdgcn_exp2f(mrun - mnew);
    float ps = 0.f;
#pragma unroll
    for (int kb = 0; kb < 2; ++kb)
#pragma unroll
      for (int i = 0; i < 16; ++i) { const float pv = __builtin_amdgcn_exp2f(st[kb][i] - mnew); st[kb][i] = pv; ps += pv; }
    ps += __shfl_xor(ps, 32);
    lrun = lrun * alpha + ps;
    mrun = mnew;
#pragma unroll
    for (int d = 0; d < 4; ++d)
#pragma unroll
      for (int i = 0; i < 16; ++i) ot[d][i] *= alpha;
#pragma unroll
    for (int kb = 0; kb < 2; ++kb)
#pragma unroll
      for (int s2 = 0; s2 < 2; ++s2) {
        unsigned pk[4];
#pragma unroll
        for (int e = 0; e < 4; ++e) pk[e] = pack2(st[kb][8 * s2 + 2 * e], st[kb][8 * s2 + 2 * e + 1]);
        const bf16x8 pb = __builtin_bit_cast(bf16x8, uint4{pk[0], pk[1], pk[2], pk[3]});
#pragma unroll
        for (int d = 0; d < 4; ++d) {
          const bf16_t* vp = Vs + (d * 32 + ql) * 72 + kb * 32 + s2 * 16 + hh * 4;
          const s16x4 lo = *(const s16x4*)vp;
          const s16x4 hi = *(const s16x4*)(vp + 8);
          const bf16x8 av = __builtin_shufflevector(lo, hi, 0, 1, 2, 3, 4, 5, 6, 7);
          ot[d] = __builtin_amdgcn_mfma_f32_32x32x16_bf16(av, pb, ot[d], 0, 0, 0);
        }
      }
    __builtin_amdgcn_sched_barrier(0);
    __syncthreads();
    ATT_LAND();
    __syncthreads();
  }
#undef ATT_ISSUE
#undef ATT_LAND
#undef GLOADS
  const float inv = 1.f / lrun;
#pragma unroll
  for (int d = 0; d < 4; ++d)
#pragma unroll
    for (int g4 = 0; g4 < 4; ++g4) {
      uint2 o; o.x = pack2(ot[d][4 * g4] * inv, ot[d][4 * g4 + 1] * inv); o.y = pack2(ot[d][4 * g4 + 2] * inv, ot[d][4 * g4 + 3] * inv);
      *(uint2*)(out + (size_t)qrow * ldo + d * 32 + 8 * g4 + 4 * hh) = o;
    }
}

DI void rwkv_scan_unit(const Params& p, int l, int u, char* smem) {
  const int tid = TID();
  const int bl = u >> 5, hd = (u >> 2) & 7, rg = u & 3;
  const int kq = tid & 15, g16 = tid >> 4;
  const bf16_t* RKV = (const bf16_t*)(p.ws + R_RKV) + (size_t)bl * SEQ * 1536;
  const bf16_t* Pm = (const bf16_t*)(p.ws + R_P) + (size_t)bl * SEQ * PLD;
  bf16_t* Y = (bf16_t*)(p.ws + R_YRW) + (size_t)bl * SEQ * 512;
  float* sm = (float*)smem;
  constexpr int BUFF = 5 * 1024 + 256 + 32;
  const int kc = hd * 64 + kq * 4;
  const float4 kk_w = *(const float4*)(p.in[27] + l * 512 + kc);
  const float4 ka_w = *(const float4*)(p.in[28] + l * 512 + kc);
  float S0 = 0.f, S1 = 0.f, S2 = 0.f, S3 = 0.f;
  uint2 g_r, g_k, g_w, g_a; bf16_t g_v;
  auto gload = [&](int c) {
    const int tok = c * 16 + g16;
    g_r = *(const uint2*)(RKV + (size_t)tok * 1536 + kc);
    g_k = *(const uint2*)(RKV + (size_t)tok * 1536 + 512 + kc);
    g_v = RKV[(size_t)tok * 1536 + 1024 + hd * 64 + rg * 16 + kq];
    g_w = *(const uint2*)(Pm + (size_t)tok * PLD + PC_RW + kc);
    g_a = *(const uint2*)(Pm + (size_t)tok * PLD + PC_RW + 512 + kc);
  };
  auto derive = [&](int buf) {
    float* b = sm + buf * BUFF;
    const float r[4] = {bflo(g_r.x), bfhi(g_r.x), bflo(g_r.y), bfhi(g_r.y)};
    const float k[4] = {bflo(g_k.x), bfhi(g_k.x), bflo(g_k.y), bfhi(g_k.y)};
    const float w[4] = {bflo(g_w.x), bfhi(g_w.x), bflo(g_w.y), bfhi(g_w.y)};
    const float a[4] = {bflo(g_a.x), bfhi(g_a.x), bflo(g_a.y), bfhi(g_a.y)};
    const float kkw[4] = {kk_w.x, kk_w.y, kk_w.z, kk_w.w};
    const float kaw[4] = {ka_w.x, ka_w.y, ka_w.z, ka_w.w};
    float kk[4], ss = 0.f;
#pragma unroll
    for (int e = 0; e < 4; ++e) { kk[e] = k[e] * kkw[e]; ss += kk[e] * kk[e]; }
    ss = red16(ss);
    const float rn = rsqrtf(ss + 1e-12f);
    float dwr[4], dw[4], dk[4], dn[4], db[4];
    float br = 0.f, khr = 0.f;
#pragma unroll
    for (int e = 0; e < 4; ++e) {
      dw[e] = __expf(-0.6065306597126334f * sigm(w[e]));
      const float kn = kk[e] * rn;
      dn[e] = -kn; db[e] = kn * a[e];
      dk[e] = k[e] * (1.f + (a[e] - 1.f) * kaw[e]);
      dwr[e] = dw[e] * r[e];
      br += db[e] * r[e]; khr += dk[e] * r[e];
    }
    br = red16(br); khr = red16(khr);
#pragma unroll
    for (int e = 0; e < 4; ++e) dwr[e] += dn[e] * br;
    *(float4*)(b + 0 * 1024 + g16 * 64 + kq * 4) = float4{dwr[0], dwr[1], dwr[2], dwr[3]};
    *(float4*)(b + 1 * 1024 + g16 * 64 + kq * 4) = float4{dw[0], dw[1], dw[2], dw[3]};
    *(float4*)(b + 2 * 1024 + g16 * 64 + kq * 4) = float4{dk[0], dk[1], dk[2], dk[3]};
    *(float4*)(b + 3 * 1024 + g16 * 64 + kq * 4) = float4{dn[0], dn[1], dn[2], dn[3]};
    *(float4*)(b + 4 * 1024 + g16 * 64 + kq * 4) = float4{db[0], db[1], db[2], db[3]};
    b[5 * 1024 + g16 * 16 + kq] = bf2f(g_v);
    if (kq == 0) b[5 * 1024 + 256 + g16] = khr;
  };
  __syncthreads();
  gload(0); derive(0);
  __syncthreads();
  constexpr int NC = SEQ / 16;
  for (int c = 0; c < NC; ++c) {
    if (c + 1 < NC) gload(c + 1);
    const float* b = sm + (c & 1) * BUFF;
    float ysel = 0.f;
    float4 nk = *(const float4*)(b + 3 * 1024 + kq * 4);
    float4 w = *(const float4*)(b + 1 * 1024 + kq * 4);
    float4 bb = *(const float4*)(b + 4 * 1024 + kq * 4);
    float4 kh = *(const float4*)(b + 2 * 1024 + kq * 4);
    float4 wr = *(const float4*)(b + 0 * 1024 + kq * 4);
    float v = b[5 * 1024 + g16];
    float khrs = b[5 * 1024 + 256];
#pragma unroll
    for (int t = 0; t < 16; ++t) {
      float4 nk2, w2, bb2, kh2, wr2; float v2, khrs2;
      if (t < 15) {
        nk2 = *(const float4*)(b + 3 * 1024 + (t + 1) * 64 + kq * 4);
        w2 = *(const float4*)(b + 1 * 1024 + (t + 1) * 64 + kq * 4);
        bb2 = *(const float4*)(b + 4 * 1024 + (t + 1) * 64 + kq * 4);
        kh2 = *(const float4*)(b + 2 * 1024 + (t + 1) * 64 + kq * 4);
        wr2 = *(const float4*)(b + 0 * 1024 + (t + 1) * 64 + kq * 4);
        v2 = b[5 * 1024 + (t + 1) * 16 + g16];
        khrs2 = b[5 * 1024 + 256 + t + 1];
      }
      float sa = S0 * nk.x + S1 * nk.y + S2 * nk.z + S3 * nk.w;
      float yy = S0 * wr.x + S1 * wr.y + S2 * wr.z + S3 * wr.w;
      sa = red16(sa);
      yy = red16(yy);
      S0 = S0 * w.x + sa * bb.x + v * kh.x;
      S1 = S1 * w.y + sa * bb.y + v * kh.y;
      S2 = S2 * w.z + sa * bb.z + v * kh.z;
      S3 = S3 * w.w + sa * bb.w + v * kh.w;
      yy += v * khrs;
      ysel = (kq == t) ? yy : ysel;
      if (t < 15) { nk = nk2; w = w2; bb = bb2; kh = kh2; wr = wr2; v = v2; khrs = khrs2; }
    }
    Y[(size_t)(c * 16 + kq) * 512 + hd * 64 + rg * 16 + g16] = f2bf(ysel);
    if (c + 1 < NC) derive((c + 1) & 1);
    __syncthreads();
  }
}

DI void hgrn_scan_unit(const Params& p, int l, int u, char* smem) {
  const int tid = TID();
  const int bl = u >> 5, hd = (u >> 3) & 3, vg = u & 7;
  const int kq = tid & 15, g16 = tid >> 4;
  bf16_t* Pm = (bf16_t*)(p.ws + R_P) + (size_t)bl * SEQ * PLD;
  float* sm = (float*)smem;
  constexpr int BUFF = 2 * 2048 + 256 + 16;
  const int kc = hd * 128 + kq * 8;
  float lb[8];
#pragma unroll
  for (int e = 0; e < 8; ++e) {
    if (l == 0) lb[e] = 0.f;
    else { const float x0 = p.in[9][kc + e], x1 = p.in[9][512 + kc + e]; lb[e] = 1.f / (1.f + expf(x0 - x1)); }
  }
  float S[8];
#pragma unroll
  for (int e = 0; e < 8; ++e) S[e] = 0.f;
  uint4 g_q, g_f; bf16_t g_v;
  const int vcol = PC_HG + 1024 + hd * 128 + vg * 16;
  auto gload = [&](int c) {
    const int tok = c * 16 + g16;
    g_q = *(const uint4*)(Pm + (size_t)tok * PLD + PC_HG + kc);
    g_f = *(const uint4*)(Pm + (size_t)tok * PLD + PC_HG + 512 + kc);
    g_v = Pm[(size_t)tok * PLD + vcol + kq];
  };
  auto derive = [&](int buf) {
    float* b = sm + buf * BUFF;
    const unsigned qu[4] = {g_q.x, g_q.y, g_q.z, g_q.w}, fu[4] = {g_f.x, g_f.y, g_f.z, g_f.w};
    float fq[8], f[8], cs = 0.f;
#pragma unroll
    for (int e = 0; e < 8; ++e) {
      const float q = (e & 1) ? bfhi(qu[e >> 1]) : bflo(qu[e >> 1]);
      const float fx = (e & 1) ? bfhi(fu[e >> 1]) : bflo(fu[e >> 1]);
      f[e] = lb[e] + (1.f - lb[e]) * sigm(fx);
      fq[e] = f[e] * q;
      cs += (1.f - f[e]) * q;
    }
    cs = red16(cs);
    *(float4*)(b + g16 * 128 + kq * 8) = float4{fq[0], fq[1], fq[2], fq[3]};
    *(float4*)(b + g16 * 128 + kq * 8 + 4) = float4{fq[4], fq[5], fq[6], fq[7]};
    *(float4*)(b + 2048 + g16 * 128 + kq * 8) = float4{f[0], f[1], f[2], f[3]};
    *(float4*)(b + 2048 + g16 * 128 + kq * 8 + 4) = float4{f[4], f[5], f[6], f[7]};
    b[4096 + g16 * 16 + kq] = bf2f(g_v);
    if (kq == 0) b[4096 + 256 + g16] = cs;
  };
  __syncthreads();
  gload(0); derive(0);
  __syncthreads();
  constexpr int NC = SEQ / 16;
  for (int c = 0; c < NC; ++c) {
    if (c + 1 < NC) gload(c + 1);
    const float* b = sm + (c & 1) * BUFF;
    float osel = 0.f;
#pragma unroll
    for (int t = 0; t < 16; ++t) {
      const float4 q0 = *(const float4*)(b + t * 128 + kq * 8), q1 = *(const float4*)(b + t * 128 + kq * 8 + 4);
      const float4 f0 = *(const float4*)(b + 2048 + t * 128 + kq * 8), f1 = *(const float4*)(b + 2048 + t * 128 + kq * 8 + 4);
      const float v = b[4096 + t * 16 + g16];
      const float cs = b[4096 + 256 + t];
      const float fq[8] = {q0.x, q0.y, q0.z, q0.w, q1.x, q1.y, q1.z, q1.w};
      const float f[8] = {f0.x, f0.y, f0.z, f0.w, f1.x, f1.y, f1.z, f1.w};
      float o = 0.f;
#pragma unroll
      for (int e = 0; e < 8; ++e) { o += S[e] * fq[e]; S[e] = f[e] * (S[e] - v) + v; }
      o = red16(o) + v * cs;
      osel = (kq == t) ? o : osel;
    }
    Pm[(size_t)(c * 16 + kq) * PLD + vcol + g16] = f2bf(osel);
    if (c + 1 < NC) derive((c + 1) & 1);
    __syncthreads();
  }
}

DI void s5_scan_unit(const Params& p, int l, int u, char* smem) {
  const int tid = TID(), lane = tid & 63, wave = tid >> 6;
  const int idx = u * 4 + wave, bl = idx >> 5, g = idx & 31;
  const bf16_t* Pm = (const bf16_t*)(p.ws + R_P) + (size_t)bl * SEQ * PLD + PC_S5 + g * 16;
  bf16_t* Z = (bf16_t*)(p.ws + R_ZS5) + (size_t)bl * SEQ * 512 + g * 16;
  constexpr int BUS = 132;
  float* buT = (float*)smem + wave * (16 * BUS);
  bf16_t* hist = (bf16_t*)(smem + 4 * 16 * BUS * 4) + wave * (16 * 136);
  const float2 ab = *(const float2*)((const float*)(p.ws + OFF_S5AB) + (g * 64 + lane) * 2);
  const int l16 = lane & 15, quad = lane >> 4;
  bf16x8 bbf[8];
  {
    const float* bbp = (const float*)(p.ws + OFF_S5BB);
#pragma unroll
    for (int jb = 0; jb < 8; ++jb) {
      const int col = jb * 16 + l16, nn = col & 63, im = col >> 6;
      unsigned pk[4] = {0u, 0u, 0u, 0u};
      if (quad < 2) {
        const float* src = bbp + (size_t)(g * 64 + nn) * 32 + im * 16 + quad * 8;
#pragma unroll
        for (int e = 0; e < 4; ++e) pk[e] = pack2(src[2 * e], src[2 * e + 1]);
      }
      bbf[jb] = __builtin_bit_cast(bf16x8, uint4{pk[0], pk[1], pk[2], pk[3]});
    }
  }
  bf16x8 cf[4];
  {
    const float* Cre = p.in[16] + (size_t)l * 32768 + (size_t)(g * 16 + l16) * 64;
    const float* Cim = p.in[17] + (size_t)l * 32768 + (size_t)(g * 16 + l16) * 64;
#pragma unroll
    for (int ks = 0; ks < 4; ++ks) {
      unsigned pk[4];
#pragma unroll
      for (int e = 0; e < 4; ++e) {
        const int k = ks * 32 + quad * 8 + 2 * e;
        const float v0 = (k < 64) ? Cre[k] : -Cim[k - 64];
        const float v1 = (k < 64) ? Cre[k + 1] : -Cim[k + 1 - 64];
        pk[e] = pack2(v0, v1);
      }
      cf[ks] = __builtin_bit_cast(bf16x8, uint4{pk[0], pk[1], pk[2], pk[3]});
    }
  }
  const float dcoef = p.in[18][l * 512 + g * 16 + l16];
  float xr = 0.f, xi = 0.f;
  uint4 ua = uint4{0u, 0u, 0u, 0u};
  bf16_t ue[4];
  auto gload = [&](int c) {
    if (quad < 2) ua = *(const uint4*)(Pm + (size_t)(c * 16 + l16) * PLD + quad * 8);
#pragma unroll
    for (int r = 0; r < 4; ++r) ue[r] = Pm[(size_t)(c * 16 + quad * 4 + r) * PLD + l16];
  };
  __syncthreads();
  gload(0);
  constexpr int NC = SEQ / 16;
  for (int c = 0; c < NC; ++c) {
    const bf16x8 afr = __builtin_bit_cast(bf16x8, ua);
    float us[4];
#pragma unroll
    for (int r = 0; r < 4; ++r) us[r] = bf2f(ue[r]);
#pragma unroll
    for (int jb = 0; jb < 8; ++jb) {
      f32x4 acc = {0.f, 0.f, 0.f, 0.f};
      acc = __builtin_amdgcn_mfma_f32_16x16x32_bf16(afr, bbf[jb], acc, 0, 0, 0);
#pragma unroll
      for (int r = 0; r < 4; ++r) buT[(quad * 4 + r) * BUS + jb * 16 + l16] = acc[r];
    }
    if (c + 1 < NC) gload(c + 1);
    __syncthreads();
#pragma unroll
    for (int t = 0; t < 16; ++t) {
      const float ur = buT[t * BUS + lane], ui = buT[t * BUS + 64 + lane];
      const float nr = ab.x * xr - ab.y * xi + ur;
      const float ni = ab.x * xi + ab.y * xr + ui;
      xr = nr; xi = ni;
      hist[t * 136 + lane] = f2bf(xr);
      hist[t * 136 + 64 + lane] = f2bf(xi);
    }
    __syncthreads();
    f32x4 acc = {0.f, 0.f, 0.f, 0.f};
#pragma unroll
    for (int ks = 0; ks < 4; ++ks) {
      const bf16x8 a = *(const bf16x8*)(hist + l16 * 136 + ks * 32 + quad * 8);
      acc = __builtin_amdgcn_mfma_f32_16x16x32_bf16(a, cf[ks], acc, 0, 0, 0);
    }
#pragma unroll
    for (int r = 0; r < 4; ++r) {
      const int t = quad * 4 + r;
      const float y = acc[r] + dcoef * us[r];
      const float z = y * sigm(1.5957691216057308f * (y + 0.044715f * y * y * y));
      Z[(size_t)(c * 16 + t) * 512 + l16] = f2bf(z);
    }
  }
}

#define GSYNC() xcd_barrier(xb)
#define TILE_MAP(u_, ntm_, tm_, tn_) { const int _x = (u_) & 7, _li = (u_) >> 3, _per = (ntm_) >> 3; tm_ = _x * _per + (_li % _per); tn_ = _li / _per; }
__global__ void __launch_bounds__(256, 2) mega_kernel(Params p) {
  cg::grid_group grid = cg::this_grid();
  __shared__ __attribute__((aligned(16))) char smem[SMEM_BYTES];
  __shared__ uint4 xb_words;
  const int bid = blockIdx.x, nb = gridDim.x;
  if (p.ws == nullptr) grid.sync();
  if (threadIdx.x == 0) xb_words = make_uint4(0u, 0u, 0u, 0u);
  __syncthreads();
  const XcdBarrier xb = xcd_barrier_post((unsigned*)(p.ws + OFF_BAR), (volatile LAS unsigned*)&xb_words);
  char* ws = p.ws;
  float* X = p.out;
  bf16_t* Wt_in = (bf16_t*)(ws + OFF_WIN);
  bf16_t* Wt_q = (bf16_t*)(ws + OFF_WQ);
  bf16_t* Wt_br = (bf16_t*)(ws + OFF_WBR);
  bf16_t* Wt_out = (bf16_t*)(ws + OFF_WOUT);
  bf16_t* Wt_glu = (bf16_t*)(ws + OFF_WGLU);
  bf16_t* Wt_wup = (bf16_t*)(ws + OFF_WWUP);
  bf16_t* Wt_aup = (bf16_t*)(ws + OFF_WAUP);
  bf16_t* Wt_gup = (bf16_t*)(ws + OFF_WGUP);
  bf16_t* Wt_v = (bf16_t*)(ws + OFF_WV);
  bf16_t* Wt_xkv = (bf16_t*)(ws + OFF_WXKV);
  bf16_t* Hb = (bf16_t*)(ws + OFF_H);
  bf16_t* Vfirst = (bf16_t*)(ws + OFF_VFIRST);
  bf16_t* Kx = (bf16_t*)(ws + OFF_KX);
  bf16_t* VxT = (bf16_t*)(ws + OFF_VXT);
  bf16_t* Hm = (bf16_t*)(ws + OFF_HM);
  float* CosT = (float*)(ws + OFF_COS);
  float* SinT = (float*)(ws + OFF_SIN);
  bf16_t* Pm = (bf16_t*)(ws + R_P);
  bf16_t* Cqn = (bf16_t*)(ws + R_CQN);
  bf16_t* Qp = (bf16_t*)(ws + R_QP);
  bf16_t* KVlat = (bf16_t*)(ws + R_KVLAT);
  bf16_t* VTm = (bf16_t*)(ws + R_VT);
  bf16_t* RKV = (bf16_t*)(ws + R_RKV);
  bf16_t* Alora = (bf16_t*)(ws + R_ALORA);
  bf16_t* Yrw = (bf16_t*)(ws + R_YRW);
  bf16_t* Zs5 = (bf16_t*)(ws + R_ZS5);
  bf16_t* Ybr = (bf16_t*)(ws + R_YBR);
  bf16_t* Wt_xq = (bf16_t*)(ws + R_WXQ);
  bf16_t* Wt_xo = (bf16_t*)(ws + R_WXO);
  bf16_t* Wt_gu = (bf16_t*)(ws + R_WGU);
  bf16_t* Wt_down = (bf16_t*)(ws + R_WDOWN);
  bf16_t* Qx = (bf16_t*)(ws + R_QX);
  bf16_t* Ox = (bf16_t*)(ws + R_OX);
  bf16_t* GU = (bf16_t*)(ws + R_GU);
  const float LOG2E = 1.4426950408889634f;

  for (int l = 0; l < 2; ++l) {
    {
      PHASE_IDS
      const float* w_in = p.in[4] + (size_t)l * 1024 * P_IN;
      transpose_all(w_in, P_IN, 1024, P_IN, Wt_in, bid, nb, smem);
      transpose_all(p.in[36] + (size_t)l * 512 * 1024, 1024, 512, 1024, Wt_br + (size_t)1 * 1024 * 512, bid, nb, smem);
      transpose_all(p.in[37] + (size_t)l * 512 * 1024, 1024, 512, 1024, Wt_br + (size_t)2 * 1024 * 512, bid, nb, smem);
      transpose_all(p.in[38] + (size_t)l * 512 * 1024, 1024, 512, 1024, Wt_br + (size_t)3 * 1024 * 512, bid, nb, smem);
      transpose_all(p.in[39] + (size_t)l * 1024 * 1024, 1024, 1024, 1024, Wt_out, bid, nb, smem);
      transpose_all(p.in[19] + (size_t)l * 512 * 512, 512, 512, 512, Wt_glu, bid, nb, smem);
      transpose_all(p.in[23] + (size_t)l * 64 * 512, 512, 64, 512, Wt_wup, bid, nb, smem);
      transpose_all(p.in[25] + (size_t)l * 64 * 512, 512, 64, 512, Wt_aup, bid, nb, smem);
      transpose_all(p.in[26] + (size_t)l * 128 * 512, 512, 128, 512, Wt_gup, bid, nb, smem);
      transpose_all(p.in[43] + (size_t)l * 1024 * 2048, 2048, 1024, 2048, Wt_xkv, bid, nb, smem);
      const int gtid = bid * 256 + tid, gsz = nb * 256;
      {
        const float* w_uq = p.in[6] + (size_t)l * 256 * 768;
        const float* w_ukv = p.in[8] + (size_t)l * 128 * 1024;
        for (int e = gtid; e < 768 * 256; e += gsz) {
          const int n = e >> 8, kq = e & 255, hh = n / 192, j = n % 192;
          float v;
          if (j >= 128) v = w_uq[kq * 768 + n];
          else {
            const float4* a = (const float4*)(w_uq + kq * 768 + hh * 192);
            const float4* b = (const float4*)(w_ukv + j * 1024 + hh * 256);
            float v0 = 0.f, v1 = 0.f, v2 = 0.f, v3 = 0.f;
#pragma unroll 8
            for (int d = 0; d < 32; ++d) { const float4 x = a[d], y = b[d]; v0 += x.x * y.x; v1 += x.y * y.y; v2 += x.z * y.z; v3 += x.w * y.w; }
            v = (v0 + v1) + (v2 + v3);
          }
          Wt_q[e] = f2bf(v);
        }
        const float* w_bm = p.in[35] + (size_t)l * 512 * 1024;
        for (int e = gtid; e < 1024 * 512; e += gsz) {
          const int n = e & 1023, kk = e >> 10, hh = kk >> 7, j = kk & 127;
          const float* a = w_ukv + j * 1024 + hh * 256 + 128;
          const float* bcol = w_bm + (size_t)(hh * 128) * 1024 + n;
          float v0 = 0.f, v1 = 0.f, v2 = 0.f, v3 = 0.f;
#pragma unroll 4
          for (int d = 0; d < 128; d += 4) {
            const float4 x = *(const float4*)(a + d);
            v0 += x.x * bcol[(size_t)(d + 0) * 1024]; v1 += x.y * bcol[(size_t)(d + 1) * 1024];
            v2 += x.z * bcol[(size_t)(d + 2) * 1024]; v3 += x.w * bcol[(size_t)(d + 3) * 1024];
          }
          Wt_br[(size_t)n * 512 + kk] = f2bf((v0 + v1) + (v2 + v3));
        }
        if (l == 1) {
          const float* vd = p.in[32];
          const float* vu = p.in[33];
          for (int e = gtid; e < 512 * 1024; e += gsz) {
            const int n = e & 511, kk = e >> 9;
            float v0 = 0.f, v1 = 0.f, v2 = 0.f, v3 = 0.f;
#pragma unroll
            for (int r = 0; r < 32; r += 4) {
              const float4 x = *(const float4*)(vd + kk * 32 + r);
              v0 += x.x * vu[(r + 0) * 512 + n]; v1 += x.y * vu[(r + 1) * 512 + n];
              v2 += x.z * vu[(r + 2) * 512 + n]; v3 += x.w * vu[(r + 3) * 512 + n];
            }
            Wt_v[(size_t)n * 1024 + kk] = f2bf((v0 + v1) + (v2 + v3));
          }
        }
      }
      {
        float* abp = (float*)(ws + OFF_S5AB);
        float* bbp = (float*)(ws + OFF_S5BB);
        for (int e = gtid; e < 2048; e += gsz) {
          const int g = e >> 6;
          const float are = fminf(p.in[11][l * 2048 + e], -1e-4f), aim = p.in[12][l * 2048 + e];
          const float dt = expf(p.in[13][l * 32 + g]);
          const float mag = expf(dt * are);
          const float abre = mag * cosf(dt * aim), abim = mag * sinf(dt * aim);
          const float den = are * are + aim * aim;
          const float zre = ((abre - 1.f) * are + abim * aim) / den;
          const float zim = (abim * are - (abre - 1.f) * aim) / den;
          abp[e * 2] = abre; abp[e * 2 + 1] = abim;
          const float* Br = p.in[14] + (size_t)l * 32768 + (size_t)e * 16;
          const float* Bi = p.in[15] + (size_t)l * 32768 + (size_t)e * 16;
          for (int c = 0; c < 16; ++c) {
            bbp[e * 32 + c] = zre * Br[c] - zim * Bi[c];
            bbp[e * 32 + 16 + c] = zre * Bi[c] + zim * Br[c];
          }
        }
      }
      if (l == 0) rmsnorm_rows(p.in[0], p.in[3], Hb, X, T_ALL, bid, nb);
      else rmsnorm_rows(X, p.in[3] + 1024, Hb, nullptr, T_ALL, bid, nb);
      rmsnorm_rows(p.in[1], p.in[41] + l * 1024, Hm, nullptr, 1024, bid, nb);
    }
    GSYNC();

    for (int half = 0; half < 2; ++half) {
      const bf16_t* Hh = Hb + (size_t)half * TH * 1024;
      {
        const int n1 = 64 * 38;
        const int n2 = (half == 0) ? 8 * 16 : 0;
        int par = 0;
        for (int u = bid; u < n1 + n2; u += nb) {
          f32x4 acc[4][4];
          zero_acc<4>(acc);
          if (u < n1) {
            int tm, tn; TILE_MAP(u, 64, tm, tn);
            int tmn = tm, tnn = tn; if (u + nb < n1) TILE_MAP(u + nb, 64, tmn, tnn);
            gemm_acc<128>(Hh + (size_t)tm * 128 * 1024, 1024, Wt_in + (size_t)tn * 128 * 1024, 1024, 1024, smem, acc,
                          Hh + (size_t)tmn * 128 * 1024, 1024, Wt_in + (size_t)tnn * 128 * 1024, 1024, u != bid, par);
            EPI4_FOR(128) {
              const int row = tm * 128 + EPI_ROW, n = tn * 128 + EPI4_COL(128);
              if (n < GATE_OFF) {
                const int pc = (n < 448) ? n : n + 64;
                *(uint2*)(Pm + (size_t)row * PLD + pc) = pack4(acc[i][j]);
              }
            }
          } else {
            const int v = u - n1, tn = v % 16, tm = v / 16;
            gemm_acc<128>(Hm + (size_t)tm * 128 * 1024, 1024, Wt_xkv + (size_t)tn * 128 * 1024, 1024, 1024, smem, acc);
            EPI_FOR(128) {
              const int row = tm * 128 + EPI_ROW, n = tn * 128 + EPI_COL(128);
              const int b = row >> 8, m = row & 255, sel = n >> 10, hh = (n >> 8) & 3, d = n & 255;
              if (sel == 0) Kx[((size_t)(b * 4 + hh) * 256 + m) * 256 + d] = f2bf(acc[i][j][r]);
              else VxT[((size_t)(b * 4 + hh) * 256 + d) * 256 + m] = f2bf(acc[i][j][r]);
            }
          }
        }
      }
      GSYNC();
      {
      PHASE_IDS
        const float* qn = p.in[5] + l * 256;
        const float* kvn = p.in[7] + l * 128;
        const float* mu = p.in[21] + l * 1792;
        for (int tk = bid * 4 + wave; tk < TH; tk += nb * 4) {
          const int gtok = half * TH + tk, s = gtok & (SEQ - 1), bl = tk >> 12;
          const bf16_t* prow = Pm + (size_t)tk * PLD;
          {
            const uint2 cu = *(const uint2*)(prow + lane * 4);
            float f[4] = {bflo(cu.x), bfhi(cu.x), bflo(cu.y), bfhi(cu.y)};
            float ss = wave_sum(f[0] * f[0] + f[1] * f[1] + f[2] * f[2] + f[3] * f[3]);
            const float rs = rsqrtf(ss * (1.f / 256.f) + 1e-6f);
            const float4 g4 = *(const float4*)(qn + lane * 4);
            uint2 o; o.x = pack2(f[0] * rs * g4.x, f[1] * rs * g4.y); o.y = pack2(f[2] * rs * g4.z, f[3] * rs * g4.w);
            *(uint2*)(Cqn + (size_t)tk * 256 + lane * 4) = o;
          }
          {
            const unsigned cu = *(const unsigned*)(prow + 256 + lane * 2);
            const float f0 = bflo(cu), f1 = bfhi(cu);
            const float ss = wave_sum(f0 * f0 + f1 * f1);
            const float rs = rsqrtf(ss * (1.f / 128.f) + 1e-6f);
            const float v0 = f0 * rs * kvn[lane * 2], v1 = f1 * rs * kvn[lane * 2 + 1];
            const bf16_t b0 = f2bf(v0), b1 = f2bf(v1);
            *(unsigned*)(KVlat + (size_t)tk * 192 + lane * 2) = (unsigned)b0 | ((unsigned)b1 << 16);
            VTm[((size_t)bl * 128 + lane * 2) * SEQ + s] = b0;
            VTm[((size_t)bl * 128 + lane * 2 + 1) * SEQ + s] = b1;
          }
          if (lane < 32) {
            const float t1 = bf2f(prow[384 + lane]), t2 = bf2f(prow[384 + 32 + lane]);
            const float posf = (float)p.pos[gtok];
            const float invf = exp2f(-(float)lane * (13.287712379549449f / 32.f));
            const float ang = posf * invf;
            const float cs = cosf(ang), sn = sinf(ang);
            KVlat[(size_t)tk * 192 + 128 + lane] = f2bf(t1 * cs - t2 * sn);
            KVlat[(size_t)tk * 192 + 160 + lane] = f2bf(t1 * sn + t2 * cs);
            CosT[tk * 32 + lane] = cs; SinT[tk * 32 + lane] = sn;
          }
#pragma unroll
          for (int jj = 0; jj < 7; ++jj) {
            const int col = (jj * 64 + lane) * 4;
            const uint2 cu = *(const uint2*)(prow + PC_RW + col);
            uint2 pu = uint2{0u, 0u};
            if (s > 0) pu = *(const uint2*)(prow - PLD + PC_RW + col);
            const float4 m4 = *(const float4*)(mu + col);
            const float cv[4] = {bflo(cu.x), bfhi(cu.x), bflo(cu.y), bfhi(cu.y)};
            const float pv[4] = {bflo(pu.x), bfhi(pu.x), bflo(pu.y), bfhi(pu.y)};
            const float mm[4] = {m4.x, m4.y, m4.z, m4.w};
            float o[4];
#pragma unroll
            for (int e = 0; e < 4; ++e) o[e] = cv[e] + (pv[e] - cv[e]) * mm[e];
            if (col < 1536) {
              uint2 ov; ov.x = pack2(o[0], o[1]); ov.y = pack2(o[2], o[3]);
              *(uint2*)(RKV + (size_t)tk * 1536 + col) = ov;
              if (l == 0 && col >= 1024) *(uint2*)(Vfirst + (size_t)gtok * 512 + (col - 1024)) = ov;
            } else {
              int dc;
              if (col < 1600) { dc = col - 1536; for (int e = 0; e < 4; ++e) o[e] = tanhf(o[e]); }
              else if (col < 1664) { dc = 64 + col - 1600; }
              else { dc = 128 + col - 1664; for (int e = 0; e < 4; ++e) o[e] = sigm(o[e]); }
              uint2 ov; ov.x = pack2(o[0], o[1]); ov.y = pack2(o[2], o[3]);
              *(uint2*)(Alora + (size_t)tk * 256 + dc) = ov;
            }
          }
        }
      }
      GSYNC();
      {
      PHASE_IDS
        const int nq = 64 * 6, nl = 64 * 4;
        const int total = nq + 3 * nl + (l == 1 ? nl : 0);
        for (int u = bid; u < total; u += nb) {
          f32x4 acc[4][4];
          zero_acc<4>(acc);
          if (u < nq) {
            int tm, tn; TILE_MAP(u, 64, tm, tn);
            gemm_acc<128>(Cqn + (size_t)tm * 128 * 256, 256, Wt_q + (size_t)tn * 128 * 256, 256, 256, smem, acc);
            const float qs = 0.07216878364870322f * LOG2E;
            const int lane_ = tid & 63, wave_ = tid >> 6, wm_ = wave_ >> 1, wn_ = wave_ & 1, l16_ = lane_ & 15, quad_ = lane_ >> 4;
            const int gc = tn * 128 + wn_ * 64;
            const bool is_rope = (gc % 192) == 128;
#pragma unroll
            for (int i = 0; i < 4; ++i) {
              const int row = tm * 128 + wm_ * 64 + i * 16 + l16_;
              if (is_rope) {
#pragma unroll
                for (int j = 0; j < 2; ++j) {
                  const int fi = j * 16 + quad_ * 4;
                  const float4 cs = *(const float4*)(CosT + row * 32 + fi), sn = *(const float4*)(SinT + row * 32 + fi);
                  const float c4[4] = {cs.x, cs.y, cs.z, cs.w}, s4[4] = {sn.x, sn.y, sn.z, sn.w};
#pragma unroll
                  for (int r = 0; r < 4; ++r) {
                    const float t1 = acc[i][j][r], t2 = acc[i][j + 2][r];
                    acc[i][j][r] = t1 * c4[r] - t2 * s4[r]; acc[i][j + 2][r] = t1 * s4[r] + t2 * c4[r];
                  }
                }
              }
#pragma unroll
              for (int j = 0; j < 4; ++j) *(uint2*)(Qp + (size_t)row * 768 + gc + j * 16 + quad_ * 4) = pack4(acc[i][j] * qs);
            }
          } else if (u < nq + 3 * nl) {
            const int v = u - nq, which = v / nl, w2 = v % nl, tn = w2 % 4, tm = w2 / 4;
            if (which == 0) {
              gemm_acc<128>(Alora + (size_t)tm * 128 * 256, 256, Wt_wup + (size_t)tn * 128 * 64, 64, 64, smem, acc);
              const float* w0 = p.in[22] + l * 512;
              EPI4_FOR(128) {
                const int row = tm * 128 + EPI_ROW, n = tn * 128 + EPI4_COL(128);
                const float4 b4 = *(const float4*)(w0 + n);
                *(uint2*)(Pm + (size_t)row * PLD + PC_RW + n) = pack4(acc[i][j] + f32x4{b4.x, b4.y, b4.z, b4.w});
              }
            } else if (which == 1) {
              gemm_acc<128>(Alora + (size_t)tm * 128 * 256 + 64, 256, Wt_aup + (size_t)tn * 128 * 64, 64, 64, smem, acc);
              const float* a0 = p.in[24] + l * 512;
              EPI4_FOR(128) {
                const int row = tm * 128 + EPI_ROW, n = tn * 128 + EPI4_COL(128);
                const float4 b4 = *(const float4*)(a0 + n);
                f32x4 v = acc[i][j] + f32x4{b4.x, b4.y, b4.z, b4.w};
#pragma unroll
                for (int r = 0; r < 4; ++r) v[r] = sigm(v[r]);
                *(uint2*)(Pm + (size_t)row * PLD + PC_RW + 512 + n) = pack4(v);
              }
            } else {
              gemm_acc<128>(Alora + (size_t)tm * 128 * 256 + 128, 256, Wt_gup + (size_t)tn * 128 * 128, 128, 128, smem, acc);
              EPI4_FOR(128) {
                const int row = tm * 128 + EPI_ROW, n = tn * 128 + EPI4_COL(128);
                *(uint2*)(Pm + (size_t)row * PLD + PC_RW + 1024 + n) = pack4(acc[i][j]);
              }
            }
          } else {
            const int w2 = u - nq - 3 * nl, tn = w2 % 4, tm = w2 / 4;
            gemm_acc<128>(Hh + (size_t)tm * 128 * 1024, 1024, Wt_v + (size_t)tn * 128 * 1024, 1024, 1024, smem, acc);
            const float* vb = p.in[34];
            EPI4_FOR(128) {
              const int row = tm * 128 + EPI_ROW, n = tn * 128 + EPI4_COL(128);
              const float4 b4 = *(const float4*)(vb + n);
              const f32x4 lg = acc[i][j] + f32x4{b4.x, b4.y, b4.z, b4.w};
              const f32x4 vc = unpack4(*(const uint2*)(RKV + (size_t)row * 1536 + 1024 + n));
              const f32x4 vf = unpack4(*(const uint2*)(Vfirst + ((size_t)half * TH + row) * 512 + n));
              f32x4 o;
#pragma unroll
              for (int r = 0; r < 4; ++r) o[r] = vc[r] + (vf[r] - vc[r]) * sigm(lg[r]);
              *(uint2*)(RKV + (size_t)row * 1536 + 1024 + n) = pack4(o);
            }
          }
        }
      }
      GSYNC();
      {
        int first, count, step;
        if (nb == 512) {
          if (bid < 144) { first = bid; count = 1; step = 0; }
          else {
            int pi = -1;
            if (bid < 256) pi = bid - 144; else if (bid >= 400 && bid < 416) pi = 112 + (bid - 400);
            first = 144 + pi; count = (pi >= 0) ? 2 : 0; step = 255 - 2 * pi;
          }
        } else { first = bid; step = nb; count = (bid < 400) ? (400 - bid + nb - 1) / nb : 0; }
#pragma unroll 1
        for (int q = 0; q < count; ++q) {
          const int u = first + q * step;
          if (u < 144) {
            __builtin_amdgcn_s_setprio(3);
            if (u < 64) rwkv_scan_unit(p, l, u, smem);
            else if (u < 128) hgrn_scan_unit(p, l, u - 64, smem);
            else s5_scan_unit(p, l, u - 128, smem);
            __builtin_amdgcn_s_setprio(0);
          } else {
            const int it = u - 144, qt = 31 - (it >> 3), bl = (it >> 2) & 1, hh = it & 3;
            attn_item_pf<192, true>(Qp + (size_t)bl * SEQ * 768 + hh * 192, 768, KVlat + (size_t)bl * SEQ * 192, 192,
                                    VTm + (size_t)bl * 128 * SEQ, SEQ, (qt * 128 + 128) / 64, qt * 128,
                                    Pm + (size_t)bl * SEQ * PLD + hh * 128, PLD, smem);
          }
        }
        {
          unsigned char* G8 = (unsigned char*)(ws + R_G8);
          int g0, gs;
          if (nb == 512) { g0 = (bid >= 416) ? bid - 416 : 2048; gs = 96; } else { g0 = bid; gs = nb; }
#pragma unroll 1
          for (int t = g0; t < 2048; t += gs) {
            const int tm = t >> 5, tn = t & 31;
            f32x4 acc[4][4];
            zero_acc<4>(acc);
            gemm_acc<128>(Hh + (size_t)tm * 128 * 1024, 1024, Wt_in + (size_t)(GATE_OFF + tn * 128) * 1024, 1024, 1024, smem, acc);
            EPI4_FOR(128) {
              const int row = tm * 128 + EPI_ROW, n = tn * 128 + EPI4_COL(128);
              unsigned q = 0;
#pragma unroll
              for (int r = 0; r < 4; ++r) q |= ((unsigned)(sigm(acc[i][j][r]) * 255.f + 0.5f)) << (8 * r);
              *(unsigned*)(G8 + (size_t)row * 4096 + n) = q;
            }
          }
        }
      }
      GSYNC();
      {
      PHASE_IDS
        const int nglu = 64 * 4;
        for (int u = bid; u < nglu; u += nb) {
          int tm, tn; TILE_MAP(u, 64, tm, tn);
          f32x4 acc[4][4];
          zero_acc<4>(acc);
          gemm_acc<128>(Zs5 + (size_t)tm * 128 * 512, 512, Wt_glu + (size_t)tn * 128 * 512, 512, 512, smem, acc);
          const float* bg = p.in[20] + l * 512;
          EPI4_FOR(128) {
            const int row = tm * 128 + EPI_ROW, n = tn * 128 + EPI4_COL(128);
            const f32x4 z = unpack4(*(const uint2*)(Zs5 + (size_t)row * 512 + n));
            const float4 b4 = *(const float4*)(bg + n);
            const f32x4 lg = acc[i][j] + f32x4{b4.x, b4.y, b4.z, b4.w};
            f32x4 o;
#pragma unroll
            for (int r = 0; r < 4; ++r) o[r] = z[r] * sigm(lg[r]);
            *(uint2*)(Pm + (size_t)row * PLD + PC_S5 + n) = pack4(o);
          }
        }
        const float* k_a = p.in[28] + l * 512;
        const float* r_k = p.in[29] + l * 512;
        const float* ln_w = p.in[30] + l * 512;
        const float* ln_b = p.in[31] + l * 512;
        const float* o_norm = p.in[10] + l * 512;
        for (int tk = bid * 4 + wave; tk < TH; tk += nb * 4) {
          const int c0 = lane * 8;
          {
            const uint4 yu = *(const uint4*)(Yrw + (size_t)tk * 512 + c0);
            const float y[8] = {bflo(yu.x), bfhi(yu.x), bflo(yu.y), bfhi(yu.y), bflo(yu.z), bfhi(yu.z), bflo(yu.w), bfhi(yu.w)};
            const uint4 ru = *(const uint4*)(RKV + (size_t)tk * 1536 + c0);
            const uint4 ku = *(const uint4*)(RKV + (size_t)tk * 1536 + 512 + c0);
            const uint4 vu = *(const uint4*)(RKV + (size_t)tk * 1536 + 1024 + c0);
            const uint4 au = *(const uint4*)(Pm + (size_t)tk * PLD + PC_RW + 512 + c0);
            const uint4 gu = *(const uint4*)(Pm + (size_t)tk * PLD + PC_RW + 1024 + c0);
            const unsigned ra[4] = {ru.x, ru.y, ru.z, ru.w}, ka[4] = {ku.x, ku.y, ku.z, ku.w}, va[4] = {vu.x, vu.y, vu.z, vu.w};
            const unsigned aa[4] = {au.x, au.y, au.z, au.w}, ga[4] = {gu.x, gu.y, gu.z, gu.w};
            float rr[8], kh[8], vv[8], gg[8];
            float sm1 = 0.f, bsum = 0.f;
#pragma unroll
            for (int e = 0; e < 8; ++e) {
              const unsigned sh = (e & 1);
              rr[e] = sh ? bfhi(ra[e >> 1]) : bflo(ra[e >> 1]);
              const float kx = sh ? bfhi(ka[e >> 1]) : bflo(ka[e >> 1]);
              vv[e] = sh ? bfhi(va[e >> 1]) : bflo(va[e >> 1]);
              const float a = sh ? bfhi(aa[e >> 1]) : bflo(aa[e >> 1]);
              gg[e] = sh ? bfhi(ga[e >> 1]) : bflo(ga[e >> 1]);
              kh[e] = kx * (1.f + (a - 1.f) * k_a[c0 + e]);
              sm1 += y[e];
              bsum += rr[e] * kh[e] * r_k[c0 + e];
            }
            sm1 = red8(sm1); bsum = red8(bsum);
            const float mean = sm1 * (1.f / 64.f);
            float vs = 0.f;
#pragma unroll
            for (int e = 0; e < 8; ++e) { const float d = y[e] - mean; vs += d * d; }
            vs = red8(vs);
            const float rstd = rsqrtf(vs * (1.f / 64.f) + 64e-5f);
            float o[8];
#pragma unroll
            for (int e = 0; e < 8; ++e) o[e] = (((y[e] - mean) * rstd) * ln_w[c0 + e] + ln_b[c0 + e] + bsum * vv[e]) * gg[e];
            uint4 ov; ov.x = pack2(o[0], o[1]); ov.y = pack2(o[2], o[3]); ov.z = pack2(o[4], o[5]); ov.w = pack2(o[6], o[7]);
            *(uint4*)(RKV + (size_t)tk * 1536 + c0) = ov;
          }
          {
            bf16_t* op = Pm + (size_t)tk * PLD + PC_HG + 1024 + c0;
            const uint4 ou = *(const uint4*)op;
            const uint4 gu = *(const uint4*)(Pm + (size_t)tk * PLD + PC_HG + 1536 + c0);
            const unsigned oa[4] = {ou.x, ou.y, ou.z, ou.w}, ga[4] = {gu.x, gu.y, gu.z, gu.w};
            float o[8], ss = 0.f;
#pragma unroll
            for (int e = 0; e < 4; ++e) { o[2 * e] = bflo(oa[e]); o[2 * e + 1] = bfhi(oa[e]); }
#pragma unroll
            for (int e = 0; e < 8; ++e) ss += o[e] * o[e];
            ss = red16(ss);
            const float rs = rsqrtf(ss * (1.f / 128.f) + 1e-6f);
            float r8[8];
#pragma unroll
            for (int e = 0; e < 8; ++e) {
              const float gte = (e & 1) ? bfhi(ga[e >> 1]) : bflo(ga[e >> 1]);
              r8[e] = o[e] * rs * o_norm[c0 + e] * sigm(gte);
            }
            uint4 ov; ov.x = pack2(r8[0], r8[1]); ov.y = pack2(r8[2], r8[3]); ov.z = pack2(r8[4], r8[5]); ov.w = pack2(r8[6], r8[7]);
            *(uint4*)op = ov;
          }
        }
      }
      GSYNC();
      {
        int par6 = 0;
        const unsigned char* G8 = (const unsigned char*)(ws + R_G8);
        auto brA = [&](int m, int tm_, int& lda_) -> const bf16_t* {
          const bf16_t* Ao;
          if (m == 0) { Ao = Pm; lda_ = PLD; }
          else if (m == 1) { Ao = Pm + PC_HG + 1024; lda_ = PLD; }
          else if (m == 2) { Ao = Pm + PC_S5; lda_ = PLD; }
          else { Ao = RKV; lda_ = 1536; }
          return Ao + (size_t)tm_ * 128 * lda_;
        };
        for (int u = bid; u < 64 * 8; u += nb) {
          int tm, tn; TILE_MAP(u, 64, tm, tn);
          const bool has_next = (u + nb < 64 * 8);
          int tmn = tm, tnn = tn; if (has_next) TILE_MAP(u + nb, 64, tmn, tnn);
          f32x4 yacc[4][4];
          zero_acc<4>(yacc);
#pragma unroll 1
          for (int m = 0; m < 4; ++m) {
            f32x4 ao[4][4];
            zero_acc<4>(ao);
            int ldo; const bf16_t* Ao = brA(m, tm, ldo);
            const bf16_t* Bo = Wt_br + ((size_t)m * 1024 + tn * 128) * 512;
            const int mn = (m < 3) ? m + 1 : 0;
            const int tmx = (m < 3) ? tm : tmn, tnx = (m < 3) ? tn : tnn;
            int ldn; const bf16_t* An = brA(mn, tmx, ldn);
            const bf16_t* Bn = Wt_br + ((size_t)mn * 1024 + tnx * 128) * 512;
            gemm_acc<128>(Ao, ldo, Bo, 512, 512, smem, ao, An, ldn, Bn, 512, !(m == 0 && u == bid), par6);
            {
              EPI4_FOR(128) {
                const int row = tm * 128 + EPI_ROW, n = tn * 128 + EPI4_COL(128);
                const unsigned q = *(const unsigned*)(G8 + (size_t)row * 4096 + m * 1024 + n);
#pragma unroll
                for (int r = 0; r < 4; ++r) yacc[i][j][r] += ao[i][j][r] * ((float)((q >> (8 * r)) & 255u) * (1.f / 255.f));
              }
            }
          }
          {
            f32x4 (&acc)[4][4] = yacc;
            EPI4_FOR(128) {
              const int row = tm * 128 + EPI_ROW, n = tn * 128 + EPI4_COL(128);
              *(uint2*)(Ybr + (size_t)row * 1024 + n) = pack4(acc[i][j]);
            }
          }
        }
      }
      GSYNC();
      {
        int par = 0;
        for (int u = bid; u < 64 * 8; u += nb) {
          int tm, tn; TILE_MAP(u, 64, tm, tn);
          int tmn = tm, tnn = tn; if (u + nb < 64 * 8) TILE_MAP(u + nb, 64, tmn, tnn);
          f32x4 acc[4][4];
          zero_acc<4>(acc);
          gemm_acc<128>(Ybr + (size_t)tm * 128 * 1024, 1024, Wt_out + (size_t)tn * 128 * 1024, 1024, 1024, smem, acc,
                        Ybr + (size_t)tmn * 128 * 1024, 1024, Wt_out + (size_t)tnn * 128 * 1024, 1024, u != bid, par);
          EPI4_FOR(128) {
            const int row = half * TH + tm * 128 + EPI_ROW, n = tn * 128 + EPI4_COL(128);
            float4* xp = (float4*)(X + (size_t)row * 1024 + n);
            float4 xv = *xp; xv.x += acc[i][j][0]; xv.y += acc[i][j][1]; xv.z += acc[i][j][2]; xv.w += acc[i][j][3];
            *xp = xv;
          }
        }
      }
      GSYNC();
    }

    {
      transpose_all(p.in[42] + (size_t)l * 1024 * 1024, 1024, 1024, 1024, Wt_xq, bid, nb, smem);
      transpose_all(p.in[44] + (size_t)l * 1024 * 1024, 1024, 1024, 1024, Wt_xo, bid, nb, smem);
      transpose_all(p.in[46] + (size_t)l * 1024 * 5632, 5632, 1024, 5632, Wt_gu, bid, nb, smem);
      transpose_all(p.in[49] + (size_t)l * 2816 * 1024, 1024, 2816, 1024, Wt_down, bid, nb, smem);
      rmsnorm_rows(X, p.in[40] + l * 1024, Hb, nullptr, T_ALL, bid, nb);
    }
    GSYNC();
    {
      const float qs = 0.0625f * LOG2E;
      int par = 0;
      for (int u = bid; u < 128 * 8; u += nb) {
        int tm, tn; TILE_MAP(u, 128, tm, tn);
        int tmn = tm, tnn = tn; if (u + nb < 128 * 8) TILE_MAP(u + nb, 128, tmn, tnn);
        f32x4 acc[4][4];
        zero_acc<4>(acc);
        gemm_acc<128>(Hb + (size_t)tm * 128 * 1024, 1024, Wt_xq + (size_t)tn * 128 * 1024, 1024, 1024, smem, acc,
                      Hb + (size_t)tmn * 128 * 1024, 1024, Wt_xq + (size_t)tnn * 128 * 1024, 1024, u != bid, par);
        EPI4_FOR(128) {
          const int row = tm * 128 + EPI_ROW, n = tn * 128 + EPI4_COL(128);
          *(uint2*)(Qx + (size_t)row * 1024 + n) = pack4(acc[i][j] * qs);
        }
      }
    }
    GSYNC();
    {
      for (int u = bid; u < 1024; u += nb) {
        const int dvh = u & 1, hh = (u >> 1) & 3, qt = (u >> 3) & 31, b = u >> 8;
        attn_item<256, false>(Qx + (size_t)b * SEQ * 1024 + hh * 256, 1024, Kx + (size_t)(b * 4 + hh) * 65536, 256,
                              VxT + (size_t)(b * 4 + hh) * 65536 + (size_t)dvh * 128 * 256, 256, 4, qt * 128,
                              Ox + (size_t)b * SEQ * 1024 + hh * 256 + dvh * 128, 1024, smem);
      }
    }
    GSYNC();
    {
      int par = 0;
      for (int u = bid; u < 128 * 8; u += nb) {
        int tm, tn; TILE_MAP(u, 128, tm, tn);
        int tmn = tm, tnn = tn; if (u + nb < 128 * 8) TILE_MAP(u + nb, 128, tmn, tnn);
        f32x4 acc[4][4];
        zero_acc<4>(acc);
        gemm_acc<128>(Ox + (size_t)tm * 128 * 1024, 1024, Wt_xo + (size_t)tn * 128 * 1024, 1024, 1024, smem, acc,
                      Ox + (size_t)tmn * 128 * 1024, 1024, Wt_xo + (size_t)tnn * 128 * 1024, 1024, u != bid, par);
        EPI4_FOR(128) {
          const int row = tm * 128 + EPI_ROW, n = tn * 128 + EPI4_COL(128);
          float4* xp = (float4*)(X + (size_t)row * 1024 + n);
          float4 xv = *xp; xv.x += acc[i][j][0]; xv.y += acc[i][j][1]; xv.z += acc[i][j][2]; xv.w += acc[i][j][3];
          *xp = xv;
        }
      }
    }
    GSYNC();
    rmsnorm_rows(X, p.in[45] + l * 1024, Hb, nullptr, T_ALL, bid, nb);
    GSYNC();
    for (int half = 0; half < 2; ++half) {
      const bf16_t* Hh = Hb + (size_t)half * TH * 1024;
      int par13 = 0;
      for (int u = bid; u < 64 * 44; u += nb) {
        int tm, tn; TILE_MAP(u, 64, tm, tn);
        int tmn = tm, tnn = tn; if (u + nb < 64 * 44) TILE_MAP(u + nb, 64, tmn, tnn);
        f32x4 acc[4][4];
        zero_acc<4>(acc);
        gemm_acc<128>(Hh + (size_t)tm * 128 * 1024, 1024, Wt_gu + (size_t)tn * 128 * 1024, 1024, 1024, smem, acc,
                      Hh + (size_t)tmn * 128 * 1024, 1024, Wt_gu + (size_t)tnn * 128 * 1024, 1024, u != bid, par13);
        EPI4_FOR(128) {
          const int row = tm * 128 + EPI_ROW, n = tn * 128 + EPI4_COL(128);
          *(uint2*)(GU + (size_t)row * 5632 + n) = pack4(acc[i][j]);
        }
      }
      GSYNC();
      {
      PHASE_IDS
        const float* cw = p.in[47] + (size_t)l * 3 * D_FF;
        const float* cb = p.in[48] + (size_t)l * D_FF;
        for (int e = bid * 256 + tid; e < TH * 352; e += nb * 256) {
          const int tk = e / 352, c0 = (e % 352) * 8;
          const int s = tk & (SEQ - 1);
          const bf16_t* gp = GU + (size_t)tk * 5632 + c0;
          const uint4 g2 = *(const uint4*)gp;
          uint4 g1 = uint4{0, 0, 0, 0}, g0 = uint4{0, 0, 0, 0};
          if (s >= 1) g1 = *(const uint4*)(gp - 5632);
          if (s >= 2) g0 = *(const uint4*)(gp - 2 * 5632);
          const uint4 uu = *(const uint4*)(gp + D_FF);
          const unsigned a2[4] = {g2.x, g2.y, g2.z, g2.w}, a1[4] = {g1.x, g1.y, g1.z, g1.w}, a0[4] = {g0.x, g0.y, g0.z, g0.w};
          const unsigned au[4] = {uu.x, uu.y, uu.z, uu.w};
          float o[8];
#pragma unroll
          for (int q = 0; q < 8; ++q) {
            const bool hi = q & 1;
            const float x2 = hi ? bfhi(a2[q >> 1]) : bflo(a2[q >> 1]);
            const float x1 = hi ? bfhi(a1[q >> 1]) : bflo(a1[q >> 1]);
            const float x0 = hi ? bfhi(a0[q >> 1]) : bflo(a0[q >> 1]);
            const float up = hi ? bfhi(au[q >> 1]) : bflo(au[q >> 1]);
            const int c = c0 + q;
            const float gv = cw[c] * x0 + cw[D_FF + c] * x1 + cw[2 * D_FF + c] * x2 + cb[c];
            o[q] = gv * sigm(gv) * up;
          }
          uint4 ov; ov.x = pack2(o[0], o[1]); ov.y = pack2(o[2], o[3]); ov.z = pack2(o[4], o[5]); ov.w = pack2(o[6], o[7]);
          *(uint4*)(GU + (size_t)tk * 5632 + D_FF + c0) = ov;
        }
      }
      GSYNC();
      int par15 = 0;
      for (int u = bid; u < 64 * 8; u += nb) {
        int tm, tn; TILE_MAP(u, 64, tm, tn);
        int tmn = tm, tnn = tn; if (u + nb < 64 * 8) TILE_MAP(u + nb, 64, tmn, tnn);
        f32x4 acc[4][4];
        zero_acc<4>(acc);
        gemm_acc<128>(GU + (size_t)tm * 128 * 5632 + D_FF, 5632, Wt_down + (size_t)tn * 128 * 2816, 2816, 2816, smem, acc,
                      GU + (size_t)tmn * 128 * 5632 + D_FF, 5632, Wt_down + (size_t)tnn * 128 * 2816, 2816, u != bid, par15);
        EPI4_FOR(128) {
          const int row = half * TH + tm * 128 + EPI_ROW, n = tn * 128 + EPI4_COL(128);
          float4* xp = (float4*)(X + (size_t)row * 1024 + n);
          float4 xv = *xp; xv.x += acc[i][j][0]; xv.y += acc[i][j][1]; xv.z += acc[i][j][2]; xv.w += acc[i][j][3];
          *xp = xv;
        }
      }
      GSYNC();
    }
  }

  {
      PHASE_IDS
    const float* g = p.in[50];
    for (int r = bid * 4 + wave; r < T_ALL; r += nb * 4) {
      float4* xr = (float4*)(X + (size_t)r * 1024);
      float4 v[4]; float ss = 0.f;
#pragma unroll
      for (int i = 0; i < 4; ++i) { v[i] = xr[lane + 64 * i]; ss += v[i].x * v[i].x + v[i].y * v[i].y + v[i].z * v[i].z + v[i].w * v[i].w; }
      ss = wave_sum(ss);
      const float rs = rsqrtf(ss * (1.f / 1024.f) + 1e-6f);
#pragma unroll
      for (int i = 0; i < 4; ++i) {
        const float4 gg = ((const float4*)g)[lane + 64 * i];
        xr[lane + 64 * i] = float4{v[i].x * rs * gg.x, v[i].y * rs * gg.y, v[i].z * rs * gg.z, v[i].w * rs * gg.w};
      }
    }
  }
}

extern "C" void kernel_launch(void* const* d_in, const int* in_sizes, int n_in, void* d_out, int out_size, void* d_ws, size_t ws_size,
                              hipStream_t stream) {
  static int grid_blocks = 0;
  if (!grid_blocks) {
    int dev = 0, cus = 0, per_cu = 0;
    hipGetDevice(&dev);
    hipDeviceGetAttribute(&cus, hipDeviceAttributeMultiprocessorCount, dev);
    hipOccupancyMaxActiveBlocksPerMultiprocessor(&per_cu, mega_kernel, 256, 0);
    if (per_cu > 2) per_cu = 2;
    if (per_cu < 1) per_cu = 1;
    grid_blocks = cus * per_cu;
  }
  if (ws_size < WS_NEED) fprintf(stderr, "workspace too small: %zu < %zu\n", ws_size, (size_t)WS_NEED);
  Params p{};
  for (int i = 0; i < 51; ++i) p.in[i] = (const float*)d_in[i];
  p.pos = (const int*)d_in[2];
  p.out = (float*)d_out;
  p.ws = (char*)d_ws;
  hipMemsetAsync((char*)d_ws + OFF_BAR, 0, 16384, stream);
  void* args[] = {&p};
  hipError_t e = hipLaunchCooperativeKernel((void*)mega_kernel, dim3(grid_blocks), dim3(256), args, 0, stream);
  if (e != hipSuccess) fprintf(stderr, "cooperative launch failed: %s (grid %d)\n", hipGetErrorString(e), grid_blocks);
}
```

```cpp
#include <hip/hip_runtime.h>
#include <hip/hip_cooperative_groups.h>
#include <cstdio>
#include <cstdint>
namespace cg = cooperative_groups;

typedef unsigned short bf16_t;
using bf16x8 = __attribute__((ext_vector_type(8))) short;
using s16x4 = __attribute__((ext_vector_type(4))) short;
using f32x4 = __attribute__((ext_vector_type(4))) float;
using f32x16 = __attribute__((ext_vector_type(16))) float;
using u32x4 = __attribute__((ext_vector_type(4))) unsigned;
#define DI __device__ __forceinline__

constexpr int T_ALL = 16384, SEQ = 4096, DM = 1024, TH = 8192;
constexpr int P_IN = 8896, GATE_OFF = 4800;
constexpr int PLD = 4864;
constexpr int PC_HG = 512, PC_S5 = 2560, PC_RW = 3072;
constexpr int D_FF = 2816;

constexpr size_t al256(size_t x) { return (x + 255) & ~(size_t)255; }
constexpr size_t OFF_WIN = 0;
constexpr size_t OFF_WQ = OFF_WIN + al256((size_t)P_IN * 1024 * 2);
constexpr size_t OFF_WBR = OFF_WQ + al256((size_t)768 * 256 * 2);
constexpr size_t OFF_WOUT = OFF_WBR + al256((size_t)4 * 1024 * 512 * 2);
constexpr size_t OFF_WGLU = OFF_WOUT + al256((size_t)1024 * 1024 * 2);
constexpr size_t OFF_WWUP = OFF_WGLU + al256((size_t)512 * 512 * 2);
constexpr size_t OFF_WAUP = OFF_WWUP + al256((size_t)512 * 64 * 2);
constexpr size_t OFF_WGUP = OFF_WAUP + al256((size_t)512 * 64 * 2);
constexpr size_t OFF_WV = OFF_WGUP + al256((size_t)512 * 128 * 2);
constexpr size_t OFF_WXKV = OFF_WV + al256((size_t)512 * 1024 * 2);
constexpr size_t OFF_S5AB = OFF_WXKV + al256((size_t)2048 * 1024 * 2);
constexpr size_t OFF_S5BB = OFF_S5AB + al256((size_t)32 * 64 * 2 * 4);
constexpr size_t OFF_H = OFF_S5BB + al256((size_t)32 * 64 * 32 * 4);
constexpr size_t OFF_VFIRST = OFF_H + al256((size_t)T_ALL * 1024 * 2);
constexpr size_t OFF_KX = OFF_VFIRST + al256((size_t)T_ALL * 512 * 2);
constexpr size_t OFF_VXT = OFF_KX + al256((size_t)16 * 256 * 256 * 2);
constexpr size_t OFF_HM = OFF_VXT + al256((size_t)16 * 256 * 256 * 2);
constexpr size_t OFF_COS = OFF_HM + al256((size_t)1024 * 1024 * 2);
constexpr size_t OFF_SIN = OFF_COS + al256((size_t)TH * 32 * 4);
constexpr size_t OFF_BAR = OFF_SIN + al256((size_t)TH * 32 * 4);
constexpr size_t OFF_REG = OFF_BAR + 16384;
constexpr size_t R_P = OFF_REG;
constexpr size_t R_CQN = R_P + al256((size_t)TH * PLD * 2);
constexpr size_t R_QP = R_CQN + (size_t)TH * 256 * 2;
constexpr size_t R_KVLAT = R_QP + al256((size_t)TH * 768 * 2);
constexpr size_t R_VT = R_KVLAT + al256((size_t)TH * 192 * 2);
constexpr size_t R_RKV = R_VT + al256((size_t)2 * 128 * 4096 * 2);
constexpr size_t R_YRW = R_RKV + al256((size_t)TH * 1536 * 2);
constexpr size_t R_ZS5 = R_YRW + al256((size_t)TH * 512 * 2);
constexpr size_t R_ALORA = R_ZS5 + al256((size_t)TH * 512 * 2);
constexpr size_t R_G8 = R_ALORA;
constexpr size_t R_END1 = R_G8 + al256((size_t)TH * 4096);
static_assert(R_END1 <= ((size_t)256 << 20), "workspace plan exceeds the guaranteed 256 MiB");
constexpr size_t R_YBR = R_CQN;
constexpr size_t R_WXQ = OFF_REG;
constexpr size_t R_WXO = R_WXQ + al256((size_t)1024 * 1024 * 2);
constexpr size_t R_WGU = R_WXO + al256((size_t)1024 * 1024 * 2);
constexpr size_t R_WDOWN = R_WGU + al256((size_t)5632 * 1024 * 2);
constexpr size_t R_QX = R_WDOWN + al256((size_t)1024 * 2816 * 2);
constexpr size_t R_OX = R_QX + al256((size_t)T_ALL * 1024 * 2);
constexpr size_t R_GU = R_QX;
constexpr size_t R_END2 = R_GU + al256((size_t)TH * 5632 * 2);
constexpr size_t WS_NEED = (R_END1 > R_END2 ? R_END1 : R_END2);

constexpr int SMEM_BYTES = 73728;

struct Params {
  const float* in[51];
  const int* pos;
  float* out;
  char* ws;
};

DI bf16_t f2bf(float x) { return __builtin_bit_cast(unsigned short, (__bf16)x); }
DI float bf2f(bf16_t b) { return __uint_as_float(((unsigned)b) << 16); }
typedef __bf16 bf16v2_t __attribute__((ext_vector_type(2)));
typedef float f32v2_t __attribute__((ext_vector_type(2)));
DI unsigned pack2(float a, float b) { const f32v2_t v = {a, b}; return __builtin_bit_cast(unsigned, __builtin_convertvector(v, bf16v2_t)); }
DI float bflo(unsigned u) { return __uint_as_float(u << 16); }
DI float bfhi(unsigned u) { return __uint_as_float(u & 0xffff0000u); }
DI float sigm(float x) { return __builtin_amdgcn_rcpf(1.f + __expf(-x)); }
template <int CTRL> DI float dppf(float v) {
  return __builtin_bit_cast(float, __builtin_amdgcn_update_dpp(0, __builtin_bit_cast(int, v), CTRL, 0xf, 0xf, false));
}
DI float red8(float v) { v += dppf<0xB1>(v); v += dppf<0x4E>(v); v += dppf<0x141>(v); return v; }
DI float red16(float v) { v = red8(v); v += dppf<0x140>(v); return v; }
DI int TID() { int t = threadIdx.x; asm volatile("" : "+v"(t)); return t; }
#define PHASE_IDS const int tid = TID(); const int lane = tid & 63, wave = tid >> 6; (void)lane; (void)wave;
DI const bf16_t* uniform_ptr(const bf16_t* p) {
  const unsigned long long v = (unsigned long long)p;
  const unsigned lo = __builtin_amdgcn_readfirstlane((unsigned)v), hi = __builtin_amdgcn_readfirstlane((unsigned)(v >> 32));
  return (const bf16_t*)(((unsigned long long)hi << 32) | lo);
}
DI float wave_sum(float v) { for (int o = 32; o > 0; o >>= 1) v += __shfl_xor(v, o); return v; }


#define XB_TMO      128
#define XB_XCNT(j)  (256  + 64 * (j))
#define XB_XSUB(j)  (1280 + 64 * (j))
#define XB_XGEN(j)  (2304 + 64 * (j))
#define XB_TOP      3328
#define XB_TOPGEN   3392
#define XCD_BAR_WORDS 3456
#define XB_SPIN_CAP (1u << 22)
#define LAS __attribute__((address_space(3)))
DI unsigned xb_ld(unsigned* p) { return __hip_atomic_load(p, __ATOMIC_RELAXED, __HIP_MEMORY_SCOPE_AGENT); }
DI unsigned xb_add(unsigned* p, unsigned v) { return __hip_atomic_fetch_add(p, v, __ATOMIC_RELAXED, __HIP_MEMORY_SCOPE_AGENT); }
DI unsigned xb_xcc_id() { return (unsigned)__builtin_amdgcn_s_getreg((3 << 11) | 20) & 0xFu; }
#define XB_SPIN(cond, bar) do { unsigned _sp = 0; while (cond) { __builtin_amdgcn_s_sleep(1); \
    if ((++_sp & 255u) == 0u) { if (xb_ld(&(bar)[XB_TMO])) break; if (_sp > XB_SPIN_CAP) { atomicAdd(&(bar)[XB_TMO], 1u); break; } } } } while (0)
struct XcdBarrier { unsigned* bar; unsigned x; volatile LAS unsigned* st; };
DI XcdBarrier xcd_barrier_post(unsigned* bar, volatile LAS unsigned* st) {
  XcdBarrier b; b.bar = bar; b.x = xb_xcc_id(); b.st = st;
  if (threadIdx.x == 0) (void)xb_add(&bar[XB_XCNT(b.x)], 1u);
  return b;
}
DI void xcd_barrier_complete(unsigned* bar, unsigned x, unsigned& nloc, unsigned& nx) {
  const unsigned G = gridDim.x * gridDim.y * gridDim.z;
  unsigned sum, cnt, mine, sp = 0u;
  for (;;) {
    sum = 0u; cnt = 0u; mine = 0u;
#pragma unroll
    for (unsigned j = 0; j < 16; ++j) { const unsigned c = xb_ld(&bar[XB_XCNT(j)]); sum += c; cnt += (c > 0u) ? 1u : 0u; mine = (j == x) ? c : mine; }
    if (sum == G) break;
    __builtin_amdgcn_s_sleep(1);
    if ((++sp & 255u) == 0u) { if (xb_ld(&bar[XB_TMO])) break; if (sp > XB_SPIN_CAP) { atomicAdd(&bar[XB_TMO], 1u); break; } }
  }
  nloc = mine > 0u ? mine : 1u; nx = cnt > 0u ? cnt : 1u;
}
DI void xcd_barrier(const XcdBarrier& b) {
  asm volatile("s_waitcnt vmcnt(0)" ::: "memory");
  __syncthreads();
  if (threadIdx.x == 0) {
    unsigned* bar = b.bar;
    __builtin_amdgcn_s_waitcnt(0);
    unsigned nloc = b.st[0], nx = b.st[1];
    if (nloc == 0u) { xcd_barrier_complete(bar, b.x, nloc, nx); b.st[0] = nloc; b.st[1] = nx; }
    const unsigned old = xb_add(&bar[XB_XSUB(b.x)], 1u);
    const unsigned gen = old / nloc;
    if (old + 1u == (gen + 1u) * nloc) {
      __builtin_amdgcn_fence(__ATOMIC_RELEASE, "agent");
      asm volatile("s_waitcnt vmcnt(0)" ::: "memory");
      const unsigned og = xb_add(&bar[XB_TOP], 1u);
      const unsigned tg = og / nx;
      if (og + 1u == (tg + 1u) * nx) xb_add(&bar[XB_TOPGEN], 1u);
      else XB_SPIN(xb_ld(&bar[XB_TOPGEN]) == tg, bar);
      __builtin_amdgcn_fence(__ATOMIC_ACQUIRE, "agent");
      xb_add(&bar[XB_XGEN(b.x)], 1u);
      asm volatile("s_waitcnt vmcnt(0)" ::: "memory");
    } else {
      XB_SPIN(xb_ld(&bar[XB_XGEN(b.x)]) == gen, bar);
      __builtin_amdgcn_fence(__ATOMIC_ACQUIRE, "agent");
      asm volatile("s_waitcnt vmcnt(0)" ::: "memory");
    }
  }
  __syncthreads();
}

#define GLOAD16(dst, ptr) asm volatile("global_load_dwordx4 %0, %1, off" : "=v"(dst) : "v"(ptr))
template <int BN>
DI void gemm_acc(const bf16_t* __restrict__ A, int lda, const bf16_t* __restrict__ Bt, int ldb, int K, char* smem,
                 f32x4 (&acc)[4][BN / 32], const bf16_t* __restrict__ An, int ldan, const bf16_t* __restrict__ Bn, int ldbn,
                 bool pre, int& par) {
  constexpr int A_EL = 128 * 72, B_EL = BN * 72, BUF_EL = A_EL + B_EL;
  constexpr int NJ = BN / 32, BCH = BN / 32;
  bf16_t* sm = (bf16_t*)smem;
  const int tid = TID(), lane = tid & 63, wave = tid >> 6;
  const int wm = wave >> 1, wn = wave & 1, l16 = lane & 15, quad = lane >> 4;
  const int crow = tid >> 3, ccol = (tid & 7) * 8;
  u32x4 ra[4], rb[BCH];
  const bf16_t* Ap = A + (size_t)crow * lda + ccol;
  const bf16_t* Bp = Bt + (size_t)crow * ldb + ccol;
  const bf16_t* Apn = An + (size_t)crow * ldan + ccol;
  const bf16_t* Bpn = Bn + (size_t)crow * ldbn + ccol;
  const int nk = K >> 6;
#define GEMM_ISSUE(ap_, sa_, bp_, sb_)                                                            \
  {                                                                                               \
    _Pragma("unroll") for (int i = 0; i < 4; ++i) GLOAD16(ra[i], (ap_) + (size_t)(32 * i) * (sa_));      \
    _Pragma("unroll") for (int i = 0; i < BCH; ++i) GLOAD16(rb[i], (bp_) + (size_t)(32 * i) * (sb_));    \
  }
#define GEMM_LAND(buf_)                                                                           \
  {                                                                                               \
    if constexpr (BCH == 4)                                                                       \
      asm volatile("s_waitcnt vmcnt(0)" : "+v"(ra[0]), "+v"(ra[1]), "+v"(ra[2]), "+v"(ra[3]), "+v"(rb[0]), "+v"(rb[1]), "+v"(rb[2]), "+v"(rb[3])); \
    else                                                                                          \
      asm volatile("s_waitcnt vmcnt(0)" : "+v"(ra[0]), "+v"(ra[1]), "+v"(ra[2]), "+v"(ra[3]), "+v"(rb[0]), "+v"(rb[1])); \
    bf16_t* sa_ = sm + (buf_) * BUF_EL; bf16_t* sb_ = sa_ + A_EL;                                 \
    _Pragma("unroll") for (int i = 0; i < 4; ++i) *(u32x4*)(sa_ + (crow + 32 * i) * 72 + ccol) = ra[i];   \
    _Pragma("unroll") for (int i = 0; i < BCH; ++i) *(u32x4*)(sb_ + (crow + 32 * i) * 72 + ccol) = rb[i]; \
  }
  if (!pre) {
    GEMM_ISSUE(Ap, lda, Bp, ldb);
    GEMM_LAND(par);
    __syncthreads();
  }
  for (int kt = 0; kt < nk; ++kt) {
    {
      const bool inner = (kt + 1 < nk);
      const bf16_t* ap = inner ? Ap + ((kt + 1) << 6) : Apn;
      const bf16_t* bp = inner ? Bp + ((kt + 1) << 6) : Bpn;
      const int sa = inner ? lda : ldan, sb = inner ? ldb : ldbn;
      GEMM_ISSUE(ap, sa, bp, sb);
    }
    __builtin_amdgcn_sched_barrier(0);
    {
      const bf16_t* sa = sm + ((par + kt) & 1) * BUF_EL; const bf16_t* sb = sa + A_EL;
#pragma unroll
      for (int ks = 0; ks < 2; ++ks) {
        bf16x8 a[4], b[NJ];
#pragma unroll
        for (int i = 0; i < 4; ++i) a[i] = *(const bf16x8*)(sa + (wm * 64 + i * 16 + l16) * 72 + ks * 32 + quad * 8);
#pragma unroll
        for (int j = 0; j < NJ; ++j) b[j] = *(const bf16x8*)(sb + (wn * (BN / 2) + j * 16 + l16) * 72 + ks * 32 + quad * 8);
        __builtin_amdgcn_s_setprio(1);
#pragma unroll
        for (int i = 0; i < 4; ++i)
#pragma unroll
          for (int j = 0; j < NJ; ++j) acc[i][j] = __builtin_amdgcn_mfma_f32_16x16x32_bf16(b[j], a[i], acc[i][j], 0, 0, 0);
        __builtin_amdgcn_s_setprio(0);
      }
    }
    __builtin_amdgcn_sched_barrier(0);
    GEMM_LAND((par + kt + 1) & 1);
    __syncthreads();
  }
  par = (par + nk) & 1;
#undef GEMM_ISSUE
#undef GEMM_LAND
}
template <int BN>
DI void gemm_acc(const bf16_t* __restrict__ A, int lda, const bf16_t* __restrict__ Bt, int ldb, int K, char* smem,
                 f32x4 (&acc)[4][BN / 32]) {
  int par = 0;
  gemm_acc<BN>(A, lda, Bt, ldb, K, smem, acc, A, lda, Bt, ldb, false, par);
}
template <int NJ> DI void zero_acc(f32x4 (&acc)[4][NJ]) {
#pragma unroll
  for (int i = 0; i < 4; ++i)
#pragma unroll
    for (int j = 0; j < NJ; ++j) acc[i][j] = f32x4{0.f, 0.f, 0.f, 0.f};
}
#define EPI_FOR(BN_)                                                                         \
  const int _t = TID(); const int _lane = _t & 63, _wave = _t >> 6;                              \
  const int _wm = _wave >> 1, _wn = _wave & 1, _l16 = _lane & 15, _quad = _lane >> 4;        \
  _Pragma("unroll") for (int i = 0; i < 4; ++i)                                              \
  _Pragma("unroll") for (int j = 0; j < (BN_) / 32; ++j)                                     \
  _Pragma("unroll") for (int r = 0; r < 4; ++r)
#define EPI_ROW (_wm * 64 + i * 16 + _l16)
#define EPI_COL(BN_) (_wn * ((BN_) / 2) + j * 16 + _quad * 4 + r)
#define EPI4_FOR(BN_)                                                                        \
  const int _t = TID(); const int _lane = _t & 63, _wave = _t >> 6;                          \
  const int _wm = _wave >> 1, _wn = _wave & 1, _l16 = _lane & 15, _quad = _lane >> 4;        \
  _Pragma("unroll") for (int i = 0; i < 4; ++i)                                              \
  _Pragma("unroll") for (int j = 0; j < (BN_) / 32; ++j)
#define EPI4_COL(BN_) (_wn * ((BN_) / 2) + j * 16 + _quad * 4)
DI uint2 pack4(f32x4 v) { uint2 o; o.x = pack2(v[0], v[1]); o.y = pack2(v[2], v[3]); return o; }
DI f32x4 unpack4(uint2 u) { return f32x4{bflo(u.x), bfhi(u.x), bflo(u.y), bfhi(u.y)}; }

DI void transpose_tile(const float* __restrict__ W, int ldw, bf16_t* __restrict__ Wt, int ldt, int k0, int n0, char* smem) {
  float* sm = (float*)smem;
  const int tid = TID();
  __syncthreads();
#pragma unroll
  for (int i = 0; i < 4; ++i) {
    const int k = (tid >> 4) + 16 * i, n4 = (tid & 15) * 4;
    const float4 v = *(const float4*)(W + (size_t)(k0 + k) * ldw + n0 + n4);
    sm[k * 65 + n4 + 0] = v.x; sm[k * 65 + n4 + 1] = v.y; sm[k * 65 + n4 + 2] = v.z; sm[k * 65 + n4 + 3] = v.w;
  }
  __syncthreads();
  const int n = tid >> 2, ks = (tid & 3) * 16;
  unsigned u[8];
#pragma unroll
  for (int e = 0; e < 8; ++e) u[e] = pack2(sm[(ks + 2 * e) * 65 + n], sm[(ks + 2 * e + 1) * 65 + n]);
  uint4* dst = (uint4*)(Wt + (size_t)(n0 + n) * ldt + k0 + ks);
  dst[0] = uint4{u[0], u[1], u[2], u[3]};
  dst[1] = uint4{u[4], u[5], u[6], u[7]};
}
DI void transpose_all(const float* W, int ldw, int K, int N, bf16_t* Wt, int bid, int nb, char* smem) {
  const int tk = K >> 6, tn = N >> 6;
  for (int t = bid; t < tk * tn; t += nb) transpose_tile(W, ldw, Wt, K, (t % tk) * 64, (t / tk) * 64, smem);
}

DI void rmsnorm_rows(const float* __restrict__ x, const float* __restrict__ g, bf16_t* __restrict__ h, float* xcopy, int rows,
                     int bid, int nb) {
  const int lane = TID() & 63, wave = TID() >> 6;
  for (int r = bid * 4 + wave; r < rows; r += nb * 4) {
    const float4* xr = (const float4*)(x + (size_t)r * 1024);
    float4 v[4]; float ss = 0.f;
#pragma unroll
    for (int i = 0; i < 4; ++i) { v[i] = xr[lane + 64 * i]; ss += v[i].x * v[i].x + v[i].y * v[i].y + v[i].z * v[i].z + v[i].w * v[i].w; }
    ss = wave_sum(ss);
    const float rs = rsqrtf(ss * (1.f / 1024.f) + 1e-6f);
#pragma unroll
    for (int i = 0; i < 4; ++i) {
      const float4 gg = ((const float4*)g)[lane + 64 * i];
      uint2 o; o.x = pack2(v[i].x * rs * gg.x, v[i].y * rs * gg.y); o.y = pack2(v[i].z * rs * gg.z, v[i].w * rs * gg.w);
      *(uint2*)(h + (size_t)r * 1024 + (lane + 64 * i) * 4) = o;
      if (xcopy) ((float4*)(xcopy + (size_t)r * 1024))[lane + 64 * i] = v[i];
    }
  }
}

template <int DQK, bool CAUSAL>
DI void attn_item(const bf16_t* __restrict__ Q, int ldq, const bf16_t* __restrict__ Kp, int ldk, const bf16_t* __restrict__ VT, int ldvt,
                  int ntiles, int q0, bf16_t* __restrict__ out, int ldo, char* smem) {
  constexpr int KS = DQK + 8, NS = DQK / 16, KCH = DQK / 8;
  bf16_t* Ks = (bf16_t*)smem;
  bf16_t* Vs = Ks + 64 * KS;
  const int tid = TID(), lane = tid & 63, wave = tid >> 6, ql = lane & 31, hh = lane >> 5;
  const int qrow = q0 + wave * 32 + ql;
  bf16x8 bq[NS];
#pragma unroll
  for (int s = 0; s < NS; ++s) bq[s] = *(const bf16x8*)(Q + (size_t)qrow * ldq + s * 16 + hh * 8);
  f32x16 ot[4];
#pragma unroll
  for (int d = 0; d < 4; ++d)
#pragma unroll
    for (int i = 0; i < 16; ++i) ot[d][i] = 0.f;
  float mrun = -INFINITY, lrun = 0.f;
  for (int kt = 0; kt < ntiles; ++kt) {
    __syncthreads();
    for (int c = tid; c < 64 * KCH; c += 256) {
      const int row = c / KCH, cc = c % KCH;
      *(uint4*)(Ks + row * KS + cc * 8) = *(const uint4*)(Kp + (size_t)(kt * 64 + row) * ldk + cc * 8);
    }
#pragma unroll
    for (int c0 = 0; c0 < 4; ++c0) {
      const int c = tid + c0 * 256, row = c >> 3, cc = c & 7;
      *(uint4*)(Vs + row * 72 + cc * 8) = *(const uint4*)(VT + (size_t)row * ldvt + kt * 64 + cc * 8);
    }
    __syncthreads();
    f32x16 st[2];
#pragma unroll
    for (int kb = 0; kb < 2; ++kb) {
#pragma unroll
      for (int i = 0; i < 16; ++i) st[kb][i] = 0.f;
#pragma unroll
      for (int s = 0; s < NS; ++s) {
        const bf16x8 a = *(const bf16x8*)(Ks + (kb * 32 + ql) * KS + s * 16 + hh * 8);
        st[kb] = __builtin_amdgcn_mfma_f32_32x32x16_bf16(a, bq[s], st[kb], 0, 0, 0);
      }
    }
    float mx = -INFINITY;
#pragma unroll
    for (int kb = 0; kb < 2; ++kb)
#pragma unroll
      for (int i = 0; i < 16; ++i) {
        if (CAUSAL) {
          const int key = kt * 64 + kb * 32 + (i & 3) + 8 * (i >> 2) + 4 * hh;
          if (key > qrow) st[kb][i] = -INFINITY;
        }
        mx = fmaxf(mx, st[kb][i]);
      }
    mx = fmaxf(mx, __shfl_xor(mx, 32));
    const float mnew = fmaxf(mrun, mx);
    const float alpha = __builtin_amdgcn_exp2f(mrun - mnew);
    float ps = 0.f;
#pragma unroll
    for (int kb = 0; kb < 2; ++kb)
#pragma unroll
      for (int i = 0; i < 16; ++i) { const float pv = __builtin_amdgcn_exp2f(st[kb][i] - mnew); st[kb][i] = pv; ps += pv; }
    ps += __shfl_xor(ps, 32);
    lrun = lrun * alpha + ps;
    mrun = mnew;
#pragma unroll
    for (int d = 0; d < 4; ++d)
#pragma unroll
      for (int i = 0; i < 16; ++i) ot[d][i] *= alpha;
#pragma unroll
    for (int kb = 0; kb < 2; ++kb)
#pragma unroll
      for (int s2 = 0; s2 < 2; ++s2) {
        unsigned pk[4];
#pragma unroll
        for (int e = 0; e < 4; ++e) pk[e] = pack2(st[kb][8 * s2 + 2 * e], st[kb][8 * s2 + 2 * e + 1]);
        const bf16x8 pb = __builtin_bit_cast(bf16x8, uint4{pk[0], pk[1], pk[2], pk[3]});
#pragma unroll
        for (int d = 0; d < 4; ++d) {
          const bf16_t* vp = Vs + (d * 32 + ql) * 72 + kb * 32 + s2 * 16 + hh * 4;
          const s16x4 lo = *(const s16x4*)vp;
          const s16x4 hi = *(const s16x4*)(vp + 8);
          const bf16x8 av = __builtin_shufflevector(lo, hi, 0, 1, 2, 3, 4, 5, 6, 7);
          ot[d] = __builtin_amdgcn_mfma_f32_32x32x16_bf16(av, pb, ot[d], 0, 0, 0);
        }
      }
  }
  const float inv = 1.f / lrun;
#pragma unroll
  for (int d = 0; d < 4; ++d)
#pragma unroll
    for (int g4 = 0; g4 < 4; ++g4) {
      uint2 o; o.x = pack2(ot[d][4 * g4] * inv, ot[d][4 * g4 + 1] * inv); o.y = pack2(ot[d][4 * g4 + 2] * inv, ot[d][4 * g4 + 3] * inv);
      *(uint2*)(out + (size_t)qrow * ldo + d * 32 + 8 * g4 + 4 * hh) = o;
    }
}


template <int DQK, bool CAUSAL>
DI void attn_item_pf(const bf16_t* __restrict__ Q, int ldq, const bf16_t* Kp, int ldk, const bf16_t* VT, int ldvt,
                  int ntiles, int q0, bf16_t* __restrict__ out, int ldo, char* smem) {
  constexpr int KS = DQK + 8, NS = DQK / 16, KCH = DQK / 8;
  bf16_t* Ks = (bf16_t*)smem;
  bf16_t* Vs = Ks + 64 * KS;
  const int tid = TID(), lane = tid & 63, wave = tid >> 6, ql = lane & 31, hh = lane >> 5;
  const int qrow = q0 + wave * 32 + ql;
  bf16x8 bq[NS];
#pragma unroll
  for (int s = 0; s < NS; ++s) bq[s] = *(const bf16x8*)(Q + (size_t)qrow * ldq + s * 16 + hh * 8);
  f32x16 ot[4];
#pragma unroll
  for (int d = 0; d < 4; ++d)
#pragma unroll
    for (int i = 0; i < 16; ++i) ot[d][i] = 0.f;
  float mrun = -INFINITY, lrun = 0.f;
  Kp = uniform_ptr(Kp); VT = uniform_ptr(VT);
  constexpr int KR = KCH / 4;
  static_assert(KR == 6, "prefetch variant is written for DQK = 192");
  u32x4 kreg[KR], vreg[4];
  const unsigned kvoff = (unsigned)(((tid >> 2) * ldk + (tid & 3) * 8) * 2);
  const unsigned vvoff = (unsigned)(((tid >> 3) * ldvt + (tid & 7) * 8) * 2);
#define GLOADS(dst, voff, sbase) asm volatile("global_load_dwordx4 %0, %1, %2" : "=v"(dst) : "v"(voff), "s"(sbase))
#define ATT_ISSUE(kt_)                                                                                        \
  {                                                                                                           \
    _Pragma("unroll") for (int c0 = 0; c0 < KR; ++c0) GLOADS(kreg[c0], kvoff, Kp + (size_t)(kt_) * 64 * ldk + c0 * 32);   \
    _Pragma("unroll") for (int c0 = 0; c0 < 4; ++c0) GLOADS(vreg[c0], vvoff, VT + (size_t)(c0 * 32) * ldvt + (kt_) * 64); \
  }
#define ATT_LAND()                                                                                            \
  {                                                                                                           \
    asm volatile("s_waitcnt vmcnt(0)" : "+v"(kreg[0]), "+v"(kreg[1]), "+v"(kreg[2]), "+v"(kreg[3]), "+v"(kreg[4]), "+v"(kreg[5]), \
                 "+v"(vreg[0]), "+v"(vreg[1]), "+v"(vreg[2]), "+v"(vreg[3]));                                 \
    _Pragma("unroll") for (int c0 = 0; c0 < KR; ++c0) *(u32x4*)(Ks + (tid >> 2) * KS + ((tid & 3) + 4 * c0) * 8) = kreg[c0];   \
    _Pragma("unroll") for (int c0 = 0; c0 < 4; ++c0) *(u32x4*)(Vs + ((tid >> 3) + 32 * c0) * 72 + (tid & 7) * 8) = vreg[c0];   \
  }
  __syncthreads();
  ATT_ISSUE(0);
  ATT_LAND();
  __syncthreads();
  for (int kt = 0; kt < ntiles; ++kt) {
    {
      const int ktn = (kt + 1 < ntiles) ? kt + 1 : kt;
      ATT_ISSUE(ktn);
    }
    __builtin_amdgcn_sched_barrier(0);
    f32x16 st[2];
#pragma unroll
    for (int kb = 0; kb < 2; ++kb) {
#pragma unroll
      for (int i = 0; i < 16; ++i) st[kb][i] = 0.f;
#pragma unroll
      for (int s = 0; s < NS; ++s) {
        const bf16x8 a = *(const bf16x8*)(Ks + (kb * 32 + ql) * KS + s * 16 + hh * 8);
        st[kb] = __builtin_amdgcn_mfma_f32_32x32x16_bf16(a, bq[s], st[kb], 0, 0, 0);
      }
    }
    float mx = -INFINITY;
#pragma unroll
    for (int kb = 0; kb < 2; ++kb)
#pragma unroll
      for (int i = 0; i < 16; ++i) {
        if (CAUSAL) {
          const int key = kt * 64 + kb * 32 + (i & 3) + 8 * (i >> 2) + 4 * hh;
          if (key > qrow) st[kb][i] = -INFINITY;
        }
        mx = fmaxf(mx, st[kb][i]);
      }
    mx = fmaxf(mx, __shfl_xor(mx, 32));
    const float mnew = fmaxf(mrun, mx);
    const float alpha = __builtin_amdgcn_exp2f(mrun - mnew);
    float ps = 0.f;
#pragma unroll
    for (int kb = 0; kb < 2; ++kb)
#pragma unroll
      for (int i = 0; i < 16; ++i) { const float pv = __builtin_amdgcn_exp2f(st[kb][i] - mnew); st[kb][i] = pv; ps += pv; }
    ps += __shfl_xor(ps, 32);
    lrun = lrun * alpha + ps;
    mrun = mnew;
#pragma unroll
    for (int d = 0; d < 4; ++d)
#pragma unroll
      for (int i = 0; i < 16; ++i) ot[d][i] *= alpha;
#pragma unroll
    for (int kb = 0; kb < 2; ++kb)
#pragma unroll
      for (int s2 = 0; s2 < 2; ++s2) {
        unsigned pk[4];
#pragma unroll
        for (int e = 0; e < 4; ++e) pk[e] = pack2(st[kb][8 * s2 + 2 * e], st[kb][8 * s2 + 2 * e + 1]);
        const bf16x8 pb = __builtin_bit_cast(bf16x8, uint4{pk[0], pk[1], pk[2], pk[3]});
#pragma unroll
        for (int d = 0; d < 4; ++d) {
          const bf16_t* vp = Vs + (d * 32 + ql) * 72 + kb * 32 + s2 * 16 + hh * 4;
          const s16x4 lo = *(const s16x4*)vp;
          const s16x4 hi = *(const s16x4*)(vp + 8);
          const bf16x8 av = __builtin_shufflevector(lo, hi, 0, 1, 2, 3, 4, 5, 6, 7);
          ot[d] = __builtin_amdgcn_mfma_f32_32x32x16_bf16(av, pb, ot[d], 0, 0, 0);
        }
      }
    __builtin_amdgcn_sched_barrier(0);
    __syncthreads();
    ATT_LAND();
    __syncthreads();
  }
#undef ATT_ISSUE
#undef ATT_LAND
#undef GLOADS
  const float inv = 1.f / lrun;
#pragma unroll
  for (int d = 0; d < 4; ++d)
#pragma unroll
    for (int g4 = 0; g4 < 4; ++g4) {
      uint2 o; o.x = pack2(ot[d][4 * g4] * inv, ot[d][4 * g4 + 1] * inv); o.y = pack2(ot[d][4 * g4 + 2] * inv, ot[d][4 * g4 + 3] * inv);
      *(uint2*)(out + (size_t)qrow * ldo + d * 32 + 8 * g4 + 4 * hh) = o;
    }
}

DI void rwkv_scan_unit(const Params& p, int l, int u, char* smem) {
  const int tid = TID();
  const int bl = u >> 5, hd = (u >> 2) & 7, rg = u & 3;
  const int kq = tid & 15, g16 = tid >> 4;
  const bf16_t* RKV = (const bf16_t*)(p.ws + R_RKV) + (size_t)bl * SEQ * 1536;
  const bf16_t* Pm = (const bf16_t*)(p.ws + R_P) + (size_t)bl * SEQ * PLD;
  bf16_t* Y = (bf16_t*)(p.ws + R_YRW) + (size_t)bl * SEQ * 512;
  float* sm = (float*)smem;
  constexpr int BUFF = 5 * 1024 + 256 + 32;
  const int kc = hd * 64 + kq * 4;
  const float4 kk_w = *(const float4*)(p.in[27] + l * 512 + kc);
  const float4 ka_w = *(const float4*)(p.in[28] + l * 512 + kc);
  float S0 = 0.f, S1 = 0.f, S2 = 0.f, S3 = 0.f;
  uint2 g_r, g_k, g_w, g_a; bf16_t g_v;
  auto gload = [&](int c) {
    const int tok = c * 16 + g16;
    g_r = *(const uint2*)(RKV + (size_t)tok * 1536 + kc);
    g_k = *(const uint2*)(RKV + (size_t)tok * 1536 + 512 + kc);
    g_v = RKV[(size_t)tok * 1536 + 1024 + hd * 64 + rg * 16 + kq];
    g_w = *(const uint2*)(Pm + (size_t)tok * PLD + PC_RW + kc);
    g_a = *(const uint2*)(Pm + (size_t)tok * PLD + PC_RW + 512 + kc);
  };
  auto derive = [&](int buf) {
    float* b = sm + buf * BUFF;
    const float r[4] = {bflo(g_r.x), bfhi(g_r.x), bflo(g_r.y), bfhi(g_r.y)};
    const float k[4] = {bflo(g_k.x), bfhi(g_k.x), bflo(g_k.y), bfhi(g_k.y)};
    const float w[4] = {bflo(g_w.x), bfhi(g_w.x), bflo(g_w.y), bfhi(g_w.y)};
    const float a[4] = {bflo(g_a.x), bfhi(g_a.x), bflo(g_a.y), bfhi(g_a.y)};
    const float kkw[4] = {kk_w.x, kk_w.y, kk_w.z, kk_w.w};
    const float kaw[4] = {ka_w.x, ka_w.y, ka_w.z, ka_w.w};
    float kk[4], ss = 0.f;
#pragma unroll
    for (int e = 0; e < 4; ++e) { kk[e] = k[e] * kkw[e]; ss += kk[e] * kk[e]; }
    ss = red16(ss);
    const float rn = rsqrtf(ss + 1e-12f);
    float dwr[4], dw[4], dk[4], dn[4], db[4];
    float br = 0.f, khr = 0.f;
#pragma unroll
    for (int e = 0; e < 4; ++e) {
      dw[e] = __expf(-0.6065306597126334f * sigm(w[e]));
      const float kn = kk[e] * rn;
      dn[e] = -kn; db[e] = kn * a[e];
      dk[e] = k[e] * (1.f + (a[e] - 1.f) * kaw[e]);
      dwr[e] = dw[e] * r[e];
      br += db[e] * r[e]; khr += dk[e] * r[e];
    }
    br = red16(br); khr = red16(khr);
#pragma unroll
    for (int e = 0; e < 4; ++e) dwr[e] += dn[e] * br;
    *(float4*)(b + 0 * 1024 + g16 * 64 + kq * 4) = float4{dwr[0], dwr[1], dwr[2], dwr[3]};
    *(float4*)(b + 1 * 1024 + g16 * 64 + kq * 4) = float4{dw[0], dw[1], dw[2], dw[3]};
    *(float4*)(b + 2 * 1024 + g16 * 64 + kq * 4) = float4{dk[0], dk[1], dk[2], dk[3]};
    *(float4*)(b + 3 * 1024 + g16 * 64 + kq * 4) = float4{dn[0], dn[1], dn[2], dn[3]};
    *(float4*)(b + 4 * 1024 + g16 * 64 + kq * 4) = float4{db[0], db[1], db[2], db[3]};
    b[5 * 1024 + g16 * 16 + kq] = bf2f(g_v);
    if (kq == 0) b[5 * 1024 + 256 + g16] = khr;
  };
  __syncthreads();
  gload(0); derive(0);
  __syncthreads();
  constexpr int NC = SEQ / 16;
  for (int c = 0; c < NC; ++c) {
    if (c + 1 < NC) gload(c + 1);
    const float* b = sm + (c & 1) * BUFF;
    float4 nk = *(const float4*)(b + 3 * 1024 + kq * 4);
    float4 w = *(const float4*)(b + 1 * 1024 + kq * 4);
    float4 bb = *(const float4*)(b + 4 * 1024 + kq * 4);
    float4 kh = *(const float4*)(b + 2 * 1024 + kq * 4);
    float4 wr = *(const float4*)(b + 0 * 1024 + kq * 4);
    float v = b[5 * 1024 + g16];
#pragma unroll
    for (int h = 0; h < 2; ++h) {
      float yp[8];
#pragma unroll
      for (int s = 0; s < 8; ++s) {
        const int t = h * 8 + s;
        float4 nk2, w2, bb2, kh2, wr2; float v2;
        if (t < 15) {
          nk2 = *(const float4*)(b + 3 * 1024 + (t + 1) * 64 + kq * 4);
          w2 = *(const float4*)(b + 1 * 1024 + (t + 1) * 64 + kq * 4);
          bb2 = *(const float4*)(b + 4 * 1024 + (t + 1) * 64 + kq * 4);
          kh2 = *(const float4*)(b + 2 * 1024 + (t + 1) * 64 + kq * 4);
          wr2 = *(const float4*)(b + 0 * 1024 + (t + 1) * 64 + kq * 4);
          v2 = b[5 * 1024 + (t + 1) * 16 + g16];
        }
        float sa = S0 * nk.x + S1 * nk.y + S2 * nk.z + S3 * nk.w;
        yp[s] = S0 * wr.x + S1 * wr.y + S2 * wr.z + S3 * wr.w;
        sa = red16(sa);
        S0 = S0 * w.x + sa * bb.x + v * kh.x;
        S1 = S1 * w.y + sa * bb.y + v * kh.y;
        S2 = S2 * w.z + sa * bb.z + v * kh.z;
        S3 = S3 * w.w + sa * bb.w + v * kh.w;
        if (t < 15) { nk = nk2; w = w2; bb = bb2; kh = kh2; wr = wr2; v = v2; }
      }
      const bool b2 = (kq & 4) != 0, b1 = (kq & 2) != 0, b0 = (kq & 1) != 0;
#pragma unroll
      for (int i = 0; i < 8; ++i) yp[i] += dppf<0x128>(yp[i]);
      float q4[4];
#pragma unroll
      for (int i = 0; i < 4; ++i) { const float keep = b2 ? yp[i + 4] : yp[i], send = b2 ? yp[i] : yp[i + 4]; q4[i] = keep + dppf<0x141>(send); }
      float q2[2];
#pragma unroll
      for (int i = 0; i < 2; ++i) { const float keep = b1 ? q4[i + 2] : q4[i], send = b1 ? q4[i] : q4[i + 2]; q2[i] = keep + dppf<0x4E>(send); }
      const float keep = b0 ? q2[1] : q2[0], send = b0 ? q2[0] : q2[1];
      float yv = keep + dppf<0xB1>(send);
      const int tt = h * 8 + (kq & 7);
      yv += b[5 * 1024 + tt * 16 + g16] * b[5 * 1024 + 256 + tt];
      if ((kq >> 3) == h) Y[(size_t)(c * 16 + tt) * 512 + hd * 64 + rg * 16 + g16] = f2bf(yv);
    }
    if (c + 1 < NC) derive((c + 1) & 1);
    __syncthreads();
  }
}

DI void hgrn_scan_unit(const Params& p, int l, int u, char* smem) {
  const int tid = TID();
  const int bl = u >> 5, hd = (u >> 3) & 3, vg = u & 7;
  const int kq = tid & 15, g16 = tid >> 4;
  bf16_t* Pm = (bf16_t*)(p.ws + R_P) + (size_t)bl * SEQ * PLD;
  float* sm = (float*)smem;
  constexpr int BUFF = 2 * 2048 + 256 + 16;
  const int kc = hd * 128 + kq * 8;
  float lb[8];
#pragma unroll
  for (int e = 0; e < 8; ++e) {
    if (l == 0) lb[e] = 0.f;
    else { const float x0 = p.in[9][kc + e], x1 = p.in[9][512 + kc + e]; lb[e] = 1.f / (1.f + expf(x0 - x1)); }
  }
  float S[8];
#pragma unroll
  for (int e = 0; e < 8; ++e) S[e] = 0.f;
  uint4 g_q, g_f; bf16_t g_v;
  const int vcol = PC_HG + 1024 + hd * 128 + vg * 16;
  auto gload = [&](int c) {
    const int tok = c * 16 + g16;
    g_q = *(const uint4*)(Pm + (size_t)tok * PLD + PC_HG + kc);
    g_f = *(const uint4*)(Pm + (size_t)tok * PLD + PC_HG + 512 + kc);
    g_v = Pm[(size_t)tok * PLD + vcol + kq];
  };
  auto derive = [&](int buf) {
    float* b = sm + buf * BUFF;
    const unsigned qu[4] = {g_q.x, g_q.y, g_q.z, g_q.w}, fu[4] = {g_f.x, g_f.y, g_f.z, g_f.w};
    float fq[8], f[8], cs = 0.f;
#pragma unroll
    for (int e = 0; e < 8; ++e) {
      const float q = (e & 1) ? bfhi(qu[e >> 1]) : bflo(qu[e >> 1]);
      const float fx = (e & 1) ? bfhi(fu[e >> 1]) : bflo(fu[e >> 1]);
      f[e] = lb[e] + (1.f - lb[e]) * sigm(fx);
      fq[e] = f[e] * q;
      cs += (1.f - f[e]) * q;
    }
    cs = red16(cs);
    *(float4*)(b + g16 * 128 + kq * 8) = float4{fq[0], fq[1], fq[2], fq[3]};
    *(float4*)(b + g16 * 128 + kq * 8 + 4) = float4{fq[4], fq[5], fq[6], fq[7]};
    *(float4*)(b + 2048 + g16 * 128 + kq * 8) = float4{f[0], f[1], f[2], f[3]};
    *(float4*)(b + 2048 + g16 * 128 + kq * 8 + 4) = float4{f[4], f[5], f[6], f[7]};
    b[4096 + g16 * 16 + kq] = bf2f(g_v);
    if (kq == 0) b[4096 + 256 + g16] = cs;
  };
  __syncthreads();
  gload(0); derive(0);
  __syncthreads();
  constexpr int NC = SEQ / 16;
  for (int c = 0; c < NC; ++c) {
    if (c + 1 < NC) gload(c + 1);
    const float* b = sm + (c & 1) * BUFF;
#pragma unroll
    for (int h = 0; h < 2; ++h) {
      float yp[8];
#pragma unroll
      for (int s = 0; s < 8; ++s) {
        const int t = h * 8 + s;
        const float4 q0 = *(const float4*)(b + t * 128 + kq * 8), q1 = *(const float4*)(b + t * 128 + kq * 8 + 4);
        const float4 f0 = *(const float4*)(b + 2048 + t * 128 + kq * 8), f1 = *(const float4*)(b + 2048 + t * 128 + kq * 8 + 4);
        const float v = b[4096 + t * 16 + g16];
        const float fq[8] = {q0.x, q0.y, q0.z, q0.w, q1.x, q1.y, q1.z, q1.w};
        const float f[8] = {f0.x, f0.y, f0.z, f0.w, f1.x, f1.y, f1.z, f1.w};
        float o = 0.f;
#pragma unroll
        for (int e = 0; e < 8; ++e) { o += S[e] * fq[e]; S[e] = f[e] * (S[e] - v) + v; }
        yp[s] = o;
      }
      const bool b2 = (kq & 4) != 0, b1 = (kq & 2) != 0, b0 = (kq & 1) != 0;
#pragma unroll
      for (int i = 0; i < 8; ++i) yp[i] += dppf<0x128>(yp[i]);
      float q4[4];
#pragma unroll
      for (int i = 0; i < 4; ++i) { const float keep = b2 ? yp[i + 4] : yp[i], send = b2 ? yp[i] : yp[i + 4]; q4[i] = keep + dppf<0x141>(send); }
      float q2[2];
#pragma unroll
      for (int i = 0; i < 2; ++i) { const float keep = b1 ? q4[i + 2] : q4[i], send = b1 ? q4[i] : q4[i + 2]; q2[i] = keep + dppf<0x4E>(send); }
      const float keep = b0 ? q2[1] : q2[0], send = b0 ? q2[0] : q2[1];
      float ov = keep + dppf<0xB1>(send);
      const int tt = h * 8 + (kq & 7);
      ov += b[4096 + tt * 16 + g16] * b[4096 + 256 + tt];
      if ((kq >> 3) == h) Pm[(size_t)(c * 16 + tt) * PLD + vcol + g16] = f2bf(ov);
    }
    if (c + 1 < NC) derive((c + 1) & 1);
    __syncthreads();
  }
}

DI void s5_scan_unit(const Params& p, int l, int u, char* smem) {
  const int tid = TID(), lane = tid & 63, wave = tid >> 6;
  const int idx = u * 4 + wave, bl = idx >> 5, g = idx & 31;
  const bf16_t* Pm = (const bf16_t*)(p.ws + R_P) + (size_t)bl * SEQ * PLD + PC_S5 + g * 16;
  bf16_t* Z = (bf16_t*)(p.ws + R_ZS5) + (size_t)bl * SEQ * 512 + g * 16;
  constexpr int BUS = 132;
  float* buT = (float*)smem + wave * (16 * BUS);
  bf16_t* hist = (bf16_t*)(smem + 4 * 16 * BUS * 4) + wave * (16 * 136);
  const float2 ab = *(const float2*)((const float*)(p.ws + OFF_S5AB) + (g * 64 + lane) * 2);
  const int l16 = lane & 15, quad = lane >> 4;
  bf16x8 bbf[8];
  {
    const float* bbp = (const float*)(p.ws + OFF_S5BB);
#pragma unroll
    for (int jb = 0; jb < 8; ++jb) {
      const int col = jb * 16 + l16, nn = col & 63, im = col >> 6;
      unsigned pk[4] = {0u, 0u, 0u, 0u};
      if (quad < 2) {
        const float* src = bbp + (size_t)(g * 64 + nn) * 32 + im * 16 + quad * 8;
#pragma unroll
        for (int e = 0; e < 4; ++e) pk[e] = pack2(src[2 * e], src[2 * e + 1]);
      }
      bbf[jb] = __builtin_bit_cast(bf16x8, uint4{pk[0], pk[1], pk[2], pk[3]});
    }
  }
  bf16x8 cf[4];
  {
    const float* Cre = p.in[16] + (size_t)l * 32768 + (size_t)(g * 16 + l16) * 64;
    const float* Cim = p.in[17] + (size_t)l * 32768 + (size_t)(g * 16 + l16) * 64;
#pragma unroll
    for (int ks = 0; ks < 4; ++ks) {
      unsigned pk[4];
#pragma unroll
      for (int e = 0; e < 4; ++e) {
        const int k = ks * 32 + quad * 8 + 2 * e;
        const float v0 = (k < 64) ? Cre[k] : -Cim[k - 64];
        const float v1 = (k < 64) ? Cre[k + 1] : -Cim[k + 1 - 64];
        pk[e] = pack2(v0, v1);
      }
      cf[ks] = __builtin_bit_cast(bf16x8, uint4{pk[0], pk[1], pk[2], pk[3]});
    }
  }
  const float dcoef = p.in[18][l * 512 + g * 16 + l16];
  float xr = 0.f, xi = 0.f;
  uint4 ua = uint4{0u, 0u, 0u, 0u};
  bf16_t ue[4];
  auto gload = [&](int c) {
    if (quad < 2) ua = *(const uint4*)(Pm + (size_t)(c * 16 + l16) * PLD + quad * 8);
#pragma unroll
    for (int r = 0; r < 4; ++r) ue[r] = Pm[(size_t)(c * 16 + quad * 4 + r) * PLD + l16];
  };
  __syncthreads();
  gload(0);
  constexpr int NC = SEQ / 16;
  for (int c = 0; c < NC; ++c) {
    const bf16x8 afr = __builtin_bit_cast(bf16x8, ua);
    float us[4];
#pragma unroll
    for (int r = 0; r < 4; ++r) us[r] = bf2f(ue[r]);
#pragma unroll
    for (int jb = 0; jb < 8; ++jb) {
      f32x4 acc = {0.f, 0.f, 0.f, 0.f};
      acc = __builtin_amdgcn_mfma_f32_16x16x32_bf16(afr, bbf[jb], acc, 0, 0, 0);
#pragma unroll
      for (int r = 0; r < 4; ++r) buT[(quad * 4 + r) * BUS + jb * 16 + l16] = acc[r];
    }
    if (c + 1 < NC) gload(c + 1);
    __syncthreads();
#pragma unroll
    for (int t = 0; t < 16; ++t) {
      const float ur = buT[t * BUS + lane], ui = buT[t * BUS + 64 + lane];
      const float nr = ab.x * xr - ab.y * xi + ur;
      const float ni = ab.x * xi + ab.y * xr + ui;
      xr = nr; xi = ni;
      hist[t * 136 + lane] = f2bf(xr);
      hist[t * 136 + 64 + lane] = f2bf(xi);
    }
    __syncthreads();
    f32x4 acc = {0.f, 0.f, 0.f, 0.f};
#pragma unroll
    for (int ks = 0; ks < 4; ++ks) {
      const bf16x8 a = *(const bf16x8*)(hist + l16 * 136 + ks * 32 + quad * 8);
      acc = __builtin_amdgcn_mfma_f32_16x16x32_bf16(a, cf[ks], acc, 0, 0, 0);
    }
#pragma unroll
    for (int r = 0; r < 4; ++r) {
      const int t = quad * 4 + r;
      const float y = acc[r] + dcoef * us[r];
      const float z = y * sigm(1.5957691216057308f * (y + 0.044715f * y * y * y));
      Z[(size_t)(c * 16 + t) * 512 + l16] = f2bf(z);
    }
  }
}

#define GSYNC() xcd_barrier(xb)
#define TILE_MAP(u_, ntm_, tm_, tn_) { const int _x = (u_) & 7, _li = (u_) >> 3, _per = (ntm_) >> 3; tm_ = _x * _per + (_li % _per); tn_ = _li / _per; }
__global__ void __launch_bounds__(256, 2) mega_kernel(Params p) {
  cg::grid_group grid = cg::this_grid();
  __shared__ __attribute__((aligned(16))) char smem[SMEM_BYTES];
  __shared__ uint4 xb_words;
  const int bid = blockIdx.x, nb = gridDim.x;
  if (p.ws == nullptr) grid.sync();
  if (threadIdx.x == 0) xb_words = make_uint4(0u, 0u, 0u, 0u);
  __syncthreads();
  const XcdBarrier xb = xcd_barrier_post((unsigned*)(p.ws + OFF_BAR), (volatile LAS unsigned*)&xb_words);
  char* ws = p.ws;
  float* X = p.out;
  bf16_t* Wt_in = (bf16_t*)(ws + OFF_WIN);
  bf16_t* Wt_q = (bf16_t*)(ws + OFF_WQ);
  bf16_t* Wt_br = (bf16_t*)(ws + OFF_WBR);
  bf16_t* Wt_out = (bf16_t*)(ws + OFF_WOUT);
  bf16_t* Wt_glu = (bf16_t*)(ws + OFF_WGLU);
  bf16_t* Wt_wup = (bf16_t*)(ws + OFF_WWUP);
  bf16_t* Wt_aup = (bf16_t*)(ws + OFF_WAUP);
  bf16_t* Wt_gup = (bf16_t*)(ws + OFF_WGUP);
  bf16_t* Wt_v = (bf16_t*)(ws + OFF_WV);
  bf16_t* Wt_xkv = (bf16_t*)(ws + OFF_WXKV);
  bf16_t* Hb = (bf16_t*)(ws + OFF_H);
  bf16_t* Vfirst = (bf16_t*)(ws + OFF_VFIRST);
  bf16_t* Kx = (bf16_t*)(ws + OFF_KX);
  bf16_t* VxT = (bf16_t*)(ws + OFF_VXT);
  bf16_t* Hm = (bf16_t*)(ws + OFF_HM);
  float* CosT = (float*)(ws + OFF_COS);
  float* SinT = (float*)(ws + OFF_SIN);
  bf16_t* Pm = (bf16_t*)(ws + R_P);
  bf16_t* Cqn = (bf16_t*)(ws + R_CQN);
  bf16_t* Qp = (bf16_t*)(ws + R_QP);
  bf16_t* KVlat = (bf16_t*)(ws + R_KVLAT);
  bf16_t* VTm = (bf16_t*)(ws + R_VT);
  bf16_t* RKV = (bf16_t*)(ws + R_RKV);
  bf16_t* Alora = (bf16_t*)(ws + R_ALORA);
  bf16_t* Yrw = (bf16_t*)(ws + R_YRW);
  bf16_t* Zs5 = (bf16_t*)(ws + R_ZS5);
  bf16_t* Ybr = (bf16_t*)(ws + R_YBR);
  bf16_t* Wt_xq = (bf16_t*)(ws + R_WXQ);
  bf16_t* Wt_xo = (bf16_t*)(ws + R_WXO);
  bf16_t* Wt_gu = (bf16_t*)(ws + R_WGU);
  bf16_t* Wt_down = (bf16_t*)(ws + R_WDOWN);
  bf16_t* Qx = (bf16_t*)(ws + R_QX);
  bf16_t* Ox = (bf16_t*)(ws + R_OX);
  bf16_t* GU = (bf16_t*)(ws + R_GU);
  const float LOG2E = 1.4426950408889634f;

  for (int l = 0; l < 2; ++l) {
    {
      PHASE_IDS
      const float* w_in = p.in[4] + (size_t)l * 1024 * P_IN;
      transpose_all(w_in, P_IN, 1024, P_IN, Wt_in, bid, nb, smem);
      transpose_all(p.in[36] + (size_t)l * 512 * 1024, 1024, 512, 1024, Wt_br + (size_t)1 * 1024 * 512, bid, nb, smem);
      transpose_all(p.in[37] + (size_t)l * 512 * 1024, 1024, 512, 1024, Wt_br + (size_t)2 * 1024 * 512, bid, nb, smem);
      transpose_all(p.in[38] + (size_t)l * 512 * 1024, 1024, 512, 1024, Wt_br + (size_t)3 * 1024 * 512, bid, nb, smem);
      transpose_all(p.in[39] + (size_t)l * 1024 * 1024, 1024, 1024, 1024, Wt_out, bid, nb, smem);
      transpose_all(p.in[19] + (size_t)l * 512 * 512, 512, 512, 512, Wt_glu, bid, nb, smem);
      transpose_all(p.in[23] + (size_t)l * 64 * 512, 512, 64, 512, Wt_wup, bid, nb, smem);
      transpose_all(p.in[25] + (size_t)l * 64 * 512, 512, 64, 512, Wt_aup, bid, nb, smem);
      transpose_all(p.in[26] + (size_t)l * 128 * 512, 512, 128, 512, Wt_gup, bid, nb, smem);
      transpose_all(p.in[43] + (size_t)l * 1024 * 2048, 2048, 1024, 2048, Wt_xkv, bid, nb, smem);
      const int gtid = bid * 256 + tid, gsz = nb * 256;
      {
        const float* w_uq = p.in[6] + (size_t)l * 256 * 768;
        const float* w_ukv = p.in[8] + (size_t)l * 128 * 1024;
        for (int e = gtid; e < 768 * 256; e += gsz) {
          const int n = e >> 8, kq = e & 255, hh = n / 192, j = n % 192;
          float v;
          if (j >= 128) v = w_uq[kq * 768 + n];
          else {
            const float4* a = (const float4*)(w_uq + kq * 768 + hh * 192);
            const float4* b = (const float4*)(w_ukv + j * 1024 + hh * 256);
            float v0 = 0.f, v1 = 0.f, v2 = 0.f, v3 = 0.f;
#pragma unroll 8
            for (int d = 0; d < 32; ++d) { const float4 x = a[d], y = b[d]; v0 += x.x * y.x; v1 += x.y * y.y; v2 += x.z * y.z; v3 += x.w * y.w; }
            v = (v0 + v1) + (v2 + v3);
          }
          Wt_q[e] = f2bf(v);
        }
        const float* w_bm = p.in[35] + (size_t)l * 512 * 1024;
        for (int e = gtid; e < 1024 * 512; e += gsz) {
          const int n = e & 1023, kk = e >> 10, hh = kk >> 7, j = kk & 127;
          const float* a = w_ukv + j * 1024 + hh * 256 + 128;
          const float* bcol = w_bm + (size_t)(hh * 128) * 1024 + n;
          float v0 = 0.f, v1 = 0.f, v2 = 0.f, v3 = 0.f;
#pragma unroll 4
          for (int d = 0; d < 128; d += 4) {
            const float4 x = *(const float4*)(a + d);
            v0 += x.x * bcol[(size_t)(d + 0) * 1024]; v1 += x.y * bcol[(size_t)(d + 1) * 1024];
            v2 += x.z * bcol[(size_t)(d + 2) * 1024]; v3 += x.w * bcol[(size_t)(d + 3) * 1024];
          }
          Wt_br[(size_t)n * 512 + kk] = f2bf((v0 + v1) + (v2 + v3));
        }
        if (l == 1) {
          const float* vd = p.in[32];
          const float* vu = p.in[33];
          for (int e = gtid; e < 512 * 1024; e += gsz) {
            const int n = e & 511, kk = e >> 9;
            float v0 = 0.f, v1 = 0.f, v2 = 0.f, v3 = 0.f;
#pragma unroll
            for (int r = 0; r < 32; r += 4) {
              const float4 x = *(const float4*)(vd + kk * 32 + r);
              v0 += x.x * vu[(r + 0) * 512 + n]; v1 += x.y * vu[(r + 1) * 512 + n];
              v2 += x.z * vu[(r + 2) * 512 + n]; v3 += x.w * vu[(r + 3) * 512 + n];
            }
            Wt_v[(size_t)n * 1024 + kk] = f2bf((v0 + v1) + (v2 + v3));
          }
        }
      }
      {
        float* abp = (float*)(ws + OFF_S5AB);
        float* bbp = (float*)(ws + OFF_S5BB);
        for (int e = gtid; e < 2048; e += gsz) {
          const int g = e >> 6;
          const float are = fminf(p.in[11][l * 2048 + e], -1e-4f), aim = p.in[12][l * 2048 + e];
          const float dt = expf(p.in[13][l * 32 + g]);
          const float mag = expf(dt * are);
          const float abre = mag * cosf(dt * aim), abim = mag * sinf(dt * aim);
          const float den = are * are + aim * aim;
          const float zre = ((abre - 1.f) * are + abim * aim) / den;
          const float zim = (abim * are - (abre - 1.f) * aim) / den;
          abp[e * 2] = abre; abp[e * 2 + 1] = abim;
          const float* Br = p.in[14] + (size_t)l * 32768 + (size_t)e * 16;
          const float* Bi = p.in[15] + (size_t)l * 32768 + (size_t)e * 16;
          for (int c = 0; c < 16; ++c) {
            bbp[e * 32 + c] = zre * Br[c] - zim * Bi[c];
            bbp[e * 32 + 16 + c] = zre * Bi[c] + zim * Br[c];
          }
        }
      }
      if (l == 0) rmsnorm_rows(p.in[0], p.in[3], Hb, X, T_ALL, bid, nb);
      else rmsnorm_rows(X, p.in[3] + 1024, Hb, nullptr, T_ALL, bid, nb);
      rmsnorm_rows(p.in[1], p.in[41] + l * 1024, Hm, nullptr, 1024, bid, nb);
    }
    GSYNC();

    for (int half = 0; half < 2; ++half) {
      const bf16_t* Hh = Hb + (size_t)half * TH * 1024;
      {
        const int n1 = 64 * 38;
        const int n2 = (half == 0) ? 8 * 16 : 0;
        int par = 0;
        for (int u = bid; u < n1 + n2; u += nb) {
          f32x4 acc[4][4];
          zero_acc<4>(acc);
          if (u < n1) {
            int tm, tn; TILE_MAP(u, 64, tm, tn);
            int tmn = tm, tnn = tn; if (u + nb < n1) TILE_MAP(u + nb, 64, tmn, tnn);
            gemm_acc<128>(Hh + (size_t)tm * 128 * 1024, 1024, Wt_in + (size_t)tn * 128 * 1024, 1024, 1024, smem, acc,
                          Hh + (size_t)tmn * 128 * 1024, 1024, Wt_in + (size_t)tnn * 128 * 1024, 1024, u != bid, par);
            EPI4_FOR(128) {
              const int row = tm * 128 + EPI_ROW, n = tn * 128 + EPI4_COL(128);
              if (n < GATE_OFF) {
                const int pc = (n < 448) ? n : n + 64;
                *(uint2*)(Pm + (size_t)row * PLD + pc) = pack4(acc[i][j]);
              }
            }
          } else {
            const int v = u - n1, tn = v % 16, tm = v / 16;
            gemm_acc<128>(Hm + (size_t)tm * 128 * 1024, 1024, Wt_xkv + (size_t)tn * 128 * 1024, 1024, 1024, smem, acc);
            EPI_FOR(128) {
              const int row = tm * 128 + EPI_ROW, n = tn * 128 + EPI_COL(128);
              const int b = row >> 8, m = row & 255, sel = n >> 10, hh = (n >> 8) & 3, d = n & 255;
              if (sel == 0) Kx[((size_t)(b * 4 + hh) * 256 + m) * 256 + d] = f2bf(acc[i][j][r]);
              else VxT[((size_t)(b * 4 + hh) * 256 + d) * 256 + m] = f2bf(acc[i][j][r]);
            }
          }
        }
      }
      GSYNC();
      {
      PHASE_IDS
        const float* qn = p.in[5] + l * 256;
        const float* kvn = p.in[7] + l * 128;
        const float* mu = p.in[21] + l * 1792;
        for (int tk = bid * 4 + wave; tk < TH; tk += nb * 4) {
          const int gtok = half * TH + tk, s = gtok & (SEQ - 1), bl = tk >> 12;
          const bf16_t* prow = Pm + (size_t)tk * PLD;
          {
            const uint2 cu = *(const uint2*)(prow + lane * 4);
            float f[4] = {bflo(cu.x), bfhi(cu.x), bflo(cu.y), bfhi(cu.y)};
            float ss = wave_sum(f[0] * f[0] + f[1] * f[1] + f[2] * f[2] + f[3] * f[3]);
            const float rs = rsqrtf(ss * (1.f / 256.f) + 1e-6f);
            const float4 g4 = *(const float4*)(qn + lane * 4);
            uint2 o; o.x = pack2(f[0] * rs * g4.x, f[1] * rs * g4.y); o.y = pack2(f[2] * rs * g4.z, f[3] * rs * g4.w);
            *(uint2*)(Cqn + (size_t)tk * 256 + lane * 4) = o;
          }
          {
            const unsigned cu = *(const unsigned*)(prow + 256 + lane * 2);
            const float f0 = bflo(cu), f1 = bfhi(cu);
            const float ss = wave_sum(f0 * f0 + f1 * f1);
            const float rs = rsqrtf(ss * (1.f / 128.f) + 1e-6f);
            const float v0 = f0 * rs * kvn[lane * 2], v1 = f1 * rs * kvn[lane * 2 + 1];
            const bf16_t b0 = f2bf(v0), b1 = f2bf(v1);
            *(unsigned*)(KVlat + (size_t)tk * 192 + lane * 2) = (unsigned)b0 | ((unsigned)b1 << 16);
            VTm[((size_t)bl * 128 + lane * 2) * SEQ + s] = b0;
            VTm[((size_t)bl * 128 + lane * 2 + 1) * SEQ + s] = b1;
          }
          if (lane < 32) {
            const float t1 = bf2f(prow[384 + lane]), t2 = bf2f(prow[384 + 32 + lane]);
            const float posf = (float)p.pos[gtok];
            const float invf = exp2f(-(float)lane * (13.287712379549449f / 32.f));
            const float ang = posf * invf;
            const float cs = cosf(ang), sn = sinf(ang);
            KVlat[(size_t)tk * 192 + 128 + lane] = f2bf(t1 * cs - t2 * sn);
            KVlat[(size_t)tk * 192 + 160 + lane] = f2bf(t1 * sn + t2 * cs);
            CosT[tk * 32 + lane] = cs; SinT[tk * 32 + lane] = sn;
          }
#pragma unroll
          for (int jj = 0; jj < 7; ++jj) {
            const int col = (jj * 64 + lane) * 4;
            const uint2 cu = *(const uint2*)(prow + PC_RW + col);
            uint2 pu = uint2{0u, 0u};
            if (s > 0) pu = *(const uint2*)(prow - PLD + PC_RW + col);
            const float4 m4 = *(const float4*)(mu + col);
            const float cv[4] = {bflo(cu.x), bfhi(cu.x), bflo(cu.y), bfhi(cu.y)};
            const float pv[4] = {bflo(pu.x), bfhi(pu.x), bflo(pu.y), bfhi(pu.y)};
            const float mm[4] = {m4.x, m4.y, m4.z, m4.w};
            float o[4];
#pragma unroll
            for (int e = 0; e < 4; ++e) o[e] = cv[e] + (pv[e] - cv[e]) * mm[e];
            if (col < 1536) {
              uint2 ov; ov.x = pack2(o[0], o[1]); ov.y = pack2(o[2], o[3]);
              *(uint2*)(RKV + (size_t)tk * 1536 + col) = ov;
              if (l == 0 && col >= 1024) *(uint2*)(Vfirst + (size_t)gtok * 512 + (col - 1024)) = ov;
            } else {
              int dc;
              if (col < 1600) { dc = col - 1536; for (int e = 0; e < 4; ++e) o[e] = tanhf(o[e]); }
              else if (col < 1664) { dc = 64 + col - 1600; }
              else { dc = 128 + col - 1664; for (int e = 0; e < 4; ++e) o[e] = sigm(o[e]); }
              uint2 ov; ov.x = pack2(o[0], o[1]); ov.y = pack2(o[2], o[3]);
              *(uint2*)(Alora + (size_t)tk * 256 + dc) = ov;
            }
          }
        }
      }
      GSYNC();
      {
      PHASE_IDS
        const int nq = 64 * 6, nl = 64 * 4;
        const int total = nq + 3 * nl + (l == 1 ? nl : 0);
        for (int u = bid; u < total; u += nb) {
          f32x4 acc[4][4];
          zero_acc<4>(acc);
          if (u < nq) {
            int tm, tn; TILE_MAP(u, 64, tm, tn);
            gemm_acc<128>(Cqn + (size_t)tm * 128 * 256, 256, Wt_q + (size_t)tn * 128 * 256, 256, 256, smem, acc);
            const float qs = 0.07216878364870322f * LOG2E;
            const int lane_ = tid & 63, wave_ = tid >> 6, wm_ = wave_ >> 1, wn_ = wave_ & 1, l16_ = lane_ & 15, quad_ = lane_ >> 4;
            const int gc = tn * 128 + wn_ * 64;
            const bool is_rope = (gc % 192) == 128;
#pragma unroll
            for (int i = 0; i < 4; ++i) {
              const int row = tm * 128 + wm_ * 64 + i * 16 + l16_;
              if (is_rope) {
#pragma unroll
                for (int j = 0; j < 2; ++j) {
                  const int fi = j * 16 + quad_ * 4;
                  const float4 cs = *(const float4*)(CosT + row * 32 + fi), sn = *(const float4*)(SinT + row * 32 + fi);
                  const float c4[4] = {cs.x, cs.y, cs.z, cs.w}, s4[4] = {sn.x, sn.y, sn.z, sn.w};
#pragma unroll
                  for (int r = 0; r < 4; ++r) {
                    const float t1 = acc[i][j][r], t2 = acc[i][j + 2][r];
                    acc[i][j][r] = t1 * c4[r] - t2 * s4[r]; acc[i][j + 2][r] = t1 * s4[r] + t2 * c4[r];
                  }
                }
              }
#pragma unroll
              for (int j = 0; j < 4; ++j) *(uint2*)(Qp + (size_t)row * 768 + gc + j * 16 + quad_ * 4) = pack4(acc[i][j] * qs);
            }
          } else if (u < nq + 3 * nl) {
            const int v = u - nq, which = v / nl, w2 = v % nl, tn = w2 % 4, tm = w2 / 4;
            if (which == 0) {
              gemm_acc<128>(Alora + (size_t)tm * 128 * 256, 256, Wt_wup + (size_t)tn * 128 * 64, 64, 64, smem, acc);
              const float* w0 = p.in[22] + l * 512;
              EPI4_FOR(128) {
                const int row = tm * 128 + EPI_ROW, n = tn * 128 + EPI4_COL(128);
                const float4 b4 = *(const float4*)(w0 + n);
                *(uint2*)(Pm + (size_t)row * PLD + PC_RW + n) = pack4(acc[i][j] + f32x4{b4.x, b4.y, b4.z, b4.w});
              }
            } else if (which == 1) {
              gemm_acc<128>(Alora + (size_t)tm * 128 * 256 + 64, 256, Wt_aup + (size_t)tn * 128 * 64, 64, 64, smem, acc);
              const float* a0 = p.in[24] + l * 512;
              EPI4_FOR(128) {
                const int row = tm * 128 + EPI_ROW, n = tn * 128 + EPI4_COL(128);
                const float4 b4 = *(const float4*)(a0 + n);
                f32x4 v = acc[i][j] + f32x4{b4.x, b4.y, b4.z, b4.w};
#pragma unroll
                for (int r = 0; r < 4; ++r) v[r] = sigm(v[r]);
                *(uint2*)(Pm + (size_t)row * PLD + PC_RW + 512 + n) = pack4(v);
              }
            } else {
              gemm_acc<128>(Alora + (size_t)tm * 128 * 256 + 128, 256, Wt_gup + (size_t)tn * 128 * 128, 128, 128, smem, acc);
              EPI4_FOR(128) {
                const int row = tm * 128 + EPI_ROW, n = tn * 128 + EPI4_COL(128);
                *(uint2*)(Pm + (size_t)row * PLD + PC_RW + 1024 + n) = pack4(acc[i][j]);
              }
            }
          } else {
            const int w2 = u - nq - 3 * nl, tn = w2 % 4, tm = w2 / 4;
            gemm_acc<128>(Hh + (size_t)tm * 128 * 1024, 1024, Wt_v + (size_t)tn * 128 * 1024, 1024, 1024, smem, acc);
            const float* vb = p.in[34];
            EPI4_FOR(128) {
              const int row = tm * 128 + EPI_ROW, n = tn * 128 + EPI4_COL(128);
              const float4 b4 = *(const float4*)(vb + n);
              const f32x4 lg = acc[i][j] + f32x4{b4.x, b4.y, b4.z, b4.w};
              const f32x4 vc = unpack4(*(const uint2*)(RKV + (size_t)row * 1536 + 1024 + n));
              const f32x4 vf = unpack4(*(const uint2*)(Vfirst + ((size_t)half * TH + row) * 512 + n));
              f32x4 o;
#pragma unroll
              for (int r = 0; r < 4; ++r) o[r] = vc[r] + (vf[r] - vc[r]) * sigm(lg[r]);
              *(uint2*)(RKV + (size_t)row * 1536 + 1024 + n) = pack4(o);
            }
          }
        }
      }
      GSYNC();
      {
        int first, count, step;
        if (nb == 512) {
          if (bid < 144) { first = bid; count = 1; step = 0; }
          else {
            int pi = -1;
            if (bid < 256) pi = bid - 144; else if (bid >= 400 && bid < 416) pi = 112 + (bid - 400);
            first = 144 + pi; count = (pi >= 0) ? 2 : 0; step = 255 - 2 * pi;
          }
        } else { first = bid; step = nb; count = (bid < 400) ? (400 - bid + nb - 1) / nb : 0; }
#pragma unroll 1
        for (int q = 0; q < count; ++q) {
          const int u = first + q * step;
          if (u < 144) {
            __builtin_amdgcn_s_setprio(3);
            if (u < 64) rwkv_scan_unit(p, l, u, smem);
            else if (u < 128) hgrn_scan_unit(p, l, u - 64, smem);
            else s5_scan_unit(p, l, u - 128, smem);
            __builtin_amdgcn_s_setprio(0);
          } else {
            const int it = u - 144, qt = 31 - (it >> 3), bl = (it >> 2) & 1, hh = it & 3;
            attn_item_pf<192, true>(Qp + (size_t)bl * SEQ * 768 + hh * 192, 768, KVlat + (size_t)bl * SEQ * 192, 192,
                                    VTm + (size_t)bl * 128 * SEQ, SEQ, (qt * 128 + 128) / 64, qt * 128,
                                    Pm + (size_t)bl * SEQ * PLD + hh * 128, PLD, smem);
          }
        }
        {
          unsigned char* G8 = (unsigned char*)(ws + R_G8);
          int g0, gs;
          if (nb == 512) { g0 = (bid >= 416) ? bid - 416 : 2048; gs = 96; } else { g0 = bid; gs = nb; }
#pragma unroll 1
          for (int t = g0; t < 2048; t += gs) {
            const int tm = t >> 5, tn = t & 31;
            f32x4 acc[4][4];
            zero_acc<4>(acc);
            gemm_acc<128>(Hh + (size_t)tm * 128 * 1024, 1024, Wt_in + (size_t)(GATE_OFF + tn * 128) * 1024, 1024, 1024, smem, acc);
            EPI4_FOR(128) {
              const int row = tm * 128 + EPI_ROW, n = tn * 128 + EPI4_COL(128);
              unsigned q = 0;
#pragma unroll
              for (int r = 0; r < 4; ++r) q |= ((unsigned)(sigm(acc[i][j][r]) * 255.f + 0.5f)) << (8 * r);
              *(unsigned*)(G8 + (size_t)row * 4096 + n) = q;
            }
          }
        }
      }
      GSYNC();
      {
      PHASE_IDS
        const int nglu = 64 * 4;
        for (int u = bid; u < nglu; u += nb) {
          int tm, tn; TILE_MAP(u, 64, tm, tn);
          f32x4 acc[4][4];
          zero_acc<4>(acc);
          gemm_acc<128>(Zs5 + (size_t)tm * 128 * 512, 512, Wt_glu + (size_t)tn * 128 * 512, 512, 512, smem, acc);
          const float* bg = p.in[20] + l * 512;
          EPI4_FOR(128) {
            const int row = tm * 128 + EPI_ROW, n = tn * 128 + EPI4_COL(128);
            const f32x4 z = unpack4(*(const uint2*)(Zs5 + (size_t)row * 512 + n));
            const float4 b4 = *(const float4*)(bg + n);
            const f32x4 lg = acc[i][j] + f32x4{b4.x, b4.y, b4.z, b4.w};
            f32x4 o;
#pragma unroll
            for (int r = 0; r < 4; ++r) o[r] = z[r] * sigm(lg[r]);
            *(uint2*)(Pm + (size_t)row * PLD + PC_S5 + n) = pack4(o);
          }
        }
        const float* k_a = p.in[28] + l * 512;
        const float* r_k = p.in[29] + l * 512;
        const float* ln_w = p.in[30] + l * 512;
        const float* ln_b = p.in[31] + l * 512;
        const float* o_norm = p.in[10] + l * 512;
        for (int tk = bid * 4 + wave; tk < TH; tk += nb * 4) {
          const int c0 = lane * 8;
          {
            const uint4 yu = *(const uint4*)(Yrw + (size_t)tk * 512 + c0);
            const float y[8] = {bflo(yu.x), bfhi(yu.x), bflo(yu.y), bfhi(yu.y), bflo(yu.z), bfhi(yu.z), bflo(yu.w), bfhi(yu.w)};
            const uint4 ru = *(const uint4*)(RKV + (size_t)tk * 1536 + c0);
            const uint4 ku = *(const uint4*)(RKV + (size_t)tk * 1536 + 512 + c0);
            const uint4 vu = *(const uint4*)(RKV + (size_t)tk * 1536 + 1024 + c0);
            const uint4 au = *(const uint4*)(Pm + (size_t)tk * PLD + PC_RW + 512 + c0);
            const uint4 gu = *(const uint4*)(Pm + (size_t)tk * PLD + PC_RW + 1024 + c0);
            const unsigned ra[4] = {ru.x, ru.y, ru.z, ru.w}, ka[4] = {ku.x, ku.y, ku.z, ku.w}, va[4] = {vu.x, vu.y, vu.z, vu.w};
            const unsigned aa[4] = {au.x, au.y, au.z, au.w}, ga[4] = {gu.x, gu.y, gu.z, gu.w};
            float rr[8], kh[8], vv[8], gg[8];
            float sm1 = 0.f, bsum = 0.f;
#pragma unroll
            for (int e = 0; e < 8; ++e) {
              const unsigned sh = (e & 1);
              rr[e] = sh ? bfhi(ra[e >> 1]) : bflo(ra[e >> 1]);
              const float kx = sh ? bfhi(ka[e >> 1]) : bflo(ka[e >> 1]);
              vv[e] = sh ? bfhi(va[e >> 1]) : bflo(va[e >> 1]);
              const float a = sh ? bfhi(aa[e >> 1]) : bflo(aa[e >> 1]);
              gg[e] = sh ? bfhi(ga[e >> 1]) : bflo(ga[e >> 1]);
              kh[e] = kx * (1.f + (a - 1.f) * k_a[c0 + e]);
              sm1 += y[e];
              bsum += rr[e] * kh[e] * r_k[c0 + e];
            }
            sm1 = red8(sm1); bsum = red8(bsum);
            const float mean = sm1 * (1.f / 64.f);
            float vs = 0.f;
#pragma unroll
            for (int e = 0; e < 8; ++e) { const float d = y[e] - mean; vs += d * d; }
            vs = red8(vs);
            const float rstd = rsqrtf(vs * (1.f / 64.f) + 64e-5f);
            float o[8];
#pragma unroll
            for (int e = 0; e < 8; ++e) o[e] = (((y[e] - mean) * rstd) * ln_w[c0 + e] + ln_b[c0 + e] + bsum * vv[e]) * gg[e];
            uint4 ov; ov.x = pack2(o[0], o[1]); ov.y = pack2(o[2], o[3]); ov.z = pack2(o[4], o[5]); ov.w = pack2(o[6], o[7]);
            *(uint4*)(RKV + (size_t)tk * 1536 + c0) = ov;
          }
          {
            bf16_t* op = Pm + (size_t)tk * PLD + PC_HG + 1024 + c0;
            const uint4 ou = *(const uint4*)op;
            const uint4 gu = *(const uint4*)(Pm + (size_t)tk * PLD + PC_HG + 1536 + c0);
            const unsigned oa[4] = {ou.x, ou.y, ou.z, ou.w}, ga[4] = {gu.x, gu.y, gu.z, gu.w};
            float o[8], ss = 0.f;
#pragma unroll
            for (int e = 0; e < 4; ++e) { o[2 * e] = bflo(oa[e]); o[2 * e + 1] = bfhi(oa[e]); }
#pragma unroll
            for (int e = 0; e < 8; ++e) ss += o[e] * o[e];
            ss = red16(ss);
            const float rs = rsqrtf(ss * (1.f / 128.f) + 1e-6f);
            float r8[8];
#pragma unroll
            for (int e = 0; e < 8; ++e) {
              const float gte = (e & 1) ? bfhi(ga[e >> 1]) : bflo(ga[e >> 1]);
              r8[e] = o[e] * rs * o_norm[c0 + e] * sigm(gte);
            }
            uint4 ov; ov.x = pack2(r8[0], r8[1]); ov.y = pack2(r8[2], r8[3]); ov.z = pack2(r8[4], r8[5]); ov.w = pack2(r8[6], r8[7]);
            *(uint4*)op = ov;
          }
        }
      }
      GSYNC();
      {
        int par6 = 0;
        const unsigned char* G8 = (const unsigned char*)(ws + R_G8);
        auto brA = [&](int m, int tm_, int& lda_) -> const bf16_t* {
          const bf16_t* Ao;
          if (m == 0) { Ao = Pm; lda_ = PLD; }
          else if (m == 1) { Ao = Pm + PC_HG + 1024; lda_ = PLD; }
          else if (m == 2) { Ao = Pm + PC_S5; lda_ = PLD; }
          else { Ao = RKV; lda_ = 1536; }
          return Ao + (size_t)tm_ * 128 * lda_;
        };
        for (int u = bid; u < 64 * 8; u += nb) {
          int tm, tn; TILE_MAP(u, 64, tm, tn);
          const bool has_next = (u + nb < 64 * 8);
          int tmn = tm, tnn = tn; if (has_next) TILE_MAP(u + nb, 64, tmn, tnn);
          f32x4 yacc[4][4];
          zero_acc<4>(yacc);
#pragma unroll 1
          for (int m = 0; m < 4; ++m) {
            f32x4 ao[4][4];
            zero_acc<4>(ao);
            int ldo; const bf16_t* Ao = brA(m, tm, ldo);
            const bf16_t* Bo = Wt_br + ((size_t)m * 1024 + tn * 128) * 512;
            const int mn = (m < 3) ? m + 1 : 0;
            const int tmx = (m < 3) ? tm : tmn, tnx = (m < 3) ? tn : tnn;
            int ldn; const bf16_t* An = brA(mn, tmx, ldn);
            const bf16_t* Bn = Wt_br + ((size_t)mn * 1024 + tnx * 128) * 512;
            gemm_acc<128>(Ao, ldo, Bo, 512, 512, smem, ao, An, ldn, Bn, 512, !(m == 0 && u == bid), par6);
            {
              EPI4_FOR(128) {
                const int row = tm * 128 + EPI_ROW, n = tn * 128 + EPI4_COL(128);
                const unsigned q = *(const unsigned*)(G8 + (size_t)row * 4096 + m * 1024 + n);
#pragma unroll
                for (int r = 0; r < 4; ++r) yacc[i][j][r] += ao[i][j][r] * ((float)((q >> (8 * r)) & 255u) * (1.f / 255.f));
              }
            }
          }
          {
            f32x4 (&acc)[4][4] = yacc;
            EPI4_FOR(128) {
              const int row = tm * 128 + EPI_ROW, n = tn * 128 + EPI4_COL(128);
              *(uint2*)(Ybr + (size_t)row * 1024 + n) = pack4(acc[i][j]);
            }
          }
        }
      }
      GSYNC();
      {
        int par = 0;
        for (int u = bid; u < 64 * 8; u += nb) {
          int tm, tn; TILE_MAP(u, 64, tm, tn);
          int tmn = tm, tnn = tn; if (u + nb < 64 * 8) TILE_MAP(u + nb, 64, tmn, tnn);
          f32x4 acc[4][4];
          zero_acc<4>(acc);
          gemm_acc<128>(Ybr + (size_t)tm * 128 * 1024, 1024, Wt_out + (size_t)tn * 128 * 1024, 1024, 1024, smem, acc,
                        Ybr + (size_t)tmn * 128 * 1024, 1024, Wt_out + (size_t)tnn * 128 * 1024, 1024, u != bid, par);
          EPI4_FOR(128) {
            const int row = half * TH + tm * 128 + EPI_ROW, n = tn * 128 + EPI4_COL(128);
            float4* xp = (float4*)(X + (size_t)row * 1024 + n);
            float4 xv = *xp; xv.x += acc[i][j][0]; xv.y += acc[i][j][1]; xv.z += acc[i][j][2]; xv.w += acc[i][j][3];
            *xp = xv;
          }
        }
      }
      GSYNC();
    }

    {
      transpose_all(p.in[42] + (size_t)l * 1024 * 1024, 1024, 1024, 1024, Wt_xq, bid, nb, smem);
      transpose_all(p.in[44] + (size_t)l * 1024 * 1024, 1024, 1024, 1024, Wt_xo, bid, nb, smem);
      transpose_all(p.in[46] + (size_t)l * 1024 * 5632, 5632, 1024, 5632, Wt_gu, bid, nb, smem);
      transpose_all(p.in[49] + (size_t)l * 2816 * 1024, 1024, 2816, 1024, Wt_down, bid, nb, smem);
      rmsnorm_rows(X, p.in[40] + l * 1024, Hb, nullptr, T_ALL, bid, nb);
    }
    GSYNC();
    {
      const float qs = 0.0625f * LOG2E;
      int par = 0;
      for (int u = bid; u < 128 * 8; u += nb) {
        int tm, tn; TILE_MAP(u, 128, tm, tn);
        int tmn = tm, tnn = tn; if (u + nb < 128 * 8) TILE_MAP(u + nb, 128, tmn, tnn);
        f32x4 acc[4][4];
        zero_acc<4>(acc);
        gemm_acc<128>(Hb + (size_t)tm * 128 * 1024, 1024, Wt_xq + (size_t)tn * 128 * 1024, 1024, 1024, smem, acc,
                      Hb + (size_t)tmn * 128 * 1024, 1024, Wt_xq + (size_t)tnn * 128 * 1024, 1024, u != bid, par);
        EPI4_FOR(128) {
          const int row = tm * 128 + EPI_ROW, n = tn * 128 + EPI4_COL(128);
          *(uint2*)(Qx + (size_t)row * 1024 + n) = pack4(acc[i][j] * qs);
        }
      }
    }
    GSYNC();
    {
      for (int u = bid; u < 1024; u += nb) {
        const int dvh = u & 1, hh = (u >> 1) & 3, qt = (u >> 3) & 31, b = u >> 8;
        attn_item<256, false>(Qx + (size_t)b * SEQ * 1024 + hh * 256, 1024, Kx + (size_t)(b * 4 + hh) * 65536, 256,
                              VxT + (size_t)(b * 4 + hh) * 65536 + (size_t)dvh * 128 * 256, 256, 4, qt * 128,
                              Ox + (size_t)b * SEQ * 1024 + hh * 256 + dvh * 128, 1024, smem);
      }
    }
    GSYNC();
    {
      int par = 0;
      for (int u = bid; u < 128 * 8; u += nb) {
        int tm, tn; TILE_MAP(u, 128, tm, tn);
        int tmn = tm, tnn = tn; if (u + nb < 128 * 8) TILE_MAP(u + nb, 128, tmn, tnn);
        f32x4 acc[4][4];
        zero_acc<4>(acc);
        gemm_acc<128>(Ox + (size_t)tm * 128 * 1024, 1024, Wt_xo + (size_t)tn * 128 * 1024, 1024, 1024, smem, acc,
                      Ox + (size_t)tmn * 128 * 1024, 1024, Wt_xo + (size_t)tnn * 128 * 1024, 1024, u != bid, par);
        EPI4_FOR(128) {
          const int row = tm * 128 + EPI_ROW, n = tn * 128 + EPI4_COL(128);
          float4* xp = (float4*)(X + (size_t)row * 1024 + n);
          float4 xv = *xp; xv.x += acc[i][j][0]; xv.y += acc[i][j][1]; xv.z += acc[i][j][2]; xv.w += acc[i][j][3];
          *xp = xv;
        }
      }
    }
    GSYNC();
    rmsnorm_rows(X, p.in[45] + l * 1024, Hb, nullptr, T_ALL, bid, nb);
    GSYNC();
    for (int half = 0; half < 2; ++half) {
      const bf16_t* Hh = Hb + (size_t)half * TH * 1024;
      int par13 = 0;
      for (int u = bid; u < 64 * 44; u += nb) {
        int tm, tn; TILE_MAP(u, 64, tm, tn);
        int tmn = tm, tnn = tn; if (u + nb < 64 * 44) TILE_MAP(u + nb, 64, tmn, tnn);
        f32x4 acc[4][4];
        zero_acc<4>(acc);
        gemm_acc<128>(Hh + (size_t)tm * 128 * 1024, 1024, Wt_gu + (size_t)tn * 128 * 1024, 1024, 1024, smem, acc,
                      Hh + (size_t)tmn * 128 * 1024, 1024, Wt_gu + (size_t)tnn * 128 * 1024, 1024, u != bid, par13);
        EPI4_FOR(128) {
          const int row = tm * 128 + EPI_ROW, n = tn * 128 + EPI4_COL(128);
          *(uint2*)(GU + (size_t)row * 5632 + n) = pack4(acc[i][j]);
        }
      }
      GSYNC();
      {
      PHASE_IDS
        const float* cw = p.in[47] + (size_t)l * 3 * D_FF;
        const float* cb = p.in[48] + (size_t)l * D_FF;
        for (int e = bid * 256 + tid; e < TH * 352; e += nb * 256) {
          const int tk = e / 352, c0 = (e % 352) * 8;
          const int s = tk & (SEQ - 1);
          const bf16_t* gp = GU + (size_t)tk * 5632 + c0;
          const uint4 g2 = *(const uint4*)gp;
          uint4 g1 = uint4{0, 0, 0, 0}, g0 = uint4{0, 0, 0, 0};
          if (s >= 1) g1 = *(const uint4*)(gp - 5632);
          if (s >= 2) g0 = *(const uint4*)(gp - 2 * 5632);
          const uint4 uu = *(const uint4*)(gp + D_FF);
          const unsigned a2[4] = {g2.x, g2.y, g2.z, g2.w}, a1[4] = {g1.x, g1.y, g1.z, g1.w}, a0[4] = {g0.x, g0.y, g0.z, g0.w};
          const unsigned au[4] = {uu.x, uu.y, uu.z, uu.w};
          float o[8];
#pragma unroll
          for (int q = 0; q < 8; ++q) {
            const bool hi = q & 1;
            const float x2 = hi ? bfhi(a2[q >> 1]) : bflo(a2[q >> 1]);
            const float x1 = hi ? bfhi(a1[q >> 1]) : bflo(a1[q >> 1]);
            const float x0 = hi ? bfhi(a0[q >> 1]) : bflo(a0[q >> 1]);
            const float up = hi ? bfhi(au[q >> 1]) : bflo(au[q >> 1]);
            const int c = c0 + q;
            const float gv = cw[c] * x0 + cw[D_FF + c] * x1 + cw[2 * D_FF + c] * x2 + cb[c];
            o[q] = gv * sigm(gv) * up;
          }
          uint4 ov; ov.x = pack2(o[0], o[1]); ov.y = pack2(o[2], o[3]); ov.z = pack2(o[4], o[5]); ov.w = pack2(o[6], o[7]);
          *(uint4*)(GU + (size_t)tk * 5632 + D_FF + c0) = ov;
        }
      }
      GSYNC();
      int par15 = 0;
      for (int u = bid; u < 64 * 8; u += nb) {
        int tm, tn; TILE_MAP(u, 64, tm, tn);
        int tmn = tm, tnn = tn; if (u + nb < 64 * 8) TILE_MAP(u + nb, 64, tmn, tnn);
        f32x4 acc[4][4];
        zero_acc<4>(acc);
        gemm_acc<128>(GU + (size_t)tm * 128 * 5632 + D_FF, 5632, Wt_down + (size_t)tn * 128 * 2816, 2816, 2816, smem, acc,
                      GU + (size_t)tmn * 128 * 5632 + D_FF, 5632, Wt_down + (size_t)tnn * 128 * 2816, 2816, u != bid, par15);
        EPI4_FOR(128) {
          const int row = half * TH + tm * 128 + EPI_ROW, n = tn * 128 + EPI4_COL(128);
          float4* xp = (float4*)(X + (size_t)row * 1024 + n);
          float4 xv = *xp; xv.x += acc[i][j][0]; xv.y += acc[i][j][1]; xv.z += acc[i][j][2]; xv.w += acc[i][j][3];
          *xp = xv;
        }
      }
      GSYNC();
    }
  }

  {
      PHASE_IDS
    const float* g = p.in[50];
    for (int r = bid * 4 + wave; r < T_ALL; r += nb * 4) {
      float4* xr = (float4*)(X + (size_t)r * 1024);
      float4 v[4]; float ss = 0.f;
#pragma unroll
      for (int i = 0; i < 4; ++i) { v[i] = xr[lane + 64 * i]; ss += v[i].x * v[i].x + v[i].y * v[i].y + v[i].z * v[i].z + v[i].w * v[i].w; }
      ss = wave_sum(ss);
      const float rs = rsqrtf(ss * (1.f / 1024.f) + 1e-6f);
#pragma unroll
      for (int i = 0; i < 4; ++i) {
        const float4 gg = ((const float4*)g)[lane + 64 * i];
        xr[lane + 64 * i] = float4{v[i].x * rs * gg.x, v[i].y * rs * gg.y, v[i].z * rs * gg.z, v[i].w * rs * gg.w};
      }
    }
  }
}

extern "C" void kernel_launch(void* const* d_in, const int* in_sizes, int n_in, void* d_out, int out_size, void* d_ws, size_t ws_size,
                              hipStream_t stream) {
  static int grid_blocks = 0;
  if (!grid_blocks) {
    int dev = 0, cus = 0, per_cu = 0;
    hipGetDevice(&dev);
    hipDeviceGetAttribute(&cus, hipDeviceAttributeMultiprocessorCount, dev);
    hipOccupancyMaxActiveBlocksPerMultiprocessor(&per_cu, mega_kernel, 256, 0);
    if (per_cu > 2) per_cu = 2;
    if (per_cu < 1) per_cu = 1;
    grid_blocks = cus * per_cu;
  }
  if (ws_size < WS_NEED) fprintf(stderr, "workspace too small: %zu < %zu\n", ws_size, (size_t)WS_NEED);
  Params p{};
  for (int i = 0; i < 51; ++i) p.in[i] = (const float*)d_in[i];
  p.pos = (const int*)d_in[2];
  p.out = (float*)d_out;
  p.ws = (char*)d_ws;
  hipMemsetAsync((char*)d_ws + OFF_BAR, 0, 16384, stream);
  void* args[] = {&p};
  hipError_t e = hipLaunchCooperativeKernel((void*)mega_kernel, dim3(grid_blocks), dim3(256), args, 0, stream);
  if (e != hipSuccess) fprintf(stderr, "cooperative launch failed: %s (grid %d)\n", hipGetErrorString(e), grid_blocks);
}
```

```cpp
#include <hip/hip_runtime.h>
#include <hip/hip_cooperative_groups.h>
#include <cstdio>
#include <cstdint>
namespace cg = cooperative_groups;

typedef unsigned short bf16_t;
using bf16x8 = __attribute__((ext_vector_type(8))) short;
using s16x4 = __attribute__((ext_vector_type(4))) short;
using f32x4 = __attribute__((ext_vector_type(4))) float;
using f32x16 = __attribute__((ext_vector_type(16))) float;
using u32x4 = __attribute__((ext_vector_type(4))) unsigned;
#define DI __device__ __forceinline__

constexpr int T_ALL = 16384, SEQ = 4096, DM = 1024, TH = 8192;
constexpr int P_IN = 8896, GATE_OFF = 4800;
constexpr int PLD = 4864;
constexpr int PC_HG = 512, PC_S5 = 2560, PC_RW = 3072;
constexpr int D_FF = 2816;

constexpr size_t al256(size_t x) { return (x + 255) & ~(size_t)255; }
constexpr size_t OFF_WIN = 0;
constexpr size_t OFF_WQ = OFF_WIN + al256((size_t)P_IN * 1024 * 2);
constexpr size_t OFF_WBR = OFF_WQ + al256((size_t)768 * 256 * 2);
constexpr size_t OFF_WOUT = OFF_WBR + al256((size_t)4 * 1024 * 512 * 2);
constexpr size_t OFF_WGLU = OFF_WOUT + al256((size_t)1024 * 1024 * 2);
constexpr size_t OFF_WWUP = OFF_WGLU + al256((size_t)512 * 512 * 2);
constexpr size_t OFF_WAUP = OFF_WWUP + al256((size_t)512 * 64 * 2);
constexpr size_t OFF_WGUP = OFF_WAUP + al256((size_t)512 * 64 * 2);
constexpr size_t OFF_WV = OFF_WGUP + al256((size_t)512 * 128 * 2);
constexpr size_t OFF_WXKV = OFF_WV + al256((size_t)512 * 1024 * 2);
constexpr size_t OFF_S5AB = OFF_WXKV + al256((size_t)2048 * 1024 * 2);
constexpr size_t OFF_S5BB = OFF_S5AB + al256((size_t)32 * 64 * 2 * 4);
constexpr size_t OFF_H = OFF_S5BB + al256((size_t)32 * 64 * 32 * 4);
constexpr size_t OFF_VFIRST = OFF_H + al256((size_t)T_ALL * 1024 * 2);
constexpr size_t OFF_KX = OFF_VFIRST + al256((size_t)T_ALL * 512 * 2);
constexpr size_t OFF_VXT = OFF_KX + al256((size_t)16 * 256 * 256 * 2);
constexpr size_t OFF_HM = OFF_VXT + al256((size_t)16 * 256 * 256 * 2);
constexpr size_t OFF_COS = OFF_HM + al256((size_t)1024 * 1024 * 2);
constexpr size_t OFF_SIN = OFF_COS + al256((size_t)TH * 32 * 4);
constexpr size_t OFF_BAR = OFF_SIN + al256((size_t)TH * 32 * 4);
constexpr size_t OFF_REG = OFF_BAR + 16384;
constexpr size_t R_P = OFF_REG;
constexpr size_t R_CQN = R_P + al256((size_t)TH * PLD * 2);
constexpr size_t R_QP = R_CQN + (size_t)TH * 256 * 2;
constexpr size_t R_KVLAT = R_QP + al256((size_t)TH * 768 * 2);
constexpr size_t R_VT = R_KVLAT + al256((size_t)TH * 192 * 2);
constexpr size_t R_RKV = R_VT + al256((size_t)2 * 128 * 4096 * 2);
constexpr size_t R_YRW = R_RKV + al256((size_t)TH * 1536 * 2);
constexpr size_t R_ZS5 = R_YRW + al256((size_t)TH * 512 * 2);
constexpr size_t R_ALORA = R_ZS5 + al256((size_t)TH * 512 * 2);
constexpr size_t R_G8 = R_ALORA;
constexpr size_t R_END1 = R_G8 + al256((size_t)TH * 4096);
static_assert(R_END1 <= ((size_t)256 << 20), "workspace plan exceeds the guaranteed 256 MiB");
constexpr size_t R_YBR = R_CQN;
constexpr size_t R_WXQ = OFF_REG;
constexpr size_t R_WXO = R_WXQ + al256((size_t)1024 * 1024 * 2);
constexpr size_t R_WGU = R_WXO + al256((size_t)1024 * 1024 * 2);
constexpr size_t R_WDOWN = R_WGU + al256((size_t)5632 * 1024 * 2);
constexpr size_t R_QX = R_WDOWN + al256((size_t)1024 * 2816 * 2);
constexpr size_t R_OX = R_QX + al256((size_t)T_ALL * 1024 * 2);
constexpr size_t R_GU = R_QX;
constexpr size_t R_END2 = R_GU + al256((size_t)TH * 5632 * 2);
constexpr size_t WS_NEED = (R_END1 > R_END2 ? R_END1 : R_END2);

constexpr int SMEM_BYTES = 73728;

struct Params {
  const float* in[51];
  const int* pos;
  float* out;
  char* ws;
};

DI bf16_t f2bf(float x) { return __builtin_bit_cast(unsigned short, (__bf16)x); }
DI float bf2f(bf16_t b) { return __uint_as_float(((unsigned)b) << 16); }
typedef __bf16 bf16v2_t __attribute__((ext_vector_type(2)));
typedef float f32v2_t __attribute__((ext_vector_type(2)));
DI unsigned pack2(float a, float b) { const f32v2_t v = {a, b}; return __builtin_bit_cast(unsigned, __builtin_convertvector(v, bf16v2_t)); }
DI float bflo(unsigned u) { return __uint_as_float(u << 16); }
DI float bfhi(unsigned u) { return __uint_as_float(u & 0xffff0000u); }
DI float sigm(float x) { return __builtin_amdgcn_rcpf(1.f + __expf(-x)); }
template <int CTRL> DI float dppf(float v) {
  return __builtin_bit_cast(float, __builtin_amdgcn_update_dpp(0, __builtin_bit_cast(int, v), CTRL, 0xf, 0xf, false));
}
DI float red8(float v) { v += dppf<0xB1>(v); v += dppf<0x4E>(v); v += dppf<0x141>(v); return v; }
DI float red16(float v) { v = red8(v); v += dppf<0x140>(v); return v; }
DI int TID() { int t = threadIdx.x; asm volatile("" : "+v"(t)); return t; }
#define PHASE_IDS const int tid = TID(); const int lane = tid & 63, wave = tid >> 6; (void)lane; (void)wave;
DI const bf16_t* uniform_ptr(const bf16_t* p) {
  const unsigned long long v = (unsigned long long)p;
  const unsigned lo = __builtin_amdgcn_readfirstlane((unsigned)v), hi = __builtin_amdgcn_readfirstlane((unsigned)(v >> 32));
  return (const bf16_t*)(((unsigned long long)hi << 32) | lo);
}
DI float wave_sum(float v) { for (int o = 32; o > 0; o >>= 1) v += __shfl_xor(v, o); return v; }


#define XB_TMO      128
#define XB_XCNT(j)  (256  + 64 * (j))
#define XB_XSUB(j)  (1280 + 64 * (j))
#define XB_XGEN(j)  (2304 + 64 * (j))
#define XB_TOP      3328
#define XB_TOPGEN   3392
#define XCD_BAR_WORDS 3456
#define XB_SPIN_CAP (1u << 22)
#define LAS __attribute__((address_space(3)))
DI unsigned xb_ld(unsigned* p) { return __hip_atomic_load(p, __ATOMIC_RELAXED, __HIP_MEMORY_SCOPE_AGENT); }
DI unsigned xb_add(unsigned* p, unsigned v) { return __hip_atomic_fetch_add(p, v, __ATOMIC_RELAXED, __HIP_MEMORY_SCOPE_AGENT); }
DI unsigned xb_xcc_id() { return (unsigned)__builtin_amdgcn_s_getreg((3 << 11) | 20) & 0xFu; }
#define XB_SPIN(cond, bar) do { unsigned _sp = 0; while (cond) { __builtin_amdgcn_s_sleep(1); \
    if ((++_sp & 255u) == 0u) { if (xb_ld(&(bar)[XB_TMO])) break; if (_sp > XB_SPIN_CAP) { atomicAdd(&(bar)[XB_TMO], 1u); break; } } } } while (0)
struct XcdBarrier { unsigned* bar; unsigned x; volatile LAS unsigned* st; };
DI XcdBarrier xcd_barrier_post(unsigned* bar, volatile LAS unsigned* st) {
  XcdBarrier b; b.bar = bar; b.x = xb_xcc_id(); b.st = st;
  if (threadIdx.x == 0) (void)xb_add(&bar[XB_XCNT(b.x)], 1u);
  return b;
}
DI void xcd_barrier_complete(unsigned* bar, unsigned x, unsigned& nloc, unsigned& nx) {
  const unsigned G = gridDim.x * gridDim.y * gridDim.z;
  unsigned sum, cnt, mine, sp = 0u;
  for (;;) {
    sum = 0u; cnt = 0u; mine = 0u;
#pragma unroll
    for (unsigned j = 0; j < 16; ++j) { const unsigned c = xb_ld(&bar[XB_XCNT(j)]); sum += c; cnt += (c > 0u) ? 1u : 0u; mine = (j == x) ? c : mine; }
    if (sum == G) break;
    __builtin_amdgcn_s_sleep(1);
    if ((++sp & 255u) == 0u) { if (xb_ld(&bar[XB_TMO])) break; if (sp > XB_SPIN_CAP) { atomicAdd(&bar[XB_TMO], 1u); break; } }
  }
  nloc = mine > 0u ? mine : 1u; nx = cnt > 0u ? cnt : 1u;
}
DI void xcd_barrier(const XcdBarrier& b) {
  asm volatile("s_waitcnt vmcnt(0)" ::: "memory");
  __syncthreads();
  if (threadIdx.x == 0) {
    unsigned* bar = b.bar;
    __builtin_amdgcn_s_waitcnt(0);
    unsigned nloc = b.st[0], nx = b.st[1];
    if (nloc == 0u) { xcd_barrier_complete(bar, b.x, nloc, nx); b.st[0] = nloc; b.st[1] = nx; }
    const unsigned old = xb_add(&bar[XB_XSUB(b.x)], 1u);
    const unsigned gen = old / nloc;
    if (old + 1u == (gen + 1u) * nloc) {
      __builtin_amdgcn_fence(__ATOMIC_RELEASE, "agent");
      asm volatile("s_waitcnt vmcnt(0)" ::: "memory");
      const unsigned og = xb_add(&bar[XB_TOP], 1u);
      const unsigned tg = og / nx;
      if (og + 1u == (tg + 1u) * nx) xb_add(&bar[XB_TOPGEN], 1u);
      else XB_SPIN(xb_ld(&bar[XB_TOPGEN]) == tg, bar);
      __builtin_amdgcn_fence(__ATOMIC_ACQUIRE, "agent");
      xb_add(&bar[XB_XGEN(b.x)], 1u);
      asm volatile("s_waitcnt vmcnt(0)" ::: "memory");
    } else {
      XB_SPIN(xb_ld(&bar[XB_XGEN(b.x)]) == gen, bar);
      __builtin_amdgcn_fence(__ATOMIC_ACQUIRE, "agent");
      asm volatile("s_waitcnt vmcnt(0)" ::: "memory");
    }
  }
  __syncthreads();
}

#define GLOAD16(dst, ptr) asm volatile("global_load_dwordx4 %0, %1, off" : "=v"(dst) : "v"(ptr))
template <int BN>
DI void gemm_acc(const bf16_t* __restrict__ A, int lda, const bf16_t* __restrict__ Bt, int ldb, int K, char* smem,
                 f32x4 (&acc)[4][BN / 32], const bf16_t* __restrict__ An, int ldan, const bf16_t* __restrict__ Bn, int ldbn,
                 bool pre, int& par) {
  constexpr int A_EL = 128 * 72, B_EL = BN * 72, BUF_EL = A_EL + B_EL;
  constexpr int NJ = BN / 32, BCH = BN / 32;
  bf16_t* sm = (bf16_t*)smem;
  const int tid = TID(), lane = tid & 63, wave = tid >> 6;
  const int wm = wave >> 1, wn = wave & 1, l16 = lane & 15, quad = lane >> 4;
  const int crow = tid >> 3, ccol = (tid & 7) * 8;
  u32x4 ra[4], rb[BCH];
  const bf16_t* Ap = A + (size_t)crow * lda + ccol;
  const bf16_t* Bp = Bt + (size_t)crow * ldb + ccol;
  const bf16_t* Apn = An + (size_t)crow * ldan + ccol;
  const bf16_t* Bpn = Bn + (size_t)crow * ldbn + ccol;
  const int nk = K >> 6;
#define GEMM_ISSUE(ap_, sa_, bp_, sb_)                                                            \
  {                                                                                               \
    _Pragma("unroll") for (int i = 0; i < 4; ++i) GLOAD16(ra[i], (ap_) + (size_t)(32 * i) * (sa_));      \
    _Pragma("unroll") for (int i = 0; i < BCH; ++i) GLOAD16(rb[i], (bp_) + (size_t)(32 * i) * (sb_));    \
  }
#define GEMM_LAND(buf_)                                                                           \
  {                                                                                               \
    if constexpr (BCH == 4)                                                                       \
      asm volatile("s_waitcnt vmcnt(0)" : "+v"(ra[0]), "+v"(ra[1]), "+v"(ra[2]), "+v"(ra[3]), "+v"(rb[0]), "+v"(rb[1]), "+v"(rb[2]), "+v"(rb[3])); \
    else                                                                                          \
      asm volatile("s_waitcnt vmcnt(0)" : "+v"(ra[0]), "+v"(ra[1]), "+v"(ra[2]), "+v"(ra[3]), "+v"(rb[0]), "+v"(rb[1])); \
    bf16_t* sa_ = sm + (buf_) * BUF_EL; bf16_t* sb_ = sa_ + A_EL;                                 \
    _Pragma("unroll") for (int i = 0; i < 4; ++i) *(u32x4*)(sa_ + (crow + 32 * i) * 72 + ccol) = ra[i];   \
    _Pragma("unroll") for (int i = 0; i < BCH; ++i) *(u32x4*)(sb_ + (crow + 32 * i) * 72 + ccol) = rb[i]; \
  }
  if (!pre) {
    GEMM_ISSUE(Ap, lda, Bp, ldb);
    GEMM_LAND(par);
    __syncthreads();
  }
  for (int kt = 0; kt < nk; ++kt) {
    {
      const bool inner = (kt + 1 < nk);
      const bf16_t* ap = inner ? Ap + ((kt + 1) << 6) : Apn;
      const bf16_t* bp = inner ? Bp + ((kt + 1) << 6) : Bpn;
      const int sa = inner ? lda : ldan, sb = inner ? ldb : ldbn;
      GEMM_ISSUE(ap, sa, bp, sb);
    }
    __builtin_amdgcn_sched_barrier(0);
    {
      const bf16_t* sa = sm + ((par + kt) & 1) * BUF_EL; const bf16_t* sb = sa + A_EL;
#pragma unroll
      for (int ks = 0; ks < 2; ++ks) {
        bf16x8 a[4], b[NJ];
#pragma unroll
        for (int i = 0; i < 4; ++i) a[i] = *(const bf16x8*)(sa + (wm * 64 + i * 16 + l16) * 72 + ks * 32 + quad * 8);
#pragma unroll
        for (int j = 0; j < NJ; ++j) b[j] = *(const bf16x8*)(sb + (wn * (BN / 2) + j * 16 + l16) * 72 + ks * 32 + quad * 8);
        __builtin_amdgcn_s_setprio(1);
#pragma unroll
        for (int i = 0; i < 4; ++i)
#pragma unroll
          for (int j = 0; j < NJ; ++j) acc[i][j] = __builtin_amdgcn_mfma_f32_16x16x32_bf16(b[j], a[i], acc[i][j], 0, 0, 0);
        __builtin_amdgcn_s_setprio(0);
      }
    }
    __builtin_amdgcn_sched_barrier(0);
    GEMM_LAND((par + kt + 1) & 1);
    __syncthreads();
  }
  par = (par + nk) & 1;
#undef GEMM_ISSUE
#undef GEMM_LAND
}
template <int BN>
DI void gemm_acc(const bf16_t* __restrict__ A, int lda, const bf16_t* __restrict__ Bt, int ldb, int K, char* smem,
                 f32x4 (&acc)[4][BN / 32]) {
  int par = 0;
  gemm_acc<BN>(A, lda, Bt, ldb, K, smem, acc, A, lda, Bt, ldb, false, par);
}
template <int NJ> DI void zero_acc(f32x4 (&acc)[4][NJ]) {
#pragma unroll
  for (int i = 0; i < 4; ++i)
#pragma unroll
    for (int j = 0; j < NJ; ++j) acc[i][j] = f32x4{0.f, 0.f, 0.f, 0.f};
}
#define EPI_FOR(BN_)                                                                         \
  const int _t = TID(); const int _lane = _t & 63, _wave = _t >> 6;                              \
  const int _wm = _wave >> 1, _wn = _wave & 1, _l16 = _lane & 15, _quad = _lane >> 4;        \
  _Pragma("unroll") for (int i = 0; i < 4; ++i)                                              \
  _Pragma("unroll") for (int j = 0; j < (BN_) / 32; ++j)                                     \
  _Pragma("unroll") for (int r = 0; r < 4; ++r)
#define EPI_ROW (_wm * 64 + i * 16 + _l16)
#define EPI_COL(BN_) (_wn * ((BN_) / 2) + j * 16 + _quad * 4 + r)
#define EPI4_FOR(BN_)                                                                        \
  const int _t = TID(); const int _lane = _t & 63, _wave = _t >> 6;                          \
  const int _wm = _wave >> 1, _wn = _wave & 1, _l16 = _lane & 15, _quad = _lane >> 4;        \
  _Pragma("unroll") for (int i = 0; i < 4; ++i)                                              \
  _Pragma("unroll") for (int j = 0; j < (BN_) / 32; ++j)
#define EPI4_COL(BN_) (_wn * ((BN_) / 2) + j * 16 + _quad * 4)
DI uint2 pack4(f32x4 v) { uint2 o; o.x = pack2(v[0], v[1]); o.y = pack2(v[2], v[3]); return o; }
DI f32x4 unpack4(uint2 u) { return f32x4{bflo(u.x), bfhi(u.x), bflo(u.y), bfhi(u.y)}; }

DI void transpose_tile(const float* __restrict__ W, int ldw, bf16_t* __restrict__ Wt, int ldt, int k0, int n0, char* smem) {
  float* sm = (float*)smem;
  const int tid = TID();
  __syncthreads();
#pragma unroll
  for (int i = 0; i < 4; ++i) {
    const int k = (tid >> 4) + 16 * i, n4 = (tid & 15) * 4;
    const float4 v = *(const float4*)(W + (size_t)(k0 + k) * ldw + n0 + n4);
    sm[k * 65 + n4 + 0] = v.x; sm[k * 65 + n4 + 1] = v.y; sm[k * 65 + n4 + 2] = v.z; sm[k * 65 + n4 + 3] = v.w;
  }
  __syncthreads();
  const int n = tid >> 2, ks = (tid & 3) * 16;
  unsigned u[8];
#pragma unroll
  for (int e = 0; e < 8; ++e) u[e] = pack2(sm[(ks + 2 * e) * 65 + n], sm[(ks + 2 * e + 1) * 65 + n]);
  uint4* dst = (uint4*)(Wt + (size_t)(n0 + n) * ldt + k0 + ks);
  dst[0] = uint4{u[0], u[1], u[2], u[3]};
  dst[1] = uint4{u[4], u[5], u[6], u[7]};
}
DI void transpose_all(const float* W, int ldw, int K, int N, bf16_t* Wt, int bid, int nb, char* smem) {
  const int tk = K >> 6, tn = N >> 6;
  for (int t = bid; t < tk * tn; t += nb) transpose_tile(W, ldw, Wt, K, (t % tk) * 64, (t / tk) * 64, smem);
}

DI void rmsnorm_rows(const float* __restrict__ x, const float* __restrict__ g, bf16_t* __restrict__ h, float* xcopy, int rows,
                     int bid, int nb) {
  const int lane = TID() & 63, wave = TID() >> 6;
  for (int r = bid * 4 + wave; r < rows; r += nb * 4) {
    const float4* xr = (const float4*)(x + (size_t)r * 1024);
    float4 v[4]; float ss = 0.f;
#pragma unroll
    for (int i = 0; i < 4; ++i) { v[i] = xr[lane + 64 * i]; ss += v[i].x * v[i].x + v[i].y * v[i].y + v[i].z * v[i].z + v[i].w * v[i].w; }
    ss = wave_sum(ss);
    const float rs = rsqrtf(ss * (1.f / 1024.f) + 1e-6f);
#pragma unroll
    for (int i = 0; i < 4; ++i) {
      const float4 gg = ((const float4*)g)[lane + 64 * i];
      uint2 o; o.x = pack2(v[i].x * rs * gg.x, v[i].y * rs * gg.y); o.y = pack2(v[i].z * rs * gg.z, v[i].w * rs * gg.w);
      *(uint2*)(h + (size_t)r * 1024 + (lane + 64 * i) * 4) = o;
      if (xcopy) ((float4*)(xcopy + (size_t)r * 1024))[lane + 64 * i] = v[i];
    }
  }
}

template <int DQK, bool CAUSAL>
DI void attn_item(const bf16_t* __restrict__ Q, int ldq, const bf16_t* __restrict__ Kp, int ldk, const bf16_t* __restrict__ VT, int ldvt,
                  int ntiles, int q0, bf16_t* __restrict__ out, int ldo, char* smem) {
  constexpr int KS = DQK + 8, NS = DQK / 16, KCH = DQK / 8;
  bf16_t* Ks = (bf16_t*)smem;
  bf16_t* Vs = Ks + 64 * KS;
  const int tid = TID(), lane = tid & 63, wave = tid >> 6, ql = lane & 31, hh = lane >> 5;
  const int qrow = q0 + wave * 32 + ql;
  bf16x8 bq[NS];
#pragma unroll
  for (int s = 0; s < NS; ++s) bq[s] = *(const bf16x8*)(Q + (size_t)qrow * ldq + s * 16 + hh * 8);
  f32x16 ot[4];
#pragma unroll
  for (int d = 0; d < 4; ++d)
#pragma unroll
    for (int i = 0; i < 16; ++i) ot[d][i] = 0.f;
  float mrun = -INFINITY, lrun = 0.f;
  for (int kt = 0; kt < ntiles; ++kt) {
    __syncthreads();
    for (int c = tid; c < 64 * KCH; c += 256) {
      const int row = c / KCH, cc = c % KCH;
      *(uint4*)(Ks + row * KS + cc * 8) = *(const uint4*)(Kp + (size_t)(kt * 64 + row) * ldk + cc * 8);
    }
#pragma unroll
    for (int c0 = 0; c0 < 4; ++c0) {
      const int c = tid + c0 * 256, row = c >> 3, cc = c & 7;
      *(uint4*)(Vs + row * 72 + cc * 8) = *(const uint4*)(VT + (size_t)row * ldvt + kt * 64 + cc * 8);
    }
    __syncthreads();
    f32x16 st[2];
#pragma unroll
    for (int kb = 0; kb < 2; ++kb) {
#pragma unroll
      for (int i = 0; i < 16; ++i) st[kb][i] = 0.f;
#pragma unroll
      for (int s = 0; s < NS; ++s) {
        const bf16x8 a = *(const bf16x8*)(Ks + (kb * 32 + ql) * KS + s * 16 + hh * 8);
        st[kb] = __builtin_amdgcn_mfma_f32_32x32x16_bf16(a, bq[s], st[kb], 0, 0, 0);
      }
    }
    float mx = -INFINITY;
#pragma unroll
    for (int kb = 0; kb < 2; ++kb)
#pragma unroll
      for (int i = 0; i < 16; ++i) {
        if (CAUSAL) {
          const int key = kt * 64 + kb * 32 + (i & 3) + 8 * (i >> 2) + 4 * hh;
          if (key > qrow) st[kb][i] = -INFINITY;
        }
        mx = fmaxf(mx, st[kb][i]);
      }
    mx = fmaxf(mx, __shfl_xor(mx, 32));
    const float mnew = fmaxf(mrun, mx);
    const float alpha = __builtin_amdgcn_exp2f(mrun - mnew);
    float ps = 0.f;
#pragma unroll
    for (int kb = 0; kb < 2; ++kb)
#pragma unroll
      for (int i = 0; i < 16; ++i) { const float pv = __builtin_amdgcn_exp2f(st[kb][i] - mnew); st[kb][i] = pv; ps += pv; }
    ps += __shfl_xor(ps, 32);
    lrun = lrun * alpha + ps;
    mrun = mnew;
#pragma unroll
    for (int d = 0; d < 4; ++d)
#pragma unroll
      for (int i = 0; i < 16; ++i) ot[d][i] *= alpha;
#pragma unroll
    for (int kb = 0; kb < 2; ++kb)
#pragma unroll
      for (int s2 = 0; s2 < 2; ++s2) {
        unsigned pk[4];
#pragma unroll
        for (int e = 0; e < 4; ++e) pk[e] = pack2(st[kb][8 * s2 + 2 * e], st[kb][8 * s2 + 2 * e + 1]);
        const bf16x8 pb = __builtin_bit_cast(bf16x8, uint4{pk[0], pk[1], pk[2], pk[3]});
#pragma unroll
        for (int d = 0; d < 4; ++d) {
          const bf16_t* vp = Vs + (d * 32 + ql) * 72 + kb * 32 + s2 * 16 + hh * 4;
          const s16x4 lo = *(const s16x4*)vp;
          const s16x4 hi = *(const s16x4*)(vp + 8);
          const bf16x8 av = __builtin_shufflevector(lo, hi, 0, 1, 2, 3, 4, 5, 6, 7);
          ot[d] = __builtin_amdgcn_mfma_f32_32x32x16_bf16(av, pb, ot[d], 0, 0, 0);
        }
      }
  }
  const float inv = 1.f / lrun;
#pragma unroll
  for (int d = 0; d < 4; ++d)
#pragma unroll
    for (int g4 = 0; g4 < 4; ++g4) {
      uint2 o; o.x = pack2(ot[d][4 * g4] * inv, ot[d][4 * g4 + 1] * inv); o.y = pack2(ot[d][4 * g4 + 2] * inv, ot[d][4 * g4 + 3] * inv);
      *(uint2*)(out + (size_t)qrow * ldo + d * 32 + 8 * g4 + 4 * hh) = o;
    }
}


template <int DQK, bool CAUSAL>
DI void attn_item_pf(const bf16_t* __restrict__ Q, int ldq, const bf16_t* Kp, int ldk, const bf16_t* VT, int ldvt,
                  int ntiles, int q0, bf16_t* __restrict__ out, int ldo, char* smem) {
  constexpr int KS = DQK + 8, NS = DQK / 16, KCH = DQK / 8;
  bf16_t* Ks = (bf16_t*)smem;
  bf16_t* Vs = Ks + 64 * KS;
  const int tid = TID(), lane = tid & 63, wave = tid >> 6, ql = lane & 31, hh = lane >> 5;
  const int qrow = q0 + wave * 32 + ql;
  bf16x8 bq[NS];
#pragma unroll
  for (int s = 0; s < NS; ++s) bq[s] = *(const bf16x8*)(Q + (size_t)qrow * ldq + s * 16 + hh * 8);
  f32x16 ot[4];
#pragma unroll
  for (int d = 0; d < 4; ++d)
#pragma unroll
    for (int i = 0; i < 16; ++i) ot[d][i] = 0.f;
  float mrun = -INFINITY, lrun = 0.f;
  Kp = uniform_ptr(Kp); VT = uniform_ptr(VT);
  constexpr int KR = KCH / 4;
  static_assert(KR == 6, "prefetch variant is written for DQK = 192");
  u32x4 kreg[KR], vreg[4];
  const unsigned kvoff = (unsigned)(((tid >> 2) * ldk + (tid & 3) * 8) * 2);
  const unsigned vvoff = (unsigned)(((tid >> 3) * ldvt + (tid & 7) * 8) * 2);
#define GLOADS(dst, voff, sbase) asm volatile("global_load_dwordx4 %0, %1, %2" : "=v"(dst) : "v"(voff), "s"(sbase))
#define ATT_ISSUE(kt_)                                                                                        \
  {                                                                                                           \
    _Pragma("unroll") for (int c0 = 0; c0 < KR; ++c0) GLOADS(kreg[c0], kvoff, Kp + (size_t)(kt_) * 64 * ldk + c0 * 32);   \
    _Pragma("unroll") for (int c0 = 0; c0 < 4; ++c0) GLOADS(vreg[c0], vvoff, VT + (size_t)(c0 * 32) * ldvt + (kt_) * 64); \
  }
#define ATT_LAND()                                                                                            \
  {                                                                                                           \
    asm volatile("s_waitcnt vmcnt(0)" : "+v"(kreg[0]), "+v"(kreg[1]), "+v"(kreg[2]), "+v"(kreg[3]), "+v"(kreg[4]), "+v"(kreg[5]), \
                 "+v"(vreg[0]), "+v"(vreg[1]), "+v"(vreg[2]), "+v"(vreg[3]));                                 \
    _Pragma("unroll") for (int c0 = 0; c0 < KR; ++c0) *(u32x4*)(Ks + (tid >> 2) * KS + ((tid & 3) + 4 * c0) * 8) = kreg[c0];   \
    _Pragma("unroll") for (int c0 = 0; c0 < 4; ++c0) *(u32x4*)(Vs + ((tid >> 3) + 32 * c0) * 72 + (tid & 7) * 8) = vreg[c0];   \
  }
  __syncthreads();
  ATT_ISSUE(0);
  ATT_LAND();
  __syncthreads();
  for (int kt = 0; kt < ntiles; ++kt) {
    {
      const int ktn = (kt + 1 < ntiles) ? kt + 1 : kt;
      ATT_ISSUE(ktn);
    }
    __builtin_amdgcn_sched_barrier(0);
    f32x16 st[2];
#pragma unroll
    for (int kb = 0; kb < 2; ++kb) {
#pragma unroll
      for (int i = 0; i < 16; ++i) st[kb][i] = 0.f;
#pragma unroll
      for (int s = 0; s < NS; ++s) {
        const bf16x8 a = *(const bf16x8*)(Ks + (kb * 32 + ql) * KS + s * 16 + hh * 8);
        st[kb] = __builtin_amdgcn_mfma_f32_32x32x16_bf16(a, bq[s], st[kb], 0, 0, 0);
      }
    }
    float mx = -INFINITY;
#pragma unroll
    for (int kb = 0; kb < 2; ++kb)
#pragma unroll
      for (int i = 0; i < 16; ++i) {
        if (CAUSAL) {
          const int key = kt * 64 + kb * 32 + (i & 3) + 8 * (i >> 2) + 4 * hh;
          if (key > qrow) st[kb][i] = -INFINITY;
        }
        mx = fmaxf(mx, st[kb][i]);
      }
    mx = fmaxf(mx, __shfl_xor(mx, 32));
    const float mnew = fmaxf(mrun, mx);
    const float alpha = __builtin_amdgcn_exp2f(mrun - mnew);
    float ps = 0.f;
#pragma unroll
    for (int kb = 0; kb < 2; ++kb)
#pragma unroll
      for (int i = 0; i < 16; ++i) { const float pv = __builtin_amdgcn_exp2f(st[kb][i] - mnew); st[kb][i] = pv; ps += pv; }
    ps += __shfl_xor(ps, 32);
    lrun = lrun * alpha + ps;
    mrun = mnew;
#pragma unroll
    for (int d = 0; d < 4; ++d)
#pragma unroll
      for (int i = 0; i < 16; ++i) ot[d][i] *= alpha;
#pragma unroll
    for (int kb = 0; kb < 2; ++kb)
#pragma unroll
      for (int s2 = 0; s2 < 2; ++s2) {
        unsigned pk[4];
#pragma unroll
        for (int e = 0; e < 4; ++e) pk[e] = pack2(st[kb][8 * s2 + 2 * e], st[kb][8 * s2 + 2 * e + 1]);
        const bf16x8 pb = __builtin_bit_cast(bf16x8, uint4{pk[0], pk[1], pk[2], pk[3]});
#pragma unroll
        for (int d = 0; d < 4; ++d) {
          const bf16_t* vp = Vs + (d * 32 + ql) * 72 + kb * 32 + s2 * 16 + hh * 4;
          const s16x4 lo = *(const s16x4*)vp;
          const s16x4 hi = *(const s16x4*)(vp + 8);
          const bf16x8 av = __builtin_shufflevector(lo, hi, 0, 1, 2, 3, 4, 5, 6, 7);
          ot[d] = __builtin_amdgcn_mfma_f32_32x32x16_bf16(av, pb, ot[d], 0, 0, 0);
        }
      }
    __builtin_amdgcn_sched_barrier(0);
    __syncthreads();
    ATT_LAND();
    __syncthreads();
  }
#undef ATT_ISSUE
#undef ATT_LAND
#undef GLOADS
  const float inv = 1.f / lrun;
#pragma unroll
  for (int d = 0; d < 4; ++d)
#pragma unroll
    for (int g4 = 0; g4 < 4; ++g4) {
      uint2 o; o.x = pack2(ot[d][4 * g4] * inv, ot[d][4 * g4 + 1] * inv); o.y = pack2(ot[d][4 * g4 + 2] * inv, ot[d][4 * g4 + 3] * inv);
      *(uint2*)(out + (size_t)qrow * ldo + d * 32 + 8 * g4 + 4 * hh) = o;
    }
}

DI void rwkv_scan_unit(const Params& p, int l, int u, char* smem) {
  const int tid = TID();
  const int bl = u >> 5, hd = (u >> 2) & 7, rg = u & 3;
  const int kq = tid & 15, g16 = tid >> 4;
  const bf16_t* RKV = (const bf16_t*)(p.ws + R_RKV) + (size_t)bl * SEQ * 1536;
  const bf16_t* Pm = (const bf16_t*)(p.ws + R_P) + (size_t)bl * SEQ * PLD;
  bf16_t* Y = (bf16_t*)(p.ws + R_YRW) + (size_t)bl * SEQ * 512;
  float* sm = (float*)smem;
  constexpr int BUFF = 5 * 1024 + 256 + 32;
  const int kc = hd * 64 + kq * 4;
  const float4 kk_w = *(const float4*)(p.in[27] + l * 512 + kc);
  const float4 ka_w = *(const float4*)(p.in[28] + l * 512 + kc);
  f32v2_t SA = {0.f, 0.f}, SB = {0.f, 0.f};
  uint2 g_r, g_k, g_w, g_a; bf16_t g_v;
  auto gload = [&](int c) {
    const int tok = c * 16 + g16;
    g_r = *(const uint2*)(RKV + (size_t)tok * 1536 + kc);
    g_k = *(const uint2*)(RKV + (size_t)tok * 1536 + 512 + kc);
    g_v = RKV[(size_t)tok * 1536 + 1024 + hd * 64 + rg * 16 + kq];
    g_w = *(const uint2*)(Pm + (size_t)tok * PLD + PC_RW + kc);
    g_a = *(const uint2*)(Pm + (size_t)tok * PLD + PC_RW + 512 + kc);
  };
  auto derive = [&](int buf) {
    float* b = sm + buf * BUFF;
    const float r[4] = {bflo(g_r.x), bfhi(g_r.x), bflo(g_r.y), bfhi(g_r.y)};
    const float k[4] = {bflo(g_k.x), bfhi(g_k.x), bflo(g_k.y), bfhi(g_k.y)};
    const float w[4] = {bflo(g_w.x), bfhi(g_w.x), bflo(g_w.y), bfhi(g_w.y)};
    const float a[4] = {bflo(g_a.x), bfhi(g_a.x), bflo(g_a.y), bfhi(g_a.y)};
    const float kkw[4] = {kk_w.x, kk_w.y, kk_w.z, kk_w.w};
    const float kaw[4] = {ka_w.x, ka_w.y, ka_w.z, ka_w.w};
    float kk[4], ss = 0.f;
#pragma unroll
    for (int e = 0; e < 4; ++e) { kk[e] = k[e] * kkw[e]; ss += kk[e] * kk[e]; }
    ss = red16(ss);
    const float rn = rsqrtf(ss + 1e-12f);
    float dwr[4], dw[4], dk[4], dn[4], db[4];
    float br = 0.f, khr = 0.f;
#pragma unroll
    for (int e = 0; e < 4; ++e) {
      dw[e] = __expf(-0.6065306597126334f * sigm(w[e]));
      const float kn = kk[e] * rn;
      dn[e] = -kn; db[e] = kn * a[e];
      dk[e] = k[e] * (1.f + (a[e] - 1.f) * kaw[e]);
      dwr[e] = dw[e] * r[e];
      br += db[e] * r[e]; khr += dk[e] * r[e];
    }
    br = red16(br); khr = red16(khr);
#pragma unroll
    for (int e = 0; e < 4; ++e) dwr[e] += dn[e] * br;
    *(float4*)(b + 0 * 1024 + g16 * 64 + kq * 4) = float4{dwr[0], dwr[1], dwr[2], dwr[3]};
    *(float4*)(b + 1 * 1024 + g16 * 64 + kq * 4) = float4{dw[0], dw[1], dw[2], dw[3]};
    *(float4*)(b + 2 * 1024 + g16 * 64 + kq * 4) = float4{dk[0], dk[1], dk[2], dk[3]};
    *(float4*)(b + 3 * 1024 + g16 * 64 + kq * 4) = float4{dn[0], dn[1], dn[2], dn[3]};
    *(float4*)(b + 4 * 1024 + g16 * 64 + kq * 4) = float4{db[0], db[1], db[2], db[3]};
    b[5 * 1024 + g16 * 16 + kq] = bf2f(g_v);
    if (kq == 0) b[5 * 1024 + 256 + g16] = khr;
  };
  __syncthreads();
  gload(0); derive(0);
  __syncthreads();
  constexpr int NC = SEQ / 16;
  for (int c = 0; c < NC; ++c) {
    if (c + 1 < NC) gload(c + 1);
    const float* b = sm + (c & 1) * BUFF;
    float4 nk = *(const float4*)(b + 3 * 1024 + kq * 4);
    float4 w = *(const float4*)(b + 1 * 1024 + kq * 4);
    float4 bb = *(const float4*)(b + 4 * 1024 + kq * 4);
    float4 kh = *(const float4*)(b + 2 * 1024 + kq * 4);
    float4 wr = *(const float4*)(b + 0 * 1024 + kq * 4);
    float v = b[5 * 1024 + g16];
#pragma unroll
    for (int h = 0; h < 2; ++h) {
      float yp[8];
#pragma unroll
      for (int s = 0; s < 8; ++s) {
        const int t = h * 8 + s;
        float4 nk2, w2, bb2, kh2, wr2; float v2;
        if (t < 15) {
          nk2 = *(const float4*)(b + 3 * 1024 + (t + 1) * 64 + kq * 4);
          w2 = *(const float4*)(b + 1 * 1024 + (t + 1) * 64 + kq * 4);
          bb2 = *(const float4*)(b + 4 * 1024 + (t + 1) * 64 + kq * 4);
          kh2 = *(const float4*)(b + 2 * 1024 + (t + 1) * 64 + kq * 4);
          wr2 = *(const float4*)(b + 0 * 1024 + (t + 1) * 64 + kq * 4);
          v2 = b[5 * 1024 + (t + 1) * 16 + g16];
        }
        const f32v2_t nka = {nk.x, nk.y}, nkb = {nk.z, nk.w}, wra = {wr.x, wr.y}, wrb = {wr.z, wr.w};
        const f32v2_t wa = {w.x, w.y}, wb = {w.z, w.w}, ba = {bb.x, bb.y}, bbv = {bb.z, bb.w}, kha = {kh.x, kh.y}, khb = {kh.z, kh.w};
        const f32v2_t ps = SA * nka + SB * nkb;
        const f32v2_t py = SA * wra + SB * wrb;
        float sa = ps.x + ps.y;
        yp[s] = py.x + py.y;
        sa = red16(sa);
        const f32v2_t sa2 = {sa, sa}, vv2 = {v, v};
        SA = SA * wa + (sa2 * ba + vv2 * kha);
        SB = SB * wb + (sa2 * bbv + vv2 * khb);
        if (t < 15) { nk = nk2; w = w2; bb = bb2; kh = kh2; wr = wr2; v = v2; }
      }
      const bool b2 = (kq & 4) != 0, b1 = (kq & 2) != 0, b0 = (kq & 1) != 0;
#pragma unroll
      for (int i = 0; i < 8; ++i) yp[i] += dppf<0x128>(yp[i]);
      float q4[4];
#pragma unroll
      for (int i = 0; i < 4; ++i) { const float keep = b2 ? yp[i + 4] : yp[i], send = b2 ? yp[i] : yp[i + 4]; q4[i] = keep + dppf<0x141>(send); }
      float q2[2];
#pragma unroll
      for (int i = 0; i < 2; ++i) { const float keep = b1 ? q4[i + 2] : q4[i], send = b1 ? q4[i] : q4[i + 2]; q2[i] = keep + dppf<0x4E>(send); }
      const float keep = b0 ? q2[1] : q2[0], send = b0 ? q2[0] : q2[1];
      float yv = keep + dppf<0xB1>(send);
      const int tt = h * 8 + (kq & 7);
      yv += b[5 * 1024 + tt * 16 + g16] * b[5 * 1024 + 256 + tt];
      if ((kq >> 3) == h) Y[(size_t)(c * 16 + tt) * 512 + hd * 64 + rg * 16 + g16] = f2bf(yv);
    }
    if (c + 1 < NC) derive((c + 1) & 1);
    __syncthreads();
  }
}

DI void hgrn_scan_unit(const Params& p, int l, int u, char* smem) {
  const int tid = TID();
  const int bl = u >> 5, hd = (u >> 3) & 3, vg = u & 7;
  const int kq = tid & 15, g16 = tid >> 4;
  bf16_t* Pm = (bf16_t*)(p.ws + R_P) + (size_t)bl * SEQ * PLD;
  float* sm = (float*)smem;
  constexpr int BUFF = 2 * 2048 + 256 + 16;
  const int kc = hd * 128 + kq * 8;
  float lb[8];
#pragma unroll
  for (int e = 0; e < 8; ++e) {
    if (l == 0) lb[e] = 0.f;
    else { const float x0 = p.in[9][kc + e], x1 = p.in[9][512 + kc + e]; lb[e] = 1.f / (1.f + expf(x0 - x1)); }
  }
  f32v2_t S2[4];
#pragma unroll
  for (int e = 0; e < 4; ++e) S2[e] = f32v2_t{0.f, 0.f};
  uint4 g_q, g_f; bf16_t g_v;
  const int vcol = PC_HG + 1024 + hd * 128 + vg * 16;
  auto gload = [&](int c) {
    const int tok = c * 16 + g16;
    g_q = *(const uint4*)(Pm + (size_t)tok * PLD + PC_HG + kc);
    g_f = *(const uint4*)(Pm + (size_t)tok * PLD + PC_HG + 512 + kc);
    g_v = Pm[(size_t)tok * PLD + vcol + kq];
  };
  auto derive = [&](int buf) {
    float* b = sm + buf * BUFF;
    const unsigned qu[4] = {g_q.x, g_q.y, g_q.z, g_q.w}, fu[4] = {g_f.x, g_f.y, g_f.z, g_f.w};
    float fq[8], f[8], cs = 0.f;
#pragma unroll
    for (int e = 0; e < 8; ++e) {
      const float q = (e & 1) ? bfhi(qu[e >> 1]) : bflo(qu[e >> 1]);
      const float fx = (e & 1) ? bfhi(fu[e >> 1]) : bflo(fu[e >> 1]);
      f[e] = lb[e] + (1.f - lb[e]) * sigm(fx);
      fq[e] = f[e] * q;
      cs += (1.f - f[e]) * q;
    }
    cs = red16(cs);
    *(float4*)(b + g16 * 128 + kq * 8) = float4{fq[0], fq[1], fq[2], fq[3]};
    *(float4*)(b + g16 * 128 + kq * 8 + 4) = float4{fq[4], fq[5], fq[6], fq[7]};
    *(float4*)(b + 2048 + g16 * 128 + kq * 8) = float4{f[0], f[1], f[2], f[3]};
    *(float4*)(b + 2048 + g16 * 128 + kq * 8 + 4) = float4{f[4], f[5], f[6], f[7]};
    b[4096 + g16 * 16 + kq] = bf2f(g_v);
    if (kq == 0) b[4096 + 256 + g16] = cs;
  };
  __syncthreads();
  gload(0); derive(0);
  __syncthreads();
  constexpr int NC = SEQ / 16;
  for (int c = 0; c < NC; ++c) {
    if (c + 1 < NC) gload(c + 1);
    const float* b = sm + (c & 1) * BUFF;
    float4 q0 = *(const float4*)(b + kq * 8), q1 = *(const float4*)(b + kq * 8 + 4);
    float4 f0 = *(const float4*)(b + 2048 + kq * 8), f1 = *(const float4*)(b + 2048 + kq * 8 + 4);
    float v = b[4096 + g16];
#pragma unroll
    for (int h = 0; h < 2; ++h) {
      float yp[8];
#pragma unroll
      for (int s = 0; s < 8; ++s) {
        const int t = h * 8 + s;
        float4 q0n, q1n, f0n, f1n; float vn;
        if (t < 15) {
          q0n = *(const float4*)(b + (t + 1) * 128 + kq * 8); q1n = *(const float4*)(b + (t + 1) * 128 + kq * 8 + 4);
          f0n = *(const float4*)(b + 2048 + (t + 1) * 128 + kq * 8); f1n = *(const float4*)(b + 2048 + (t + 1) * 128 + kq * 8 + 4);
          vn = b[4096 + (t + 1) * 16 + g16];
        }
        const f32v2_t fq2[4] = {{q0.x, q0.y}, {q0.z, q0.w}, {q1.x, q1.y}, {q1.z, q1.w}};
        const f32v2_t ff2[4] = {{f0.x, f0.y}, {f0.z, f0.w}, {f1.x, f1.y}, {f1.z, f1.w}};
        const f32v2_t vv2 = {v, v};
        f32v2_t o2 = S2[0] * fq2[0];
#pragma unroll
        for (int e = 1; e < 4; ++e) o2 = S2[e] * fq2[e] + o2;
#pragma unroll
        for (int e = 0; e < 4; ++e) S2[e] = ff2[e] * (S2[e] - vv2) + vv2;
        yp[s] = o2.x + o2.y;
        if (t < 15) { q0 = q0n; q1 = q1n; f0 = f0n; f1 = f1n; v = vn; }
      }
      const bool b2 = (kq & 4) != 0, b1 = (kq & 2) != 0, b0 = (kq & 1) != 0;
#pragma unroll
      for (int i = 0; i < 8; ++i) yp[i] += dppf<0x128>(yp[i]);
      float q4[4];
#pragma unroll
      for (int i = 0; i < 4; ++i) { const float keep = b2 ? yp[i + 4] : yp[i], send = b2 ? yp[i] : yp[i + 4]; q4[i] = keep + dppf<0x141>(send); }
      float q2[2];
#pragma unroll
      for (int i = 0; i < 2; ++i) { const float keep = b1 ? q4[i + 2] : q4[i], send = b1 ? q4[i] : q4[i + 2]; q2[i] = keep + dppf<0x4E>(send); }
      const float keep = b0 ? q2[1] : q2[0], send = b0 ? q2[0] : q2[1];
      float ov = keep + dppf<0xB1>(send);
      const int tt = h * 8 + (kq & 7);
      ov += b[4096 + tt * 16 + g16] * b[4096 + 256 + tt];
      if ((kq >> 3) == h) Pm[(size_t)(c * 16 + tt) * PLD + vcol + g16] = f2bf(ov);
    }
    if (c + 1 < NC) derive((c + 1) & 1);
    __syncthreads();
  }
}

DI void s5_scan_unit(const Params& p, int l, int u, char* smem) {
  const int tid = TID(), lane = tid & 63, wave = tid >> 6;
  const int idx = u * 4 + wave, bl = idx >> 5, g = idx & 31;
  const bf16_t* Pm = (const bf16_t*)(p.ws + R_P) + (size_t)bl * SEQ * PLD + PC_S5 + g * 16;
  bf16_t* Z = (bf16_t*)(p.ws + R_ZS5) + (size_t)bl * SEQ * 512 + g * 16;
  constexpr int BUS = 132;
  float* buT = (float*)smem + wave * (16 * BUS);
  bf16_t* hist = (bf16_t*)(smem + 4 * 16 * BUS * 4) + wave * (16 * 136);
  const float2 ab = *(const float2*)((const float*)(p.ws + OFF_S5AB) + (g * 64 + lane) * 2);
  const int l16 = lane & 15, quad = lane >> 4;
  bf16x8 bbf[8];
  {
    const float* bbp = (const float*)(p.ws + OFF_S5BB);
#pragma unroll
    for (int jb = 0; jb < 8; ++jb) {
      const int col = jb * 16 + l16, nn = col & 63, im = col >> 6;
      unsigned pk[4] = {0u, 0u, 0u, 0u};
      if (quad < 2) {
        const float* src = bbp + (size_t)(g * 64 + nn) * 32 + im * 16 + quad * 8;
#pragma unroll
        for (int e = 0; e < 4; ++e) pk[e] = pack2(src[2 * e], src[2 * e + 1]);
      }
      bbf[jb] = __builtin_bit_cast(bf16x8, uint4{pk[0], pk[1], pk[2], pk[3]});
    }
  }
  bf16x8 cf[4];
  {
    const float* Cre = p.in[16] + (size_t)l * 32768 + (size_t)(g * 16 + l16) * 64;
    const float* Cim = p.in[17] + (size_t)l * 32768 + (size_t)(g * 16 + l16) * 64;
#pragma unroll
    for (int ks = 0; ks < 4; ++ks) {
      unsigned pk[4];
#pragma unroll
      for (int e = 0; e < 4; ++e) {
        const int k = ks * 32 + quad * 8 + 2 * e;
        const float v0 = (k < 64) ? Cre[k] : -Cim[k - 64];
        const float v1 = (k < 64) ? Cre[k + 1] : -Cim[k + 1 - 64];
        pk[e] = pack2(v0, v1);
      }
      cf[ks] = __builtin_bit_cast(bf16x8, uint4{pk[0], pk[1], pk[2], pk[3]});
    }
  }
  const float dcoef = p.in[18][l * 512 + g * 16 + l16];
  float xr = 0.f, xi = 0.f;
  uint4 ua = uint4{0u, 0u, 0u, 0u};
  bf16_t ue[4];
  auto gload = [&](int c) {
    if (quad < 2) ua = *(const uint4*)(Pm + (size_t)(c * 16 + l16) * PLD + quad * 8);
#pragma unroll
    for (int r = 0; r < 4; ++r) ue[r] = Pm[(size_t)(c * 16 + quad * 4 + r) * PLD + l16];
  };
  __syncthreads();
  gload(0);
  constexpr int NC = SEQ / 16;
  for (int c = 0; c < NC; ++c) {
    const bf16x8 afr = __builtin_bit_cast(bf16x8, ua);
    float us[4];
#pragma unroll
    for (int r = 0; r < 4; ++r) us[r] = bf2f(ue[r]);
#pragma unroll
    for (int jb = 0; jb < 8; ++jb) {
      f32x4 acc = {0.f, 0.f, 0.f, 0.f};
      acc = __builtin_amdgcn_mfma_f32_16x16x32_bf16(afr, bbf[jb], acc, 0, 0, 0);
#pragma unroll
      for (int r = 0; r < 4; ++r) buT[(quad * 4 + r) * BUS + jb * 16 + l16] = acc[r];
    }
    if (c + 1 < NC) gload(c + 1);
    __syncthreads();
#pragma unroll
    for (int t = 0; t < 16; ++t) {
      const float ur = buT[t * BUS + lane], ui = buT[t * BUS + 64 + lane];
      const float nr = ab.x * xr - ab.y * xi + ur;
      const float ni = ab.x * xi + ab.y * xr + ui;
      xr = nr; xi = ni;
      hist[t * 136 + lane] = f2bf(xr);
      hist[t * 136 + 64 + lane] = f2bf(xi);
    }
    __syncthreads();
    f32x4 acc = {0.f, 0.f, 0.f, 0.f};
#pragma unroll
    for (int ks = 0; ks < 4; ++ks) {
      const bf16x8 a = *(const bf16x8*)(hist + l16 * 136 + ks * 32 + quad * 8);
      acc = __builtin_amdgcn_mfma_f32_16x16x32_bf16(a, cf[ks], acc, 0, 0, 0);
    }
#pragma unroll
    for (int r = 0; r < 4; ++r) {
      const int t = quad * 4 + r;
      const float y = acc[r] + dcoef * us[r];
      const float z = y * sigm(1.5957691216057308f * (y + 0.044715f * y * y * y));
      Z[(size_t)(c * 16 + t) * 512 + l16] = f2bf(z);
    }
  }
}

#define GSYNC() xcd_barrier(xb)
#define TILE_MAP(u_, ntm_, tm_, tn_) { const int _x = (u_) & 7, _li = (u_) >> 3, _per = (ntm_) >> 3; tm_ = _x * _per + (_li % _per); tn_ = _li / _per; }
__global__ void __launch_bounds__(256, 2) mega_kernel(Params p) {
  cg::grid_group grid = cg::this_grid();
  __shared__ __attribute__((aligned(16))) char smem[SMEM_BYTES];
  __shared__ uint4 xb_words;
  const int bid = blockIdx.x, nb = gridDim.x;
  if (p.ws == nullptr) grid.sync();
  if (threadIdx.x == 0) xb_words = make_uint4(0u, 0u, 0u, 0u);
  __syncthreads();
  const XcdBarrier xb = xcd_barrier_post((unsigned*)(p.ws + OFF_BAR), (volatile LAS unsigned*)&xb_words);
  char* ws = p.ws;
  float* X = p.out;
  bf16_t* Wt_in = (bf16_t*)(ws + OFF_WIN);
  bf16_t* Wt_q = (bf16_t*)(ws + OFF_WQ);
  bf16_t* Wt_br = (bf16_t*)(ws + OFF_WBR);
  bf16_t* Wt_out = (bf16_t*)(ws + OFF_WOUT);
  bf16_t* Wt_glu = (bf16_t*)(ws + OFF_WGLU);
  bf16_t* Wt_wup = (bf16_t*)(ws + OFF_WWUP);
  bf16_t* Wt_aup = (bf16_t*)(ws + OFF_WAUP);
  bf16_t* Wt_gup = (bf16_t*)(ws + OFF_WGUP);
  bf16_t* Wt_v = (bf16_t*)(ws + OFF_WV);
  bf16_t* Wt_xkv = (bf16_t*)(ws + OFF_WXKV);
  bf16_t* Hb = (bf16_t*)(ws + OFF_H);
  bf16_t* Vfirst = (bf16_t*)(ws + OFF_VFIRST);
  bf16_t* Kx = (bf16_t*)(ws + OFF_KX);
  bf16_t* VxT = (bf16_t*)(ws + OFF_VXT);
  bf16_t* Hm = (bf16_t*)(ws + OFF_HM);
  float* CosT = (float*)(ws + OFF_COS);
  float* SinT = (float*)(ws + OFF_SIN);
  bf16_t* Pm = (bf16_t*)(ws + R_P);
  bf16_t* Cqn = (bf16_t*)(ws + R_CQN);
  bf16_t* Qp = (bf16_t*)(ws + R_QP);
  bf16_t* KVlat = (bf16_t*)(ws + R_KVLAT);
  bf16_t* VTm = (bf16_t*)(ws + R_VT);
  bf16_t* RKV = (bf16_t*)(ws + R_RKV);
  bf16_t* Alora = (bf16_t*)(ws + R_ALORA);
  bf16_t* Yrw = (bf16_t*)(ws + R_YRW);
  bf16_t* Zs5 = (bf16_t*)(ws + R_ZS5);
  bf16_t* Ybr = (bf16_t*)(ws + R_YBR);
  bf16_t* Wt_xq = (bf16_t*)(ws + R_WXQ);
  bf16_t* Wt_xo = (bf16_t*)(ws + R_WXO);
  bf16_t* Wt_gu = (bf16_t*)(ws + R_WGU);
  bf16_t* Wt_down = (bf16_t*)(ws + R_WDOWN);
  bf16_t* Qx = (bf16_t*)(ws + R_QX);
  bf16_t* Ox = (bf16_t*)(ws + R_OX);
  bf16_t* GU = (bf16_t*)(ws + R_GU);
  const float LOG2E = 1.4426950408889634f;

  for (int l = 0; l < 2; ++l) {
    {
      PHASE_IDS
      const float* w_in = p.in[4] + (size_t)l * 1024 * P_IN;
      transpose_all(w_in, P_IN, 1024, P_IN, Wt_in, bid, nb, smem);
      transpose_all(p.in[36] + (size_t)l * 512 * 1024, 1024, 512, 1024, Wt_br + (size_t)1 * 1024 * 512, bid, nb, smem);
      transpose_all(p.in[37] + (size_t)l * 512 * 1024, 1024, 512, 1024, Wt_br + (size_t)2 * 1024 * 512, bid, nb, smem);
      transpose_all(p.in[38] + (size_t)l * 512 * 1024, 1024, 512, 1024, Wt_br + (size_t)3 * 1024 * 512, bid, nb, smem);
      transpose_all(p.in[39] + (size_t)l * 1024 * 1024, 1024, 1024, 1024, Wt_out, bid, nb, smem);
      transpose_all(p.in[19] + (size_t)l * 512 * 512, 512, 512, 512, Wt_glu, bid, nb, smem);
      transpose_all(p.in[23] + (size_t)l * 64 * 512, 512, 64, 512, Wt_wup, bid, nb, smem);
      transpose_all(p.in[25] + (size_t)l * 64 * 512, 512, 64, 512, Wt_aup, bid, nb, smem);
      transpose_all(p.in[26] + (size_t)l * 128 * 512, 512, 128, 512, Wt_gup, bid, nb, smem);
      transpose_all(p.in[43] + (size_t)l * 1024 * 2048, 2048, 1024, 2048, Wt_xkv, bid, nb, smem);
      const int gtid = bid * 256 + tid, gsz = nb * 256;
      {
        const float* w_uq = p.in[6] + (size_t)l * 256 * 768;
        const float* w_ukv = p.in[8] + (size_t)l * 128 * 1024;
        for (int e = gtid; e < 768 * 256; e += gsz) {
          const int n = e >> 8, kq = e & 255, hh = n / 192, j = n % 192;
          float v;
          if (j >= 128) v = w_uq[kq * 768 + n];
          else {
            const float4* a = (const float4*)(w_uq + kq * 768 + hh * 192);
            const float4* b = (const float4*)(w_ukv + j * 1024 + hh * 256);
            float v0 = 0.f, v1 = 0.f, v2 = 0.f, v3 = 0.f;
#pragma unroll 8
            for (int d = 0; d < 32; ++d) { const float4 x = a[d], y = b[d]; v0 += x.x * y.x; v1 += x.y * y.y; v2 += x.z * y.z; v3 += x.w * y.w; }
            v = (v0 + v1) + (v2 + v3);
          }
          Wt_q[e] = f2bf(v);
        }
        const float* w_bm = p.in[35] + (size_t)l * 512 * 1024;
        for (int e = gtid; e < 1024 * 512; e += gsz) {
          const int n = e & 1023, kk = e >> 10, hh = kk >> 7, j = kk & 127;
          const float* a = w_ukv + j * 1024 + hh * 256 + 128;
          const float* bcol = w_bm + (size_t)(hh * 128) * 1024 + n;
          float v0 = 0.f, v1 = 0.f, v2 = 0.f, v3 = 0.f;
#pragma unroll 4
          for (int d = 0; d < 128; d += 4) {
            const float4 x = *(const float4*)(a + d);
            v0 += x.x * bcol[(size_t)(d + 0) * 1024]; v1 += x.y * bcol[(size_t)(d + 1) * 1024];
            v2 += x.z * bcol[(size_t)(d + 2) * 1024]; v3 += x.w * bcol[(size_t)(d + 3) * 1024];
          }
          Wt_br[(size_t)n * 512 + kk] = f2bf((v0 + v1) + (v2 + v3));
        }
        if (l == 1) {
          const float* vd = p.in[32];
          const float* vu = p.in[33];
          for (int e = gtid; e < 512 * 1024; e += gsz) {
            const int n = e & 511, kk = e >> 9;
            float v0 = 0.f, v1 = 0.f, v2 = 0.f, v3 = 0.f;
#pragma unroll
            for (int r = 0; r < 32; r += 4) {
              const float4 x = *(const float4*)(vd + kk * 32 + r);
              v0 += x.x * vu[(r + 0) * 512 + n]; v1 += x.y * vu[(r + 1) * 512 + n];
              v2 += x.z * vu[(r + 2) * 512 + n]; v3 += x.w * vu[(r + 3) * 512 + n];
            }
            Wt_v[(size_t)n * 1024 + kk] = f2bf((v0 + v1) + (v2 + v3));
          }
        }
      }
      {
        float* abp = (float*)(ws + OFF_S5AB);
        float* bbp = (float*)(ws + OFF_S5BB);
        for (int e = gtid; e < 2048; e += gsz) {
          const int g = e >> 6;
          const float are = fminf(p.in[11][l * 2048 + e], -1e-4f), aim = p.in[12][l * 2048 + e];
          const float dt = expf(p.in[13][l * 32 + g]);
          const float mag = expf(dt * are);
          const float abre = mag * cosf(dt * aim), abim = mag * sinf(dt * aim);
          const float den = are * are + aim * aim;
          const float zre = ((abre - 1.f) * are + abim * aim) / den;
          const float zim = (abim * are - (abre - 1.f) * aim) / den;
          abp[e * 2] = abre; abp[e * 2 + 1] = abim;
          const float* Br = p.in[14] + (size_t)l * 32768 + (size_t)e * 16;
          const float* Bi = p.in[15] + (size_t)l * 32768 + (size_t)e * 16;
          for (int c = 0; c < 16; ++c) {
            bbp[e * 32 + c] = zre * Br[c] - zim * Bi[c];
            bbp[e * 32 + 16 + c] = zre * Bi[c] + zim * Br[c];
          }
        }
      }
      if (l == 0) rmsnorm_rows(p.in[0], p.in[3], Hb, X, T_ALL, bid, nb);
      else rmsnorm_rows(X, p.in[3] + 1024, Hb, nullptr, T_ALL, bid, nb);
      rmsnorm_rows(p.in[1], p.in[41] + l * 1024, Hm, nullptr, 1024, bid, nb);
    }
    GSYNC();

    for (int half = 0; half < 2; ++half) {
      const bf16_t* Hh = Hb + (size_t)half * TH * 1024;
      {
        const int n1 = 64 * 38;
        const int n2 = (half == 0) ? 8 * 16 : 0;
        int par = 0;
        for (int u = bid; u < n1 + n2; u += nb) {
          f32x4 acc[4][4];
          zero_acc<4>(acc);
          if (u < n1) {
            int tm, tn; TILE_MAP(u, 64, tm, tn);
            int tmn = tm, tnn = tn; if (u + nb < n1) TILE_MAP(u + nb, 64, tmn, tnn);
            gemm_acc<128>(Hh + (size_t)tm * 128 * 1024, 1024, Wt_in + (size_t)tn * 128 * 1024, 1024, 1024, smem, acc,
                          Hh + (size_t)tmn * 128 * 1024, 1024, Wt_in + (size_t)tnn * 128 * 1024, 1024, u != bid, par);
            EPI4_FOR(128) {
              const int row = tm * 128 + EPI_ROW, n = tn * 128 + EPI4_COL(128);
              if (n < GATE_OFF) {
                const int pc = (n < 448) ? n : n + 64;
                *(uint2*)(Pm + (size_t)row * PLD + pc) = pack4(acc[i][j]);
              }
            }
          } else {
            const int v = u - n1, tn = v % 16, tm = v / 16;
            gemm_acc<128>(Hm + (size_t)tm * 128 * 1024, 1024, Wt_xkv + (size_t)tn * 128 * 1024, 1024, 1024, smem, acc);
            EPI_FOR(128) {
              const int row = tm * 128 + EPI_ROW, n = tn * 128 + EPI_COL(128);
              const int b = row >> 8, m = row & 255, sel = n >> 10, hh = (n >> 8) & 3, d = n & 255;
              if (sel == 0) Kx[((size_t)(b * 4 + hh) * 256 + m) * 256 + d] = f2bf(acc[i][j][r]);
              else VxT[((size_t)(b * 4 + hh) * 256 + d) * 256 + m] = f2bf(acc[i][j][r]);
            }
          }
        }
      }
      GSYNC();
      {
      PHASE_IDS
        const float* qn = p.in[5] + l * 256;
        const float* kvn = p.in[7] + l * 128;
        const float* mu = p.in[21] + l * 1792;
        for (int tk = bid * 4 + wave; tk < TH; tk += nb * 4) {
          const int gtok = half * TH + tk, s = gtok & (SEQ - 1), bl = tk >> 12;
          const bf16_t* prow = Pm + (size_t)tk * PLD;
          {
            const uint2 cu = *(const uint2*)(prow + lane * 4);
            float f[4] = {bflo(cu.x), bfhi(cu.x), bflo(cu.y), bfhi(cu.y)};
            float ss = wave_sum(f[0] * f[0] + f[1] * f[1] + f[2] * f[2] + f[3] * f[3]);
            const float rs = rsqrtf(ss * (1.f / 256.f) + 1e-6f);
            const float4 g4 = *(const float4*)(qn + lane * 4);
            uint2 o; o.x = pack2(f[0] * rs * g4.x, f[1] * rs * g4.y); o.y = pack2(f[2] * rs * g4.z, f[3] * rs * g4.w);
            *(uint2*)(Cqn + (size_t)tk * 256 + lane * 4) = o;
          }
          {
            const unsigned cu = *(const unsigned*)(prow + 256 + lane * 2);
            const float f0 = bflo(cu), f1 = bfhi(cu);
            const float ss = wave_sum(f0 * f0 + f1 * f1);
            const float rs = rsqrtf(ss * (1.f / 128.f) + 1e-6f);
            const float v0 = f0 * rs * kvn[lane * 2], v1 = f1 * rs * kvn[lane * 2 + 1];
            const bf16_t b0 = f2bf(v0), b1 = f2bf(v1);
            *(unsigned*)(KVlat + (size_t)tk * 192 + lane * 2) = (unsigned)b0 | ((unsigned)b1 << 16);
            VTm[((size_t)bl * 128 + lane * 2) * SEQ + s] = b0;
            VTm[((size_t)bl * 128 + lane * 2 + 1) * SEQ + s] = b1;
          }
          if (lane < 32) {
            const float t1 = bf2f(prow[384 + lane]), t2 = bf2f(prow[384 + 32 + lane]);
            const float posf = (float)p.pos[gtok];
            const float invf = exp2f(-(float)lane * (13.287712379549449f / 32.f));
            const float ang = posf * invf;
            const float cs = cosf(ang), sn = sinf(ang);
            KVlat[(size_t)tk * 192 + 128 + lane] = f2bf(t1 * cs - t2 * sn);
            KVlat[(size_t)tk * 192 + 160 + lane] = f2bf(t1 * sn + t2 * cs);
            CosT[tk * 32 + lane] = cs; SinT[tk * 32 + lane] = sn;
          }
#pragma unroll
          for (int jj = 0; jj < 7; ++jj) {
            const int col = (jj * 64 + lane) * 4;
            const uint2 cu = *(const uint2*)(prow + PC_RW + col);
            uint2 pu = uint2{0u, 0u};
            if (s > 0) pu = *(const uint2*)(prow - PLD + PC_RW + col);
            const float4 m4 = *(const float4*)(mu + col);
            const float cv[4] = {bflo(cu.x), bfhi(cu.x), bflo(cu.y), bfhi(cu.y)};
            const float pv[4] = {bflo(pu.x), bfhi(pu.x), bflo(pu.y), bfhi(pu.y)};
            const float mm[4] = {m4.x, m4.y, m4.z, m4.w};
            float o[4];
#pragma unroll
            for (int e = 0; e < 4; ++e) o[e] = cv[e] + (pv[e] - cv[e]) * mm[e];
            if (col < 1536) {
              uint2 ov; ov.x = pack2(o[0], o[1]); ov.y = pack2(o[2], o[3]);
              *(uint2*)(RKV + (size_t)tk * 1536 + col) = ov;
              if (l == 0 && col >= 1024) *(uint2*)(Vfirst + (size_t)gtok * 512 + (col - 1024)) = ov;
            } else {
              int dc;
              if (col < 1600) { dc = col - 1536; for (int e = 0; e < 4; ++e) o[e] = tanhf(o[e]); }
              else if (col < 1664) { dc = 64 + col - 1600; }
              else { dc = 128 + col - 1664; for (int e = 0; e < 4; ++e) o[e] = sigm(o[e]); }
              uint2 ov; ov.x = pack2(o[0], o[1]); ov.y = pack2(o[2], o[3]);
              *(uint2*)(Alora + (size_t)tk * 256 + dc) = ov;
            }
          }
        }
      }
      GSYNC();
      {
      PHASE_IDS
        const int nq = 64 * 6, nl = 64 * 4;
        const int total = nq + 3 * nl + (l == 1 ? nl : 0);
        for (int u = bid; u < total; u += nb) {
          f32x4 acc[4][4];
          zero_acc<4>(acc);
          if (u < nq) {
            int tm, tn; TILE_MAP(u, 64, tm, tn);
            gemm_acc<128>(Cqn + (size_t)tm * 128 * 256, 256, Wt_q + (size_t)tn * 128 * 256, 256, 256, smem, acc);
            const float qs = 0.07216878364870322f * LOG2E;
            const int lane_ = tid & 63, wave_ = tid >> 6, wm_ = wave_ >> 1, wn_ = wave_ & 1, l16_ = lane_ & 15, quad_ = lane_ >> 4;
            const int gc = tn * 128 + wn_ * 64;
            const bool is_rope = (gc % 192) == 128;
#pragma unroll
            for (int i = 0; i < 4; ++i) {
              const int row = tm * 128 + wm_ * 64 + i * 16 + l16_;
              if (is_rope) {
#pragma unroll
                for (int j = 0; j < 2; ++j) {
                  const int fi = j * 16 + quad_ * 4;
                  const float4 cs = *(const float4*)(CosT + row * 32 + fi), sn = *(const float4*)(SinT + row * 32 + fi);
                  const float c4[4] = {cs.x, cs.y, cs.z, cs.w}, s4[4] = {sn.x, sn.y, sn.z, sn.w};
#pragma unroll
                  for (int r = 0; r < 4; ++r) {
                    const float t1 = acc[i][j][r], t2 = acc[i][j + 2][r];
                    acc[i][j][r] = t1 * c4[r] - t2 * s4[r]; acc[i][j + 2][r] = t1 * s4[r] + t2 * c4[r];
                  }
                }
              }
#pragma unroll
              for (int j = 0; j < 4; ++j) *(uint2*)(Qp + (size_t)row * 768 + gc + j * 16 + quad_ * 4) = pack4(acc[i][j] * qs);
            }
          } else if (u < nq + 3 * nl) {
            const int v = u - nq, which = v / nl, w2 = v % nl, tn = w2 % 4, tm = w2 / 4;
            if (which == 0) {
              gemm_acc<128>(Alora + (size_t)tm * 128 * 256, 256, Wt_wup + (size_t)tn * 128 * 64, 64, 64, smem, acc);
              const float* w0 = p.in[22] + l * 512;
              EPI4_FOR(128) {
                const int row = tm * 128 + EPI_ROW, n = tn * 128 + EPI4_COL(128);
                const float4 b4 = *(const float4*)(w0 + n);
                *(uint2*)(Pm + (size_t)row * PLD + PC_RW + n) = pack4(acc[i][j] + f32x4{b4.x, b4.y, b4.z, b4.w});
              }
            } else if (which == 1) {
              gemm_acc<128>(Alora + (size_t)tm * 128 * 256 + 64, 256, Wt_aup + (size_t)tn * 128 * 64, 64, 64, smem, acc);
              const float* a0 = p.in[24] + l * 512;
              EPI4_FOR(128) {
                const int row = tm * 128 + EPI_ROW, n = tn * 128 + EPI4_COL(128);
                const float4 b4 = *(const float4*)(a0 + n);
                f32x4 v = acc[i][j] + f32x4{b4.x, b4.y, b4.z, b4.w};
#pragma unroll
                for (int r = 0; r < 4; ++r) v[r] = sigm(v[r]);
                *(uint2*)(Pm + (size_t)row * PLD + PC_RW + 512 + n) = pack4(v);
              }
            } else {
              gemm_acc<128>(Alora + (size_t)tm * 128 * 256 + 128, 256, Wt_gup + (size_t)tn * 128 * 128, 128, 128, smem, acc);
              EPI4_FOR(128) {
                const int row = tm * 128 + EPI_ROW, n = tn * 128 + EPI4_COL(128);
                *(uint2*)(Pm + (size_t)row * PLD + PC_RW + 1024 + n) = pack4(acc[i][j]);
              }
            }
          } else {
            const int w2 = u - nq - 3 * nl, tn = w2 % 4, tm = w2 / 4;
            gemm_acc<128>(Hh + (size_t)tm * 128 * 1024, 1024, Wt_v + (size_t)tn * 128 * 1024, 1024, 1024, smem, acc);
            const float* vb = p.in[34];
            EPI4_FOR(128) {
              const int row = tm * 128 + EPI_ROW, n = tn * 128 + EPI4_COL(128);
              const float4 b4 = *(const float4*)(vb + n);
              const f32x4 lg = acc[i][j] + f32x4{b4.x, b4.y, b4.z, b4.w};
              const f32x4 vc = unpack4(*(const uint2*)(RKV + (size_t)row * 1536 + 1024 + n));
              const f32x4 vf = unpack4(*(const uint2*)(Vfirst + ((size_t)half * TH + row) * 512 + n));
              f32x4 o;
#pragma unroll
              for (int r = 0; r < 4; ++r) o[r] = vc[r] + (vf[r] - vc[r]) * sigm(lg[r]);
              *(uint2*)(RKV + (size_t)row * 1536 + 1024 + n) = pack4(o);
            }
          }
        }
      }
      GSYNC();
      {
        int first, count, step;
        if (nb == 512) {
          if (bid < 144) { first = bid; count = 1; step = 0; }
          else {
            int pi = -1;
            if (bid < 256) pi = bid - 144; else if (bid >= 400 && bid < 416) pi = 112 + (bid - 400);
            first = 144 + pi; count = (pi >= 0) ? 2 : 0; step = 255 - 2 * pi;
          }
        } else { first = bid; step = nb; count = (bid < 400) ? (400 - bid + nb - 1) / nb : 0; }
#pragma unroll 1
        for (int q = 0; q < count; ++q) {
          const int u = first + q * step;
          if (u < 144) {
            __builtin_amdgcn_s_setprio(3);
            if (u < 64) rwkv_scan_unit(p, l, u, smem);
            else if (u < 128) hgrn_scan_unit(p, l, u - 64, smem);
            else s5_scan_unit(p, l, u - 128, smem);
            __builtin_amdgcn_s_setprio(0);
          } else {
            const int it = u - 144, qt = 31 - (it >> 3), bl = (it >> 2) & 1, hh = it & 3;
            attn_item_pf<192, true>(Qp + (size_t)bl * SEQ * 768 + hh * 192, 768, KVlat + (size_t)bl * SEQ * 192, 192,
                                    VTm + (size_t)bl * 128 * SEQ, SEQ, (qt * 128 + 128) / 64, qt * 128,
                                    Pm + (size_t)bl * SEQ * PLD + hh * 128, PLD, smem);
          }
        }
        {
          unsigned char* G8 = (unsigned char*)(ws + R_G8);
          int g0, gs;
          if (nb == 512) { g0 = (bid >= 416) ? bid - 416 : 2048; gs = 96; } else { g0 = bid; gs = nb; }
#pragma unroll 1
          for (int t = g0; t < 2048; t += gs) {
            const int tm = t >> 5, tn = t & 31;
            f32x4 acc[4][4];
            zero_acc<4>(acc);
            gemm_acc<128>(Hh + (size_t)tm * 128 * 1024, 1024, Wt_in + (size_t)(GATE_OFF + tn * 128) * 1024, 1024, 1024, smem, acc);
            EPI4_FOR(128) {
              const int row = tm * 128 + EPI_ROW, n = tn * 128 + EPI4_COL(128);
              unsigned q = 0;
#pragma unroll
              for (int r = 0; r < 4; ++r) q |= ((unsigned)(sigm(acc[i][j][r]) * 255.f + 0.5f)) << (8 * r);
              *(unsigned*)(G8 + (size_t)row * 4096 + n) = q;
            }
          }
        }
      }
      GSYNC();
      {
      PHASE_IDS
        const int nglu = 64 * 4;
        for (int u = bid; u < nglu; u += nb) {
          int tm, tn; TILE_MAP(u, 64, tm, tn);
          f32x4 acc[4][4];
          zero_acc<4>(acc);
          gemm_acc<128>(Zs5 + (size_t)tm * 128 * 512, 512, Wt_glu + (size_t)tn * 128 * 512, 512, 512, smem, acc);
          const float* bg = p.in[20] + l * 512;
          EPI4_FOR(128) {
            const int row = tm * 128 + EPI_ROW, n = tn * 128 + EPI4_COL(128);
            const f32x4 z = unpack4(*(const uint2*)(Zs5 + (size_t)row * 512 + n));
            const float4 b4 = *(const float4*)(bg + n);
            const f32x4 lg = acc[i][j] + f32x4{b4.x, b4.y, b4.z, b4.w};
            f32x4 o;
#pragma unroll
            for (int r = 0; r < 4; ++r) o[r] = z[r] * sigm(lg[r]);
            *(uint2*)(Pm + (size_t)row * PLD + PC_S5 + n) = pack4(o);
          }
        }
        const float* k_a = p.in[28] + l * 512;
        const float* r_k = p.in[29] + l * 512;
        const float* ln_w = p.in[30] + l * 512;
        const float* ln_b = p.in[31] + l * 512;
        const float* o_norm = p.in[10] + l * 512;
        for (int tk = bid * 4 + wave; tk < TH; tk += nb * 4) {
          const int c0 = lane * 8;
          {
            const uint4 yu = *(const uint4*)(Yrw + (size_t)tk * 512 + c0);
            const float y[8] = {bflo(yu.x), bfhi(yu.x), bflo(yu.y), bfhi(yu.y), bflo(yu.z), bfhi(yu.z), bflo(yu.w), bfhi(yu.w)};
            const uint4 ru = *(const uint4*)(RKV + (size_t)tk * 1536 + c0);
            const uint4 ku = *(const uint4*)(RKV + (size_t)tk * 1536 + 512 + c0);
            const uint4 vu = *(const uint4*)(RKV + (size_t)tk * 1536 + 1024 + c0);
            const uint4 au = *(const uint4*)(Pm + (size_t)tk * PLD + PC_RW + 512 + c0);
            const uint4 gu = *(const uint4*)(Pm + (size_t)tk * PLD + PC_RW + 1024 + c0);
            const unsigned ra[4] = {ru.x, ru.y, ru.z, ru.w}, ka[4] = {ku.x, ku.y, ku.z, ku.w}, va[4] = {vu.x, vu.y, vu.z, vu.w};
            const unsigned aa[4] = {au.x, au.y, au.z, au.w}, ga[4] = {gu.x, gu.y, gu.z, gu.w};
            float rr[8], kh[8], vv[8], gg[8];
            float sm1 = 0.f, bsum = 0.f;
#pragma unroll
            for (int e = 0; e < 8; ++e) {
              const unsigned sh = (e & 1);
              rr[e] = sh ? bfhi(ra[e >> 1]) : bflo(ra[e >> 1]);
              const float kx = sh ? bfhi(ka[e >> 1]) : bflo(ka[e >> 1]);
              vv[e] = sh ? bfhi(va[e >> 1]) : bflo(va[e >> 1]);
              const float a = sh ? bfhi(aa[e >> 1]) : bflo(aa[e >> 1]);
              gg[e] = sh ? bfhi(ga[e >> 1]) : bflo(ga[e >> 1]);
              kh[e] = kx * (1.f + (a - 1.f) * k_a[c0 + e]);
              sm1 += y[e];
              bsum += rr[e] * kh[e] * r_k[c0 + e];
            }
            sm1 = red8(sm1); bsum = red8(bsum);
            const float mean = sm1 * (1.f / 64.f);
            float vs = 0.f;
#pragma unroll
            for (int e = 0; e < 8; ++e) { const float d = y[e] - mean; vs += d * d; }
            vs = red8(vs);
            const float rstd = rsqrtf(vs * (1.f / 64.f) + 64e-5f);
            float o[8];
#pragma unroll
            for (int e = 0; e < 8; ++e) o[e] = (((y[e] - mean) * rstd) * ln_w[c0 + e] + ln_b[c0 + e] + bsum * vv[e]) * gg[e];
            uint4 ov; ov.x = pack2(o[0], o[1]); ov.y = pack2(o[2], o[3]); ov.z = pack2(o[4], o[5]); ov.w = pack2(o[6], o[7]);
            *(uint4*)(RKV + (size_t)tk * 1536 + c0) = ov;
          }
          {
            bf16_t* op = Pm + (size_t)tk * PLD + PC_HG + 1024 + c0;
            const uint4 ou = *(const uint4*)op;
            const uint4 gu = *(const uint4*)(Pm + (size_t)tk * PLD + PC_HG + 1536 + c0);
            const unsigned oa[4] = {ou.x, ou.y, ou.z, ou.w}, ga[4] = {gu.x, gu.y, gu.z, gu.w};
            float o[8], ss = 0.f;
#pragma unroll
            for (int e = 0; e < 4; ++e) { o[2 * e] = bflo(oa[e]); o[2 * e + 1] = bfhi(oa[e]); }
#pragma unroll
            for (int e = 0; e < 8; ++e) ss += o[e] * o[e];
            ss = red16(ss);
            const float rs = rsqrtf(ss * (1.f / 128.f) + 1e-6f);
            float r8[8];
#pragma unroll
            for (int e = 0; e < 8; ++e) {
              const float gte = (e & 1) ? bfhi(ga[e >> 1]) : bflo(ga[e >> 1]);
              r8[e] = o[e] * rs * o_norm[c0 + e] * sigm(gte);
            }
            uint4 ov; ov.x = pack2(r8[0], r8[1]); ov.y = pack2(r8[2], r8[3]); ov.z = pack2(r8[4], r8[5]); ov.w = pack2(r8[6], r8[7]);
            *(uint4*)op = ov;
          }
        }
      }
      GSYNC();
      {
        int par6 = 0;
        const unsigned char* G8 = (const unsigned char*)(ws + R_G8);
        auto brA = [&](int m, int tm_, int& lda_) -> const bf16_t* {
          const bf16_t* Ao;
          if (m == 0) { Ao = Pm; lda_ = PLD; }
          else if (m == 1) { Ao = Pm + PC_HG + 1024; lda_ = PLD; }
          else if (m == 2) { Ao = Pm + PC_S5; lda_ = PLD; }
          else { Ao = RKV; lda_ = 1536; }
          return Ao + (size_t)tm_ * 128 * lda_;
        };
        for (int u = bid; u < 64 * 8; u += nb) {
          int tm, tn; TILE_MAP(u, 64, tm, tn);
          const bool has_next = (u + nb < 64 * 8);
          int tmn = tm, tnn = tn; if (has_next) TILE_MAP(u + nb, 64, tmn, tnn);
          f32x4 yacc[4][4];
          zero_acc<4>(yacc);
#pragma unroll 1
          for (int m = 0; m < 4; ++m) {
            f32x4 ao[4][4];
            zero_acc<4>(ao);
            int ldo; const bf16_t* Ao = brA(m, tm, ldo);
            const bf16_t* Bo = Wt_br + ((size_t)m * 1024 + tn * 128) * 512;
            const int mn = (m < 3) ? m + 1 : 0;
            const int tmx = (m < 3) ? tm : tmn, tnx = (m < 3) ? tn : tnn;
            int ldn; const bf16_t* An = brA(mn, tmx, ldn);
            const bf16_t* Bn = Wt_br + ((size_t)mn * 1024 + tnx * 128) * 512;
            gemm_acc<128>(Ao, ldo, Bo, 512, 512, smem, ao, An, ldn, Bn, 512, !(m == 0 && u == bid), par6);
            {
              EPI4_FOR(128) {
                const int row = tm * 128 + EPI_ROW, n = tn * 128 + EPI4_COL(128);
                const unsigned q = *(const unsigned*)(G8 + (size_t)row * 4096 + m * 1024 + n);
#pragma unroll
                for (int r = 0; r < 4; ++r) yacc[i][j][r] += ao[i][j][r] * ((float)((q >> (8 * r)) & 255u) * (1.f / 255.f));
              }
            }
          }
          {
            f32x4 (&acc)[4][4] = yacc;
            EPI4_FOR(128) {
              const int row = tm * 128 + EPI_ROW, n = tn * 128 + EPI4_COL(128);
              *(uint2*)(Ybr + (size_t)row * 1024 + n) = pack4(acc[i][j]);
            }
          }
        }
      }
      GSYNC();
      {
        int par = 0;
        for (int u = bid; u < 64 * 8; u += nb) {
          int tm, tn; TILE_MAP(u, 64, tm, tn);
          int tmn = tm, tnn = tn; if (u + nb < 64 * 8) TILE_MAP(u + nb, 64, tmn, tnn);
          f32x4 acc[4][4];
          zero_acc<4>(acc);
          gemm_acc<128>(Ybr + (size_t)tm * 128 * 1024, 1024, Wt_out + (size_t)tn * 128 * 1024, 1024, 1024, smem, acc,
                        Ybr + (size_t)tmn * 128 * 1024, 1024, Wt_out + (size_t)tnn * 128 * 1024, 1024, u != bid, par);
          EPI4_FOR(128) {
            const int row = half * TH + tm * 128 + EPI_ROW, n = tn * 128 + EPI4_COL(128);
            float4* xp = (float4*)(X + (size_t)row * 1024 + n);
            float4 xv = *xp; xv.x += acc[i][j][0]; xv.y += acc[i][j][1]; xv.z += acc[i][j][2]; xv.w += acc[i][j][3];
            *xp = xv;
          }
        }
      }
      GSYNC();
    }

    {
      transpose_all(p.in[42] + (size_t)l * 1024 * 1024, 1024, 1024, 1024, Wt_xq, bid, nb, smem);
      transpose_all(p.in[44] + (size_t)l * 1024 * 1024, 1024, 1024, 1024, Wt_xo, bid, nb, smem);
      transpose_all(p.in[46] + (size_t)l * 1024 * 5632, 5632, 1024, 5632, Wt_gu, bid, nb, smem);
      transpose_all(p.in[49] + (size_t)l * 2816 * 1024, 1024, 2816, 1024, Wt_down, bid, nb, smem);
      rmsnorm_rows(X, p.in[40] + l * 1024, Hb, nullptr, T_ALL, bid, nb);
    }
    GSYNC();
    {
      const float qs = 0.0625f * LOG2E;
      int par = 0;
      for (int u = bid; u < 128 * 8; u += nb) {
        int tm, tn; TILE_MAP(u, 128, tm, tn);
        int tmn = tm, tnn = tn; if (u + nb < 128 * 8) TILE_MAP(u + nb, 128, tmn, tnn);
        f32x4 acc[4][4];
        zero_acc<4>(acc);
        gemm_acc<128>(Hb + (size_t)tm * 128 * 1024, 1024, Wt_xq + (size_t)tn * 128 * 1024, 1024, 1024, smem, acc,
                      Hb + (size_t)tmn * 128 * 1024, 1024, Wt_xq + (size_t)tnn * 128 * 1024, 1024, u != bid, par);
        EPI4_FOR(128) {
          const int row = tm * 128 + EPI_ROW, n = tn * 128 + EPI4_COL(128);
          *(uint2*)(Qx + (size_t)row * 1024 + n) = pack4(acc[i][j] * qs);
        }
      }
    }
    GSYNC();
    {
      for (int u = bid; u < 1024; u += nb) {
        const int dvh = u & 1, hh = (u >> 1) & 3, qt = (u >> 3) & 31, b = u >> 8;
        attn_item<256, false>(Qx + (size_t)b * SEQ * 1024 + hh * 256, 1024, Kx + (size_t)(b * 4 + hh) * 65536, 256,
                              VxT + (size_t)(b * 4 + hh) * 65536 + (size_t)dvh * 128 * 256, 256, 4, qt * 128,
                              Ox + (size_t)b * SEQ * 1024 + hh * 256 + dvh * 128, 1024, smem);
      }
    }
    GSYNC();
    {
      int par = 0;
      for (int u = bid; u < 128 * 8; u += nb) {
        int tm, tn; TILE_MAP(u, 128, tm, tn);
        int tmn = tm, tnn = tn; if (u + nb < 128 * 8) TILE_MAP(u + nb, 128, tmn, tnn);
        f32x4 acc[4][4];
        zero_acc<4>(acc);
        gemm_acc<128>(Ox + (size_t)tm * 128 * 1024, 1024, Wt_xo + (size_t)tn * 128 * 1024, 1024, 1024, smem, acc,
                      Ox + (size_t)tmn * 128 * 1024, 1024, Wt_xo + (size_t)tnn * 128 * 1024, 1024, u != bid, par);
        EPI4_FOR(128) {
          const int row = tm * 128 + EPI_ROW, n = tn * 128 + EPI4_COL(128);
          float4* xp = (float4*)(X + (size_t)row * 1024 + n);
          float4 xv = *xp; xv.x += acc[i][j][0]; xv.y += acc[i][j][1]; xv.z += acc[i][j][2]; xv.w += acc[i][j][3];
          *xp = xv;
        }
      }
    }
    GSYNC();
    rmsnorm_rows(X, p.in[45] + l * 1024, Hb, nullptr, T_ALL, bid, nb);
    GSYNC();
    for (int half = 0; half < 2; ++half) {
      const bf16_t* Hh = Hb + (size_t)half * TH * 1024;
      int par13 = 0;
      for (int u = bid; u < 64 * 44; u += nb) {
        int tm, tn; TILE_MAP(u, 64, tm, tn);
        int tmn = tm, tnn = tn; if (u + nb < 64 * 44) TILE_MAP(u + nb, 64, tmn, tnn);
        f32x4 acc[4][4];
        zero_acc<4>(acc);
        gemm_acc<128>(Hh + (size_t)tm * 128 * 1024, 1024, Wt_gu + (size_t)tn * 128 * 1024, 1024, 1024, smem, acc,
                      Hh + (size_t)tmn * 128 * 1024, 1024, Wt_gu + (size_t)tnn * 128 * 1024, 1024, u != bid, par13);
        EPI4_FOR(128) {
          const int row = tm * 128 + EPI_ROW, n = tn * 128 + EPI4_COL(128);
          *(uint2*)(GU + (size_t)row * 5632 + n) = pack4(acc[i][j]);
        }
      }
      GSYNC();
      {
      PHASE_IDS
        const float* cw = p.in[47] + (size_t)l * 3 * D_FF;
        const float* cb = p.in[48] + (size_t)l * D_FF;
        for (int e = bid * 256 + tid; e < TH * 352; e += nb * 256) {
          const int tk = e / 352, c0 = (e % 352) * 8;
          const int s = tk & (SEQ - 1);
          const bf16_t* gp = GU + (size_t)tk * 5632 + c0;
          const uint4 g2 = *(const uint4*)gp;
          uint4 g1 = uint4{0, 0, 0, 0}, g0 = uint4{0, 0, 0, 0};
          if (s >= 1) g1 = *(const uint4*)(gp - 5632);
          if (s >= 2) g0 = *(const uint4*)(gp - 2 * 5632);
          const uint4 uu = *(const uint4*)(gp + D_FF);
          const unsigned a2[4] = {g2.x, g2.y, g2.z, g2.w}, a1[4] = {g1.x, g1.y, g1.z, g1.w}, a0[4] = {g0.x, g0.y, g0.z, g0.w};
          const unsigned au[4] = {uu.x, uu.y, uu.z, uu.w};
          float o[8];
#pragma unroll
          for (int q = 0; q < 8; ++q) {
            const bool hi = q & 1;
            const float x2 = hi ? bfhi(a2[q >> 1]) : bflo(a2[q >> 1]);
            const float x1 = hi ? bfhi(a1[q >> 1]) : bflo(a1[q >> 1]);
            const float x0 = hi ? bfhi(a0[q >> 1]) : bflo(a0[q >> 1]);
            const float up = hi ? bfhi(au[q >> 1]) : bflo(au[q >> 1]);
            const int c = c0 + q;
            const float gv = cw[c] * x0 + cw[D_FF + c] * x1 + cw[2 * D_FF + c] * x2 + cb[c];
            o[q] = gv * sigm(gv) * up;
          }
          uint4 ov; ov.x = pack2(o[0], o[1]); ov.y = pack2(o[2], o[3]); ov.z = pack2(o[4], o[5]); ov.w = pack2(o[6], o[7]);
          *(uint4*)(GU + (size_t)tk * 5632 + D_FF + c0) = ov;
        }
      }
      GSYNC();
      int par15 = 0;
      for (int u = bid; u < 64 * 8; u += nb) {
        int tm, tn; TILE_MAP(u, 64, tm, tn);
        int tmn = tm, tnn = tn; if (u + nb < 64 * 8) TILE_MAP(u + nb, 64, tmn, tnn);
        f32x4 acc[4][4];
        zero_acc<4>(acc);
        gemm_acc<128>(GU + (size_t)tm * 128 * 5632 + D_FF, 5632, Wt_down + (size_t)tn * 128 * 2816, 2816, 2816, smem, acc,
                      GU + (size_t)tmn * 128 * 5632 + D_FF, 5632, Wt_down + (size_t)tnn * 128 * 2816, 2816, u != bid, par15);
        EPI4_FOR(128) {
          const int row = half * TH + tm * 128 + EPI_ROW, n = tn * 128 + EPI4_COL(128);
          float4* xp = (float4*)(X + (size_t)row * 1024 + n);
          float4 xv = *xp; xv.x += acc[i][j][0]; xv.y += acc[i][j][1]; xv.z += acc[i][j][2]; xv.w += acc[i][j][3];
          *xp = xv;
        }
      }
      GSYNC();
    }
  }

  {
      PHASE_IDS
    const float* g = p.in[50];
    for (int r = bid * 4 + wave; r < T_ALL; r += nb * 4) {
      float4* xr = (float4*)(X + (size_t)r * 1024);
      float4 v[4]; float ss = 0.f;
#pragma unroll
      for (int i = 0; i < 4; ++i) { v[i] = xr[lane + 64 * i]; ss += v[i].x * v[i].x + v[i].y * v[i].y + v[i].z * v[i].z + v[i].w * v[i].w; }
      ss = wave_sum(ss);
      const float rs = rsqrtf(ss * (1.f / 1024.f) + 1e-6f);
#pragma unroll
      for (int i = 0; i < 4; ++i) {
        const float4 gg = ((const float4*)g)[lane + 64 * i];
        xr[lane + 64 * i] = float4{v[i].x * rs * gg.x, v[i].y * rs * gg.y, v[i].z * rs * gg.z, v[i].w * rs * gg.w};
      }
    }
  }
}

extern "C" void kernel_launch(void* const* d_in, const int* in_sizes, int n_in, void* d_out, int out_size, void* d_ws, size_t ws_size,
                              hipStream_t stream) {
  static int grid_blocks = 0;
  if (!grid_blocks) {
    int dev = 0, cus = 0, per_cu = 0;
    hipGetDevice(&dev);
    hipDeviceGetAttribute(&cus, hipDeviceAttributeMultiprocessorCount, dev);
    hipOccupancyMaxActiveBlocksPerMultiprocessor(&per_cu, mega_kernel, 256, 0);
    if (per_cu > 2) per_cu = 2;
    if (per_cu < 1) per_cu = 1;
    grid_blocks = cus * per_cu;
  }
  if (ws_size < WS_NEED) fprintf(stderr, "workspace too small: %zu < %zu\n", ws_size, (size_t)WS_NEED);
  Params p{};
  for (int i = 0; i < 51; ++i) p.in[i] = (const float*)d_in[i];
  p.pos = (const int*)d_in[2];
  p.out = (float*)d_out;
  p.ws = (char*)d_ws;
  hipMemsetAsync((char*)d_ws + OFF_BAR, 0, 16384, stream);
  void* args[] = {&p};
  hipError_t e = hipLaunchCooperativeKernel((void*)mega_kernel, dim3(grid_blocks), dim3(256), args, 0, stream);
  if (e != hipSuccess) fprintf(stderr, "cooperative launch failed: %s (grid %d)\n", hipGetErrorString(e), grid_blocks);
}
```

```cpp
#include <hip/hip_runtime.h>
#include <hip/hip_cooperative_groups.h>
#include <cstdio>
#include <cstdint>
namespace cg = cooperative_groups;

typedef unsigned short bf16_t;
using bf16x8 = __attribute__((ext_vector_type(8))) short;
using s16x4 = __attribute__((ext_vector_type(4))) short;
using f32x4 = __attribute__((ext_vector_type(4))) float;
using f32x16 = __attribute__((ext_vector_type(16))) float;
using u32x4 = __attribute__((ext_vector_type(4))) unsigned;
#define DI __device__ __forceinline__

constexpr int T_ALL = 16384, SEQ = 4096, DM = 1024, TH = 8192;
constexpr int P_IN = 8896, GATE_OFF = 4800;
constexpr int PLD = 4864;
constexpr int PC_HG = 512, PC_S5 = 2560, PC_RW = 3072;
constexpr int D_FF = 2816;

constexpr size_t al256(size_t x) { return (x + 255) & ~(size_t)255; }
constexpr size_t OFF_WIN = 0;
constexpr size_t OFF_WQ = OFF_WIN + al256((size_t)P_IN * 1024 * 2);
constexpr size_t OFF_WBR = OFF_WQ + al256((size_t)768 * 256 * 2);
constexpr size_t OFF_WOUT = OFF_WBR + al256((size_t)4 * 1024 * 512 * 2);
constexpr size_t OFF_WGLU = OFF_WOUT + al256((size_t)1024 * 1024 * 2);
constexpr size_t OFF_WWUP = OFF_WGLU + al256((size_t)512 * 512 * 2);
constexpr size_t OFF_WAUP = OFF_WWUP + al256((size_t)512 * 64 * 2);
constexpr size_t OFF_WGUP = OFF_WAUP + al256((size_t)512 * 64 * 2);
constexpr size_t OFF_WV = OFF_WGUP + al256((size_t)512 * 128 * 2);
constexpr size_t OFF_WXKV = OFF_WV + al256((size_t)512 * 1024 * 2);
constexpr size_t OFF_S5AB = OFF_WXKV + al256((size_t)2048 * 1024 * 2);
constexpr size_t OFF_S5BB = OFF_S5AB + al256((size_t)32 * 64 * 2 * 4);
constexpr size_t OFF_H = OFF_S5BB + al256((size_t)32 * 64 * 32 * 4);
constexpr size_t OFF_VFIRST = OFF_H + al256((size_t)T_ALL * 1024 * 2);
constexpr size_t OFF_KX = OFF_VFIRST + al256((size_t)T_ALL * 512 * 2);
constexpr size_t OFF_VXT = OFF_KX + al256((size_t)16 * 256 * 256 * 2);
constexpr size_t OFF_HM = OFF_VXT + al256((size_t)16 * 256 * 256 * 2);
constexpr size_t OFF_COS = OFF_HM + al256((size_t)1024 * 1024 * 2);
constexpr size_t OFF_SIN = OFF_COS + al256((size_t)TH * 32 * 4);
constexpr size_t OFF_BAR = OFF_SIN + al256((size_t)TH * 32 * 4);
constexpr size_t OFF_REG = OFF_BAR + 16384;
constexpr size_t R_P = OFF_REG;
constexpr size_t R_CQN = R_P + al256((size_t)TH * PLD * 2);
constexpr size_t R_QP = R_CQN + (size_t)TH * 256 * 2;
constexpr size_t R_KVLAT = R_QP + al256((size_t)TH * 768 * 2);
constexpr size_t R_VT = R_KVLAT + al256((size_t)TH * 192 * 2);
constexpr size_t R_RKV = R_VT + al256((size_t)2 * 128 * 4096 * 2);
constexpr size_t R_YRW = R_RKV + al256((size_t)TH * 1536 * 2);
constexpr size_t R_ZS5 = R_YRW + al256((size_t)TH * 512 * 2);
constexpr size_t R_ALORA = R_ZS5 + al256((size_t)TH * 512 * 2);
constexpr size_t R_G8 = R_ALORA;
constexpr size_t R_END1 = R_G8 + al256((size_t)TH * 4096);
static_assert(R_END1 <= ((size_t)256 << 20), "workspace plan exceeds the guaranteed 256 MiB");
constexpr size_t R_YBR = R_CQN;
constexpr size_t R_WXQ = OFF_REG;
constexpr size_t R_WXO = R_WXQ + al256((size_t)1024 * 1024 * 2);
constexpr size_t R_WGU = R_WXO + al256((size_t)1024 * 1024 * 2);
constexpr size_t R_WDOWN = R_WGU + al256((size_t)5632 * 1024 * 2);
constexpr size_t R_QX = R_WDOWN + al256((size_t)1024 * 2816 * 2);
constexpr size_t R_OX = R_QX + al256((size_t)T_ALL * 1024 * 2);
constexpr size_t R_GU = R_QX;
constexpr size_t R_END2 = R_GU + al256((size_t)TH * 5632 * 2);
constexpr size_t WS_NEED = (R_END1 > R_END2 ? R_END1 : R_END2);

constexpr int SMEM_BYTES = 73728;

struct Params {
  const float* in[51];
  const int* pos;
  float* out;
  char* ws;
};

DI bf16_t f2bf(float x) { return __builtin_bit_cast(unsigned short, (__bf16)x); }
DI float bf2f(bf16_t b) { return __uint_as_float(((unsigned)b) << 16); }
typedef __bf16 bf16v2_t __attribute__((ext_vector_type(2)));
typedef float f32v2_t __attribute__((ext_vector_type(2)));
DI unsigned pack2(float a, float b) { const f32v2_t v = {a, b}; return __builtin_bit_cast(unsigned, __builtin_convertvector(v, bf16v2_t)); }
DI float bflo(unsigned u) { return __uint_as_float(u << 16); }
DI float bfhi(unsigned u) { return __uint_as_float(u & 0xffff0000u); }
DI float sigm(float x) { return __builtin_amdgcn_rcpf(1.f + __expf(-x)); }
template <int CTRL> DI float dppf(float v) {
  return __builtin_bit_cast(float, __builtin_amdgcn_update_dpp(0, __builtin_bit_cast(int, v), CTRL, 0xf, 0xf, false));
}
DI float red8(float v) { v += dppf<0xB1>(v); v += dppf<0x4E>(v); v += dppf<0x141>(v); return v; }
DI float red16(float v) { v = red8(v); v += dppf<0x140>(v); return v; }
DI int TID() { int t = threadIdx.x; asm volatile("" : "+v"(t)); return t; }
#define PHASE_IDS const int tid = TID(); const int lane = tid & 63, wave = tid >> 6; (void)lane; (void)wave;
DI const bf16_t* uniform_ptr(const bf16_t* p) {
  const unsigned long long v = (unsigned long long)p;
  const unsigned lo = __builtin_amdgcn_readfirstlane((unsigned)v), hi = __builtin_amdgcn_readfirstlane((unsigned)(v >> 32));
  return (const bf16_t*)(((unsigned long long)hi << 32) | lo);
}
DI float wave_sum(float v) { for (int o = 32; o > 0; o >>= 1) v += __shfl_xor(v, o); return v; }


#define XB_TMO      128
#define XB_XCNT(j)  (256  + 64 * (j))
#define XB_XSUB(j)  (1280 + 64 * (j))
#define XB_XGEN(j)  (2304 + 64 * (j))
#define XB_TOP      3328
#define XB_TOPGEN   3392
#define XCD_BAR_WORDS 3456
#define XB_SPIN_CAP (1u << 22)
#define LAS __attribute__((address_space(3)))
DI unsigned xb_ld(unsigned* p) { return __hip_atomic_load(p, __ATOMIC_RELAXED, __HIP_MEMORY_SCOPE_AGENT); }
DI unsigned xb_add(unsigned* p, unsigned v) { return __hip_atomic_fetch_add(p, v, __ATOMIC_RELAXED, __HIP_MEMORY_SCOPE_AGENT); }
DI unsigned xb_xcc_id() { return (unsigned)__builtin_amdgcn_s_getreg((3 << 11) | 20) & 0xFu; }
#define XB_SPIN(cond, bar) do { unsigned _sp = 0; while (cond) { __builtin_amdgcn_s_sleep(1); \
    if ((++_sp & 255u) == 0u) { if (xb_ld(&(bar)[XB_TMO])) break; if (_sp > XB_SPIN_CAP) { atomicAdd(&(bar)[XB_TMO], 1u); break; } } } } while (0)
struct XcdBarrier { unsigned* bar; unsigned x; volatile LAS unsigned* st; };
DI XcdBarrier xcd_barrier_post(unsigned* bar, volatile LAS unsigned* st) {
  XcdBarrier b; b.bar = bar; b.x = xb_xcc_id(); b.st = st;
  if (threadIdx.x == 0) (void)xb_add(&bar[XB_XCNT(b.x)], 1u);
  return b;
}
DI void xcd_barrier_complete(unsigned* bar, unsigned x, unsigned& nloc, unsigned& nx) {
  const unsigned G = gridDim.x * gridDim.y * gridDim.z;
  unsigned sum, cnt, mine, sp = 0u;
  for (;;) {
    sum = 0u; cnt = 0u; mine = 0u;
#pragma unroll
    for (unsigned j = 0; j < 16; ++j) { const unsigned c = xb_ld(&bar[XB_XCNT(j)]); sum += c; cnt += (c > 0u) ? 1u : 0u; mine = (j == x) ? c : mine; }
    if (sum == G) break;
    __builtin_amdgcn_s_sleep(1);
    if ((++sp & 255u) == 0u) { if (xb_ld(&bar[XB_TMO])) break; if (sp > XB_SPIN_CAP) { atomicAdd(&bar[XB_TMO], 1u); break; } }
  }
  nloc = mine > 0u ? mine : 1u; nx = cnt > 0u ? cnt : 1u;
}
DI void xcd_barrier(const XcdBarrier& b) {
  asm volatile("s_waitcnt vmcnt(0)" ::: "memory");
  __syncthreads();
  if (threadIdx.x == 0) {
    unsigned* bar = b.bar;
    __builtin_amdgcn_s_waitcnt(0);
    unsigned nloc = b.st[0], nx = b.st[1];
    if (nloc == 0u) { xcd_barrier_complete(bar, b.x, nloc, nx); b.st[0] = nloc; b.st[1] = nx; }
    const unsigned old = xb_add(&bar[XB_XSUB(b.x)], 1u);
    const unsigned gen = old / nloc;
    if (old + 1u == (gen + 1u) * nloc) {
      __builtin_amdgcn_fence(__ATOMIC_RELEASE, "agent");
      asm volatile("s_waitcnt vmcnt(0)" ::: "memory");
      const unsigned og = xb_add(&bar[XB_TOP], 1u);
      const unsigned tg = og / nx;
      if (og + 1u == (tg + 1u) * nx) xb_add(&bar[XB_TOPGEN], 1u);
      else XB_SPIN(xb_ld(&bar[XB_TOPGEN]) == tg, bar);
      __builtin_amdgcn_fence(__ATOMIC_ACQUIRE, "agent");
      xb_add(&bar[XB_XGEN(b.x)], 1u);
      asm volatile("s_waitcnt vmcnt(0)" ::: "memory");
    } else {
      XB_SPIN(xb_ld(&bar[XB_XGEN(b.x)]) == gen, bar);
      __builtin_amdgcn_fence(__ATOMIC_ACQUIRE, "agent");
      asm volatile("s_waitcnt vmcnt(0)" ::: "memory");
    }
  }
  __syncthreads();
}

#define GLOAD16(dst, ptr) asm volatile("global_load_dwordx4 %0, %1, off" : "=v"(dst) : "v"(ptr))
template <int BN>
DI void gemm_acc(const bf16_t* __restrict__ A, int lda, const bf16_t* __restrict__ Bt, int ldb, int K, char* smem,
                 f32x4 (&acc)[4][BN / 32], const bf16_t* __restrict__ An, int ldan, const bf16_t* __restrict__ Bn, int ldbn,
                 bool pre, int& par) {
  constexpr int A_EL = 128 * 72, B_EL = BN * 72, BUF_EL = A_EL + B_EL;
  constexpr int NJ = BN / 32, BCH = BN / 32;
  bf16_t* sm = (bf16_t*)smem;
  const int tid = TID(), lane = tid & 63, wave = tid >> 6;
  const int wm = wave >> 1, wn = wave & 1, l16 = lane & 15, quad = lane >> 4;
  const int crow = tid >> 3, ccol = (tid & 7) * 8;
  u32x4 ra[4], rb[BCH];
  const bf16_t* Ap = A + (size_t)crow * lda + ccol;
  const bf16_t* Bp = Bt + (size_t)crow * ldb + ccol;
  const bf16_t* Apn = An + (size_t)crow * ldan + ccol;
  const bf16_t* Bpn = Bn + (size_t)crow * ldbn + ccol;
  const int nk = K >> 6;
#define GEMM_ISSUE(ap_, sa_, bp_, sb_)                                                            \
  {                                                                                               \
    _Pragma("unroll") for (int i = 0; i < 4; ++i) GLOAD16(ra[i], (ap_) + (size_t)(32 * i) * (sa_));      \
    _Pragma("unroll") for (int i = 0; i < BCH; ++i) GLOAD16(rb[i], (bp_) + (size_t)(32 * i) * (sb_));    \
  }
#define GEMM_LAND(buf_)                                                                           \
  {                                                                                               \
    if constexpr (BCH == 4)                                                                       \
      asm volatile("s_waitcnt vmcnt(0)" : "+v"(ra[0]), "+v"(ra[1]), "+v"(ra[2]), "+v"(ra[3]), "+v"(rb[0]), "+v"(rb[1]), "+v"(rb[2]), "+v"(rb[3])); \
    else                                                                                          \
      asm volatile("s_waitcnt vmcnt(0)" : "+v"(ra[0]), "+v"(ra[1]), "+v"(ra[2]), "+v"(ra[3]), "+v"(rb[0]), "+v"(rb[1])); \
    bf16_t* sa_ = sm + (buf_) * BUF_EL; bf16_t* sb_ = sa_ + A_EL;                                 \
    _Pragma("unroll") for (int i = 0; i < 4; ++i) *(u32x4*)(sa_ + (crow + 32 * i) * 72 + ccol) = ra[i];   \
    _Pragma("unroll") for (int i = 0; i < BCH; ++i) *(u32x4*)(sb_ + (crow + 32 * i) * 72 + ccol) = rb[i]; \
  }
  if (!pre) {
    GEMM_ISSUE(Ap, lda, Bp, ldb);
    GEMM_LAND(par);
    __syncthreads();
  }
  for (int kt = 0; kt < nk; ++kt) {
    {
      const bool inner = (kt + 1 < nk);
      const bf16_t* ap = inner ? Ap + ((kt + 1) << 6) : Apn;
      const bf16_t* bp = inner ? Bp + ((kt + 1) << 6) : Bpn;
      const int sa = inner ? lda : ldan, sb = inner ? ldb : ldbn;
      GEMM_ISSUE(ap, sa, bp, sb);
    }
    __builtin_amdgcn_sched_barrier(0);
    {
      const bf16_t* sa = sm + ((par + kt) & 1) * BUF_EL; const bf16_t* sb = sa + A_EL;
#pragma unroll
      for (int ks = 0; ks < 2; ++ks) {
        bf16x8 a[4], b[NJ];
#pragma unroll
        for (int i = 0; i < 4; ++i) a[i] = *(const bf16x8*)(sa + (wm * 64 + i * 16 + l16) * 72 + ks * 32 + quad * 8);
#pragma unroll
        for (int j = 0; j < NJ; ++j) b[j] = *(const bf16x8*)(sb + (wn * (BN / 2) + j * 16 + l16) * 72 + ks * 32 + quad * 8);
        __builtin_amdgcn_s_setprio(1);
#pragma unroll
        for (int i = 0; i < 4; ++i)
#pragma unroll
          for (int j = 0; j < NJ; ++j) acc[i][j] = __builtin_amdgcn_mfma_f32_16x16x32_bf16(b[j], a[i], acc[i][j], 0, 0, 0);
        __builtin_amdgcn_s_setprio(0);
      }
    }
    __builtin_amdgcn_sched_barrier(0);
    GEMM_LAND((par + kt + 1) & 1);
    __syncthreads();
  }
  par = (par + nk) & 1;
#undef GEMM_ISSUE
#undef GEMM_LAND
}
template <int BN>
DI void gemm_acc(const bf16_t* __restrict__ A, int lda, const bf16_t* __restrict__ Bt, int ldb, int K, char* smem,
                 f32x4 (&acc)[4][BN / 32]) {
  int par = 0;
  gemm_acc<BN>(A, lda, Bt, ldb, K, smem, acc, A, lda, Bt, ldb, false, par);
}
template <int NJ> DI void zero_acc(f32x4 (&acc)[4][NJ]) {
#pragma unroll
  for (int i = 0; i < 4; ++i)
#pragma unroll
    for (int j = 0; j < NJ; ++j) acc[i][j] = f32x4{0.f, 0.f, 0.f, 0.f};
}
#define EPI_FOR(BN_)                                                                         \
  const int _t = TID(); const int _lane = _t & 63, _wave = _t >> 6;                              \
  const int _wm = _wave >> 1, _wn = _wave & 1, _l16 = _lane & 15, _quad = _lane >> 4;        \
  _Pragma("unroll") for (int i = 0; i < 4; ++i)                                              \
  _Pragma("unroll") for (int j = 0; j < (BN_) / 32; ++j)                                     \
  _Pragma("unroll") for (int r = 0; r < 4; ++r)
#define EPI_ROW (_wm * 64 + i * 16 + _l16)
#define EPI_COL(BN_) (_wn * ((BN_) / 2) + j * 16 + _quad * 4 + r)
#define EPI4_FOR(BN_)                                                                        \
  const int _t = TID(); const int _lane = _t & 63, _wave = _t >> 6;                          \
  const int _wm = _wave >> 1, _wn = _wave & 1, _l16 = _lane & 15, _quad = _lane >> 4;        \
  _Pragma("unroll") for (int i = 0; i < 4; ++i)                                              \
  _Pragma("unroll") for (int j = 0; j < (BN_) / 32; ++j)
#define EPI4_COL(BN_) (_wn * ((BN_) / 2) + j * 16 + _quad * 4)
DI uint2 pack4(f32x4 v) { uint2 o; o.x = pack2(v[0], v[1]); o.y = pack2(v[2], v[3]); return o; }
DI f32x4 unpack4(uint2 u) { return f32x4{bflo(u.x), bfhi(u.x), bflo(u.y), bfhi(u.y)}; }

DI void transpose_tile(const float* __restrict__ W, int ldw, bf16_t* __restrict__ Wt, int ldt, int k0, int n0, char* smem) {
  float* sm = (float*)smem;
  const int tid = TID();
  __syncthreads();
#pragma unroll
  for (int i = 0; i < 4; ++i) {
    const int k = (tid >> 4) + 16 * i, n4 = (tid & 15) * 4;
    const float4 v = *(const float4*)(W + (size_t)(k0 + k) * ldw + n0 + n4);
    sm[k * 65 + n4 + 0] = v.x; sm[k * 65 + n4 + 1] = v.y; sm[k * 65 + n4 + 2] = v.z; sm[k * 65 + n4 + 3] = v.w;
  }
  __syncthreads();
  const int n = tid >> 2, ks = (tid & 3) * 16;
  unsigned u[8];
#pragma unroll
  for (int e = 0; e < 8; ++e) u[e] = pack2(sm[(ks + 2 * e) * 65 + n], sm[(ks + 2 * e + 1) * 65 + n]);
  uint4* dst = (uint4*)(Wt + (size_t)(n0 + n) * ldt + k0 + ks);
  dst[0] = uint4{u[0], u[1], u[2], u[3]};
  dst[1] = uint4{u[4], u[5], u[6], u[7]};
}
DI void transpose_all(const float* W, int ldw, int K, int N, bf16_t* Wt, int bid, int nb, char* smem) {
  const int tk = K >> 6, tn = N >> 6;
  for (int t = bid; t < tk * tn; t += nb) transpose_tile(W, ldw, Wt, K, (t % tk) * 64, (t / tk) * 64, smem);
}

DI void rmsnorm_rows(const float* __restrict__ x, const float* __restrict__ g, bf16_t* __restrict__ h, float* xcopy, int rows,
                     int bid, int nb) {
  const int lane = TID() & 63, wave = TID() >> 6;
  for (int r = bid * 4 + wave; r < rows; r += nb * 4) {
    const float4* xr = (const float4*)(x + (size_t)r * 1024);
    float4 v[4]; float ss = 0.f;
#pragma unroll
    for (int i = 0; i < 4; ++i) { v[i] = xr[lane + 64 * i]; ss += v[i].x * v[i].x + v[i].y * v[i].y + v[i].z * v[i].z + v[i].w * v[i].w; }
    ss = wave_sum(ss);
    const float rs = rsqrtf(ss * (1.f / 1024.f) + 1e-6f);
#pragma unroll
    for (int i = 0; i < 4; ++i) {
      const float4 gg = ((const float4*)g)[lane + 64 * i];
      uint2 o; o.x = pack2(v[i].x * rs * gg.x, v[i].y * rs * gg.y); o.y = pack2(v[i].z * rs * gg.z, v[i].w * rs * gg.w);
      *(uint2*)(h + (size_t)r * 1024 + (lane + 64 * i) * 4) = o;
      if (xcopy) ((float4*)(xcopy + (size_t)r * 1024))[lane + 64 * i] = v[i];
    }
  }
}

template <int DQK, bool CAUSAL>
DI void attn_item(const bf16_t* __restrict__ Q, int ldq, const bf16_t* __restrict__ Kp, int ldk, const bf16_t* __restrict__ VT, int ldvt,
                  int ntiles, int q0, bf16_t* __restrict__ out, int ldo, char* smem) {
  constexpr int KS = DQK + 8, NS = DQK / 16, KCH = DQK / 8;
  bf16_t* Ks = (bf16_t*)smem;
  bf16_t* Vs = Ks + 64 * KS;
  const int tid = TID(), lane = tid & 63, wave = tid >> 6, ql = lane & 31, hh = lane >> 5;
  const int qrow = q0 + wave * 32 + ql;
  bf16x8 bq[NS];
#pragma unroll
  for (int s = 0; s < NS; ++s) bq[s] = *(const bf16x8*)(Q + (size_t)qrow * ldq + s * 16 + hh * 8);
  f32x16 ot[4];
#pragma unroll
  for (int d = 0; d < 4; ++d)
#pragma unroll
    for (int i = 0; i < 16; ++i) ot[d][i] = 0.f;
  float mrun = -INFINITY, lrun = 0.f;
  for (int kt = 0; kt < ntiles; ++kt) {
    __syncthreads();
    for (int c = tid; c < 64 * KCH; c += 256) {
      const int row = c / KCH, cc = c % KCH;
      *(uint4*)(Ks + row * KS + cc * 8) = *(const uint4*)(Kp + (size_t)(kt * 64 + row) * ldk + cc * 8);
    }
#pragma unroll
    for (int c0 = 0; c0 < 4; ++c0) {
      const int c = tid + c0 * 256, row = c >> 3, cc = c & 7;
      *(uint4*)(Vs + row * 72 + cc * 8) = *(const uint4*)(VT + (size_t)row * ldvt + kt * 64 + cc * 8);
    }
    __syncthreads();
    f32x16 st[2];
#pragma unroll
    for (int kb = 0; kb < 2; ++kb) {
#pragma unroll
      for (int i = 0; i < 16; ++i) st[kb][i] = 0.f;
#pragma unroll
      for (int s = 0; s < NS; ++s) {
        const bf16x8 a = *(const bf16x8*)(Ks + (kb * 32 + ql) * KS + s * 16 + hh * 8);
        st[kb] = __builtin_amdgcn_mfma_f32_32x32x16_bf16(a, bq[s], st[kb], 0, 0, 0);
      }
    }
    float mx = -INFINITY;
#pragma unroll
    for (int kb = 0; kb < 2; ++kb)
#pragma unroll
      for (int i = 0; i < 16; ++i) {
        if (CAUSAL) {
          const int key = kt * 64 + kb * 32 + (i & 3) + 8 * (i >> 2) + 4 * hh;
          if (key > qrow) st[kb][i] = -INFINITY;
        }
        mx = fmaxf(mx, st[kb][i]);
      }
    mx = fmaxf(mx, __shfl_xor(mx, 32));
    const float mnew = fmaxf(mrun, mx);
    const float alpha = __builtin_amdgcn_exp2f(mrun - mnew);
    float ps = 0.f;
#pragma unroll
    for (int kb = 0; kb < 2; ++kb)
#pragma unroll
      for (int i = 0; i < 16; ++i) { const float pv = __builtin_amdgcn_exp2f(st[kb][i] - mnew); st[kb][i] = pv; ps += pv; }
    ps += __shfl_xor(ps, 32);
    lrun = lrun * alpha + ps;
    mrun = mnew;
#pragma unroll
    for (int d = 0; d < 4; ++d)
#pragma unroll
      for (int i = 0; i < 16; ++i) ot[d][i] *= alpha;
#pragma unroll
    for (int kb = 0; kb < 2; ++kb)
#pragma unroll
      for (int s2 = 0; s2 < 2; ++s2) {
        unsigned pk[4];
#pragma unroll
        for (int e = 0; e < 4; ++e) pk[e] = pack2(st[kb][8 * s2 + 2 * e], st[kb][8 * s2 + 2 * e + 1]);
        const bf16x8 pb = __builtin_bit_cast(bf16x8, uint4{pk[0], pk[1], pk[2], pk[3]});
#pragma unroll
        for (int d = 0; d < 4; ++d) {
          const bf16_t* vp = Vs + (d * 32 + ql) * 72 + kb * 32 + s2 * 16 + hh * 4;
          const s16x4 lo = *(const s16x4*)vp;
          const s16x4 hi = *(const s16x4*)(vp + 8);
          const bf16x8 av = __builtin_shufflevector(lo, hi, 0, 1, 2, 3, 4, 5, 6, 7);
          ot[d] = __builtin_amdgcn_mfma_f32_32x32x16_bf16(av, pb, ot[d], 0, 0, 0);
        }
      }
  }
  const float inv = 1.f / lrun;
#pragma unroll
  for (int d = 0; d < 4; ++d)
#pragma unroll
    for (int g4 = 0; g4 < 4; ++g4) {
      uint2 o; o.x = pack2(ot[d][4 * g4] * inv, ot[d][4 * g4 + 1] * inv); o.y = pack2(ot[d][4 * g4 + 2] * inv, ot[d][4 * g4 + 3] * inv);
      *(uint2*)(out + (size_t)qrow * ldo + d * 32 + 8 * g4 + 4 * hh) = o;
    }
}


template <int DQK, bool CAUSAL>
DI void attn_item_pf(const bf16_t* __restrict__ Q, int ldq, const bf16_t* Kp, int ldk, const bf16_t* VT, int ldvt,
                  int ntiles, int q0, bf16_t* __restrict__ out, int ldo, char* smem) {
  constexpr int KS = DQK + 8, NS = DQK / 16, KCH = DQK / 8;
  bf16_t* Ks = (bf16_t*)smem;
  bf16_t* Vs = Ks + 64 * KS;
  const int tid = TID(), lane = tid & 63, wave = tid >> 6, ql = lane & 31, hh = lane >> 5;
  const int qrow = q0 + wave * 32 + ql;
  bf16x8 bq[NS];
#pragma unroll
  for (int s = 0; s < NS; ++s) bq[s] = *(const bf16x8*)(Q + (size_t)qrow * ldq + s * 16 + hh * 8);
  f32x16 ot[4];
#pragma unroll
  for (int d = 0; d < 4; ++d)
#pragma unroll
    for (int i = 0; i < 16; ++i) ot[d][i] = 0.f;
  float mrun = -INFINITY, lrun = 0.f;
  Kp = uniform_ptr(Kp); VT = uniform_ptr(VT);
  constexpr int KR = KCH / 4;
  static_assert(KR == 6, "prefetch variant is written for DQK = 192");
  u32x4 kreg[KR], vreg[4];
  const unsigned kvoff = (unsigned)(((tid >> 2) * ldk + (tid & 3) * 8) * 2);
  const unsigned vvoff = (unsigned)(((tid >> 3) * ldvt + (tid & 7) * 8) * 2);
#define GLOADS(dst, voff, sbase) asm volatile("global_load_dwordx4 %0, %1, %2" : "=v"(dst) : "v"(voff), "s"(sbase))
#define ATT_ISSUE(kt_)                                                                                        \
  {                                                                                                           \
    _Pragma("unroll") for (int c0 = 0; c0 < KR; ++c0) GLOADS(kreg[c0], kvoff, Kp + (size_t)(kt_) * 64 * ldk + c0 * 32);   \
    _Pragma("unroll") for (int c0 = 0; c0 < 4; ++c0) GLOADS(vreg[c0], vvoff, VT + (size_t)(c0 * 32) * ldvt + (kt_) * 64); \
  }
#define ATT_LAND()                                                                                            \
  {                                                                                                           \
    asm volatile("s_waitcnt vmcnt(0)" : "+v"(kreg[0]), "+v"(kreg[1]), "+v"(kreg[2]), "+v"(kreg[3]), "+v"(kreg[4]), "+v"(kreg[5]), \
                 "+v"(vreg[0]), "+v"(vreg[1]), "+v"(vreg[2]), "+v"(vreg[3]));                                 \
    _Pragma("unroll") for (int c0 = 0; c0 < KR; ++c0) *(u32x4*)(Ks + (tid >> 2) * KS + ((tid & 3) + 4 * c0) * 8) = kreg[c0];   \
    _Pragma("unroll") for (int c0 = 0; c0 < 4; ++c0) *(u32x4*)(Vs + ((tid >> 3) + 32 * c0) * 72 + (tid & 7) * 8) = vreg[c0];   \
  }
  __syncthreads();
  ATT_ISSUE(0);
  ATT_LAND();
  __syncthreads();
  for (int kt = 0; kt < ntiles; ++kt) {
    {
      const int ktn = (kt + 1 < ntiles) ? kt + 1 : kt;
      ATT_ISSUE(ktn);
    }
    __builtin_amdgcn_sched_barrier(0);
    f32x16 st[2];
#pragma unroll
    for (int kb = 0; kb < 2; ++kb) {
#pragma unroll
      for (int i = 0; i < 16; ++i) st[kb][i] = 0.f;
#pragma unroll
      for (int s = 0; s < NS; ++s) {
        const bf16x8 a = *(const bf16x8*)(Ks + (kb * 32 + ql) * KS + s * 16 + hh * 8);
        st[kb] = __builtin_amdgcn_mfma_f32_32x32x16_bf16(a, bq[s], st[kb], 0, 0, 0);
      }
    }
    float mx = -INFINITY;
#pragma unroll
    for (int kb = 0; kb < 2; ++kb)
#pragma unroll
      for (int i = 0; i < 16; ++i) {
        if (CAUSAL) {
          const int key = kt * 64 + kb * 32 + (i & 3) + 8 * (i >> 2) + 4 * hh;
          if (key > qrow) st[kb][i] = -INFINITY;
        }
        mx = fmaxf(mx, st[kb][i]);
      }
    mx = fmaxf(mx, __shfl_xor(mx, 32));
    const float mnew = fmaxf(mrun, mx);
    const float alpha = __builtin_amdgcn_exp2f(mrun - mnew);
    float ps = 0.f;
#pragma unroll
    for (int kb = 0; kb < 2; ++kb)
#pragma unroll
      for (int i = 0; i < 16; ++i) { const float pv = __builtin_amdgcn_exp2f(st[kb][i] - mnew); st[kb][i] = pv; ps += pv; }
    ps += __shfl_xor(ps, 32);
    lrun = lrun * alpha + ps;
    mrun = mnew;
#pragma unroll
    for (int d = 0; d < 4; ++d)
#pragma unroll
      for (int i = 0; i < 16; ++i) ot[d][i] *= alpha;
#pragma unroll
    for (int kb = 0; kb < 2; ++kb)
#pragma unroll
      for (int s2 = 0; s2 < 2; ++s2) {
        unsigned pk[4];
#pragma unroll
        for (int e = 0; e < 4; ++e) pk[e] = pack2(st[kb][8 * s2 + 2 * e], st[kb][8 * s2 + 2 * e + 1]);
        const bf16x8 pb = __builtin_bit_cast(bf16x8, uint4{pk[0], pk[1], pk[2], pk[3]});
#pragma unroll
        for (int d = 0; d < 4; ++d) {
          const bf16_t* vp = Vs + (d * 32 + ql) * 72 + kb * 32 + s2 * 16 + hh * 4;
          const s16x4 lo = *(const s16x4*)vp;
          const s16x4 hi = *(const s16x4*)(vp + 8);
          const bf16x8 av = __builtin_shufflevector(lo, hi, 0, 1, 2, 3, 4, 5, 6, 7);
          ot[d] = __builtin_amdgcn_mfma_f32_32x32x16_bf16(av, pb, ot[d], 0, 0, 0);
        }
      }
    __builtin_amdgcn_sched_barrier(0);
    __syncthreads();
    ATT_LAND();
    __syncthreads();
  }
#undef ATT_ISSUE
#undef ATT_LAND
#undef GLOADS
  const float inv = 1.f / lrun;
#pragma unroll
  for (int d = 0; d < 4; ++d)
#pragma unroll
    for (int g4 = 0; g4 < 4; ++g4) {
      uint2 o; o.x = pack2(ot[d][4 * g4] * inv, ot[d][4 * g4 + 1] * inv); o.y = pack2(ot[d][4 * g4 + 2] * inv, ot[d][4 * g4 + 3] * inv);
      *(uint2*)(out + (size_t)qrow * ldo + d * 32 + 8 * g4 + 4 * hh) = o;
    }
}

DI void rwkv_scan_unit(const Params& p, int l, int u, char* smem) {
  const int tid = TID();
  const int bl = u >> 5, hd = (u >> 2) & 7, rg = u & 3;
  const int kq = tid & 15, g16 = tid >> 4;
  const bf16_t* RKV = (const bf16_t*)(p.ws + R_RKV) + (size_t)bl * SEQ * 1536;
  const bf16_t* Pm = (const bf16_t*)(p.ws + R_P) + (size_t)bl * SEQ * PLD;
  bf16_t* Y = (bf16_t*)(p.ws + R_YRW) + (size_t)bl * SEQ * 512;
  float* sm = (float*)smem;
  constexpr int BUFF = 5 * 1024 + 256 + 32;
  const int kc = hd * 64 + kq * 4;
  const float4 kk_w = *(const float4*)(p.in[27] + l * 512 + kc);
  const float4 ka_w = *(const float4*)(p.in[28] + l * 512 + kc);
  f32v2_t SA = {0.f, 0.f}, SB = {0.f, 0.f};
  uint2 g_r, g_k, g_w, g_a; bf16_t g_v;
  auto gload = [&](int c) {
    const int tok = c * 16 + g16;
    g_r = *(const uint2*)(RKV + (size_t)tok * 1536 + kc);
    g_k = *(const uint2*)(RKV + (size_t)tok * 1536 + 512 + kc);
    g_v = RKV[(size_t)tok * 1536 + 1024 + hd * 64 + rg * 16 + kq];
    g_w = *(const uint2*)(Pm + (size_t)tok * PLD + PC_RW + kc);
    g_a = *(const uint2*)(Pm + (size_t)tok * PLD + PC_RW + 512 + kc);
  };
  auto derive = [&](int buf) {
    float* b = sm + buf * BUFF;
    const float r[4] = {bflo(g_r.x), bfhi(g_r.x), bflo(g_r.y), bfhi(g_r.y)};
    const float k[4] = {bflo(g_k.x), bfhi(g_k.x), bflo(g_k.y), bfhi(g_k.y)};
    const float w[4] = {bflo(g_w.x), bfhi(g_w.x), bflo(g_w.y), bfhi(g_w.y)};
    const float a[4] = {bflo(g_a.x), bfhi(g_a.x), bflo(g_a.y), bfhi(g_a.y)};
    const float kkw[4] = {kk_w.x, kk_w.y, kk_w.z, kk_w.w};
    const float kaw[4] = {ka_w.x, ka_w.y, ka_w.z, ka_w.w};
    float kk[4], ss = 0.f;
#pragma unroll
    for (int e = 0; e < 4; ++e) { kk[e] = k[e] * kkw[e]; ss += kk[e] * kk[e]; }
    ss = red16(ss);
    const float rn = rsqrtf(ss + 1e-12f);
    float dwr[4], dw[4], dk[4], dn[4], db[4];
    float br = 0.f, khr = 0.f;
#pragma unroll
    for (int e = 0; e < 4; ++e) {
      dw[e] = __expf(w[e]);
      const float kn = kk[e] * rn;
      dn[e] = -kn; db[e] = kn * a[e];
      dk[e] = k[e] * (1.f + (a[e] - 1.f) * kaw[e]);
      dwr[e] = dw[e] * r[e];
      br += db[e] * r[e]; khr += dk[e] * r[e];
    }
    br = red16(br); khr = red16(khr);
#pragma unroll
    for (int e = 0; e < 4; ++e) dwr[e] += dn[e] * br;
    *(float4*)(b + 0 * 1024 + g16 * 64 + kq * 4) = float4{dwr[0], dwr[1], dwr[2], dwr[3]};
    *(float4*)(b + 1 * 1024 + g16 * 64 + kq * 4) = float4{dw[0], dw[1], dw[2], dw[3]};
    *(float4*)(b + 2 * 1024 + g16 * 64 + kq * 4) = float4{dk[0], dk[1], dk[2], dk[3]};
    *(float4*)(b + 3 * 1024 + g16 * 64 + kq * 4) = float4{dn[0], dn[1], dn[2], dn[3]};
    *(float4*)(b + 4 * 1024 + g16 * 64 + kq * 4) = float4{db[0], db[1], db[2], db[3]};
    b[5 * 1024 + g16 * 16 + kq] = bf2f(g_v);
    if (kq == 0) b[5 * 1024 + 256 + g16] = khr;
  };
  __syncthreads();
  gload(0); derive(0);
  __syncthreads();
  constexpr int NC = SEQ / 16;
  for (int c = 0; c < NC; ++c) {
    if (c + 1 < NC) gload(c + 1);
    const float* b = sm + (c & 1) * BUFF;
    float4 nk = *(const float4*)(b + 3 * 1024 + kq * 4);
    float4 w = *(const float4*)(b + 1 * 1024 + kq * 4);
    float4 bb = *(const float4*)(b + 4 * 1024 + kq * 4);
    float4 kh = *(const float4*)(b + 2 * 1024 + kq * 4);
    float4 wr = *(const float4*)(b + 0 * 1024 + kq * 4);
    float v = b[5 * 1024 + g16];
#pragma unroll
    for (int h = 0; h < 2; ++h) {
      float yp[8];
#pragma unroll
      for (int s = 0; s < 8; ++s) {
        const int t = h * 8 + s;
        float4 nk2, w2, bb2, kh2, wr2; float v2;
        if (t < 15) {
          nk2 = *(const float4*)(b + 3 * 1024 + (t + 1) * 64 + kq * 4);
          w2 = *(const float4*)(b + 1 * 1024 + (t + 1) * 64 + kq * 4);
          bb2 = *(const float4*)(b + 4 * 1024 + (t + 1) * 64 + kq * 4);
          kh2 = *(const float4*)(b + 2 * 1024 + (t + 1) * 64 + kq * 4);
          wr2 = *(const float4*)(b + 0 * 1024 + (t + 1) * 64 + kq * 4);
          v2 = b[5 * 1024 + (t + 1) * 16 + g16];
        }
        const f32v2_t nka = {nk.x, nk.y}, nkb = {nk.z, nk.w}, wra = {wr.x, wr.y}, wrb = {wr.z, wr.w};
        const f32v2_t wa = {w.x, w.y}, wb = {w.z, w.w}, ba = {bb.x, bb.y}, bbv = {bb.z, bb.w}, kha = {kh.x, kh.y}, khb = {kh.z, kh.w};
        const f32v2_t ps = SA * nka + SB * nkb;
        const f32v2_t py = SA * wra + SB * wrb;
        float sa = ps.x + ps.y;
        yp[s] = py.x + py.y;
        sa = red16(sa);
        const f32v2_t sa2 = {sa, sa}, vv2 = {v, v};
        SA = SA * wa + (sa2 * ba + vv2 * kha);
        SB = SB * wb + (sa2 * bbv + vv2 * khb);
        if (t < 15) { nk = nk2; w = w2; bb = bb2; kh = kh2; wr = wr2; v = v2; }
      }
      const bool b2 = (kq & 4) != 0, b1 = (kq & 2) != 0, b0 = (kq & 1) != 0;
#pragma unroll
      for (int i = 0; i < 8; ++i) yp[i] += dppf<0x128>(yp[i]);
      float q4[4];
#pragma unroll
      for (int i = 0; i < 4; ++i) { const float keep = b2 ? yp[i + 4] : yp[i], send = b2 ? yp[i] : yp[i + 4]; q4[i] = keep + dppf<0x141>(send); }
      float q2[2];
#pragma unroll
      for (int i = 0; i < 2; ++i) { const float keep = b1 ? q4[i + 2] : q4[i], send = b1 ? q4[i] : q4[i + 2]; q2[i] = keep + dppf<0x4E>(send); }
      const float keep = b0 ? q2[1] : q2[0], send = b0 ? q2[0] : q2[1];
      float yv = keep + dppf<0xB1>(send);
      const int tt = h * 8 + (kq & 7);
      yv += b[5 * 1024 + tt * 16 + g16] * b[5 * 1024 + 256 + tt];
      if ((kq >> 3) == h) Y[(size_t)(c * 16 + tt) * 512 + hd * 64 + rg * 16 + g16] = f2bf(yv);
    }
    if (c + 1 < NC) derive((c + 1) & 1);
    __syncthreads();
  }
}

DI void hgrn_scan_unit(const Params& p, int l, int u, char* smem) {
  const int tid = TID();
  const int bl = u >> 5, hd = (u >> 3) & 3, vg = u & 7;
  const int kq = tid & 15, g16 = tid >> 4;
  bf16_t* Pm = (bf16_t*)(p.ws + R_P) + (size_t)bl * SEQ * PLD;
  float* sm = (float*)smem;
  constexpr int BUFF = 2 * 2048 + 256 + 16;
  const int kc = hd * 128 + kq * 8;
  f32v2_t S2[4];
#pragma unroll
  for (int e = 0; e < 4; ++e) S2[e] = f32v2_t{0.f, 0.f};
  uint4 g_q, g_f; bf16_t g_v;
  const int vcol = PC_HG + 1024 + hd * 128 + vg * 16;
  auto gload = [&](int c) {
    const int tok = c * 16 + g16;
    g_q = *(const uint4*)(Pm + (size_t)tok * PLD + PC_HG + kc);
    g_f = *(const uint4*)(Pm + (size_t)tok * PLD + PC_HG + 512 + kc);
    g_v = Pm[(size_t)tok * PLD + vcol + kq];
  };
  auto derive = [&](int buf) {
    float* b = sm + buf * BUFF;
    const unsigned qu[4] = {g_q.x, g_q.y, g_q.z, g_q.w}, fu[4] = {g_f.x, g_f.y, g_f.z, g_f.w};
    float fq[8], f[8], cs = 0.f;
#pragma unroll
    for (int e = 0; e < 8; ++e) {
      const float q = (e & 1) ? bfhi(qu[e >> 1]) : bflo(qu[e >> 1]);
      const float kf = (e & 1) ? bfhi(fu[e >> 1]) : bflo(fu[e >> 1]);
      f[e] = 1.f - kf;
      fq[e] = f[e] * q;
      cs += kf * q;
    }
    cs = red16(cs);
    *(float4*)(b + g16 * 128 + kq * 8) = float4{fq[0], fq[1], fq[2], fq[3]};
    *(float4*)(b + g16 * 128 + kq * 8 + 4) = float4{fq[4], fq[5], fq[6], fq[7]};
    *(float4*)(b + 2048 + g16 * 128 + kq * 8) = float4{f[0], f[1], f[2], f[3]};
    *(float4*)(b + 2048 + g16 * 128 + kq * 8 + 4) = float4{f[4], f[5], f[6], f[7]};
    b[4096 + g16 * 16 + kq] = bf2f(g_v);
    if (kq == 0) b[4096 + 256 + g16] = cs;
  };
  __syncthreads();
  gload(0); derive(0);
  __syncthreads();
  constexpr int NC = SEQ / 16;
  for (int c = 0; c < NC; ++c) {
    if (c + 1 < NC) gload(c + 1);
    const float* b = sm + (c & 1) * BUFF;
    float4 q0 = *(const float4*)(b + kq * 8), q1 = *(const float4*)(b + kq * 8 + 4);
    float4 f0 = *(const float4*)(b + 2048 + kq * 8), f1 = *(const float4*)(b + 2048 + kq * 8 + 4);
    float v = b[4096 + g16];
#pragma unroll
    for (int h = 0; h < 2; ++h) {
      float yp[8];
#pragma unroll
      for (int s = 0; s < 8; ++s) {
        const int t = h * 8 + s;
        float4 q0n, q1n, f0n, f1n; float vn;
        if (t < 15) {
          q0n = *(const float4*)(b + (t + 1) * 128 + kq * 8); q1n = *(const float4*)(b + (t + 1) * 128 + kq * 8 + 4);
          f0n = *(const float4*)(b + 2048 + (t + 1) * 128 + kq * 8); f1n = *(const float4*)(b + 2048 + (t + 1) * 128 + kq * 8 + 4);
          vn = b[4096 + (t + 1) * 16 + g16];
        }
        const f32v2_t fq2[4] = {{q0.x, q0.y}, {q0.z, q0.w}, {q1.x, q1.y}, {q1.z, q1.w}};
        const f32v2_t ff2[4] = {{f0.x, f0.y}, {f0.z, f0.w}, {f1.x, f1.y}, {f1.z, f1.w}};
        const f32v2_t vv2 = {v, v};
        f32v2_t o2 = S2[0] * fq2[0];
#pragma unroll
        for (int e = 1; e < 4; ++e) o2 = S2[e] * fq2[e] + o2;
#pragma unroll
        for (int e = 0; e < 4; ++e) S2[e] = ff2[e] * (S2[e] - vv2) + vv2;
        yp[s] = o2.x + o2.y;
        if (t < 15) { q0 = q0n; q1 = q1n; f0 = f0n; f1 = f1n; v = vn; }
      }
      const bool b2 = (kq & 4) != 0, b1 = (kq & 2) != 0, b0 = (kq & 1) != 0;
#pragma unroll
      for (int i = 0; i < 8; ++i) yp[i] += dppf<0x128>(yp[i]);
      float q4[4];
#pragma unroll
      for (int i = 0; i < 4; ++i) { const float keep = b2 ? yp[i + 4] : yp[i], send = b2 ? yp[i] : yp[i + 4]; q4[i] = keep + dppf<0x141>(send); }
      float q2[2];
#pragma unroll
      for (int i = 0; i < 2; ++i) { const float keep = b1 ? q4[i + 2] : q4[i], send = b1 ? q4[i] : q4[i + 2]; q2[i] = keep + dppf<0x4E>(send); }
      const float keep = b0 ? q2[1] : q2[0], send = b0 ? q2[0] : q2[1];
      float ov = keep + dppf<0xB1>(send);
      const int tt = h * 8 + (kq & 7);
      ov += b[4096 + tt * 16 + g16] * b[4096 + 256 + tt];
      if ((kq >> 3) == h) Pm[(size_t)(c * 16 + tt) * PLD + vcol + g16] = f2bf(ov);
    }
    if (c + 1 < NC) derive((c + 1) & 1);
    __syncthreads();
  }
}

DI void s5_scan_unit(const Params& p, int l, int u, char* smem) {
  const int tid = TID(), lane = tid & 63, wave = tid >> 6;
  const int idx = u * 4 + wave, bl = idx >> 5, g = idx & 31;
  const bf16_t* Pm = (const bf16_t*)(p.ws + R_P) + (size_t)bl * SEQ * PLD + PC_S5 + g * 16;
  bf16_t* Z = (bf16_t*)(p.ws + R_ZS5) + (size_t)bl * SEQ * 512 + g * 16;
  constexpr int BUS = 132;
  float* buT = (float*)smem + wave * (16 * BUS);
  bf16_t* hist = (bf16_t*)(smem + 4 * 16 * BUS * 4) + wave * (16 * 136);
  const float2 ab = *(const float2*)((const float*)(p.ws + OFF_S5AB) + (g * 64 + lane) * 2);
  const int l16 = lane & 15, quad = lane >> 4;
  bf16x8 bbf[8];
  {
    const float* bbp = (const float*)(p.ws + OFF_S5BB);
#pragma unroll
    for (int jb = 0; jb < 8; ++jb) {
      const int col = jb * 16 + l16, nn = col & 63, im = col >> 6;
      unsigned pk[4] = {0u, 0u, 0u, 0u};
      if (quad < 2) {
        const float* src = bbp + (size_t)(g * 64 + nn) * 32 + im * 16 + quad * 8;
#pragma unroll
        for (int e = 0; e < 4; ++e) pk[e] = pack2(src[2 * e], src[2 * e + 1]);
      }
      bbf[jb] = __builtin_bit_cast(bf16x8, uint4{pk[0], pk[1], pk[2], pk[3]});
    }
  }
  bf16x8 cf[4];
  {
    const float* Cre = p.in[16] + (size_t)l * 32768 + (size_t)(g * 16 + l16) * 64;
    const float* Cim = p.in[17] + (size_t)l * 32768 + (size_t)(g * 16 + l16) * 64;
#pragma unroll
    for (int ks = 0; ks < 4; ++ks) {
      unsigned pk[4];
#pragma unroll
      for (int e = 0; e < 4; ++e) {
        const int k = ks * 32 + quad * 8 + 2 * e;
        const float v0 = (k < 64) ? Cre[k] : -Cim[k - 64];
        const float v1 = (k < 64) ? Cre[k + 1] : -Cim[k + 1 - 64];
        pk[e] = pack2(v0, v1);
      }
      cf[ks] = __builtin_bit_cast(bf16x8, uint4{pk[0], pk[1], pk[2], pk[3]});
    }
  }
  const float dcoef = p.in[18][l * 512 + g * 16 + l16];
  float xr = 0.f, xi = 0.f;
  uint4 ua = uint4{0u, 0u, 0u, 0u};
  bf16_t ue[4];
  auto gload = [&](int c) {
    if (quad < 2) ua = *(const uint4*)(Pm + (size_t)(c * 16 + l16) * PLD + quad * 8);
#pragma unroll
    for (int r = 0; r < 4; ++r) ue[r] = Pm[(size_t)(c * 16 + quad * 4 + r) * PLD + l16];
  };
  __syncthreads();
  gload(0);
  constexpr int NC = SEQ / 16;
  for (int c = 0; c < NC; ++c) {
    const bf16x8 afr = __builtin_bit_cast(bf16x8, ua);
    float us[4];
#pragma unroll
    for (int r = 0; r < 4; ++r) us[r] = bf2f(ue[r]);
#pragma unroll
    for (int jb = 0; jb < 8; ++jb) {
      f32x4 acc = {0.f, 0.f, 0.f, 0.f};
      acc = __builtin_amdgcn_mfma_f32_16x16x32_bf16(afr, bbf[jb], acc, 0, 0, 0);
#pragma unroll
      for (int r = 0; r < 4; ++r) buT[(quad * 4 + r) * BUS + jb * 16 + l16] = acc[r];
    }
    if (c + 1 < NC) gload(c + 1);
    __syncthreads();
#pragma unroll
    for (int t = 0; t < 16; ++t) {
      const float ur = buT[t * BUS + lane], ui = buT[t * BUS + 64 + lane];
      const float nr = ab.x * xr - ab.y * xi + ur;
      const float ni = ab.x * xi + ab.y * xr + ui;
      xr = nr; xi = ni;
      hist[t * 136 + lane] = f2bf(xr);
      hist[t * 136 + 64 + lane] = f2bf(xi);
    }
    __syncthreads();
    f32x4 acc = {0.f, 0.f, 0.f, 0.f};
#pragma unroll
    for (int ks = 0; ks < 4; ++ks) {
      const bf16x8 a = *(const bf16x8*)(hist + l16 * 136 + ks * 32 + quad * 8);
      acc = __builtin_amdgcn_mfma_f32_16x16x32_bf16(a, cf[ks], acc, 0, 0, 0);
    }
#pragma unroll
    for (int r = 0; r < 4; ++r) {
      const int t = quad * 4 + r;
      const float y = acc[r] + dcoef * us[r];
      const float z = y * sigm(1.5957691216057308f * (y + 0.044715f * y * y * y));
      Z[(size_t)(c * 16 + t) * 512 + l16] = f2bf(z);
    }
  }
}

#define GSYNC() xcd_barrier(xb)
#define TILE_MAP(u_, ntm_, tm_, tn_) { const int _x = (u_) & 7, _li = (u_) >> 3, _per = (ntm_) >> 3; tm_ = _x * _per + (_li % _per); tn_ = _li / _per; }
__global__ void __launch_bounds__(256, 2) mega_kernel(Params p) {
  cg::grid_group grid = cg::this_grid();
  __shared__ __attribute__((aligned(16))) char smem[SMEM_BYTES];
  __shared__ uint4 xb_words;
  const int bid = blockIdx.x, nb = gridDim.x;
  if (p.ws == nullptr) grid.sync();
  if (threadIdx.x == 0) xb_words = make_uint4(0u, 0u, 0u, 0u);
  __syncthreads();
  const XcdBarrier xb = xcd_barrier_post((unsigned*)(p.ws + OFF_BAR), (volatile LAS unsigned*)&xb_words);
  char* ws = p.ws;
  float* X = p.out;
  bf16_t* Wt_in = (bf16_t*)(ws + OFF_WIN);
  bf16_t* Wt_q = (bf16_t*)(ws + OFF_WQ);
  bf16_t* Wt_br = (bf16_t*)(ws + OFF_WBR);
  bf16_t* Wt_out = (bf16_t*)(ws + OFF_WOUT);
  bf16_t* Wt_glu = (bf16_t*)(ws + OFF_WGLU);
  bf16_t* Wt_wup = (bf16_t*)(ws + OFF_WWUP);
  bf16_t* Wt_aup = (bf16_t*)(ws + OFF_WAUP);
  bf16_t* Wt_gup = (bf16_t*)(ws + OFF_WGUP);
  bf16_t* Wt_v = (bf16_t*)(ws + OFF_WV);
  bf16_t* Wt_xkv = (bf16_t*)(ws + OFF_WXKV);
  bf16_t* Hb = (bf16_t*)(ws + OFF_H);
  bf16_t* Vfirst = (bf16_t*)(ws + OFF_VFIRST);
  bf16_t* Kx = (bf16_t*)(ws + OFF_KX);
  bf16_t* VxT = (bf16_t*)(ws + OFF_VXT);
  bf16_t* Hm = (bf16_t*)(ws + OFF_HM);
  float* CosT = (float*)(ws + OFF_COS);
  float* SinT = (float*)(ws + OFF_SIN);
  bf16_t* Pm = (bf16_t*)(ws + R_P);
  bf16_t* Cqn = (bf16_t*)(ws + R_CQN);
  bf16_t* Qp = (bf16_t*)(ws + R_QP);
  bf16_t* KVlat = (bf16_t*)(ws + R_KVLAT);
  bf16_t* VTm = (bf16_t*)(ws + R_VT);
  bf16_t* RKV = (bf16_t*)(ws + R_RKV);
  bf16_t* Alora = (bf16_t*)(ws + R_ALORA);
  bf16_t* Yrw = (bf16_t*)(ws + R_YRW);
  bf16_t* Zs5 = (bf16_t*)(ws + R_ZS5);
  bf16_t* Ybr = (bf16_t*)(ws + R_YBR);
  bf16_t* Wt_xq = (bf16_t*)(ws + R_WXQ);
  bf16_t* Wt_xo = (bf16_t*)(ws + R_WXO);
  bf16_t* Wt_gu = (bf16_t*)(ws + R_WGU);
  bf16_t* Wt_down = (bf16_t*)(ws + R_WDOWN);
  bf16_t* Qx = (bf16_t*)(ws + R_QX);
  bf16_t* Ox = (bf16_t*)(ws + R_OX);
  bf16_t* GU = (bf16_t*)(ws + R_GU);
  const float LOG2E = 1.4426950408889634f;

  for (int l = 0; l < 2; ++l) {
    {
      PHASE_IDS
      const float* w_in = p.in[4] + (size_t)l * 1024 * P_IN;
      transpose_all(w_in, P_IN, 1024, P_IN, Wt_in, bid, nb, smem);
      transpose_all(p.in[36] + (size_t)l * 512 * 1024, 1024, 512, 1024, Wt_br + (size_t)1 * 1024 * 512, bid, nb, smem);
      transpose_all(p.in[37] + (size_t)l * 512 * 1024, 1024, 512, 1024, Wt_br + (size_t)2 * 1024 * 512, bid, nb, smem);
      transpose_all(p.in[38] + (size_t)l * 512 * 1024, 1024, 512, 1024, Wt_br + (size_t)3 * 1024 * 512, bid, nb, smem);
      transpose_all(p.in[39] + (size_t)l * 1024 * 1024, 1024, 1024, 1024, Wt_out, bid, nb, smem);
      transpose_all(p.in[19] + (size_t)l * 512 * 512, 512, 512, 512, Wt_glu, bid, nb, smem);
      transpose_all(p.in[23] + (size_t)l * 64 * 512, 512, 64, 512, Wt_wup, bid, nb, smem);
      transpose_all(p.in[25] + (size_t)l * 64 * 512, 512, 64, 512, Wt_aup, bid, nb, smem);
      transpose_all(p.in[26] + (size_t)l * 128 * 512, 512, 128, 512, Wt_gup, bid, nb, smem);
      transpose_all(p.in[43] + (size_t)l * 1024 * 2048, 2048, 1024, 2048, Wt_xkv, bid, nb, smem);
      const int gtid = bid * 256 + tid, gsz = nb * 256;
      {
        const float* w_uq = p.in[6] + (size_t)l * 256 * 768;
        const float* w_ukv = p.in[8] + (size_t)l * 128 * 1024;
        for (int e = gtid; e < 768 * 256; e += gsz) {
          const int n = e >> 8, kq = e & 255, hh = n / 192, j = n % 192;
          float v;
          if (j >= 128) v = w_uq[kq * 768 + n];
          else {
            const float4* a = (const float4*)(w_uq + kq * 768 + hh * 192);
            const float4* b = (const float4*)(w_ukv + j * 1024 + hh * 256);
            float v0 = 0.f, v1 = 0.f, v2 = 0.f, v3 = 0.f;
#pragma unroll 8
            for (int d = 0; d < 32; ++d) { const float4 x = a[d], y = b[d]; v0 += x.x * y.x; v1 += x.y * y.y; v2 += x.z * y.z; v3 += x.w * y.w; }
            v = (v0 + v1) + (v2 + v3);
          }
          Wt_q[e] = f2bf(v);
        }
        const float* w_bm = p.in[35] + (size_t)l * 512 * 1024;
        for (int e = gtid; e < 1024 * 512; e += gsz) {
          const int n = e & 1023, kk = e >> 10, hh = kk >> 7, j = kk & 127;
          const float* a = w_ukv + j * 1024 + hh * 256 + 128;
          const float* bcol = w_bm + (size_t)(hh * 128) * 1024 + n;
          float v0 = 0.f, v1 = 0.f, v2 = 0.f, v3 = 0.f;
#pragma unroll 4
          for (int d = 0; d < 128; d += 4) {
            const float4 x = *(const float4*)(a + d);
            v0 += x.x * bcol[(size_t)(d + 0) * 1024]; v1 += x.y * bcol[(size_t)(d + 1) * 1024];
            v2 += x.z * bcol[(size_t)(d + 2) * 1024]; v3 += x.w * bcol[(size_t)(d + 3) * 1024];
          }
          Wt_br[(size_t)n * 512 + kk] = f2bf((v0 + v1) + (v2 + v3));
        }
        if (l == 1) {
          const float* vd = p.in[32];
          const float* vu = p.in[33];
          for (int e = gtid; e < 512 * 1024; e += gsz) {
            const int n = e & 511, kk = e >> 9;
            float v0 = 0.f, v1 = 0.f, v2 = 0.f, v3 = 0.f;
#pragma unroll
            for (int r = 0; r < 32; r += 4) {
              const float4 x = *(const float4*)(vd + kk * 32 + r);
              v0 += x.x * vu[(r + 0) * 512 + n]; v1 += x.y * vu[(r + 1) * 512 + n];
              v2 += x.z * vu[(r + 2) * 512 + n]; v3 += x.w * vu[(r + 3) * 512 + n];
            }
            Wt_v[(size_t)n * 1024 + kk] = f2bf((v0 + v1) + (v2 + v3));
          }
        }
      }
      {
        float* lbt = (float*)(ws + OFF_BAR) + 3456;
        for (int e = gtid; e < 512; e += gsz) {
          const float x0 = p.in[9][e], x1 = p.in[9][512 + e];
          lbt[e] = (l == 0) ? 0.f : 1.f / (1.f + expf(x0 - x1));
        }
      }
      {
        float* abp = (float*)(ws + OFF_S5AB);
        float* bbp = (float*)(ws + OFF_S5BB);
        for (int e = gtid; e < 2048; e += gsz) {
          const int g = e >> 6;
          const float are = fminf(p.in[11][l * 2048 + e], -1e-4f), aim = p.in[12][l * 2048 + e];
          const float dt = expf(p.in[13][l * 32 + g]);
          const float mag = expf(dt * are);
          const float abre = mag * cosf(dt * aim), abim = mag * sinf(dt * aim);
          const float den = are * are + aim * aim;
          const float zre = ((abre - 1.f) * are + abim * aim) / den;
          const float zim = (abim * are - (abre - 1.f) * aim) / den;
          abp[e * 2] = abre; abp[e * 2 + 1] = abim;
          const float* Br = p.in[14] + (size_t)l * 32768 + (size_t)e * 16;
          const float* Bi = p.in[15] + (size_t)l * 32768 + (size_t)e * 16;
          for (int c = 0; c < 16; ++c) {
            bbp[e * 32 + c] = zre * Br[c] - zim * Bi[c];
            bbp[e * 32 + 16 + c] = zre * Bi[c] + zim * Br[c];
          }
        }
      }
      if (l == 0) rmsnorm_rows(p.in[0], p.in[3], Hb, X, T_ALL, bid, nb);
      else rmsnorm_rows(X, p.in[3] + 1024, Hb, nullptr, T_ALL, bid, nb);
      rmsnorm_rows(p.in[1], p.in[41] + l * 1024, Hm, nullptr, 1024, bid, nb);
    }
    GSYNC();

    for (int half = 0; half < 2; ++half) {
      const bf16_t* Hh = Hb + (size_t)half * TH * 1024;
      {
        const int n1 = 64 * 38;
        const int n2 = (half == 0) ? 8 * 16 : 0;
        int par = 0;
        for (int u = bid; u < n1 + n2; u += nb) {
          f32x4 acc[4][4];
          zero_acc<4>(acc);
          if (u < n1) {
            int tm, tn; TILE_MAP(u, 64, tm, tn);
            int tmn = tm, tnn = tn; if (u + nb < n1) TILE_MAP(u + nb, 64, tmn, tnn);
            gemm_acc<128>(Hh + (size_t)tm * 128 * 1024, 1024, Wt_in + (size_t)tn * 128 * 1024, 1024, 1024, smem, acc,
                          Hh + (size_t)tmn * 128 * 1024, 1024, Wt_in + (size_t)tnn * 128 * 1024, 1024, u != bid, par);
            EPI4_FOR(128) {
              const int row = tm * 128 + EPI_ROW, n = tn * 128 + EPI4_COL(128);
              if (n < GATE_OFF) {
                const int pc = (n < 448) ? n : n + 64;
                f32x4 ov = acc[i][j];
                if (n >= 960 && n < 1472) {
                  const float4 lb4 = *(const float4*)((const float*)(ws + OFF_BAR) + 3456 + (n - 960));
                  ov[0] = (1.f - lb4.x) * sigm(-ov[0]); ov[1] = (1.f - lb4.y) * sigm(-ov[1]);
                  ov[2] = (1.f - lb4.z) * sigm(-ov[2]); ov[3] = (1.f - lb4.w) * sigm(-ov[3]);
                }
                *(uint2*)(Pm + (size_t)row * PLD + pc) = pack4(ov);
              }
            }
          } else {
            const int v = u - n1, tn = v % 16, tm = v / 16;
            gemm_acc<128>(Hm + (size_t)tm * 128 * 1024, 1024, Wt_xkv + (size_t)tn * 128 * 1024, 1024, 1024, smem, acc);
            EPI_FOR(128) {
              const int row = tm * 128 + EPI_ROW, n = tn * 128 + EPI_COL(128);
              const int b = row >> 8, m = row & 255, sel = n >> 10, hh = (n >> 8) & 3, d = n & 255;
              if (sel == 0) Kx[((size_t)(b * 4 + hh) * 256 + m) * 256 + d] = f2bf(acc[i][j][r]);
              else VxT[((size_t)(b * 4 + hh) * 256 + d) * 256 + m] = f2bf(acc[i][j][r]);
            }
          }
        }
      }
      GSYNC();
      {
      PHASE_IDS
        const float* qn = p.in[5] + l * 256;
        const float* kvn = p.in[7] + l * 128;
        const float* mu = p.in[21] + l * 1792;
        for (int tk = bid * 4 + wave; tk < TH; tk += nb * 4) {
          const int gtok = half * TH + tk, s = gtok & (SEQ - 1), bl = tk >> 12;
          const bf16_t* prow = Pm + (size_t)tk * PLD;
          {
            const uint2 cu = *(const uint2*)(prow + lane * 4);
            float f[4] = {bflo(cu.x), bfhi(cu.x), bflo(cu.y), bfhi(cu.y)};
            float ss = wave_sum(f[0] * f[0] + f[1] * f[1] + f[2] * f[2] + f[3] * f[3]);
            const float rs = rsqrtf(ss * (1.f / 256.f) + 1e-6f);
            const float4 g4 = *(const float4*)(qn + lane * 4);
            uint2 o; o.x = pack2(f[0] * rs * g4.x, f[1] * rs * g4.y); o.y = pack2(f[2] * rs * g4.z, f[3] * rs * g4.w);
            *(uint2*)(Cqn + (size_t)tk * 256 + lane * 4) = o;
          }
          {
            const unsigned cu = *(const unsigned*)(prow + 256 + lane * 2);
            const float f0 = bflo(cu), f1 = bfhi(cu);
            const float ss = wave_sum(f0 * f0 + f1 * f1);
            const float rs = rsqrtf(ss * (1.f / 128.f) + 1e-6f);
            const float v0 = f0 * rs * kvn[lane * 2], v1 = f1 * rs * kvn[lane * 2 + 1];
            const bf16_t b0 = f2bf(v0), b1 = f2bf(v1);
            *(unsigned*)(KVlat + (size_t)tk * 192 + lane * 2) = (unsigned)b0 | ((unsigned)b1 << 16);
            VTm[((size_t)bl * 128 + lane * 2) * SEQ + s] = b0;
            VTm[((size_t)bl * 128 + lane * 2 + 1) * SEQ + s] = b1;
          }
          if (lane < 32) {
            const float t1 = bf2f(prow[384 + lane]), t2 = bf2f(prow[384 + 32 + lane]);
            const float posf = (float)p.pos[gtok];
            const float invf = exp2f(-(float)lane * (13.287712379549449f / 32.f));
            const float ang = posf * invf;
            const float cs = cosf(ang), sn = sinf(ang);
            KVlat[(size_t)tk * 192 + 128 + lane] = f2bf(t1 * cs - t2 * sn);
            KVlat[(size_t)tk * 192 + 160 + lane] = f2bf(t1 * sn + t2 * cs);
            CosT[tk * 32 + lane] = cs; SinT[tk * 32 + lane] = sn;
          }
#pragma unroll
          for (int jj = 0; jj < 7; ++jj) {
            const int col = (jj * 64 + lane) * 4;
            const uint2 cu = *(const uint2*)(prow + PC_RW + col);
            uint2 pu = uint2{0u, 0u};
            if (s > 0) pu = *(const uint2*)(prow - PLD + PC_RW + col);
            const float4 m4 = *(const float4*)(mu + col);
            const float cv[4] = {bflo(cu.x), bfhi(cu.x), bflo(cu.y), bfhi(cu.y)};
            const float pv[4] = {bflo(pu.x), bfhi(pu.x), bflo(pu.y), bfhi(pu.y)};
            const float mm[4] = {m4.x, m4.y, m4.z, m4.w};
            float o[4];
#pragma unroll
            for (int e = 0; e < 4; ++e) o[e] = cv[e] + (pv[e] - cv[e]) * mm[e];
            if (col < 1536) {
              uint2 ov; ov.x = pack2(o[0], o[1]); ov.y = pack2(o[2], o[3]);
              *(uint2*)(RKV + (size_t)tk * 1536 + col) = ov;
              if (l == 0 && col >= 1024) *(uint2*)(Vfirst + (size_t)gtok * 512 + (col - 1024)) = ov;
            } else {
              int dc;
              if (col < 1600) { dc = col - 1536; for (int e = 0; e < 4; ++e) o[e] = tanhf(o[e]); }
              else if (col < 1664) { dc = 64 + col - 1600; }
              else { dc = 128 + col - 1664; for (int e = 0; e < 4; ++e) o[e] = sigm(o[e]); }
              uint2 ov; ov.x = pack2(o[0], o[1]); ov.y = pack2(o[2], o[3]);
              *(uint2*)(Alora + (size_t)tk * 256 + dc) = ov;
            }
          }
        }
      }
      GSYNC();
      {
      PHASE_IDS
        const int nq = 64 * 6, nl = 64 * 4;
        const int total = nq + 3 * nl + (l == 1 ? nl : 0);
        for (int u = bid; u < total; u += nb) {
          f32x4 acc[4][4];
          zero_acc<4>(acc);
          if (u < nq) {
            int tm, tn; TILE_MAP(u, 64, tm, tn);
            gemm_acc<128>(Cqn + (size_t)tm * 128 * 256, 256, Wt_q + (size_t)tn * 128 * 256, 256, 256, smem, acc);
            const float qs = 0.07216878364870322f * LOG2E;
            const int lane_ = tid & 63, wave_ = tid >> 6, wm_ = wave_ >> 1, wn_ = wave_ & 1, l16_ = lane_ & 15, quad_ = lane_ >> 4;
            const int gc = tn * 128 + wn_ * 64;
            const bool is_rope = (gc % 192) == 128;
#pragma unroll
            for (int i = 0; i < 4; ++i) {
              const int row = tm * 128 + wm_ * 64 + i * 16 + l16_;
              if (is_rope) {
#pragma unroll
                for (int j = 0; j < 2; ++j) {
                  const int fi = j * 16 + quad_ * 4;
                  const float4 cs = *(const float4*)(CosT + row * 32 + fi), sn = *(const float4*)(SinT + row * 32 + fi);
                  const float c4[4] = {cs.x, cs.y, cs.z, cs.w}, s4[4] = {sn.x, sn.y, sn.z, sn.w};
#pragma unroll
                  for (int r = 0; r < 4; ++r) {
                    const float t1 = acc[i][j][r], t2 = acc[i][j + 2][r];
                    acc[i][j][r] = t1 * c4[r] - t2 * s4[r]; acc[i][j + 2][r] = t1 * s4[r] + t2 * c4[r];
                  }
                }
              }
#pragma unroll
              for (int j = 0; j < 4; ++j) *(uint2*)(Qp + (size_t)row * 768 + gc + j * 16 + quad_ * 4) = pack4(acc[i][j] * qs);
            }
          } else if (u < nq + 3 * nl) {
            const int v = u - nq, which = v / nl, w2 = v % nl, tn = w2 % 4, tm = w2 / 4;
            if (which == 0) {
              gemm_acc<128>(Alora + (size_t)tm * 128 * 256, 256, Wt_wup + (size_t)tn * 128 * 64, 64, 64, smem, acc);
              const float* w0 = p.in[22] + l * 512;
              EPI4_FOR(128) {
                const int row = tm * 128 + EPI_ROW, n = tn * 128 + EPI4_COL(128);
                const float4 b4 = *(const float4*)(w0 + n);
                f32x4 wv = acc[i][j] + f32x4{b4.x, b4.y, b4.z, b4.w};
#pragma unroll
                for (int r = 0; r < 4; ++r) wv[r] = -0.6065306597126334f * sigm(wv[r]);
                *(uint2*)(Pm + (size_t)row * PLD + PC_RW + n) = pack4(wv);
              }
            } else if (which == 1) {
              gemm_acc<128>(Alora + (size_t)tm * 128 * 256 + 64, 256, Wt_aup + (size_t)tn * 128 * 64, 64, 64, smem, acc);
              const float* a0 = p.in[24] + l * 512;
              EPI4_FOR(128) {
                const int row = tm * 128 + EPI_ROW, n = tn * 128 + EPI4_COL(128);
                const float4 b4 = *(const float4*)(a0 + n);
                f32x4 v = acc[i][j] + f32x4{b4.x, b4.y, b4.z, b4.w};
#pragma unroll
                for (int r = 0; r < 4; ++r) v[r] = sigm(v[r]);
                *(uint2*)(Pm + (size_t)row * PLD + PC_RW + 512 + n) = pack4(v);
              }
            } else {
              gemm_acc<128>(Alora + (size_t)tm * 128 * 256 + 128, 256, Wt_gup + (size_t)tn * 128 * 128, 128, 128, smem, acc);
              EPI4_FOR(128) {
                const int row = tm * 128 + EPI_ROW, n = tn * 128 + EPI4_COL(128);
                *(uint2*)(Pm + (size_t)row * PLD + PC_RW + 1024 + n) = pack4(acc[i][j]);
              }
            }
          } else {
            const int w2 = u - nq - 3 * nl, tn = w2 % 4, tm = w2 / 4;
            gemm_acc<128>(Hh + (size_t)tm * 128 * 1024, 1024, Wt_v + (size_t)tn * 128 * 1024, 1024, 1024, smem, acc);
            const float* vb = p.in[34];
            EPI4_FOR(128) {
              const int row = tm * 128 + EPI_ROW, n = tn * 128 + EPI4_COL(128);
              const float4 b4 = *(const float4*)(vb + n);
              const f32x4 lg = acc[i][j] + f32x4{b4.x, b4.y, b4.z, b4.w};
              const f32x4 vc = unpack4(*(const uint2*)(RKV + (size_t)row * 1536 + 1024 + n));
              const f32x4 vf = unpack4(*(const uint2*)(Vfirst + ((size_t)half * TH + row) * 512 + n));
              f32x4 o;
#pragma unroll
              for (int r = 0; r < 4; ++r) o[r] = vc[r] + (vf[r] - vc[r]) * sigm(lg[r]);
              *(uint2*)(RKV + (size_t)row * 1536 + 1024 + n) = pack4(o);
            }
          }
        }
      }
      GSYNC();
      {
        int first, count, step;
        if (nb == 512) {
          if (bid < 144) { first = bid; count = 1; step = 0; }
          else {
            int pi = -1;
            if (bid < 256) pi = bid - 144; else if (bid >= 400 && bid < 416) pi = 112 + (bid - 400);
            first = 144 + pi; count = (pi >= 0) ? 2 : 0; step = 255 - 2 * pi;
          }
        } else { first = bid; step = nb; count = (bid < 400) ? (400 - bid + nb - 1) / nb : 0; }
#pragma unroll 1
        for (int q = 0; q < count; ++q) {
          const int u = first + q * step;
          if (u < 144) {
            __builtin_amdgcn_s_setprio(3);
            if (u < 64) rwkv_scan_unit(p, l, u, smem);
            else if (u < 128) hgrn_scan_unit(p, l, u - 64, smem);
            else s5_scan_unit(p, l, u - 128, smem);
            __builtin_amdgcn_s_setprio(0);
          } else {
            const int it = u - 144, qt = 31 - (it >> 3), bl = (it >> 2) & 1, hh = it & 3;
            attn_item_pf<192, true>(Qp + (size_t)bl * SEQ * 768 + hh * 192, 768, KVlat + (size_t)bl * SEQ * 192, 192,
                                    VTm + (size_t)bl * 128 * SEQ, SEQ, (qt * 128 + 128) / 64, qt * 128,
                                    Pm + (size_t)bl * SEQ * PLD + hh * 128, PLD, smem);
          }
        }
        {
          unsigned char* G8 = (unsigned char*)(ws + R_G8);
          int g0, gs;
          if (nb == 512) { g0 = (bid >= 416) ? bid - 416 : 2048; gs = 96; } else { g0 = bid; gs = nb; }
#pragma unroll 1
          for (int t = g0; t < 2048; t += gs) {
            const int tm = t >> 5, tn = t & 31;
            f32x4 acc[4][4];
            zero_acc<4>(acc);
            gemm_acc<128>(Hh + (size_t)tm * 128 * 1024, 1024, Wt_in + (size_t)(GATE_OFF + tn * 128) * 1024, 1024, 1024, smem, acc);
            EPI4_FOR(128) {
              const int row = tm * 128 + EPI_ROW, n = tn * 128 + EPI4_COL(128);
              unsigned q = 0;
#pragma unroll
              for (int r = 0; r < 4; ++r) q |= ((unsigned)(sigm(acc[i][j][r]) * 255.f + 0.5f)) << (8 * r);
              *(unsigned*)(G8 + (size_t)row * 4096 + n) = q;
            }
          }
        }
      }
      GSYNC();
      {
      PHASE_IDS
        const int nglu = 64 * 4;
        for (int u = bid; u < nglu; u += nb) {
          int tm, tn; TILE_MAP(u, 64, tm, tn);
          f32x4 acc[4][4];
          zero_acc<4>(acc);
          gemm_acc<128>(Zs5 + (size_t)tm * 128 * 512, 512, Wt_glu + (size_t)tn * 128 * 512, 512, 512, smem, acc);
          const float* bg = p.in[20] + l * 512;
          EPI4_FOR(128) {
            const int row = tm * 128 + EPI_ROW, n = tn * 128 + EPI4_COL(128);
            const f32x4 z = unpack4(*(const uint2*)(Zs5 + (size_t)row * 512 + n));
            const float4 b4 = *(const float4*)(bg + n);
            const f32x4 lg = acc[i][j] + f32x4{b4.x, b4.y, b4.z, b4.w};
            f32x4 o;
#pragma unroll
            for (int r = 0; r < 4; ++r) o[r] = z[r] * sigm(lg[r]);
            *(uint2*)(Pm + (size_t)row * PLD + PC_S5 + n) = pack4(o);
          }
        }
        const float* k_a = p.in[28] + l * 512;
        const float* r_k = p.in[29] + l * 512;
        const float* ln_w = p.in[30] + l * 512;
        const float* ln_b = p.in[31] + l * 512;
        const float* o_norm = p.in[10] + l * 512;
        for (int tk = bid * 4 + wave; tk < TH; tk += nb * 4) {
          const int c0 = lane * 8;
          {
            const uint4 yu = *(const uint4*)(Yrw + (size_t)tk * 512 + c0);
            const float y[8] = {bflo(yu.x), bfhi(yu.x), bflo(yu.y), bfhi(yu.y), bflo(yu.z), bfhi(yu.z), bflo(yu.w), bfhi(yu.w)};
            const uint4 ru = *(const uint4*)(RKV + (size_t)tk * 1536 + c0);
            const uint4 ku = *(const uint4*)(RKV + (size_t)tk * 1536 + 512 + c0);
            const uint4 vu = *(const uint4*)(RKV + (size_t)tk * 1536 + 1024 + c0);
            const uint4 au = *(const uint4*)(Pm + (size_t)tk * PLD + PC_RW + 512 + c0);
            const uint4 gu = *(const uint4*)(Pm + (size_t)tk * PLD + PC_RW + 1024 + c0);
            const unsigned ra[4] = {ru.x, ru.y, ru.z, ru.w}, ka[4] = {ku.x, ku.y, ku.z, ku.w}, va[4] = {vu.x, vu.y, vu.z, vu.w};
            const unsigned aa[4] = {au.x, au.y, au.z, au.w}, ga[4] = {gu.x, gu.y, gu.z, gu.w};
            float rr[8], kh[8], vv[8], gg[8];
            float sm1 = 0.f, bsum = 0.f;
#pragma unroll
            for (int e = 0; e < 8; ++e) {
              const unsigned sh = (e & 1);
              rr[e] = sh ? bfhi(ra[e >> 1]) : bflo(ra[e >> 1]);
              const float kx = sh ? bfhi(ka[e >> 1]) : bflo(ka[e >> 1]);
              vv[e] = sh ? bfhi(va[e >> 1]) : bflo(va[e >> 1]);
              const float a = sh ? bfhi(aa[e >> 1]) : bflo(aa[e >> 1]);
              gg[e] = sh ? bfhi(ga[e >> 1]) : bflo(ga[e >> 1]);
              kh[e] = kx * (1.f + (a - 1.f) * k_a[c0 + e]);
              sm1 += y[e];
              bsum += rr[e] * kh[e] * r_k[c0 + e];
            }
            sm1 = red8(sm1); bsum = red8(bsum);
            const float mean = sm1 * (1.f / 64.f);
            float vs = 0.f;
#pragma unroll
            for (int e = 0; e < 8; ++e) { const float d = y[e] - mean; vs += d * d; }
            vs = red8(vs);
            const float rstd = rsqrtf(vs * (1.f / 64.f) + 64e-5f);
            float o[8];
#pragma unroll
            for (int e = 0; e < 8; ++e) o[e] = (((y[e] - mean) * rstd) * ln_w[c0 + e] + ln_b[c0 + e] + bsum * vv[e]) * gg[e];
            uint4 ov; ov.x = pack2(o[0], o[1]); ov.y = pack2(o[2], o[3]); ov.z = pack2(o[4], o[5]); ov.w = pack2(o[6], o[7]);
            *(uint4*)(RKV + (size_t)tk * 1536 + c0) = ov;
          }
          {
            bf16_t* op = Pm + (size_t)tk * PLD + PC_HG + 1024 + c0;
            const uint4 ou = *(const uint4*)op;
            const uint4 gu = *(const uint4*)(Pm + (size_t)tk * PLD + PC_HG + 1536 + c0);
            const unsigned oa[4] = {ou.x, ou.y, ou.z, ou.w}, ga[4] = {gu.x, gu.y, gu.z, gu.w};
            float o[8], ss = 0.f;
#pragma unroll
            for (int e = 0; e < 4; ++e) { o[2 * e] = bflo(oa[e]); o[2 * e + 1] = bfhi(oa[e]); }
#pragma unroll
            for (int e = 0; e < 8; ++e) ss += o[e] * o[e];
            ss = red16(ss);
            const float rs = rsqrtf(ss * (1.f / 128.f) + 1e-6f);
            float r8[8];
#pragma unroll
            for (int e = 0; e < 8; ++e) {
              const float gte = (e & 1) ? bfhi(ga[e >> 1]) : bflo(ga[e >> 1]);
              r8[e] = o[e] * rs * o_norm[c0 + e] * sigm(gte);
            }
            uint4 ov; ov.x = pack2(r8[0], r8[1]); ov.y = pack2(r8[2], r8[3]); ov.z = pack2(r8[4], r8[5]); ov.w = pack2(r8[6], r8[7]);
            *(uint4*)op = ov;
          }
        }
      }
      GSYNC();
      {
        int par6 = 0;
        const unsigned char* G8 = (const unsigned char*)(ws + R_G8);
        auto brA = [&](int m, int tm_, int& lda_) -> const bf16_t* {
          const bf16_t* Ao;
          if (m == 0) { Ao = Pm; lda_ = PLD; }
          else if (m == 1) { Ao = Pm + PC_HG + 1024; lda_ = PLD; }
          else if (m == 2) { Ao = Pm + PC_S5; lda_ = PLD; }
          else { Ao = RKV; lda_ = 1536; }
          return Ao + (size_t)tm_ * 128 * lda_;
        };
        for (int u = bid; u < 64 * 8; u += nb) {
          int tm, tn; TILE_MAP(u, 64, tm, tn);
          const bool has_next = (u + nb < 64 * 8);
          int tmn = tm, tnn = tn; if (has_next) TILE_MAP(u + nb, 64, tmn, tnn);
          f32x4 yacc[4][4];
          zero_acc<4>(yacc);
#pragma unroll 1
          for (int m = 0; m < 4; ++m) {
            f32x4 ao[4][4];
            zero_acc<4>(ao);
            int ldo; const bf16_t* Ao = brA(m, tm, ldo);
            const bf16_t* Bo = Wt_br + ((size_t)m * 1024 + tn * 128) * 512;
            const int mn = (m < 3) ? m + 1 : 0;
            const int tmx = (m < 3) ? tm : tmn, tnx = (m < 3) ? tn : tnn;
            int ldn; const bf16_t* An = brA(mn, tmx, ldn);
            const bf16_t* Bn = Wt_br + ((size_t)mn * 1024 + tnx * 128) * 512;
            gemm_acc<128>(Ao, ldo, Bo, 512, 512, smem, ao, An, ldn, Bn, 512, !(m == 0 && u == bid), par6);
            {
              EPI4_FOR(128) {
                const int row = tm * 128 + EPI_ROW, n = tn * 128 + EPI4_COL(128);
                const unsigned q = *(const unsigned*)(G8 + (size_t)row * 4096 + m * 1024 + n);
#pragma unroll
                for (int r = 0; r < 4; ++r) yacc[i][j][r] += ao[i][j][r] * ((float)((q >> (8 * r)) & 255u) * (1.f / 255.f));
              }
            }
          }
          {
            f32x4 (&acc)[4][4] = yacc;
            EPI4_FOR(128) {
              const int row = tm * 128 + EPI_ROW, n = tn * 128 + EPI4_COL(128);
              *(uint2*)(Ybr + (size_t)row * 1024 + n) = pack4(acc[i][j]);
            }
          }
        }
      }
      GSYNC();
      {
        int par = 0;
        for (int u = bid; u < 64 * 8; u += nb) {
          int tm, tn; TILE_MAP(u, 64, tm, tn);
          int tmn = tm, tnn = tn; if (u + nb < 64 * 8) TILE_MAP(u + nb, 64, tmn, tnn);
          f32x4 acc[4][4];
          zero_acc<4>(acc);
          gemm_acc<128>(Ybr + (size_t)tm * 128 * 1024, 1024, Wt_out + (size_t)tn * 128 * 1024, 1024, 1024, smem, acc,
                        Ybr + (size_t)tmn * 128 * 1024, 1024, Wt_out + (size_t)tnn * 128 * 1024, 1024, u != bid, par);
          EPI4_FOR(128) {
            const int row = half * TH + tm * 128 + EPI_ROW, n = tn * 128 + EPI4_COL(128);
            float4* xp = (float4*)(X + (size_t)row * 1024 + n);
            float4 xv = *xp; xv.x += acc[i][j][0]; xv.y += acc[i][j][1]; xv.z += acc[i][j][2]; xv.w += acc[i][j][3];
            *xp = xv;
          }
        }
      }
      GSYNC();
    }

    {
      transpose_all(p.in[42] + (size_t)l * 1024 * 1024, 1024, 1024, 1024, Wt_xq, bid, nb, smem);
      transpose_all(p.in[44] + (size_t)l * 1024 * 1024, 1024, 1024, 1024, Wt_xo, bid, nb, smem);
      transpose_all(p.in[46] + (size_t)l * 1024 * 5632, 5632, 1024, 5632, Wt_gu, bid, nb, smem);
      transpose_all(p.in[49] + (size_t)l * 2816 * 1024, 1024, 2816, 1024, Wt_down, bid, nb, smem);
      rmsnorm_rows(X, p.in[40] + l * 1024, Hb, nullptr, T_ALL, bid, nb);
    }
    GSYNC();
    {
      const float qs = 0.0625f * LOG2E;
      int par = 0;
      for (int u = bid; u < 128 * 8; u += nb) {
        int tm, tn; TILE_MAP(u, 128, tm, tn);
        int tmn = tm, tnn = tn; if (u + nb < 128 * 8) TILE_MAP(u + nb, 128, tmn, tnn);
        f32x4 acc[4][4];
        zero_acc<4>(acc);
        gemm_acc<128>(Hb + (size_t)tm * 128 * 1024, 1024, Wt_xq + (size_t)tn * 128 * 1024, 1024, 1024, smem, acc,
                      Hb + (size_t)tmn * 128 * 1024, 1024, Wt_xq + (size_t)tnn * 128 * 1024, 1024, u != bid, par);
        EPI4_FOR(128) {
          const int row = tm * 128 + EPI_ROW, n = tn * 128 + EPI4_COL(128);
          *(uint2*)(Qx + (size_t)row * 1024 + n) = pack4(acc[i][j] * qs);
        }
      }
    }
    GSYNC();
    {
      for (int u = bid; u < 1024; u += nb) {
        const int dvh = u & 1, hh = (u >> 1) & 3, qt = (u >> 3) & 31, b = u >> 8;
        attn_item<256, false>(Qx + (size_t)b * SEQ * 1024 + hh * 256, 1024, Kx + (size_t)(b * 4 + hh) * 65536, 256,
                              VxT + (size_t)(b * 4 + hh) * 65536 + (size_t)dvh * 128 * 256, 256, 4, qt * 128,
                              Ox + (size_t)b * SEQ * 1024 + hh * 256 + dvh * 128, 1024, smem);
      }
    }
    GSYNC();
    {
      int par = 0;
      for (int u = bid; u < 128 * 8; u += nb) {
        int tm, tn; TILE_MAP(u, 128, tm, tn);
        int tmn = tm, tnn = tn; if (u + nb < 128 * 8) TILE_MAP(u + nb, 128, tmn, tnn);
        f32x4 acc[4][4];
        zero_acc<4>(acc);
        gemm_acc<128>(Ox + (size_t)tm * 128 * 1024, 1024, Wt_xo + (size_t)tn * 128 * 1024, 1024, 1024, smem, acc,
                      Ox + (size_t)tmn * 128 * 1024, 1024, Wt_xo + (size_t)tnn * 128 * 1024, 1024, u != bid, par);
        EPI4_FOR(128) {
          const int row = tm * 128 + EPI_ROW, n = tn * 128 + EPI4_COL(128);
          float4* xp = (float4*)(X + (size_t)row * 1024 + n);
          float4 xv = *xp; xv.x += acc[i][j][0]; xv.y += acc[i][j][1]; xv.z += acc[i][j][2]; xv.w += acc[i][j][3];
          *xp = xv;
        }
      }
    }
    GSYNC();
    rmsnorm_rows(X, p.in[45] + l * 1024, Hb, nullptr, T_ALL, bid, nb);
    GSYNC();
    for (int half = 0; half < 2; ++half) {
      const bf16_t* Hh = Hb + (size_t)half * TH * 1024;
      int par13 = 0;
      for (int u = bid; u < 64 * 44; u += nb) {
        int tm, tn; TILE_MAP(u, 64, tm, tn);
        int tmn = tm, tnn = tn; if (u + nb < 64 * 44) TILE_MAP(u + nb, 64, tmn, tnn);
        f32x4 acc[4][4];
        zero_acc<4>(acc);
        gemm_acc<128>(Hh + (size_t)tm * 128 * 1024, 1024, Wt_gu + (size_t)tn * 128 * 1024, 1024, 1024, smem, acc,
                      Hh + (size_t)tmn * 128 * 1024, 1024, Wt_gu + (size_t)tnn * 128 * 1024, 1024, u != bid, par13);
        EPI4_FOR(128) {
          const int row = tm * 128 + EPI_ROW, n = tn * 128 + EPI4_COL(128);
          *(uint2*)(GU + (size_t)row * 5632 + n) = pack4(acc[i][j]);
        }
      }
      GSYNC();
      {
      PHASE_IDS
        const float* cw = p.in[47] + (size_t)l * 3 * D_FF;
        const float* cb = p.in[48] + (size_t)l * D_FF;
        for (int e = bid * 256 + tid; e < TH * 352; e += nb * 256) {
          const int tk = e / 352, c0 = (e % 352) * 8;
          const int s = tk & (SEQ - 1);
          const bf16_t* gp = GU + (size_t)tk * 5632 + c0;
          const uint4 g2 = *(const uint4*)gp;
          uint4 g1 = uint4{0, 0, 0, 0}, g0 = uint4{0, 0, 0, 0};
          if (s >= 1) g1 = *(const uint4*)(gp - 5632);
          if (s >= 2) g0 = *(const uint4*)(gp - 2 * 5632);
          const uint4 uu = *(const uint4*)(gp + D_FF);
          const unsigned a2[4] = {g2.x, g2.y, g2.z, g2.w}, a1[4] = {g1.x, g1.y, g1.z, g1.w}, a0[4] = {g0.x, g0.y, g0.z, g0.w};
          const unsigned au[4] = {uu.x, uu.y, uu.z, uu.w};
          float o[8];
#pragma unroll
          for (int q = 0; q < 8; ++q) {
            const bool hi = q & 1;
            const float x2 = hi ? bfhi(a2[q >> 1]) : bflo(a2[q >> 1]);
            const float x1 = hi ? bfhi(a1[q >> 1]) : bflo(a1[q >> 1]);
            const float x0 = hi ? bfhi(a0[q >> 1]) : bflo(a0[q >> 1]);
            const float up = hi ? bfhi(au[q >> 1]) : bflo(au[q >> 1]);
            const int c = c0 + q;
            const float gv = cw[c] * x0 + cw[D_FF + c] * x1 + cw[2 * D_FF + c] * x2 + cb[c];
            o[q] = gv * sigm(gv) * up;
          }
          uint4 ov; ov.x = pack2(o[0], o[1]); ov.y = pack2(o[2], o[3]); ov.z = pack2(o[4], o[5]); ov.w = pack2(o[6], o[7]);
          *(uint4*)(GU + (size_t)tk * 5632 + D_FF + c0) = ov;
        }
      }
      GSYNC();
      int par15 = 0;
      for (int u = bid; u < 64 * 8; u += nb) {
        int tm, tn; TILE_MAP(u, 64, tm, tn);
        int tmn = tm, tnn = tn; if (u + nb < 64 * 8) TILE_MAP(u + nb, 64, tmn, tnn);
        f32x4 acc[4][4];
        zero_acc<4>(acc);
        gemm_acc<128>(GU + (size_t)tm * 128 * 5632 + D_FF, 5632, Wt_down + (size_t)tn * 128 * 2816, 2816, 2816, smem, acc,
                      GU + (size_t)tmn * 128 * 5632 + D_FF, 5632, Wt_down + (size_t)tnn * 128 * 2816, 2816, u != bid, par15);
        EPI4_FOR(128) {
          const int row = half * TH + tm * 128 + EPI_ROW, n = tn * 128 + EPI4_COL(128);
          float4* xp = (float4*)(X + (size_t)row * 1024 + n);
          float4 xv = *xp; xv.x += acc[i][j][0]; xv.y += acc[i][j][1]; xv.z += acc[i][j][2]; xv.w += acc[i][j][3];
          *xp = xv;
        }
      }
      GSYNC();
    }
  }

  {
      PHASE_IDS
    const float* g = p.in[50];
    for (int r = bid * 4 + wave; r < T_ALL; r += nb * 4) {
      float4* xr = (float4*)(X + (size_t)r * 1024);
      float4 v[4]; float ss = 0.f;
#pragma unroll
      for (int i = 0; i < 4; ++i) { v[i] = xr[lane + 64 * i]; ss += v[i].x * v[i].x + v[i].y * v[i].y + v[i].z * v[i].z + v[i].w * v[i].w; }
      ss = wave_sum(ss);
      const float rs = rsqrtf(ss * (1.f / 1024.f) + 1e-6f);
#pragma unroll
      for (int i = 0; i < 4; ++i) {
        const float4 gg = ((const float4*)g)[lane + 64 * i];
        xr[lane + 64 * i] = float4{v[i].x * rs * gg.x, v[i].y * rs * gg.y, v[i].z * rs * gg.z, v[i].w * rs * gg.w};
      }
    }
  }
}

extern "C" void kernel_launch(void* const* d_in, const int* in_sizes, int n_in, void* d_out, int out_size, void* d_ws, size_t ws_size,
                              hipStream_t stream) {
  static int grid_blocks = 0;
  if (!grid_blocks) {
    int dev = 0, cus = 0, per_cu = 0;
    hipGetDevice(&dev);
    hipDeviceGetAttribute(&cus, hipDeviceAttributeMultiprocessorCount, dev);
    hipOccupancyMaxActiveBlocksPerMultiprocessor(&per_cu, mega_kernel, 256, 0);
    if (per_cu > 2) per_cu = 2;
    if (per_cu < 1) per_cu = 1;
    grid_blocks = cus * per_cu;
  }
  if (ws_size < WS_NEED) fprintf(stderr, "workspace too small: %zu < %zu\n", ws_size, (size_t)WS_NEED);
  Params p{};
  for (int i = 0; i < 51; ++i) p.in[i] = (const float*)d_in[i];
  p.pos = (const int*)d_in[2];
  p.out = (float*)d_out;
  p.ws = (char*)d_ws;
  hipMemsetAsync((char*)d_ws + OFF_BAR, 0, 16384, stream);
  void* args[] = {&p};
  hipError_t e = hipLaunchCooperativeKernel((void*)mega_kernel, dim3(grid_blocks), dim3(256), args, 0, stream);
  if (e != hipSuccess) fprintf(stderr, "cooperative launch failed: %s (grid %d)\n", hipGetErrorString(e), grid_blocks);
}
```

```cpp
#include <hip/hip_runtime.h>
#include <hip/hip_cooperative_groups.h>
#include <cstdio>
#include <cstdint>
namespace cg = cooperative_groups;

typedef unsigned short bf16_t;
using bf16x8 = __attribute__((ext_vector_type(8))) short;
using s16x4 = __attribute__((ext_vector_type(4))) short;
using f32x4 = __attribute__((ext_vector_type(4))) float;
using f32x16 = __attribute__((ext_vector_type(16))) float;
using u32x4 = __attribute__((ext_vector_type(4))) unsigned;
#define DI __device__ __forceinline__

constexpr int T_ALL = 16384, SEQ = 4096, DM = 1024, TH = 8192;
constexpr int P_IN = 8896, GATE_OFF = 4800;
constexpr int PLD = 4864;
constexpr int PC_HG = 512, PC_S5 = 2560, PC_RW = 3072;
constexpr int D_FF = 2816;

constexpr size_t al256(size_t x) { return (x + 255) & ~(size_t)255; }
constexpr size_t OFF_WIN = 0;
constexpr size_t OFF_WQ = OFF_WIN + al256((size_t)P_IN * 1024 * 2);
constexpr size_t OFF_WBR = OFF_WQ + al256((size_t)768 * 256 * 2);
constexpr size_t OFF_WOUT = OFF_WBR + al256((size_t)4 * 1024 * 512 * 2);
constexpr size_t OFF_WGLU = OFF_WOUT + al256((size_t)1024 * 1024 * 2);
constexpr size_t OFF_WWUP = OFF_WGLU + al256((size_t)512 * 512 * 2);
constexpr size_t OFF_WAUP = OFF_WWUP + al256((size_t)512 * 64 * 2);
constexpr size_t OFF_WGUP = OFF_WAUP + al256((size_t)512 * 64 * 2);
constexpr size_t OFF_WV = OFF_WGUP + al256((size_t)512 * 128 * 2);
constexpr size_t OFF_WXKV = OFF_WV + al256((size_t)512 * 1024 * 2);
constexpr size_t OFF_S5AB = OFF_WXKV + al256((size_t)2048 * 1024 * 2);
constexpr size_t OFF_S5BB = OFF_S5AB + al256((size_t)32 * 64 * 2 * 4);
constexpr size_t OFF_H = OFF_S5BB + al256((size_t)32 * 64 * 32 * 4);
constexpr size_t OFF_VFIRST = OFF_H + al256((size_t)T_ALL * 1024 * 2);
constexpr size_t OFF_KX = OFF_VFIRST + al256((size_t)T_ALL * 512 * 2);
constexpr size_t OFF_VXT = OFF_KX + al256((size_t)16 * 256 * 256 * 2);
constexpr size_t OFF_HM = OFF_VXT + al256((size_t)16 * 256 * 256 * 2);
constexpr size_t OFF_COS = OFF_HM + al256((size_t)1024 * 1024 * 2);
constexpr size_t OFF_SIN = OFF_COS + al256((size_t)TH * 32 * 4);
constexpr size_t OFF_BAR = OFF_SIN + al256((size_t)TH * 32 * 4);
constexpr size_t OFF_REG = OFF_BAR + 16384;
constexpr size_t R_P = OFF_REG;
constexpr size_t R_CQN = R_P + al256((size_t)TH * PLD * 2);
constexpr size_t R_QP = R_CQN + (size_t)TH * 256 * 2;
constexpr size_t R_KVLAT = R_QP + al256((size_t)TH * 768 * 2);
constexpr size_t R_VT = R_KVLAT + al256((size_t)TH * 192 * 2);
constexpr size_t R_RKV = R_VT + al256((size_t)2 * 128 * 4096 * 2);
constexpr size_t R_YRW = R_RKV + al256((size_t)TH * 1536 * 2);
constexpr size_t R_ZS5 = R_YRW + al256((size_t)TH * 512 * 2);
constexpr size_t R_ALORA = R_ZS5 + al256((size_t)TH * 512 * 2);
constexpr size_t R_G8 = R_ALORA;
constexpr size_t R_END1 = R_G8 + al256((size_t)TH * 4096);
static_assert(R_END1 <= ((size_t)256 << 20), "workspace plan exceeds the guaranteed 256 MiB");
constexpr size_t R_YBR = R_CQN;
constexpr size_t R_WXQ = OFF_REG;
constexpr size_t R_WXO = R_WXQ + al256((size_t)1024 * 1024 * 2);
constexpr size_t R_WGU = R_WXO + al256((size_t)1024 * 1024 * 2);
constexpr size_t R_WDOWN = R_WGU + al256((size_t)5632 * 1024 * 2);
constexpr size_t R_QX = R_WDOWN + al256((size_t)1024 * 2816 * 2);
constexpr size_t R_OX = R_QX + al256((size_t)T_ALL * 1024 * 2);
constexpr size_t R_GU = R_QX;
constexpr size_t R_END2 = R_GU + al256((size_t)TH * 5632 * 2);
constexpr size_t WS_NEED = (R_END1 > R_END2 ? R_END1 : R_END2);

constexpr int SMEM_BYTES = 73728;

struct Params {
  const float* in[51];
  const int* pos;
  float* out;
  char* ws;
};

DI bf16_t f2bf(float x) { return __builtin_bit_cast(unsigned short, (__bf16)x); }
DI float bf2f(bf16_t b) { return __uint_as_float(((unsigned)b) << 16); }
typedef __bf16 bf16v2_t __attribute__((ext_vector_type(2)));
typedef float f32v2_t __attribute__((ext_vector_type(2)));
DI unsigned pack2(float a, float b) { const f32v2_t v = {a, b}; return __builtin_bit_cast(unsigned, __builtin_convertvector(v, bf16v2_t)); }
DI float bflo(unsigned u) { return __uint_as_float(u << 16); }
DI float bfhi(unsigned u) { return __uint_as_float(u & 0xffff0000u); }
DI float sigm(float x) { return __builtin_amdgcn_rcpf(1.f + __expf(-x)); }
template <int CTRL> DI float dppf(float v) {
  return __builtin_bit_cast(float, __builtin_amdgcn_update_dpp(0, __builtin_bit_cast(int, v), CTRL, 0xf, 0xf, false));
}
DI float red8(float v) { v += dppf<0xB1>(v); v += dppf<0x4E>(v); v += dppf<0x141>(v); return v; }
DI float red16(float v) { v = red8(v); v += dppf<0x140>(v); return v; }
DI int TID() { int t = threadIdx.x; asm volatile("" : "+v"(t)); return t; }
#define PHASE_IDS const int tid = TID(); const int lane = tid & 63, wave = tid >> 6; (void)lane; (void)wave;
DI const bf16_t* uniform_ptr(const bf16_t* p) {
  const unsigned long long v = (unsigned long long)p;
  const unsigned lo = __builtin_amdgcn_readfirstlane((unsigned)v), hi = __builtin_amdgcn_readfirstlane((unsigned)(v >> 32));
  return (const bf16_t*)(((unsigned long long)hi << 32) | lo);
}
DI float wave_sum(float v) { for (int o = 32; o > 0; o >>= 1) v += __shfl_xor(v, o); return v; }


#define XB_TMO      128
#define XB_XCNT(j)  (256  + 64 * (j))
#define XB_XSUB(j)  (1280 + 64 * (j))
#define XB_XGEN(j)  (2304 + 64 * (j))
#define XB_TOP      3328
#define XB_TOPGEN   3392
#define XCD_BAR_WORDS 3456
#define XB_SPIN_CAP (1u << 22)
#define LAS __attribute__((address_space(3)))
DI unsigned xb_ld(unsigned* p) { return __hip_atomic_load(p, __ATOMIC_RELAXED, __HIP_MEMORY_SCOPE_AGENT); }
DI unsigned xb_add(unsigned* p, unsigned v) { return __hip_atomic_fetch_add(p, v, __ATOMIC_RELAXED, __HIP_MEMORY_SCOPE_AGENT); }
DI unsigned xb_xcc_id() { return (unsigned)__builtin_amdgcn_s_getreg((3 << 11) | 20) & 0xFu; }
#define XB_SPIN(cond, bar) do { unsigned _sp = 0; while (cond) { __builtin_amdgcn_s_sleep(1); \
    if ((++_sp & 255u) == 0u) { if (xb_ld(&(bar)[XB_TMO])) break; if (_sp > XB_SPIN_CAP) { atomicAdd(&(bar)[XB_TMO], 1u); break; } } } } while (0)
struct XcdBarrier { unsigned* bar; unsigned x; volatile LAS unsigned* st; };
DI XcdBarrier xcd_barrier_post(unsigned* bar, volatile LAS unsigned* st) {
  XcdBarrier b; b.bar = bar; b.x = xb_xcc_id(); b.st = st;
  if (threadIdx.x == 0) (void)xb_add(&bar[XB_XCNT(b.x)], 1u);
  return b;
}
DI void xcd_barrier_complete(unsigned* bar, unsigned x, unsigned& nloc, unsigned& nx) {
  const unsigned G = gridDim.x * gridDim.y * gridDim.z;
  unsigned sum, cnt, mine, sp = 0u;
  for (;;) {
    sum = 0u; cnt = 0u; mine = 0u;
#pragma unroll
    for (unsigned j = 0; j < 16; ++j) { const unsigned c = xb_ld(&bar[XB_XCNT(j)]); sum += c; cnt += (c > 0u) ? 1u : 0u; mine = (j == x) ? c : mine; }
    if (sum == G) break;
    __builtin_amdgcn_s_sleep(1);
    if ((++sp & 255u) == 0u) { if (xb_ld(&bar[XB_TMO])) break; if (sp > XB_SPIN_CAP) { atomicAdd(&bar[XB_TMO], 1u); break; } }
  }
  nloc = mine > 0u ? mine : 1u; nx = cnt > 0u ? cnt : 1u;
}
DI void xcd_barrier(const XcdBarrier& b) {
  asm volatile("s_waitcnt vmcnt(0)" ::: "memory");
  __syncthreads();
  if (threadIdx.x == 0) {
    unsigned* bar = b.bar;
    __builtin_amdgcn_s_waitcnt(0);
    unsigned nloc = b.st[0], nx = b.st[1];
    if (nloc == 0u) { xcd_barrier_complete(bar, b.x, nloc, nx); b.st[0] = nloc; b.st[1] = nx; }
    const unsigned old = xb_add(&bar[XB_XSUB(b.x)], 1u);
    const unsigned gen = old / nloc;
    if (old + 1u == (gen + 1u) * nloc) {
      __builtin_amdgcn_fence(__ATOMIC_RELEASE, "agent");
      asm volatile("s_waitcnt vmcnt(0)" ::: "memory");
      const unsigned og = xb_add(&bar[XB_TOP], 1u);
      const unsigned tg = og / nx;
      if (og + 1u == (tg + 1u) * nx) xb_add(&bar[XB_TOPGEN], 1u);
      else XB_SPIN(xb_ld(&bar[XB_TOPGEN]) == tg, bar);
      __builtin_amdgcn_fence(__ATOMIC_ACQUIRE, "agent");
      xb_add(&bar[XB_XGEN(b.x)], 1u);
      asm volatile("s_waitcnt vmcnt(0)" ::: "memory");
    } else {
      XB_SPIN(xb_ld(&bar[XB_XGEN(b.x)]) == gen, bar);
      __builtin_amdgcn_fence(__ATOMIC_ACQUIRE, "agent");
      asm volatile("s_waitcnt vmcnt(0)" ::: "memory");
    }
  }
  __syncthreads();
}

#define GLOAD16(dst, ptr) asm volatile("global_load_dwordx4 %0, %1, off" : "=v"(dst) : "v"(ptr))
template <int BN>
DI void gemm_acc(const bf16_t* __restrict__ A, int lda, const bf16_t* __restrict__ Bt, int ldb, int K, char* smem,
                 f32x4 (&acc)[4][BN / 32], const bf16_t* __restrict__ An, int ldan, const bf16_t* __restrict__ Bn, int ldbn,
                 bool pre, int& par) {
  constexpr int A_EL = 128 * 72, B_EL = BN * 72, BUF_EL = A_EL + B_EL;
  constexpr int NJ = BN / 32, BCH = BN / 32;
  bf16_t* sm = (bf16_t*)smem;
  const int tid = TID(), lane = tid & 63, wave = tid >> 6;
  const int wm = wave >> 1, wn = wave & 1, l16 = lane & 15, quad = lane >> 4;
  const int crow = tid >> 3, ccol = (tid & 7) * 8;
  u32x4 ra[4], rb[BCH];
  const bf16_t* Ap = A + (size_t)crow * lda + ccol;
  const bf16_t* Bp = Bt + (size_t)crow * ldb + ccol;
  const bf16_t* Apn = An + (size_t)crow * ldan + ccol;
  const bf16_t* Bpn = Bn + (size_t)crow * ldbn + ccol;
  const int nk = K >> 6;
#define GEMM_ISSUE(ap_, sa_, bp_, sb_)                                                            \
  {                                                                                               \
    _Pragma("unroll") for (int i = 0; i < 4; ++i) GLOAD16(ra[i], (ap_) + (size_t)(32 * i) * (sa_));      \
    _Pragma("unroll") for (int i = 0; i < BCH; ++i) GLOAD16(rb[i], (bp_) + (size_t)(32 * i) * (sb_));    \
  }
#define GEMM_LAND(buf_)                                                                           \
  {                                                                                               \
    if constexpr (BCH == 4)                                                                       \
      asm volatile("s_waitcnt vmcnt(0)" : "+v"(ra[0]), "+v"(ra[1]), "+v"(ra[2]), "+v"(ra[3]), "+v"(rb[0]), "+v"(rb[1]), "+v"(rb[2]), "+v"(rb[3])); \
    else                                                                                          \
      asm volatile("s_waitcnt vmcnt(0)" : "+v"(ra[0]), "+v"(ra[1]), "+v"(ra[2]), "+v"(ra[3]), "+v"(rb[0]), "+v"(rb[1])); \
    bf16_t* sa_ = sm + (buf_) * BUF_EL; bf16_t* sb_ = sa_ + A_EL;                                 \
    _Pragma("unroll") for (int i = 0; i < 4; ++i) *(u32x4*)(sa_ + (crow + 32 * i) * 72 + ccol) = ra[i];   \
    _Pragma("unroll") for (int i = 0; i < BCH; ++i) *(u32x4*)(sb_ + (crow + 32 * i) * 72 + ccol) = rb[i]; \
  }
  if (!pre) {
    GEMM_ISSUE(Ap, lda, Bp, ldb);
    GEMM_LAND(par);
    __syncthreads();
  }
  for (int kt = 0; kt < nk; ++kt) {
    {
      const bool inner = (kt + 1 < nk);
      const bf16_t* ap = inner ? Ap + ((kt + 1) << 6) : Apn;
      const bf16_t* bp = inner ? Bp + ((kt + 1) << 6) : Bpn;
      const int sa = inner ? lda : ldan, sb = inner ? ldb : ldbn;
      GEMM_ISSUE(ap, sa, bp, sb);
    }
    __builtin_amdgcn_sched_barrier(0);
    {
      const bf16_t* sa = sm + ((par + kt) & 1) * BUF_EL; const bf16_t* sb = sa + A_EL;
#pragma unroll
      for (int ks = 0; ks < 2; ++ks) {
        bf16x8 a[4], b[NJ];
#pragma unroll
        for (int i = 0; i < 4; ++i) a[i] = *(const bf16x8*)(sa + (wm * 64 + i * 16 + l16) * 72 + ks * 32 + quad * 8);
#pragma unroll
        for (int j = 0; j < NJ; ++j) b[j] = *(const bf16x8*)(sb + (wn * (BN / 2) + j * 16 + l16) * 72 + ks * 32 + quad * 8);
        __builtin_amdgcn_s_setprio(3);
#pragma unroll
        for (int i = 0; i < 4; ++i)
#pragma unroll
          for (int j = 0; j < NJ; ++j) acc[i][j] = __builtin_amdgcn_mfma_f32_16x16x32_bf16(b[j], a[i], acc[i][j], 0, 0, 0);
        __builtin_amdgcn_s_setprio(0);
      }
    }
    __builtin_amdgcn_sched_barrier(0);
    GEMM_LAND((par + kt + 1) & 1);
    __syncthreads();
  }
  par = (par + nk) & 1;
#undef GEMM_ISSUE
#undef GEMM_LAND
}
template <int BN>
DI void gemm_acc(const bf16_t* __restrict__ A, int lda, const bf16_t* __restrict__ Bt, int ldb, int K, char* smem,
                 f32x4 (&acc)[4][BN / 32]) {
  int par = 0;
  gemm_acc<BN>(A, lda, Bt, ldb, K, smem, acc, A, lda, Bt, ldb, false, par);
}
template <int NJ> DI void zero_acc(f32x4 (&acc)[4][NJ]) {
#pragma unroll
  for (int i = 0; i < 4; ++i)
#pragma unroll
    for (int j = 0; j < NJ; ++j) acc[i][j] = f32x4{0.f, 0.f, 0.f, 0.f};
}
#define EPI_FOR(BN_)                                                                         \
  const int _t = TID(); const int _lane = _t & 63, _wave = _t >> 6;                              \
  const int _wm = _wave >> 1, _wn = _wave & 1, _l16 = _lane & 15, _quad = _lane >> 4;        \
  _Pragma("unroll") for (int i = 0; i < 4; ++i)                                              \
  _Pragma("unroll") for (int j = 0; j < (BN_) / 32; ++j)                                     \
  _Pragma("unroll") for (int r = 0; r < 4; ++r)
#define EPI_ROW (_wm * 64 + i * 16 + _l16)
#define EPI_COL(BN_) (_wn * ((BN_) / 2) + j * 16 + _quad * 4 + r)
#define EPI4_FOR(BN_)                                                                        \
  const int _t = TID(); const int _lane = _t & 63, _wave = _t >> 6;                          \
  const int _wm = _wave >> 1, _wn = _wave & 1, _l16 = _lane & 15, _quad = _lane >> 4;        \
  _Pragma("unroll") for (int i = 0; i < 4; ++i)                                              \
  _Pragma("unroll") for (int j = 0; j < (BN_) / 32; ++j)
#define EPI4_COL(BN_) (_wn * ((BN_) / 2) + j * 16 + _quad * 4)
DI uint2 pack4(f32x4 v) { uint2 o; o.x = pack2(v[0], v[1]); o.y = pack2(v[2], v[3]); return o; }
DI f32x4 unpack4(uint2 u) { return f32x4{bflo(u.x), bfhi(u.x), bflo(u.y), bfhi(u.y)}; }

DI void transpose_tile(const float* __restrict__ W, int ldw, bf16_t* __restrict__ Wt, int ldt, int k0, int n0, char* smem) {
  float* sm = (float*)smem;
  const int tid = TID();
  __syncthreads();
#pragma unroll
  for (int i = 0; i < 4; ++i) {
    const int k = (tid >> 4) + 16 * i, n4 = (tid & 15) * 4;
    const float4 v = *(const float4*)(W + (size_t)(k0 + k) * ldw + n0 + n4);
    sm[k * 65 + n4 + 0] = v.x; sm[k * 65 + n4 + 1] = v.y; sm[k * 65 + n4 + 2] = v.z; sm[k * 65 + n4 + 3] = v.w;
  }
  __syncthreads();
  const int n = tid >> 2, ks = (tid & 3) * 16;
  unsigned u[8];
#pragma unroll
  for (int e = 0; e < 8; ++e) u[e] = pack2(sm[(ks + 2 * e) * 65 + n], sm[(ks + 2 * e + 1) * 65 + n]);
  uint4* dst = (uint4*)(Wt + (size_t)(n0 + n) * ldt + k0 + ks);
  dst[0] = uint4{u[0], u[1], u[2], u[3]};
  dst[1] = uint4{u[4], u[5], u[6], u[7]};
}
DI void transpose_all(const float* W, int ldw, int K, int N, bf16_t* Wt, int bid, int nb, char* smem) {
  const int tk = K >> 6, tn = N >> 6;
  for (int t = bid; t < tk * tn; t += nb) transpose_tile(W, ldw, Wt, K, (t % tk) * 64, (t / tk) * 64, smem);
}

DI void rmsnorm_rows(const float* __restrict__ x, const float* __restrict__ g, bf16_t* __restrict__ h, float* xcopy, int rows,
                     int bid, int nb) {
  const int lane = TID() & 63, wave = TID() >> 6;
  for (int r = bid * 4 + wave; r < rows; r += nb * 4) {
    const float4* xr = (const float4*)(x + (size_t)r * 1024);
    float4 v[4]; float ss = 0.f;
#pragma unroll
    for (int i = 0; i < 4; ++i) { v[i] = xr[lane + 64 * i]; ss += v[i].x * v[i].x + v[i].y * v[i].y + v[i].z * v[i].z + v[i].w * v[i].w; }
    ss = wave_sum(ss);
    const float rs = rsqrtf(ss * (1.f / 1024.f) + 1e-6f);
#pragma unroll
    for (int i = 0; i < 4; ++i) {
      const float4 gg = ((const float4*)g)[lane + 64 * i];
      uint2 o; o.x = pack2(v[i].x * rs * gg.x, v[i].y * rs * gg.y); o.y = pack2(v[i].z * rs * gg.z, v[i].w * rs * gg.w);
      *(uint2*)(h + (size_t)r * 1024 + (lane + 64 * i) * 4) = o;
      if (xcopy) ((float4*)(xcopy + (size_t)r * 1024))[lane + 64 * i] = v[i];
    }
  }
}

template <int DQK, bool CAUSAL>
DI void attn_item(const bf16_t* __restrict__ Q, int ldq, const bf16_t* __restrict__ Kp, int ldk, const bf16_t* __restrict__ VT, int ldvt,
                  int ntiles, int q0, bf16_t* __restrict__ out, int ldo, char* smem) {
  constexpr int KS = DQK + 8, NS = DQK / 16, KCH = DQK / 8;
  bf16_t* Ks = (bf16_t*)smem;
  bf16_t* Vs = Ks + 64 * KS;
  const int tid = TID(), lane = tid & 63, wave = tid >> 6, ql = lane & 31, hh = lane >> 5;
  const int qrow = q0 + wave * 32 + ql;
  bf16x8 bq[NS];
#pragma unroll
  for (int s = 0; s < NS; ++s) bq[s] = *(const bf16x8*)(Q + (size_t)qrow * ldq + s * 16 + hh * 8);
  f32x16 ot[4];
#pragma unroll
  for (int d = 0; d < 4; ++d)
#pragma unroll
    for (int i = 0; i < 16; ++i) ot[d][i] = 0.f;
  float mrun = -INFINITY, lrun = 0.f;
  for (int kt = 0; kt < ntiles; ++kt) {
    __syncthreads();
    for (int c = tid; c < 64 * KCH; c += 256) {
      const int row = c / KCH, cc = c % KCH;
      *(uint4*)(Ks + row * KS + cc * 8) = *(const uint4*)(Kp + (size_t)(kt * 64 + row) * ldk + cc * 8);
    }
#pragma unroll
    for (int c0 = 0; c0 < 4; ++c0) {
      const int c = tid + c0 * 256, row = c >> 3, cc = c & 7;
      *(uint4*)(Vs + row * 72 + cc * 8) = *(const uint4*)(VT + (size_t)row * ldvt + kt * 64 + cc * 8);
    }
    __syncthreads();
    f32x16 st[2];
#pragma unroll
    for (int kb = 0; kb < 2; ++kb) {
#pragma unroll
      for (int i = 0; i < 16; ++i) st[kb][i] = 0.f;
#pragma unroll
      for (int s = 0; s < NS; ++s) {
        const bf16x8 a = *(const bf16x8*)(Ks + (kb * 32 + ql) * KS + s * 16 + hh * 8);
        st[kb] = __builtin_amdgcn_mfma_f32_32x32x16_bf16(a, bq[s], st[kb], 0, 0, 0);
      }
    }
    float mx = -INFINITY;
#pragma unroll
    for (int kb = 0; kb < 2; ++kb)
#pragma unroll
      for (int i = 0; i < 16; ++i) {
        if (CAUSAL) {
          const int key = kt * 64 + kb * 32 + (i & 3) + 8 * (i >> 2) + 4 * hh;
          if (key > qrow) st[kb][i] = -INFINITY;
        }
        mx = fmaxf(mx, st[kb][i]);
      }
    mx = fmaxf(mx, __shfl_xor(mx, 32));
    const float mnew = fmaxf(mrun, mx);
    const float alpha = __builtin_amdgcn_exp2f(mrun - mnew);
    float ps = 0.f;
#pragma unroll
    for (int kb = 0; kb < 2; ++kb)
#pragma unroll
      for (int i = 0; i < 16; ++i) { const float pv = __builtin_amdgcn_exp2f(st[kb][i] - mnew); st[kb][i] = pv; ps += pv; }
    ps += __shfl_xor(ps, 32);
    lrun = lrun * alpha + ps;
    mrun = mnew;
#pragma unroll
    for (int d = 0; d < 4; ++d)
#pragma unroll
      for (int i = 0; i < 16; ++i) ot[d][i] *= alpha;
#pragma unroll
    for (int kb = 0; kb < 2; ++kb)
#pragma unroll
      for (int s2 = 0; s2 < 2; ++s2) {
        unsigned pk[4];
#pragma unroll
        for (int e = 0; e < 4; ++e) pk[e] = pack2(st[kb][8 * s2 + 2 * e], st[kb][8 * s2 + 2 * e + 1]);
        const bf16x8 pb = __builtin_bit_cast(bf16x8, uint4{pk[0], pk[1], pk[2], pk[3]});
#pragma unroll
        for (int d = 0; d < 4; ++d) {
          const bf16_t* vp = Vs + (d * 32 + ql) * 72 + kb * 32 + s2 * 16 + hh * 4;
          const s16x4 lo = *(const s16x4*)vp;
          const s16x4 hi = *(const s16x4*)(vp + 8);
          const bf16x8 av = __builtin_shufflevector(lo, hi, 0, 1, 2, 3, 4, 5, 6, 7);
          ot[d] = __builtin_amdgcn_mfma_f32_32x32x16_bf16(av, pb, ot[d], 0, 0, 0);
        }
      }
  }
  const float inv = 1.f / lrun;
#pragma unroll
  for (int d = 0; d < 4; ++d)
#pragma unroll
    for (int g4 = 0; g4 < 4; ++g4) {
      uint2 o; o.x = pack2(ot[d][4 * g4] * inv, ot[d][4 * g4 + 1] * inv); o.y = pack2(ot[d][4 * g4 + 2] * inv, ot[d][4 * g4 + 3] * inv);
      *(uint2*)(out + (size_t)qrow * ldo + d * 32 + 8 * g4 + 4 * hh) = o;
    }
}


template <int DQK, bool CAUSAL>
DI void attn_item_pf(const bf16_t* __restrict__ Q, int ldq, const bf16_t* Kp, int ldk, const bf16_t* VT, int ldvt,
                  int ntiles, int q0, bf16_t* __restrict__ out, int ldo, char* smem) {
  constexpr int KS = DQK + 8, NS = DQK / 16, KCH = DQK / 8;
  bf16_t* Ks = (bf16_t*)smem;
  bf16_t* Vs = Ks + 64 * KS;
  const int tid = TID(), lane = tid & 63, wave = tid >> 6, ql = lane & 31, hh = lane >> 5;
  const int qrow = q0 + wave * 32 + ql;
  bf16x8 bq[NS];
#pragma unroll
  for (int s = 0; s < NS; ++s) bq[s] = *(const bf16x8*)(Q + (size_t)qrow * ldq + s * 16 + hh * 8);
  f32x16 ot[4];
#pragma unroll
  for (int d = 0; d < 4; ++d)
#pragma unroll
    for (int i = 0; i < 16; ++i) ot[d][i] = 0.f;
  float mrun = -INFINITY, lrun = 0.f;
  Kp = uniform_ptr(Kp); VT = uniform_ptr(VT);
  constexpr int KR = KCH / 4;
  static_assert(KR == 6, "prefetch variant is written for DQK = 192");
  u32x4 kreg[KR], vreg[4];
  const unsigned kvoff = (unsigned)(((tid >> 2) * ldk + (tid & 3) * 8) * 2);
  const unsigned vvoff = (unsigned)(((tid >> 3) * ldvt + (tid & 7) * 8) * 2);
#define GLOADS(dst, voff, sbase) asm volatile("global_load_dwordx4 %0, %1, %2" : "=v"(dst) : "v"(voff), "s"(sbase))
#define ATT_ISSUE(kt_)                                                                                        \
  {                                                                                                           \
    _Pragma("unroll") for (int c0 = 0; c0 < KR; ++c0) GLOADS(kreg[c0], kvoff, Kp + (size_t)(kt_) * 64 * ldk + c0 * 32);   \
    _Pragma("unroll") for (int c0 = 0; c0 < 4; ++c0) GLOADS(vreg[c0], vvoff, VT + (size_t)(c0 * 32) * ldvt + (kt_) * 64); \
  }
#define ATT_LAND()                                                                                            \
  {                                                                                                           \
    asm volatile("s_waitcnt vmcnt(0)" : "+v"(kreg[0]), "+v"(kreg[1]), "+v"(kreg[2]), "+v"(kreg[3]), "+v"(kreg[4]), "+v"(kreg[5]), \
                 "+v"(vreg[0]), "+v"(vreg[1]), "+v"(vreg[2]), "+v"(vreg[3]));                                 \
    _Pragma("unroll") for (int c0 = 0; c0 < KR; ++c0) *(u32x4*)(Ks + (tid >> 2) * KS + ((tid & 3) + 4 * c0) * 8) = kreg[c0];   \
    _Pragma("unroll") for (int c0 = 0; c0 < 4; ++c0) *(u32x4*)(Vs + ((tid >> 3) + 32 * c0) * 72 + (tid & 7) * 8) = vreg[c0];   \
  }
  __syncthreads();
  ATT_ISSUE(0);
  ATT_LAND();
  __syncthreads();
  for (int kt = 0; kt < ntiles; ++kt) {
    {
      const int ktn = (kt + 1 < ntiles) ? kt + 1 : kt;
      ATT_ISSUE(ktn);
    }
    __builtin_amdgcn_sched_barrier(0);
    f32x16 st[2];
#pragma unroll
    for (int kb = 0; kb < 2; ++kb) {
#pragma unroll
      for (int i = 0; i < 16; ++i) st[kb][i] = 0.f;
#pragma unroll
      for (int s = 0; s < NS; ++s) {
        const bf16x8 a = *(const bf16x8*)(Ks + (kb * 32 + ql) * KS + s * 16 + hh * 8);
        st[kb] = __builtin_amdgcn_mfma_f32_32x32x16_bf16(a, bq[s], st[kb], 0, 0, 0);
      }
    }
    float mx = -INFINITY;
#pragma unroll
    for (int kb = 0; kb < 2; ++kb)
#pragma unroll
      for (int i = 0; i < 16; ++i) {
        if (CAUSAL) {
          const int key = kt * 64 + kb * 32 + (i & 3) + 8 * (i >> 2) + 4 * hh;
          if (key > qrow) st[kb][i] = -INFINITY;
        }
        mx = fmaxf(mx, st[kb][i]);
      }
    mx = fmaxf(mx, __shfl_xor(mx, 32));
    const float mnew = fmaxf(mrun, mx);
    const float alpha = __builtin_amdgcn_exp2f(mrun - mnew);
    float ps = 0.f;
#pragma unroll
    for (int kb = 0; kb < 2; ++kb)
#pragma unroll
      for (int i = 0; i < 16; ++i) { const float pv = __builtin_amdgcn_exp2f(st[kb][i] - mnew); st[kb][i] = pv; ps += pv; }
    ps += __shfl_xor(ps, 32);
    lrun = lrun * alpha + ps;
    mrun = mnew;
#pragma unroll
    for (int d = 0; d < 4; ++d)
#pragma unroll
      for (int i = 0; i < 16; ++i) ot[d][i] *= alpha;
#pragma unroll
    for (int kb = 0; kb < 2; ++kb)
#pragma unroll
      for (int s2 = 0; s2 < 2; ++s2) {
        unsigned pk[4];
#pragma unroll
        for (int e = 0; e < 4; ++e) pk[e] = pack2(st[kb][8 * s2 + 2 * e], st[kb][8 * s2 + 2 * e + 1]);
        const bf16x8 pb = __builtin_bit_cast(bf16x8, uint4{pk[0], pk[1], pk[2], pk[3]});
#pragma unroll
        for (int d = 0; d < 4; ++d) {
          const bf16_t* vp = Vs + (d * 32 + ql) * 72 + kb * 32 + s2 * 16 + hh * 4;
          const s16x4 lo = *(const s16x4*)vp;
          const s16x4 hi = *(const s16x4*)(vp + 8);
          const bf16x8 av = __builtin_shufflevector(lo, hi, 0, 1, 2, 3, 4, 5, 6, 7);
          ot[d] = __builtin_amdgcn_mfma_f32_32x32x16_bf16(av, pb, ot[d], 0, 0, 0);
        }
      }
    __builtin_amdgcn_sched_barrier(0);
    __syncthreads();
    ATT_LAND();
    __syncthreads();
  }
#undef ATT_ISSUE
#undef ATT_LAND
#undef GLOADS
  const float inv = 1.f / lrun;
#pragma unroll
  for (int d = 0; d < 4; ++d)
#pragma unroll
    for (int g4 = 0; g4 < 4; ++g4) {
      uint2 o; o.x = pack2(ot[d][4 * g4] * inv, ot[d][4 * g4 + 1] * inv); o.y = pack2(ot[d][4 * g4 + 2] * inv, ot[d][4 * g4 + 3] * inv);
      *(uint2*)(out + (size_t)qrow * ldo + d * 32 + 8 * g4 + 4 * hh) = o;
    }
}

DI void rwkv_scan_unit(const Params& p, int l, int u, char* smem) {
  const int tid = TID();
  const int bl = u >> 5, hd = (u >> 2) & 7, rg = u & 3;
  const int kq = tid & 15, g16 = tid >> 4;
  const bf16_t* RKV = (const bf16_t*)(p.ws + R_RKV) + (size_t)bl * SEQ * 1536;
  const bf16_t* Pm = (const bf16_t*)(p.ws + R_P) + (size_t)bl * SEQ * PLD;
  bf16_t* Y = (bf16_t*)(p.ws + R_YRW) + (size_t)bl * SEQ * 512;
  float* sm = (float*)smem;
  constexpr int BUFF = 5 * 1024 + 256 + 32;
  const int kc = hd * 64 + kq * 4;
  const float4 kk_w = *(const float4*)(p.in[27] + l * 512 + kc);
  const float4 ka_w = *(const float4*)(p.in[28] + l * 512 + kc);
  f32v2_t SA = {0.f, 0.f}, SB = {0.f, 0.f};
  uint2 g_r, g_k, g_w, g_a; bf16_t g_v;
  auto gload = [&](int c) {
    const int tok = c * 16 + g16;
    g_r = *(const uint2*)(RKV + (size_t)tok * 1536 + kc);
    g_k = *(const uint2*)(RKV + (size_t)tok * 1536 + 512 + kc);
    g_v = RKV[(size_t)tok * 1536 + 1024 + hd * 64 + rg * 16 + kq];
    g_w = *(const uint2*)(Pm + (size_t)tok * PLD + PC_RW + kc);
    g_a = *(const uint2*)(Pm + (size_t)tok * PLD + PC_RW + 512 + kc);
  };
  auto derive = [&](int buf) {
    float* b = sm + buf * BUFF;
    const float r[4] = {bflo(g_r.x), bfhi(g_r.x), bflo(g_r.y), bfhi(g_r.y)};
    const float k[4] = {bflo(g_k.x), bfhi(g_k.x), bflo(g_k.y), bfhi(g_k.y)};
    const float w[4] = {bflo(g_w.x), bfhi(g_w.x), bflo(g_w.y), bfhi(g_w.y)};
    const float a[4] = {bflo(g_a.x), bfhi(g_a.x), bflo(g_a.y), bfhi(g_a.y)};
    const float kkw[4] = {kk_w.x, kk_w.y, kk_w.z, kk_w.w};
    const float kaw[4] = {ka_w.x, ka_w.y, ka_w.z, ka_w.w};
    float kk[4], ss = 0.f;
#pragma unroll
    for (int e = 0; e < 4; ++e) { kk[e] = k[e] * kkw[e]; ss += kk[e] * kk[e]; }
    ss = red16(ss);
    const float rn = rsqrtf(ss + 1e-12f);
    float dwr[4], dw[4], dk[4], dn[4], db[4];
    float br = 0.f, khr = 0.f;
#pragma unroll
    for (int e = 0; e < 4; ++e) {
      dw[e] = __expf(w[e]);
      const float kn = kk[e] * rn;
      dn[e] = -kn; db[e] = kn * a[e];
      dk[e] = k[e] * (1.f + (a[e] - 1.f) * kaw[e]);
      dwr[e] = dw[e] * r[e];
      br += db[e] * r[e]; khr += dk[e] * r[e];
    }
    br = red16(br); khr = red16(khr);
#pragma unroll
    for (int e = 0; e < 4; ++e) dwr[e] += dn[e] * br;
    *(float4*)(b + 0 * 1024 + g16 * 64 + kq * 4) = float4{dwr[0], dwr[1], dwr[2], dwr[3]};
    *(float4*)(b + 1 * 1024 + g16 * 64 + kq * 4) = float4{dw[0], dw[1], dw[2], dw[3]};
    *(float4*)(b + 2 * 1024 + g16 * 64 + kq * 4) = float4{dk[0], dk[1], dk[2], dk[3]};
    *(float4*)(b + 3 * 1024 + g16 * 64 + kq * 4) = float4{dn[0], dn[1], dn[2], dn[3]};
    *(float4*)(b + 4 * 1024 + g16 * 64 + kq * 4) = float4{db[0], db[1], db[2], db[3]};
    b[5 * 1024 + g16 * 16 + kq] = bf2f(g_v);
    if (kq == 0) b[5 * 1024 + 256 + g16] = khr;
  };
  __syncthreads();
  gload(0); derive(0);
  __syncthreads();
  constexpr int NC = SEQ / 16;
  for (int c = 0; c < NC; ++c) {
    if (c + 1 < NC) gload(c + 1);
    const float* b = sm + (c & 1) * BUFF;
    float4 nk = *(const float4*)(b + 3 * 1024 + kq * 4);
    float4 w = *(const float4*)(b + 1 * 1024 + kq * 4);
    float4 bb = *(const float4*)(b + 4 * 1024 + kq * 4);
    float4 kh = *(const float4*)(b + 2 * 1024 + kq * 4);
    float4 wr = *(const float4*)(b + 0 * 1024 + kq * 4);
    float v = b[5 * 1024 + g16];
#pragma unroll
    for (int h = 0; h < 2; ++h) {
      float yp[8];
#pragma unroll
      for (int s = 0; s < 8; ++s) {
        const int t = h * 8 + s;
        float4 nk2, w2, bb2, kh2, wr2; float v2;
        if (t < 15) {
          nk2 = *(const float4*)(b + 3 * 1024 + (t + 1) * 64 + kq * 4);
          w2 = *(const float4*)(b + 1 * 1024 + (t + 1) * 64 + kq * 4);
          bb2 = *(const float4*)(b + 4 * 1024 + (t + 1) * 64 + kq * 4);
          kh2 = *(const float4*)(b + 2 * 1024 + (t + 1) * 64 + kq * 4);
          wr2 = *(const float4*)(b + 0 * 1024 + (t + 1) * 64 + kq * 4);
          v2 = b[5 * 1024 + (t + 1) * 16 + g16];
        }
        const f32v2_t nka = {nk.x, nk.y}, nkb = {nk.z, nk.w}, wra = {wr.x, wr.y}, wrb = {wr.z, wr.w};
        const f32v2_t wa = {w.x, w.y}, wb = {w.z, w.w}, ba = {bb.x, bb.y}, bbv = {bb.z, bb.w}, kha = {kh.x, kh.y}, khb = {kh.z, kh.w};
        const f32v2_t ps = SA * nka + SB * nkb;
        const f32v2_t py = SA * wra + SB * wrb;
        float sa = ps.x + ps.y;
        yp[s] = py.x + py.y;
        sa = red16(sa);
        const f32v2_t sa2 = {sa, sa}, vv2 = {v, v};
        SA = SA * wa + (sa2 * ba + vv2 * kha);
        SB = SB * wb + (sa2 * bbv + vv2 * khb);
        if (t < 15) { nk = nk2; w = w2; bb = bb2; kh = kh2; wr = wr2; v = v2; }
      }
      const bool b2 = (kq & 4) != 0, b1 = (kq & 2) != 0, b0 = (kq & 1) != 0;
#pragma unroll
      for (int i = 0; i < 8; ++i) yp[i] += dppf<0x128>(yp[i]);
      float q4[4];
#pragma unroll
      for (int i = 0; i < 4; ++i) { const float keep = b2 ? yp[i + 4] : yp[i], send = b2 ? yp[i] : yp[i + 4]; q4[i] = keep + dppf<0x141>(send); }
      float q2[2];
#pragma unroll
      for (int i = 0; i < 2; ++i) { const float keep = b1 ? q4[i + 2] : q4[i], send = b1 ? q4[i] : q4[i + 2]; q2[i] = keep + dppf<0x4E>(send); }
      const float keep = b0 ? q2[1] : q2[0], send = b0 ? q2[0] : q2[1];
      float yv = keep + dppf<0xB1>(send);
      const int tt = h * 8 + (kq & 7);
      yv += b[5 * 1024 + tt * 16 + g16] * b[5 * 1024 + 256 + tt];
      if ((kq >> 3) == h) Y[(size_t)(c * 16 + tt) * 512 + hd * 64 + rg * 16 + g16] = f2bf(yv);
    }
    if (c + 1 < NC) derive((c + 1) & 1);
    __syncthreads();
  }
}

DI void hgrn_scan_unit(const Params& p, int l, int u, char* smem) {
  const int tid = TID();
  const int bl = u >> 5, hd = (u >> 3) & 3, vg = u & 7;
  const int kq = tid & 15, g16 = tid >> 4;
  bf16_t* Pm = (bf16_t*)(p.ws + R_P) + (size_t)bl * SEQ * PLD;
  float* sm = (float*)smem;
  constexpr int BUFF = 2 * 2048 + 256 + 16;
  const int kc = hd * 128 + kq * 8;
  f32v2_t S2[4];
#pragma unroll
  for (int e = 0; e < 4; ++e) S2[e] = f32v2_t{0.f, 0.f};
  uint4 g_q, g_f; bf16_t g_v;
  const int vcol = PC_HG + 1024 + hd * 128 + vg * 16;
  auto gload = [&](int c) {
    const int tok = c * 16 + g16;
    g_q = *(const uint4*)(Pm + (size_t)tok * PLD + PC_HG + kc);
    g_f = *(const uint4*)(Pm + (size_t)tok * PLD + PC_HG + 512 + kc);
    g_v = Pm[(size_t)tok * PLD + vcol + kq];
  };
  auto derive = [&](int buf) {
    float* b = sm + buf * BUFF;
    const unsigned qu[4] = {g_q.x, g_q.y, g_q.z, g_q.w}, fu[4] = {g_f.x, g_f.y, g_f.z, g_f.w};
    float fq[8], f[8], cs = 0.f;
#pragma unroll
    for (int e = 0; e < 8; ++e) {
      const float q = (e & 1) ? bfhi(qu[e >> 1]) : bflo(qu[e >> 1]);
      const float kf = (e & 1) ? bfhi(fu[e >> 1]) : bflo(fu[e >> 1]);
      f[e] = 1.f - kf;
      fq[e] = f[e] * q;
      cs += kf * q;
    }
    cs = red16(cs);
    *(float4*)(b + g16 * 128 + kq * 8) = float4{fq[0], fq[1], fq[2], fq[3]};
    *(float4*)(b + g16 * 128 + kq * 8 + 4) = float4{fq[4], fq[5], fq[6], fq[7]};
    *(float4*)(b + 2048 + g16 * 128 + kq * 8) = float4{f[0], f[1], f[2], f[3]};
    *(float4*)(b + 2048 + g16 * 128 + kq * 8 + 4) = float4{f[4], f[5], f[6], f[7]};
    b[4096 + g16 * 16 + kq] = bf2f(g_v);
    if (kq == 0) b[4096 + 256 + g16] = cs;
  };
  __syncthreads();
  gload(0); derive(0);
  __syncthreads();
  constexpr int NC = SEQ / 16;
  for (int c = 0; c < NC; ++c) {
    if (c + 1 < NC) gload(c + 1);
    const float* b = sm + (c & 1) * BUFF;
    float4 q0 = *(const float4*)(b + kq * 8), q1 = *(const float4*)(b + kq * 8 + 4);
    float4 f0 = *(const float4*)(b + 2048 + kq * 8), f1 = *(const float4*)(b + 2048 + kq * 8 + 4);
    float v = b[4096 + g16];
#pragma unroll
    for (int h = 0; h < 2; ++h) {
      float yp[8];
#pragma unroll
      for (int s = 0; s < 8; ++s) {
        const int t = h * 8 + s;
        float4 q0n, q1n, f0n, f1n; float vn;
        if (t < 15) {
          q0n = *(const float4*)(b + (t + 1) * 128 + kq * 8); q1n = *(const float4*)(b + (t + 1) * 128 + kq * 8 + 4);
          f0n = *(const float4*)(b + 2048 + (t + 1) * 128 + kq * 8); f1n = *(const float4*)(b + 2048 + (t + 1) * 128 + kq * 8 + 4);
          vn = b[4096 + (t + 1) * 16 + g16];
        }
        const f32v2_t fq2[4] = {{q0.x, q0.y}, {q0.z, q0.w}, {q1.x, q1.y}, {q1.z, q1.w}};
        const f32v2_t ff2[4] = {{f0.x, f0.y}, {f0.z, f0.w}, {f1.x, f1.y}, {f1.z, f1.w}};
        const f32v2_t vv2 = {v, v};
        f32v2_t o2 = S2[0] * fq2[0];
#pragma unroll
        for (int e = 1; e < 4; ++e) o2 = S2[e] * fq2[e] + o2;
#pragma unroll
        for (int e = 0; e < 4; ++e) S2[e] = ff2[e] * (S2[e] - vv2) + vv2;
        yp[s] = o2.x + o2.y;
        if (t < 15) { q0 = q0n; q1 = q1n; f0 = f0n; f1 = f1n; v = vn; }
      }
      const bool b2 = (kq & 4) != 0, b1 = (kq & 2) != 0, b0 = (kq & 1) != 0;
#pragma unroll
      for (int i = 0; i < 8; ++i) yp[i] += dppf<0x128>(yp[i]);
      float q4[4];
#pragma unroll
      for (int i = 0; i < 4; ++i) { const float keep = b2 ? yp[i + 4] : yp[i], send = b2 ? yp[i] : yp[i + 4]; q4[i] = keep + dppf<0x141>(send); }
      float q2[2];
#pragma unroll
      for (int i = 0; i < 2; ++i) { const float keep = b1 ? q4[i + 2] : q4[i], send = b1 ? q4[i] : q4[i + 2]; q2[i] = keep + dppf<0x4E>(send); }
      const float keep = b0 ? q2[1] : q2[0], send = b0 ? q2[0] : q2[1];
      float ov = keep + dppf<0xB1>(send);
      const int tt = h * 8 + (kq & 7);
      ov += b[4096 + tt * 16 + g16] * b[4096 + 256 + tt];
      if ((kq >> 3) == h) Pm[(size_t)(c * 16 + tt) * PLD + vcol + g16] = f2bf(ov);
    }
    if (c + 1 < NC) derive((c + 1) & 1);
    __syncthreads();
  }
}

DI void s5_scan_unit(const Params& p, int l, int u, char* smem) {
  const int tid = TID(), lane = tid & 63, wave = tid >> 6;
  const int idx = u * 4 + wave, bl = idx >> 5, g = idx & 31;
  const bf16_t* Pm = (const bf16_t*)(p.ws + R_P) + (size_t)bl * SEQ * PLD + PC_S5 + g * 16;
  bf16_t* Z = (bf16_t*)(p.ws + R_ZS5) + (size_t)bl * SEQ * 512 + g * 16;
  constexpr int BUS = 132;
  float* buT = (float*)smem + wave * (16 * BUS);
  bf16_t* hist = (bf16_t*)(smem + 4 * 16 * BUS * 4) + wave * (16 * 136);
  const float2 ab = *(const float2*)((const float*)(p.ws + OFF_S5AB) + (g * 64 + lane) * 2);
  const int l16 = lane & 15, quad = lane >> 4;
  bf16x8 bbf[8];
  {
    const float* bbp = (const float*)(p.ws + OFF_S5BB);
#pragma unroll
    for (int jb = 0; jb < 8; ++jb) {
      const int col = jb * 16 + l16, nn = col & 63, im = col >> 6;
      unsigned pk[4] = {0u, 0u, 0u, 0u};
      if (quad < 2) {
        const float* src = bbp + (size_t)(g * 64 + nn) * 32 + im * 16 + quad * 8;
#pragma unroll
        for (int e = 0; e < 4; ++e) pk[e] = pack2(src[2 * e], src[2 * e + 1]);
      }
      bbf[jb] = __builtin_bit_cast(bf16x8, uint4{pk[0], pk[1], pk[2], pk[3]});
    }
  }
  bf16x8 cf[4];
  {
    const float* Cre = p.in[16] + (size_t)l * 32768 + (size_t)(g * 16 + l16) * 64;
    const float* Cim = p.in[17] + (size_t)l * 32768 + (size_t)(g * 16 + l16) * 64;
#pragma unroll
    for (int ks = 0; ks < 4; ++ks) {
      unsigned pk[4];
#pragma unroll
      for (int e = 0; e < 4; ++e) {
        const int k = ks * 32 + quad * 8 + 2 * e;
        const float v0 = (k < 64) ? Cre[k] : -Cim[k - 64];
        const float v1 = (k < 64) ? Cre[k + 1] : -Cim[k + 1 - 64];
        pk[e] = pack2(v0, v1);
      }
      cf[ks] = __builtin_bit_cast(bf16x8, uint4{pk[0], pk[1], pk[2], pk[3]});
    }
  }
  const float dcoef = p.in[18][l * 512 + g * 16 + l16];
  float xr = 0.f, xi = 0.f;
  uint4 ua = uint4{0u, 0u, 0u, 0u};
  bf16_t ue[4];
  auto gload = [&](int c) {
    if (quad < 2) ua = *(const uint4*)(Pm + (size_t)(c * 16 + l16) * PLD + quad * 8);
#pragma unroll
    for (int r = 0; r < 4; ++r) ue[r] = Pm[(size_t)(c * 16 + quad * 4 + r) * PLD + l16];
  };
  __syncthreads();
  gload(0);
  constexpr int NC = SEQ / 16;
  for (int c = 0; c < NC; ++c) {
    const bf16x8 afr = __builtin_bit_cast(bf16x8, ua);
    float us[4];
#pragma unroll
    for (int r = 0; r < 4; ++r) us[r] = bf2f(ue[r]);
#pragma unroll
    for (int jb = 0; jb < 8; ++jb) {
      f32x4 acc = {0.f, 0.f, 0.f, 0.f};
      acc = __builtin_amdgcn_mfma_f32_16x16x32_bf16(afr, bbf[jb], acc, 0, 0, 0);
#pragma unroll
      for (int r = 0; r < 4; ++r) buT[(quad * 4 + r) * BUS + jb * 16 + l16] = acc[r];
    }
    if (c + 1 < NC) gload(c + 1);
    __syncthreads();
#pragma unroll
    for (int t = 0; t < 16; ++t) {
      const float ur = buT[t * BUS + lane], ui = buT[t * BUS + 64 + lane];
      const float nr = ab.x * xr - ab.y * xi + ur;
      const float ni = ab.x * xi + ab.y * xr + ui;
      xr = nr; xi = ni;
      hist[t * 136 + lane] = f2bf(xr);
      hist[t * 136 + 64 + lane] = f2bf(xi);
    }
    __syncthreads();
    f32x4 acc = {0.f, 0.f, 0.f, 0.f};
#pragma unroll
    for (int ks = 0; ks < 4; ++ks) {
      const bf16x8 a = *(const bf16x8*)(hist + l16 * 136 + ks * 32 + quad * 8);
      acc = __builtin_amdgcn_mfma_f32_16x16x32_bf16(a, cf[ks], acc, 0, 0, 0);
    }
#pragma unroll
    for (int r = 0; r < 4; ++r) {
      const int t = quad * 4 + r;
      const float y = acc[r] + dcoef * us[r];
      const float z = y * sigm(1.5957691216057308f * (y + 0.044715f * y * y * y));
      Z[(size_t)(c * 16 + t) * 512 + l16] = f2bf(z);
    }
  }
}

#define GSYNC() xcd_barrier(xb)
#define TILE_MAP(u_, ntm_, tm_, tn_) { const int _x = (u_) & 7, _li = (u_) >> 3, _per = (ntm_) >> 3; tm_ = _x * _per + (_li % _per); tn_ = _li / _per; }
__global__ void __launch_bounds__(256, 2) mega_kernel(Params p) {
  cg::grid_group grid = cg::this_grid();
  __shared__ __attribute__((aligned(16))) char smem[SMEM_BYTES];
  __shared__ uint4 xb_words;
  const int bid = blockIdx.x, nb = gridDim.x;
  if (p.ws == nullptr) grid.sync();
  if (threadIdx.x == 0) xb_words = make_uint4(0u, 0u, 0u, 0u);
  __syncthreads();
  const XcdBarrier xb = xcd_barrier_post((unsigned*)(p.ws + OFF_BAR), (volatile LAS unsigned*)&xb_words);
  char* ws = p.ws;
  float* X = p.out;
  bf16_t* Wt_in = (bf16_t*)(ws + OFF_WIN);
  bf16_t* Wt_q = (bf16_t*)(ws + OFF_WQ);
  bf16_t* Wt_br = (bf16_t*)(ws + OFF_WBR);
  bf16_t* Wt_out = (bf16_t*)(ws + OFF_WOUT);
  bf16_t* Wt_glu = (bf16_t*)(ws + OFF_WGLU);
  bf16_t* Wt_wup = (bf16_t*)(ws + OFF_WWUP);
  bf16_t* Wt_aup = (bf16_t*)(ws + OFF_WAUP);
  bf16_t* Wt_gup = (bf16_t*)(ws + OFF_WGUP);
  bf16_t* Wt_v = (bf16_t*)(ws + OFF_WV);
  bf16_t* Wt_xkv = (bf16_t*)(ws + OFF_WXKV);
  bf16_t* Hb = (bf16_t*)(ws + OFF_H);
  bf16_t* Vfirst = (bf16_t*)(ws + OFF_VFIRST);
  bf16_t* Kx = (bf16_t*)(ws + OFF_KX);
  bf16_t* VxT = (bf16_t*)(ws + OFF_VXT);
  bf16_t* Hm = (bf16_t*)(ws + OFF_HM);
  float* CosT = (float*)(ws + OFF_COS);
  float* SinT = (float*)(ws + OFF_SIN);
  bf16_t* Pm = (bf16_t*)(ws + R_P);
  bf16_t* Cqn = (bf16_t*)(ws + R_CQN);
  bf16_t* Qp = (bf16_t*)(ws + R_QP);
  bf16_t* KVlat = (bf16_t*)(ws + R_KVLAT);
  bf16_t* VTm = (bf16_t*)(ws + R_VT);
  bf16_t* RKV = (bf16_t*)(ws + R_RKV);
  bf16_t* Alora = (bf16_t*)(ws + R_ALORA);
  bf16_t* Yrw = (bf16_t*)(ws + R_YRW);
  bf16_t* Zs5 = (bf16_t*)(ws + R_ZS5);
  bf16_t* Ybr = (bf16_t*)(ws + R_YBR);
  bf16_t* Wt_xq = (bf16_t*)(ws + R_WXQ);
  bf16_t* Wt_xo = (bf16_t*)(ws + R_WXO);
  bf16_t* Wt_gu = (bf16_t*)(ws + R_WGU);
  bf16_t* Wt_down = (bf16_t*)(ws + R_WDOWN);
  bf16_t* Qx = (bf16_t*)(ws + R_QX);
  bf16_t* Ox = (bf16_t*)(ws + R_OX);
  bf16_t* GU = (bf16_t*)(ws + R_GU);
  const float LOG2E = 1.4426950408889634f;

  for (int l = 0; l < 2; ++l) {
    {
      PHASE_IDS
      const float* w_in = p.in[4] + (size_t)l * 1024 * P_IN;
      transpose_all(w_in, P_IN, 1024, P_IN, Wt_in, bid, nb, smem);
      transpose_all(p.in[36] + (size_t)l * 512 * 1024, 1024, 512, 1024, Wt_br + (size_t)1 * 1024 * 512, bid, nb, smem);
      transpose_all(p.in[37] + (size_t)l * 512 * 1024, 1024, 512, 1024, Wt_br + (size_t)2 * 1024 * 512, bid, nb, smem);
      transpose_all(p.in[38] + (size_t)l * 512 * 1024, 1024, 512, 1024, Wt_br + (size_t)3 * 1024 * 512, bid, nb, smem);
      transpose_all(p.in[39] + (size_t)l * 1024 * 1024, 1024, 1024, 1024, Wt_out, bid, nb, smem);
      transpose_all(p.in[19] + (size_t)l * 512 * 512, 512, 512, 512, Wt_glu, bid, nb, smem);
      transpose_all(p.in[23] + (size_t)l * 64 * 512, 512, 64, 512, Wt_wup, bid, nb, smem);
      transpose_all(p.in[25] + (size_t)l * 64 * 512, 512, 64, 512, Wt_aup, bid, nb, smem);
      transpose_all(p.in[26] + (size_t)l * 128 * 512, 512, 128, 512, Wt_gup, bid, nb, smem);
      transpose_all(p.in[43] + (size_t)l * 1024 * 2048, 2048, 1024, 2048, Wt_xkv, bid, nb, smem);
      const int gtid = bid * 256 + tid, gsz = nb * 256;
      {
        const float* w_uq = p.in[6] + (size_t)l * 256 * 768;
        const float* w_ukv = p.in[8] + (size_t)l * 128 * 1024;
        for (int e = gtid; e < 768 * 256; e += gsz) {
          const int n = e >> 8, kq = e & 255, hh = n / 192, j = n % 192;
          float v;
          if (j >= 128) v = w_uq[kq * 768 + n];
          else {
            const float4* a = (const float4*)(w_uq + kq * 768 + hh * 192);
            const float4* b = (const float4*)(w_ukv + j * 1024 + hh * 256);
            float v0 = 0.f, v1 = 0.f, v2 = 0.f, v3 = 0.f;
#pragma unroll 8
            for (int d = 0; d < 32; ++d) { const float4 x = a[d], y = b[d]; v0 += x.x * y.x; v1 += x.y * y.y; v2 += x.z * y.z; v3 += x.w * y.w; }
            v = (v0 + v1) + (v2 + v3);
          }
          Wt_q[e] = f2bf(v);
        }
        const float* w_bm = p.in[35] + (size_t)l * 512 * 1024;
        for (int e = gtid; e < 1024 * 512; e += gsz) {
          const int n = e & 1023, kk = e >> 10, hh = kk >> 7, j = kk & 127;
          const float* a = w_ukv + j * 1024 + hh * 256 + 128;
          const float* bcol = w_bm + (size_t)(hh * 128) * 1024 + n;
          float v0 = 0.f, v1 = 0.f, v2 = 0.f, v3 = 0.f;
#pragma unroll 4
          for (int d = 0; d < 128; d += 4) {
            const float4 x = *(const float4*)(a + d);
            v0 += x.x * bcol[(size_t)(d + 0) * 1024]; v1 += x.y * bcol[(size_t)(d + 1) * 1024];
            v2 += x.z * bcol[(size_t)(d + 2) * 1024]; v3 += x.w * bcol[(size_t)(d + 3) * 1024];
          }
          Wt_br[(size_t)n * 512 + kk] = f2bf((v0 + v1) + (v2 + v3));
        }
        if (l == 1) {
          const float* vd = p.in[32];
          const float* vu = p.in[33];
          for (int e = gtid; e < 512 * 1024; e += gsz) {
            const int n = e & 511, kk = e >> 9;
            float v0 = 0.f, v1 = 0.f, v2 = 0.f, v3 = 0.f;
#pragma unroll
            for (int r = 0; r < 32; r += 4) {
              const float4 x = *(const float4*)(vd + kk * 32 + r);
              v0 += x.x * vu[(r + 0) * 512 + n]; v1 += x.y * vu[(r + 1) * 512 + n];
              v2 += x.z * vu[(r + 2) * 512 + n]; v3 += x.w * vu[(r + 3) * 512 + n];
            }
            Wt_v[(size_t)n * 1024 + kk] = f2bf((v0 + v1) + (v2 + v3));
          }
        }
      }
      {
        float* lbt = (float*)(ws + OFF_BAR) + 3456;
        for (int e = gtid; e < 512; e += gsz) {
          const float x0 = p.in[9][e], x1 = p.in[9][512 + e];
          lbt[e] = (l == 0) ? 0.f : 1.f / (1.f + expf(x0 - x1));
        }
      }
      {
        float* abp = (float*)(ws + OFF_S5AB);
        float* bbp = (float*)(ws + OFF_S5BB);
        for (int e = gtid; e < 2048; e += gsz) {
          const int g = e >> 6;
          const float are = fminf(p.in[11][l * 2048 + e], -1e-4f), aim = p.in[12][l * 2048 + e];
          const float dt = expf(p.in[13][l * 32 + g]);
          const float mag = expf(dt * are);
          const float abre = mag * cosf(dt * aim), abim = mag * sinf(dt * aim);
          const float den = are * are + aim * aim;
          const float zre = ((abre - 1.f) * are + abim * aim) / den;
          const float zim = (abim * are - (abre - 1.f) * aim) / den;
          abp[e * 2] = abre; abp[e * 2 + 1] = abim;
          const float* Br = p.in[14] + (size_t)l * 32768 + (size_t)e * 16;
          const float* Bi = p.in[15] + (size_t)l * 32768 + (size_t)e * 16;
          for (int c = 0; c < 16; ++c) {
            bbp[e * 32 + c] = zre * Br[c] - zim * Bi[c];
            bbp[e * 32 + 16 + c] = zre * Bi[c] + zim * Br[c];
          }
        }
      }
      if (l == 0) rmsnorm_rows(p.in[0], p.in[3], Hb, X, T_ALL, bid, nb);
      else rmsnorm_rows(X, p.in[3] + 1024, Hb, nullptr, T_ALL, bid, nb);
      rmsnorm_rows(p.in[1], p.in[41] + l * 1024, Hm, nullptr, 1024, bid, nb);
    }
    GSYNC();

    for (int half = 0; half < 2; ++half) {
      const bf16_t* Hh = Hb + (size_t)half * TH * 1024;
      {
        const int n1 = 64 * 38;
        const int n2 = (half == 0) ? 8 * 16 : 0;
        int par = 0;
        for (int u = bid; u < n1 + n2; u += nb) {
          f32x4 acc[4][4];
          zero_acc<4>(acc);
          if (u < n1) {
            int tm, tn; TILE_MAP(u, 64, tm, tn);
            int tmn = tm, tnn = tn; if (u + nb < n1) TILE_MAP(u + nb, 64, tmn, tnn);
            gemm_acc<128>(Hh + (size_t)tm * 128 * 1024, 1024, Wt_in + (size_t)tn * 128 * 1024, 1024, 1024, smem, acc,
                          Hh + (size_t)tmn * 128 * 1024, 1024, Wt_in + (size_t)tnn * 128 * 1024, 1024, u != bid, par);
            EPI4_FOR(128) {
              const int row = tm * 128 + EPI_ROW, n = tn * 128 + EPI4_COL(128);
              if (n < GATE_OFF) {
                const int pc = (n < 448) ? n : n + 64;
                f32x4 ov = acc[i][j];
                if (n >= 960 && n < 1472) {
                  const float4 lb4 = *(const float4*)((const float*)(ws + OFF_BAR) + 3456 + (n - 960));
                  ov[0] = (1.f - lb4.x) * sigm(-ov[0]); ov[1] = (1.f - lb4.y) * sigm(-ov[1]);
                  ov[2] = (1.f - lb4.z) * sigm(-ov[2]); ov[3] = (1.f - lb4.w) * sigm(-ov[3]);
                }
                *(uint2*)(Pm + (size_t)row * PLD + pc) = pack4(ov);
              }
            }
          } else {
            const int v = u - n1, tn = v % 16, tm = v / 16;
            gemm_acc<128>(Hm + (size_t)tm * 128 * 1024, 1024, Wt_xkv + (size_t)tn * 128 * 1024, 1024, 1024, smem, acc);
            EPI_FOR(128) {
              const int row = tm * 128 + EPI_ROW, n = tn * 128 + EPI_COL(128);
              const int b = row >> 8, m = row & 255, sel = n >> 10, hh = (n >> 8) & 3, d = n & 255;
              if (sel == 0) Kx[((size_t)(b * 4 + hh) * 256 + m) * 256 + d] = f2bf(acc[i][j][r]);
              else VxT[((size_t)(b * 4 + hh) * 256 + d) * 256 + m] = f2bf(acc[i][j][r]);
            }
          }
        }
      }
      GSYNC();
      {
      PHASE_IDS
        const float* qn = p.in[5] + l * 256;
        const float* kvn = p.in[7] + l * 128;
        const float* mu = p.in[21] + l * 1792;
        for (int tk = bid * 4 + wave; tk < TH; tk += nb * 4) {
          const int gtok = half * TH + tk, s = gtok & (SEQ - 1), bl = tk >> 12;
          const bf16_t* prow = Pm + (size_t)tk * PLD;
          {
            const uint2 cu = *(const uint2*)(prow + lane * 4);
            float f[4] = {bflo(cu.x), bfhi(cu.x), bflo(cu.y), bfhi(cu.y)};
            float ss = wave_sum(f[0] * f[0] + f[1] * f[1] + f[2] * f[2] + f[3] * f[3]);
            const float rs = rsqrtf(ss * (1.f / 256.f) + 1e-6f);
            const float4 g4 = *(const float4*)(qn + lane * 4);
            uint2 o; o.x = pack2(f[0] * rs * g4.x, f[1] * rs * g4.y); o.y = pack2(f[2] * rs * g4.z, f[3] * rs * g4.w);
            *(uint2*)(Cqn + (size_t)tk * 256 + lane * 4) = o;
          }
          {
            const unsigned cu = *(const unsigned*)(prow + 256 + lane * 2);
            const float f0 = bflo(cu), f1 = bfhi(cu);
            const float ss = wave_sum(f0 * f0 + f1 * f1);
            const float rs = rsqrtf(ss * (1.f / 128.f) + 1e-6f);
            const float v0 = f0 * rs * kvn[lane * 2], v1 = f1 * rs * kvn[lane * 2 + 1];
            const bf16_t b0 = f2bf(v0), b1 = f2bf(v1);
            *(unsigned*)(KVlat + (size_t)tk * 192 + lane * 2) = (unsigned)b0 | ((unsigned)b1 << 16);
            VTm[((size_t)bl * 128 + lane * 2) * SEQ + s] = b0;
            VTm[((size_t)bl * 128 + lane * 2 + 1) * SEQ + s] = b1;
          }
          if (lane < 32) {
            const float t1 = bf2f(prow[384 + lane]), t2 = bf2f(prow[384 + 32 + lane]);
            const float posf = (float)p.pos[gtok];
            const float invf = exp2f(-(float)lane * (13.287712379549449f / 32.f));
            const float ang = posf * invf;
            const float cs = cosf(ang), sn = sinf(ang);
            KVlat[(size_t)tk * 192 + 128 + lane] = f2bf(t1 * cs - t2 * sn);
            KVlat[(size_t)tk * 192 + 160 + lane] = f2bf(t1 * sn + t2 * cs);
            CosT[tk * 32 + lane] = cs; SinT[tk * 32 + lane] = sn;
          }
#pragma unroll
          for (int jj = 0; jj < 7; ++jj) {
            const int col = (jj * 64 + lane) * 4;
            const uint2 cu = *(const uint2*)(prow + PC_RW + col);
            uint2 pu = uint2{0u, 0u};
            if (s > 0) pu = *(const uint2*)(prow - PLD + PC_RW + col);
            const float4 m4 = *(const float4*)(mu + col);
            const float cv[4] = {bflo(cu.x), bfhi(cu.x), bflo(cu.y), bfhi(cu.y)};
            const float pv[4] = {bflo(pu.x), bfhi(pu.x), bflo(pu.y), bfhi(pu.y)};
            const float mm[4] = {m4.x, m4.y, m4.z, m4.w};
            float o[4];
#pragma unroll
            for (int e = 0; e < 4; ++e) o[e] = cv[e] + (pv[e] - cv[e]) * mm[e];
            if (col < 1536) {
              uint2 ov; ov.x = pack2(o[0], o[1]); ov.y = pack2(o[2], o[3]);
              *(uint2*)(RKV + (size_t)tk * 1536 + col) = ov;
              if (l == 0 && col >= 1024) *(uint2*)(Vfirst + (size_t)gtok * 512 + (col - 1024)) = ov;
            } else {
              int dc;
              if (col < 1600) { dc = col - 1536; for (int e = 0; e < 4; ++e) o[e] = tanhf(o[e]); }
              else if (col < 1664) { dc = 64 + col - 1600; }
              else { dc = 128 + col - 1664; for (int e = 0; e < 4; ++e) o[e] = sigm(o[e]); }
              uint2 ov; ov.x = pack2(o[0], o[1]); ov.y = pack2(o[2], o[3]);
              *(uint2*)(Alora + (size_t)tk * 256 + dc) = ov;
            }
          }
        }
      }
      GSYNC();
      {
      PHASE_IDS
        const int nq = 64 * 6, nl = 64 * 4;
        const int total = nq + 3 * nl + (l == 1 ? nl : 0);
        for (int u = bid; u < total; u += nb) {
          f32x4 acc[4][4];
          zero_acc<4>(acc);
          if (u < nq) {
            int tm, tn; TILE_MAP(u, 64, tm, tn);
            gemm_acc<128>(Cqn + (size_t)tm * 128 * 256, 256, Wt_q + (size_t)tn * 128 * 256, 256, 256, smem, acc);
            const float qs = 0.07216878364870322f * LOG2E;
            const int lane_ = tid & 63, wave_ = tid >> 6, wm_ = wave_ >> 1, wn_ = wave_ & 1, l16_ = lane_ & 15, quad_ = lane_ >> 4;
            const int gc = tn * 128 + wn_ * 64;
            const bool is_rope = (gc % 192) == 128;
#pragma unroll
            for (int i = 0; i < 4; ++i) {
              const int row = tm * 128 + wm_ * 64 + i * 16 + l16_;
              if (is_rope) {
#pragma unroll
                for (int j = 0; j < 2; ++j) {
                  const int fi = j * 16 + quad_ * 4;
                  const float4 cs = *(const float4*)(CosT + row * 32 + fi), sn = *(const float4*)(SinT + row * 32 + fi);
                  const float c4[4] = {cs.x, cs.y, cs.z, cs.w}, s4[4] = {sn.x, sn.y, sn.z, sn.w};
#pragma unroll
                  for (int r = 0; r < 4; ++r) {
                    const float t1 = acc[i][j][r], t2 = acc[i][j + 2][r];
                    acc[i][j][r] = t1 * c4[r] - t2 * s4[r]; acc[i][j + 2][r] = t1 * s4[r] + t2 * c4[r];
                  }
                }
              }
#pragma unroll
              for (int j = 0; j < 4; ++j) *(uint2*)(Qp + (size_t)row * 768 + gc + j * 16 + quad_ * 4) = pack4(acc[i][j] * qs);
            }
          } else if (u < nq + 3 * nl) {
            const int v = u - nq, which = v / nl, w2 = v % nl, tn = w2 % 4, tm = w2 / 4;
            if (which == 0) {
              gemm_acc<128>(Alora + (size_t)tm * 128 * 256, 256, Wt_wup + (size_t)tn * 128 * 64, 64, 64, smem, acc);
              const float* w0 = p.in[22] + l * 512;
              EPI4_FOR(128) {
                const int row = tm * 128 + EPI_ROW, n = tn * 128 + EPI4_COL(128);
                const float4 b4 = *(const float4*)(w0 + n);
                f32x4 wv = acc[i][j] + f32x4{b4.x, b4.y, b4.z, b4.w};
#pragma unroll
                for (int r = 0; r < 4; ++r) wv[r] = -0.6065306597126334f * sigm(wv[r]);
                *(uint2*)(Pm + (size_t)row * PLD + PC_RW + n) = pack4(wv);
              }
            } else if (which == 1) {
              gemm_acc<128>(Alora + (size_t)tm * 128 * 256 + 64, 256, Wt_aup + (size_t)tn * 128 * 64, 64, 64, smem, acc);
              const float* a0 = p.in[24] + l * 512;
              EPI4_FOR(128) {
                const int row = tm * 128 + EPI_ROW, n = tn * 128 + EPI4_COL(128);
                const float4 b4 = *(const float4*)(a0 + n);
                f32x4 v = acc[i][j] + f32x4{b4.x, b4.y, b4.z, b4.w};
#pragma unroll
                for (int r = 0; r < 4; ++r) v[r] = sigm(v[r]);
                *(uint2*)(Pm + (size_t)row * PLD + PC_RW + 512 + n) = pack4(v);
              }
            } else {
              gemm_acc<128>(Alora + (size_t)tm * 128 * 256 + 128, 256, Wt_gup + (size_t)tn * 128 * 128, 128, 128, smem, acc);
              EPI4_FOR(128) {
                const int row = tm * 128 + EPI_ROW, n = tn * 128 + EPI4_COL(128);
                *(uint2*)(Pm + (size_t)row * PLD + PC_RW + 1024 + n) = pack4(acc[i][j]);
              }
            }
          } else {
            const int w2 = u - nq - 3 * nl, tn = w2 % 4, tm = w2 / 4;
            gemm_acc<128>(Hh + (size_t)tm * 128 * 1024, 1024, Wt_v + (size_t)tn * 128 * 1024, 1024, 1024, smem, acc);
            const float* vb = p.in[34];
            EPI4_FOR(128) {
              const int row = tm * 128 + EPI_ROW, n = tn * 128 + EPI4_COL(128);
              const float4 b4 = *(const float4*)(vb + n);
              const f32x4 lg = acc[i][j] + f32x4{b4.x, b4.y, b4.z, b4.w};
              const f32x4 vc = unpack4(*(const uint2*)(RKV + (size_t)row * 1536 + 1024 + n));
              const f32x4 vf = unpack4(*(const uint2*)(Vfirst + ((size_t)half * TH + row) * 512 + n));
              f32x4 o;
#pragma unroll
              for (int r = 0; r < 4; ++r) o[r] = vc[r] + (vf[r] - vc[r]) * sigm(lg[r]);
              *(uint2*)(RKV + (size_t)row * 1536 + 1024 + n) = pack4(o);
            }
          }
        }
      }
      GSYNC();
      {
        int first, count, step;
        if (nb == 512) {
          if (bid < 144) { first = bid; count = 1; step = 0; }
          else {
            int pi = -1;
            if (bid < 256) pi = bid - 144; else if (bid >= 400 && bid < 416) pi = 112 + (bid - 400);
            first = 144 + pi; count = (pi >= 0) ? 2 : 0; step = 255 - 2 * pi;
          }
        } else { first = bid; step = nb; count = (bid < 400) ? (400 - bid + nb - 1) / nb : 0; }
#pragma unroll 1
        for (int q = 0; q < count; ++q) {
          const int u = first + q * step;
          if (u < 144) {
            __builtin_amdgcn_s_setprio(3);
            if (u < 64) rwkv_scan_unit(p, l, u, smem);
            else if (u < 128) hgrn_scan_unit(p, l, u - 64, smem);
            else s5_scan_unit(p, l, u - 128, smem);
            __builtin_amdgcn_s_setprio(0);
          } else {
            const int it = u - 144, qt = 31 - (it >> 3), bl = (it >> 2) & 1, hh = it & 3;
            attn_item_pf<192, true>(Qp + (size_t)bl * SEQ * 768 + hh * 192, 768, KVlat + (size_t)bl * SEQ * 192, 192,
                                    VTm + (size_t)bl * 128 * SEQ, SEQ, (qt * 128 + 128) / 64, qt * 128,
                                    Pm + (size_t)bl * SEQ * PLD + hh * 128, PLD, smem);
          }
        }
        {
          unsigned char* G8 = (unsigned char*)(ws + R_G8);
          int g0, gs;
          if (nb == 512) { g0 = (bid >= 416) ? bid - 416 : 2048; gs = 96; } else { g0 = bid; gs = nb; }
#pragma unroll 1
          for (int t = g0; t < 2048; t += gs) {
            const int tm = t >> 5, tn = t & 31;
            f32x4 acc[4][4];
            zero_acc<4>(acc);
            gemm_acc<128>(Hh + (size_t)tm * 128 * 1024, 1024, Wt_in + (size_t)(GATE_OFF + tn * 128) * 1024, 1024, 1024, smem, acc);
            EPI4_FOR(128) {
              const int row = tm * 128 + EPI_ROW, n = tn * 128 + EPI4_COL(128);
              unsigned q = 0;
#pragma unroll
              for (int r = 0; r < 4; ++r) q |= ((unsigned)(sigm(acc[i][j][r]) * 255.f + 0.5f)) << (8 * r);
              *(unsigned*)(G8 + (size_t)row * 4096 + n) = q;
            }
          }
        }
      }
      GSYNC();
      {
      PHASE_IDS
        const int nglu = 64 * 4;
        for (int u = bid; u < nglu; u += nb) {
          int tm, tn; TILE_MAP(u, 64, tm, tn);
          f32x4 acc[4][4];
          zero_acc<4>(acc);
          gemm_acc<128>(Zs5 + (size_t)tm * 128 * 512, 512, Wt_glu + (size_t)tn * 128 * 512, 512, 512, smem, acc);
          const float* bg = p.in[20] + l * 512;
          EPI4_FOR(128) {
            const int row = tm * 128 + EPI_ROW, n = tn * 128 + EPI4_COL(128);
            const f32x4 z = unpack4(*(const uint2*)(Zs5 + (size_t)row * 512 + n));
            const float4 b4 = *(const float4*)(bg + n);
            const f32x4 lg = acc[i][j] + f32x4{b4.x, b4.y, b4.z, b4.w};
            f32x4 o;
#pragma unroll
            for (int r = 0; r < 4; ++r) o[r] = z[r] * sigm(lg[r]);
            *(uint2*)(Pm + (size_t)row * PLD + PC_S5 + n) = pack4(o);
          }
        }
        const float* k_a = p.in[28] + l * 512;
        const float* r_k = p.in[29] + l * 512;
        const float* ln_w = p.in[30] + l * 512;
        const float* ln_b = p.in[31] + l * 512;
        const float* o_norm = p.in[10] + l * 512;
        for (int tk = bid * 4 + wave; tk < TH; tk += nb * 4) {
          const int c0 = lane * 8;
          {
            const uint4 yu = *(const uint4*)(Yrw + (size_t)tk * 512 + c0);
            const float y[8] = {bflo(yu.x), bfhi(yu.x), bflo(yu.y), bfhi(yu.y), bflo(yu.z), bfhi(yu.z), bflo(yu.w), bfhi(yu.w)};
            const uint4 ru = *(const uint4*)(RKV + (size_t)tk * 1536 + c0);
            const uint4 ku = *(const uint4*)(RKV + (size_t)tk * 1536 + 512 + c0);
            const uint4 vu = *(const uint4*)(RKV + (size_t)tk * 1536 + 1024 + c0);
            const uint4 au = *(const uint4*)(Pm + (size_t)tk * PLD + PC_RW + 512 + c0);
            const uint4 gu = *(const uint4*)(Pm + (size_t)tk * PLD + PC_RW + 1024 + c0);
            const unsigned ra[4] = {ru.x, ru.y, ru.z, ru.w}, ka[4] = {ku.x, ku.y, ku.z, ku.w}, va[4] = {vu.x, vu.y, vu.z, vu.w};
            const unsigned aa[4] = {au.x, au.y, au.z, au.w}, ga[4] = {gu.x, gu.y, gu.z, gu.w};
            float rr[8], kh[8], vv[8], gg[8];
            float sm1 = 0.f, bsum = 0.f;
#pragma unroll
            for (int e = 0; e < 8; ++e) {
              const unsigned sh = (e & 1);
              rr[e] = sh ? bfhi(ra[e >> 1]) : bflo(ra[e >> 1]);
              const float kx = sh ? bfhi(ka[e >> 1]) : bflo(ka[e >> 1]);
              vv[e] = sh ? bfhi(va[e >> 1]) : bflo(va[e >> 1]);
              const float a = sh ? bfhi(aa[e >> 1]) : bflo(aa[e >> 1]);
              gg[e] = sh ? bfhi(ga[e >> 1]) : bflo(ga[e >> 1]);
              kh[e] = kx * (1.f + (a - 1.f) * k_a[c0 + e]);
              sm1 += y[e];
              bsum += rr[e] * kh[e] * r_k[c0 + e];
            }
            sm1 = red8(sm1); bsum = red8(bsum);
            const float mean = sm1 * (1.f / 64.f);
            float vs = 0.f;
#pragma unroll
            for (int e = 0; e < 8; ++e) { const float d = y[e] - mean; vs += d * d; }
            vs = red8(vs);
            const float rstd = rsqrtf(vs * (1.f / 64.f) + 64e-5f);
            float o[8];
#pragma unroll
            for (int e = 0; e < 8; ++e) o[e] = (((y[e] - mean) * rstd) * ln_w[c0 + e] + ln_b[c0 + e] + bsum * vv[e]) * gg[e];
            uint4 ov; ov.x = pack2(o[0], o[1]); ov.y = pack2(o[2], o[3]); ov.z = pack2(o[4], o[5]); ov.w = pack2(o[6], o[7]);
            *(uint4*)(RKV + (size_t)tk * 1536 + c0) = ov;
          }
          {
            bf16_t* op = Pm + (size_t)tk * PLD + PC_HG + 1024 + c0;
            const uint4 ou = *(const uint4*)op;
            const uint4 gu = *(const uint4*)(Pm + (size_t)tk * PLD + PC_HG + 1536 + c0);
            const unsigned oa[4] = {ou.x, ou.y, ou.z, ou.w}, ga[4] = {gu.x, gu.y, gu.z, gu.w};
            float o[8], ss = 0.f;
#pragma unroll
            for (int e = 0; e < 4; ++e) { o[2 * e] = bflo(oa[e]); o[2 * e + 1] = bfhi(oa[e]); }
#pragma unroll
            for (int e = 0; e < 8; ++e) ss += o[e] * o[e];
            ss = red16(ss);
            const float rs = rsqrtf(ss * (1.f / 128.f) + 1e-6f);
            float r8[8];
#pragma unroll
            for (int e = 0; e < 8; ++e) {
              const float gte = (e & 1) ? bfhi(ga[e >> 1]) : bflo(ga[e >> 1]);
              r8[e] = o[e] * rs * o_norm[c0 + e] * sigm(gte);
            }
            uint4 ov; ov.x = pack2(r8[0], r8[1]); ov.y = pack2(r8[2], r8[3]); ov.z = pack2(r8[4], r8[5]); ov.w = pack2(r8[6], r8[7]);
            *(uint4*)op = ov;
          }
        }
      }
      GSYNC();
      {
        int par6 = 0;
        const unsigned char* G8 = (const unsigned char*)(ws + R_G8);
        auto brA = [&](int m, int tm_, int& lda_) -> const bf16_t* {
          const bf16_t* Ao;
          if (m == 0) { Ao = Pm; lda_ = PLD; }
          else if (m == 1) { Ao = Pm + PC_HG + 1024; lda_ = PLD; }
          else if (m == 2) { Ao = Pm + PC_S5; lda_ = PLD; }
          else { Ao = RKV; lda_ = 1536; }
          return Ao + (size_t)tm_ * 128 * lda_;
        };
        for (int u = bid; u < 64 * 8; u += nb) {
          int tm, tn; TILE_MAP(u, 64, tm, tn);
          const bool has_next = (u + nb < 64 * 8);
          int tmn = tm, tnn = tn; if (has_next) TILE_MAP(u + nb, 64, tmn, tnn);
          f32x4 yacc[4][4];
          zero_acc<4>(yacc);
#pragma unroll 1
          for (int m = 0; m < 4; ++m) {
            f32x4 ao[4][4];
            zero_acc<4>(ao);
            int ldo; const bf16_t* Ao = brA(m, tm, ldo);
            const bf16_t* Bo = Wt_br + ((size_t)m * 1024 + tn * 128) * 512;
            const int mn = (m < 3) ? m + 1 : 0;
            const int tmx = (m < 3) ? tm : tmn, tnx = (m < 3) ? tn : tnn;
            int ldn; const bf16_t* An = brA(mn, tmx, ldn);
            const bf16_t* Bn = Wt_br + ((size_t)mn * 1024 + tnx * 128) * 512;
            gemm_acc<128>(Ao, ldo, Bo, 512, 512, smem, ao, An, ldn, Bn, 512, !(m == 0 && u == bid), par6);
            {
              EPI4_FOR(128) {
                const int row = tm * 128 + EPI_ROW, n = tn * 128 + EPI4_COL(128);
                const unsigned q = *(const unsigned*)(G8 + (size_t)row * 4096 + m * 1024 + n);
#pragma unroll
                for (int r = 0; r < 4; ++r) yacc[i][j][r] += ao[i][j][r] * ((float)((q >> (8 * r)) & 255u) * (1.f / 255.f));
              }
            }
          }
          {
            f32x4 (&acc)[4][4] = yacc;
            EPI4_FOR(128) {
              const int row = tm * 128 + EPI_ROW, n = tn * 128 + EPI4_COL(128);
              *(uint2*)(Ybr + (size_t)row * 1024 + n) = pack4(acc[i][j]);
            }
          }
        }
      }
      GSYNC();
      {
        int par = 0;
        for (int u = bid; u < 64 * 8; u += nb) {
          int tm, tn; TILE_MAP(u, 64, tm, tn);
          int tmn = tm, tnn = tn; if (u + nb < 64 * 8) TILE_MAP(u + nb, 64, tmn, tnn);
          f32x4 acc[4][4];
          zero_acc<4>(acc);
          gemm_acc<128>(Ybr + (size_t)tm * 128 * 1024, 1024, Wt_out + (size_t)tn * 128 * 1024, 1024, 1024, smem, acc,
                        Ybr + (size_t)tmn * 128 * 1024, 1024, Wt_out + (size_t)tnn * 128 * 1024, 1024, u != bid, par);
          EPI4_FOR(128) {
            const int row = half * TH + tm * 128 + EPI_ROW, n = tn * 128 + EPI4_COL(128);
            float4* xp = (float4*)(X + (size_t)row * 1024 + n);
            float4 xv = *xp; xv.x += acc[i][j][0]; xv.y += acc[i][j][1]; xv.z += acc[i][j][2]; xv.w += acc[i][j][3];
            *xp = xv;
          }
        }
      }
      GSYNC();
    }

    {
      transpose_all(p.in[42] + (size_t)l * 1024 * 1024, 1024, 1024, 1024, Wt_xq, bid, nb, smem);
      transpose_all(p.in[44] + (size_t)l * 1024 * 1024, 1024, 1024, 1024, Wt_xo, bid, nb, smem);
      transpose_all(p.in[46] + (size_t)l * 1024 * 5632, 5632, 1024, 5632, Wt_gu, bid, nb, smem);
      transpose_all(p.in[49] + (size_t)l * 2816 * 1024, 1024, 2816, 1024, Wt_down, bid, nb, smem);
      rmsnorm_rows(X, p.in[40] + l * 1024, Hb, nullptr, T_ALL, bid, nb);
    }
    GSYNC();
    {
      const float qs = 0.0625f * LOG2E;
      int par = 0;
      for (int u = bid; u < 128 * 8; u += nb) {
        int tm, tn; TILE_MAP(u, 128, tm, tn);
        int tmn = tm, tnn = tn; if (u + nb < 128 * 8) TILE_MAP(u + nb, 128, tmn, tnn);
        f32x4 acc[4][4];
        zero_acc<4>(acc);
        gemm_acc<128>(Hb + (size_t)tm * 128 * 1024, 1024, Wt_xq + (size_t)tn * 128 * 1024, 1024, 1024, smem, acc,
                      Hb + (size_t)tmn * 128 * 1024, 1024, Wt_xq + (size_t)tnn * 128 * 1024, 1024, u != bid, par);
        EPI4_FOR(128) {
          const int row = tm * 128 + EPI_ROW, n = tn * 128 + EPI4_COL(128);
          *(uint2*)(Qx + (size_t)row * 1024 + n) = pack4(acc[i][j] * qs);
        }
      }
    }
    GSYNC();
    {
      for (int u = bid; u < 1024; u += nb) {
        const int dvh = u & 1, hh = (u >> 1) & 3, qt = (u >> 3) & 31, b = u >> 8;
        attn_item<256, false>(Qx + (size_t)b * SEQ * 1024 + hh * 256, 1024, Kx + (size_t)(b * 4 + hh) * 65536, 256,
                              VxT + (size_t)(b * 4 + hh) * 65536 + (size_t)dvh * 128 * 256, 256, 4, qt * 128,
                              Ox + (size_t)b * SEQ * 1024 + hh * 256 + dvh * 128, 1024, smem);
      }
    }
    GSYNC();
    {
      int par = 0;
      for (int u = bid; u < 128 * 8; u += nb) {
        int tm, tn; TILE_MAP(u, 128, tm, tn);
        int tmn = tm, tnn = tn; if (u + nb < 128 * 8) TILE_MAP(u + nb, 128, tmn, tnn);
        f32x4 acc[4][4];
        zero_acc<4>(acc);
        gemm_acc<128>(Ox + (size_t)tm * 128 * 1024, 1024, Wt_xo + (size_t)tn * 128 * 1024, 1024, 1024, smem, acc,
                      Ox + (size_t)tmn * 128 * 1024, 1024, Wt_xo + (size_t)tnn * 128 * 1024, 1024, u != bid, par);
        EPI4_FOR(128) {
          const int row = tm * 128 + EPI_ROW, n = tn * 128 + EPI4_COL(128);
          float4* xp = (float4*)(X + (size_t)row * 1024 + n);
          float4 xv = *xp; xv.x += acc[i][j][0]; xv.y += acc[i][j][1]; xv.z += acc[i][j][2]; xv.w += acc[i][j][3];
          *xp = xv;
        }
      }
    }
    GSYNC();
    rmsnorm_rows(X, p.in[45] + l * 1024, Hb, nullptr, T_ALL, bid, nb);
    GSYNC();
    for (int half = 0; half < 2; ++half) {
      const bf16_t* Hh = Hb + (size_t)half * TH * 1024;
      int par13 = 0;
      for (int u = bid; u < 64 * 44; u += nb) {
        int tm, tn; TILE_MAP(u, 64, tm, tn);
        int tmn = tm, tnn = tn; if (u + nb < 64 * 44) TILE_MAP(u + nb, 64, tmn, tnn);
        f32x4 acc[4][4];
        zero_acc<4>(acc);
        gemm_acc<128>(Hh + (size_t)tm * 128 * 1024, 1024, Wt_gu + (size_t)tn * 128 * 1024, 1024, 1024, smem, acc,
                      Hh + (size_t)tmn * 128 * 1024, 1024, Wt_gu + (size_t)tnn * 128 * 1024, 1024, u != bid, par13);
        EPI4_FOR(128) {
          const int row = tm * 128 + EPI_ROW, n = tn * 128 + EPI4_COL(128);
          *(uint2*)(GU + (size_t)row * 5632 + n) = pack4(acc[i][j]);
        }
      }
      GSYNC();
      {
      PHASE_IDS
        const float* cw = p.in[47] + (size_t)l * 3 * D_FF;
        const float* cb = p.in[48] + (size_t)l * D_FF;
        for (int e = bid * 256 + tid; e < TH * 352; e += nb * 256) {
          const int tk = e / 352, c0 = (e % 352) * 8;
          const int s = tk & (SEQ - 1);
          const bf16_t* gp = GU + (size_t)tk * 5632 + c0;
          const uint4 g2 = *(const uint4*)gp;
          uint4 g1 = uint4{0, 0, 0, 0}, g0 = uint4{0, 0, 0, 0};
          if (s >= 1) g1 = *(const uint4*)(gp - 5632);
          if (s >= 2) g0 = *(const uint4*)(gp - 2 * 5632);
          const uint4 uu = *(const uint4*)(gp + D_FF);
          const unsigned a2[4] = {g2.x, g2.y, g2.z, g2.w}, a1[4] = {g1.x, g1.y, g1.z, g1.w}, a0[4] = {g0.x, g0.y, g0.z, g0.w};
          const unsigned au[4] = {uu.x, uu.y, uu.z, uu.w};
          float o[8];
#pragma unroll
          for (int q = 0; q < 8; ++q) {
            const bool hi = q & 1;
            const float x2 = hi ? bfhi(a2[q >> 1]) : bflo(a2[q >> 1]);
            const float x1 = hi ? bfhi(a1[q >> 1]) : bflo(a1[q >> 1]);
            const float x0 = hi ? bfhi(a0[q >> 1]) : bflo(a0[q >> 1]);
            const float up = hi ? bfhi(au[q >> 1]) : bflo(au[q >> 1]);
            const int c = c0 + q;
            const float gv = cw[c] * x0 + cw[D_FF + c] * x1 + cw[2 * D_FF + c] * x2 + cb[c];
            o[q] = gv * sigm(gv) * up;
          }
          uint4 ov; ov.x = pack2(o[0], o[1]); ov.y = pack2(o[2], o[3]); ov.z = pack2(o[4], o[5]); ov.w = pack2(o[6], o[7]);
          *(uint4*)(GU + (size_t)tk * 5632 + D_FF + c0) = ov;
        }
      }
      GSYNC();
      int par15 = 0;
      for (int u = bid; u < 64 * 8; u += nb) {
        int tm, tn; TILE_MAP(u, 64, tm, tn);
        int tmn = tm, tnn = tn; if (u + nb < 64 * 8) TILE_MAP(u + nb, 64, tmn, tnn);
        f32x4 acc[4][4];
        zero_acc<4>(acc);
        gemm_acc<128>(GU + (size_t)tm * 128 * 5632 + D_FF, 5632, Wt_down + (size_t)tn * 128 * 2816, 2816, 2816, smem, acc,
                      GU + (size_t)tmn * 128 * 5632 + D_FF, 5632, Wt_down + (size_t)tnn * 128 * 2816, 2816, u != bid, par15);
        EPI4_FOR(128) {
          const int row = half * TH + tm * 128 + EPI_ROW, n = tn * 128 + EPI4_COL(128);
          float4* xp = (float4*)(X + (size_t)row * 1024 + n);
          float4 xv = *xp; xv.x += acc[i][j][0]; xv.y += acc[i][j][1]; xv.z += acc[i][j][2]; xv.w += acc[i][j][3];
          *xp = xv;
        }
      }
      GSYNC();
    }
  }

  {
      PHASE_IDS
    const float* g = p.in[50];
    for (int r = bid * 4 + wave; r < T_ALL; r += nb * 4) {
      float4* xr = (float4*)(X + (size_t)r * 1024);
      float4 v[4]; float ss = 0.f;
#pragma unroll
      for (int i = 0; i < 4; ++i) { v[i] = xr[lane + 64 * i]; ss += v[i].x * v[i].x + v[i].y * v[i].y + v[i].z * v[i].z + v[i].w * v[i].w; }
      ss = wave_sum(ss);
      const float rs = rsqrtf(ss * (1.f / 1024.f) + 1e-6f);
#pragma unroll
      for (int i = 0; i < 4; ++i) {
        const float4 gg = ((const float4*)g)[lane + 64 * i];
        xr[lane + 64 * i] = float4{v[i].x * rs * gg.x, v[i].y * rs * gg.y, v[i].z * rs * gg.z, v[i].w * rs * gg.w};
      }
    }
  }
}

extern "C" void kernel_launch(void* const* d_in, const int* in_sizes, int n_in, void* d_out, int out_size, void* d_ws, size_t ws_size,
                              hipStream_t stream) {
  static int grid_blocks = 0;
  if (!grid_blocks) {
    int dev = 0, cus = 0, per_cu = 0;
    hipGetDevice(&dev);
    hipDeviceGetAttribute(&cus, hipDeviceAttributeMultiprocessorCount, dev);
    hipOccupancyMaxActiveBlocksPerMultiprocessor(&per_cu, mega_kernel, 256, 0);
    if (per_cu > 2) per_cu = 2;
    if (per_cu < 1) per_cu = 1;
    grid_blocks = cus * per_cu;
  }
  if (ws_size < WS_NEED) fprintf(stderr, "workspace too small: %zu < %zu\n", ws_size, (size_t)WS_NEED);
  Params p{};
  for (int i = 0; i < 51; ++i) p.in[i] = (const float*)d_in[i];
  p.pos = (const int*)d_in[2];
  p.out = (float*)d_out;
  p.ws = (char*)d_ws;
  hipMemsetAsync((char*)d_ws + OFF_BAR, 0, 16384, stream);
  void* args[] = {&p};
  hipError_t e = hipLaunchCooperativeKernel((void*)mega_kernel, dim3(grid_blocks), dim3(256), args, 0, stream);
  if (e != hipSuccess) fprintf(stderr, "cooperative launch failed: %s (grid %d)\n", hipGetErrorString(e), grid_blocks);
}
```

```cpp
#include <hip/hip_runtime.h>
#include <hip/hip_cooperative_groups.h>
#include <cstdio>
#include <cstdint>
namespace cg = cooperative_groups;

typedef unsigned short bf16_t;
using bf16x8 = __attribute__((ext_vector_type(8))) short;
using s16x4 = __attribute__((ext_vector_type(4))) short;
using f32x4 = __attribute__((ext_vector_type(4))) float;
using f32x16 = __attribute__((ext_vector_type(16))) float;
using u32x4 = __attribute__((ext_vector_type(4))) unsigned;
#define DI __device__ __forceinline__

constexpr int T_ALL = 16384, SEQ = 4096, DM = 1024, TH = 8192;
constexpr int P_IN = 8896, GATE_OFF = 4800;
constexpr int PLD = 4864;
constexpr int PC_HG = 512, PC_S5 = 2560, PC_RW = 3072;
constexpr int D_FF = 2816;

constexpr size_t al256(size_t x) { return (x + 255) & ~(size_t)255; }
constexpr size_t OFF_WIN = 0;
constexpr size_t OFF_WQ = OFF_WIN + al256((size_t)P_IN * 1024 * 2);
constexpr size_t OFF_WBR = OFF_WQ + al256((size_t)768 * 256 * 2);
constexpr size_t OFF_WOUT = OFF_WBR + al256((size_t)4 * 1024 * 512 * 2);
constexpr size_t OFF_WGLU = OFF_WOUT + al256((size_t)1024 * 1024 * 2);
constexpr size_t OFF_WWUP = OFF_WGLU + al256((size_t)512 * 512 * 2);
constexpr size_t OFF_WAUP = OFF_WWUP + al256((size_t)512 * 64 * 2);
constexpr size_t OFF_WGUP = OFF_WAUP + al256((size_t)512 * 64 * 2);
constexpr size_t OFF_WV = OFF_WGUP + al256((size_t)512 * 128 * 2);
constexpr size_t OFF_WXKV = OFF_WV + al256((size_t)512 * 1024 * 2);
constexpr size_t OFF_S5AB = OFF_WXKV + al256((size_t)2048 * 1024 * 2);
constexpr size_t OFF_S5BB = OFF_S5AB + al256((size_t)32 * 64 * 2 * 4);
constexpr size_t OFF_H = OFF_S5BB + al256((size_t)32 * 64 * 32 * 4);
constexpr size_t OFF_VFIRST = OFF_H + al256((size_t)T_ALL * 1024 * 2);
constexpr size_t OFF_KX = OFF_VFIRST + al256((size_t)T_ALL * 512 * 2);
constexpr size_t OFF_VXT = OFF_KX + al256((size_t)16 * 256 * 256 * 2);
constexpr size_t OFF_HM = OFF_VXT + al256((size_t)16 * 256 * 256 * 2);
constexpr size_t OFF_COS = OFF_HM + al256((size_t)1024 * 1024 * 2);
constexpr size_t OFF_SIN = OFF_COS + al256((size_t)TH * 32 * 4);
constexpr size_t OFF_BAR = OFF_SIN + al256((size_t)TH * 32 * 4);
constexpr size_t OFF_REG = OFF_BAR + 16384;
constexpr size_t R_P = OFF_REG;
constexpr size_t R_CQN = R_P + al256((size_t)TH * PLD * 2);
constexpr size_t R_QP = R_CQN + (size_t)TH * 256 * 2;
constexpr size_t R_KVLAT = R_QP + al256((size_t)TH * 768 * 2);
constexpr size_t R_VT = R_KVLAT + al256((size_t)TH * 192 * 2);
constexpr size_t R_RKV = R_VT + al256((size_t)2 * 128 * 4096 * 2);
constexpr size_t R_YRW = R_RKV + al256((size_t)TH * 1536 * 2);
constexpr size_t R_ZS5 = R_YRW + al256((size_t)TH * 512 * 2);
constexpr size_t R_ALORA = R_ZS5 + al256((size_t)TH * 512 * 2);
constexpr size_t R_G8 = R_ALORA;
constexpr size_t R_END1 = R_G8 + al256((size_t)TH * 4096);
static_assert(R_END1 <= ((size_t)256 << 20), "workspace plan exceeds the guaranteed 256 MiB");
constexpr size_t R_YBR = R_CQN;
constexpr size_t R_WXQ = OFF_REG;
constexpr size_t R_WXO = R_WXQ + al256((size_t)1024 * 1024 * 2);
constexpr size_t R_WGU = R_WXO + al256((size_t)1024 * 1024 * 2);
constexpr size_t R_WDOWN = R_WGU + al256((size_t)5632 * 1024 * 2);
constexpr size_t R_QX = R_WDOWN + al256((size_t)1024 * 2816 * 2);
constexpr size_t R_OX = R_QX + al256((size_t)T_ALL * 1024 * 2);
constexpr size_t R_GU = R_QX;
constexpr size_t R_END2 = R_GU + al256((size_t)TH * 5632 * 2);
constexpr size_t WS_NEED = (R_END1 > R_END2 ? R_END1 : R_END2);

constexpr int SMEM_BYTES = 73728;

struct Params {
  const float* in[51];
  const int* pos;
  float* out;
  char* ws;
};

DI bf16_t f2bf(float x) { return __builtin_bit_cast(unsigned short, (__bf16)x); }
DI float bf2f(bf16_t b) { return __uint_as_float(((unsigned)b) << 16); }
typedef __bf16 bf16v2_t __attribute__((ext_vector_type(2)));
typedef float f32v2_t __attribute__((ext_vector_type(2)));
DI unsigned pack2(float a, float b) { const f32v2_t v = {a, b}; return __builtin_bit_cast(unsigned, __builtin_convertvector(v, bf16v2_t)); }
DI float bflo(unsigned u) { return __uint_as_float(u << 16); }
DI float bfhi(unsigned u) { return __uint_as_float(u & 0xffff0000u); }
DI float sigm(float x) { return __builtin_amdgcn_rcpf(1.f + __expf(-x)); }
template <int CTRL> DI float dppf(float v) {
  return __builtin_bit_cast(float, __builtin_amdgcn_update_dpp(0, __builtin_bit_cast(int, v), CTRL, 0xf, 0xf, false));
}
DI float red8(float v) { v += dppf<0xB1>(v); v += dppf<0x4E>(v); v += dppf<0x141>(v); return v; }
DI float red16(float v) { v = red8(v); v += dppf<0x140>(v); return v; }
DI int TID() { int t = threadIdx.x; asm volatile("" : "+v"(t)); return t; }
#define PHASE_IDS const int tid = TID(); const int lane = tid & 63, wave = tid >> 6; (void)lane; (void)wave;
DI const bf16_t* uniform_ptr(const bf16_t* p) {
  const unsigned long long v = (unsigned long long)p;
  const unsigned lo = __builtin_amdgcn_readfirstlane((unsigned)v), hi = __builtin_amdgcn_readfirstlane((unsigned)(v >> 32));
  return (const bf16_t*)(((unsigned long long)hi << 32) | lo);
}
DI float wave_sum(float v) { for (int o = 32; o > 0; o >>= 1) v += __shfl_xor(v, o); return v; }


#define XB_TMO      128
#define XB_XCNT(j)  (256  + 64 * (j))
#define XB_XSUB(j)  (1280 + 64 * (j))
#define XB_XGEN(j)  (2304 + 64 * (j))
#define XB_TOP      3328
#define XB_TOPGEN   3392
#define XCD_BAR_WORDS 3456
#define XB_SPIN_CAP (1u << 22)
#define LAS __attribute__((address_space(3)))
DI unsigned xb_ld(unsigned* p) { return __hip_atomic_load(p, __ATOMIC_RELAXED, __HIP_MEMORY_SCOPE_AGENT); }
DI unsigned xb_add(unsigned* p, unsigned v) { return __hip_atomic_fetch_add(p, v, __ATOMIC_RELAXED, __HIP_MEMORY_SCOPE_AGENT); }
DI unsigned xb_xcc_id() { return (unsigned)__builtin_amdgcn_s_getreg((3 << 11) | 20) & 0xFu; }
#define XB_SPIN(cond, bar) do { unsigned _sp = 0; while (cond) { __builtin_amdgcn_s_sleep(1); \
    if ((++_sp & 255u) == 0u) { if (xb_ld(&(bar)[XB_TMO])) break; if (_sp > XB_SPIN_CAP) { atomicAdd(&(bar)[XB_TMO], 1u); break; } } } } while (0)
struct XcdBarrier { unsigned* bar; unsigned x; volatile LAS unsigned* st; };
DI XcdBarrier xcd_barrier_post(unsigned* bar, volatile LAS unsigned* st) {
  XcdBarrier b; b.bar = bar; b.x = xb_xcc_id(); b.st = st;
  if (threadIdx.x == 0) (void)xb_add(&bar[XB_XCNT(b.x)], 1u);
  return b;
}
DI void xcd_barrier_complete(unsigned* bar, unsigned x, unsigned& nloc, unsigned& nx) {
  const unsigned G = gridDim.x * gridDim.y * gridDim.z;
  unsigned sum, cnt, mine, sp = 0u;
  for (;;) {
    sum = 0u; cnt = 0u; mine = 0u;
#pragma unroll
    for (unsigned j = 0; j < 16; ++j) { const unsigned c = xb_ld(&bar[XB_XCNT(j)]); sum += c; cnt += (c > 0u) ? 1u : 0u; mine = (j == x) ? c : mine; }
    if (sum == G) break;
    __builtin_amdgcn_s_sleep(1);
    if ((++sp & 255u) == 0u) { if (xb_ld(&bar[XB_TMO])) break; if (sp > XB_SPIN_CAP) { atomicAdd(&bar[XB_TMO], 1u); break; } }
  }
  nloc = mine > 0u ? mine : 1u; nx = cnt > 0u ? cnt : 1u;
}
DI void xcd_barrier(const XcdBarrier& b) {
  asm volatile("s_waitcnt vmcnt(0)" ::: "memory");
  __syncthreads();
  if (threadIdx.x == 0) {
    unsigned* bar = b.bar;
    __builtin_amdgcn_s_waitcnt(0);
    unsigned nloc = b.st[0], nx = b.st[1];
    if (nloc == 0u) { xcd_barrier_complete(bar, b.x, nloc, nx); b.st[0] = nloc; b.st[1] = nx; }
    const unsigned old = xb_add(&bar[XB_XSUB(b.x)], 1u);
    const unsigned gen = old / nloc;
    if (old + 1u == (gen + 1u) * nloc) {
      __builtin_amdgcn_fence(__ATOMIC_RELEASE, "agent");
      asm volatile("s_waitcnt vmcnt(0)" ::: "memory");
      const unsigned og = xb_add(&bar[XB_TOP], 1u);
      const unsigned tg = og / nx;
      if (og + 1u == (tg + 1u) * nx) xb_add(&bar[XB_TOPGEN], 1u);
      else XB_SPIN(xb_ld(&bar[XB_TOPGEN]) == tg, bar);
      __builtin_amdgcn_fence(__ATOMIC_ACQUIRE, "agent");
      xb_add(&bar[XB_XGEN(b.x)], 1u);
      asm volatile("s_waitcnt vmcnt(0)" ::: "memory");
    } else {
      XB_SPIN(xb_ld(&bar[XB_XGEN(b.x)]) == gen, bar);
      __builtin_amdgcn_fence(__ATOMIC_ACQUIRE, "agent");
      asm volatile("s_waitcnt vmcnt(0)" ::: "memory");
    }
  }
  __syncthreads();
}

#define GLOAD16(dst, ptr) asm volatile("global_load_dwordx4 %0, %1, off" : "=v"(dst) : "v"(ptr))
template <int BN>
DI void gemm_acc(const bf16_t* __restrict__ A, int lda, const bf16_t* __restrict__ Bt, int ldb, int K, char* smem,
                 f32x4 (&acc)[4][BN / 32], const bf16_t* __restrict__ An, int ldan, const bf16_t* __restrict__ Bn, int ldbn,
                 bool pre, int& par) {
  constexpr int A_EL = 128 * 72, B_EL = BN * 72, BUF_EL = A_EL + B_EL;
  constexpr int NJ = BN / 32, BCH = BN / 32;
  bf16_t* sm = (bf16_t*)smem;
  const int tid = TID(), lane = tid & 63, wave = tid >> 6;
  const int wm = wave >> 1, wn = wave & 1, l16 = lane & 15, quad = lane >> 4;
  const int crow = tid >> 3, ccol = (tid & 7) * 8;
  u32x4 ra[4], rb[BCH];
  const bf16_t* Ap = A + (size_t)crow * lda + ccol;
  const bf16_t* Bp = Bt + (size_t)crow * ldb + ccol;
  const bf16_t* Apn = An + (size_t)crow * ldan + ccol;
  const bf16_t* Bpn = Bn + (size_t)crow * ldbn + ccol;
  const int nk = K >> 6;
#define GEMM_ISSUE(ap_, sa_, bp_, sb_)                                                            \
  {                                                                                               \
    _Pragma("unroll") for (int i = 0; i < 4; ++i) GLOAD16(ra[i], (ap_) + (size_t)(32 * i) * (sa_));      \
    _Pragma("unroll") for (int i = 0; i < BCH; ++i) GLOAD16(rb[i], (bp_) + (size_t)(32 * i) * (sb_));    \
  }
#define GEMM_LAND(buf_)                                                                           \
  {                                                                                               \
    if constexpr (BCH == 4)                                                                       \
      asm volatile("s_waitcnt vmcnt(0)" : "+v"(ra[0]), "+v"(ra[1]), "+v"(ra[2]), "+v"(ra[3]), "+v"(rb[0]), "+v"(rb[1]), "+v"(rb[2]), "+v"(rb[3])); \
    else                                                                                          \
      asm volatile("s_waitcnt vmcnt(0)" : "+v"(ra[0]), "+v"(ra[1]), "+v"(ra[2]), "+v"(ra[3]), "+v"(rb[0]), "+v"(rb[1])); \
    bf16_t* sa_ = sm + (buf_) * BUF_EL; bf16_t* sb_ = sa_ + A_EL;                                 \
    _Pragma("unroll") for (int i = 0; i < 4; ++i) *(u32x4*)(sa_ + (crow + 32 * i) * 72 + ccol) = ra[i];   \
    _Pragma("unroll") for (int i = 0; i < BCH; ++i) *(u32x4*)(sb_ + (crow + 32 * i) * 72 + ccol) = rb[i]; \
  }
  if (!pre) {
    GEMM_ISSUE(Ap, lda, Bp, ldb);
    GEMM_LAND(par);
    __syncthreads();
  }
  for (int kt = 0; kt < nk; ++kt) {
    {
      const bool inner = (kt + 1 < nk);
      const bf16_t* ap = inner ? Ap + ((kt + 1) << 6) : Apn;
      const bf16_t* bp = inner ? Bp + ((kt + 1) << 6) : Bpn;
      const int sa = inner ? lda : ldan, sb = inner ? ldb : ldbn;
      GEMM_ISSUE(ap, sa, bp, sb);
    }
    __builtin_amdgcn_sched_barrier(0);
    {
      const bf16_t* sa = sm + ((par + kt) & 1) * BUF_EL; const bf16_t* sb = sa + A_EL;
      __builtin_amdgcn_s_setprio(2);
#pragma unroll
      for (int ks = 0; ks < 2; ++ks) {
        bf16x8 a[4], b[NJ];
#pragma unroll
        for (int i = 0; i < 4; ++i) a[i] = *(const bf16x8*)(sa + (wm * 64 + i * 16 + l16) * 72 + ks * 32 + quad * 8);
#pragma unroll
        for (int j = 0; j < NJ; ++j) b[j] = *(const bf16x8*)(sb + (wn * (BN / 2) + j * 16 + l16) * 72 + ks * 32 + quad * 8);
        __builtin_amdgcn_s_setprio(3);
#pragma unroll
        for (int i = 0; i < 4; ++i)
#pragma unroll
          for (int j = 0; j < NJ; ++j) acc[i][j] = __builtin_amdgcn_mfma_f32_16x16x32_bf16(b[j], a[i], acc[i][j], 0, 0, 0);
        __builtin_amdgcn_s_setprio(2);
      }
      __builtin_amdgcn_s_setprio(0);
    }
    __builtin_amdgcn_sched_barrier(0);
    GEMM_LAND((par + kt + 1) & 1);
    __syncthreads();
  }
  par = (par + nk) & 1;
#undef GEMM_ISSUE
#undef GEMM_LAND
}
template <int BN>
DI void gemm_acc(const bf16_t* __restrict__ A, int lda, const bf16_t* __restrict__ Bt, int ldb, int K, char* smem,
                 f32x4 (&acc)[4][BN / 32]) {
  int par = 0;
  gemm_acc<BN>(A, lda, Bt, ldb, K, smem, acc, A, lda, Bt, ldb, false, par);
}
template <int NJ> DI void zero_acc(f32x4 (&acc)[4][NJ]) {
#pragma unroll
  for (int i = 0; i < 4; ++i)
#pragma unroll
    for (int j = 0; j < NJ; ++j) acc[i][j] = f32x4{0.f, 0.f, 0.f, 0.f};
}
#define EPI_FOR(BN_)                                                                         \
  const int _t = TID(); const int _lane = _t & 63, _wave = _t >> 6;                              \
  const int _wm = _wave >> 1, _wn = _wave & 1, _l16 = _lane & 15, _quad = _lane >> 4;        \
  _Pragma("unroll") for (int i = 0; i < 4; ++i)                                              \
  _Pragma("unroll") for (int j = 0; j < (BN_) / 32; ++j)                                     \
  _Pragma("unroll") for (int r = 0; r < 4; ++r)
#define EPI_ROW (_wm * 64 + i * 16 + _l16)
#define EPI_COL(BN_) (_wn * ((BN_) / 2) + j * 16 + _quad * 4 + r)
#define EPI4_FOR(BN_)                                                                        \
  const int _t = TID(); const int _lane = _t & 63, _wave = _t >> 6;                          \
  const int _wm = _wave >> 1, _wn = _wave & 1, _l16 = _lane & 15, _quad = _lane >> 4;        \
  _Pragma("unroll") for (int i = 0; i < 4; ++i)                                              \
  _Pragma("unroll") for (int j = 0; j < (BN_) / 32; ++j)
#define EPI4_COL(BN_) (_wn * ((BN_) / 2) + j * 16 + _quad * 4)
DI uint2 pack4(f32x4 v) { uint2 o; o.x = pack2(v[0], v[1]); o.y = pack2(v[2], v[3]); return o; }
DI f32x4 unpack4(uint2 u) { return f32x4{bflo(u.x), bfhi(u.x), bflo(u.y), bfhi(u.y)}; }

DI void transpose_tile(const float* __restrict__ W, int ldw, bf16_t* __restrict__ Wt, int ldt, int k0, int n0, char* smem) {
  float* sm = (float*)smem;
  const int tid = TID();
  __syncthreads();
#pragma unroll
  for (int i = 0; i < 4; ++i) {
    const int k = (tid >> 4) + 16 * i, n4 = (tid & 15) * 4;
    const float4 v = *(const float4*)(W + (size_t)(k0 + k) * ldw + n0 + n4);
    sm[k * 65 + n4 + 0] = v.x; sm[k * 65 + n4 + 1] = v.y; sm[k * 65 + n4 + 2] = v.z; sm[k * 65 + n4 + 3] = v.w;
  }
  __syncthreads();
  const int n = tid >> 2, ks = (tid & 3) * 16;
  unsigned u[8];
#pragma unroll
  for (int e = 0; e < 8; ++e) u[e] = pack2(sm[(ks + 2 * e) * 65 + n], sm[(ks + 2 * e + 1) * 65 + n]);
  uint4* dst = (uint4*)(Wt + (size_t)(n0 + n) * ldt + k0 + ks);
  dst[0] = uint4{u[0], u[1], u[2], u[3]};
  dst[1] = uint4{u[4], u[5], u[6], u[7]};
}
DI void transpose_all(const float* W, int ldw, int K, int N, bf16_t* Wt, int bid, int nb, char* smem) {
  const int tk = K >> 6, tn = N >> 6;
  for (int t = bid; t < tk * tn; t += nb) transpose_tile(W, ldw, Wt, K, (t % tk) * 64, (t / tk) * 64, smem);
}

DI void rmsnorm_rows(const float* __restrict__ x, const float* __restrict__ g, bf16_t* __restrict__ h, float* xcopy, int rows,
                     int bid, int nb) {
  const int lane = TID() & 63, wave = TID() >> 6;
  for (int r = bid * 4 + wave; r < rows; r += nb * 4) {
    const float4* xr = (const float4*)(x + (size_t)r * 1024);
    float4 v[4]; float ss = 0.f;
#pragma unroll
    for (int i = 0; i < 4; ++i) { v[i] = xr[lane + 64 * i]; ss += v[i].x * v[i].x + v[i].y * v[i].y + v[i].z * v[i].z + v[i].w * v[i].w; }
    ss = wave_sum(ss);
    const float rs = rsqrtf(ss * (1.f / 1024.f) + 1e-6f);
#pragma unroll
    for (int i = 0; i < 4; ++i) {
      const float4 gg = ((const float4*)g)[lane + 64 * i];
      uint2 o; o.x = pack2(v[i].x * rs * gg.x, v[i].y * rs * gg.y); o.y = pack2(v[i].z * rs * gg.z, v[i].w * rs * gg.w);
      *(uint2*)(h + (size_t)r * 1024 + (lane + 64 * i) * 4) = o;
      if (xcopy) ((float4*)(xcopy + (size_t)r * 1024))[lane + 64 * i] = v[i];
    }
  }
}

template <int DQK, bool CAUSAL>
DI void attn_item(const bf16_t* __restrict__ Q, int ldq, const bf16_t* __restrict__ Kp, int ldk, const bf16_t* __restrict__ VT, int ldvt,
                  int ntiles, int q0, bf16_t* __restrict__ out, int ldo, char* smem) {
  constexpr int KS = DQK + 8, NS = DQK / 16, KCH = DQK / 8;
  bf16_t* Ks = (bf16_t*)smem;
  bf16_t* Vs = Ks + 64 * KS;
  const int tid = TID(), lane = tid & 63, wave = tid >> 6, ql = lane & 31, hh = lane >> 5;
  const int qrow = q0 + wave * 32 + ql;
  bf16x8 bq[NS];
#pragma unroll
  for (int s = 0; s < NS; ++s) bq[s] = *(const bf16x8*)(Q + (size_t)qrow * ldq + s * 16 + hh * 8);
  f32x16 ot[4];
#pragma unroll
  for (int d = 0; d < 4; ++d)
#pragma unroll
    for (int i = 0; i < 16; ++i) ot[d][i] = 0.f;
  float mrun = -INFINITY, lrun = 0.f;
  for (int kt = 0; kt < ntiles; ++kt) {
    __syncthreads();
    for (int c = tid; c < 64 * KCH; c += 256) {
      const int row = c / KCH, cc = c % KCH;
      *(uint4*)(Ks + row * KS + cc * 8) = *(const uint4*)(Kp + (size_t)(kt * 64 + row) * ldk + cc * 8);
    }
#pragma unroll
    for (int c0 = 0; c0 < 4; ++c0) {
      const int c = tid + c0 * 256, row = c >> 3, cc = c & 7;
      *(uint4*)(Vs + row * 72 + cc * 8) = *(const uint4*)(VT + (size_t)row * ldvt + kt * 64 + cc * 8);
    }
    __syncthreads();
    f32x16 st[2];
#pragma unroll
    for (int kb = 0; kb < 2; ++kb) {
#pragma unroll
      for (int i = 0; i < 16; ++i) st[kb][i] = 0.f;
#pragma unroll
      for (int s = 0; s < NS; ++s) {
        const bf16x8 a = *(const bf16x8*)(Ks + (kb * 32 + ql) * KS + s * 16 + hh * 8);
        st[kb] = __builtin_amdgcn_mfma_f32_32x32x16_bf16(a, bq[s], st[kb], 0, 0, 0);
      }
    }
    float mx = -INFINITY;
#pragma unroll
    for (int kb = 0; kb < 2; ++kb)
#pragma unroll
      for (int i = 0; i < 16; ++i) {
        if (CAUSAL) {
          const int key = kt * 64 + kb * 32 + (i & 3) + 8 * (i >> 2) + 4 * hh;
          if (key > qrow) st[kb][i] = -INFINITY;
        }
        mx = fmaxf(mx, st[kb][i]);
      }
    mx = fmaxf(mx, __shfl_xor(mx, 32));
    const float mnew = fmaxf(mrun, mx);
    const float alpha = __builtin_amdgcn_exp2f(mrun - mnew);
    float ps = 0.f;
#pragma unroll
    for (int kb = 0; kb < 2; ++kb)
#pragma unroll
      for (int i = 0; i < 16; ++i) { const float pv = __builtin_amdgcn_exp2f(st[kb][i] - mnew); st[kb][i] = pv; ps += pv; }
    ps += __shfl_xor(ps, 32);
    lrun = lrun * alpha + ps;
    mrun = mnew;
#pragma unroll
    for (int d = 0; d < 4; ++d)
#pragma unroll
      for (int i = 0; i < 16; ++i) ot[d][i] *= alpha;
#pragma unroll
    for (int kb = 0; kb < 2; ++kb)
#pragma unroll
      for (int s2 = 0; s2 < 2; ++s2) {
        unsigned pk[4];
#pragma unroll
        for (int e = 0; e < 4; ++e) pk[e] = pack2(st[kb][8 * s2 + 2 * e], st[kb][8 * s2 + 2 * e + 1]);
        const bf16x8 pb = __builtin_bit_cast(bf16x8, uint4{pk[0], pk[1], pk[2], pk[3]});
#pragma unroll
        for (int d = 0; d < 4; ++d) {
          const bf16_t* vp = Vs + (d * 32 + ql) * 72 + kb * 32 + s2 * 16 + hh * 4;
          const s16x4 lo = *(const s16x4*)vp;
          const s16x4 hi = *(const s16x4*)(vp + 8);
          const bf16x8 av = __builtin_shufflevector(lo, hi, 0, 1, 2, 3, 4, 5, 6, 7);
          ot[d] = __builtin_amdgcn_mfma_f32_32x32x16_bf16(av, pb, ot[d], 0, 0, 0);
        }
      }
  }
  const float inv = 1.f / lrun;
#pragma unroll
  for (int d = 0; d < 4; ++d)
#pragma unroll
    for (int g4 = 0; g4 < 4; ++g4) {
      uint2 o; o.x = pack2(ot[d][4 * g4] * inv, ot[d][4 * g4 + 1] * inv); o.y = pack2(ot[d][4 * g4 + 2] * inv, ot[d][4 * g4 + 3] * inv);
      *(uint2*)(out + (size_t)qrow * ldo + d * 32 + 8 * g4 + 4 * hh) = o;
    }
}


template <int DQK, bool CAUSAL>
DI void attn_item_pf(const bf16_t* __restrict__ Q, int ldq, const bf16_t* Kp, int ldk, const bf16_t* VT, int ldvt,
                  int ntiles, int q0, bf16_t* __restrict__ out, int ldo, char* smem) {
  constexpr int KS = DQK + 8, NS = DQK / 16, KCH = DQK / 8;
  bf16_t* Ks = (bf16_t*)smem;
  bf16_t* Vs = Ks + 64 * KS;
  const int tid = TID(), lane = tid & 63, wave = tid >> 6, ql = lane & 31, hh = lane >> 5;
  const int qrow = q0 + wave * 32 + ql;
  bf16x8 bq[NS];
#pragma unroll
  for (int s = 0; s < NS; ++s) bq[s] = *(const bf16x8*)(Q + (size_t)qrow * ldq + s * 16 + hh * 8);
  f32x16 ot[4];
#pragma unroll
  for (int d = 0; d < 4; ++d)
#pragma unroll
    for (int i = 0; i < 16; ++i) ot[d][i] = 0.f;
  float mrun = -INFINITY, lrun = 0.f;
  Kp = uniform_ptr(Kp); VT = uniform_ptr(VT);
  constexpr int KR = KCH / 4;
  static_assert(KR == 6, "prefetch variant is written for DQK = 192");
  u32x4 kreg[KR], vreg[4];
  const unsigned kvoff = (unsigned)(((tid >> 2) * ldk + (tid & 3) * 8) * 2);
  const unsigned vvoff = (unsigned)(((tid >> 3) * ldvt + (tid & 7) * 8) * 2);
#define GLOADS(dst, voff, sbase) asm volatile("global_load_dwordx4 %0, %1, %2" : "=v"(dst) : "v"(voff), "s"(sbase))
#define ATT_ISSUE(kt_)                                                                                        \
  {                                                                                                           \
    _Pragma("unroll") for (int c0 = 0; c0 < KR; ++c0) GLOADS(kreg[c0], kvoff, Kp + (size_t)(kt_) * 64 * ldk + c0 * 32);   \
    _Pragma("unroll") for (int c0 = 0; c0 < 4; ++c0) GLOADS(vreg[c0], vvoff, VT + (size_t)(c0 * 32) * ldvt + (kt_) * 64); \
  }
#define ATT_LAND()                                                                                            \
  {                                                                                                           \
    asm volatile("s_waitcnt vmcnt(0)" : "+v"(kreg[0]), "+v"(kreg[1]), "+v"(kreg[2]), "+v"(kreg[3]), "+v"(kreg[4]), "+v"(kreg[5]), \
                 "+v"(vreg[0]), "+v"(vreg[1]), "+v"(vreg[2]), "+v"(vreg[3]));                                 \
    _Pragma("unroll") for (int c0 = 0; c0 < KR; ++c0) *(u32x4*)(Ks + (tid >> 2) * KS + ((tid & 3) + 4 * c0) * 8) = kreg[c0];   \
    _Pragma("unroll") for (int c0 = 0; c0 < 4; ++c0) *(u32x4*)(Vs + ((tid >> 3) + 32 * c0) * 72 + (tid & 7) * 8) = vreg[c0];   \
  }
  __syncthreads();
  ATT_ISSUE(0);
  ATT_LAND();
  __syncthreads();
  for (int kt = 0; kt < ntiles; ++kt) {
    {
      const int ktn = (kt + 1 < ntiles) ? kt + 1 : kt;
      ATT_ISSUE(ktn);
    }
    __builtin_amdgcn_sched_barrier(0);
    f32x16 st[2];
#pragma unroll
    for (int kb = 0; kb < 2; ++kb) {
#pragma unroll
      for (int i = 0; i < 16; ++i) st[kb][i] = 0.f;
#pragma unroll
      for (int s = 0; s < NS; ++s) {
        const bf16x8 a = *(const bf16x8*)(Ks + (kb * 32 + ql) * KS + s * 16 + hh * 8);
        st[kb] = __builtin_amdgcn_mfma_f32_32x32x16_bf16(a, bq[s], st[kb], 0, 0, 0);
      }
    }
    float mx = -INFINITY;
#pragma unroll
    for (int kb = 0; kb < 2; ++kb)
#pragma unroll
      for (int i = 0; i < 16; ++i) {
        if (CAUSAL) {
          const int key = kt * 64 + kb * 32 + (i & 3) + 8 * (i >> 2) + 4 * hh;
          if (key > qrow) st[kb][i] = -INFINITY;
        }
        mx = fmaxf(mx, st[kb][i]);
      }
    mx = fmaxf(mx, __shfl_xor(mx, 32));
    const float mnew = fmaxf(mrun, mx);
    const float alpha = __builtin_amdgcn_exp2f(mrun - mnew);
    float ps = 0.f;
#pragma unroll
    for (int kb = 0; kb < 2; ++kb)
#pragma unroll
      for (int i = 0; i < 16; ++i) { const float pv = __builtin_amdgcn_exp2f(st[kb][i] - mnew); st[kb][i] = pv; ps += pv; }
    ps += __shfl_xor(ps, 32);
    lrun = lrun * alpha + ps;
    mrun = mnew;
#pragma unroll
    for (int d = 0; d < 4; ++d)
#pragma unroll
      for (int i = 0; i < 16; ++i) ot[d][i] *= alpha;
#pragma unroll
    for (int kb = 0; kb < 2; ++kb)
#pragma unroll
      for (int s2 = 0; s2 < 2; ++s2) {
        unsigned pk[4];
#pragma unroll
        for (int e = 0; e < 4; ++e) pk[e] = pack2(st[kb][8 * s2 + 2 * e], st[kb][8 * s2 + 2 * e + 1]);
        const bf16x8 pb = __builtin_bit_cast(bf16x8, uint4{pk[0], pk[1], pk[2], pk[3]});
#pragma unroll
        for (int d = 0; d < 4; ++d) {
          const bf16_t* vp = Vs + (d * 32 + ql) * 72 + kb * 32 + s2 * 16 + hh * 4;
          const s16x4 lo = *(const s16x4*)vp;
          const s16x4 hi = *(const s16x4*)(vp + 8);
          const bf16x8 av = __builtin_shufflevector(lo, hi, 0, 1, 2, 3, 4, 5, 6, 7);
          ot[d] = __builtin_amdgcn_mfma_f32_32x32x16_bf16(av, pb, ot[d], 0, 0, 0);
        }
      }
    __builtin_amdgcn_sched_barrier(0);
    __syncthreads();
    ATT_LAND();
    __syncthreads();
  }
#undef ATT_ISSUE
#undef ATT_LAND
#undef GLOADS
  const float inv = 1.f / lrun;
#pragma unroll
  for (int d = 0; d < 4; ++d)
#pragma unroll
    for (int g4 = 0; g4 < 4; ++g4) {
      uint2 o; o.x = pack2(ot[d][4 * g4] * inv, ot[d][4 * g4 + 1] * inv); o.y = pack2(ot[d][4 * g4 + 2] * inv, ot[d][4 * g4 + 3] * inv);
      *(uint2*)(out + (size_t)qrow * ldo + d * 32 + 8 * g4 + 4 * hh) = o;
    }
}

DI void rwkv_scan_unit(const Params& p, int l, int u, char* smem) {
  const int tid = TID();
  const int bl = u >> 5, hd = (u >> 2) & 7, rg = u & 3;
  const int kq = tid & 15, g16 = tid >> 4;
  const bf16_t* RKV = (const bf16_t*)(p.ws + R_RKV) + (size_t)bl * SEQ * 1536;
  const bf16_t* Pm = (const bf16_t*)(p.ws + R_P) + (size_t)bl * SEQ * PLD;
  bf16_t* Y = (bf16_t*)(p.ws + R_YRW) + (size_t)bl * SEQ * 512;
  float* sm = (float*)smem;
  constexpr int BUFF = 5 * 1024 + 256 + 32;
  const int kc = hd * 64 + kq * 4;
  const float4 kk_w = *(const float4*)(p.in[27] + l * 512 + kc);
  const float4 ka_w = *(const float4*)(p.in[28] + l * 512 + kc);
  f32v2_t SA = {0.f, 0.f}, SB = {0.f, 0.f};
  uint2 g_r, g_k, g_w, g_a; bf16_t g_v;
  auto gload = [&](int c) {
    const int tok = c * 16 + g16;
    g_r = *(const uint2*)(RKV + (size_t)tok * 1536 + kc);
    g_k = *(const uint2*)(RKV + (size_t)tok * 1536 + 512 + kc);
    g_v = RKV[(size_t)tok * 1536 + 1024 + hd * 64 + rg * 16 + kq];
    g_w = *(const uint2*)(Pm + (size_t)tok * PLD + PC_RW + kc);
    g_a = *(const uint2*)(Pm + (size_t)tok * PLD + PC_RW + 512 + kc);
  };
  auto derive = [&](int buf) {
    float* b = sm + buf * BUFF;
    const float r[4] = {bflo(g_r.x), bfhi(g_r.x), bflo(g_r.y), bfhi(g_r.y)};
    const float k[4] = {bflo(g_k.x), bfhi(g_k.x), bflo(g_k.y), bfhi(g_k.y)};
    const float w[4] = {bflo(g_w.x), bfhi(g_w.x), bflo(g_w.y), bfhi(g_w.y)};
    const float a[4] = {bflo(g_a.x), bfhi(g_a.x), bflo(g_a.y), bfhi(g_a.y)};
    const float kkw[4] = {kk_w.x, kk_w.y, kk_w.z, kk_w.w};
    const float kaw[4] = {ka_w.x, ka_w.y, ka_w.z, ka_w.w};
    float kk[4], ss = 0.f;
#pragma unroll
    for (int e = 0; e < 4; ++e) { kk[e] = k[e] * kkw[e]; ss += kk[e] * kk[e]; }
    ss = red16(ss);
    const float rn = rsqrtf(ss + 1e-12f);
    float dwr[4], dw[4], dk[4], dn[4], db[4];
    float br = 0.f, khr = 0.f;
#pragma unroll
    for (int e = 0; e < 4; ++e) {
      dw[e] = __expf(w[e]);
      const float kn = kk[e] * rn;
      dn[e] = -kn; db[e] = kn * a[e];
      dk[e] = k[e] * (1.f + (a[e] - 1.f) * kaw[e]);
      dwr[e] = dw[e] * r[e];
      br += db[e] * r[e]; khr += dk[e] * r[e];
    }
    br = red16(br); khr = red16(khr);
#pragma unroll
    for (int e = 0; e < 4; ++e) dwr[e] += dn[e] * br;
    *(float4*)(b + 0 * 1024 + g16 * 64 + kq * 4) = float4{dwr[0], dwr[1], dwr[2], dwr[3]};
    *(float4*)(b + 1 * 1024 + g16 * 64 + kq * 4) = float4{dw[0], dw[1], dw[2], dw[3]};
    *(float4*)(b + 2 * 1024 + g16 * 64 + kq * 4) = float4{dk[0], dk[1], dk[2], dk[3]};
    *(float4*)(b + 3 * 1024 + g16 * 64 + kq * 4) = float4{dn[0], dn[1], dn[2], dn[3]};
    *(float4*)(b + 4 * 1024 + g16 * 64 + kq * 4) = float4{db[0], db[1], db[2], db[3]};
    b[5 * 1024 + g16 * 16 + kq] = bf2f(g_v);
    if (kq == 0) b[5 * 1024 + 256 + g16] = khr;
  };
  __syncthreads();
  gload(0); derive(0);
  __syncthreads();
  constexpr int NC = SEQ / 16;
  for (int c = 0; c < NC; ++c) {
    if (c + 1 < NC) gload(c + 1);
    const float* b = sm + (c & 1) * BUFF;
    float4 nk = *(const float4*)(b + 3 * 1024 + kq * 4);
    float4 w = *(const float4*)(b + 1 * 1024 + kq * 4);
    float4 bb = *(const float4*)(b + 4 * 1024 + kq * 4);
    float4 kh = *(const float4*)(b + 2 * 1024 + kq * 4);
    float4 wr = *(const float4*)(b + 0 * 1024 + kq * 4);
    float v = b[5 * 1024 + g16];
#pragma unroll
    for (int h = 0; h < 2; ++h) {
      float yp[8];
#pragma unroll
      for (int s = 0; s < 8; ++s) {
        const int t = h * 8 + s;
        float4 nk2, w2, bb2, kh2, wr2; float v2;
        if (t < 15) {
          nk2 = *(const float4*)(b + 3 * 1024 + (t + 1) * 64 + kq * 4);
          w2 = *(const float4*)(b + 1 * 1024 + (t + 1) * 64 + kq * 4);
          bb2 = *(const float4*)(b + 4 * 1024 + (t + 1) * 64 + kq * 4);
          kh2 = *(const float4*)(b + 2 * 1024 + (t + 1) * 64 + kq * 4);
          wr2 = *(const float4*)(b + 0 * 1024 + (t + 1) * 64 + kq * 4);
          v2 = b[5 * 1024 + (t + 1) * 16 + g16];
        }
        const f32v2_t nka = {nk.x, nk.y}, nkb = {nk.z, nk.w}, wra = {wr.x, wr.y}, wrb = {wr.z, wr.w};
        const f32v2_t wa = {w.x, w.y}, wb = {w.z, w.w}, ba = {bb.x, bb.y}, bbv = {bb.z, bb.w}, kha = {kh.x, kh.y}, khb = {kh.z, kh.w};
        const f32v2_t ps = SA * nka + SB * nkb;
        const f32v2_t py = SA * wra + SB * wrb;
        float sa = ps.x + ps.y;
        yp[s] = py.x + py.y;
        sa = red16(sa);
        const f32v2_t sa2 = {sa, sa}, vv2 = {v, v};
        SA = SA * wa + (sa2 * ba + vv2 * kha);
        SB = SB * wb + (sa2 * bbv + vv2 * khb);
        if (t < 15) { nk = nk2; w = w2; bb = bb2; kh = kh2; wr = wr2; v = v2; }
      }
      const bool b2 = (kq & 4) != 0, b1 = (kq & 2) != 0, b0 = (kq & 1) != 0;
#pragma unroll
      for (int i = 0; i < 8; ++i) yp[i] += dppf<0x128>(yp[i]);
      float q4[4];
#pragma unroll
      for (int i = 0; i < 4; ++i) { const float keep = b2 ? yp[i + 4] : yp[i], send = b2 ? yp[i] : yp[i + 4]; q4[i] = keep + dppf<0x141>(send); }
      float q2[2];
#pragma unroll
      for (int i = 0; i < 2; ++i) { const float keep = b1 ? q4[i + 2] : q4[i], send = b1 ? q4[i] : q4[i + 2]; q2[i] = keep + dppf<0x4E>(send); }
      const float keep = b0 ? q2[1] : q2[0], send = b0 ? q2[0] : q2[1];
      float yv = keep + dppf<0xB1>(send);
      const int tt = h * 8 + (kq & 7);
      yv += b[5 * 1024 + tt * 16 + g16] * b[5 * 1024 + 256 + tt];
      if ((kq >> 3) == h) Y[(size_t)(c * 16 + tt) * 512 + hd * 64 + rg * 16 + g16] = f2bf(yv);
    }
    if (c + 1 < NC) derive((c + 1) & 1);
    __syncthreads();
  }
}

DI void hgrn_scan_unit(const Params& p, int l, int u, char* smem) {
  const int tid = TID();
  const int bl = u >> 5, hd = (u >> 3) & 3, vg = u & 7;
  const int kq = tid & 15, g16 = tid >> 4;
  bf16_t* Pm = (bf16_t*)(p.ws + R_P) + (size_t)bl * SEQ * PLD;
  float* sm = (float*)smem;
  constexpr int BUFF = 2 * 2048 + 256 + 16;
  const int kc = hd * 128 + kq * 8;
  f32v2_t S2[4];
#pragma unroll
  for (int e = 0; e < 4; ++e) S2[e] = f32v2_t{0.f, 0.f};
  uint4 g_q, g_f; bf16_t g_v;
  const int vcol = PC_HG + 1024 + hd * 128 + vg * 16;
  auto gload = [&](int c) {
    const int tok = c * 16 + g16;
    g_q = *(const uint4*)(Pm + (size_t)tok * PLD + PC_HG + kc);
    g_f = *(const uint4*)(Pm + (size_t)tok * PLD + PC_HG + 512 + kc);
    g_v = Pm[(size_t)tok * PLD + vcol + kq];
  };
  auto derive = [&](int buf) {
    float* b = sm + buf * BUFF;
    const unsigned qu[4] = {g_q.x, g_q.y, g_q.z, g_q.w}, fu[4] = {g_f.x, g_f.y, g_f.z, g_f.w};
    float fq[8], f[8], cs = 0.f;
#pragma unroll
    for (int e = 0; e < 8; ++e) {
      const float q = (e & 1) ? bfhi(qu[e >> 1]) : bflo(qu[e >> 1]);
      const float kf = (e & 1) ? bfhi(fu[e >> 1]) : bflo(fu[e >> 1]);
      f[e] = 1.f - kf;
      fq[e] = f[e] * q;
      cs += kf * q;
    }
    cs = red16(cs);
    *(float4*)(b + g16 * 128 + kq * 8) = float4{fq[0], fq[1], fq[2], fq[3]};
    *(float4*)(b + g16 * 128 + kq * 8 + 4) = float4{fq[4], fq[5], fq[6], fq[7]};
    *(float4*)(b + 2048 + g16 * 128 + kq * 8) = float4{f[0], f[1], f[2], f[3]};
    *(float4*)(b + 2048 + g16 * 128 + kq * 8 + 4) = float4{f[4], f[5], f[6], f[7]};
    b[4096 + g16 * 16 + kq] = bf2f(g_v);
    if (kq == 0) b[4096 + 256 + g16] = cs;
  };
  __syncthreads();
  gload(0); derive(0);
  __syncthreads();
  constexpr int NC = SEQ / 16;
  for (int c = 0; c < NC; ++c) {
    if (c + 1 < NC) gload(c + 1);
    const float* b = sm + (c & 1) * BUFF;
    float4 q0 = *(const float4*)(b + kq * 8), q1 = *(const float4*)(b + kq * 8 + 4);
    float4 f0 = *(const float4*)(b + 2048 + kq * 8), f1 = *(const float4*)(b + 2048 + kq * 8 + 4);
    float v = b[4096 + g16];
#pragma unroll
    for (int h = 0; h < 2; ++h) {
      float yp[8];
#pragma unroll
      for (int s = 0; s < 8; ++s) {
        const int t = h * 8 + s;
        float4 q0n, q1n, f0n, f1n; float vn;
        if (t < 15) {
          q0n = *(const float4*)(b + (t + 1) * 128 + kq * 8); q1n = *(const float4*)(b + (t + 1) * 128 + kq * 8 + 4);
          f0n = *(const float4*)(b + 2048 + (t + 1) * 128 + kq * 8); f1n = *(const float4*)(b + 2048 + (t + 1) * 128 + kq * 8 + 4);
          vn = b[4096 + (t + 1) * 16 + g16];
        }
        const f32v2_t fq2[4] = {{q0.x, q0.y}, {q0.z, q0.w}, {q1.x, q1.y}, {q1.z, q1.w}};
        const f32v2_t ff2[4] = {{f0.x, f0.y}, {f0.z, f0.w}, {f1.x, f1.y}, {f1.z, f1.w}};
        const f32v2_t vv2 = {v, v};
        f32v2_t o2 = S2[0] * fq2[0];
#pragma unroll
        for (int e = 1; e < 4; ++e) o2 = S2[e] * fq2[e] + o2;
#pragma unroll
        for (int e = 0; e < 4; ++e) S2[e] = ff2[e] * (S2[e] - vv2) + vv2;
        yp[s] = o2.x + o2.y;
        if (t < 15) { q0 = q0n; q1 = q1n; f0 = f0n; f1 = f1n; v = vn; }
      }
      const bool b2 = (kq & 4) != 0, b1 = (kq & 2) != 0, b0 = (kq & 1) != 0;
#pragma unroll
      for (int i = 0; i < 8; ++i) yp[i] += dppf<0x128>(yp[i]);
      float q4[4];
#pragma unroll
      for (int i = 0; i < 4; ++i) { const float keep = b2 ? yp[i + 4] : yp[i], send = b2 ? yp[i] : yp[i + 4]; q4[i] = keep + dppf<0x141>(send); }
      float q2[2];
#pragma unroll
      for (int i = 0; i < 2; ++i) { const float keep = b1 ? q4[i + 2] : q4[i], send = b1 ? q4[i] : q4[i + 2]; q2[i] = keep + dppf<0x4E>(send); }
      const float keep = b0 ? q2[1] : q2[0], send = b0 ? q2[0] : q2[1];
      float ov = keep + dppf<0xB1>(send);
      const int tt = h * 8 + (kq & 7);
      ov += b[4096 + tt * 16 + g16] * b[4096 + 256 + tt];
      if ((kq >> 3) == h) Pm[(size_t)(c * 16 + tt) * PLD + vcol + g16] = f2bf(ov);
    }
    if (c + 1 < NC) derive((c + 1) & 1);
    __syncthreads();
  }
}

DI void s5_scan_unit(const Params& p, int l, int u, char* smem) {
  const int tid = TID(), lane = tid & 63, wave = tid >> 6;
  const int idx = u * 4 + wave, bl = idx >> 5, g = idx & 31;
  const bf16_t* Pm = (const bf16_t*)(p.ws + R_P) + (size_t)bl * SEQ * PLD + PC_S5 + g * 16;
  bf16_t* Z = (bf16_t*)(p.ws + R_ZS5) + (size_t)bl * SEQ * 512 + g * 16;
  constexpr int BUS = 132;
  float* buT = (float*)smem + wave * (16 * BUS);
  bf16_t* hist = (bf16_t*)(smem + 4 * 16 * BUS * 4) + wave * (16 * 136);
  const float2 ab = *(const float2*)((const float*)(p.ws + OFF_S5AB) + (g * 64 + lane) * 2);
  const int l16 = lane & 15, quad = lane >> 4;
  bf16x8 bbf[8];
  {
    const float* bbp = (const float*)(p.ws + OFF_S5BB);
#pragma unroll
    for (int jb = 0; jb < 8; ++jb) {
      const int col = jb * 16 + l16, nn = col & 63, im = col >> 6;
      unsigned pk[4] = {0u, 0u, 0u, 0u};
      if (quad < 2) {
        const float* src = bbp + (size_t)(g * 64 + nn) * 32 + im * 16 + quad * 8;
#pragma unroll
        for (int e = 0; e < 4; ++e) pk[e] = pack2(src[2 * e], src[2 * e + 1]);
      }
      bbf[jb] = __builtin_bit_cast(bf16x8, uint4{pk[0], pk[1], pk[2], pk[3]});
    }
  }
  bf16x8 cf[4];
  {
    const float* Cre = p.in[16] + (size_t)l * 32768 + (size_t)(g * 16 + l16) * 64;
    const float* Cim = p.in[17] + (size_t)l * 32768 + (size_t)(g * 16 + l16) * 64;
#pragma unroll
    for (int ks = 0; ks < 4; ++ks) {
      unsigned pk[4];
#pragma unroll
      for (int e = 0; e < 4; ++e) {
        const int k = ks * 32 + quad * 8 + 2 * e;
        const float v0 = (k < 64) ? Cre[k] : -Cim[k - 64];
        const float v1 = (k < 64) ? Cre[k + 1] : -Cim[k + 1 - 64];
        pk[e] = pack2(v0, v1);
      }
      cf[ks] = __builtin_bit_cast(bf16x8, uint4{pk[0], pk[1], pk[2], pk[3]});
    }
  }
  const float dcoef = p.in[18][l * 512 + g * 16 + l16];
  float xr = 0.f, xi = 0.f;
  uint4 ua = uint4{0u, 0u, 0u, 0u};
  bf16_t ue[4];
  auto gload = [&](int c) {
    if (quad < 2) ua = *(const uint4*)(Pm + (size_t)(c * 16 + l16) * PLD + quad * 8);
#pragma unroll
    for (int r = 0; r < 4; ++r) ue[r] = Pm[(size_t)(c * 16 + quad * 4 + r) * PLD + l16];
  };
  __syncthreads();
  gload(0);
  constexpr int NC = SEQ / 16;
  for (int c = 0; c < NC; ++c) {
    const bf16x8 afr = __builtin_bit_cast(bf16x8, ua);
    float us[4];
#pragma unroll
    for (int r = 0; r < 4; ++r) us[r] = bf2f(ue[r]);
#pragma unroll
    for (int jb = 0; jb < 8; ++jb) {
      f32x4 acc = {0.f, 0.f, 0.f, 0.f};
      acc = __builtin_amdgcn_mfma_f32_16x16x32_bf16(afr, bbf[jb], acc, 0, 0, 0);
#pragma unroll
      for (int r = 0; r < 4; ++r) buT[(quad * 4 + r) * BUS + jb * 16 + l16] = acc[r];
    }
    if (c + 1 < NC) gload(c + 1);
    __syncthreads();
#pragma unroll
    for (int t = 0; t < 16; ++t) {
      const float ur = buT[t * BUS + lane], ui = buT[t * BUS + 64 + lane];
      const float nr = ab.x * xr - ab.y * xi + ur;
      const float ni = ab.x * xi + ab.y * xr + ui;
      xr = nr; xi = ni;
      hist[t * 136 + lane] = f2bf(xr);
      hist[t * 136 + 64 + lane] = f2bf(xi);
    }
    __syncthreads();
    f32x4 acc = {0.f, 0.f, 0.f, 0.f};
#pragma unroll
    for (int ks = 0; ks < 4; ++ks) {
      const bf16x8 a = *(const bf16x8*)(hist + l16 * 136 + ks * 32 + quad * 8);
      acc = __builtin_amdgcn_mfma_f32_16x16x32_bf16(a, cf[ks], acc, 0, 0, 0);
    }
#pragma unroll
    for (int r = 0; r < 4; ++r) {
      const int t = quad * 4 + r;
      const float y = acc[r] + dcoef * us[r];
      const float z = y * sigm(1.5957691216057308f * (y + 0.044715f * y * y * y));
      Z[(size_t)(c * 16 + t) * 512 + l16] = f2bf(z);
    }
  }
}

#define GSYNC() xcd_barrier(xb)
#define TILE_MAP(u_, ntm_, tm_, tn_) { const int _x = (u_) & 7, _li = (u_) >> 3, _per = (ntm_) >> 3; tm_ = _x * _per + (_li % _per); tn_ = _li / _per; }
__global__ void __launch_bounds__(256, 2) mega_kernel(Params p) {
  cg::grid_group grid = cg::this_grid();
  __shared__ __attribute__((aligned(16))) char smem[SMEM_BYTES];
  __shared__ uint4 xb_words;
  const int bid = blockIdx.x, nb = gridDim.x;
  if (p.ws == nullptr) grid.sync();
  if (threadIdx.x == 0) xb_words = make_uint4(0u, 0u, 0u, 0u);
  __syncthreads();
  const XcdBarrier xb = xcd_barrier_post((unsigned*)(p.ws + OFF_BAR), (volatile LAS unsigned*)&xb_words);
  char* ws = p.ws;
  float* X = p.out;
  bf16_t* Wt_in = (bf16_t*)(ws + OFF_WIN);
  bf16_t* Wt_q = (bf16_t*)(ws + OFF_WQ);
  bf16_t* Wt_br = (bf16_t*)(ws + OFF_WBR);
  bf16_t* Wt_out = (bf16_t*)(ws + OFF_WOUT);
  bf16_t* Wt_glu = (bf16_t*)(ws + OFF_WGLU);
  bf16_t* Wt_wup = (bf16_t*)(ws + OFF_WWUP);
  bf16_t* Wt_aup = (bf16_t*)(ws + OFF_WAUP);
  bf16_t* Wt_gup = (bf16_t*)(ws + OFF_WGUP);
  bf16_t* Wt_v = (bf16_t*)(ws + OFF_WV);
  bf16_t* Wt_xkv = (bf16_t*)(ws + OFF_WXKV);
  bf16_t* Hb = (bf16_t*)(ws + OFF_H);
  bf16_t* Vfirst = (bf16_t*)(ws + OFF_VFIRST);
  bf16_t* Kx = (bf16_t*)(ws + OFF_KX);
  bf16_t* VxT = (bf16_t*)(ws + OFF_VXT);
  bf16_t* Hm = (bf16_t*)(ws + OFF_HM);
  float* CosT = (float*)(ws + OFF_COS);
  float* SinT = (float*)(ws + OFF_SIN);
  bf16_t* Pm = (bf16_t*)(ws + R_P);
  bf16_t* Cqn = (bf16_t*)(ws + R_CQN);
  bf16_t* Qp = (bf16_t*)(ws + R_QP);
  bf16_t* KVlat = (bf16_t*)(ws + R_KVLAT);
  bf16_t* VTm = (bf16_t*)(ws + R_VT);
  bf16_t* RKV = (bf16_t*)(ws + R_RKV);
  bf16_t* Alora = (bf16_t*)(ws + R_ALORA);
  bf16_t* Yrw = (bf16_t*)(ws + R_YRW);
  bf16_t* Zs5 = (bf16_t*)(ws + R_ZS5);
  bf16_t* Ybr = (bf16_t*)(ws + R_YBR);
  bf16_t* Wt_xq = (bf16_t*)(ws + R_WXQ);
  bf16_t* Wt_xo = (bf16_t*)(ws + R_WXO);
  bf16_t* Wt_gu = (bf16_t*)(ws + R_WGU);
  bf16_t* Wt_down = (bf16_t*)(ws + R_WDOWN);
  bf16_t* Qx = (bf16_t*)(ws + R_QX);
  bf16_t* Ox = (bf16_t*)(ws + R_OX);
  bf16_t* GU = (bf16_t*)(ws + R_GU);
  const float LOG2E = 1.4426950408889634f;

  for (int l = 0; l < 2; ++l) {
    {
      PHASE_IDS
      const float* w_in = p.in[4] + (size_t)l * 1024 * P_IN;
      transpose_all(w_in, P_IN, 1024, P_IN, Wt_in, bid, nb, smem);
      transpose_all(p.in[36] + (size_t)l * 512 * 1024, 1024, 512, 1024, Wt_br + (size_t)1 * 1024 * 512, bid, nb, smem);
      transpose_all(p.in[37] + (size_t)l * 512 * 1024, 1024, 512, 1024, Wt_br + (size_t)2 * 1024 * 512, bid, nb, smem);
      transpose_all(p.in[38] + (size_t)l * 512 * 1024, 1024, 512, 1024, Wt_br + (size_t)3 * 1024 * 512, bid, nb, smem);
      transpose_all(p.in[39] + (size_t)l * 1024 * 1024, 1024, 1024, 1024, Wt_out, bid, nb, smem);
      transpose_all(p.in[19] + (size_t)l * 512 * 512, 512, 512, 512, Wt_glu, bid, nb, smem);
      transpose_all(p.in[23] + (size_t)l * 64 * 512, 512, 64, 512, Wt_wup, bid, nb, smem);
      transpose_all(p.in[25] + (size_t)l * 64 * 512, 512, 64, 512, Wt_aup, bid, nb, smem);
      transpose_all(p.in[26] + (size_t)l * 128 * 512, 512, 128, 512, Wt_gup, bid, nb, smem);
      transpose_all(p.in[43] + (size_t)l * 1024 * 2048, 2048, 1024, 2048, Wt_xkv, bid, nb, smem);
      const int gtid = bid * 256 + tid, gsz = nb * 256;
      {
        const float* w_uq = p.in[6] + (size_t)l * 256 * 768;
        const float* w_ukv = p.in[8] + (size_t)l * 128 * 1024;
        for (int e = gtid; e < 768 * 256; e += gsz) {
          const int n = e >> 8, kq = e & 255, hh = n / 192, j = n % 192;
          float v;
          if (j >= 128) v = w_uq[kq * 768 + n];
          else {
            const float4* a = (const float4*)(w_uq + kq * 768 + hh * 192);
            const float4* b = (const float4*)(w_ukv + j * 1024 + hh * 256);
            float v0 = 0.f, v1 = 0.f, v2 = 0.f, v3 = 0.f;
#pragma unroll 8
            for (int d = 0; d < 32; ++d) { const float4 x = a[d], y = b[d]; v0 += x.x * y.x; v1 += x.y * y.y; v2 += x.z * y.z; v3 += x.w * y.w; }
            v = (v0 + v1) + (v2 + v3);
          }
          Wt_q[e] = f2bf(v);
        }
        const float* w_bm = p.in[35] + (size_t)l * 512 * 1024;
        for (int e = gtid; e < 1024 * 512; e += gsz) {
          const int n = e & 1023, kk = e >> 10, hh = kk >> 7, j = kk & 127;
          const float* a = w_ukv + j * 1024 + hh * 256 + 128;
          const float* bcol = w_bm + (size_t)(hh * 128) * 1024 + n;
          float v0 = 0.f, v1 = 0.f, v2 = 0.f, v3 = 0.f;
#pragma unroll 4
          for (int d = 0; d < 128; d += 4) {
            const float4 x = *(const float4*)(a + d);
            v0 += x.x * bcol[(size_t)(d + 0) * 1024]; v1 += x.y * bcol[(size_t)(d + 1) * 1024];
            v2 += x.z * bcol[(size_t)(d + 2) * 1024]; v3 += x.w * bcol[(size_t)(d + 3) * 1024];
          }
          Wt_br[(size_t)n * 512 + kk] = f2bf((v0 + v1) + (v2 + v3));
        }
        if (l == 1) {
          const float* vd = p.in[32];
          const float* vu = p.in[33];
          for (int e = gtid; e < 512 * 1024; e += gsz) {
            const int n = e & 511, kk = e >> 9;
            float v0 = 0.f, v1 = 0.f, v2 = 0.f, v3 = 0.f;
#pragma unroll
            for (int r = 0; r < 32; r += 4) {
              const float4 x = *(const float4*)(vd + kk * 32 + r);
              v0 += x.x * vu[(r + 0) * 512 + n]; v1 += x.y * vu[(r + 1) * 512 + n];
              v2 += x.z * vu[(r + 2) * 512 + n]; v3 += x.w * vu[(r + 3) * 512 + n];
            }
            Wt_v[(size_t)n * 1024 + kk] = f2bf((v0 + v1) + (v2 + v3));
          }
        }
      }
      {
        float* lbt = (float*)(ws + OFF_BAR) + 3456;
        for (int e = gtid; e < 512; e += gsz) {
          const float x0 = p.in[9][e], x1 = p.in[9][512 + e];
          lbt[e] = (l == 0) ? 0.f : 1.f / (1.f + expf(x0 - x1));
        }
      }
      {
        float* abp = (float*)(ws + OFF_S5AB);
        float* bbp = (float*)(ws + OFF_S5BB);
        for (int e = gtid; e < 2048; e += gsz) {
          const int g = e >> 6;
          const float are = fminf(p.in[11][l * 2048 + e], -1e-4f), aim = p.in[12][l * 2048 + e];
          const float dt = expf(p.in[13][l * 32 + g]);
          const float mag = expf(dt * are);
          const float abre = mag * cosf(dt * aim), abim = mag * sinf(dt * aim);
          const float den = are * are + aim * aim;
          const float zre = ((abre - 1.f) * are + abim * aim) / den;
          const float zim = (abim * are - (abre - 1.f) * aim) / den;
          abp[e * 2] = abre; abp[e * 2 + 1] = abim;
          const float* Br = p.in[14] + (size_t)l * 32768 + (size_t)e * 16;
          const float* Bi = p.in[15] + (size_t)l * 32768 + (size_t)e * 16;
          for (int c = 0; c < 16; ++c) {
            bbp[e * 32 + c] = zre * Br[c] - zim * Bi[c];
            bbp[e * 32 + 16 + c] = zre * Bi[c] + zim * Br[c];
          }
        }
      }
      if (l == 0) rmsnorm_rows(p.in[0], p.in[3], Hb, X, T_ALL, bid, nb);
      else rmsnorm_rows(X, p.in[3] + 1024, Hb, nullptr, T_ALL, bid, nb);
      rmsnorm_rows(p.in[1], p.in[41] + l * 1024, Hm, nullptr, 1024, bid, nb);
    }
    GSYNC();

    for (int half = 0; half < 2; ++half) {
      const bf16_t* Hh = Hb + (size_t)half * TH * 1024;
      {
        const int n1 = 64 * 38;
        const int n2 = (half == 0) ? 8 * 16 : 0;
        int par = 0;
        for (int u = bid; u < n1 + n2; u += nb) {
          f32x4 acc[4][4];
          zero_acc<4>(acc);
          if (u < n1) {
            int tm, tn; TILE_MAP(u, 64, tm, tn);
            int tmn = tm, tnn = tn; if (u + nb < n1) TILE_MAP(u + nb, 64, tmn, tnn);
            gemm_acc<128>(Hh + (size_t)tm * 128 * 1024, 1024, Wt_in + (size_t)tn * 128 * 1024, 1024, 1024, smem, acc,
                          Hh + (size_t)tmn * 128 * 1024, 1024, Wt_in + (size_t)tnn * 128 * 1024, 1024, u != bid, par);
            EPI4_FOR(128) {
              const int row = tm * 128 + EPI_ROW, n = tn * 128 + EPI4_COL(128);
              if (n < GATE_OFF) {
                const int pc = (n < 448) ? n : n + 64;
                f32x4 ov = acc[i][j];
                if (n >= 960 && n < 1472) {
                  const float4 lb4 = *(const float4*)((const float*)(ws + OFF_BAR) + 3456 + (n - 960));
                  ov[0] = (1.f - lb4.x) * sigm(-ov[0]); ov[1] = (1.f - lb4.y) * sigm(-ov[1]);
                  ov[2] = (1.f - lb4.z) * sigm(-ov[2]); ov[3] = (1.f - lb4.w) * sigm(-ov[3]);
                }
                *(uint2*)(Pm + (size_t)row * PLD + pc) = pack4(ov);
              }
            }
          } else {
            const int v = u - n1, tn = v % 16, tm = v / 16;
            gemm_acc<128>(Hm + (size_t)tm * 128 * 1024, 1024, Wt_xkv + (size_t)tn * 128 * 1024, 1024, 1024, smem, acc);
            EPI_FOR(128) {
              const int row = tm * 128 + EPI_ROW, n = tn * 128 + EPI_COL(128);
              const int b = row >> 8, m = row & 255, sel = n >> 10, hh = (n >> 8) & 3, d = n & 255;
              if (sel == 0) Kx[((size_t)(b * 4 + hh) * 256 + m) * 256 + d] = f2bf(acc[i][j][r]);
              else VxT[((size_t)(b * 4 + hh) * 256 + d) * 256 + m] = f2bf(acc[i][j][r]);
            }
          }
        }
      }
      GSYNC();
      {
      PHASE_IDS
        const float* qn = p.in[5] + l * 256;
        const float* kvn = p.in[7] + l * 128;
        const float* mu = p.in[21] + l * 1792;
        for (int tk = bid * 4 + wave; tk < TH; tk += nb * 4) {
          const int gtok = half * TH + tk, s = gtok & (SEQ - 1), bl = tk >> 12;
          const bf16_t* prow = Pm + (size_t)tk * PLD;
          {
            const uint2 cu = *(const uint2*)(prow + lane * 4);
            float f[4] = {bflo(cu.x), bfhi(cu.x), bflo(cu.y), bfhi(cu.y)};
            float ss = wave_sum(f[0] * f[0] + f[1] * f[1] + f[2] * f[2] + f[3] * f[3]);
            const float rs = rsqrtf(ss * (1.f / 256.f) + 1e-6f);
            const float4 g4 = *(const float4*)(qn + lane * 4);
            uint2 o; o.x = pack2(f[0] * rs * g4.x, f[1] * rs * g4.y); o.y = pack2(f[2] * rs * g4.z, f[3] * rs * g4.w);
            *(uint2*)(Cqn + (size_t)tk * 256 + lane * 4) = o;
          }
          {
            const unsigned cu = *(const unsigned*)(prow + 256 + lane * 2);
            const float f0 = bflo(cu), f1 = bfhi(cu);
            const float ss = wave_sum(f0 * f0 + f1 * f1);
            const float rs = rsqrtf(ss * (1.f / 128.f) + 1e-6f);
            const float v0 = f0 * rs * kvn[lane * 2], v1 = f1 * rs * kvn[lane * 2 + 1];
            const bf16_t b0 = f2bf(v0), b1 = f2bf(v1);
            *(unsigned*)(KVlat + (size_t)tk * 192 + lane * 2) = (unsigned)b0 | ((unsigned)b1 << 16);
            VTm[((size_t)bl * 128 + lane * 2) * SEQ + s] = b0;
            VTm[((size_t)bl * 128 + lane * 2 + 1) * SEQ + s] = b1;
          }
          if (lane < 32) {
            const float t1 = bf2f(prow[384 + lane]), t2 = bf2f(prow[384 + 32 + lane]);
            const float posf = (float)p.pos[gtok];
            const float invf = exp2f(-(float)lane * (13.287712379549449f / 32.f));
            const float ang = posf * invf;
            const float cs = cosf(ang), sn = sinf(ang);
            KVlat[(size_t)tk * 192 + 128 + lane] = f2bf(t1 * cs - t2 * sn);
            KVlat[(size_t)tk * 192 + 160 + lane] = f2bf(t1 * sn + t2 * cs);
            CosT[tk * 32 + lane] = cs; SinT[tk * 32 + lane] = sn;
          }
#pragma unroll
          for (int jj = 0; jj < 7; ++jj) {
            const int col = (jj * 64 + lane) * 4;
            const uint2 cu = *(const uint2*)(prow + PC_RW + col);
            uint2 pu = uint2{0u, 0u};
            if (s > 0) pu = *(const uint2*)(prow - PLD + PC_RW + col);
            const float4 m4 = *(const float4*)(mu + col);
            const float cv[4] = {bflo(cu.x), bfhi(cu.x), bflo(cu.y), bfhi(cu.y)};
            const float pv[4] = {bflo(pu.x), bfhi(pu.x), bflo(pu.y), bfhi(pu.y)};
            const float mm[4] = {m4.x, m4.y, m4.z, m4.w};
            float o[4];
#pragma unroll
            for (int e = 0; e < 4; ++e) o[e] = cv[e] + (pv[e] - cv[e]) * mm[e];
            if (col < 1536) {
              uint2 ov; ov.x = pack2(o[0], o[1]); ov.y = pack2(o[2], o[3]);
              *(uint2*)(RKV + (size_t)tk * 1536 + col) = ov;
              if (l == 0 && col >= 1024) *(uint2*)(Vfirst + (size_t)gtok * 512 + (col - 1024)) = ov;
            } else {
              int dc;
              if (col < 1600) { dc = col - 1536; for (int e = 0; e < 4; ++e) o[e] = tanhf(o[e]); }
              else if (col < 1664) { dc = 64 + col - 1600; }
              else { dc = 128 + col - 1664; for (int e = 0; e < 4; ++e) o[e] = sigm(o[e]); }
              uint2 ov; ov.x = pack2(o[0], o[1]); ov.y = pack2(o[2], o[3]);
              *(uint2*)(Alora + (size_t)tk * 256 + dc) = ov;
            }
          }
        }
      }
      GSYNC();
      {
      PHASE_IDS
        const int nq = 64 * 6, nl = 64 * 4;
        const int total = nq + 3 * nl + (l == 1 ? nl : 0);
        for (int u = bid; u < total; u += nb) {
          f32x4 acc[4][4];
          zero_acc<4>(acc);
          if (u < nq) {
            int tm, tn; TILE_MAP(u, 64, tm, tn);
            gemm_acc<128>(Cqn + (size_t)tm * 128 * 256, 256, Wt_q + (size_t)tn * 128 * 256, 256, 256, smem, acc);
            const float qs = 0.07216878364870322f * LOG2E;
            const int lane_ = tid & 63, wave_ = tid >> 6, wm_ = wave_ >> 1, wn_ = wave_ & 1, l16_ = lane_ & 15, quad_ = lane_ >> 4;
            const int gc = tn * 128 + wn_ * 64;
            const bool is_rope = (gc % 192) == 128;
#pragma unroll
            for (int i = 0; i < 4; ++i) {
              const int row = tm * 128 + wm_ * 64 + i * 16 + l16_;
              if (is_rope) {
#pragma unroll
                for (int j = 0; j < 2; ++j) {
                  const int fi = j * 16 + quad_ * 4;
                  const float4 cs = *(const float4*)(CosT + row * 32 + fi), sn = *(const float4*)(SinT + row * 32 + fi);
                  const float c4[4] = {cs.x, cs.y, cs.z, cs.w}, s4[4] = {sn.x, sn.y, sn.z, sn.w};
#pragma unroll
                  for (int r = 0; r < 4; ++r) {
                    const float t1 = acc[i][j][r], t2 = acc[i][j + 2][r];
                    acc[i][j][r] = t1 * c4[r] - t2 * s4[r]; acc[i][j + 2][r] = t1 * s4[r] + t2 * c4[r];
                  }
                }
              }
#pragma unroll
              for (int j = 0; j < 4; ++j) *(uint2*)(Qp + (size_t)row * 768 + gc + j * 16 + quad_ * 4) = pack4(acc[i][j] * qs);
            }
          } else if (u < nq + 3 * nl) {
            const int v = u - nq, which = v / nl, w2 = v % nl, tn = w2 % 4, tm = w2 / 4;
            if (which == 0) {
              gemm_acc<128>(Alora + (size_t)tm * 128 * 256, 256, Wt_wup + (size_t)tn * 128 * 64, 64, 64, smem, acc);
              const float* w0 = p.in[22] + l * 512;
              EPI4_FOR(128) {
                const int row = tm * 128 + EPI_ROW, n = tn * 128 + EPI4_COL(128);
                const float4 b4 = *(const float4*)(w0 + n);
                f32x4 wv = acc[i][j] + f32x4{b4.x, b4.y, b4.z, b4.w};
#pragma unroll
                for (int r = 0; r < 4; ++r) wv[r] = -0.6065306597126334f * sigm(wv[r]);
                *(uint2*)(Pm + (size_t)row * PLD + PC_RW + n) = pack4(wv);
              }
            } else if (which == 1) {
              gemm_acc<128>(Alora + (size_t)tm * 128 * 256 + 64, 256, Wt_aup + (size_t)tn * 128 * 64, 64, 64, smem, acc);
              const float* a0 = p.in[24] + l * 512;
              EPI4_FOR(128) {
                const int row = tm * 128 + EPI_ROW, n = tn * 128 + EPI4_COL(128);
                const float4 b4 = *(const float4*)(a0 + n);
                f32x4 v = acc[i][j] + f32x4{b4.x, b4.y, b4.z, b4.w};
#pragma unroll
                for (int r = 0; r < 4; ++r) v[r] = sigm(v[r]);
                *(uint2*)(Pm + (size_t)row * PLD + PC_RW + 512 + n) = pack4(v);
              }
            } else {
              gemm_acc<128>(Alora + (size_t)tm * 128 * 256 + 128, 256, Wt_gup + (size_t)tn * 128 * 128, 128, 128, smem, acc);
              EPI4_FOR(128) {
                const int row = tm * 128 + EPI_ROW, n = tn * 128 + EPI4_COL(128);
                *(uint2*)(Pm + (size_t)row * PLD + PC_RW + 1024 + n) = pack4(acc[i][j]);
              }
            }
          } else {
            const int w2 = u - nq - 3 * nl, tn = w2 % 4, tm = w2 / 4;
            gemm_acc<128>(Hh + (size_t)tm * 128 * 1024, 1024, Wt_v + (size_t)tn * 128 * 1024, 1024, 1024, smem, acc);
            const float* vb = p.in[34];
            EPI4_FOR(128) {
              const int row = tm * 128 + EPI_ROW, n = tn * 128 + EPI4_COL(128);
              const float4 b4 = *(const float4*)(vb + n);
              const f32x4 lg = acc[i][j] + f32x4{b4.x, b4.y, b4.z, b4.w};
              const f32x4 vc = unpack4(*(const uint2*)(RKV + (size_t)row * 1536 + 1024 + n));
              const f32x4 vf = unpack4(*(const uint2*)(Vfirst + ((size_t)half * TH + row) * 512 + n));
              f32x4 o;
#pragma unroll
              for (int r = 0; r < 4; ++r) o[r] = vc[r] + (vf[r] - vc[r]) * sigm(lg[r]);
              *(uint2*)(RKV + (size_t)row * 1536 + 1024 + n) = pack4(o);
            }
          }
        }
      }
      GSYNC();
      {
        int first, count, step;
        if (nb == 512) {
          if (bid < 144) { first = bid; count = 1; step = 0; }
          else {
            int pi = -1;
            if (bid < 256) pi = bid - 144; else if (bid >= 400 && bid < 416) pi = 112 + (bid - 400);
            first = 144 + pi; count = (pi >= 0) ? 2 : 0; step = 255 - 2 * pi;
          }
        } else { first = bid; step = nb; count = (bid < 400) ? (400 - bid + nb - 1) / nb : 0; }
#pragma unroll 1
        for (int q = 0; q < count; ++q) {
          const int u = first + q * step;
          if (u < 144) {
            __builtin_amdgcn_s_setprio(3);
            if (u < 64) rwkv_scan_unit(p, l, u, smem);
            else if (u < 128) hgrn_scan_unit(p, l, u - 64, smem);
            else s5_scan_unit(p, l, u - 128, smem);
            __builtin_amdgcn_s_setprio(0);
          } else {
            const int it = u - 144, qt = 31 - (it >> 3), bl = (it >> 2) & 1, hh = it & 3;
            attn_item_pf<192, true>(Qp + (size_t)bl * SEQ * 768 + hh * 192, 768, KVlat + (size_t)bl * SEQ * 192, 192,
                                    VTm + (size_t)bl * 128 * SEQ, SEQ, (qt * 128 + 128) / 64, qt * 128,
                                    Pm + (size_t)bl * SEQ * PLD + hh * 128, PLD, smem);
          }
        }
        {
          unsigned char* G8 = (unsigned char*)(ws + R_G8);
          int g0, gs;
          if (nb == 512) { g0 = (bid >= 416) ? bid - 416 : 2048; gs = 96; } else { g0 = bid; gs = nb; }
#pragma unroll 1
          for (int t = g0; t < 2048; t += gs) {
            const int tm = t >> 5, tn = t & 31;
            f32x4 acc[4][4];
            zero_acc<4>(acc);
            gemm_acc<128>(Hh + (size_t)tm * 128 * 1024, 1024, Wt_in + (size_t)(GATE_OFF + tn * 128) * 1024, 1024, 1024, smem, acc);
            EPI4_FOR(128) {
              const int row = tm * 128 + EPI_ROW, n = tn * 128 + EPI4_COL(128);
              unsigned q = 0;
#pragma unroll
              for (int r = 0; r < 4; ++r) q |= ((unsigned)(sigm(acc[i][j][r]) * 255.f + 0.5f)) << (8 * r);
              *(unsigned*)(G8 + (size_t)row * 4096 + n) = q;
            }
          }
        }
      }
      GSYNC();
      {
      PHASE_IDS
        const int nglu = 64 * 4;
        for (int u = bid; u < nglu; u += nb) {
          int tm, tn; TILE_MAP(u, 64, tm, tn);
          f32x4 acc[4][4];
          zero_acc<4>(acc);
          gemm_acc<128>(Zs5 + (size_t)tm * 128 * 512, 512, Wt_glu + (size_t)tn * 128 * 512, 512, 512, smem, acc);
          const float* bg = p.in[20] + l * 512;
          EPI4_FOR(128) {
            const int row = tm * 128 + EPI_ROW, n = tn * 128 + EPI4_COL(128);
            const f32x4 z = unpack4(*(const uint2*)(Zs5 + (size_t)row * 512 + n));
            const float4 b4 = *(const float4*)(bg + n);
            const f32x4 lg = acc[i][j] + f32x4{b4.x, b4.y, b4.z, b4.w};
            f32x4 o;
#pragma unroll
            for (int r = 0; r < 4; ++r) o[r] = z[r] * sigm(lg[r]);
            *(uint2*)(Pm + (size_t)row * PLD + PC_S5 + n) = pack4(o);
          }
        }
        const float* k_a = p.in[28] + l * 512;
        const float* r_k = p.in[29] + l * 512;
        const float* ln_w = p.in[30] + l * 512;
        const float* ln_b = p.in[31] + l * 512;
        const float* o_norm = p.in[10] + l * 512;
        for (int tk = bid * 4 + wave; tk < TH; tk += nb * 4) {
          const int c0 = lane * 8;
          {
            const uint4 yu = *(const uint4*)(Yrw + (size_t)tk * 512 + c0);
            const float y[8] = {bflo(yu.x), bfhi(yu.x), bflo(yu.y), bfhi(yu.y), bflo(yu.z), bfhi(yu.z), bflo(yu.w), bfhi(yu.w)};
            const uint4 ru = *(const uint4*)(RKV + (size_t)tk * 1536 + c0);
            const uint4 ku = *(const uint4*)(RKV + (size_t)tk * 1536 + 512 + c0);
            const uint4 vu = *(const uint4*)(RKV + (size_t)tk * 1536 + 1024 + c0);
            const uint4 au = *(const uint4*)(Pm + (size_t)tk * PLD + PC_RW + 512 + c0);
            const uint4 gu = *(const uint4*)(Pm + (size_t)tk * PLD + PC_RW + 1024 + c0);
            const unsigned ra[4] = {ru.x, ru.y, ru.z, ru.w}, ka[4] = {ku.x, ku.y, ku.z, ku.w}, va[4] = {vu.x, vu.y, vu.z, vu.w};
            const unsigned aa[4] = {au.x, au.y, au.z, au.w}, ga[4] = {gu.x, gu.y, gu.z, gu.w};
            float rr[8], kh[8], vv[8], gg[8];
            float sm1 = 0.f, bsum = 0.f;
#pragma unroll
            for (int e = 0; e < 8; ++e) {
              const unsigned sh = (e & 1);
              rr[e] = sh ? bfhi(ra[e >> 1]) : bflo(ra[e >> 1]);
              const float kx = sh ? bfhi(ka[e >> 1]) : bflo(ka[e >> 1]);
              vv[e] = sh ? bfhi(va[e >> 1]) : bflo(va[e >> 1]);
              const float a = sh ? bfhi(aa[e >> 1]) : bflo(aa[e >> 1]);
              gg[e] = sh ? bfhi(ga[e >> 1]) : bflo(ga[e >> 1]);
              kh[e] = kx * (1.f + (a - 1.f) * k_a[c0 + e]);
              sm1 += y[e];
              bsum += rr[e] * kh[e] * r_k[c0 + e];
            }
            sm1 = red8(sm1); bsum = red8(bsum);
            const float mean = sm1 * (1.f / 64.f);
            float vs = 0.f;
#pragma unroll
            for (int e = 0; e < 8; ++e) { const float d = y[e] - mean; vs += d * d; }
            vs = red8(vs);
            const float rstd = rsqrtf(vs * (1.f / 64.f) + 64e-5f);
            float o[8];
#pragma unroll
            for (int e = 0; e < 8; ++e) o[e] = (((y[e] - mean) * rstd) * ln_w[c0 + e] + ln_b[c0 + e] + bsum * vv[e]) * gg[e];
            uint4 ov; ov.x = pack2(o[0], o[1]); ov.y = pack2(o[2], o[3]); ov.z = pack2(o[4], o[5]); ov.w = pack2(o[6], o[7]);
            *(uint4*)(RKV + (size_t)tk * 1536 + c0) = ov;
          }
          {
            bf16_t* op = Pm + (size_t)tk * PLD + PC_HG + 1024 + c0;
            const uint4 ou = *(const uint4*)op;
            const uint4 gu = *(const uint4*)(Pm + (size_t)tk * PLD + PC_HG + 1536 + c0);
            const unsigned oa[4] = {ou.x, ou.y, ou.z, ou.w}, ga[4] = {gu.x, gu.y, gu.z, gu.w};
            float o[8], ss = 0.f;
#pragma unroll
            for (int e = 0; e < 4; ++e) { o[2 * e] = bflo(oa[e]); o[2 * e + 1] = bfhi(oa[e]); }
#pragma unroll
            for (int e = 0; e < 8; ++e) ss += o[e] * o[e];
            ss = red16(ss);
            const float rs = rsqrtf(ss * (1.f / 128.f) + 1e-6f);
            float r8[8];
#pragma unroll
            for (int e = 0; e < 8; ++e) {
              const float gte = (e & 1) ? bfhi(ga[e >> 1]) : bflo(ga[e >> 1]);
              r8[e] = o[e] * rs * o_norm[c0 + e] * sigm(gte);
            }
            uint4 ov; ov.x = pack2(r8[0], r8[1]); ov.y = pack2(r8[2], r8[3]); ov.z = pack2(r8[4], r8[5]); ov.w = pack2(r8[6], r8[7]);
            *(uint4*)op = ov;
          }
        }
      }
      GSYNC();
      {
        int par6 = 0;
        const unsigned char* G8 = (const unsigned char*)(ws + R_G8);
        auto brA = [&](int m, int tm_, int& lda_) -> const bf16_t* {
          const bf16_t* Ao;
          if (m == 0) { Ao = Pm; lda_ = PLD; }
          else if (m == 1) { Ao = Pm + PC_HG + 1024; lda_ = PLD; }
          else if (m == 2) { Ao = Pm + PC_S5; lda_ = PLD; }
          else { Ao = RKV; lda_ = 1536; }
          return Ao + (size_t)tm_ * 128 * lda_;
        };
        for (int u = bid; u < 64 * 8; u += nb) {
          int tm, tn; TILE_MAP(u, 64, tm, tn);
          const bool has_next = (u + nb < 64 * 8);
          int tmn = tm, tnn = tn; if (has_next) TILE_MAP(u + nb, 64, tmn, tnn);
          f32x4 yacc[4][4];
          zero_acc<4>(yacc);
#pragma unroll 1
          for (int m = 0; m < 4; ++m) {
            f32x4 ao[4][4];
            zero_acc<4>(ao);
            int ldo; const bf16_t* Ao = brA(m, tm, ldo);
            const bf16_t* Bo = Wt_br + ((size_t)m * 1024 + tn * 128) * 512;
            const int mn = (m < 3) ? m + 1 : 0;
            const int tmx = (m < 3) ? tm : tmn, tnx = (m < 3) ? tn : tnn;
            int ldn; const bf16_t* An = brA(mn, tmx, ldn);
            const bf16_t* Bn = Wt_br + ((size_t)mn * 1024 + tnx * 128) * 512;
            gemm_acc<128>(Ao, ldo, Bo, 512, 512, smem, ao, An, ldn, Bn, 512, !(m == 0 && u == bid), par6);
            {
              EPI4_FOR(128) {
                const int row = tm * 128 + EPI_ROW, n = tn * 128 + EPI4_COL(128);
                const unsigned q = *(const unsigned*)(G8 + (size_t)row * 4096 + m * 1024 + n);
#pragma unroll
                for (int r = 0; r < 4; ++r) yacc[i][j][r] += ao[i][j][r] * ((float)((q >> (8 * r)) & 255u) * (1.f / 255.f));
              }
            }
          }
          {
            f32x4 (&acc)[4][4] = yacc;
            EPI4_FOR(128) {
              const int row = tm * 128 + EPI_ROW, n = tn * 128 + EPI4_COL(128);
              *(uint2*)(Ybr + (size_t)row * 1024 + n) = pack4(acc[i][j]);
            }
          }
        }
      }
      GSYNC();
      {
        int par = 0;
        for (int u = bid; u < 64 * 8; u += nb) {
          int tm, tn; TILE_MAP(u, 64, tm, tn);
          int tmn = tm, tnn = tn; if (u + nb < 64 * 8) TILE_MAP(u + nb, 64, tmn, tnn);
          f32x4 acc[4][4];
          zero_acc<4>(acc);
          gemm_acc<128>(Ybr + (size_t)tm * 128 * 1024, 1024, Wt_out + (size_t)tn * 128 * 1024, 1024, 1024, smem, acc,
                        Ybr + (size_t)tmn * 128 * 1024, 1024, Wt_out + (size_t)tnn * 128 * 1024, 1024, u != bid, par);
          EPI4_FOR(128) {
            const int row = half * TH + tm * 128 + EPI_ROW, n = tn * 128 + EPI4_COL(128);
            float4* xp = (float4*)(X + (size_t)row * 1024 + n);
            float4 xv = *xp; xv.x += acc[i][j][0]; xv.y += acc[i][j][1]; xv.z += acc[i][j][2]; xv.w += acc[i][j][3];
            *xp = xv;
          }
        }
      }
      GSYNC();
    }

    {
      transpose_all(p.in[42] + (size_t)l * 1024 * 1024, 1024, 1024, 1024, Wt_xq, bid, nb, smem);
      transpose_all(p.in[44] + (size_t)l * 1024 * 1024, 1024, 1024, 1024, Wt_xo, bid, nb, smem);
      transpose_all(p.in[46] + (size_t)l * 1024 * 5632, 5632, 1024, 5632, Wt_gu, bid, nb, smem);
      transpose_all(p.in[49] + (size_t)l * 2816 * 1024, 1024, 2816, 1024, Wt_down, bid, nb, smem);
      rmsnorm_rows(X, p.in[40] + l * 1024, Hb, nullptr, T_ALL, bid, nb);
    }
    GSYNC();
    {
      const float qs = 0.0625f * LOG2E;
      int par = 0;
      for (int u = bid; u < 128 * 8; u += nb) {
        int tm, tn; TILE_MAP(u, 128, tm, tn);
        int tmn = tm, tnn = tn; if (u + nb < 128 * 8) TILE_MAP(u + nb, 128, tmn, tnn);
        f32x4 acc[4][4];
        zero_acc<4>(acc);
        gemm_acc<128>(Hb + (size_t)tm * 128 * 1024, 1024, Wt_xq + (size_t)tn * 128 * 1024, 1024, 1024, smem, acc,
                      Hb + (size_t)tmn * 128 * 1024, 1024, Wt_xq + (size_t)tnn * 128 * 1024, 1024, u != bid, par);
        EPI4_FOR(128) {
          const int row = tm * 128 + EPI_ROW, n = tn * 128 + EPI4_COL(128);
          *(uint2*)(Qx + (size_t)row * 1024 + n) = pack4(acc[i][j] * qs);
        }
      }
    }
    GSYNC();
    {
      for (int u = bid; u < 1024; u += nb) {
        const int dvh = u & 1, hh = (u >> 1) & 3, qt = (u >> 3) & 31, b = u >> 8;
        attn_item<256, false>(Qx + (size_t)b * SEQ * 1024 + hh * 256, 1024, Kx + (size_t)(b * 4 + hh) * 65536, 256,
                              VxT + (size_t)(b * 4 + hh) * 65536 + (size_t)dvh * 128 * 256, 256, 4, qt * 128,
                              Ox + (size_t)b * SEQ * 1024 + hh * 256 + dvh * 128, 1024, smem);
      }
    }
    GSYNC();
    {
      int par = 0;
      for (int u = bid; u < 128 * 8; u += nb) {
        int tm, tn; TILE_MAP(u, 128, tm, tn);
        int tmn = tm, tnn = tn; if (u + nb < 128 * 8) TILE_MAP(u + nb, 128, tmn, tnn);
        f32x4 acc[4][4];
        zero_acc<4>(acc);
        gemm_acc<128>(Ox + (size_t)tm * 128 * 1024, 1024, Wt_xo + (size_t)tn * 128 * 1024, 1024, 1024, smem, acc,
                      Ox + (size_t)tmn * 128 * 1024, 1024, Wt_xo + (size_t)tnn * 128 * 1024, 1024, u != bid, par);
        EPI4_FOR(128) {
          const int row = tm * 128 + EPI_ROW, n = tn * 128 + EPI4_COL(128);
          float4* xp = (float4*)(X + (size_t)row * 1024 + n);
          float4 xv = *xp; xv.x += acc[i][j][0]; xv.y += acc[i][j][1]; xv.z += acc[i][j][2]; xv.w += acc[i][j][3];
          *xp = xv;
        }
      }
    }
    GSYNC();
    rmsnorm_rows(X, p.in[45] + l * 1024, Hb, nullptr, T_ALL, bid, nb);
    GSYNC();
    for (int half = 0; half < 2; ++half) {
      const bf16_t* Hh = Hb + (size_t)half * TH * 1024;
      int par13 = 0;
      for (int u = bid; u < 64 * 44; u += nb) {
        int tm, tn; TILE_MAP(u, 64, tm, tn);
        int tmn = tm, tnn = tn; if (u + nb < 64 * 44) TILE_MAP(u + nb, 64, tmn, tnn);
        f32x4 acc[4][4];
        zero_acc<4>(acc);
        gemm_acc<128>(Hh + (size_t)tm * 128 * 1024, 1024, Wt_gu + (size_t)tn * 128 * 1024, 1024, 1024, smem, acc,
                      Hh + (size_t)tmn * 128 * 1024, 1024, Wt_gu + (size_t)tnn * 128 * 1024, 1024, u != bid, par13);
        EPI4_FOR(128) {
          const int row = tm * 128 + EPI_ROW, n = tn * 128 + EPI4_COL(128);
          *(uint2*)(GU + (size_t)row * 5632 + n) = pack4(acc[i][j]);
        }
      }
      GSYNC();
      {
      PHASE_IDS
        const float* cw = p.in[47] + (size_t)l * 3 * D_FF;
        const float* cb = p.in[48] + (size_t)l * D_FF;
        for (int e = bid * 256 + tid; e < TH * 352; e += nb * 256) {
          const int tk = e / 352, c0 = (e % 352) * 8;
          const int s = tk & (SEQ - 1);
          const bf16_t* gp = GU + (size_t)tk * 5632 + c0;
          const uint4 g2 = *(const uint4*)gp;
          uint4 g1 = uint4{0, 0, 0, 0}, g0 = uint4{0, 0, 0, 0};
          if (s >= 1) g1 = *(const uint4*)(gp - 5632);
          if (s >= 2) g0 = *(const uint4*)(gp - 2 * 5632);
          const uint4 uu = *(const uint4*)(gp + D_FF);
          const unsigned a2[4] = {g2.x, g2.y, g2.z, g2.w}, a1[4] = {g1.x, g1.y, g1.z, g1.w}, a0[4] = {g0.x, g0.y, g0.z, g0.w};
          const unsigned au[4] = {uu.x, uu.y, uu.z, uu.w};
          float o[8];
#pragma unroll
          for (int q = 0; q < 8; ++q) {
            const bool hi = q & 1;
            const float x2 = hi ? bfhi(a2[q >> 1]) : bflo(a2[q >> 1]);
            const float x1 = hi ? bfhi(a1[q >> 1]) : bflo(a1[q >> 1]);
            const float x0 = hi ? bfhi(a0[q >> 1]) : bflo(a0[q >> 1]);
            const float up = hi ? bfhi(au[q >> 1]) : bflo(au[q >> 1]);
            const int c = c0 + q;
            const float gv = cw[c] * x0 + cw[D_FF + c] * x1 + cw[2 * D_FF + c] * x2 + cb[c];
            o[q] = gv * sigm(gv) * up;
          }
          uint4 ov; ov.x = pack2(o[0], o[1]); ov.y = pack2(o[2], o[3]); ov.z = pack2(o[4], o[5]); ov.w = pack2(o[6], o[7]);
          *(uint4*)(GU + (size_t)tk * 5632 + D_FF + c0) = ov;
        }
      }
      GSYNC();
      int par15 = 0;
      for (int u = bid; u < 64 * 8; u += nb) {
        int tm, tn; TILE_MAP(u, 64, tm, tn);
        int tmn = tm, tnn = tn; if (u + nb < 64 * 8) TILE_MAP(u + nb, 64, tmn, tnn);
        f32x4 acc[4][4];
        zero_acc<4>(acc);
        gemm_acc<128>(GU + (size_t)tm * 128 * 5632 + D_FF, 5632, Wt_down + (size_t)tn * 128 * 2816, 2816, 2816, smem, acc,
                      GU + (size_t)tmn * 128 * 5632 + D_FF, 5632, Wt_down + (size_t)tnn * 128 * 2816, 2816, u != bid, par15);
        EPI4_FOR(128) {
          const int row = half * TH + tm * 128 + EPI_ROW, n = tn * 128 + EPI4_COL(128);
          float4* xp = (float4*)(X + (size_t)row * 1024 + n);
          float4 xv = *xp; xv.x += acc[i][j][0]; xv.y += acc[i][j][1]; xv.z += acc[i][j][2]; xv.w += acc[i][j][3];
          *xp = xv;
        }
      }
      GSYNC();
    }
  }

  {
      PHASE_IDS
    const float* g = p.in[50];
    for (int r = bid * 4 + wave; r < T_ALL; r += nb * 4) {
      float4* xr = (float4*)(X + (size_t)r * 1024);
      float4 v[4]; float ss = 0.f;
#pragma unroll
      for (int i = 0; i < 4; ++i) { v[i] = xr[lane + 64 * i]; ss += v[i].x * v[i].x + v[i].y * v[i].y + v[i].z * v[i].z + v[i].w * v[i].w; }
      ss = wave_sum(ss);
      const float rs = rsqrtf(ss * (1.f / 1024.f) + 1e-6f);
#pragma unroll
      for (int i = 0; i < 4; ++i) {
        const float4 gg = ((const float4*)g)[lane + 64 * i];
        xr[lane + 64 * i] = float4{v[i].x * rs * gg.x, v[i].y * rs * gg.y, v[i].z * rs * gg.z, v[i].w * rs * gg.w};
      }
    }
  }
}

extern "C" void kernel_launch(void* const* d_in, const int* in_sizes, int n_in, void* d_out, int out_size, void* d_ws, size_t ws_size,
                              hipStream_t stream) {
  static int grid_blocks = 0;
  if (!grid_blocks) {
    int dev = 0, cus = 0, per_cu = 0;
    hipGetDevice(&dev);
    hipDeviceGetAttribute(&cus, hipDeviceAttributeMultiprocessorCount, dev);
    hipOccupancyMaxActiveBlocksPerMultiprocessor(&per_cu, mega_kernel, 256, 0);
    if (per_cu > 2) per_cu = 2;
    if (per_cu < 1) per_cu = 1;
    grid_blocks = cus * per_cu;
  }
  if (ws_size < WS_NEED) fprintf(stderr, "workspace too small: %zu < %zu\n", ws_size, (size_t)WS_NEED);
  Params p{};
  for (int i = 0; i < 51; ++i) p.in[i] = (const float*)d_in[i];
  p.pos = (const int*)d_in[2];
  p.out = (float*)d_out;
  p.ws = (char*)d_ws;
  hipMemsetAsync((char*)d_ws + OFF_BAR, 0, 16384, stream);
  void* args[] = {&p};
  hipError_t e = hipLaunchCooperativeKernel((void*)mega_kernel, dim3(grid_blocks), dim3(256), args, 0, stream);
  if (e != hipSuccess) fprintf(stderr, "cooperative launch failed: %s (grid %d)\n", hipGetErrorString(e), grid_blocks);
}
```

```cpp
#include <hip/hip_runtime.h>
#include <hip/hip_cooperative_groups.h>
#include <cstdio>
#include <cstdint>
namespace cg = cooperative_groups;

typedef unsigned short bf16_t;
using bf16x8 = __attribute__((ext_vector_type(8))) short;
using s16x4 = __attribute__((ext_vector_type(4))) short;
using f32x4 = __attribute__((ext_vector_type(4))) float;
using f32x16 = __attribute__((ext_vector_type(16))) float;
using u32x4 = __attribute__((ext_vector_type(4))) unsigned;
#define DI __device__ __forceinline__

constexpr int T_ALL = 16384, SEQ = 4096, DM = 1024, TH = 8192;
constexpr int P_IN = 8896, GATE_OFF = 4800;
constexpr int PLD = 4864;
constexpr int PC_HG = 512, PC_S5 = 2560, PC_RW = 3072;
constexpr int D_FF = 2816;

constexpr size_t al256(size_t x) { return (x + 255) & ~(size_t)255; }
constexpr size_t OFF_WIN = 0;
constexpr size_t OFF_WQ = OFF_WIN + al256((size_t)P_IN * 1024 * 2);
constexpr size_t OFF_WBR = OFF_WQ + al256((size_t)768 * 256 * 2);
constexpr size_t OFF_WOUT = OFF_WBR + al256((size_t)4 * 1024 * 512 * 2);
constexpr size_t OFF_WGLU = OFF_WOUT + al256((size_t)1024 * 1024 * 2);
constexpr size_t OFF_WWUP = OFF_WGLU + al256((size_t)512 * 512 * 2);
constexpr size_t OFF_WAUP = OFF_WWUP + al256((size_t)512 * 64 * 2);
constexpr size_t OFF_WGUP = OFF_WAUP + al256((size_t)512 * 64 * 2);
constexpr size_t OFF_WV = OFF_WGUP + al256((size_t)512 * 128 * 2);
constexpr size_t OFF_WXKV = OFF_WV + al256((size_t)512 * 1024 * 2);
constexpr size_t OFF_S5AB = OFF_WXKV + al256((size_t)2048 * 1024 * 2);
constexpr size_t OFF_S5BB = OFF_S5AB + al256((size_t)32 * 64 * 2 * 4);
constexpr size_t OFF_H = OFF_S5BB + al256((size_t)32 * 64 * 32 * 4);
constexpr size_t OFF_VFIRST = OFF_H + al256((size_t)T_ALL * 1024 * 2);
constexpr size_t OFF_KX = OFF_VFIRST + al256((size_t)T_ALL * 512 * 2);
constexpr size_t OFF_VXT = OFF_KX + al256((size_t)16 * 256 * 256 * 2);
constexpr size_t OFF_HM = OFF_VXT + al256((size_t)16 * 256 * 256 * 2);
constexpr size_t OFF_COS = OFF_HM + al256((size_t)1024 * 1024 * 2);
constexpr size_t OFF_SIN = OFF_COS + al256((size_t)TH * 32 * 4);
constexpr size_t OFF_BAR = OFF_SIN + al256((size_t)TH * 32 * 4);
constexpr size_t OFF_REG = OFF_BAR + 16384;
constexpr size_t R_P = OFF_REG;
constexpr size_t R_CQN = R_P + al256((size_t)TH * PLD * 2);
constexpr size_t R_QP = R_CQN + (size_t)TH * 256 * 2;
constexpr size_t R_KVLAT = R_QP + al256((size_t)TH * 768 * 2);
constexpr size_t R_VT = R_KVLAT + al256((size_t)TH * 192 * 2);
constexpr size_t R_RKV = R_VT + al256((size_t)2 * 128 * 4096 * 2);
constexpr size_t R_YRW = R_RKV + al256((size_t)TH * 1536 * 2);
constexpr size_t R_ZS5 = R_YRW + al256((size_t)TH * 512 * 2);
constexpr size_t R_ALORA = R_ZS5 + al256((size_t)TH * 512 * 2);
constexpr size_t R_G8 = R_ALORA;
constexpr size_t R_END1 = R_G8 + al256((size_t)TH * 4096);
static_assert(R_END1 <= ((size_t)256 << 20), "workspace plan exceeds the guaranteed 256 MiB");
constexpr size_t R_YBR = R_CQN;
constexpr size_t R_WXQ = OFF_REG;
constexpr size_t R_WXO = R_WXQ + al256((size_t)1024 * 1024 * 2);
constexpr size_t R_WGU = R_WXO + al256((size_t)1024 * 1024 * 2);
constexpr size_t R_WDOWN = R_WGU + al256((size_t)5632 * 1024 * 2);
constexpr size_t R_QX = R_WDOWN + al256((size_t)1024 * 2816 * 2);
constexpr size_t R_OX = R_QX + al256((size_t)T_ALL * 1024 * 2);
constexpr size_t R_GU = R_QX;
constexpr size_t R_END2 = R_GU + al256((size_t)TH * 5632 * 2);
constexpr size_t WS_NEED = (R_END1 > R_END2 ? R_END1 : R_END2);

constexpr int SMEM_BYTES = 73728;

struct Params {
  const float* in[51];
  const int* pos;
  float* out;
  char* ws;
};

DI bf16_t f2bf(float x) { return __builtin_bit_cast(unsigned short, (__bf16)x); }
DI float bf2f(bf16_t b) { return __uint_as_float(((unsigned)b) << 16); }
typedef __bf16 bf16v2_t __attribute__((ext_vector_type(2)));
typedef float f32v2_t __attribute__((ext_vector_type(2)));
DI unsigned pack2(float a, float b) { const f32v2_t v = {a, b}; return __builtin_bit_cast(unsigned, __builtin_convertvector(v, bf16v2_t)); }
DI float bflo(unsigned u) { return __uint_as_float(u << 16); }
DI float bfhi(unsigned u) { return __uint_as_float(u & 0xffff0000u); }
DI float sigm(float x) { return __builtin_amdgcn_rcpf(1.f + __expf(-x)); }
template <int CTRL> DI float dppf(float v) {
  return __builtin_bit_cast(float, __builtin_amdgcn_update_dpp(0, __builtin_bit_cast(int, v), CTRL, 0xf, 0xf, false));
}
DI float red8(float v) { v += dppf<0xB1>(v); v += dppf<0x4E>(v); v += dppf<0x141>(v); return v; }
DI float red16(float v) { v = red8(v); v += dppf<0x140>(v); return v; }
DI int TID() { int t = threadIdx.x; asm volatile("" : "+v"(t)); return t; }
#define PHASE_IDS const int tid = TID(); const int lane = tid & 63, wave = tid >> 6; (void)lane; (void)wave;
DI const bf16_t* uniform_ptr(const bf16_t* p) {
  const unsigned long long v = (unsigned long long)p;
  const unsigned lo = __builtin_amdgcn_readfirstlane((unsigned)v), hi = __builtin_amdgcn_readfirstlane((unsigned)(v >> 32));
  return (const bf16_t*)(((unsigned long long)hi << 32) | lo);
}
DI float wave_sum(float v) { for (int o = 32; o > 0; o >>= 1) v += __shfl_xor(v, o); return v; }


#define XB_TMO      128
#define XB_XCNT(j)  (256  + 64 * (j))
#define XB_XSUB(j)  (1280 + 64 * (j))
#define XB_XGEN(j)  (2304 + 64 * (j))
#define XB_TOP      3328
#define XB_TOPGEN   3392
#define XCD_BAR_WORDS 3456
#define XB_SPIN_CAP (1u << 22)
#define LAS __attribute__((address_space(3)))
DI unsigned xb_ld(unsigned* p) { return __hip_atomic_load(p, __ATOMIC_RELAXED, __HIP_MEMORY_SCOPE_AGENT); }
DI unsigned xb_add(unsigned* p, unsigned v) { return __hip_atomic_fetch_add(p, v, __ATOMIC_RELAXED, __HIP_MEMORY_SCOPE_AGENT); }
DI unsigned xb_xcc_id() { return (unsigned)__builtin_amdgcn_s_getreg((3 << 11) | 20) & 0xFu; }
#define XB_SPIN(cond, bar) do { unsigned _sp = 0; while (cond) { __builtin_amdgcn_s_sleep(1); \
    if ((++_sp & 255u) == 0u) { if (xb_ld(&(bar)[XB_TMO])) break; if (_sp > XB_SPIN_CAP) { atomicAdd(&(bar)[XB_TMO], 1u); break; } } } } while (0)
struct XcdBarrier { unsigned* bar; unsigned x; volatile LAS unsigned* st; };
DI XcdBarrier xcd_barrier_post(unsigned* bar, volatile LAS unsigned* st) {
  XcdBarrier b; b.bar = bar; b.x = xb_xcc_id(); b.st = st;
  if (threadIdx.x == 0) (void)xb_add(&bar[XB_XCNT(b.x)], 1u);
  return b;
}
DI void xcd_barrier_complete(unsigned* bar, unsigned x, unsigned& nloc, unsigned& nx) {
  const unsigned G = gridDim.x * gridDim.y * gridDim.z;
  unsigned sum, cnt, mine, sp = 0u;
  for (;;) {
    sum = 0u; cnt = 0u; mine = 0u;
#pragma unroll
    for (unsigned j = 0; j < 16; ++j) { const unsigned c = xb_ld(&bar[XB_XCNT(j)]); sum += c; cnt += (c > 0u) ? 1u : 0u; mine = (j == x) ? c : mine; }
    if (sum == G) break;
    __builtin_amdgcn_s_sleep(1);
    if ((++sp & 255u) == 0u) { if (xb_ld(&bar[XB_TMO])) break; if (sp > XB_SPIN_CAP) { atomicAdd(&bar[XB_TMO], 1u); break; } }
  }
  nloc = mine > 0u ? mine : 1u; nx = cnt > 0u ? cnt : 1u;
}
DI void xcd_barrier(const XcdBarrier& b) {
  asm volatile("s_waitcnt vmcnt(0)" ::: "memory");
  __syncthreads();
  if (threadIdx.x == 0) {
    unsigned* bar = b.bar;
    __builtin_amdgcn_s_waitcnt(0);
    unsigned nloc = b.st[0], nx = b.st[1];
    if (nloc == 0u) { xcd_barrier_complete(bar, b.x, nloc, nx); b.st[0] = nloc; b.st[1] = nx; }
    const unsigned old = xb_add(&bar[XB_XSUB(b.x)], 1u);
    const unsigned gen = old / nloc;
    if (old + 1u == (gen + 1u) * nloc) {
      __builtin_amdgcn_fence(__ATOMIC_RELEASE, "agent");
      asm volatile("s_waitcnt vmcnt(0)" ::: "memory");
      const unsigned og = xb_add(&bar[XB_TOP], 1u);
      const unsigned tg = og / nx;
      if (og + 1u == (tg + 1u) * nx) xb_add(&bar[XB_TOPGEN], 1u);
      else XB_SPIN(xb_ld(&bar[XB_TOPGEN]) == tg, bar);
      __builtin_amdgcn_fence(__ATOMIC_ACQUIRE, "agent");
      xb_add(&bar[XB_XGEN(b.x)], 1u);
      asm volatile("s_waitcnt vmcnt(0)" ::: "memory");
    } else {
      XB_SPIN(xb_ld(&bar[XB_XGEN(b.x)]) == gen, bar);
      __builtin_amdgcn_fence(__ATOMIC_ACQUIRE, "agent");
      asm volatile("s_waitcnt vmcnt(0)" ::: "memory");
    }
  }
  __syncthreads();
}

#define GLOAD16(dst, ptr) asm volatile("global_load_dwordx4 %0, %1, off" : "=v"(dst) : "v"(ptr))
template <int BN>
DI void gemm_acc(const bf16_t* __restrict__ A, int lda, const bf16_t* __restrict__ Bt, int ldb, int K, char* smem,
                 f32x4 (&acc)[4][BN / 32], const bf16_t* __restrict__ An, int ldan, const bf16_t* __restrict__ Bn, int ldbn,
                 bool pre, int& par) {
  constexpr int A_EL = 128 * 72, B_EL = BN * 72, BUF_EL = A_EL + B_EL;
  constexpr int NJ = BN / 32, BCH = BN / 32;
  bf16_t* sm = (bf16_t*)smem;
  const int tid = TID(), lane = tid & 63, wave = tid >> 6;
  const int wm = wave >> 1, wn = wave & 1, l16 = lane & 15, quad = lane >> 4;
  const int crow = tid >> 3, ccol = (tid & 7) * 8;
  u32x4 ra[4], rb[BCH];
  const bf16_t* Ap = A + (size_t)crow * lda + ccol;
  const bf16_t* Bp = Bt + (size_t)crow * ldb + ccol;
  const bf16_t* Apn = An + (size_t)crow * ldan + ccol;
  const bf16_t* Bpn = Bn + (size_t)crow * ldbn + ccol;
  const int nk = K >> 6;
#define GEMM_ISSUE(ap_, sa_, bp_, sb_)                                                            \
  {                                                                                               \
    _Pragma("unroll") for (int i = 0; i < 4; ++i) GLOAD16(ra[i], (ap_) + (size_t)(32 * i) * (sa_));      \
    _Pragma("unroll") for (int i = 0; i < BCH; ++i) GLOAD16(rb[i], (bp_) + (size_t)(32 * i) * (sb_));    \
  }
#define GEMM_LAND(buf_)                                                                           \
  {                                                                                               \
    if constexpr (BCH == 4)                                                                       \
      asm volatile("s_waitcnt vmcnt(0)" : "+v"(ra[0]), "+v"(ra[1]), "+v"(ra[2]), "+v"(ra[3]), "+v"(rb[0]), "+v"(rb[1]), "+v"(rb[2]), "+v"(rb[3])); \
    else                                                                                          \
      asm volatile("s_waitcnt vmcnt(0)" : "+v"(ra[0]), "+v"(ra[1]), "+v"(ra[2]), "+v"(ra[3]), "+v"(rb[0]), "+v"(rb[1])); \
    bf16_t* sa_ = sm + (buf_) * BUF_EL; bf16_t* sb_ = sa_ + A_EL;                                 \
    _Pragma("unroll") for (int i = 0; i < 4; ++i) *(u32x4*)(sa_ + (crow + 32 * i) * 72 + ccol) = ra[i];   \
    _Pragma("unroll") for (int i = 0; i < BCH; ++i) *(u32x4*)(sb_ + (crow + 32 * i) * 72 + ccol) = rb[i]; \
  }
  if (!pre) {
    GEMM_ISSUE(Ap, lda, Bp, ldb);
    GEMM_LAND(par);
    __syncthreads();
  }
  for (int kt = 0; kt < nk; ++kt) {
    {
      const bool inner = (kt + 1 < nk);
      const bf16_t* ap = inner ? Ap + ((kt + 1) << 6) : Apn;
      const bf16_t* bp = inner ? Bp + ((kt + 1) << 6) : Bpn;
      const int sa = inner ? lda : ldan, sb = inner ? ldb : ldbn;
      GEMM_ISSUE(ap, sa, bp, sb);
    }
    __builtin_amdgcn_sched_barrier(0);
    {
      const bf16_t* sa = sm + ((par + kt) & 1) * BUF_EL; const bf16_t* sb = sa + A_EL;
      __builtin_amdgcn_s_setprio(2);
#pragma unroll
      for (int ks = 0; ks < 2; ++ks) {
        bf16x8 a[4], b[NJ];
#pragma unroll
        for (int i = 0; i < 4; ++i) a[i] = *(const bf16x8*)(sa + (wm * 64 + i * 16 + l16) * 72 + ks * 32 + quad * 8);
#pragma unroll
        for (int j = 0; j < NJ; ++j) b[j] = *(const bf16x8*)(sb + (wn * (BN / 2) + j * 16 + l16) * 72 + ks * 32 + quad * 8);
        __builtin_amdgcn_s_setprio(3);
#pragma unroll
        for (int i = 0; i < 4; ++i)
#pragma unroll
          for (int j = 0; j < NJ; ++j) acc[i][j] = __builtin_amdgcn_mfma_f32_16x16x32_bf16(b[j], a[i], acc[i][j], 0, 0, 0);
        __builtin_amdgcn_s_setprio(2);
      }
      __builtin_amdgcn_s_setprio(0);
    }
    __builtin_amdgcn_sched_barrier(0);
    GEMM_LAND((par + kt + 1) & 1);
    __syncthreads();
  }
  par = (par + nk) & 1;
#undef GEMM_ISSUE
#undef GEMM_LAND
}
template <int BN>
DI void gemm_acc(const bf16_t* __restrict__ A, int lda, const bf16_t* __restrict__ Bt, int ldb, int K, char* smem,
                 f32x4 (&acc)[4][BN / 32]) {
  int par = 0;
  gemm_acc<BN>(A, lda, Bt, ldb, K, smem, acc, A, lda, Bt, ldb, false, par);
}
template <int NJ> DI void zero_acc(f32x4 (&acc)[4][NJ]) {
#pragma unroll
  for (int i = 0; i < 4; ++i)
#pragma unroll
    for (int j = 0; j < NJ; ++j) acc[i][j] = f32x4{0.f, 0.f, 0.f, 0.f};
}
#define EPI_FOR(BN_)                                                                         \
  const int _t = TID(); const int _lane = _t & 63, _wave = _t >> 6;                              \
  const int _wm = _wave >> 1, _wn = _wave & 1, _l16 = _lane & 15, _quad = _lane >> 4;        \
  _Pragma("unroll") for (int i = 0; i < 4; ++i)                                              \
  _Pragma("unroll") for (int j = 0; j < (BN_) / 32; ++j)                                     \
  _Pragma("unroll") for (int r = 0; r < 4; ++r)
#define EPI_ROW (_wm * 64 + i * 16 + _l16)
#define EPI_COL(BN_) (_wn * ((BN_) / 2) + j * 16 + _quad * 4 + r)
#define EPI4_FOR(BN_)                                                                        \
  const int _t = TID(); const int _lane = _t & 63, _wave = _t >> 6;                          \
  const int _wm = _wave >> 1, _wn = _wave & 1, _l16 = _lane & 15, _quad = _lane >> 4;        \
  _Pragma("unroll") for (int i = 0; i < 4; ++i)                                              \
  _Pragma("unroll") for (int j = 0; j < (BN_) / 32; ++j)
#define EPI4_COL(BN_) (_wn * ((BN_) / 2) + j * 16 + _quad * 4)
DI uint2 pack4(f32x4 v) { uint2 o; o.x = pack2(v[0], v[1]); o.y = pack2(v[2], v[3]); return o; }
DI f32x4 unpack4(uint2 u) { return f32x4{bflo(u.x), bfhi(u.x), bflo(u.y), bfhi(u.y)}; }

DI void transpose_tile(const float* __restrict__ W, int ldw, bf16_t* __restrict__ Wt, int ldt, int k0, int n0, char* smem) {
  float* sm = (float*)smem;
  const int tid = TID();
  __syncthreads();
#pragma unroll
  for (int i = 0; i < 4; ++i) {
    const int k = (tid >> 4) + 16 * i, n4 = (tid & 15) * 4;
    const float4 v = *(const float4*)(W + (size_t)(k0 + k) * ldw + n0 + n4);
    sm[k * 65 + n4 + 0] = v.x; sm[k * 65 + n4 + 1] = v.y; sm[k * 65 + n4 + 2] = v.z; sm[k * 65 + n4 + 3] = v.w;
  }
  __syncthreads();
  const int n = tid >> 2, ks = (tid & 3) * 16;
  unsigned u[8];
#pragma unroll
  for (int e = 0; e < 8; ++e) u[e] = pack2(sm[(ks + 2 * e) * 65 + n], sm[(ks + 2 * e + 1) * 65 + n]);
  uint4* dst = (uint4*)(Wt + (size_t)(n0 + n) * ldt + k0 + ks);
  dst[0] = uint4{u[0], u[1], u[2], u[3]};
  dst[1] = uint4{u[4], u[5], u[6], u[7]};
}
DI void transpose_all(const float* W, int ldw, int K, int N, bf16_t* Wt, int bid, int nb, char* smem) {
  const int tk = K >> 6, tn = N >> 6;
  for (int t = bid; t < tk * tn; t += nb) transpose_tile(W, ldw, Wt, K, (t % tk) * 64, (t / tk) * 64, smem);
}

DI void rmsnorm_rows(const float* __restrict__ x, const float* __restrict__ g, bf16_t* __restrict__ h, float* xcopy, int rows,
                     int bid, int nb) {
  const int lane = TID() & 63, wave = TID() >> 6;
  for (int r = bid * 4 + wave; r < rows; r += nb * 4) {
    const float4* xr = (const float4*)(x + (size_t)r * 1024);
    float4 v[4]; float ss = 0.f;
#pragma unroll
    for (int i = 0; i < 4; ++i) { v[i] = xr[lane + 64 * i]; ss += v[i].x * v[i].x + v[i].y * v[i].y + v[i].z * v[i].z + v[i].w * v[i].w; }
    ss = wave_sum(ss);
    const float rs = rsqrtf(ss * (1.f / 1024.f) + 1e-6f);
#pragma unroll
    for (int i = 0; i < 4; ++i) {
      const float4 gg = ((const float4*)g)[lane + 64 * i];
      uint2 o; o.x = pack2(v[i].x * rs * gg.x, v[i].y * rs * gg.y); o.y = pack2(v[i].z * rs * gg.z, v[i].w * rs * gg.w);
      *(uint2*)(h + (size_t)r * 1024 + (lane + 64 * i) * 4) = o;
      if (xcopy) ((float4*)(xcopy + (size_t)r * 1024))[lane + 64 * i] = v[i];
    }
  }
}

template <int DQK, bool CAUSAL>
DI void attn_item(const bf16_t* __restrict__ Q, int ldq, const bf16_t* __restrict__ Kp, int ldk, const bf16_t* __restrict__ VT, int ldvt,
                  int ntiles, int q0, bf16_t* __restrict__ out, int ldo, char* smem) {
  constexpr int KS = DQK + 8, NS = DQK / 16, KCH = DQK / 8;
  bf16_t* Ks = (bf16_t*)smem;
  bf16_t* Vs = Ks + 64 * KS;
  const int tid = TID(), lane = tid & 63, wave = tid >> 6, ql = lane & 31, hh = lane >> 5;
  const int qrow = q0 + wave * 32 + ql;
  bf16x8 bq[NS];
#pragma unroll
  for (int s = 0; s < NS; ++s) bq[s] = *(const bf16x8*)(Q + (size_t)qrow * ldq + s * 16 + hh * 8);
  f32x16 ot[4];
#pragma unroll
  for (int d = 0; d < 4; ++d)
#pragma unroll
    for (int i = 0; i < 16; ++i) ot[d][i] = 0.f;
  float mrun = -INFINITY, lrun = 0.f;
  for (int kt = 0; kt < ntiles; ++kt) {
    __syncthreads();
    for (int c = tid; c < 64 * KCH; c += 256) {
      const int row = c / KCH, cc = c % KCH;
      *(uint4*)(Ks + row * KS + cc * 8) = *(const uint4*)(Kp + (size_t)(kt * 64 + row) * ldk + cc * 8);
    }
#pragma unroll
    for (int c0 = 0; c0 < 4; ++c0) {
      const int c = tid + c0 * 256, row = c >> 3, cc = c & 7;
      *(uint4*)(Vs + row * 72 + cc * 8) = *(const uint4*)(VT + (size_t)row * ldvt + kt * 64 + cc * 8);
    }
    __syncthreads();
    f32x16 st[2];
#pragma unroll
    for (int kb = 0; kb < 2; ++kb) {
#pragma unroll
      for (int i = 0; i < 16; ++i) st[kb][i] = 0.f;
#pragma unroll
      for (int s = 0; s < NS; ++s) {
        const bf16x8 a = *(const bf16x8*)(Ks + (kb * 32 + ql) * KS + s * 16 + hh * 8);
        st[kb] = __builtin_amdgcn_mfma_f32_32x32x16_bf16(a, bq[s], st[kb], 0, 0, 0);
      }
    }
    float mx = -INFINITY;
#pragma unroll
    for (int kb = 0; kb < 2; ++kb)
#pragma unroll
      for (int i = 0; i < 16; ++i) {
        if (CAUSAL) {
          const int key = kt * 64 + kb * 32 + (i & 3) + 8 * (i >> 2) + 4 * hh;
          if (key > qrow) st[kb][i] = -INFINITY;
        }
        mx = fmaxf(mx, st[kb][i]);
      }
    mx = fmaxf(mx, __shfl_xor(mx, 32));
    const float mnew = fmaxf(mrun, mx);
    const float alpha = __builtin_amdgcn_exp2f(mrun - mnew);
    float ps = 0.f;
#pragma unroll
    for (int kb = 0; kb < 2; ++kb)
#pragma unroll
      for (int i = 0; i < 16; ++i) { const float pv = __builtin_amdgcn_exp2f(st[kb][i] - mnew); st[kb][i] = pv; ps += pv; }
    ps += __shfl_xor(ps, 32);
    lrun = lrun * alpha + ps;
    mrun = mnew;
#pragma unroll
    for (int d = 0; d < 4; ++d)
#pragma unroll
      for (int i = 0; i < 16; ++i) ot[d][i] *= alpha;
#pragma unroll
    for (int kb = 0; kb < 2; ++kb)
#pragma unroll
      for (int s2 = 0; s2 < 2; ++s2) {
        unsigned pk[4];
#pragma unroll
        for (int e = 0; e < 4; ++e) pk[e] = pack2(st[kb][8 * s2 + 2 * e], st[kb][8 * s2 + 2 * e + 1]);
        const bf16x8 pb = __builtin_bit_cast(bf16x8, uint4{pk[0], pk[1], pk[2], pk[3]});
#pragma unroll
        for (int d = 0; d < 4; ++d) {
          const bf16_t* vp = Vs + (d * 32 + ql) * 72 + kb * 32 + s2 * 16 + hh * 4;
          const s16x4 lo = *(const s16x4*)vp;
          const s16x4 hi = *(const s16x4*)(vp + 8);
          const bf16x8 av = __builtin_shufflevector(lo, hi, 0, 1, 2, 3, 4, 5, 6, 7);
          ot[d] = __builtin_amdgcn_mfma_f32_32x32x16_bf16(av, pb, ot[d], 0, 0, 0);
        }
      }
  }
  const float inv = 1.f / lrun;
#pragma unroll
  for (int d = 0; d < 4; ++d)
#pragma unroll
    for (int g4 = 0; g4 < 4; ++g4) {
      uint2 o; o.x = pack2(ot[d][4 * g4] * inv, ot[d][4 * g4 + 1] * inv); o.y = pack2(ot[d][4 * g4 + 2] * inv, ot[d][4 * g4 + 3] * inv);
      *(uint2*)(out + (size_t)qrow * ldo + d * 32 + 8 * g4 + 4 * hh) = o;
    }
}


template <int DQK, bool CAUSAL>
DI void attn_item_pf(const bf16_t* __restrict__ Q, int ldq, const bf16_t* Kp, int ldk, const bf16_t* VT, int ldvt,
                  int ntiles, int q0, bf16_t* __restrict__ out, int ldo, char* smem) {
  constexpr int KS = DQK + 8, NS = DQK / 16, KCH = DQK / 8;
  bf16_t* Ks = (bf16_t*)smem;
  bf16_t* Vs = Ks + 64 * KS;
  const int tid = TID(), lane = tid & 63, wave = tid >> 6, ql = lane & 31, hh = lane >> 5;
  const int qrow = q0 + wave * 32 + ql;
  bf16x8 bq[NS];
#pragma unroll
  for (int s = 0; s < NS; ++s) bq[s] = *(const bf16x8*)(Q + (size_t)qrow * ldq + s * 16 + hh * 8);
  f32x16 ot[4];
#pragma unroll
  for (int d = 0; d < 4; ++d)
#pragma unroll
    for (int i = 0; i < 16; ++i) ot[d][i] = 0.f;
  float mrun = -INFINITY, lrun = 0.f;
  Kp = uniform_ptr(Kp); VT = uniform_ptr(VT);
  constexpr int KR = KCH / 4;
  static_assert(KR == 6, "prefetch variant is written for DQK = 192");
  u32x4 kreg[KR], vreg[4];
  const unsigned kvoff = (unsigned)(((tid >> 2) * ldk + (tid & 3) * 8) * 2);
  const unsigned vvoff = (unsigned)(((tid >> 3) * ldvt + (tid & 7) * 8) * 2);
#define GLOADS(dst, voff, sbase) asm volatile("global_load_dwordx4 %0, %1, %2" : "=v"(dst) : "v"(voff), "s"(sbase))
#define ATT_ISSUE(kt_)                                                                                        \
  {                                                                                                           \
    _Pragma("unroll") for (int c0 = 0; c0 < KR; ++c0) GLOADS(kreg[c0], kvoff, Kp + (size_t)(kt_) * 64 * ldk + c0 * 32);   \
    _Pragma("unroll") for (int c0 = 0; c0 < 4; ++c0) GLOADS(vreg[c0], vvoff, VT + (size_t)(c0 * 32) * ldvt + (kt_) * 64); \
  }
#define ATT_LAND()                                                                                            \
  {                                                                                                           \
    asm volatile("s_waitcnt vmcnt(0)" : "+v"(kreg[0]), "+v"(kreg[1]), "+v"(kreg[2]), "+v"(kreg[3]), "+v"(kreg[4]), "+v"(kreg[5]), \
                 "+v"(vreg[0]), "+v"(vreg[1]), "+v"(vreg[2]), "+v"(vreg[3]));                                 \
    _Pragma("unroll") for (int c0 = 0; c0 < KR; ++c0) *(u32x4*)(Ks + (tid >> 2) * KS + ((tid & 3) + 4 * c0) * 8) = kreg[c0];   \
    _Pragma("unroll") for (int c0 = 0; c0 < 4; ++c0) *(u32x4*)(Vs + ((tid >> 3) + 32 * c0) * 72 + (tid & 7) * 8) = vreg[c0];   \
  }
  __syncthreads();
  ATT_ISSUE(0);
  ATT_LAND();
  __syncthreads();
  for (int kt = 0; kt < ntiles; ++kt) {
    {
      const int ktn = (kt + 1 < ntiles) ? kt + 1 : kt;
      ATT_ISSUE(ktn);
    }
    __builtin_amdgcn_sched_barrier(0);
    f32x16 st[2];
#pragma unroll
    for (int kb = 0; kb < 2; ++kb) {
#pragma unroll
      for (int i = 0; i < 16; ++i) st[kb][i] = 0.f;
#pragma unroll
      for (int s = 0; s < NS; ++s) {
        const bf16x8 a = *(const bf16x8*)(Ks + (kb * 32 + ql) * KS + s * 16 + hh * 8);
        st[kb] = __builtin_amdgcn_mfma_f32_32x32x16_bf16(a, bq[s], st[kb], 0, 0, 0);
      }
    }
    float mx = -INFINITY;
#pragma unroll
    for (int kb = 0; kb < 2; ++kb)
#pragma unroll
      for (int i = 0; i < 16; ++i) {
        if (CAUSAL) {
          const int key = kt * 64 + kb * 32 + (i & 3) + 8 * (i >> 2) + 4 * hh;
          if (key > qrow) st[kb][i] = -INFINITY;
        }
        mx = fmaxf(mx, st[kb][i]);
      }
    mx = fmaxf(mx, __shfl_xor(mx, 32));
    const float mnew = fmaxf(mrun, mx);
    const float alpha = __builtin_amdgcn_exp2f(mrun - mnew);
    float ps = 0.f;
#pragma unroll
    for (int kb = 0; kb < 2; ++kb)
#pragma unroll
      for (int i = 0; i < 16; ++i) { const float pv = __builtin_amdgcn_exp2f(st[kb][i] - mnew); st[kb][i] = pv; ps += pv; }
    ps += __shfl_xor(ps, 32);
    lrun = lrun * alpha + ps;
    mrun = mnew;
#pragma unroll
    for (int d = 0; d < 4; ++d)
#pragma unroll
      for (int i = 0; i < 16; ++i) ot[d][i] *= alpha;
#pragma unroll
    for (int kb = 0; kb < 2; ++kb)
#pragma unroll
      for (int s2 = 0; s2 < 2; ++s2) {
        unsigned pk[4];
#pragma unroll
        for (int e = 0; e < 4; ++e) pk[e] = pack2(st[kb][8 * s2 + 2 * e], st[kb][8 * s2 + 2 * e + 1]);
        const bf16x8 pb = __builtin_bit_cast(bf16x8, uint4{pk[0], pk[1], pk[2], pk[3]});
#pragma unroll
        for (int d = 0; d < 4; ++d) {
          const bf16_t* vp = Vs + (d * 32 + ql) * 72 + kb * 32 + s2 * 16 + hh * 4;
          const s16x4 lo = *(const s16x4*)vp;
          const s16x4 hi = *(const s16x4*)(vp + 8);
          const bf16x8 av = __builtin_shufflevector(lo, hi, 0, 1, 2, 3, 4, 5, 6, 7);
          ot[d] = __builtin_amdgcn_mfma_f32_32x32x16_bf16(av, pb, ot[d], 0, 0, 0);
        }
      }
    __builtin_amdgcn_sched_barrier(0);
    __syncthreads();
    ATT_LAND();
    __syncthreads();
  }
#undef ATT_ISSUE
#undef ATT_LAND
#undef GLOADS
  const float inv = 1.f / lrun;
#pragma unroll
  for (int d = 0; d < 4; ++d)
#pragma unroll
    for (int g4 = 0; g4 < 4; ++g4) {
      uint2 o; o.x = pack2(ot[d][4 * g4] * inv, ot[d][4 * g4 + 1] * inv); o.y = pack2(ot[d][4 * g4 + 2] * inv, ot[d][4 * g4 + 3] * inv);
      *(uint2*)(out + (size_t)qrow * ldo + d * 32 + 8 * g4 + 4 * hh) = o;
    }
}

DI void rwkv_scan_unit(const Params& p, int l, int u, char* smem) {
  const int tid = TID();
  const int bl = u >> 5, hd = (u >> 2) & 7, rg = u & 3;
  const int kq = tid & 15, g16 = tid >> 4;
  const bf16_t* RKV = (const bf16_t*)(p.ws + R_RKV) + (size_t)bl * SEQ * 1536;
  const bf16_t* Pm = (const bf16_t*)(p.ws + R_P) + (size_t)bl * SEQ * PLD;
  bf16_t* Y = (bf16_t*)(p.ws + R_YRW) + (size_t)bl * SEQ * 512;
  float* sm = (float*)smem;
  constexpr int BUFF = 5 * 1024 + 256 + 32;
  const int kc = hd * 64 + kq * 4;
  const float4 kk_w = *(const float4*)(p.in[27] + l * 512 + kc);
  const float4 ka_w = *(const float4*)(p.in[28] + l * 512 + kc);
  f32v2_t SA = {0.f, 0.f}, SB = {0.f, 0.f};
  uint2 g_r, g_k, g_w, g_a; bf16_t g_v;
  auto gload = [&](int c) {
    const int tok = c * 16 + g16;
    g_r = *(const uint2*)(RKV + (size_t)tok * 1536 + kc);
    g_k = *(const uint2*)(RKV + (size_t)tok * 1536 + 512 + kc);
    g_v = RKV[(size_t)tok * 1536 + 1024 + hd * 64 + rg * 16 + kq];
    g_w = *(const uint2*)(Pm + (size_t)tok * PLD + PC_RW + kc);
    g_a = *(const uint2*)(Pm + (size_t)tok * PLD + PC_RW + 512 + kc);
  };
  auto derive = [&](int buf) {
    float* b = sm + buf * BUFF;
    const float r[4] = {bflo(g_r.x), bfhi(g_r.x), bflo(g_r.y), bfhi(g_r.y)};
    const float k[4] = {bflo(g_k.x), bfhi(g_k.x), bflo(g_k.y), bfhi(g_k.y)};
    const float w[4] = {bflo(g_w.x), bfhi(g_w.x), bflo(g_w.y), bfhi(g_w.y)};
    const float a[4] = {bflo(g_a.x), bfhi(g_a.x), bflo(g_a.y), bfhi(g_a.y)};
    const float kkw[4] = {kk_w.x, kk_w.y, kk_w.z, kk_w.w};
    const float kaw[4] = {ka_w.x, ka_w.y, ka_w.z, ka_w.w};
    float kk[4], ss = 0.f;
#pragma unroll
    for (int e = 0; e < 4; ++e) { kk[e] = k[e] * kkw[e]; ss += kk[e] * kk[e]; }
    ss = red16(ss);
    const float rn = rsqrtf(ss + 1e-12f);
    float dwr[4], dw[4], dk[4], dn[4], db[4];
    float br = 0.f, khr = 0.f;
#pragma unroll
    for (int e = 0; e < 4; ++e) {
      dw[e] = __expf(w[e]);
      const float kn = kk[e] * rn;
      dn[e] = -kn; db[e] = kn * a[e];
      dk[e] = k[e] * (1.f + (a[e] - 1.f) * kaw[e]);
      dwr[e] = dw[e] * r[e];
      br += db[e] * r[e]; khr += dk[e] * r[e];
    }
    br = red16(br); khr = red16(khr);
#pragma unroll
    for (int e = 0; e < 4; ++e) dwr[e] += dn[e] * br;
    *(float4*)(b + 0 * 1024 + g16 * 64 + kq * 4) = float4{dwr[0], dwr[1], dwr[2], dwr[3]};
    *(float4*)(b + 1 * 1024 + g16 * 64 + kq * 4) = float4{dw[0], dw[1], dw[2], dw[3]};
    *(float4*)(b + 2 * 1024 + g16 * 64 + kq * 4) = float4{dk[0], dk[1], dk[2], dk[3]};
    *(float4*)(b + 3 * 1024 + g16 * 64 + kq * 4) = float4{dn[0], dn[1], dn[2], dn[3]};
    *(float4*)(b + 4 * 1024 + g16 * 64 + kq * 4) = float4{db[0], db[1], db[2], db[3]};
    b[5 * 1024 + g16 * 16 + kq] = bf2f(g_v);
    if (kq == 0) b[5 * 1024 + 256 + g16] = khr;
  };
  __syncthreads();
  gload(0); derive(0);
  __syncthreads();
  constexpr int NC = SEQ / 16;
  for (int c = 0; c < NC; ++c) {
    if (c + 1 < NC) gload(c + 1);
    const float* b = sm + (c & 1) * BUFF;
    float4 nk = *(const float4*)(b + 3 * 1024 + kq * 4);
    float4 w = *(const float4*)(b + 1 * 1024 + kq * 4);
    float4 bb = *(const float4*)(b + 4 * 1024 + kq * 4);
    float4 kh = *(const float4*)(b + 2 * 1024 + kq * 4);
    float4 wr = *(const float4*)(b + 0 * 1024 + kq * 4);
    float v = b[5 * 1024 + g16];
#pragma unroll
    for (int h = 0; h < 2; ++h) {
      float yp[8];
#pragma unroll
      for (int s = 0; s < 8; ++s) {
        const int t = h * 8 + s;
        float4 nk2, w2, bb2, kh2, wr2; float v2;
        if (t < 15) {
          nk2 = *(const float4*)(b + 3 * 1024 + (t + 1) * 64 + kq * 4);
          w2 = *(const float4*)(b + 1 * 1024 + (t + 1) * 64 + kq * 4);
          bb2 = *(const float4*)(b + 4 * 1024 + (t + 1) * 64 + kq * 4);
          kh2 = *(const float4*)(b + 2 * 1024 + (t + 1) * 64 + kq * 4);
          wr2 = *(const float4*)(b + 0 * 1024 + (t + 1) * 64 + kq * 4);
          v2 = b[5 * 1024 + (t + 1) * 16 + g16];
        }
        const f32v2_t nka = {nk.x, nk.y}, nkb = {nk.z, nk.w}, wra = {wr.x, wr.y}, wrb = {wr.z, wr.w};
        const f32v2_t wa = {w.x, w.y}, wb = {w.z, w.w}, ba = {bb.x, bb.y}, bbv = {bb.z, bb.w}, kha = {kh.x, kh.y}, khb = {kh.z, kh.w};
        const f32v2_t ps = SA * nka + SB * nkb;
        const f32v2_t py = SA * wra + SB * wrb;
        float sa = ps.x + ps.y;
        yp[s] = py.x + py.y;
        sa = red16(sa);
        const f32v2_t sa2 = {sa, sa}, vv2 = {v, v};
        SA = SA * wa + (sa2 * ba + vv2 * kha);
        SB = SB * wb + (sa2 * bbv + vv2 * khb);
        if (t < 15) { nk = nk2; w = w2; bb = bb2; kh = kh2; wr = wr2; v = v2; }
      }
      const bool b2 = (kq & 4) != 0, b1 = (kq & 2) != 0, b0 = (kq & 1) != 0;
#pragma unroll
      for (int i = 0; i < 8; ++i) yp[i] += dppf<0x128>(yp[i]);
      float q4[4];
#pragma unroll
      for (int i = 0; i < 4; ++i) { const float keep = b2 ? yp[i + 4] : yp[i], send = b2 ? yp[i] : yp[i + 4]; q4[i] = keep + dppf<0x141>(send); }
      float q2[2];
#pragma unroll
      for (int i = 0; i < 2; ++i) { const float keep = b1 ? q4[i + 2] : q4[i], send = b1 ? q4[i] : q4[i + 2]; q2[i] = keep + dppf<0x4E>(send); }
      const float keep = b0 ? q2[1] : q2[0], send = b0 ? q2[0] : q2[1];
      float yv = keep + dppf<0xB1>(send);
      const int tt = h * 8 + (kq & 7);
      yv += b[5 * 1024 + tt * 16 + g16] * b[5 * 1024 + 256 + tt];
      if ((kq >> 3) == h) Y[(size_t)(c * 16 + tt) * 512 + hd * 64 + rg * 16 + g16] = f2bf(yv);
    }
    if (c + 1 < NC) derive((c + 1) & 1);
    __syncthreads();
  }
}

DI void hgrn_scan_unit(const Params& p, int l, int u, char* smem) {
  const int tid = TID();
  const int bl = u >> 5, hd = (u >> 3) & 3, vg = u & 7;
  const int kq = tid & 15, g16 = tid >> 4;
  bf16_t* Pm = (bf16_t*)(p.ws + R_P) + (size_t)bl * SEQ * PLD;
  float* sm = (float*)smem;
  constexpr int BUFF = 2 * 2048 + 256 + 16;
  const int kc = hd * 128 + kq * 8;
  f32v2_t S2[4];
#pragma unroll
  for (int e = 0; e < 4; ++e) S2[e] = f32v2_t{0.f, 0.f};
  uint4 g_q, g_f; bf16_t g_v;
  const int vcol = PC_HG + 1024 + hd * 128 + vg * 16;
  auto gload = [&](int c) {
    const int tok = c * 16 + g16;
    g_q = *(const uint4*)(Pm + (size_t)tok * PLD + PC_HG + kc);
    g_f = *(const uint4*)(Pm + (size_t)tok * PLD + PC_HG + 512 + kc);
    g_v = Pm[(size_t)tok * PLD + vcol + kq];
  };
  auto derive = [&](int buf) {
    float* b = sm + buf * BUFF;
    const unsigned qu[4] = {g_q.x, g_q.y, g_q.z, g_q.w}, fu[4] = {g_f.x, g_f.y, g_f.z, g_f.w};
    float fq[8], f[8], cs = 0.f;
#pragma unroll
    for (int e = 0; e < 8; ++e) {
      const float q = (e & 1) ? bfhi(qu[e >> 1]) : bflo(qu[e >> 1]);
      const float kf = (e & 1) ? bfhi(fu[e >> 1]) : bflo(fu[e >> 1]);
      f[e] = 1.f - kf;
      fq[e] = f[e] * q;
      cs += kf * q;
    }
    cs = red16(cs);
    *(float4*)(b + g16 * 128 + kq * 8) = float4{fq[0], fq[1], fq[2], fq[3]};
    *(float4*)(b + g16 * 128 + kq * 8 + 4) = float4{fq[4], fq[5], fq[6], fq[7]};
    *(float4*)(b + 2048 + g16 * 128 + kq * 8) = float4{f[0], f[1], f[2], f[3]};
    *(float4*)(b + 2048 + g16 * 128 + kq * 8 + 4) = float4{f[4], f[5], f[6], f[7]};
    b[4096 + g16 * 16 + kq] = bf2f(g_v);
    if (kq == 0) b[4096 + 256 + g16] = cs;
  };
  __syncthreads();
  gload(0); derive(0);
  __syncthreads();
  constexpr int NC = SEQ / 16;
  for (int c = 0; c < NC; ++c) {
    if (c + 1 < NC) gload(c + 1);
    const float* b = sm + (c & 1) * BUFF;
    float4 q0 = *(const float4*)(b + kq * 8), q1 = *(const float4*)(b + kq * 8 + 4);
    float4 f0 = *(const float4*)(b + 2048 + kq * 8), f1 = *(const float4*)(b + 2048 + kq * 8 + 4);
    float v = b[4096 + g16];
#pragma unroll
    for (int h = 0; h < 2; ++h) {
      float yp[8];
#pragma unroll
      for (int s = 0; s < 8; ++s) {
        const int t = h * 8 + s;
        float4 q0n, q1n, f0n, f1n; float vn;
        if (t < 15) {
          q0n = *(const float4*)(b + (t + 1) * 128 + kq * 8); q1n = *(const float4*)(b + (t + 1) * 128 + kq * 8 + 4);
          f0n = *(const float4*)(b + 2048 + (t + 1) * 128 + kq * 8); f1n = *(const float4*)(b + 2048 + (t + 1) * 128 + kq * 8 + 4);
          vn = b[4096 + (t + 1) * 16 + g16];
        }
        const f32v2_t fq2[4] = {{q0.x, q0.y}, {q0.z, q0.w}, {q1.x, q1.y}, {q1.z, q1.w}};
        const f32v2_t ff2[4] = {{f0.x, f0.y}, {f0.z, f0.w}, {f1.x, f1.y}, {f1.z, f1.w}};
        const f32v2_t vv2 = {v, v};
        f32v2_t o2 = S2[0] * fq2[0];
#pragma unroll
        for (int e = 1; e < 4; ++e) o2 = S2[e] * fq2[e] + o2;
#pragma unroll
        for (int e = 0; e < 4; ++e) S2[e] = ff2[e] * (S2[e] - vv2) + vv2;
        yp[s] = o2.x + o2.y;
        if (t < 15) { q0 = q0n; q1 = q1n; f0 = f0n; f1 = f1n; v = vn; }
      }
      const bool b2 = (kq & 4) != 0, b1 = (kq & 2) != 0, b0 = (kq & 1) != 0;
#pragma unroll
      for (int i = 0; i < 8; ++i) yp[i] += dppf<0x128>(yp[i]);
      float q4[4];
#pragma unroll
      for (int i = 0; i < 4; ++i) { const float keep = b2 ? yp[i + 4] : yp[i], send = b2 ? yp[i] : yp[i + 4]; q4[i] = keep + dppf<0x141>(send); }
      float q2[2];
#pragma unroll
      for (int i = 0; i < 2; ++i) { const float keep = b1 ? q4[i + 2] : q4[i], send = b1 ? q4[i] : q4[i + 2]; q2[i] = keep + dppf<0x4E>(send); }
      const float keep = b0 ? q2[1] : q2[0], send = b0 ? q2[0] : q2[1];
      float ov = keep + dppf<0xB1>(send);
      const int tt = h * 8 + (kq & 7);
      ov += b[4096 + tt * 16 + g16] * b[4096 + 256 + tt];
      if ((kq >> 3) == h) Pm[(size_t)(c * 16 + tt) * PLD + vcol + g16] = f2bf(ov);
    }
    if (c + 1 < NC) derive((c + 1) & 1);
    __syncthreads();
  }
}

DI void s5_scan_unit(const Params& p, int l, int u, char* smem) {
  const int tid = TID(), lane = tid & 63, wave = tid >> 6;
  const int idx = u * 4 + wave, bl = idx >> 5, g = idx & 31;
  const bf16_t* Pm = (const bf16_t*)(p.ws + R_P) + (size_t)bl * SEQ * PLD + PC_S5 + g * 16;
  bf16_t* Z = (bf16_t*)(p.ws + R_ZS5) + (size_t)bl * SEQ * 512 + g * 16;
  constexpr int BUS = 132;
  float* buT = (float*)smem + wave * (16 * BUS);
  bf16_t* hist = (bf16_t*)(smem + 4 * 16 * BUS * 4) + wave * (16 * 136);
  const float2 ab = *(const float2*)((const float*)(p.ws + OFF_S5AB) + (g * 64 + lane) * 2);
  const int l16 = lane & 15, quad = lane >> 4;
  bf16x8 bbf[8];
  {
    const float* bbp = (const float*)(p.ws + OFF_S5BB);
#pragma unroll
    for (int jb = 0; jb < 8; ++jb) {
      const int col = jb * 16 + l16, nn = col & 63, im = col >> 6;
      unsigned pk[4] = {0u, 0u, 0u, 0u};
      if (quad < 2) {
        const float* src = bbp + (size_t)(g * 64 + nn) * 32 + im * 16 + quad * 8;
#pragma unroll
        for (int e = 0; e < 4; ++e) pk[e] = pack2(src[2 * e], src[2 * e + 1]);
      }
      bbf[jb] = __builtin_bit_cast(bf16x8, uint4{pk[0], pk[1], pk[2], pk[3]});
    }
  }
  bf16x8 cf[4];
  {
    const float* Cre = p.in[16] + (size_t)l * 32768 + (size_t)(g * 16 + l16) * 64;
    const float* Cim = p.in[17] + (size_t)l * 32768 + (size_t)(g * 16 + l16) * 64;
#pragma unroll
    for (int ks = 0; ks < 4; ++ks) {
      unsigned pk[4];
#pragma unroll
      for (int e = 0; e < 4; ++e) {
        const int k = ks * 32 + quad * 8 + 2 * e;
        const float v0 = (k < 64) ? Cre[k] : -Cim[k - 64];
        const float v1 = (k < 64) ? Cre[k + 1] : -Cim[k + 1 - 64];
        pk[e] = pack2(v0, v1);
      }
      cf[ks] = __builtin_bit_cast(bf16x8, uint4{pk[0], pk[1], pk[2], pk[3]});
    }
  }
  const float dcoef = p.in[18][l * 512 + g * 16 + l16];
  float xr = 0.f, xi = 0.f;
  uint4 ua = uint4{0u, 0u, 0u, 0u};
  bf16_t ue[4];
  auto gload = [&](int c) {
    if (quad < 2) ua = *(const uint4*)(Pm + (size_t)(c * 16 + l16) * PLD + quad * 8);
#pragma unroll
    for (int r = 0; r < 4; ++r) ue[r] = Pm[(size_t)(c * 16 + quad * 4 + r) * PLD + l16];
  };
  __syncthreads();
  gload(0);
  constexpr int NC = SEQ / 16;
  for (int c = 0; c < NC; ++c) {
    const bf16x8 afr = __builtin_bit_cast(bf16x8, ua);
    float us[4];
#pragma unroll
    for (int r = 0; r < 4; ++r) us[r] = bf2f(ue[r]);
#pragma unroll
    for (int jb = 0; jb < 8; ++jb) {
      f32x4 acc = {0.f, 0.f, 0.f, 0.f};
      acc = __builtin_amdgcn_mfma_f32_16x16x32_bf16(afr, bbf[jb], acc, 0, 0, 0);
#pragma unroll
      for (int r = 0; r < 4; ++r) buT[(quad * 4 + r) * BUS + jb * 16 + l16] = acc[r];
    }
    if (c + 1 < NC) gload(c + 1);
    __syncthreads();
#pragma unroll
    for (int t = 0; t < 16; ++t) {
      const float ur = buT[t * BUS + lane], ui = buT[t * BUS + 64 + lane];
      const float nr = ab.x * xr - ab.y * xi + ur;
      const float ni = ab.x * xi + ab.y * xr + ui;
      xr = nr; xi = ni;
      hist[t * 136 + lane] = f2bf(xr);
      hist[t * 136 + 64 + lane] = f2bf(xi);
    }
    __syncthreads();
    f32x4 acc = {0.f, 0.f, 0.f, 0.f};
#pragma unroll
    for (int ks = 0; ks < 4; ++ks) {
      const bf16x8 a = *(const bf16x8*)(hist + l16 * 136 + ks * 32 + quad * 8);
      acc = __builtin_amdgcn_mfma_f32_16x16x32_bf16(a, cf[ks], acc, 0, 0, 0);
    }
#pragma unroll
    for (int r = 0; r < 4; ++r) {
      const int t = quad * 4 + r;
      const float y = acc[r] + dcoef * us[r];
      const float z = y * sigm(1.5957691216057308f * (y + 0.044715f * y * y * y));
      Z[(size_t)(c * 16 + t) * 512 + l16] = f2bf(z);
    }
  }
}

#define GSYNC() xcd_barrier(xb)
#define TILE_MAP(u_, ntm_, tm_, tn_) { const int _x = (u_) & 7, _li = (u_) >> 3, _per = (ntm_) >> 3; tm_ = _x * _per + (_li % _per); tn_ = _li / _per; }
__global__ void __launch_bounds__(256, 2) mega_kernel(Params p) {
  cg::grid_group grid = cg::this_grid();
  __shared__ __attribute__((aligned(16))) char smem[SMEM_BYTES];
  __shared__ uint4 xb_words;
  const int bid = blockIdx.x, nb = gridDim.x;
  if (p.ws == nullptr) grid.sync();
  if (threadIdx.x == 0) xb_words = make_uint4(0u, 0u, 0u, 0u);
  __syncthreads();
  const XcdBarrier xb = xcd_barrier_post((unsigned*)(p.ws + OFF_BAR), (volatile LAS unsigned*)&xb_words);
  char* ws = p.ws;
  float* X = p.out;
  bf16_t* Wt_in = (bf16_t*)(ws + OFF_WIN);
  bf16_t* Wt_q = (bf16_t*)(ws + OFF_WQ);
  bf16_t* Wt_br = (bf16_t*)(ws + OFF_WBR);
  bf16_t* Wt_out = (bf16_t*)(ws + OFF_WOUT);
  bf16_t* Wt_glu = (bf16_t*)(ws + OFF_WGLU);
  bf16_t* Wt_wup = (bf16_t*)(ws + OFF_WWUP);
  bf16_t* Wt_aup = (bf16_t*)(ws + OFF_WAUP);
  bf16_t* Wt_gup = (bf16_t*)(ws + OFF_WGUP);
  bf16_t* Wt_v = (bf16_t*)(ws + OFF_WV);
  bf16_t* Wt_xkv = (bf16_t*)(ws + OFF_WXKV);
  bf16_t* Hb = (bf16_t*)(ws + OFF_H);
  bf16_t* Vfirst = (bf16_t*)(ws + OFF_VFIRST);
  bf16_t* Kx = (bf16_t*)(ws + OFF_KX);
  bf16_t* VxT = (bf16_t*)(ws + OFF_VXT);
  bf16_t* Hm = (bf16_t*)(ws + OFF_HM);
  float* CosT = (float*)(ws + OFF_COS);
  float* SinT = (float*)(ws + OFF_SIN);
  bf16_t* Pm = (bf16_t*)(ws + R_P);
  bf16_t* Cqn = (bf16_t*)(ws + R_CQN);
  bf16_t* Qp = (bf16_t*)(ws + R_QP);
  bf16_t* KVlat = (bf16_t*)(ws + R_KVLAT);
  bf16_t* VTm = (bf16_t*)(ws + R_VT);
  bf16_t* RKV = (bf16_t*)(ws + R_RKV);
  bf16_t* Alora = (bf16_t*)(ws + R_ALORA);
  bf16_t* Yrw = (bf16_t*)(ws + R_YRW);
  bf16_t* Zs5 = (bf16_t*)(ws + R_ZS5);
  bf16_t* Ybr = (bf16_t*)(ws + R_YBR);
  bf16_t* Wt_xq = (bf16_t*)(ws + R_WXQ);
  bf16_t* Wt_xo = (bf16_t*)(ws + R_WXO);
  bf16_t* Wt_gu = (bf16_t*)(ws + R_WGU);
  bf16_t* Wt_down = (bf16_t*)(ws + R_WDOWN);
  bf16_t* Qx = (bf16_t*)(ws + R_QX);
  bf16_t* Ox = (bf16_t*)(ws + R_OX);
  bf16_t* GU = (bf16_t*)(ws + R_GU);
  const float LOG2E = 1.4426950408889634f;

  for (int l = 0; l < 2; ++l) {
    {
      PHASE_IDS
      const float* w_in = p.in[4] + (size_t)l * 1024 * P_IN;
      transpose_all(w_in, P_IN, 1024, P_IN, Wt_in, bid, nb, smem);
      transpose_all(p.in[36] + (size_t)l * 512 * 1024, 1024, 512, 1024, Wt_br + (size_t)1 * 1024 * 512, bid, nb, smem);
      transpose_all(p.in[37] + (size_t)l * 512 * 1024, 1024, 512, 1024, Wt_br + (size_t)2 * 1024 * 512, bid, nb, smem);
      transpose_all(p.in[38] + (size_t)l * 512 * 1024, 1024, 512, 1024, Wt_br + (size_t)3 * 1024 * 512, bid, nb, smem);
      transpose_all(p.in[39] + (size_t)l * 1024 * 1024, 1024, 1024, 1024, Wt_out, bid, nb, smem);
      transpose_all(p.in[19] + (size_t)l * 512 * 512, 512, 512, 512, Wt_glu, bid, nb, smem);
      transpose_all(p.in[23] + (size_t)l * 64 * 512, 512, 64, 512, Wt_wup, bid, nb, smem);
      transpose_all(p.in[25] + (size_t)l * 64 * 512, 512, 64, 512, Wt_aup, bid, nb, smem);
      transpose_all(p.in[26] + (size_t)l * 128 * 512, 512, 128, 512, Wt_gup, bid, nb, smem);
      transpose_all(p.in[43] + (size_t)l * 1024 * 2048, 2048, 1024, 2048, Wt_xkv, bid, nb, smem);
      const int gtid = bid * 256 + tid, gsz = nb * 256;
      {
        const float* w_uq = p.in[6] + (size_t)l * 256 * 768;
        const float* w_ukv = p.in[8] + (size_t)l * 128 * 1024;
        for (int e = gtid; e < 768 * 256; e += gsz) {
          const int n = e >> 8, kq = e & 255, hh = n / 192, j = n % 192;
          float v;
          if (j >= 128) v = w_uq[kq * 768 + n];
          else {
            const float4* a = (const float4*)(w_uq + kq * 768 + hh * 192);
            const float4* b = (const float4*)(w_ukv + j * 1024 + hh * 256);
            float v0 = 0.f, v1 = 0.f, v2 = 0.f, v3 = 0.f;
#pragma unroll 8
            for (int d = 0; d < 32; ++d) { const float4 x = a[d], y = b[d]; v0 += x.x * y.x; v1 += x.y * y.y; v2 += x.z * y.z; v3 += x.w * y.w; }
            v = (v0 + v1) + (v2 + v3);
          }
          Wt_q[e] = f2bf(v);
        }
        const float* w_bm = p.in[35] + (size_t)l * 512 * 1024;
        for (int e = gtid; e < 1024 * 512; e += gsz) {
          const int n = e & 1023, kk = e >> 10, hh = kk >> 7, j = kk & 127;
          const float* a = w_ukv + j * 1024 + hh * 256 + 128;
          const float* bcol = w_bm + (size_t)(hh * 128) * 1024 + n;
          float v0 = 0.f, v1 = 0.f, v2 = 0.f, v3 = 0.f;
#pragma unroll 4
          for (int d = 0; d < 128; d += 4) {
            const float4 x = *(const float4*)(a + d);
            v0 += x.x * bcol[(size_t)(d + 0) * 1024]; v1 += x.y * bcol[(size_t)(d + 1) * 1024];
            v2 += x.z * bcol[(size_t)(d + 2) * 1024]; v3 += x.w * bcol[(size_t)(d + 3) * 1024];
          }
          Wt_br[(size_t)n * 512 + kk] = f2bf((v0 + v1) + (v2 + v3));
        }
        if (l == 1) {
          const float* vd = p.in[32];
          const float* vu = p.in[33];
          for (int e = gtid; e < 512 * 1024; e += gsz) {
            const int n = e & 511, kk = e >> 9;
            float v0 = 0.f, v1 = 0.f, v2 = 0.f, v3 = 0.f;
#pragma unroll
            for (int r = 0; r < 32; r += 4) {
              const float4 x = *(const float4*)(vd + kk * 32 + r);
              v0 += x.x * vu[(r + 0) * 512 + n]; v1 += x.y * vu[(r + 1) * 512 + n];
              v2 += x.z * vu[(r + 2) * 512 + n]; v3 += x.w * vu[(r + 3) * 512 + n];
            }
            Wt_v[(size_t)n * 1024 + kk] = f2bf((v0 + v1) + (v2 + v3));
          }
        }
      }
      {
        float* lbt = (float*)(ws + OFF_BAR) + 3456;
        for (int e = gtid; e < 512; e += gsz) {
          const float x0 = p.in[9][e], x1 = p.in[9][512 + e];
          lbt[e] = (l == 0) ? 0.f : 1.f / (1.f + expf(x0 - x1));
        }
      }
      {
        float* abp = (float*)(ws + OFF_S5AB);
        float* bbp = (float*)(ws + OFF_S5BB);
        for (int e = gtid; e < 2048; e += gsz) {
          const int g = e >> 6;
          const float are = fminf(p.in[11][l * 2048 + e], -1e-4f), aim = p.in[12][l * 2048 + e];
          const float dt = expf(p.in[13][l * 32 + g]);
          const float mag = expf(dt * are);
          const float abre = mag * cosf(dt * aim), abim = mag * sinf(dt * aim);
          const float den = are * are + aim * aim;
          const float zre = ((abre - 1.f) * are + abim * aim) / den;
          const float zim = (abim * are - (abre - 1.f) * aim) / den;
          abp[e * 2] = abre; abp[e * 2 + 1] = abim;
          const float* Br = p.in[14] + (size_t)l * 32768 + (size_t)e * 16;
          const float* Bi = p.in[15] + (size_t)l * 32768 + (size_t)e * 16;
          for (int c = 0; c < 16; ++c) {
            bbp[e * 32 + c] = zre * Br[c] - zim * Bi[c];
            bbp[e * 32 + 16 + c] = zre * Bi[c] + zim * Br[c];
          }
        }
      }
      if (l == 0) rmsnorm_rows(p.in[0], p.in[3], Hb, X, T_ALL, bid, nb);
      else rmsnorm_rows(X, p.in[3] + 1024, Hb, nullptr, T_ALL, bid, nb);
      rmsnorm_rows(p.in[1], p.in[41] + l * 1024, Hm, nullptr, 1024, bid, nb);
    }
    GSYNC();

    for (int half = 0; half < 2; ++half) {
      const bf16_t* Hh = Hb + (size_t)half * TH * 1024;
      {
        const int n1 = 64 * 38;
        const int n2 = (half == 0) ? 8 * 16 : 0;
        int par = 0;
        for (int u = bid; u < n1 + n2; u += nb) {
          f32x4 acc[4][4];
          zero_acc<4>(acc);
          if (u < n1) {
            int tm, tn; TILE_MAP(u, 64, tm, tn);
            int tmn = tm, tnn = tn; if (u + nb < n1) TILE_MAP(u + nb, 64, tmn, tnn);
            gemm_acc<128>(Hh + (size_t)tm * 128 * 1024, 1024, Wt_in + (size_t)tn * 128 * 1024, 1024, 1024, smem, acc,
                          Hh + (size_t)tmn * 128 * 1024, 1024, Wt_in + (size_t)tnn * 128 * 1024, 1024, u != bid, par);
            EPI4_FOR(128) {
              const int row = tm * 128 + EPI_ROW, n = tn * 128 + EPI4_COL(128);
              if (n < GATE_OFF) {
                const int pc = (n < 448) ? n : n + 64;
                f32x4 ov = acc[i][j];
                if (n >= 960 && n < 1472) {
                  const float4 lb4 = *(const float4*)((const float*)(ws + OFF_BAR) + 3456 + (n - 960));
                  ov[0] = (1.f - lb4.x) * sigm(-ov[0]); ov[1] = (1.f - lb4.y) * sigm(-ov[1]);
                  ov[2] = (1.f - lb4.z) * sigm(-ov[2]); ov[3] = (1.f - lb4.w) * sigm(-ov[3]);
                }
                *(uint2*)(Pm + (size_t)row * PLD + pc) = pack4(ov);
              }
            }
          } else {
            const int v = u - n1, tn = v % 16, tm = v / 16;
            gemm_acc<128>(Hm + (size_t)tm * 128 * 1024, 1024, Wt_xkv + (size_t)tn * 128 * 1024, 1024, 1024, smem, acc);
            EPI_FOR(128) {
              const int row = tm * 128 + EPI_ROW, n = tn * 128 + EPI_COL(128);
              const int b = row >> 8, m = row & 255, sel = n >> 10, hh = (n >> 8) & 3, d = n & 255;
              if (sel == 0) Kx[((size_t)(b * 4 + hh) * 256 + m) * 256 + d] = f2bf(acc[i][j][r]);
              else VxT[((size_t)(b * 4 + hh) * 256 + d) * 256 + m] = f2bf(acc[i][j][r]);
            }
          }
        }
      }
      GSYNC();
      {
      PHASE_IDS
        const float* qn = p.in[5] + l * 256;
        const float* kvn = p.in[7] + l * 128;
        const float* mu = p.in[21] + l * 1792;
        for (int tk = bid * 4 + wave; tk < TH; tk += nb * 4) {
          const int gtok = half * TH + tk, s = gtok & (SEQ - 1), bl = tk >> 12;
          const bf16_t* prow = Pm + (size_t)tk * PLD;
          {
            const uint2 cu = *(const uint2*)(prow + lane * 4);
            float f[4] = {bflo(cu.x), bfhi(cu.x), bflo(cu.y), bfhi(cu.y)};
            float ss = wave_sum(f[0] * f[0] + f[1] * f[1] + f[2] * f[2] + f[3] * f[3]);
            const float rs = rsqrtf(ss * (1.f / 256.f) + 1e-6f);
            const float4 g4 = *(const float4*)(qn + lane * 4);
            uint2 o; o.x = pack2(f[0] * rs * g4.x, f[1] * rs * g4.y); o.y = pack2(f[2] * rs * g4.z, f[3] * rs * g4.w);
            *(uint2*)(Cqn + (size_t)tk * 256 + lane * 4) = o;
          }
          {
            const unsigned cu = *(const unsigned*)(prow + 256 + lane * 2);
            const float f0 = bflo(cu), f1 = bfhi(cu);
            const float ss = wave_sum(f0 * f0 + f1 * f1);
            const float rs = rsqrtf(ss * (1.f / 128.f) + 1e-6f);
            const float v0 = f0 * rs * kvn[lane * 2], v1 = f1 * rs * kvn[lane * 2 + 1];
            const bf16_t b0 = f2bf(v0), b1 = f2bf(v1);
            *(unsigned*)(KVlat + (size_t)tk * 192 + lane * 2) = (unsigned)b0 | ((unsigned)b1 << 16);
            VTm[((size_t)bl * 128 + lane * 2) * SEQ + s] = b0;
            VTm[((size_t)bl * 128 + lane * 2 + 1) * SEQ + s] = b1;
          }
          if (lane < 32) {
            const float t1 = bf2f(prow[384 + lane]), t2 = bf2f(prow[384 + 32 + lane]);
            const float posf = (float)p.pos[gtok];
            const float invf = exp2f(-(float)lane * (13.287712379549449f / 32.f));
            const float ang = posf * invf;
            const float cs = cosf(ang), sn = sinf(ang);
            KVlat[(size_t)tk * 192 + 128 + lane] = f2bf(t1 * cs - t2 * sn);
            KVlat[(size_t)tk * 192 + 160 + lane] = f2bf(t1 * sn + t2 * cs);
            CosT[tk * 32 + lane] = cs; SinT[tk * 32 + lane] = sn;
          }
#pragma unroll
          for (int jj = 0; jj < 7; ++jj) {
            const int col = (jj * 64 + lane) * 4;
            const uint2 cu = *(const uint2*)(prow + PC_RW + col);
            uint2 pu = uint2{0u, 0u};
            if (s > 0) pu = *(const uint2*)(prow - PLD + PC_RW + col);
            const float4 m4 = *(const float4*)(mu + col);
            const float cv[4] = {bflo(cu.x), bfhi(cu.x), bflo(cu.y), bfhi(cu.y)};
            const float pv[4] = {bflo(pu.x), bfhi(pu.x), bflo(pu.y), bfhi(pu.y)};
            const float mm[4] = {m4.x, m4.y, m4.z, m4.w};
            float o[4];
#pragma unroll
            for (int e = 0; e < 4; ++e) o[e] = cv[e] + (pv[e] - cv[e]) * mm[e];
            if (col < 1536) {
              uint2 ov; ov.x = pack2(o[0], o[1]); ov.y = pack2(o[2], o[3]);
              *(uint2*)(RKV + (size_t)tk * 1536 + col) = ov;
              if (l == 0 && col >= 1024) *(uint2*)(Vfirst + (size_t)gtok * 512 + (col - 1024)) = ov;
            } else {
              int dc;
              if (col < 1600) { dc = col - 1536; for (int e = 0; e < 4; ++e) o[e] = tanhf(o[e]); }
              else if (col < 1664) { dc = 64 + col - 1600; }
              else { dc = 128 + col - 1664; for (int e = 0; e < 4; ++e) o[e] = sigm(o[e]); }
              uint2 ov; ov.x = pack2(o[0], o[1]); ov.y = pack2(o[2], o[3]);
              *(uint2*)(Alora + (size_t)tk * 256 + dc) = ov;
            }
          }
        }
      }
      GSYNC();
      {
      PHASE_IDS
        const int nq = 64 * 6, nl = 64 * 4;
        const int total = nq + 3 * nl + (l == 1 ? nl : 0);
        for (int u = bid; u < total; u += nb) {
          f32x4 acc[4][4];
          zero_acc<4>(acc);
          if (u < nq) {
            int tm, tn; TILE_MAP(u, 64, tm, tn);
            gemm_acc<128>(Cqn + (size_t)tm * 128 * 256, 256, Wt_q + (size_t)tn * 128 * 256, 256, 256, smem, acc);
            const float qs = 0.07216878364870322f * LOG2E;
            const int lane_ = tid & 63, wave_ = tid >> 6, wm_ = wave_ >> 1, wn_ = wave_ & 1, l16_ = lane_ & 15, quad_ = lane_ >> 4;
            const int gc = tn * 128 + wn_ * 64;
            const bool is_rope = (gc % 192) == 128;
#pragma unroll
            for (int i = 0; i < 4; ++i) {
              const int row = tm * 128 + wm_ * 64 + i * 16 + l16_;
              if (is_rope) {
#pragma unroll
                for (int j = 0; j < 2; ++j) {
                  const int fi = j * 16 + quad_ * 4;
                  const float4 cs = *(const float4*)(CosT + row * 32 + fi), sn = *(const float4*)(SinT + row * 32 + fi);
                  const float c4[4] = {cs.x, cs.y, cs.z, cs.w}, s4[4] = {sn.x, sn.y, sn.z, sn.w};
#pragma unroll
                  for (int r = 0; r < 4; ++r) {
                    const float t1 = acc[i][j][r], t2 = acc[i][j + 2][r];
                    acc[i][j][r] = t1 * c4[r] - t2 * s4[r]; acc[i][j + 2][r] = t1 * s4[r] + t2 * c4[r];
                  }
                }
              }
#pragma unroll
              for (int j = 0; j < 4; ++j) *(uint2*)(Qp + (size_t)row * 768 + gc + j * 16 + quad_ * 4) = pack4(acc[i][j] * qs);
            }
          } else if (u < nq + 3 * nl) {
            const int v = u - nq, which = v / nl, w2 = v % nl, tn = w2 % 4, tm = w2 / 4;
            if (which == 0) {
              gemm_acc<128>(Alora + (size_t)tm * 128 * 256, 256, Wt_wup + (size_t)tn * 128 * 64, 64, 64, smem, acc);
              const float* w0 = p.in[22] + l * 512;
              EPI4_FOR(128) {
                const int row = tm * 128 + EPI_ROW, n = tn * 128 + EPI4_COL(128);
                const float4 b4 = *(const float4*)(w0 + n);
                f32x4 wv = acc[i][j] + f32x4{b4.x, b4.y, b4.z, b4.w};
#pragma unroll
                for (int r = 0; r < 4; ++r) wv[r] = -0.6065306597126334f * sigm(wv[r]);
                *(uint2*)(Pm + (size_t)row * PLD + PC_RW + n) = pack4(wv);
              }
            } else if (which == 1) {
              gemm_acc<128>(Alora + (size_t)tm * 128 * 256 + 64, 256, Wt_aup + (size_t)tn * 128 * 64, 64, 64, smem, acc);
              const float* a0 = p.in[24] + l * 512;
              EPI4_FOR(128) {
                const int row = tm * 128 + EPI_ROW, n = tn * 128 + EPI4_COL(128);
                const float4 b4 = *(const float4*)(a0 + n);
                f32x4 v = acc[i][j] + f32x4{b4.x, b4.y, b4.z, b4.w};
#pragma unroll
                for (int r = 0; r < 4; ++r) v[r] = sigm(v[r]);
                *(uint2*)(Pm + (size_t)row * PLD + PC_RW + 512 + n) = pack4(v);
              }
            } else {
              gemm_acc<128>(Alora + (size_t)tm * 128 * 256 + 128, 256, Wt_gup + (size_t)tn * 128 * 128, 128, 128, smem, acc);
              EPI4_FOR(128) {
                const int row = tm * 128 + EPI_ROW, n = tn * 128 + EPI4_COL(128);
                *(uint2*)(Pm + (size_t)row * PLD + PC_RW + 1024 + n) = pack4(acc[i][j]);
              }
            }
          } else {
            const int w2 = u - nq - 3 * nl, tn = w2 % 4, tm = w2 / 4;
            gemm_acc<128>(Hh + (size_t)tm * 128 * 1024, 1024, Wt_v + (size_t)tn * 128 * 1024, 1024, 1024, smem, acc);
            const float* vb = p.in[34];
            EPI4_FOR(128) {
              const int row = tm * 128 + EPI_ROW, n = tn * 128 + EPI4_COL(128);
              const float4 b4 = *(const float4*)(vb + n);
              const f32x4 lg = acc[i][j] + f32x4{b4.x, b4.y, b4.z, b4.w};
              const f32x4 vc = unpack4(*(const uint2*)(RKV + (size_t)row * 1536 + 1024 + n));
              const f32x4 vf = unpack4(*(const uint2*)(Vfirst + ((size_t)half * TH + row) * 512 + n));
              f32x4 o;
#pragma unroll
              for (int r = 0; r < 4; ++r) o[r] = vc[r] + (vf[r] - vc[r]) * sigm(lg[r]);
              *(uint2*)(RKV + (size_t)row * 1536 + 1024 + n) = pack4(o);
            }
          }
        }
      }
      GSYNC();
      {
        int first, count, step;
        if (nb == 512) {
          if (bid < 144) { first = bid; count = 1; step = 0; }
          else {
            int pi = -1;
            if (bid < 256) pi = bid - 144; else if (bid >= 400 && bid < 416) pi = 112 + (bid - 400);
            first = 144 + pi; count = (pi >= 0) ? 2 : 0; step = 255 - 2 * pi;
          }
        } else { first = bid; step = nb; count = (bid < 400) ? (400 - bid + nb - 1) / nb : 0; }
#pragma unroll 1
        for (int q = 0; q < count; ++q) {
          const int u = first + q * step;
          if (u < 144) {
            __builtin_amdgcn_s_setprio(3);
            if (u < 64) rwkv_scan_unit(p, l, u, smem);
            else if (u < 128) hgrn_scan_unit(p, l, u - 64, smem);
            else s5_scan_unit(p, l, u - 128, smem);
            __builtin_amdgcn_s_setprio(0);
          } else {
            const int it = u - 144, qt = 31 - (it >> 3), bl = (it >> 2) & 1, hh = it & 3;
            attn_item_pf<192, true>(Qp + (size_t)bl * SEQ * 768 + hh * 192, 768, KVlat + (size_t)bl * SEQ * 192, 192,
                                    VTm + (size_t)bl * 128 * SEQ, SEQ, (qt * 128 + 128) / 64, qt * 128,
                                    Pm + (size_t)bl * SEQ * PLD + hh * 128, PLD, smem);
          }
        }
        {
          unsigned char* G8 = (unsigned char*)(ws + R_G8);
          int g0, gs;
          if (nb == 512) { g0 = (bid >= 416) ? bid - 416 : 2048; gs = 96; } else { g0 = bid; gs = nb; }
#pragma unroll 1
          for (int t = g0; t < 2048; t += gs) {
            const int tm = t >> 5, tn = t & 31;
            f32x4 acc[4][4];
            zero_acc<4>(acc);
            gemm_acc<128>(Hh + (size_t)tm * 128 * 1024, 1024, Wt_in + (size_t)(GATE_OFF + tn * 128) * 1024, 1024, 1024, smem, acc);
            EPI4_FOR(128) {
              const int row = tm * 128 + EPI_ROW, n = tn * 128 + EPI4_COL(128);
              unsigned q = 0;
#pragma unroll
              for (int r = 0; r < 4; ++r) q |= ((unsigned)(sigm(acc[i][j][r]) * 255.f + 0.5f)) << (8 * r);
              *(unsigned*)(G8 + (size_t)row * 4096 + n) = q;
            }
          }
        }
      }
      GSYNC();
      {
      PHASE_IDS
        const int nglu = 64 * 4;
        for (int u = bid; u < nglu; u += nb) {
          int tm, tn; TILE_MAP(u, 64, tm, tn);
          f32x4 acc[4][4];
          zero_acc<4>(acc);
          gemm_acc<128>(Zs5 + (size_t)tm * 128 * 512, 512, Wt_glu + (size_t)tn * 128 * 512, 512, 512, smem, acc);
          const float* bg = p.in[20] + l * 512;
          EPI4_FOR(128) {
            const int row = tm * 128 + EPI_ROW, n = tn * 128 + EPI4_COL(128);
            const f32x4 z = unpack4(*(const uint2*)(Zs5 + (size_t)row * 512 + n));
            const float4 b4 = *(const float4*)(bg + n);
            const f32x4 lg = acc[i][j] + f32x4{b4.x, b4.y, b4.z, b4.w};
            f32x4 o;
#pragma unroll
            for (int r = 0; r < 4; ++r) o[r] = z[r] * sigm(lg[r]);
            *(uint2*)(Pm + (size_t)row * PLD + PC_S5 + n) = pack4(o);
          }
        }
        const float* k_a = p.in[28] + l * 512;
        const float* r_k = p.in[29] + l * 512;
        const float* ln_w = p.in[30] + l * 512;
        const float* ln_b = p.in[31] + l * 512;
        const float* o_norm = p.in[10] + l * 512;
        for (int tk = bid * 4 + wave; tk < TH; tk += nb * 4) {
          const int c0 = lane * 8;
          {
            const uint4 yu = *(const uint4*)(Yrw + (size_t)tk * 512 + c0);
            const float y[8] = {bflo(yu.x), bfhi(yu.x), bflo(yu.y), bfhi(yu.y), bflo(yu.z), bfhi(yu.z), bflo(yu.w), bfhi(yu.w)};
            const uint4 ru = *(const uint4*)(RKV + (size_t)tk * 1536 + c0);
            const uint4 ku = *(const uint4*)(RKV + (size_t)tk * 1536 + 512 + c0);
            const uint4 vu = *(const uint4*)(RKV + (size_t)tk * 1536 + 1024 + c0);
            const uint4 au = *(const uint4*)(Pm + (size_t)tk * PLD + PC_RW + 512 + c0);
            const uint4 gu = *(const uint4*)(Pm + (size_t)tk * PLD + PC_RW + 1024 + c0);
            const unsigned ra[4] = {ru.x, ru.y, ru.z, ru.w}, ka[4] = {ku.x, ku.y, ku.z, ku.w}, va[4] = {vu.x, vu.y, vu.z, vu.w};
            const unsigned aa[4] = {au.x, au.y, au.z, au.w}, ga[4] = {gu.x, gu.y, gu.z, gu.w};
            float rr[8], kh[8], vv[8], gg[8];
            float sm1 = 0.f, bsum = 0.f;
#pragma unroll
            for (int e = 0; e < 8; ++e) {
              const unsigned sh = (e & 1);
              rr[e] = sh ? bfhi(ra[e >> 1]) : bflo(ra[e >> 1]);
              const float kx = sh ? bfhi(ka[e >> 1]) : bflo(ka[e >> 1]);
              vv[e] = sh ? bfhi(va[e >> 1]) : bflo(va[e >> 1]);
              const float a = sh ? bfhi(aa[e >> 1]) : bflo(aa[e >> 1]);
              gg[e] = sh ? bfhi(ga[e >> 1]) : bflo(ga[e >> 1]);
              kh[e] = kx * (1.f + (a - 1.f) * k_a[c0 + e]);
              sm1 += y[e];
              bsum += rr[e] * kh[e] * r_k[c0 + e];
            }
            sm1 = red8(sm1); bsum = red8(bsum);
            const float mean = sm1 * (1.f / 64.f);
            float vs = 0.f;
#pragma unroll
            for (int e = 0; e < 8; ++e) { const float d = y[e] - mean; vs += d * d; }
            vs = red8(vs);
            const float rstd = rsqrtf(vs * (1.f / 64.f) + 64e-5f);
            float o[8];
#pragma unroll
            for (int e = 0; e < 8; ++e) o[e] = (((y[e] - mean) * rstd) * ln_w[c0 + e] + ln_b[c0 + e] + bsum * vv[e]) * gg[e];
            uint4 ov; ov.x = pack2(o[0], o[1]); ov.y = pack2(o[2], o[3]); ov.z = pack2(o[4], o[5]); ov.w = pack2(o[6], o[7]);
            *(uint4*)(RKV + (size_t)tk * 1536 + c0) = ov;
          }
          {
            bf16_t* op = Pm + (size_t)tk * PLD + PC_HG + 1024 + c0;
            const uint4 ou = *(const uint4*)op;
            const uint4 gu = *(const uint4*)(Pm + (size_t)tk * PLD + PC_HG + 1536 + c0);
            const unsigned oa[4] = {ou.x, ou.y, ou.z, ou.w}, ga[4] = {gu.x, gu.y, gu.z, gu.w};
            float o[8], ss = 0.f;
#pragma unroll
            for (int e = 0; e < 4; ++e) { o[2 * e] = bflo(oa[e]); o[2 * e + 1] = bfhi(oa[e]); }
#pragma unroll
            for (int e = 0; e < 8; ++e) ss += o[e] * o[e];
            ss = red16(ss);
            const float rs = rsqrtf(ss * (1.f / 128.f) + 1e-6f);
            float r8[8];
#pragma unroll
            for (int e = 0; e < 8; ++e) {
              const float gte = (e & 1) ? bfhi(ga[e >> 1]) : bflo(ga[e >> 1]);
              r8[e] = o[e] * rs * o_norm[c0 + e] * sigm(gte);
            }
            uint4 ov; ov.x = pack2(r8[0], r8[1]); ov.y = pack2(r8[2], r8[3]); ov.z = pack2(r8[4], r8[5]); ov.w = pack2(r8[6], r8[7]);
            *(uint4*)op = ov;
          }
        }
      }
      GSYNC();
      {
        int par6 = 0;
        const unsigned char* G8 = (const unsigned char*)(ws + R_G8);
        auto brA = [&](int m, int tm_, int& lda_) -> const bf16_t* {
          const bf16_t* Ao;
          if (m == 0) { Ao = Pm; lda_ = PLD; }
          else if (m == 1) { Ao = Pm + PC_HG + 1024; lda_ = PLD; }
          else if (m == 2) { Ao = Pm + PC_S5; lda_ = PLD; }
          else { Ao = RKV; lda_ = 1536; }
          return Ao + (size_t)tm_ * 128 * lda_;
        };
        for (int u = bid; u < 64 * 8; u += nb) {
          int tm, tn; TILE_MAP(u, 64, tm, tn);
          const bool has_next = (u + nb < 64 * 8);
          int tmn = tm, tnn = tn; if (has_next) TILE_MAP(u + nb, 64, tmn, tnn);
          f32x4 yacc[4][4];
          zero_acc<4>(yacc);
#pragma unroll 1
          for (int m = 0; m < 4; ++m) {
            f32x4 ao[4][4];
            zero_acc<4>(ao);
            int ldo; const bf16_t* Ao = brA(m, tm, ldo);
            const bf16_t* Bo = Wt_br + ((size_t)m * 1024 + tn * 128) * 512;
            const int mn = (m < 3) ? m + 1 : 0;
            const int tmx = (m < 3) ? tm : tmn, tnx = (m < 3) ? tn : tnn;
            int ldn; const bf16_t* An = brA(mn, tmx, ldn);
            const bf16_t* Bn = Wt_br + ((size_t)mn * 1024 + tnx * 128) * 512;
            gemm_acc<128>(Ao, ldo, Bo, 512, 512, smem, ao, An, ldn, Bn, 512, !(m == 0 && u == bid), par6);
            {
              EPI4_FOR(128) {
                const int row = tm * 128 + EPI_ROW, n = tn * 128 + EPI4_COL(128);
                const unsigned q = *(const unsigned*)(G8 + (size_t)row * 4096 + m * 1024 + n);
#pragma unroll
                for (int r = 0; r < 4; ++r) yacc[i][j][r] += ao[i][j][r] * ((float)((q >> (8 * r)) & 255u) * (1.f / 255.f));
              }
            }
          }
          {
            f32x4 (&acc)[4][4] = yacc;
            EPI4_FOR(128) {
              const int row = tm * 128 + EPI_ROW, n = tn * 128 + EPI4_COL(128);
              *(uint2*)(Ybr + (size_t)row * 1024 + n) = pack4(acc[i][j]);
            }
          }
        }
      }
      GSYNC();
      {
        int par = 0;
        for (int u = bid; u < 64 * 8; u += nb) {
          int tm, tn; TILE_MAP(u, 64, tm, tn);
          int tmn = tm, tnn = tn; if (u + nb < 64 * 8) TILE_MAP(u + nb, 64, tmn, tnn);
          f32x4 acc[4][4];
          zero_acc<4>(acc);
          gemm_acc<128>(Ybr + (size_t)tm * 128 * 1024, 1024, Wt_out + (size_t)tn * 128 * 1024, 1024, 1024, smem, acc,
                        Ybr + (size_t)tmn * 128 * 1024, 1024, Wt_out + (size_t)tnn * 128 * 1024, 1024, u != bid, par);
          EPI4_FOR(128) {
            const int row = half * TH + tm * 128 + EPI_ROW, n = tn * 128 + EPI4_COL(128);
            float4* xp = (float4*)(X + (size_t)row * 1024 + n);
            float4 xv = *xp; xv.x += acc[i][j][0]; xv.y += acc[i][j][1]; xv.z += acc[i][j][2]; xv.w += acc[i][j][3];
            *xp = xv;
          }
        }
      }
      GSYNC();
    }

    {
      transpose_all(p.in[42] + (size_t)l * 1024 * 1024, 1024, 1024, 1024, Wt_xq, bid, nb, smem);
      transpose_all(p.in[44] + (size_t)l * 1024 * 1024, 1024, 1024, 1024, Wt_xo, bid, nb, smem);
      transpose_all(p.in[46] + (size_t)l * 1024 * 5632, 5632, 1024, 5632, Wt_gu, bid, nb, smem);
      transpose_all(p.in[49] + (size_t)l * 2816 * 1024, 1024, 2816, 1024, Wt_down, bid, nb, smem);
      rmsnorm_rows(X, p.in[40] + l * 1024, Hb, nullptr, T_ALL, bid, nb);
    }
    GSYNC();
    {
      const float qs = 0.0625f * LOG2E;
      int par = 0;
      for (int u = bid; u < 128 * 8; u += nb) {
        int tm, tn; TILE_MAP(u, 128, tm, tn);
        int tmn = tm, tnn = tn; if (u + nb < 128 * 8) TILE_MAP(u + nb, 128, tmn, tnn);
        f32x4 acc[4][4];
        zero_acc<4>(acc);
        gemm_acc<128>(Hb + (size_t)tm * 128 * 1024, 1024, Wt_xq + (size_t)tn * 128 * 1024, 1024, 1024, smem, acc,
                      Hb + (size_t)tmn * 128 * 1024, 1024, Wt_xq + (size_t)tnn * 128 * 1024, 1024, u != bid, par);
        EPI4_FOR(128) {
          const int row = tm * 128 + EPI_ROW, n = tn * 128 + EPI4_COL(128);
          *(uint2*)(Qx + (size_t)row * 1024 + n) = pack4(acc[i][j] * qs);
        }
      }
    }
    GSYNC();
    {
      for (int u = bid; u < 1024; u += nb) {
        const int dvh = u & 1, hh = (u >> 1) & 3, qt = (u >> 3) & 31, b = u >> 8;
        attn_item<256, false>(Qx + (size_t)b * SEQ * 1024 + hh * 256, 1024, Kx + (size_t)(b * 4 + hh) * 65536, 256,
                              VxT + (size_t)(b * 4 + hh) * 65536 + (size_t)dvh * 128 * 256, 256, 4, qt * 128,
                              Ox + (size_t)b * SEQ * 1024 + hh * 256 + dvh * 128, 1024, smem);
      }
    }
    GSYNC();
    {
      int par = 0;
      for (int u = bid; u < 128 * 8; u += nb) {
        int tm, tn; TILE_MAP(u, 128, tm, tn);
        int tmn = tm, tnn = tn; if (u + nb < 128 * 8) TILE_MAP(u + nb, 128, tmn, tnn);
        f32x4 acc[4][4];
        zero_acc<4>(acc);
        gemm_acc<128>(Ox + (size_t)tm * 128 * 1024, 1024, Wt_xo + (size_t)tn * 128 * 1024, 1024, 1024, smem, acc,
                      Ox + (size_t)tmn * 128 * 1024, 1024, Wt_xo + (size_t)tnn * 128 * 1024, 1024, u != bid, par);
        EPI4_FOR(128) {
          const int row = tm * 128 + EPI_ROW, n = tn * 128 + EPI4_COL(128);
          float4* xp = (float4*)(X + (size_t)row * 1024 + n);
          float4 xv = *xp; xv.x += acc[i][j][0]; xv.y += acc[i][j][1]; xv.z += acc[i][j][2]; xv.w += acc[i][j][3];
          *xp = xv;
        }
      }
    }
    GSYNC();
    rmsnorm_rows(X, p.in[45] + l * 1024, Hb, nullptr, T_ALL, bid, nb);
    GSYNC();
    for (int half = 0; half < 2; ++half) {
      const bf16_t* Hh = Hb + (size_t)half * TH * 1024;
      int par13 = 0;
      for (int u = bid; u < 64 * 44; u += nb) {
        int tm, tn; TILE_MAP(u, 64, tm, tn);
        int tmn = tm, tnn = tn; if (u + nb < 64 * 44) TILE_MAP(u + nb, 64, tmn, tnn);
        f32x4 acc[4][4];
        zero_acc<4>(acc);
        gemm_acc<128>(Hh + (size_t)tm * 128 * 1024, 1024, Wt_gu + (size_t)tn * 128 * 1024, 1024, 1024, smem, acc,
                      Hh + (size_t)tmn * 128 * 1024, 1024, Wt_gu + (size_t)tnn * 128 * 1024, 1024, u != bid, par13);
        EPI4_FOR(128) {
          const int row = tm * 128 + EPI_ROW, n = tn * 128 + EPI4_COL(128);
          *(uint2*)(GU + (size_t)row * 5632 + n) = pack4(acc[i][j]);
        }
      }
      GSYNC();
      {
      PHASE_IDS
        const float* cw = p.in[47] + (size_t)l * 3 * D_FF;
        const float* cb = p.in[48] + (size_t)l * D_FF;
        for (int e = bid * 256 + tid; e < (TH / 32) * 352; e += nb * 256) {
          const int c0 = (e % 352) * 8, tk0 = (e / 352) * 32;
          float w0[8], w1[8], w2[8], bz[8];
#pragma unroll
          for (int q = 0; q < 8; ++q) { w0[q] = cw[c0 + q]; w1[q] = cw[D_FF + c0 + q]; w2[q] = cw[2 * D_FF + c0 + q]; bz[q] = cb[c0 + q]; }
          bf16_t* gp = GU + (size_t)tk0 * 5632 + c0;
          uint4 gm2 = uint4{0, 0, 0, 0}, gm1 = uint4{0, 0, 0, 0};
          if ((tk0 & (SEQ - 1)) != 0) { gm1 = *(const uint4*)(gp - 5632); gm2 = *(const uint4*)(gp - 2 * 5632); }
          uint4 gc = *(const uint4*)gp, uc = *(const uint4*)(gp + D_FF);
#pragma unroll 2
          for (int t = 0; t < 32; ++t) {
            uint4 gn = gc, un = uc;
            if (t < 31) { gn = *(const uint4*)(gp + 5632); un = *(const uint4*)(gp + 5632 + D_FF); }
            const unsigned a2[4] = {gc.x, gc.y, gc.z, gc.w}, a1[4] = {gm1.x, gm1.y, gm1.z, gm1.w}, a0[4] = {gm2.x, gm2.y, gm2.z, gm2.w};
            const unsigned au[4] = {uc.x, uc.y, uc.z, uc.w};
            float o[8];
#pragma unroll
            for (int q = 0; q < 8; ++q) {
              const bool hi = q & 1;
              const float x2 = hi ? bfhi(a2[q >> 1]) : bflo(a2[q >> 1]);
              const float x1 = hi ? bfhi(a1[q >> 1]) : bflo(a1[q >> 1]);
              const float x0 = hi ? bfhi(a0[q >> 1]) : bflo(a0[q >> 1]);
              const float up = hi ? bfhi(au[q >> 1]) : bflo(au[q >> 1]);
              const float gv = w0[q] * x0 + w1[q] * x1 + w2[q] * x2 + bz[q];
              o[q] = gv * sigm(gv) * up;
            }
            uint4 ov; ov.x = pack2(o[0], o[1]); ov.y = pack2(o[2], o[3]); ov.z = pack2(o[4], o[5]); ov.w = pack2(o[6], o[7]);
            *(uint4*)(gp + D_FF) = ov;
            gm2 = gm1; gm1 = gc; gc = gn; uc = un; gp += 5632;
          }
        }
      }
      GSYNC();
      int par15 = 0;
      for (int u = bid; u < 64 * 8; u += nb) {
        int tm, tn; TILE_MAP(u, 64, tm, tn);
        int tmn = tm, tnn = tn; if (u + nb < 64 * 8) TILE_MAP(u + nb, 64, tmn, tnn);
        f32x4 acc[4][4];
        zero_acc<4>(acc);
        gemm_acc<128>(GU + (size_t)tm * 128 * 5632 + D_FF, 5632, Wt_down + (size_t)tn * 128 * 2816, 2816, 2816, smem, acc,
                      GU + (size_t)tmn * 128 * 5632 + D_FF, 5632, Wt_down + (size_t)tnn * 128 * 2816, 2816, u != bid, par15);
        EPI4_FOR(128) {
          const int row = half * TH + tm * 128 + EPI_ROW, n = tn * 128 + EPI4_COL(128);
          float4* xp = (float4*)(X + (size_t)row * 1024 + n);
          float4 xv = *xp; xv.x += acc[i][j][0]; xv.y += acc[i][j][1]; xv.z += acc[i][j][2]; xv.w += acc[i][j][3];
          *xp = xv;
        }
      }
      GSYNC();
    }
  }

  {
      PHASE_IDS
    const float* g = p.in[50];
    for (int r = bid * 4 + wave; r < T_ALL; r += nb * 4) {
      float4* xr = (float4*)(X + (size_t)r * 1024);
      float4 v[4]; float ss = 0.f;
#pragma unroll
      for (int i = 0; i < 4; ++i) { v[i] = xr[lane + 64 * i]; ss += v[i].x * v[i].x + v[i].y * v[i].y + v[i].z * v[i].z + v[i].w * v[i].w; }
      ss = wave_sum(ss);
      const float rs = rsqrtf(ss * (1.f / 1024.f) + 1e-6f);
#pragma unroll
      for (int i = 0; i < 4; ++i) {
        const float4 gg = ((const float4*)g)[lane + 64 * i];
        xr[lane + 64 * i] = float4{v[i].x * rs * gg.x, v[i].y * rs * gg.y, v[i].z * rs * gg.z, v[i].w * rs * gg.w};
      }
    }
  }
}

extern "C" void kernel_launch(void* const* d_in, const int* in_sizes, int n_in, void* d_out, int out_size, void* d_ws, size_t ws_size,
                              hipStream_t stream) {
  static int grid_blocks = 0;
  if (!grid_blocks) {
    int dev = 0, cus = 0, per_cu = 0;
    hipGetDevice(&dev);
    hipDeviceGetAttribute(&cus, hipDeviceAttributeMultiprocessorCount, dev);
    hipOccupancyMaxActiveBlocksPerMultiprocessor(&per_cu, mega_kernel, 256, 0);
    if (per_cu > 2) per_cu = 2;
    if (per_cu < 1) per_cu = 1;
    grid_blocks = cus * per_cu;
  }
  if (ws_size < WS_NEED) fprintf(stderr, "workspace too small: %zu < %zu\n", ws_size, (size_t)WS_NEED);
  Params p{};
  for (int i = 0; i < 51; ++i) p.in[i] = (const float*)d_in[i];
  p.pos = (const int*)d_in[2];
  p.out = (float*)d_out;
  p.ws = (char*)d_ws;
  hipMemsetAsync((char*)d_ws + OFF_BAR, 0, 16384, stream);
  void* args[] = {&p};
  hipError_t e = hipLaunchCooperativeKernel((void*)mega_kernel, dim3(grid_blocks), dim3(256), args, 0, stream);
  if (e != hipSuccess) fprintf(stderr, "cooperative launch failed: %s (grid %d)\n", hipGetErrorString(e), grid_blocks);
}
```
